# Optimizing an MI355X kernel written in HIP

```python
import math, functools
import jax, jax.numpy as jnp
from jax import lax
import numpy as np

D_MODEL = 1024
BATCH = 8
SEQ = 4096
DEPTH = 4

CTX_LEN = 256
GRID_W = 64
N_MIXERS = 4
D_MIX = D_MODEL
GROUP_W = D_MIX // N_MIXERS
HEAD_DIM = 64
FFN_DIM = ((8 * D_MODEL // 3 + 255) // 256) * 256
MACARON = 0.5
N_MOD = 9
NORM_EPS = 1e-6
SHORT_CONV = 3
S5_P = 16
S5_GROUPS = GROUP_W // S5_P
S5_STATE = 64
S5_DT_MIN = 1e-3
S5_DT_MAX = 1e-1
MLA_HEADS = GROUP_W // HEAD_DIM
MLA_NOPE = HEAD_DIM
MLA_ROPE = HEAD_DIM // 2
MLA_V = HEAD_DIM
MLA_Q_RANK = D_MODEL // 4
MLA_KV_RANK = D_MODEL // 8
ROPE_AXIS = MLA_ROPE // 2
ROPE_BASE = 10000.0
ATTN_BLOCK = 128
RWKV_HEADS = GROUP_W // HEAD_DIM
RWKV_DECAY_LORA = 32
RWKV_A_LORA = 32
RWKV_GATE_LORA = 64
RWKV_GN_EPS = HEAD_DIM * 1e-5
MLSTM_HEADS = GROUP_W // HEAD_DIM
MLSTM_CHUNK = 64
S5_COLS = GROUP_W
MLA_COLS = MLA_Q_RANK + MLA_KV_RANK + MLA_ROPE
RWKV_COLS = 3 * GROUP_W + RWKV_DECAY_LORA + RWKV_A_LORA + RWKV_GATE_LORA
MLSTM_COLS = 4 * GROUP_W + 4 * MLSTM_HEADS
IN_COLS = S5_COLS + MLA_COLS + RWKV_COLS + MLSTM_COLS

kernel_name = 'hybrid_parallel_head_flow_block'


def rms_norm(x, g):
    xf = x.astype(jnp.float32)
    y = xf * lax.rsqrt(jnp.mean(xf * xf, axis=-1, keepdims=True) + NORM_EPS)
    return (y * g.astype(jnp.float32)).astype(x.dtype)


def head_norm(y, heads, eps):
    B, T, W = y.shape
    yh = y.astype(jnp.float32).reshape(B, T, heads, W // heads)
    mu = jnp.mean(yh, axis=-1, keepdims=True)
    var = jnp.mean(jnp.square(yh - mu), axis=-1, keepdims=True)
    return ((yh - mu) * lax.rsqrt(var + eps)).reshape(B, T, W)


def modulate(h, shift, scale):
    return h * (1 + scale) + shift


def swiglu(h, w_gate, w_up, w_down):
    return (jax.nn.silu(h @ w_gate) * (h @ w_up)) @ w_down


def half_ffn(h, shift, scale, gate, g_pre, g_post, w_gate, w_up, w_down):
    y = swiglu(modulate(rms_norm(h, g_pre), shift, scale), w_gate, w_up, w_down)
    return MACARON * gate * rms_norm(y, g_post)


def short_conv(x, w, b):
    pad = SHORT_CONV // 2
    T = x.shape[1]
    xp = jnp.pad(x, ((0, 0), (pad, pad), (0, 0)))
    y = b
    for j in range(SHORT_CONV):
        y = y + xp[:, j:j + T] * w[j]
    return y


def axial_rope_tables(seq_len):
    rows = seq_len // GRID_W
    r_idx, c_idx = jnp.meshgrid(jnp.arange(rows), jnp.arange(GRID_W), indexing='ij')
    inv_freq = 1.0 / (ROPE_BASE ** (jnp.arange(0, ROPE_AXIS, 2, dtype=jnp.float32) / ROPE_AXIS))
    ang_r = r_idx.reshape(-1, 1).astype(jnp.float32) * inv_freq
    ang_c = c_idx.reshape(-1, 1).astype(jnp.float32) * inv_freq
    ang = jnp.concatenate([ang_r, ang_r, ang_c, ang_c], axis=-1)
    return jnp.cos(ang), jnp.sin(ang)


def apply_axial_rope(x, cos, sin):
    h = ROPE_AXIS // 2
    row, col = x[..., :ROPE_AXIS], x[..., ROPE_AXIS:]
    rot = jnp.concatenate([-row[..., h:], row[..., :h], -col[..., h:], col[..., :h]], axis=-1)
    return x * cos.astype(x.dtype) + rot * sin.astype(x.dtype)


def bidirectional(run_fwd, run_bwd, ctx_in, lat_in, h0):
    flip = lambda t: jax.tree.map(lambda a: jnp.flip(a, axis=1), t)
    yc_f, hc_f = run_fwd(ctx_in, h0)
    yl_f, _ = run_fwd(lat_in, hc_f)
    yc_b, hc_b = run_bwd(flip(ctx_in), h0)
    yl_b, _ = run_bwd(flip(lat_in), hc_b)
    return yl_f + jnp.flip(yl_b, axis=1), yc_f + jnp.flip(yc_b, axis=1)


def _complex_combine(e1, e2):
    ar1, ai1, br1, bi1 = e1
    ar2, ai2, br2, bi2 = e2
    return (ar2 * ar1 - ai2 * ai1, ar2 * ai1 + ai2 * ar1,
            ar2 * br1 - ai2 * bi1 + br2, ar2 * bi1 + ai2 * br1 + bi2)


def s5_scan(u, h0, lam_re, lam_im, log_dt, b_re, b_im, c_re, c_im):
    dt = jnp.exp(log_dt)[:, None]
    mag = jnp.exp(lam_re * dt)
    ar, ai = mag * jnp.cos(lam_im * dt), mag * jnp.sin(lam_im * dt)
    den = lam_re * lam_re + lam_im * lam_im
    fr = ((ar - 1) * lam_re + ai * lam_im) / den
    fi = (ai * lam_re - (ar - 1) * lam_im) / den
    bu_re = jnp.einsum('btgp,gnp->btgn', u, b_re)
    bu_im = jnp.einsum('btgp,gnp->btgn', u, b_im)
    xr = fr * bu_re - fi * bu_im
    xi = fr * bu_im + fi * bu_re
    h0r, h0i = h0
    xr = xr.at[:, 0].add(ar * h0r - ai * h0i)
    xi = xi.at[:, 0].add(ar * h0i + ai * h0r)
    elems = (jnp.broadcast_to(ar, xr.shape), jnp.broadcast_to(ai, xr.shape), xr, xi)
    _, _, sr, si = lax.associative_scan(_complex_combine, elems, axis=1)
    y = jnp.einsum('btgn,gpn->btgp', sr, c_re) - jnp.einsum('btgn,gpn->btgp', si, c_im)
    return y, (sr[:, -1], si[:, -1])


def s5_mixer(u_lat, u_ctx, lam_re, lam_im, log_dt, b_re, b_im, c_re, c_im, d_skip, w_glu, b_glu):
    groups = lambda u: u.astype(jnp.float32).reshape(u.shape[0], u.shape[1], S5_GROUPS, S5_P)
    runs = [functools.partial(s5_scan, lam_re=lam_re[d], lam_im=lam_im[d], log_dt=log_dt[d],
                              b_re=b_re[d], b_im=b_im[d], c_re=c_re[d], c_im=c_im[d]) for d in range(2)]
    B = u_lat.shape[0]
    h0 = (jnp.zeros((B, S5_GROUPS, S5_STATE), jnp.float32), jnp.zeros((B, S5_GROUPS, S5_STATE), jnp.float32))
    y_l, y_c = bidirectional(runs[0], runs[1], groups(u_ctx), groups(u_lat), h0)

    def finish(y, u):
        y = y.reshape(u.shape) + d_skip * u
        z = jax.nn.gelu(y)
        return z * jax.nn.sigmoid(z @ w_glu + b_glu)
    return finish(y_l, u_lat), finish(y_c, u_ctx)


def mla_mixer(z_lat, z_ctx, cos, sin, q_norm, kv_norm, w_uq, w_ukv):
    def project(z):
        B, T, _ = z.shape
        cq, ckv, k_rope = jnp.split(z, [MLA_Q_RANK, MLA_Q_RANK + MLA_KV_RANK], axis=-1)
        q = (rms_norm(cq, q_norm) @ w_uq).reshape(B, T, MLA_HEADS, MLA_NOPE + MLA_ROPE)
        kv = (rms_norm(ckv, kv_norm) @ w_ukv).reshape(B, T, MLA_HEADS, MLA_NOPE + MLA_V)
        return q, kv[..., :MLA_NOPE], kv[..., MLA_NOPE:], k_rope

    def full_key(k_nope, k_rope):
        kr = jnp.broadcast_to(k_rope[:, :, None, :], k_nope.shape[:3] + (MLA_ROPE,))
        return jnp.concatenate([k_nope, kr], axis=-1)

    scale = (MLA_NOPE + MLA_ROPE) ** -0.5

    def attend(q, k, v):
        s = jnp.einsum('bqhd,bkhd->bhqk', q, k).astype(jnp.float32) * scale
        p = jax.nn.softmax(s, axis=-1).astype(v.dtype)
        return jnp.einsum('bhqk,bkhd->bqhd', p, v)

    q_c, kn_c, v_c, kr_c = project(z_ctx)
    k_c = full_key(kn_c, kr_c)
    y_ctx = attend(q_c, k_c, v_c)
    q_l, kn_l, v_l, kr_l = project(z_lat)
    q_l = jnp.concatenate([q_l[..., :MLA_NOPE],
                           apply_axial_rope(q_l[..., MLA_NOPE:], cos[:, None], sin[:, None])], axis=-1)
    k_l = full_key(kn_l, apply_axial_rope(kr_l, cos, sin))
    k_all = jnp.concatenate([k_c, k_l], axis=1)
    v_all = jnp.concatenate([v_c, v_l], axis=1)
    B, T = q_l.shape[:2]
    nb = T // ATTN_BLOCK
    qb = jnp.moveaxis(q_l.reshape(B, nb, ATTN_BLOCK, MLA_HEADS, MLA_NOPE + MLA_ROPE), 1, 0)
    yb = lax.map(lambda qblk: attend(qblk, k_all, v_all), qb)
    y_lat = jnp.moveaxis(yb, 0, 1).reshape(B, T, MLA_HEADS * MLA_V)
    return y_lat, y_ctx.reshape(B, -1, MLA_HEADS * MLA_V)


def rwkv_direction(inp, state, w0, w_up, a0, a_up, k_a):
    r, k, v, kk, wd, ad = inp
    B, T, _ = r.shape
    w_log = -jax.nn.softplus(-(w0 + wd @ w_up)) - 0.5
    decay = jnp.exp(-jnp.exp(w_log.astype(jnp.float32)))
    a = jax.nn.sigmoid(a0 + ad @ a_up)
    k_eff = k * (1 + (a - 1) * k_a)
    heads = lambda t: jnp.moveaxis(t.astype(jnp.float32).reshape(B, T, RWKV_HEADS, HEAD_DIM), 1, 0)

    def step(S, xs):
        rt, wt, kt, vt, kkt, at = xs
        sa = jnp.einsum('bhvk,bhk->bhv', S, kkt)
        S = S * wt[:, :, None, :] - sa[..., :, None] * (kkt * at)[:, :, None, :] + vt[..., :, None] * kt[:, :, None, :]
        return S, jnp.einsum('bhvk,bhk->bhv', S, rt)
    S, y = lax.scan(step, state, tuple(heads(t) for t in (r, decay, k_eff, v, kk, a)))
    return jnp.moveaxis(y, 0, 1).reshape(B, T, GROUP_W), S


def rwkv_mixer(z_lat, z_ctx, conv_w, conv_b, w0, w_up, a0, a_up, g_up, k_k, k_a, r_k, ln_w, ln_b):
    def prepare(z):
        B, T, _ = z.shape
        o1 = 3 * GROUP_W
        rkv, wd, ad, gd = jnp.split(z, [o1, o1 + RWKV_DECAY_LORA, o1 + RWKV_DECAY_LORA + RWKV_A_LORA], axis=-1)
        r, k, v = jnp.split(short_conv(rkv, conv_w, conv_b), 3, axis=-1)
        kk = (k * k_k).astype(jnp.float32).reshape(B, T, RWKV_HEADS, HEAD_DIM)
        kk = kk / jnp.maximum(jnp.sqrt(jnp.sum(kk * kk, axis=-1, keepdims=True)), 1e-12)
        return (r, k, v, kk.reshape(B, T, GROUP_W), jnp.tanh(wd), ad), jax.nn.sigmoid(gd) @ g_up

    inp_l, g_l = prepare(z_lat)
    inp_c, g_c = prepare(z_ctx)
    runs = [functools.partial(rwkv_direction, w0=w0[d], w_up=w_up[d], a0=a0[d], a_up=a_up[d], k_a=k_a)
            for d in range(2)]
    B = z_lat.shape[0]
    s0 = jnp.zeros((B, RWKV_HEADS, HEAD_DIM, HEAD_DIM), jnp.float32)
    y_l, y_c = bidirectional(runs[0], runs[1], inp_c, inp_l, s0)

    def finish(y, inp, g):
        r, k, v = inp[0], inp[1], inp[2]
        B, T, _ = r.shape
        hs = lambda t: t.astype(jnp.float32).reshape(B, T, RWKV_HEADS, HEAD_DIM)
        bonus = jnp.sum(hs(r) * hs(k) * r_k, axis=-1, keepdims=True) * hs(v)
        y = head_norm(y, RWKV_HEADS, RWKV_GN_EPS) * ln_w + ln_b + bonus.reshape(B, T, GROUP_W)
        return y * g
    return finish(y_l, inp_l, g_l), finish(y_c, inp_c, g_c)


def mlstm_chunkwise(q, k, v, log_i, log_f, state):
    B, T, H, D = q.shape
    L = MLSTM_CHUNK
    nc = T // L
    to_chunks = lambda t: jnp.moveaxis(t.reshape((B, nc, L) + t.shape[2:]), (1, 3), (0, 2))
    k = k * (D ** -0.5)
    tril = jnp.tril(jnp.ones((L, L), dtype=bool))

    def step(carry, xs):
        C, n, m = carry
        qc, kc, vc, li, lf = xs
        b = jnp.cumsum(lf, axis=-1)
        log_d = jnp.where(tril, b[..., :, None] - b[..., None, :] + li[..., None, :], -jnp.inf)
        inter = b + m[..., None]
        m_t = jnp.maximum(inter, jnp.max(log_d, axis=-1))
        s = jnp.einsum('bhld,bhsd->bhls', qc, kc) * jnp.exp(log_d - m_t[..., None])
        w_inter = jnp.exp(inter - m_t)
        num = jnp.einsum('bhls,bhsd->bhld', s, vc) + w_inter[..., None] * jnp.einsum('bhed,bhld->bhle', C, qc)
        den = jnp.sum(s, axis=-1) + w_inter * jnp.einsum('bhd,bhld->bhl', n, qc)
        h = num / jnp.maximum(jnp.abs(den), jnp.exp(-m_t))[..., None]
        b_last = b[..., -1]
        lw = b_last[..., None] - b + li
        m_new = jnp.maximum(b_last + m, jnp.max(lw, axis=-1))
        wk = jnp.exp(lw - m_new[..., None])
        sc = jnp.exp(b_last + m - m_new)
        C_new = sc[..., None, None] * C + jnp.einsum('bhl,bhle,bhld->bhed', wk, vc, kc)
        n_new = sc[..., None] * n + jnp.einsum('bhl,bhld->bhd', wk, kc)
        return (C_new, n_new, m_new), h

    state, hs = lax.scan(step, state, tuple(to_chunks(t) for t in (q, k, v, log_i, log_f)))
    return jnp.moveaxis(hs, (0, 2), (1, 3)).reshape(B, T, H, D), state


def mlstm_direction(inp, state, direction):
    q, k, v, gates = inp
    B, T, _ = q.shape
    g = gates.astype(jnp.float32).reshape(B, T, 2, 2, MLSTM_HEADS)[:, :, direction]
    log_i, log_f = g[:, :, 0], jax.nn.log_sigmoid(g[:, :, 1])
    heads = lambda t: t.astype(jnp.float32).reshape(B, T, MLSTM_HEADS, HEAD_DIM)
    h, state = mlstm_chunkwise(heads(q), heads(k), heads(v), log_i, log_f, state)
    return h.reshape(B, T, GROUP_W), state


def mlstm_mixer(z_lat, z_ctx, conv_w, conv_b, gate_b, norm_w):
    def prepare(z):
        qk, v, o, gates = jnp.split(z, [2 * GROUP_W, 3 * GROUP_W, 4 * GROUP_W], axis=-1)
        q, k = jnp.split(jax.nn.silu(short_conv(qk, conv_w, conv_b)), 2, axis=-1)
        return (q, k, v, gates + gate_b), jax.nn.sigmoid(o)

    inp_l, o_l = prepare(z_lat)
    inp_c, o_c = prepare(z_ctx)
    B = z_lat.shape[0]
    state0 = (jnp.zeros((B, MLSTM_HEADS, HEAD_DIM, HEAD_DIM), jnp.float32),
              jnp.zeros((B, MLSTM_HEADS, HEAD_DIM), jnp.float32),
              jnp.zeros((B, MLSTM_HEADS), jnp.float32))
    runs = [functools.partial(mlstm_direction, direction=d) for d in range(2)]
    y_l, y_c = bidirectional(runs[0], runs[1], inp_c, inp_l, state0)
    finish = lambda y, o: head_norm(y, MLSTM_HEADS, NORM_EPS) * norm_w * o
    return finish(y_l, o_l), finish(y_c, o_c)


def setup_inputs(seed: int = 0) -> dict:
    key = jax.random.key(seed)
    ks = iter(jax.random.split(key, 64))
    nrm = lambda shape, s=1.0: s * jax.random.normal(next(ks), shape, jnp.float32)
    gain = lambda shape: 1.0 + nrm(shape, 0.05)
    L, D, W, H = DEPTH, D_MODEL, GROUP_W, MLSTM_HEADS
    n_idx = jnp.arange(S5_STATE, dtype=jnp.float32)
    gate_i = nrm((L, 2, H), 0.1)
    gate_f = jnp.linspace(3.0, 6.0, H, dtype=jnp.float32) + nrm((L, 2, H), 0.1)
    return {
        'x': nrm((BATCH, SEQ, D)),
        'c': nrm((BATCH, D)),
        'ctx': nrm((BATCH, CTX_LEN, D)),
        'c_ctx': nrm((D,)),
        'w_ada': nrm((L, D, N_MOD * D), 0.5 * D ** -0.5),
        'b_ada': nrm((L, N_MOD * D), 0.01),
        'norm_pre': gain((L, 3, D)),
        'norm_post': gain((L, 3, D)),
        'ffn_w_gate': nrm((L, 2, D, FFN_DIM), D ** -0.5),
        'ffn_w_up': nrm((L, 2, D, FFN_DIM), D ** -0.5),
        'ffn_w_down': nrm((L, 2, FFN_DIM, D), FFN_DIM ** -0.5),
        'w_in': nrm((L, D, IN_COLS), D ** -0.5),
        'w_out': nrm((L, D_MIX, D), D_MIX ** -0.5),
        's5_lam_re': -0.5 + nrm((L, 2, S5_GROUPS, S5_STATE), 0.01),
        's5_lam_im': math.pi * n_idx + nrm((L, 2, S5_GROUPS, S5_STATE), 0.01),
        's5_log_dt': jax.random.uniform(next(ks), (L, 2, S5_GROUPS), jnp.float32,
                                        math.log(S5_DT_MIN), math.log(S5_DT_MAX)),
        's5_b_re': nrm((L, 2, S5_GROUPS, S5_STATE, S5_P), (2 * S5_P) ** -0.5),
        's5_b_im': nrm((L, 2, S5_GROUPS, S5_STATE, S5_P), (2 * S5_P) ** -0.5),
        's5_c_re': nrm((L, 2, S5_GROUPS, S5_P, S5_STATE), S5_STATE ** -0.5),
        's5_c_im': nrm((L, 2, S5_GROUPS, S5_P, S5_STATE), S5_STATE ** -0.5),
        's5_d': nrm((L, W)),
        's5_w_glu': nrm((L, W, W), W ** -0.5),
        's5_b_glu': nrm((L, W), 0.01),
        'mla_q_norm': gain((L, MLA_Q_RANK)),
        'mla_kv_norm': gain((L, MLA_KV_RANK)),
        'mla_w_uq': nrm((L, MLA_Q_RANK, MLA_HEADS * (MLA_NOPE + MLA_ROPE)), MLA_Q_RANK ** -0.5),
        'mla_w_ukv': nrm((L, MLA_KV_RANK, MLA_HEADS * (MLA_NOPE + MLA_V)), MLA_KV_RANK ** -0.5),
        'rwkv_conv_w': nrm((L, SHORT_CONV, 3 * W), SHORT_CONV ** -0.5),
        'rwkv_conv_b': nrm((L, 3 * W), 0.01),
        'rwkv_w0': jax.random.uniform(next(ks), (L, 2, W), jnp.float32, -6.0, 1.0),
        'rwkv_w_up': nrm((L, 2, RWKV_DECAY_LORA, W), 0.5 * RWKV_DECAY_LORA ** -0.5),
        'rwkv_a0': nrm((L, 2, W), 0.5),
        'rwkv_a_up': nrm((L, 2, RWKV_A_LORA, W), RWKV_A_LORA ** -0.5),
        'rwkv_g_up': nrm((L, RWKV_GATE_LORA, W), RWKV_GATE_LORA ** -0.5),
        'rwkv_k_k': 0.85 + nrm((L, W), 0.05),
        'rwkv_k_a': 1.0 + nrm((L, W), 0.05),
        'rwkv_r_k': nrm((L, RWKV_HEADS, HEAD_DIM), 0.1),
        'rwkv_ln_w': gain((L, W)),
        'rwkv_ln_b': nrm((L, W), 0.01),
        'mlstm_conv_w': nrm((L, SHORT_CONV, 2 * W), SHORT_CONV ** -0.5),
        'mlstm_conv_b': nrm((L, 2 * W), 0.01),
        'mlstm_gate_b': jnp.stack([gate_i, gate_f], axis=2).reshape(L, 4 * H),
        'mlstm_norm': gain((L, W)),
    }


def reference(x, c, ctx, c_ctx, w_ada, b_ada, norm_pre, norm_post, ffn_w_gate, ffn_w_up, ffn_w_down,
              w_in, w_out, s5_lam_re, s5_lam_im, s5_log_dt, s5_b_re, s5_b_im, s5_c_re, s5_c_im, s5_d,
              s5_w_glu, s5_b_glu, mla_q_norm, mla_kv_norm, mla_w_uq, mla_w_ukv, rwkv_conv_w, rwkv_conv_b,
              rwkv_w0, rwkv_w_up, rwkv_a0, rwkv_a_up, rwkv_g_up, rwkv_k_k, rwkv_k_a, rwkv_r_k, rwkv_ln_w,
              rwkv_ln_b, mlstm_conv_w, mlstm_conv_b, mlstm_gate_b, mlstm_norm):
    cos, sin = axial_rope_tables(x.shape[1])
    split_at = [S5_COLS, S5_COLS + MLA_COLS, S5_COLS + MLA_COLS + RWKV_COLS]
    xc = ctx
    for l in range(DEPTH):
        last = l == DEPTH - 1
        mod_x = jnp.split((jax.nn.silu(c) @ w_ada[l] + b_ada[l])[:, None, :], N_MOD, axis=-1)
        mod_c = jnp.split(jax.nn.silu(c_ctx) @ w_ada[l] + b_ada[l], N_MOD, axis=-1)
        ffn0 = (norm_pre[l, 0], norm_post[l, 0], ffn_w_gate[l, 0], ffn_w_up[l, 0], ffn_w_down[l, 0])
        ffn1 = (norm_pre[l, 2], norm_post[l, 2], ffn_w_gate[l, 1], ffn_w_up[l, 1], ffn_w_down[l, 1])
        x = x + half_ffn(x, *mod_x[0:3], *ffn0)
        xc = xc + half_ffn(xc, *mod_c[0:3], *ffn0)
        hx = modulate(rms_norm(x, norm_pre[l, 1]), mod_x[3], mod_x[4])
        hc = modulate(rms_norm(xc, norm_pre[l, 1]), mod_c[3], mod_c[4])
        zx = jnp.split(hx @ w_in[l], split_at, axis=-1)
        zc = jnp.split(hc @ w_in[l], split_at, axis=-1)
        outs = [
            s5_mixer(zx[0], zc[0], s5_lam_re[l], s5_lam_im[l], s5_log_dt[l], s5_b_re[l], s5_b_im[l],
                     s5_c_re[l], s5_c_im[l], s5_d[l], s5_w_glu[l], s5_b_glu[l]),
            mla_mixer(zx[1], zc[1], cos, sin, mla_q_norm[l], mla_kv_norm[l], mla_w_uq[l], mla_w_ukv[l]),
            rwkv_mixer(zx[2], zc[2], rwkv_conv_w[l], rwkv_conv_b[l], rwkv_w0[l], rwkv_w_up[l], rwkv_a0[l],
                       rwkv_a_up[l], rwkv_g_up[l], rwkv_k_k[l], rwkv_k_a[l], rwkv_r_k[l], rwkv_ln_w[l],
                       rwkv_ln_b[l]),
            mlstm_mixer(zx[3], zc[3], mlstm_conv_w[l], mlstm_conv_b[l], mlstm_gate_b[l], mlstm_norm[l]),
        ]
        y_x = jnp.concatenate([o[0].astype(x.dtype) for o in outs], axis=-1) @ w_out[l]
        x = x + mod_x[5] * rms_norm(y_x, norm_post[l, 1])
        x = x + half_ffn(x, *mod_x[6:9], *ffn1)
        if not last:
            y_c = jnp.concatenate([o[1].astype(xc.dtype) for o in outs], axis=-1) @ w_out[l]
            xc = xc + mod_c[5] * rms_norm(y_c, norm_post[l, 1])
            xc = xc + half_ffn(xc, *mod_c[6:9], *ffn1)
    return x
```

```cpp
#include <hip/hip_runtime.h>
#include <cstdio>
#include <cstdint>

namespace pg8 {
#define PG8_LAS __attribute__((address_space(3)))
typedef unsigned short bf16_t;
typedef short bf16x8 __attribute__((ext_vector_type(8)));
typedef float f32x4 __attribute__((ext_vector_type(4)));
typedef unsigned u32x4 __attribute__((ext_vector_type(4)));
constexpr int BM = 256, BK = 64, HALF = 128, HTB = HALF * BK * 2  , STAGE_BYTES = 8 * HTB, NXCD = 8, WGM = 8;

__host__ __device__ __forceinline__ int lds_byte(int r, int c) { const int st = (r >> 4) * 2 + (c >> 5), rr = r & 15, cc = c & 31, ob = rr * 64 + cc * 2; return st * 1024 + (ob ^ (((ob >> 9) & 1) << 5)); }
__host__ __device__ __forceinline__ void stage_rc(int b, int& R, int& C) { const int st = b / 1024, sb = b % 1024, swz = sb ^ (((sb >> 9) & 1) << 5); R = (st >> 1) * 16 + swz / 64; C = (st & 1) * 32 + (swz % 64) / 2; }
__host__ __device__ __forceinline__ int perm32(int rho) { const int n = rho >> 4, i = rho & 15; return 8 * (i >> 2) + 4 * n + (i & 3); }

struct Unit { int pm, pn; };
struct Gemm { const bf16_t* A; const bf16_t* Bt; int M, N, K; };

struct StaticOrder {
    int nM, nN, nwg, G, c;
    __host__ __device__ void init(int M, int N, int G_, int c_) { nM = M / BM; nN = N / BM; nwg = nM * nN; G = G_; c = c_; }
    __host__ __device__ bool next(int i, Unit& u) const {
        const long L = (long)i * G + c; if (L >= nwg) return false;
        int wgid = (int)L; { const int q = nwg / NXCD, r = nwg % NXCD, xcd = wgid % NXCD, off = wgid / NXCD; wgid = (xcd < r ? xcd * (q + 1) : r * (q + 1) + (xcd - r) * q) + off; }
        const int nig = WGM * nN, gid = wgid / nig, fm = gid * WGM, gsz = (nM - fm) < WGM ? (nM - fm) : WGM;
        u.pm = fm + ((wgid % nig) % gsz); u.pn = (wgid % nig) / gsz; return true;
    }
    __device__ __forceinline__ void a_ready(const Unit&) const {}
    __device__ __forceinline__ void done(const Unit&) const {}
};

typedef __bf16 nbf16v2 __attribute__((ext_vector_type(2))); typedef float nf32v2 __attribute__((ext_vector_type(2)));
__device__ __forceinline__ unsigned cvt_pk_bf16(float lo, float hi) { const nf32v2 v = {lo, hi}; return __builtin_bit_cast(unsigned, __builtin_convertvector(v, nbf16v2)); }
struct EpiSwiGLU {
    static constexpr bool PERM = true, AFTER_DRAIN = false;
    bf16_t* O; int ldc;
    __device__ __forceinline__ void operator()(const f32x4 (&acc)[2][2][4][2], const Unit& u, int wr, int wc, int fr, int fq) const {
        const int row0 = u.pm * BM + wr * 64 + fr; const int col0 = u.pn * HALF + wc * 32 + 8 * fq;
#pragma unroll
        for (int ai = 0; ai < 2; ++ai)
#pragma unroll
            for (int m = 0; m < 4; ++m) { bf16_t* rowp = O + (size_t)(row0 + ai * HALF + m * 16) * ldc + col0;
                float o[8];
#pragma unroll
                for (int n = 0; n < 2; ++n)
#pragma unroll
                    for (int j = 0; j < 4; ++j) { const float g = acc[ai][0][m][n][j], up = acc[ai][1][m][n][j];
                        const float sg = __builtin_amdgcn_rcpf(1.0f + __builtin_amdgcn_exp2f(-1.44269504089f * g)); o[n * 4 + j] = g * sg * up; }
                u32x4 w; w.x = cvt_pk_bf16(o[0], o[1]); w.y = cvt_pk_bf16(o[2], o[3]); w.z = cvt_pk_bf16(o[4], o[5]); w.w = cvt_pk_bf16(o[6], o[7]);
                *(u32x4*)rowp = w; }
    }
};
struct EpiStore {
    static constexpr bool PERM = true, AFTER_DRAIN = false;
    bf16_t* O; int ldc; int ncols;
    __device__ __forceinline__ void operator()(const f32x4 (&acc)[2][2][4][2], const Unit& u, int wr, int wc, int fr, int fq) const {
        const int row0 = u.pm * BM + wr * 64 + fr; const int col0 = u.pn * BM + wc * 32 + 8 * fq;
#pragma unroll
        for (int ai = 0; ai < 2; ++ai)
#pragma unroll
            for (int m = 0; m < 4; ++m) { bf16_t* rowp = O + (size_t)(row0 + ai * HALF + m * 16) * ldc + col0;
#pragma unroll
                for (int bj = 0; bj < 2; ++bj) { if (col0 + bj * HALF < ncols) { const f32x4 v0 = acc[ai][bj][m][0], v1 = acc[ai][bj][m][1];
                    u32x4 w; w.x = cvt_pk_bf16(v0[0], v0[1]); w.y = cvt_pk_bf16(v0[2], v0[3]); w.z = cvt_pk_bf16(v1[0], v1[1]); w.w = cvt_pk_bf16(v1[2], v1[3]);
                    *(u32x4*)(rowp + bj * HALF) = w; } } }
    }
};
template <class Epi, class Sched, bool ALIGN_EPI = false, bool SP2 = false>
__device__ __forceinline__ void gemm_phase(PG8_LAS unsigned char* lds, const Gemm g, const Sched& S, const Epi& E, const int tid) {
    const int wid = __builtin_amdgcn_readfirstlane(tid >> 6), lane = tid & 63, wr = wid >> 2, wc = wid & 3, fr = lane & 15, fq = lane >> 4;
    const int K = g.K, nt = K / BK;
    unsigned voffA[2], voffB[2];
#pragma unroll
    for (int i = 0; i < 2; ++i) { int R, C; stage_rc(tid * 16 + i * 8192, R, C); const int Rb = Epi::PERM ? ((R & ~31) + perm32(R & 31)) : R;
        voffA[i] = (unsigned)(R * K + C) * 2u; voffB[i] = (unsigned)(Rb * K + C) * 2u; }
    const size_t kstep = (size_t)(BK * 2);
    const size_t hstep = (size_t)HALF * K * 2;
    const size_t tstep = 2 * hstep;
    const unsigned ldsw = (unsigned)wid * 1024u;
    const int aoff = lds_byte(wr * 64 + fr, fq * 8), boff = lds_byte(wc * 32 + fr, fq * 8);
#define PG8_SA(b, h) (((b) * 2 + (h)) * HTB)
#define PG8_SB(b, h) ((4 + (b) * 2 + (h)) * HTB)
#define PG8_STAGE(bufoff, gbase, voff) do { _Pragma("unroll") for (int _i = 0; _i < 2; ++_i) \
        __builtin_amdgcn_global_load_lds((const unsigned*)((const char*)(gbase) + (voff)[_i]), (PG8_LAS unsigned*)(lds + (bufoff) + ldsw + _i * 8192), 16, 0, 0); } while (0)
#define PG8_LDA(dst, b, h) do { _Pragma("unroll") for (int m = 0; m < 4; ++m) _Pragma("unroll") for (int k = 0; k < 2; ++k) dst[m][k] = *(const PG8_LAS bf16x8*)(lds + PG8_SA(b, h) + aoff + m * 2048 + k * 1024); } while (0)
#define PG8_LDB(dst, b, h) do { _Pragma("unroll") for (int n = 0; n < 2; ++n) _Pragma("unroll") for (int k = 0; k < 2; ++k) dst[n][k] = *(const PG8_LAS bf16x8*)(lds + PG8_SB(b, h) + boff + n * 2048 + k * 1024); } while (0)
#define PG8_MMA(ai, bj, At, Bt) do { __builtin_amdgcn_s_setprio(1); _Pragma("unroll") for (int m = 0; m < 4; ++m) _Pragma("unroll") for (int n = 0; n < 2; ++n) _Pragma("unroll") for (int k = 0; k < 2; ++k) \
        acc[ai][bj][m][n] = __builtin_amdgcn_mfma_f32_16x16x32_bf16(Bt[n][k], At[m][k], acc[ai][bj][m][n], 0, 0, 0); __builtin_amdgcn_s_setprio(0); } while (0)
#define PG8_WAIT_V(n) asm volatile("s_waitcnt vmcnt(" #n ")" ::: "memory")
#define PG8_WAIT_L(n) asm volatile("s_waitcnt lgkmcnt(" #n ")" ::: "memory")
#define PG8_BAR __builtin_amdgcn_s_barrier()
#define PG8_SCHED __builtin_amdgcn_sched_barrier(0)
    Unit cur, nxt; int ui = 0;
    if (!S.next(0, cur)) return;
    f32x4 acc[2][2][4][2];
#pragma unroll
    for (int a = 0; a < 2; ++a)
#pragma unroll
        for (int b = 0; b < 2; ++b)
#pragma unroll
            for (int m = 0; m < 4; ++m)
#pragma unroll
                for (int n = 0; n < 2; ++n) acc[a][b][m][n] = (f32x4){0.f, 0.f, 0.f, 0.f};
    bf16x8 At[4][2], B0[2][2], B1[2][2];
    const char* cA = (const char*)g.A + (size_t)cur.pm * tstep; const char* cB = (const char*)g.Bt + (size_t)cur.pn * tstep;
    S.a_ready(cur);
    if constexpr (SP2) {
        PG8_STAGE(PG8_SB(0, 0), cB, voffB); PG8_STAGE(PG8_SB(0, 1), cB + hstep, voffB); PG8_STAGE(PG8_SA(0, 0), cA, voffA); PG8_STAGE(PG8_SA(0, 1), cA + hstep, voffA);
        if (wr == 1) PG8_BAR;
        PG8_WAIT_V(2); PG8_BAR;
        PG8_STAGE(PG8_SB(1, 0), cB + kstep, voffB); PG8_STAGE(PG8_SA(1, 0), cA + kstep, voffA); PG8_STAGE(PG8_SB(1, 1), cB + hstep + kstep, voffB);
        PG8_WAIT_V(6); PG8_BAR;
    } else {
        PG8_STAGE(PG8_SB(0, 0), cB, voffB); PG8_STAGE(PG8_SA(0, 0), cA, voffA); PG8_STAGE(PG8_SB(0, 1), cB + hstep, voffB); PG8_STAGE(PG8_SA(0, 1), cA + hstep, voffA);
        if (wr == 1) PG8_BAR;
        PG8_WAIT_V(4); PG8_BAR;
        PG8_STAGE(PG8_SB(1, 0), cB + kstep, voffB); PG8_STAGE(PG8_SA(1, 0), cA + kstep, voffA); PG8_STAGE(PG8_SB(1, 1), cB + hstep + kstep, voffB);
        PG8_WAIT_V(6); PG8_BAR;
    }
    for (;;) {
        const bool has_next = S.next(ui + 1, nxt);
        const char* nA = has_next ? (const char*)g.A + (size_t)nxt.pm * tstep : cA; const char* nB = has_next ? (const char*)g.Bt + (size_t)nxt.pn * tstep : cB;
        for (int t = 0; t < nt; t += 2) {
            const bool last = (t == nt - 2);
            const char* a1 = cA + (size_t)(t + 1) * kstep;
            const char* a2 = last ? nA : cA + (size_t)(t + 2) * kstep; const char* b2 = last ? nB : cB + (size_t)(t + 2) * kstep;
            const char* a3 = a2 + kstep; const char* b3 = b2 + kstep;
            if (last && has_next) S.a_ready(nxt);
            if constexpr (SP2) {
            PG8_LDB(B0, 0, 0); PG8_LDB(B1, 0, 1); PG8_SCHED; PG8_LDA(At, 0, 0); PG8_STAGE(PG8_SA(1, 1), a1 + hstep, voffA);
            PG8_WAIT_V(8); PG8_WAIT_L(0); PG8_BAR; PG8_MMA(0, 0, At, B0); PG8_MMA(0, 1, At, B1); PG8_BAR; PG8_SCHED;
            PG8_LDA(At, 0, 1); PG8_STAGE(PG8_SB(0, 0), b2, voffB); PG8_STAGE(PG8_SB(0, 1), b2 + hstep, voffB); PG8_STAGE(PG8_SA(0, 0), a2, voffA);
            PG8_WAIT_V(8); PG8_WAIT_L(0); PG8_BAR; PG8_MMA(1, 0, At, B0); PG8_MMA(1, 1, At, B1); PG8_BAR; PG8_SCHED;
            PG8_LDB(B0, 1, 0); PG8_LDB(B1, 1, 1); PG8_SCHED; PG8_LDA(At, 1, 0); PG8_STAGE(PG8_SA(0, 1), a2 + hstep, voffA);
            PG8_WAIT_V(8); PG8_WAIT_L(0); PG8_BAR; PG8_MMA(0, 0, At, B0); PG8_MMA(0, 1, At, B1); PG8_BAR; PG8_SCHED;
            PG8_LDA(At, 1, 1); PG8_STAGE(PG8_SB(1, 0), b3, voffB); PG8_STAGE(PG8_SB(1, 1), b3 + hstep, voffB); PG8_STAGE(PG8_SA(1, 0), a3, voffA);
            PG8_WAIT_V(8); PG8_WAIT_L(0); PG8_BAR; PG8_MMA(1, 0, At, B0); PG8_MMA(1, 1, At, B1); PG8_BAR; PG8_SCHED;
            } else {
            PG8_LDB(B0, 0, 0); PG8_SCHED; PG8_LDA(At, 0, 0); PG8_STAGE(PG8_SA(1, 1), a1 + hstep, voffA);
            PG8_WAIT_L(8); PG8_BAR; PG8_WAIT_L(0); PG8_MMA(0, 0, At, B0); PG8_BAR; PG8_SCHED;
            PG8_LDB(B1, 0, 1); PG8_STAGE(PG8_SB(0, 0), b2, voffB);
            PG8_BAR; PG8_WAIT_L(0); PG8_MMA(0, 1, At, B1); PG8_BAR;
            PG8_LDA(At, 0, 1); PG8_STAGE(PG8_SA(0, 0), a2, voffA);
            PG8_BAR; PG8_WAIT_L(0); PG8_MMA(1, 0, At, B0); PG8_BAR; PG8_SCHED;
            PG8_STAGE(PG8_SB(0, 1), b2 + hstep, voffB);
            PG8_WAIT_V(6); PG8_BAR; PG8_MMA(1, 1, At, B1); PG8_BAR;
            PG8_LDB(B0, 1, 0); PG8_SCHED; PG8_LDA(At, 1, 0); PG8_STAGE(PG8_SA(0, 1), a2 + hstep, voffA);
            PG8_WAIT_L(8); PG8_BAR; PG8_WAIT_L(0); PG8_MMA(0, 0, At, B0); PG8_BAR; PG8_SCHED;
            PG8_LDB(B1, 1, 1); PG8_STAGE(PG8_SB(1, 0), b3, voffB);
            PG8_BAR; PG8_WAIT_L(0); PG8_MMA(0, 1, At, B1); PG8_BAR;
            PG8_LDA(At, 1, 1); PG8_STAGE(PG8_SA(1, 0), a3, voffA);
            PG8_BAR; PG8_WAIT_L(0); PG8_MMA(1, 0, At, B0); PG8_BAR; PG8_SCHED;
            PG8_STAGE(PG8_SB(1, 1), b3 + hstep, voffB);
            PG8_WAIT_V(6); PG8_BAR; PG8_MMA(1, 1, At, B1); PG8_BAR;
            }
        }
        if constexpr (ALIGN_EPI) { if (wr == 0) PG8_BAR; }
        if constexpr (!Epi::AFTER_DRAIN) { E(acc, cur, wr, wc, fr, fq); S.done(cur); }
        if (!has_next) break;
#pragma unroll
        for (int a = 0; a < 2; ++a)
#pragma unroll
            for (int b = 0; b < 2; ++b)
#pragma unroll
                for (int m = 0; m < 4; ++m)
#pragma unroll
                    for (int n = 0; n < 2; ++n) acc[a][b][m][n] = (f32x4){0.f, 0.f, 0.f, 0.f};
        cur = nxt; cA = nA; cB = nB; ++ui;
        if constexpr (ALIGN_EPI) { if (wr == 1) PG8_BAR; }
    }
    PG8_WAIT_V(0);
    if constexpr (!ALIGN_EPI) { if (wr == 0) PG8_BAR; }
    PG8_BAR;
    if constexpr (Epi::AFTER_DRAIN) { E.fused(acc, cur, wr, wc, fr, fq, lds, wid, lane); S.done(cur); }
#undef PG8_SA
#undef PG8_SB
#undef PG8_STAGE
#undef PG8_LDA
#undef PG8_LDB
#undef PG8_MMA
#undef PG8_WAIT_V
#undef PG8_WAIT_L
#undef PG8_BAR
#undef PG8_SCHED
}
}
#define PG8_SP2 true
#define PG8_ALIGN true

constexpr int NWAVES = 8, NTHR = 512;
constexpr int D = 1024, NB = 8, T = 4096, TC = 256, DEPTH = 4, FF = 2816, ZP = 2608, ZPAD = 2816;
constexpr int NLAT = NB * T, NCTX = NB * TC, NROWS = NLAT + NCTX;
constexpr int MODW = 9 * D;
constexpr int NKEY = TC + T;
constexpr float NORM_EPS = 1e-6f;
constexpr int ZS5 = 0, ZCQ = 256, ZCKV = 512, ZKR = 640, ZRKV = 672, ZWD = 1440, ZAD = 1472, ZGD = 1504, ZMQK = 1568, ZMV = 2080, ZMO = 2336, ZMG = 2592;

constexpr size_t MiB = 1u << 20;
constexpr size_t WS_CTL = 0, CTL_ZERO_BYTES = 1 * MiB;
constexpr size_t WS_MODV = 1 * MiB;
constexpr size_t WS_ROPE = 3 * MiB;
constexpr size_t WS_SMALLW = 4 * MiB;
constexpr size_t SW_UQ = 0, SW_UKV = 196608, SW_GLU = 327680, SW_GUP = 458752;
constexpr size_t WS_WGU = 6 * MiB, WS_WDN = 17 * MiB, WS_WIN = 23 * MiB, WS_WOUT = 29 * MiB;
constexpr size_t WS_X = 31 * MiB;
constexpr size_t WS_Y = 167 * MiB;
constexpr size_t WS_Q = WS_Y, WS_K = WS_Y + (size_t)NROWS * 384 * 2, WS_VT = WS_K + (size_t)NROWS * 384 * 2;
constexpr size_t WS_H = 235 * MiB;
constexpr size_t WS_ACT = 303 * MiB;
constexpr size_t WS_YS5 = 490 * MiB, WS_YR = 524 * MiB, WS_YM = 558 * MiB, WS_END = 592 * MiB;
static_assert(WS_VT + (size_t)NB * 4 * 64 * NKEY * 2 <= WS_H, "qkv overlay");
static_assert(WS_WGU + (size_t)5632 * 1024 * 2 <= WS_WDN && WS_WDN + (size_t)1024 * 2816 * 2 <= WS_WIN && WS_WIN + (size_t)2816 * 1024 * 2 <= WS_WOUT && WS_WOUT + 2 * MiB <= WS_X, "weights");
static_assert(WS_X + (size_t)NROWS * D * 4 <= WS_Y && WS_Y + (size_t)NROWS * D * 2 <= WS_H && WS_H + (size_t)NROWS * D * 2 <= WS_ACT && WS_ACT + (size_t)NROWS * ZPAD * 2 <= WS_YS5, "map");
static_assert(WS_YS5 + (size_t)2 * NROWS * 256 * 2 <= WS_YR && WS_YM + (size_t)2 * NROWS * 256 * 2 <= WS_END, "map2");
constexpr int CW_BAR = 4096;

constexpr int RING_BYTES = 131072, LDSCTL_OFF = RING_BYTES, MISC_OFF = LDSCTL_OFF + 320, LDS_BYTES = 147456;

#define GAS __attribute__((address_space(1)))
#define LAS __attribute__((address_space(3)))
typedef unsigned short bf16;
typedef unsigned char uchar;
typedef unsigned v4u __attribute__((ext_vector_type(4)));
typedef unsigned v2u __attribute__((ext_vector_type(2)));
typedef float f32x4 __attribute__((ext_vector_type(4)));
typedef float f32x16 __attribute__((ext_vector_type(16)));
typedef short bf16x8 __attribute__((ext_vector_type(8)));
typedef short bf16x4 __attribute__((ext_vector_type(4)));
#define DI __device__ __forceinline__
DI unsigned f2bf(float f) { unsigned u = __builtin_bit_cast(unsigned, f); return (u + 0x7fffu + ((u >> 16) & 1u)) >> 16; }
DI unsigned pk2(float lo, float hi) { return pg8::cvt_pk_bf16(lo, hi); }
DI float bf2f(unsigned b) { return __builtin_bit_cast(float, b << 16); }
DI float bflo(unsigned w) { return __builtin_bit_cast(float, w << 16); }
DI float bfhi(unsigned w) { return __builtin_bit_cast(float, w & 0xffff0000u); }
DI float wave_sum(float v) {
#pragma unroll
    for (int o = 1; o < 64; o <<= 1) v += __shfl_xor(v, o);
    return v;
}
DI float wave_max(float v) {
#pragma unroll
    for (int o = 1; o < 64; o <<= 1) v = fmaxf(v, __shfl_xor(v, o));
    return v;
}
DI float fexp(float x) { return __builtin_amdgcn_exp2f(x * 1.44269504089f); }
DI float fsigmoid(float x) { return __builtin_amdgcn_rcpf(1.0f + fexp(-x)); }
DI f32x16 mfma32(bf16x8 a, bf16x8 b, f32x16 c) { return __builtin_amdgcn_mfma_f32_32x32x16_bf16(a, b, c, 0, 0, 0); }
DI f32x4 mfma16(bf16x8 a, bf16x8 b, f32x4 c) { return __builtin_amdgcn_mfma_f32_16x16x32_bf16(a, b, c, 0, 0, 0); }
DI int crow(int r, int h) { return (r & 3) + 8 * (r >> 2) + 4 * h; }
DI bf16x8 pack8(float a0, float a1, float a2, float a3, float a4, float a5, float a6, float a7) {
    typedef __bf16 nb8 __attribute__((ext_vector_type(8))); typedef float nf8 __attribute__((ext_vector_type(8)));
    const nf8 v = {a0, a1, a2, a3, a4, a5, a6, a7}; return __builtin_bit_cast(bf16x8, __builtin_convertvector(v, nb8));
}
DI void my_sincosf(float x, float& s, float& c) {
    const float k = __builtin_rintf(x * 0.63661977236758134f);
    float r = __builtin_fmaf(-k, 1.5703125f, x); r = __builtin_fmaf(-k, 4.837512969970703125e-4f, r); r = __builtin_fmaf(-k, 7.54978995489188216e-8f, r);
    const float r2 = r * r;
    const float ps = r + r * r2 * (-1.6666654611e-1f + r2 * (8.3321608736e-3f + r2 * (-1.9515295891e-4f)));
    const float pc = 1.0f - 0.5f * r2 + r2 * r2 * (4.166664568298827e-2f + r2 * (-1.388731625493765e-3f + r2 * 2.443315711809948e-5f));
    const int q = ((int)k) & 3;
    const float ss = (q & 1) ? pc : ps, cc = (q & 1) ? ps : pc;
    s = (q & 2) ? -ss : ss; c = ((q + 1) & 2) ? -cc : cc;
}

#define XB_TMO      128
#define XB_XCNT(j)  (256  + 64 * (j))
#define XB_XSUB(j)  (1280 + 64 * (j))
#define XB_XGEN(j)  (2304 + 64 * (j))
#define XB_TOP      3328
#define XB_TOPGEN   3392
#define XCD_BAR_WORDS 3456
#define XB_SPIN_CAP (1u << 22)
DI unsigned xb_ld(unsigned* p)              { return __hip_atomic_load(p, __ATOMIC_RELAXED, __HIP_MEMORY_SCOPE_AGENT); }
DI unsigned xb_add(unsigned* p, unsigned v) { return __hip_atomic_fetch_add(p, v, __ATOMIC_RELAXED, __HIP_MEMORY_SCOPE_AGENT); }
DI unsigned xb_xcc_id() { return (unsigned)__builtin_amdgcn_s_getreg((3 << 11) | 20) & 0xFu; }
#define XB_SPIN(cond, bar) do { unsigned _sp = 0; while (cond) { __builtin_amdgcn_s_sleep(1); \
    if ((++_sp & 255u) == 0u) { if (xb_ld(&(bar)[XB_TMO])) break; if (_sp > XB_SPIN_CAP) { atomicAdd(&(bar)[XB_TMO], 1u); break; } } } } while (0)
struct XcdBarrier { unsigned* bar; unsigned x; volatile LAS unsigned* st; };
DI XcdBarrier xcd_barrier_post(unsigned* bar, volatile LAS unsigned* st, bool t0) {
    XcdBarrier b; b.bar = bar; b.x = xb_xcc_id(); b.st = st;
    if (t0) (void)xb_add(&bar[XB_XCNT(b.x)], 1u);
    return b;
}
DI void xcd_barrier_complete(unsigned* bar, unsigned x, unsigned& nloc, unsigned& nx) {
    const unsigned G = gridDim.x * gridDim.y * gridDim.z;
    unsigned sum, cnt, mine, sp = 0u;
    for (;;) {
        sum = 0u; cnt = 0u; mine = 0u;
#pragma unroll
        for (unsigned j = 0; j < 16; ++j) { const unsigned c = xb_ld(&bar[XB_XCNT(j)]); sum += c; cnt += (c > 0u) ? 1u : 0u; mine = (j == x) ? c : mine; }
        if (sum == G) break;
        __builtin_amdgcn_s_sleep(1);
        if ((++sp & 255u) == 0u) { if (xb_ld(&bar[XB_TMO])) break; if (sp > XB_SPIN_CAP) { atomicAdd(&bar[XB_TMO], 1u); break; } }
    }
    nloc = mine > 0u ? mine : 1u; nx = cnt > 0u ? cnt : 1u;
}
DI void xcd_barrier(const XcdBarrier& b, bool t0) {
    asm volatile("s_waitcnt vmcnt(0)" ::: "memory");
    __syncthreads();
    if (t0) {
        unsigned* bar = b.bar;
        __builtin_amdgcn_s_waitcnt(0);
        unsigned nloc = b.st[0], nx = b.st[1];
        if (nloc == 0u) { xcd_barrier_complete(bar, b.x, nloc, nx); b.st[0] = nloc; b.st[1] = nx; }
        const unsigned old = xb_add(&bar[XB_XSUB(b.x)], 1u);
        const unsigned gen = old / nloc;
        if (old + 1u == (gen + 1u) * nloc) {
            __builtin_amdgcn_fence(__ATOMIC_RELEASE, "agent");
            asm volatile("s_waitcnt vmcnt(0)" ::: "memory");
            const unsigned og = xb_add(&bar[XB_TOP], 1u);
            const unsigned tg = og / nx;
            if (og + 1u == (tg + 1u) * nx) xb_add(&bar[XB_TOPGEN], 1u);
            else XB_SPIN(xb_ld(&bar[XB_TOPGEN]) == tg, bar);
            __builtin_amdgcn_fence(__ATOMIC_ACQUIRE, "agent");
            xb_add(&bar[XB_XGEN(b.x)], 1u);
            asm volatile("s_waitcnt vmcnt(0)" ::: "memory");
        } else {
            XB_SPIN(xb_ld(&bar[XB_XGEN(b.x)]) == gen, bar);
            __builtin_amdgcn_fence(__ATOMIC_ACQUIRE, "agent");
            asm volatile("s_waitcnt vmcnt(0)" ::: "memory");
        }
    }
    __syncthreads();
}

struct Args { const float* in[43]; float* out; unsigned char* ws; int ph_lo, ph_hi, use_bar, pad; };
typedef const __attribute__((address_space(4))) Args* KArgs;
enum { I_X = 0, I_C, I_CTX, I_CCTX, I_WADA, I_BADA, I_NPRE, I_NPOST, I_WG, I_WU, I_WD, I_WIN, I_WOUT, I_S5LRE, I_S5LIM, I_S5DT, I_S5BRE, I_S5BIM, I_S5CRE, I_S5CIM, I_S5D, I_S5GLU, I_S5BGLU,
       I_MQN, I_MKVN, I_MUQ, I_MUKV, I_RCW, I_RCB, I_RW0, I_RWUP, I_RA0, I_RAUP, I_RGUP, I_RKK, I_RKA, I_RRK, I_RLNW, I_RLNB, I_MCW, I_MCB, I_MGB, I_MNORM };

struct Ctx {
    LAS uchar* lds; int tid, lane, wave, vcu, G;
};
DI int tok_row(int b, int seg, int t) { return seg ? b * T + t : NLAT + b * TC + t; }
DI void phase_prologue(KArgs a, const Ctx& F) {
    LAS float* sc = (LAS float*)F.lds;
    LAS float* red = (LAS float*)(F.lds + 40960);
    const float* c = a->in[I_C]; const float* cc = a->in[I_CCTX];
    for (int i = F.tid; i < 9 * D; i += NTHR) { const float v = (i < 8 * D) ? c[i] : cc[i - 8 * D]; sc[i] = v * fsigmoid(v); }
    __syncthreads();
    const float* wada = a->in[I_WADA]; const float* bada = a->in[I_BADA];
    float* modv = (float*)(a->ws + WS_MODV);
    for (int task = F.vcu; task < DEPTH * 144; task += F.G) {
        const int l = task / 144, nb = task % 144, n = nb * 64 + F.lane;
        const float* wp = wada + ((size_t)l * D + F.wave * 128) * MODW + n;
        float acc[9];
#pragma unroll
        for (int m = 0; m < 9; ++m) acc[m] = 0.f;
#pragma unroll 8
        for (int k = 0; k < 128; ++k) { const float w = wp[(size_t)k * MODW];
#pragma unroll
            for (int m = 0; m < 9; ++m) acc[m] += sc[m * D + F.wave * 128 + k] * w; }
#pragma unroll
        for (int m = 0; m < 9; ++m) red[(F.wave * 9 + m) * 64 + F.lane] = acc[m];
        __syncthreads();
        for (int i = F.tid; i < 576; i += NTHR) { const int m = i >> 6, ln = i & 63; float s = 0.f;
#pragma unroll
            for (int w = 0; w < 8; ++w) s += red[(w * 9 + m) * 64 + ln];
            modv[((size_t)l * 9 + m) * MODW + nb * 64 + ln] = s + bada[l * MODW + nb * 64 + ln]; }
        __syncthreads();
    }
    float* rc = (float*)(a->ws + WS_ROPE); float* rs = rc + T * 16;
    for (int i = F.vcu * NTHR + F.tid; i < T * 16; i += F.G * NTHR) {
        const int t = i >> 4, f = i & 15, pos = f < 8 ? (t >> 6) : (t & 63), fi = f & 7;
        const float invf = (fi == 0) ? 1.0f : (fi == 1) ? 0.31622776601683794f : (fi == 2) ? 0.1f : (fi == 3) ? 0.031622776601683794f : (fi == 4) ? 0.01f : (fi == 5) ? 0.0031622776601683794f : (fi == 6) ? 0.001f : 0.00031622776601683794f;
        const float ang = (float)pos * invf; float s, co; my_sincosf(ang, s, co);
        rc[i] = co; rs[i] = s;
    }
}

DI void tr_item(const float* W, int K, int N, bf16* WT, int kb, int n0, int drow0, LAS float* scr, int lane) {
    const int k0 = 64 * kb, nn = n0 + (lane & 31);
#pragma unroll 8
    for (int i = 0; i < 32; ++i) { const int kk = 2 * i + (lane >> 5); scr[kk * 33 + (lane & 31)] = (nn < N) ? W[(size_t)(k0 + kk) * N + nn] : 0.f; }
    const int c = lane & 7;
#pragma unroll
    for (int j = 0; j < 4; ++j) { const int n = (lane >> 3) + 8 * j; const LAS float* s = scr + (8 * c) * 33 + n;
        v4u o; o.x = pk2(s[0 * 33], s[1 * 33]); o.y = pk2(s[2 * 33], s[3 * 33]); o.z = pk2(s[4 * 33], s[5 * 33]); o.w = pk2(s[6 * 33], s[7 * 33]);
        if (n0 + n < N) *(v4u*)(WT + (size_t)(drow0 + n) * K + k0 + 8 * c) = o; }
}
DI void convert_weights(KArgs a, const Ctx& F, int l, int set) {
    LAS float* scr = (LAS float*)(F.lds + F.wave * 8704);
    const int gw = F.vcu * NWAVES + F.wave, NGW = F.G * NWAVES;
    bf16* WGU = (bf16*)(a->ws + WS_WGU); bf16* WDN = (bf16*)(a->ws + WS_WDN); bf16* WIN = (bf16*)(a->ws + WS_WIN); bf16* WOUT = (bf16*)(a->ws + WS_WOUT);
    bf16* SW = (bf16*)(a->ws + WS_SMALLW);
    const int fl = l * 2 + set;
    const float* wg = a->in[I_WG] + (size_t)fl * D * FF; const float* wu = a->in[I_WU] + (size_t)fl * D * FF; const float* wd = a->in[I_WD] + (size_t)fl * FF * D;
    constexpr int I_G = 16 * 88, I_D = 44 * 32, I_IN = 16 * 82, I_O = 16 * 32, I_UQ = 4 * 12, I_UKV = 2 * 16, I_GLU = 4 * 8, I_GUP = 1 * 8;
    const int nitems = set == 0 ? (2 * I_G + I_D + I_IN + I_O + I_UQ + I_UKV + I_GLU + I_GUP) : (2 * I_G + I_D);
    for (int it = gw; it < nitems; it += NGW) {
        int r = it;
        if (r < I_G) { const int kb = r / 88, nb = r % 88, n0 = 32 * nb; tr_item(wg, D, FF, WGU, kb, n0, 256 * (n0 >> 7) + (n0 & 127), scr, F.lane); continue; } r -= I_G;
        if (r < I_G) { const int kb = r / 88, nb = r % 88, n0 = 32 * nb; tr_item(wu, D, FF, WGU, kb, n0, 256 * (n0 >> 7) + 128 + (n0 & 127), scr, F.lane); continue; } r -= I_G;
        if (r < I_D) { const int kb = r / 32, nb = r % 32; tr_item(wd, FF, D, WDN, kb, 32 * nb, 32 * nb, scr, F.lane); continue; } r -= I_D;
        if (r < I_IN) { const int kb = r / 82, nb = r % 82; tr_item(a->in[I_WIN] + (size_t)l * D * ZP, D, ZP, WIN, kb, 32 * nb, 32 * nb, scr, F.lane); continue; } r -= I_IN;
        if (r < I_O) { const int kb = r / 32, nb = r % 32; tr_item(a->in[I_WOUT] + (size_t)l * D * D, D, D, WOUT, kb, 32 * nb, 32 * nb, scr, F.lane); continue; } r -= I_O;
        if (r < I_UQ) { const int kb = r / 12, nb = r % 12; tr_item(a->in[I_MUQ] + (size_t)l * 256 * 384, 256, 384, (bf16*)((uchar*)SW + SW_UQ), kb, 32 * nb, 32 * nb, scr, F.lane); continue; } r -= I_UQ;
        if (r < I_UKV) { const int kb = r / 16, nb = r % 16; tr_item(a->in[I_MUKV] + (size_t)l * 128 * 512, 128, 512, (bf16*)((uchar*)SW + SW_UKV), kb, 32 * nb, 32 * nb, scr, F.lane); continue; } r -= I_UKV;
        if (r < I_GLU) { const int kb = r / 8, nb = r % 8; tr_item(a->in[I_S5GLU] + (size_t)l * 256 * 256, 256, 256, (bf16*)((uchar*)SW + SW_GLU), kb, 32 * nb, 32 * nb, scr, F.lane); continue; } r -= I_GLU;
        { const int nb = r; tr_item(a->in[I_RGUP] + (size_t)l * 64 * 256, 64, 256, (bf16*)((uchar*)SW + SW_GUP), 0, 32 * nb, 32 * nb, scr, F.lane); }
    }
    if (set == 0) {
        v4u z = {0u, 0u, 0u, 0u}; v4u* p = (v4u*)(WIN + (size_t)ZP * D);
        for (int i = F.vcu * NTHR + F.tid; i < (ZPAD - ZP) * D / 8; i += F.G * NTHR) p[i] = z;
    }
}

DI void norm_rows(KArgs a, const Ctx& F, bool p_first, bool p_hasY, bool p_hasH, bool p_final, int p_nrows, const float* p_modY, int p_gi, const float* p_pw, float p_coef, const float* p_modH, int p_si, const float* p_prew) {
    float* X = (float*)(a->ws + WS_X); const bf16* Y = (const bf16*)(a->ws + WS_Y); bf16* H = (bf16*)(a->ws + WS_H);
    const int gw = F.vcu * NWAVES + F.wave, NGW = F.G * NWAVES, lane = F.lane;
    for (int r = gw; r < p_nrows; r += NGW) {
        const int mr = r < NLAT ? (r >> 12) : 8;
        const float* xs = p_first ? (r < NLAT ? a->in[I_X] + (size_t)r * D : a->in[I_CTX] + (size_t)(r - NLAT) * D) : X + (size_t)r * D;
        f32x4 v[4];
#pragma unroll
        for (int j = 0; j < 4; ++j) v[j] = *(const f32x4*)(xs + 4 * lane + 256 * j);
        if (p_hasY) {
            f32x4 y[4]; float ss = 0.f;
#pragma unroll
            for (int j = 0; j < 4; ++j) { const v2u w = *(const v2u*)(Y + (size_t)r * D + 4 * lane + 256 * j); y[j] = (f32x4){bflo(w.x), bfhi(w.x), bflo(w.y), bfhi(w.y)};
                ss += (y[j].x * y[j].x + y[j].y * y[j].y) + (y[j].z * y[j].z + y[j].w * y[j].w); }
            const float rstd = 1.0f / sqrtf(wave_sum(ss) * (1.0f / D) + NORM_EPS);
            const float* g = p_modY + (size_t)mr * MODW + p_gi * D;
#pragma unroll
            for (int j = 0; j < 4; ++j) { const f32x4 gg = *(const f32x4*)(g + 4 * lane + 256 * j), ww = *(const f32x4*)(p_pw + 4 * lane + 256 * j);
                v[j] = v[j] + (gg * p_coef) * ((y[j] * rstd) * ww); }
        }
        if (p_final) {
#pragma unroll
            for (int j = 0; j < 4; ++j) *(f32x4*)(a->out + (size_t)r * D + 4 * lane + 256 * j) = v[j];
        } else if (p_hasY || p_first) {
#pragma unroll
            for (int j = 0; j < 4; ++j) *(f32x4*)(X + (size_t)r * D + 4 * lane + 256 * j) = v[j];
        }
        if (p_hasH) {
            float ss = 0.f;
#pragma unroll
            for (int j = 0; j < 4; ++j) ss += (v[j].x * v[j].x + v[j].y * v[j].y) + (v[j].z * v[j].z + v[j].w * v[j].w);
            const float rstd = 1.0f / sqrtf(wave_sum(ss) * (1.0f / D) + NORM_EPS);
            const float* sh = p_modH + (size_t)mr * MODW + p_si * D; const float* scp = sh + D;
#pragma unroll
            for (int j = 0; j < 4; ++j) { const f32x4 ww = *(const f32x4*)(p_prew + 4 * lane + 256 * j), s1 = *(const f32x4*)(scp + 4 * lane + 256 * j), s0 = *(const f32x4*)(sh + 4 * lane + 256 * j);
                const f32x4 h = ((v[j] * rstd) * ww) * (s1 + 1.0f) + s0;
                v2u o; o.x = pk2(h.x, h.y); o.y = pk2(h.z, h.w); *(v2u*)(H + (size_t)r * D + 4 * lane + 256 * j) = o; }
        }
    }
}
template <int K, int NBK, int MBK, bool TRANS>
DI void small_gemm(const LAS bf16* A, int apitch, const bf16* Wt, int n0w, f32x4 (&acc)[NBK][MBK], int lane) {
    const int lr = lane & 15, kq = lane >> 4;
#pragma unroll
    for (int nb = 0; nb < NBK; ++nb)
#pragma unroll
        for (int mb = 0; mb < MBK; ++mb) acc[nb][mb] = (f32x4){0.f, 0.f, 0.f, 0.f};
#pragma unroll
    for (int s = 0; s < K / 32; ++s) {
        bf16x8 av[MBK];
#pragma unroll
        for (int mb = 0; mb < MBK; ++mb) av[mb] = *(const LAS bf16x8*)(A + (16 * mb + lr) * apitch + 32 * s + 8 * kq);
#pragma unroll
        for (int nb = 0; nb < NBK; ++nb) { const bf16x8 w = *(const bf16x8*)(Wt + (size_t)(n0w + 16 * nb + lr) * K + 32 * s + 8 * kq);
#pragma unroll
            for (int mb = 0; mb < MBK; ++mb) acc[nb][mb] = TRANS ? mfma16(w, av[mb], acc[nb][mb]) : mfma16(av[mb], w, acc[nb][mb]); }
    }
}

DI void s5_coef(const float* lre, const float* lim, float dt, int nn, float& ar, float& ai, float& fr, float& fi) {
    const float lr = lre[nn], li = lim[nn], x = lr * dt;
    const float em = x * (1.0f + x * (0.5f + x * (0.16666667f + x * (0.041666668f + x * 0.0083333338f))));
    float sh, ch; my_sincosf(0.5f * li * dt, sh, ch);
    const float cm1 = -2.0f * sh * sh, sn = 2.0f * sh * ch;
    const float arm1 = em * (1.0f + cm1) + cm1;
    ai = (1.0f + em) * sn; ar = 1.0f + arm1;
    const float den = lr * lr + li * li;
    fr = (arm1 * lr + ai * li) / den; fi = (ai * lr - arm1 * li) / den;
}
DI void s5_scan_task(KArgs a, int l, int b, int dir, int g, LAS bf16* wl  , int lane) {
    const bf16* Z = (const bf16*)(a->ws + WS_ACT); bf16* YS = (bf16*)(a->ws + WS_YS5) + (size_t)dir * NROWS * 256;
    const int pg = (l * 2 + dir) * 16 + g;
    const float* lre = a->in[I_S5LRE] + pg * 64; const float* lim = a->in[I_S5LIM] + pg * 64;
    const float dt = __expf(a->in[I_S5DT][pg]);
    float ar, ai, tfr, tfi; s5_coef(lre, lim, dt, lane, ar, ai, tfr, tfi);
    bf16x8 Bf[4];
    { const int hh = lane >> 5;
#pragma unroll
      for (int nblk = 0; nblk < 2; ++nblk) { const int nn = 32 * nblk + (lane & 31); float xr, xi, fr, fi; s5_coef(lre, lim, dt, nn, xr, xi, fr, fi);
        const float* bre = a->in[I_S5BRE] + ((size_t)pg * 64 + nn) * 16 + 8 * hh; const float* bim = a->in[I_S5BIM] + ((size_t)pg * 64 + nn) * 16 + 8 * hh;
        float re[8], im[8];
#pragma unroll
        for (int j = 0; j < 8; ++j) { re[j] = fr * bre[j] - fi * bim[j]; im[j] = fi * bre[j] + fr * bim[j]; }
        Bf[nblk] = pack8(re[0], re[1], re[2], re[3], re[4], re[5], re[6], re[7]); Bf[2 + nblk] = pack8(im[0], im[1], im[2], im[3], im[4], im[5], im[6], im[7]); } }
    bf16x8 Cf[4];
    { const int p = lane & 15, q = lane >> 4;
#pragma unroll
      for (int s = 0; s < 4; ++s) { const int kc = 32 * s + 8 * q; float cv[8];
        const float* src = (s < 2) ? a->in[I_S5CRE] + ((size_t)pg * 16 + p) * 64 + kc : a->in[I_S5CIM] + ((size_t)pg * 16 + p) * 64 + (kc - 64);
        const float sg = (s < 2) ? 1.f : -1.f;
#pragma unroll
        for (int j = 0; j < 8; ++j) cv[j] = sg * src[j];
        Cf[s] = pack8(cv[0], cv[1], cv[2], cv[3], cv[4], cv[5], cv[6], cv[7]); } }
    float sr = 0.f, si = 0.f;
    const int hh = lane >> 5, li5 = lane & 31, q = lane >> 4, t16 = lane & 15;
    const f32x16 zero16 = {0.f, 0.f, 0.f, 0.f, 0.f, 0.f, 0.f, 0.f, 0.f, 0.f, 0.f, 0.f, 0.f, 0.f, 0.f, 0.f};
    for (int seg = 0; seg < 2; ++seg) {
        const int len = seg ? T : TC, nch = len / 32;
        for (int ch = 0; ch < nch; ++ch) {
            const int sidx = 32 * ch + li5, tt = dir ? (len - 1 - sidx) : sidx;
            const bf16x8 af = *(const bf16x8*)(Z + (size_t)tok_row(b, seg, tt) * ZP + ZS5 + g * 16 + 8 * hh);
            f32x16 d1 = mfma32(af, Bf[0], zero16), d2 = mfma32(af, Bf[1], zero16), d3 = mfma32(af, Bf[2], zero16), d4 = mfma32(af, Bf[3], zero16);
            float xa[16], xb[16], ya[16], yb[16];
#pragma unroll
            for (int r = 0; r < 16; ++r) {
                auto r1 = __builtin_amdgcn_permlane32_swap(__float_as_uint(d1[r]), __float_as_uint(d2[r]), false, false); xa[r] = __uint_as_float(r1[0]); xb[r] = __uint_as_float(r1[1]);
                auto r2 = __builtin_amdgcn_permlane32_swap(__float_as_uint(d3[r]), __float_as_uint(d4[r]), false, false); ya[r] = __uint_as_float(r2[0]); yb[r] = __uint_as_float(r2[1]); }
#pragma unroll
            for (int i = 0; i < 32; ++i) {
                const int r = 4 * (i >> 3) + (i & 3); const bool hi = (i >> 2) & 1;
                const float xre = hi ? xb[r] : xa[r], xim = hi ? yb[r] : ya[r];
                const float nsr = ar * sr - ai * si + xre, nsi = ar * si + ai * sr + xim; sr = nsr; si = nsi;
                wl[i * 136 + lane] = (bf16)f2bf(sr); wl[i * 136 + 64 + lane] = (bf16)f2bf(si);
            }
#pragma unroll
            for (int tb = 0; tb < 2; ++tb) {
                f32x4 acc = {0.f, 0.f, 0.f, 0.f};
#pragma unroll
                for (int s = 0; s < 4; ++s) { const bf16x8 bfr = *(const LAS bf16x8*)(wl + (16 * tb + t16) * 136 + 32 * s + 8 * q); acc = mfma16(Cf[s], bfr, acc); }
                const int so = 32 * ch + 16 * tb + t16, to = dir ? (len - 1 - so) : so;
                v2u o; o.x = pk2(acc[0], acc[1]); o.y = pk2(acc[2], acc[3]);
                *(v2u*)(YS + (size_t)tok_row(b, seg, to) * 256 + g * 16 + 4 * q) = o;
            }
        }
    }
}

DI void mla_prep_tile(KArgs a, const Ctx& F, int l, int tile) {
    const bf16* Z = (const bf16*)(a->ws + WS_ACT);
    bf16* Q = (bf16*)(a->ws + WS_Q); bf16* Kf = (bf16*)(a->ws + WS_K); bf16* Vt = (bf16*)(a->ws + WS_VT);
    const bf16* WUQ = (const bf16*)(a->ws + WS_SMALLW + SW_UQ); const bf16* WUKV = (const bf16*)(a->ws + WS_SMALLW + SW_UKV);
    const float* rc = (const float*)(a->ws + WS_ROPE); const float* rs = rc + T * 16;
    LAS bf16* Aq = (LAS bf16*)F.lds;
    LAS bf16* Akv = (LAS bf16*)(F.lds + 64 * 264 * 2);
    const int row0 = tile * 64, tid = F.tid, lane = F.lane, wave = F.wave;
    const bool lat = row0 < NLAT;
    {
        const int i = tid >> 3, part = tid & 7, row = row0 + i;
        const bf16* zr = Z + (size_t)row * ZP;
        float q[32], kv[16]; float sq = 0.f, sk = 0.f;
#pragma unroll
        for (int j = 0; j < 4; ++j) { const v4u w = *(const v4u*)(zr + ZCQ + part * 32 + 8 * j);
            q[8 * j + 0] = bflo(w.x); q[8 * j + 1] = bfhi(w.x); q[8 * j + 2] = bflo(w.y); q[8 * j + 3] = bfhi(w.y); q[8 * j + 4] = bflo(w.z); q[8 * j + 5] = bfhi(w.z); q[8 * j + 6] = bflo(w.w); q[8 * j + 7] = bfhi(w.w); }
#pragma unroll
        for (int j = 0; j < 2; ++j) { const v4u w = *(const v4u*)(zr + ZCKV + part * 16 + 8 * j);
            kv[8 * j + 0] = bflo(w.x); kv[8 * j + 1] = bfhi(w.x); kv[8 * j + 2] = bflo(w.y); kv[8 * j + 3] = bfhi(w.y); kv[8 * j + 4] = bflo(w.z); kv[8 * j + 5] = bfhi(w.z); kv[8 * j + 6] = bflo(w.w); kv[8 * j + 7] = bfhi(w.w); }
#pragma unroll
        for (int j = 0; j < 32; ++j) sq += q[j] * q[j];
#pragma unroll
        for (int j = 0; j < 16; ++j) sk += kv[j] * kv[j];
        sq += __shfl_xor(sq, 1); sq += __shfl_xor(sq, 2); sq += __shfl_xor(sq, 4);
        sk += __shfl_xor(sk, 1); sk += __shfl_xor(sk, 2); sk += __shfl_xor(sk, 4);
        const float rq = 1.0f / sqrtf(sq * (1.0f / 256.0f) + NORM_EPS), rk = 1.0f / sqrtf(sk * (1.0f / 128.0f) + NORM_EPS);
        const float* qn = a->in[I_MQN] + l * 256 + part * 32; const float* kn = a->in[I_MKVN] + l * 128 + part * 16;
#pragma unroll
        for (int j = 0; j < 32; j += 2) *(LAS unsigned*)(Aq + i * 264 + part * 32 + j) = pk2(q[j] * rq * qn[j], q[j + 1] * rq * qn[j + 1]);
#pragma unroll
        for (int j = 0; j < 16; j += 2) *(LAS unsigned*)(Akv + i * 136 + part * 16 + j) = pk2(kv[j] * rk * kn[j], kv[j + 1] * rk * kn[j + 1]);
        if (part == 0) {
            float kr[32];
#pragma unroll
            for (int j = 0; j < 4; ++j) { const v4u w = *(const v4u*)(zr + ZKR + 8 * j);
                kr[8 * j + 0] = bflo(w.x); kr[8 * j + 1] = bfhi(w.x); kr[8 * j + 2] = bflo(w.y); kr[8 * j + 3] = bfhi(w.y); kr[8 * j + 4] = bflo(w.z); kr[8 * j + 5] = bfhi(w.z); kr[8 * j + 6] = bflo(w.w); kr[8 * j + 7] = bfhi(w.w); }
            float o[32];
            if (lat) { const int t = row & (T - 1);
#pragma unroll
                for (int hf = 0; hf < 2; ++hf)
#pragma unroll
                    for (int j = 0; j < 8; ++j) { const float c = rc[t * 16 + hf * 8 + j], s = rs[t * 16 + hf * 8 + j]; const float x0 = kr[hf * 16 + j], x1 = kr[hf * 16 + 8 + j];
                        o[hf * 16 + j] = x0 * c - x1 * s; o[hf * 16 + 8 + j] = x1 * c + x0 * s; }
            } else {
#pragma unroll
                for (int j = 0; j < 32; ++j) o[j] = kr[j];
            }
#pragma unroll
            for (int hd = 0; hd < 4; ++hd) { bf16* kp = Kf + (size_t)row * 384 + hd * 96 + 64;
#pragma unroll
                for (int j = 0; j < 4; ++j) { v4u w; w.x = pk2(o[8 * j], o[8 * j + 1]); w.y = pk2(o[8 * j + 2], o[8 * j + 3]); w.z = pk2(o[8 * j + 4], o[8 * j + 5]); w.w = pk2(o[8 * j + 6], o[8 * j + 7]); *(v4u*)(kp + 8 * j) = w; } }
        }
    }
    __syncthreads();
    const int lr = lane & 15, kq = lane >> 4;
    {
        f32x4 acc[3][4];
        small_gemm<256, 3, 4, true>(Aq, 264, WUQ, 48 * wave, acc, lane);
        const float qs = 0.10206207261596577f * 1.44269504089f;
#pragma unroll
        for (int nb = 0; nb < 3; ++nb) { const int blk = 3 * wave + nb, hb = blk % 6;
#pragma unroll
            for (int mb = 0; mb < 4; ++mb) { const int row = row0 + 16 * mb + lr; f32x4 v = acc[nb][mb];
                if (hb >= 4) {
                    f32x4 pv; pv.x = __shfl_xor(v.x, 32); pv.y = __shfl_xor(v.y, 32); pv.z = __shfl_xor(v.z, 32); pv.w = __shfl_xor(v.w, 32);
                    if (lat) { const int t = row & (T - 1); const int fb = (hb - 4) * 8 + 4 * (kq & 1);
                        const f32x4 c = *(const f32x4*)(rc + t * 16 + fb), s = *(const f32x4*)(rs + t * 16 + fb);
                        v = (kq < 2) ? (v * c - pv * s) : (v * c + pv * s); }
                }
                v = v * qs;
                v2u o; o.x = pk2(v.x, v.y); o.y = pk2(v.z, v.w);
                *(v2u*)(Q + (size_t)row * 384 + 16 * blk + 4 * kq) = o; } }
    }
    {
        const int hd = wave >> 1;
        if ((wave & 1) == 0) {
            f32x4 acc[4][4];
            small_gemm<128, 4, 4, true>(Akv, 136, WUKV, 64 * wave, acc, lane);
#pragma unroll
            for (int nb = 0; nb < 4; ++nb)
#pragma unroll
                for (int mb = 0; mb < 4; ++mb) { const int row = row0 + 16 * mb + lr; const f32x4 v = acc[nb][mb];
                    v2u o; o.x = pk2(v.x, v.y); o.y = pk2(v.z, v.w);
                    *(v2u*)(Kf + (size_t)row * 384 + hd * 96 + 16 * nb + 4 * kq) = o; }
        } else {
            f32x4 acc[4][4];
            small_gemm<128, 4, 4, false>(Akv, 136, WUKV, 64 * wave, acc, lane);
            const int bb = lat ? (row0 >> 12) : ((row0 - NLAT) >> 8);
            const int key0 = lat ? (TC + (row0 & (T - 1))) : ((row0 - NLAT) & (TC - 1));
#pragma unroll
            for (int nb = 0; nb < 4; ++nb)
#pragma unroll
                for (int mb = 0; mb < 4; ++mb) { const f32x4 v = acc[nb][mb];
                    v2u o; o.x = pk2(v.x, v.y); o.y = pk2(v.z, v.w);
                    *(v2u*)(Vt + ((size_t)(bb * 4 + hd) * 64 + 16 * nb + lr) * NKEY + key0 + 16 * mb + 4 * kq) = o; }
        }
    }
    __syncthreads();
}

DI void attn_unit(KArgs a, const Ctx& F, int b, int hd, int qrow0, int nkeys) {
    const bf16* Q = (const bf16*)(a->ws + WS_Q); const bf16* Kf = (const bf16*)(a->ws + WS_K); const bf16* Vt = (const bf16*)(a->ws + WS_VT);
    bf16* MO = (bf16*)(a->ws + WS_H);
    constexpr int KP = 208, VP = 144, BUF = 64 * KP + 64 * VP;
    const int tid = F.tid, lane = F.lane, wave = F.wave, l31 = lane & 31, h2 = lane >> 5;
    const int qrow = qrow0 + 32 * wave + l31;
    bf16x8 Qf[6];
#pragma unroll
    for (int s = 0; s < 6; ++s) Qf[s] = *(const bf16x8*)(Q + (size_t)qrow * 384 + hd * 96 + 16 * s + 8 * h2);
    const int kc0 = tid, kc1 = tid + 512;
    const int kr0 = kc0 / 12, kcc0 = kc0 % 12, kr1 = kc1 / 12, kcc1 = kc1 % 12; const bool k1v = kc1 < 768;
    const int vd = tid >> 3, vcc = tid & 7;
    const bf16* vbase = Vt + ((size_t)(b * 4 + hd) * 64 + vd) * NKEY + vcc * 8;
    v4u gk0, gk1, gv;
    auto gload = [&](int kt) {
        const int key0 = 64 * kt; const int krow = key0 < TC ? (NLAT + b * TC + key0) : (b * T + key0 - TC);
        gk0 = *(const v4u*)(Kf + (size_t)(krow + kr0) * 384 + hd * 96 + kcc0 * 8);
        if (k1v) gk1 = *(const v4u*)(Kf + (size_t)(krow + kr1) * 384 + hd * 96 + kcc1 * 8);
        gv = *(const v4u*)(vbase + key0);
    };
    auto lstore = [&](int buf) {
        LAS uchar* base = F.lds + buf * BUF;
        *(LAS v4u*)(base + kr0 * KP + kcc0 * 16) = gk0;
        if (k1v) *(LAS v4u*)(base + kr1 * KP + kcc1 * 16) = gk1;
        *(LAS v4u*)(base + 64 * KP + vd * VP + vcc * 16) = gv;
    };
    const int nt = nkeys / 64;
    gload(0); lstore(0);
    __syncthreads();
    f32x16 O0, O1;
#pragma unroll
    for (int r = 0; r < 16; ++r) { O0[r] = 0.f; O1[r] = 0.f; }
    float m = -1e30f, lsum = 0.f;
    for (int kt = 0; kt < nt; ++kt) {
        const bool more = kt + 1 < nt;
        if (more) gload(kt + 1);
        const LAS uchar* kb_ = F.lds + (kt & 1) * BUF; const LAS uchar* vb_ = kb_ + 64 * KP;
        f32x16 s0, s1;
#pragma unroll
        for (int r = 0; r < 16; ++r) { s0[r] = 0.f; s1[r] = 0.f; }
#pragma unroll
        for (int s = 0; s < 6; ++s) {
            const bf16x8 ka = *(const LAS bf16x8*)(kb_ + l31 * KP + (16 * s + 8 * h2) * 2);
            const bf16x8 kb2 = *(const LAS bf16x8*)(kb_ + (32 + l31) * KP + (16 * s + 8 * h2) * 2);
            s0 = mfma32(ka, Qf[s], s0); s1 = mfma32(kb2, Qf[s], s1);
        }
        float mx = s0[0];
#pragma unroll
        for (int r = 1; r < 16; ++r) mx = fmaxf(mx, s0[r]);
#pragma unroll
        for (int r = 0; r < 16; ++r) mx = fmaxf(mx, s1[r]);
        mx = fmaxf(mx, __shfl_xor(mx, 32));
        const float mn = fmaxf(m, mx), alpha = __builtin_amdgcn_exp2f(m - mn); m = mn;
        float ps = 0.f;
#pragma unroll
        for (int r = 0; r < 16; ++r) { s0[r] = __builtin_amdgcn_exp2f(s0[r] - mn); s1[r] = __builtin_amdgcn_exp2f(s1[r] - mn); ps += s0[r] + s1[r]; }
        lsum = lsum * alpha + ps;
#pragma unroll
        for (int r = 0; r < 16; ++r) { O0[r] *= alpha; O1[r] *= alpha; }
#pragma unroll
        for (int kb = 0; kb < 2; ++kb)
#pragma unroll
            for (int sp = 0; sp < 2; ++sp) {
                const f32x16& sx = kb ? s1 : s0;
                const bf16x8 pf = pack8(sx[8 * sp + 0], sx[8 * sp + 1], sx[8 * sp + 2], sx[8 * sp + 3], sx[8 * sp + 4], sx[8 * sp + 5], sx[8 * sp + 6], sx[8 * sp + 7]);
                const int ko = (32 * kb + 16 * sp + 4 * h2) * 2;
                const bf16x4 a0 = *(const LAS bf16x4*)(vb_ + l31 * VP + ko), a1 = *(const LAS bf16x4*)(vb_ + l31 * VP + ko + 16);
                const bf16x4 c0 = *(const LAS bf16x4*)(vb_ + (32 + l31) * VP + ko), c1 = *(const LAS bf16x4*)(vb_ + (32 + l31) * VP + ko + 16);
                const bf16x8 va = __builtin_shufflevector(a0, a1, 0, 1, 2, 3, 4, 5, 6, 7), vc = __builtin_shufflevector(c0, c1, 0, 1, 2, 3, 4, 5, 6, 7);
                O0 = mfma32(va, pf, O0); O1 = mfma32(vc, pf, O1);
            }
        if (more) lstore((kt + 1) & 1);
        __syncthreads();
    }
    const float ltot = lsum + __shfl_xor(lsum, 32), inv = 1.0f / ltot;
    bf16* op = MO + (size_t)qrow * D + 256 + hd * 64;
#pragma unroll
    for (int gq = 0; gq < 4; ++gq) {
        v2u o; o.x = pk2(O0[4 * gq] * inv, O0[4 * gq + 1] * inv); o.y = pk2(O0[4 * gq + 2] * inv, O0[4 * gq + 3] * inv);
        *(v2u*)(op + 8 * gq + 4 * h2) = o;
        v2u o2; o2.x = pk2(O1[4 * gq] * inv, O1[4 * gq + 1] * inv); o2.y = pk2(O1[4 * gq + 2] * inv, O1[4 * gq + 3] * inv);
        *(v2u*)(op + 32 + 8 * gq + 4 * h2) = o2;
    }
}
DI float conv3(const bf16* Z, int b, int seg, int t, int len, int col, float w0, float w1, float w2, float cb) {
    const bf16* zp = Z + (size_t)tok_row(b, seg, t) * ZP + col;
    float y = cb + w1 * bf2f(zp[0]);
    if (t > 0) y += w0 * bf2f(zp[-ZP]);
    if (t + 1 < len) y += w2 * bf2f(zp[ZP]);
    return y;
}
DI void rwkv_scan_task(KArgs a, const Ctx& F, int l, int b, int hd, int dir) {
    const bf16* Z = (const bf16*)(a->ws + WS_ACT); bf16* YR = (bf16*)(a->ws + WS_YR) + (size_t)dir * NROWS * 256;
    LAS float* Sdec = (LAS float*)F.lds;
    LAS float* Skk = Sdec + 2048; LAS float* Sbb = Skk + 2048; LAS float* Ske = Sbb + 2048; LAS float* Sr = Ske + 2048; LAS float* Sv = Sr + 2048;
    LAS float* Sy = Sv + 2048;
    LAS float* Slw = Sy + 2048;
    const int tid = F.tid, lane = F.lane, wave = F.wave;
    const int c = lane, hc = hd * 64 + c;
    float wup[32], aup[32];
    { const float* wu = a->in[I_RWUP] + ((size_t)(l * 2 + dir) * 32) * 256 + hc; const float* au = a->in[I_RAUP] + ((size_t)(l * 2 + dir) * 32) * 256 + hc;
#pragma unroll
      for (int j = 0; j < 32; ++j) { wup[j] = wu[j * 256]; aup[j] = au[j * 256]; } }
    const float w0c = a->in[I_RW0][(l * 2 + dir) * 256 + hc], a0c = a->in[I_RA0][(l * 2 + dir) * 256 + hc];
    const float kkc = a->in[I_RKK][l * 256 + hc], kac = a->in[I_RKA][l * 256 + hc];
    const float* cw = a->in[I_RCW] + (size_t)l * 3 * 768; const float* cbp = a->in[I_RCB] + (size_t)l * 768;
    float cwr[3], cwk[3], cwv[3];
#pragma unroll
    for (int j = 0; j < 3; ++j) { cwr[j] = cw[j * 768 + hc]; cwk[j] = cw[j * 768 + 256 + hc]; cwv[j] = cw[j * 768 + 512 + hc]; }
    const float cbr = cbp[hc], cbk = cbp[256 + hc], cbv = cbp[512 + hc];
    float st[8];
#pragma unroll
    for (int j = 0; j < 8; ++j) st[j] = 0.f;
    const int sv = tid >> 3, kq = tid & 7;
    for (int seg = 0; seg < 2; ++seg) {
        const int len = seg ? T : TC, nch = len / 32;
        for (int ch = 0; ch < nch; ++ch) {
            {
                const int i = tid >> 4, q4 = (tid & 15) * 4, sidx = 32 * ch + i, t = dir ? (len - 1 - sidx) : sidx;
                const v2u w = *(const v2u*)(Z + (size_t)tok_row(b, seg, t) * ZP + ZWD + q4);
                float x0 = bflo(w.x), x1 = bfhi(w.x), x2 = bflo(w.y), x3 = bfhi(w.y);
                if (q4 < 32) { x0 = tanhf(x0); x1 = tanhf(x1); x2 = tanhf(x2); x3 = tanhf(x3); }
                *(LAS f32x4*)(Slw + i * 64 + q4) = (f32x4){x0, x1, x2, x3};
            }
            __syncthreads();
#pragma unroll 1
            for (int tt = 0; tt < 4; ++tt) {
                const int i = wave + 8 * tt, sidx = 32 * ch + i, t = dir ? (len - 1 - sidx) : sidx;
                const float rv = conv3(Z, b, seg, t, len, ZRKV + hc, cwr[0], cwr[1], cwr[2], cbr);
                const float kv = conv3(Z, b, seg, t, len, ZRKV + 256 + hc, cwk[0], cwk[1], cwk[2], cbk);
                const float vv = conv3(Z, b, seg, t, len, ZRKV + 512 + hc, cwv[0], cwv[1], cwv[2], cbv);
                const float kx = kv * kkc; const float nrm = sqrtf(wave_sum(kx * kx)); const float kn = kx / fmaxf(nrm, 1e-12f);
                float wl_ = w0c, al_ = a0c;
#pragma unroll
                for (int j = 0; j < 32; ++j) { wl_ += Slw[i * 64 + j] * wup[j]; al_ += Slw[i * 64 + 32 + j] * aup[j]; }
                const float xneg = -wl_; const float sp = fmaxf(xneg, 0.f) + log1pf(__expf(-fabsf(xneg)));
                const float dec = __expf(-__expf(-sp - 0.5f));
                const float av = 1.0f / (1.0f + __expf(-al_));
                Sdec[i * 64 + c] = dec; Skk[i * 64 + c] = kn; Sbb[i * 64 + c] = kn * av; Ske[i * 64 + c] = kv * (1.0f + (av - 1.0f) * kac); Sr[i * 64 + c] = rv; Sv[i * 64 + c] = vv;
            }
            __syncthreads();
#pragma unroll 2
            for (int i = 0; i < 32; ++i) {
                const f32x4 k0 = *(const LAS f32x4*)(Skk + i * 64 + 8 * kq), k1 = *(const LAS f32x4*)(Skk + i * 64 + 8 * kq + 4);
                const f32x4 d0 = *(const LAS f32x4*)(Sdec + i * 64 + 8 * kq), d1 = *(const LAS f32x4*)(Sdec + i * 64 + 8 * kq + 4);
                const f32x4 b0 = *(const LAS f32x4*)(Sbb + i * 64 + 8 * kq), b1 = *(const LAS f32x4*)(Sbb + i * 64 + 8 * kq + 4);
                const f32x4 e0 = *(const LAS f32x4*)(Ske + i * 64 + 8 * kq), e1 = *(const LAS f32x4*)(Ske + i * 64 + 8 * kq + 4);
                const f32x4 r0 = *(const LAS f32x4*)(Sr + i * 64 + 8 * kq), r1 = *(const LAS f32x4*)(Sr + i * 64 + 8 * kq + 4);
                const float vv = Sv[i * 64 + sv];
                float sa = (st[0] * k0.x + st[1] * k0.y) + (st[2] * k0.z + st[3] * k0.w) + (st[4] * k1.x + st[5] * k1.y) + (st[6] * k1.z + st[7] * k1.w);
                sa += __shfl_xor(sa, 1); sa += __shfl_xor(sa, 2); sa += __shfl_xor(sa, 4);
                st[0] = st[0] * d0.x - sa * b0.x + vv * e0.x; st[1] = st[1] * d0.y - sa * b0.y + vv * e0.y; st[2] = st[2] * d0.z - sa * b0.z + vv * e0.z; st[3] = st[3] * d0.w - sa * b0.w + vv * e0.w;
                st[4] = st[4] * d1.x - sa * b1.x + vv * e1.x; st[5] = st[5] * d1.y - sa * b1.y + vv * e1.y; st[6] = st[6] * d1.z - sa * b1.z + vv * e1.z; st[7] = st[7] * d1.w - sa * b1.w + vv * e1.w;
                float y = (st[0] * r0.x + st[1] * r0.y) + (st[2] * r0.z + st[3] * r0.w) + (st[4] * r1.x + st[5] * r1.y) + (st[6] * r1.z + st[7] * r1.w);
                y += __shfl_xor(y, 1); y += __shfl_xor(y, 2); y += __shfl_xor(y, 4);
                if (kq == 0) Sy[i * 64 + sv] = y;
            }
            __syncthreads();
            {
                const int i = tid >> 4, q4 = (tid & 15) * 4, sidx = 32 * ch + i, t = dir ? (len - 1 - sidx) : sidx;
                const f32x4 y = *(const LAS f32x4*)(Sy + i * 64 + q4);
                v2u o; o.x = pk2(y.x, y.y); o.y = pk2(y.z, y.w);
                *(v2u*)(YR + (size_t)tok_row(b, seg, t) * 256 + hd * 64 + q4) = o;
            }
        }
    }
    __syncthreads();
}

DI void mlstm_task(KArgs a, const Ctx& F, int l, int b, int hd) {
    const bf16* Z = (const bf16*)(a->ws + WS_ACT);
    const int tid = F.tid, lane = F.lane, wave = F.wave, dir = wave >> 2, w2 = wave & 3, tid2 = tid & 255, l31 = lane & 31, hh = lane >> 5;
    bf16* YM = (bf16*)(a->ws + WS_YM) + (size_t)dir * NROWS * 256;
    constexpr int HP = 72;
    LAS uchar* base = F.lds + dir * 53248;
    LAS bf16* Qc = (LAS bf16*)base; LAS bf16* Kc = Qc + 64 * HP; LAS bf16* KTw = Kc + 64 * HP; LAS bf16* VT = KTw + 64 * HP; LAS bf16* Cb = VT + 64 * HP;
    LAS float* fv = (LAS float*)(base + 5 * 9216);
    LAS float* Vgv = fv; LAS float* VMr = fv + 64; LAS float* Vwi = fv + 128; LAS float* Vem = fv + 192; LAS float* Vwk = fv + 256; LAS float* Vn = fv + 320; LAS float* Vsc = fv + 384;
    for (int i = tid2; i < 64 * HP; i += 256) Cb[i] = 0;
    if (tid2 < 64) Vn[tid2] = 0.f;
    if (tid2 == 0) { float one_ = 1.f, zero_ = 0.f; asm volatile("" : "+v"(one_), "+v"(zero_)); Vsc[0] = one_; Vsc[1] = zero_; }
    f32x16 accC;
#pragma unroll
    for (int r = 0; r < 16; ++r) accC[r] = 0.f;
    const int eb = w2 >> 1, lb = w2 & 1;
    const float* cw = a->in[I_MCW] + (size_t)l * 3 * 512; const float* cbp = a->in[I_MCB] + (size_t)l * 512;
    const float gbi = a->in[I_MGB][l * 16 + dir * 8 + hd], gbf = a->in[I_MGB][l * 16 + dir * 8 + 4 + hd];
    __syncthreads();
    for (int seg = 0; seg < 2; ++seg) {
        const int len = seg ? T : TC, nch = len / 64;
        for (int ch = 0; ch < nch; ++ch) {
            if (w2 == 0) {
                const int sidx = 64 * ch + lane, t = dir ? (len - 1 - sidx) : sidx;
                const bf16* zp = Z + (size_t)tok_row(b, seg, t) * ZP + ZMG + dir * 8 + hd;
                const float li = bf2f(zp[0]) + gbi, fraw = bf2f(zp[4]) + gbf;
                const float lf = fminf(fraw, 0.f) - log1pf(__expf(-fabsf(fraw)));
                float bc = lf;
#pragma unroll
                for (int o = 1; o < 64; o <<= 1) { const float n = __shfl_up(bc, o); if (lane >= o) bc += n; }
                const float g = li - bc; float pm = g;
#pragma unroll
                for (int o = 1; o < 64; o <<= 1) { const float n = __shfl_up(pm, o); if (lane >= o) pm = fmaxf(pm, n); }
                const float mprev = Vsc[1];
                const float blast = __shfl(bc, 63);
                const float lw = blast - bc + li;
                const float mnew = fmaxf(blast + mprev, wave_max(lw));
                const float Mr = fmaxf(mprev, pm);
                Vgv[lane] = g; VMr[lane] = Mr; Vwi[lane] = __expf(mprev - Mr); Vem[lane] = __expf(-bc - Mr); Vwk[lane] = __expf(lw - mnew);
                if (lane == 0) { Vsc[0] = __expf(blast + mprev - mnew); Vsc[2] = mnew; }
            }
            __syncthreads();
            {
                const int i = tid2 >> 2, qq = tid2 & 3, sidx = 64 * ch + i, t = dir ? (len - 1 - sidx) : sidx;
                const bf16* zr = Z + (size_t)tok_row(b, seg, t) * ZP;
                const float wk_i = Vwk[i];
                const int cq = hd * 64 + qq * 16;
                float qv[16], kvv[16];
#pragma unroll
                for (int j = 0; j < 16; ++j) {
                    float yq = cbp[cq + j] + cw[512 + cq + j] * bf2f(zr[ZMQK + cq + j]);
                    float yk = cbp[256 + cq + j] + cw[512 + 256 + cq + j] * bf2f(zr[ZMQK + 256 + cq + j]);
                    if (t > 0) { yq += cw[cq + j] * bf2f(zr[ZMQK + cq + j - ZP]); yk += cw[256 + cq + j] * bf2f(zr[ZMQK + 256 + cq + j - ZP]); }
                    if (t + 1 < len) { yq += cw[1024 + cq + j] * bf2f(zr[ZMQK + cq + j + ZP]); yk += cw[1024 + 256 + cq + j] * bf2f(zr[ZMQK + 256 + cq + j + ZP]); }
                    qv[j] = yq * fsigmoid(yq); kvv[j] = yk * fsigmoid(yk) * 0.125f;
                }
#pragma unroll
                for (int j = 0; j < 16; j += 2) { *(LAS unsigned*)(Qc + i * HP + qq * 16 + j) = pk2(qv[j], qv[j + 1]); *(LAS unsigned*)(Kc + i * HP + qq * 16 + j) = pk2(kvv[j], kvv[j + 1]); }
#pragma unroll
                for (int j = 0; j < 16; ++j) { KTw[(qq * 16 + j) * HP + i] = (bf16)f2bf(kvv[j] * wk_i); VT[(qq * 16 + j) * HP + i] = zr[ZMV + cq + j]; }
            }
            __syncthreads();
            {
                const int lidx = 32 * lb + l31;
                f32x16 accN, accI;
#pragma unroll
                for (int r = 0; r < 16; ++r) { accN[r] = 0.f; accI[r] = 0.f; }
                float dsum = 0.f;
                const float Mr = VMr[lidx];
#pragma unroll
                for (int sb = 0; sb < 2; ++sb) {
                    if (sb <= lb) {
                        f32x16 sT;
#pragma unroll
                        for (int r = 0; r < 16; ++r) sT[r] = 0.f;
#pragma unroll
                        for (int s = 0; s < 4; ++s) {
                            const bf16x8 ka = *(const LAS bf16x8*)(Kc + (32 * sb + l31) * HP + 16 * s + 8 * hh);
                            const bf16x8 qb = *(const LAS bf16x8*)(Qc + lidx * HP + 16 * s + 8 * hh);
                            sT = mfma32(ka, qb, sT);
                        }
#pragma unroll
                        for (int r = 0; r < 16; ++r) { const int sidx = 32 * sb + crow(r, hh);
                            const float p = (sidx <= lidx) ? sT[r] * __expf(Vgv[sidx] - Mr) : 0.f; sT[r] = p; dsum += p; }
#pragma unroll
                        for (int sp = 0; sp < 2; ++sp) {
                            const bf16x8 pf = pack8(sT[8 * sp + 0], sT[8 * sp + 1], sT[8 * sp + 2], sT[8 * sp + 3], sT[8 * sp + 4], sT[8 * sp + 5], sT[8 * sp + 6], sT[8 * sp + 7]);
                            const int ko = 32 * sb + 16 * sp + 4 * hh;
                            const bf16x4 a0 = *(const LAS bf16x4*)(VT + (32 * eb + l31) * HP + ko), a1 = *(const LAS bf16x4*)(VT + (32 * eb + l31) * HP + ko + 8);
                            accN = mfma32(__builtin_shufflevector(a0, a1, 0, 1, 2, 3, 4, 5, 6, 7), pf, accN);
                        }
                    }
                }
#pragma unroll
                for (int s = 0; s < 4; ++s) {
                    const bf16x8 ca = *(const LAS bf16x8*)(Cb + (32 * eb + l31) * HP + 16 * s + 8 * hh);
                    const bf16x8 qb = *(const LAS bf16x8*)(Qc + lidx * HP + 16 * s + 8 * hh);
                    accI = mfma32(ca, qb, accI);
                }
                dsum += __shfl_xor(dsum, 32);
                float nq = 0.f;
#pragma unroll
                for (int j = 0; j < 64; j += 2) { const unsigned w = *(const LAS unsigned*)(Qc + lidx * HP + j); nq += Vn[j] * bflo(w) + Vn[j + 1] * bfhi(w); }
                const float wi = Vwi[lidx];
                const float den = dsum + wi * nq, hden = fmaxf(fabsf(den), Vem[lidx]), inv = 1.0f / hden;
                const int sidx = 64 * ch + lidx, t = dir ? (len - 1 - sidx) : sidx;
                bf16* op = YM + (size_t)tok_row(b, seg, t) * 256 + hd * 64 + 32 * eb;
#pragma unroll
                for (int gq = 0; gq < 4; ++gq) {
                    const float h0 = (accN[4 * gq] + wi * accI[4 * gq]) * inv, h1 = (accN[4 * gq + 1] + wi * accI[4 * gq + 1]) * inv, h2 = (accN[4 * gq + 2] + wi * accI[4 * gq + 2]) * inv, h3 = (accN[4 * gq + 3] + wi * accI[4 * gq + 3]) * inv;
                    v2u o; o.x = pk2(h0, h1); o.y = pk2(h2, h3);
                    *(v2u*)(op + 8 * gq + 4 * hh) = o;
                }
            }
            __syncthreads();
            {
                const float sc = Vsc[0];
#pragma unroll
                for (int r = 0; r < 16; ++r) accC[r] *= sc;
#pragma unroll
                for (int s = 0; s < 4; ++s) {
                    const bf16x8 va = *(const LAS bf16x8*)(VT + (32 * eb + l31) * HP + 16 * s + 8 * hh);
                    const bf16x8 kb = *(const LAS bf16x8*)(KTw + (32 * lb + l31) * HP + 16 * s + 8 * hh);
                    accC = mfma32(va, kb, accC);
                }
#pragma unroll
                for (int r = 0; r < 16; ++r) Cb[(32 * eb + crow(r, hh)) * HP + 32 * lb + l31] = (bf16)f2bf(accC[r]);
                if (tid2 < 64) { float s = 0.f;
#pragma unroll
                    for (int j = 0; j < 64; j += 2) { const unsigned w = *(const LAS unsigned*)(KTw + tid2 * HP + j); s += bflo(w) + bfhi(w); }
                    Vn[tid2] = sc * Vn[tid2] + s; }
                if (tid2 == 0) Vsc[1] = Vsc[2];
            }
            __syncthreads();
        }
    }
}
DI float gelu_tanh(float x) { const float u = 0.7978845608028654f * (x + 0.044715f * x * x * x); const float e = __expf(2.0f * u); const float th = 1.0f - 2.0f / (e + 1.0f); return 0.5f * x * (1.0f + th); }
DI void fin_tile(KArgs a, const Ctx& F, int l, int tile) {
    const bf16* Z = (const bf16*)(a->ws + WS_ACT); bf16* MO = (bf16*)(a->ws + WS_H);
    const bf16* YS = (const bf16*)(a->ws + WS_YS5); const bf16* YR = (const bf16*)(a->ws + WS_YR); const bf16* YM = (const bf16*)(a->ws + WS_YM);
    const bf16* WGLU = (const bf16*)(a->ws + WS_SMALLW + SW_GLU); const bf16* WGUP = (const bf16*)(a->ws + WS_SMALLW + SW_GUP);
    LAS bf16* Az = (LAS bf16*)F.lds;
    LAS bf16* Ag = (LAS bf16*)(F.lds + 33792);
    LAS float* Pr = (LAS float*)(F.lds + 33792 + 9216);
    const int tid = F.tid, lane = F.lane, wave = F.wave, row0 = tile * 64;
    const int i = tid >> 3, part = tid & 7, row = row0 + i;
    const size_t DS = (size_t)NROWS * 256;
    {
        const float* dsk = a->in[I_S5D] + l * 256 + part * 32;
#pragma unroll
        for (int j = 0; j < 4; ++j) { const int c0 = part * 32 + 8 * j;
            const v4u y0 = *(const v4u*)(YS + (size_t)row * 256 + c0), y1 = *(const v4u*)(YS + DS + (size_t)row * 256 + c0), u = *(const v4u*)(Z + (size_t)row * ZP + ZS5 + c0);
            float z[8];
            z[0] = gelu_tanh(bflo(y0.x) + bflo(y1.x) + dsk[8 * j + 0] * bflo(u.x)); z[1] = gelu_tanh(bfhi(y0.x) + bfhi(y1.x) + dsk[8 * j + 1] * bfhi(u.x));
            z[2] = gelu_tanh(bflo(y0.y) + bflo(y1.y) + dsk[8 * j + 2] * bflo(u.y)); z[3] = gelu_tanh(bfhi(y0.y) + bfhi(y1.y) + dsk[8 * j + 3] * bfhi(u.y));
            z[4] = gelu_tanh(bflo(y0.z) + bflo(y1.z) + dsk[8 * j + 4] * bflo(u.z)); z[5] = gelu_tanh(bfhi(y0.z) + bfhi(y1.z) + dsk[8 * j + 5] * bfhi(u.z));
            z[6] = gelu_tanh(bflo(y0.w) + bflo(y1.w) + dsk[8 * j + 6] * bflo(u.w)); z[7] = gelu_tanh(bfhi(y0.w) + bfhi(y1.w) + dsk[8 * j + 7] * bfhi(u.w));
            v4u o; o.x = pk2(z[0], z[1]); o.y = pk2(z[2], z[3]); o.z = pk2(z[4], z[5]); o.w = pk2(z[6], z[7]);
            *(LAS v4u*)(Az + i * 264 + c0) = o; }
    }
    {
        const int hq = part >> 1, hf = part & 1, c0 = hq * 64 + hf * 32;
        const bool lat = row < NLAT; const int t = lat ? (row & (T - 1)) : ((row - NLAT) & (TC - 1)); const int len = lat ? T : TC;
        const bf16* zr = Z + (size_t)row * ZP;
        {
            float y[32]; float s = 0.f;
#pragma unroll
            for (int j = 0; j < 4; ++j) { const v4u y0 = *(const v4u*)(YM + (size_t)row * 256 + c0 + 8 * j), y1 = *(const v4u*)(YM + DS + (size_t)row * 256 + c0 + 8 * j);
                y[8 * j + 0] = bflo(y0.x) + bflo(y1.x); y[8 * j + 1] = bfhi(y0.x) + bfhi(y1.x); y[8 * j + 2] = bflo(y0.y) + bflo(y1.y); y[8 * j + 3] = bfhi(y0.y) + bfhi(y1.y);
                y[8 * j + 4] = bflo(y0.z) + bflo(y1.z); y[8 * j + 5] = bfhi(y0.z) + bfhi(y1.z); y[8 * j + 6] = bflo(y0.w) + bflo(y1.w); y[8 * j + 7] = bfhi(y0.w) + bfhi(y1.w); }
#pragma unroll
            for (int j = 0; j < 32; ++j) s += y[j];
            s += __shfl_xor(s, 1); const float mu = s * (1.0f / 64.0f); float q = 0.f;
#pragma unroll
            for (int j = 0; j < 32; ++j) { y[j] -= mu; q += y[j] * y[j]; }
            q += __shfl_xor(q, 1); const float rstd = 1.0f / sqrtf(q * (1.0f / 64.0f) + 1e-6f);
            const float* nw = a->in[I_MNORM] + l * 256 + c0;
#pragma unroll
            for (int j = 0; j < 4; ++j) { const v4u ov = *(const v4u*)(zr + ZMO + c0 + 8 * j); float o[8];
                o[0] = bflo(ov.x); o[1] = bfhi(ov.x); o[2] = bflo(ov.y); o[3] = bfhi(ov.y); o[4] = bflo(ov.z); o[5] = bfhi(ov.z); o[6] = bflo(ov.w); o[7] = bfhi(ov.w);
#pragma unroll
                for (int e = 0; e < 8; ++e) o[e] = y[8 * j + e] * rstd * nw[8 * j + e] * fsigmoid(o[e]);
                v4u w; w.x = pk2(o[0], o[1]); w.y = pk2(o[2], o[3]); w.z = pk2(o[4], o[5]); w.w = pk2(o[6], o[7]);
                *(v4u*)(MO + (size_t)row * D + 768 + c0 + 8 * j) = w; }
        }
        {
            float y[32]; float s = 0.f;
#pragma unroll
            for (int j = 0; j < 4; ++j) { const v4u y0 = *(const v4u*)(YR + (size_t)row * 256 + c0 + 8 * j), y1 = *(const v4u*)(YR + DS + (size_t)row * 256 + c0 + 8 * j);
                y[8 * j + 0] = bflo(y0.x) + bflo(y1.x); y[8 * j + 1] = bfhi(y0.x) + bfhi(y1.x); y[8 * j + 2] = bflo(y0.y) + bflo(y1.y); y[8 * j + 3] = bfhi(y0.y) + bfhi(y1.y);
                y[8 * j + 4] = bflo(y0.z) + bflo(y1.z); y[8 * j + 5] = bfhi(y0.z) + bfhi(y1.z); y[8 * j + 6] = bflo(y0.w) + bflo(y1.w); y[8 * j + 7] = bfhi(y0.w) + bfhi(y1.w); }
#pragma unroll
            for (int j = 0; j < 32; ++j) s += y[j];
            s += __shfl_xor(s, 1); const float mu = s * (1.0f / 64.0f); float q = 0.f;
#pragma unroll
            for (int j = 0; j < 32; ++j) { y[j] -= mu; q += y[j] * y[j]; }
            q += __shfl_xor(q, 1); const float rstd = 1.0f / sqrtf(q * (1.0f / 64.0f) + 64e-5f);
            const float* cw = a->in[I_RCW] + (size_t)l * 3 * 768; const float* cbp = a->in[I_RCB] + (size_t)l * 768;
            const float* rk = a->in[I_RRK] + l * 256 + c0; const float* lw = a->in[I_RLNW] + l * 256 + c0; const float* lb = a->in[I_RLNB] + l * 256 + c0;
            float vv[32]; float bs = 0.f;
#pragma unroll 4
            for (int j = 0; j < 32; ++j) { const int c = c0 + j;
                float rr = cbp[c] + cw[768 + c] * bf2f(zr[ZRKV + c]), kk = cbp[256 + c] + cw[768 + 256 + c] * bf2f(zr[ZRKV + 256 + c]), v = cbp[512 + c] + cw[768 + 512 + c] * bf2f(zr[ZRKV + 512 + c]);
                if (t > 0) { rr += cw[c] * bf2f(zr[ZRKV + c - ZP]); kk += cw[256 + c] * bf2f(zr[ZRKV + 256 + c - ZP]); v += cw[512 + c] * bf2f(zr[ZRKV + 512 + c - ZP]); }
                if (t + 1 < len) { rr += cw[1536 + c] * bf2f(zr[ZRKV + c + ZP]); kk += cw[1536 + 256 + c] * bf2f(zr[ZRKV + 256 + c + ZP]); v += cw[1536 + 512 + c] * bf2f(zr[ZRKV + 512 + c + ZP]); }
                bs += rr * kk * rk[j]; vv[j] = v; }
            bs += __shfl_xor(bs, 1);
#pragma unroll
            for (int j = 0; j < 32; ++j) Pr[i * 260 + c0 + j] = y[j] * rstd * lw[j] + lb[j] + bs * vv[j];
        }
        { const v4u gv = *(const v4u*)(zr + ZGD + part * 8);
          v4u o; o.x = pk2(fsigmoid(bflo(gv.x)), fsigmoid(bfhi(gv.x))); o.y = pk2(fsigmoid(bflo(gv.y)), fsigmoid(bfhi(gv.y))); o.z = pk2(fsigmoid(bflo(gv.z)), fsigmoid(bfhi(gv.z))); o.w = pk2(fsigmoid(bflo(gv.w)), fsigmoid(bfhi(gv.w)));
          *(LAS v4u*)(Ag + i * 72 + part * 8) = o; }
    }
    __syncthreads();
    const int lr = lane & 15, kq = lane >> 4;
    {
        f32x4 acc[2][4];
        small_gemm<256, 2, 4, true>(Az, 264, WGLU, 32 * wave, acc, lane);
        const float* bg = a->in[I_S5BGLU] + l * 256;
#pragma unroll
        for (int nb = 0; nb < 2; ++nb)
#pragma unroll
            for (int mb = 0; mb < 4; ++mb) { const int tk = 16 * mb + lr, n = 32 * wave + 16 * nb + 4 * kq; const f32x4 v = acc[nb][mb]; const f32x4 b4 = *(const f32x4*)(bg + n);
                const v2u zz = *(const LAS v2u*)(Az + tk * 264 + n);
                const float o0 = bflo(zz.x) * fsigmoid(v.x + b4.x), o1 = bfhi(zz.x) * fsigmoid(v.y + b4.y), o2 = bflo(zz.y) * fsigmoid(v.z + b4.z), o3 = bfhi(zz.y) * fsigmoid(v.w + b4.w);
                v2u o; o.x = pk2(o0, o1); o.y = pk2(o2, o3);
                *(v2u*)(MO + (size_t)(row0 + tk) * D + n) = o; }
    }
    {
        f32x4 acc[2][4];
        small_gemm<64, 2, 4, true>(Ag, 72, WGUP, 32 * wave, acc, lane);
#pragma unroll
        for (int nb = 0; nb < 2; ++nb)
#pragma unroll
            for (int mb = 0; mb < 4; ++mb) { const int tk = 16 * mb + lr, n = 32 * wave + 16 * nb + 4 * kq; const f32x4 v = acc[nb][mb];
                const f32x4 pr = *(const LAS f32x4*)(Pr + tk * 260 + n);
                v2u o; o.x = pk2(pr.x * v.x, pr.y * v.y); o.y = pk2(pr.z * v.z, pr.w * v.w);
                *(v2u*)(MO + (size_t)(row0 + tk) * D + 512 + n) = o; }
    }
    __syncthreads();
}

#ifndef MK_SPLIT
#define MK_SPLIT 1
#endif
#ifdef USE_NOINLINE
#define NI static __device__ __noinline__
#else
#define NI static __device__ __forceinline__
#endif
extern __shared__ __attribute__((aligned(16))) unsigned char lds_raw[];
DI Ctx make_ctx(int wave0) {
    Ctx F; F.lds = (LAS uchar*)lds_raw; { int ln_ = __builtin_amdgcn_mbcnt_hi(~0u, __builtin_amdgcn_mbcnt_lo(~0u, 0u)); asm volatile("" : "+v"(ln_)); F.lane = ln_; } F.wave = wave0; F.tid = wave0 * 64 + F.lane;
    F.G = gridDim.x; { int bx = blockIdx.x; asm volatile("" : "+s"(bx)); F.vcu = (F.G % 8 == 0) ? (bx % 8) * (F.G / 8) + bx / 8 : bx; }
    return F;
}
NI void ph_prologue(KArgs a_, int wave0) { KArgs a = a_; asm volatile("" : "+s"(a)); const Ctx F = make_ctx(wave0); phase_prologue(a, F); __syncthreads(); }
NI void ph_norm(KArgs a_, int wave0, int l, int kind) { KArgs a = a_; asm volatile("" : "+s"(a));
    const Ctx F = make_ctx(wave0);
    float* modv = (float*)(a->ws + WS_MODV);
    const bool last = (l == DEPTH - 1);
    if (kind == 0) convert_weights(a, F, l, 0);
    if (kind == 1) convert_weights(a, F, l, 1);
    const int lY = (kind == 0) ? (l > 0 ? l - 1 : 0) : l;
    const int gi = (kind == 0 || kind == 3) ? 8 : (kind == 1 ? 2 : 5);
    const int pi = (kind == 0 || kind == 3) ? 2 : (kind == 1 ? 0 : 1);
    const float coef = (kind == 2) ? 1.0f : 0.5f;
    const int si = (kind == 0) ? 0 : (kind == 1 ? 3 : 6);
    const int ni = (kind == 0) ? 0 : (kind == 1 ? 1 : 2);
    const bool first = (kind == 0 && l == 0), hasY = !(kind == 0 && l == 0), hasH = (kind != 3), fin = (kind == 3);
    const int nrows = (kind == 3 || (kind == 2 && last)) ? NLAT : NROWS;
    norm_rows(a, F, first, hasY, hasH, fin, nrows, modv + (size_t)lY * 9 * MODW, gi, a->in[I_NPOST] + (lY * 3 + pi) * D, coef, modv + (size_t)l * 9 * MODW, si, a->in[I_NPRE] + (l * 3 + ni) * D);
    __syncthreads();
}
NI void ph_gemm_swiglu(KArgs a_, int wave0, int M) { KArgs a = a_; asm volatile("" : "+s"(a));
    const Ctx F = make_ctx(wave0);
    pg8::Gemm g{(const bf16*)(a->ws + WS_H), (const bf16*)(a->ws + WS_WGU), M, 2 * FF, D}; pg8::StaticOrder S; S.init(M, 2 * FF, F.G, (int)blockIdx.x);
    pg8::EpiSwiGLU E{(bf16*)(a->ws + WS_ACT), FF};
    pg8::gemm_phase<pg8::EpiSwiGLU, pg8::StaticOrder, PG8_ALIGN, PG8_SP2>(F.lds, g, S, E, F.tid);
}
NI void ph_gemm_store(KArgs a_, int wave0, int which, int M) { KArgs a = a_; asm volatile("" : "+s"(a));
    const Ctx F = make_ctx(wave0);
    const bf16* A = (const bf16*)(a->ws + (which == 0 ? WS_ACT : WS_H));
    const bf16* W = (const bf16*)(a->ws + (which == 0 ? WS_WDN : which == 1 ? WS_WIN : WS_WOUT));
    const int N = which == 1 ? ZPAD : D, K = which == 0 ? FF : D;
    pg8::Gemm g{A, W, M, N, K}; pg8::StaticOrder S; S.init(M, N, F.G, (int)blockIdx.x);
    pg8::EpiStore E{(bf16*)(a->ws + (which == 1 ? WS_ACT : WS_Y)), which == 1 ? ZP : D, which == 1 ? ZP : D};
    pg8::gemm_phase<pg8::EpiStore, pg8::StaticOrder, PG8_ALIGN, PG8_SP2>(F.lds, g, S, E, F.tid);
}
NI void ph_mla_prep(KArgs a_, int wave0, int l) { KArgs a = a_; asm volatile("" : "+s"(a)); const Ctx F = make_ctx(wave0); for (int tile = F.vcu; tile < NROWS / 64; tile += F.G) mla_prep_tile(a, F, l, tile); }
NI void ph_rwkv(KArgs a_, int wave0, int l, int v) { KArgs a = a_; asm volatile("" : "+s"(a)); const Ctx F = make_ctx(wave0); rwkv_scan_task(a, F, l, v >> 3, (v >> 1) & 3, v & 1); }
NI void ph_mlstm(KArgs a_, int wave0, int l, int idx) { KArgs a = a_; asm volatile("" : "+s"(a)); const Ctx F = make_ctx(wave0); mlstm_task(a, F, l, idx >> 2, idx & 3); __syncthreads(); }
NI void ph_s5(KArgs a_, int wave0, int l, int wg) { KArgs a = a_; asm volatile("" : "+s"(a)); const Ctx F = make_ctx(wave0); const int tk = wg * 8 + F.wave; s5_scan_task(a, l, tk >> 5, (tk >> 4) & 1, tk & 15, (LAS bf16*)(F.lds + F.wave * 8704), F.lane); __syncthreads(); }
NI void ph_attn(KArgs a_, int wave0, int first, int stride) { KArgs a = a_; asm volatile("" : "+s"(a));
    const Ctx F = make_ctx(wave0);
    for (int u = first; u < 512 + 32; u += stride) {
        if (u < 512) { const int b = u >> 6, hd = (u >> 4) & 3, qb = u & 15; attn_unit(a, F, b, hd, b * T + qb * 256, NKEY); }
        else { const int c = u - 512, b = c >> 2, hd = c & 3; attn_unit(a, F, b, hd, NLAT + b * TC, TC); }
    }
}
NI void ph_fin(KArgs a_, int wave0, int l, int M) { KArgs a = a_; asm volatile("" : "+s"(a)); const Ctx F = make_ctx(wave0); for (int tile = F.vcu; tile < M / 64; tile += F.G) fin_tile(a, F, l, tile); }


#ifdef DBG_CUT
NI void ph_dump(KArgs a_, int wave0) { KArgs a = a_; asm volatile("" : "+s"(a)); const Ctx F = make_ctx(wave0);
    const float* X = (const float*)(a->ws + WS_X); const bf16* Z = (const bf16*)(a->ws + WS_ACT); const bf16* Q = (const bf16*)(a->ws + WS_Q); const bf16* Kf = (const bf16*)(a->ws + WS_K); const bf16* Vt = (const bf16*)(a->ws + WS_VT);
    const bf16* YS = (const bf16*)(a->ws + WS_YS5); const bf16* YR = (const bf16*)(a->ws + WS_YR); const bf16* YM = (const bf16*)(a->ws + WS_YM); const bf16* MO = (const bf16*)(a->ws + WS_H); const bf16* Y = (const bf16*)(a->ws + WS_Y);
    const size_t DS = (size_t)NROWS * 256;
    for (size_t i = (size_t)F.vcu * NTHR + F.tid; i < (size_t)NLAT * D; i += (size_t)F.G * NTHR) {
#ifdef DBG_CTX
        const size_t r = NLAT + ((i >> 10) % NCTX);
#else
        const size_t r = i >> 10;
#endif
        const int c = (int)(i & 1023); float v = 0.f;
        if (DBG_WHICH & 1) v += X[r * D + c];
        if (DBG_WHICH & 2) { v += bf2f(Z[r * ZP + c]) + bf2f(Z[r * ZP + 1024 + c]); if (c + 2048 < ZP) v += bf2f(Z[r * ZP + 2048 + c]); }
        if (DBG_WHICH & 4) { v += bf2f(Q[r * 384 + c % 384]) + bf2f(Kf[r * 384 + c % 384]) + bf2f(Vt[i % ((size_t)NB * 4 * 64 * NKEY)]); }
        if (DBG_WHICH & 256) v += bf2f(Q[r * 384 + c % 384]);
        if (DBG_WHICH & 512) v += bf2f(Kf[r * 384 + c % 384]);
        if (DBG_WHICH & 1024) v += bf2f(Vt[i % ((size_t)NB * 4 * 64 * NKEY)]);
        if (DBG_WHICH & 2048) { const float* rc = (const float*)(a->ws + WS_ROPE); const bf16* sw = (const bf16*)(a->ws + WS_SMALLW); v += rc[i % (T * 32)] + bf2f(sw[i % 245760]); }
        if (DBG_WHICH & 8) v += bf2f(YS[r * 256 + (c & 255)]) + bf2f(YS[DS + r * 256 + (c & 255)]);
        if (DBG_WHICH & 16) v += bf2f(YR[r * 256 + (c & 255)]) + bf2f(YR[DS + r * 256 + (c & 255)]);
        if (DBG_WHICH & 32) v += bf2f(YM[r * 256 + (c & 255)]) + bf2f(YM[DS + r * 256 + (c & 255)]);
        if (DBG_WHICH & 64) v += bf2f(MO[r * D + c]);
        if (DBG_WHICH & 128) v += bf2f(Y[r * D + c]);
        a->out[i] = v;
    }
}
#endif
#if !MK_SPLIT
#ifndef ONLY_PH
#define PHON(k) true
#else
#define PHON(k) ((k) == ONLY_PH)
#endif
#ifndef ONLY_ROLE
#define ROLE(k) true
#else
#define ROLE(k) ((k) == ONLY_ROLE)
#endif
constexpr int NPH = 2 + 12 * DEPTH;
__global__ void __launch_bounds__(NTHR, 2) hybrid_fwd(Args args_byval) {
    KArgs a = (KArgs)__builtin_amdgcn_kernarg_segment_ptr();
    LAS uchar* lds = (LAS uchar*)lds_raw;
    const int tid = threadIdx.x; const int wave0 = __builtin_amdgcn_readfirstlane(tid >> 6);
    volatile LAS unsigned* MISC = (volatile LAS unsigned*)(lds + MISC_OFF);
    for (int u = tid; u < (LDS_BYTES - LDSCTL_OFF) / 4; u += NTHR) ((LAS unsigned*)(lds + LDSCTL_OFF))[u] = 0u;
    __syncthreads();
    unsigned* ctl = (unsigned*)(a->ws + WS_CTL);
    const int use_bar = a->use_bar;
    XcdBarrier bar; bar.bar = ctl + CW_BAR; bar.x = 0; bar.st = nullptr;
    if (use_bar) bar = xcd_barrier_post(ctl + CW_BAR, MISC + 8, tid == 0);
    const int lo = a->ph_lo, hi = a->ph_hi;
    const int G = gridDim.x; const int vcu = (G % 8 == 0) ? ((int)blockIdx.x % 8) * (G / 8) + (int)blockIdx.x / 8 : (int)blockIdx.x;
#ifdef DBG_CUT
#define IN(k) (lo <= (k) && (k) < hi && (k) < DBG_CUT)
#else
#define IN(k) (lo <= (k) && (k) < hi)
#endif
#define SEAM(k) do { if (use_bar && IN(k) && IN((k) + 1)) { int ln_ = __builtin_amdgcn_mbcnt_hi(~0u, __builtin_amdgcn_mbcnt_lo(~0u, 0u)); asm volatile("" : "+v"(ln_)); xcd_barrier(bar, wave0 == 0 && ln_ == 0); } } while (0)
    if (PHON(100) && IN(0)) ph_prologue(a, wave0);
    SEAM(0);
#pragma unroll 1
    for (int l = 0; l < DEPTH; ++l) {
        const int P = 1 + 12 * l;
        const int Mtail = (l == DEPTH - 1) ? NLAT : NROWS;
        if (PHON(0) && IN(P + 0)) ph_norm(a, wave0, l, 0);
        SEAM(P + 0);
        if (PHON(1) && IN(P + 1)) ph_gemm_swiglu(a, wave0, NROWS);
        SEAM(P + 1);
        if (PHON(2) && IN(P + 2)) ph_gemm_store(a, wave0, 0, NROWS);
        SEAM(P + 2);
        if (PHON(3) && IN(P + 3)) ph_norm(a, wave0, l, 1);
        SEAM(P + 3);
        if (PHON(4) && IN(P + 4)) ph_gemm_store(a, wave0, 1, NROWS);
        SEAM(P + 4);
        if (PHON(5) && IN(P + 5)) ph_mla_prep(a, wave0, l);
        SEAM(P + 5);
        if (PHON(6) && IN(P + 6) && G >= 256) {
            if (ROLE(0) && vcu < 64) ph_rwkv(a, wave0, l, vcu);
            else if (ROLE(1) && vcu < 96) ph_mlstm(a, wave0, l, vcu - 64);
            else if (ROLE(2) && vcu < 128) ph_s5(a, wave0, l, vcu - 96);
            else if (ROLE(3)) ph_attn(a, wave0, vcu - 128, G - 128);
        }
        SEAM(P + 6);
        if (PHON(7) && IN(P + 7)) ph_fin(a, wave0, l, Mtail);
        SEAM(P + 7);
        if (PHON(8) && IN(P + 8)) ph_gemm_store(a, wave0, 2, Mtail);
        SEAM(P + 8);
        if (PHON(9) && IN(P + 9)) ph_norm(a, wave0, l, 2);
        SEAM(P + 9);
        if (PHON(10) && IN(P + 10)) ph_gemm_swiglu(a, wave0, Mtail);
        SEAM(P + 10);
        if (PHON(11) && IN(P + 11)) ph_gemm_store(a, wave0, 0, Mtail);
        SEAM(P + 11);
    }
#ifdef DBG_CUT
    if (lo <= NPH - 1 && NPH - 1 < hi) ph_dump(a, wave0);
#else
    if (PHON(101) && IN(NPH - 1)) ph_norm(a, wave0, DEPTH - 1, 3);
#endif
#undef IN
#undef SEAM
}

#endif
#if MK_SPLIT
struct ArgsS { Args base; int kind, l, sub, M; };
typedef const __attribute__((address_space(4))) ArgsS* KArgsS;
template <int KIND>
__global__ void __launch_bounds__(NTHR, 2) phase_kernel(ArgsS args_byval) {
    KArgsS as = (KArgsS)__builtin_amdgcn_kernarg_segment_ptr();
    KArgs a = (KArgs)as;
    const int tid = threadIdx.x; const int wave0 = __builtin_amdgcn_readfirstlane(tid >> 6);
    const int l = as->l, sub = as->sub, M = as->M;
    const int G = gridDim.x; const int vcu = (G % 8 == 0) ? ((int)blockIdx.x % 8) * (G / 8) + (int)blockIdx.x / 8 : (int)blockIdx.x;
    if constexpr (KIND == 0) ph_prologue(a, wave0);
    if constexpr (KIND == 1) ph_norm(a, wave0, l, sub);
    if constexpr (KIND == 2) ph_gemm_swiglu(a, wave0, M);
    if constexpr (KIND == 3) ph_gemm_store(a, wave0, sub, M);
    if constexpr (KIND == 4) ph_mla_prep(a, wave0, l);
    if constexpr (KIND == 5) { if (vcu < 64) ph_rwkv(a, wave0, l, vcu); }
    if constexpr (KIND == 6) { if (vcu >= 64 && vcu < 96) ph_mlstm(a, wave0, l, vcu - 64); }
    if constexpr (KIND == 7) { if (vcu >= 96 && vcu < 128) ph_s5(a, wave0, l, vcu - 96); }
    if constexpr (KIND == 8) { if (vcu >= 128) ph_attn(a, wave0, vcu - 128, G - 128); }
    if constexpr (KIND == 9) ph_fin(a, wave0, l, M);
}
template <int KIND> static void launch_phase(int grid, hipStream_t stream, const Args& base, int l, int sub, int M) {
    static bool attr = false;
    if (!attr) { (void)hipFuncSetAttribute((const void*)phase_kernel<KIND>, hipFuncAttributeMaxDynamicSharedMemorySize, LDS_BYTES); attr = true; }
    ArgsS s{}; s.base = base; s.kind = KIND; s.l = l; s.sub = sub; s.M = M;
    hipLaunchKernelGGL(phase_kernel<KIND>, dim3(grid), dim3(NTHR), LDS_BYTES, stream, s);
}
static void launch_split(int grid, hipStream_t stream, const Args& a) {
    launch_phase<0>(grid, stream, a, 0, 0, 0);
    for (int l = 0; l < DEPTH; ++l) {
        const int Mtail = (l == DEPTH - 1) ? NLAT : NROWS;
        launch_phase<1>(grid, stream, a, l, 0, 0);
        launch_phase<2>(grid, stream, a, l, 0, NROWS);
        launch_phase<3>(grid, stream, a, l, 0, NROWS);
        launch_phase<1>(grid, stream, a, l, 1, 0);
        launch_phase<3>(grid, stream, a, l, 1, NROWS);
        launch_phase<4>(grid, stream, a, l, 0, 0);
        launch_phase<5>(grid, stream, a, l, 0, 0);
        launch_phase<6>(grid, stream, a, l, 0, 0);
        launch_phase<7>(grid, stream, a, l, 0, 0);
        launch_phase<8>(grid, stream, a, l, 0, 0);
        launch_phase<9>(grid, stream, a, l, 0, Mtail);
        launch_phase<3>(grid, stream, a, l, 2, Mtail);
        launch_phase<1>(grid, stream, a, l, 2, 0);
        launch_phase<2>(grid, stream, a, l, 0, Mtail);
        launch_phase<3>(grid, stream, a, l, 0, Mtail);
    }
    launch_phase<1>(grid, stream, a, DEPTH - 1, 3, 0);
}
#endif
extern "C" void kernel_launch(void* const* d_in, const int* in_sizes, int n_in, void* d_out, int out_size, void* d_ws, size_t ws_size, hipStream_t stream) {
    static int grid = 0;
    if (grid == 0) {
        if (n_in != 43 || out_size != NLAT * D || ws_size < WS_END) { fprintf(stderr, "kernel_launch: unexpected shapes: n_in %d out %d ws %zu (need %zu)\n", n_in, out_size, ws_size, (size_t)WS_END); grid = -1; return; }
        int dev = 0, cus = 0, per_cu = 0;
        if (hipGetDevice(&dev) != hipSuccess || hipDeviceGetAttribute(&cus, hipDeviceAttributeMultiprocessorCount, dev) != hipSuccess) { grid = -1; return; }
        if (false) { grid = -1; return; }
        (void)hipGetLastError();
        grid = cus;
    }
    if (grid < 0) return;
    (void)hipMemsetAsync((char*)d_ws + WS_CTL, 0, CTL_ZERO_BYTES, stream);
    Args a{};
    for (int i = 0; i < 43; ++i) a.in[i] = (const float*)d_in[i];
    a.out = (float*)d_out; a.ws = (unsigned char*)d_ws; a.pad = 0;
#if MK_SPLIT
    launch_split(grid, stream, a);
#else
    static bool attr1 = false; if (!attr1) { (void)hipFuncSetAttribute((const void*)hybrid_fwd, hipFuncAttributeMaxDynamicSharedMemorySize, LDS_BYTES); attr1 = true; }
    a.ph_lo = 0; a.ph_hi = NPH; a.use_bar = 1;
    hipLaunchKernelGGL(hybrid_fwd, dim3(grid), dim3(NTHR), LDS_BYTES, stream, a);
#endif
}
```

```cpp
#include <hip/hip_runtime.h>
#include <cstdio>
#include <cstdint>
#define MK_SPLIT 0
namespace pg8 {
#define PG8_LAS __attribute__((address_space(3)))
typedef unsigned short bf16_t;
typedef short bf16x8 __attribute__((ext_vector_type(8)));
typedef float f32x4 __attribute__((ext_vector_type(4)));
typedef unsigned u32x4 __attribute__((ext_vector_type(4)));
constexpr int BM = 256, BK = 64, HALF = 128, HTB = HALF * BK * 2  , STAGE_BYTES = 8 * HTB, NXCD = 8, WGM = 8;

__host__ __device__ __forceinline__ int lds_byte(int r, int c) { const int st = (r >> 4) * 2 + (c >> 5), rr = r & 15, cc = c & 31, ob = rr * 64 + cc * 2; return st * 1024 + (ob ^ (((ob >> 9) & 1) << 5)); }
__host__ __device__ __forceinline__ void stage_rc(int b, int& R, int& C) { const int st = b / 1024, sb = b % 1024, swz = sb ^ (((sb >> 9) & 1) << 5); R = (st >> 1) * 16 + swz / 64; C = (st & 1) * 32 + (swz % 64) / 2; }
__host__ __device__ __forceinline__ int perm32(int rho) { const int n = rho >> 4, i = rho & 15; return 8 * (i >> 2) + 4 * n + (i & 3); }

struct Unit { int pm, pn; };
struct Gemm { const bf16_t* A; const bf16_t* Bt; int M, N, K; };

struct StaticOrder {
    int nM, nN, nwg, G, c;
    __host__ __device__ void init(int M, int N, int G_, int c_) { nM = M / BM; nN = N / BM; nwg = nM * nN; G = G_; c = c_; }
    __host__ __device__ bool next(int i, Unit& u) const {
        const long L = (long)i * G + c; if (L >= nwg) return false;
        int wgid = (int)L; { const int q = nwg / NXCD, r = nwg % NXCD, xcd = wgid % NXCD, off = wgid / NXCD; wgid = (xcd < r ? xcd * (q + 1) : r * (q + 1) + (xcd - r) * q) + off; }
        const int nig = WGM * nN, gid = wgid / nig, fm = gid * WGM, gsz = (nM - fm) < WGM ? (nM - fm) : WGM;
        u.pm = fm + ((wgid % nig) % gsz); u.pn = (wgid % nig) / gsz; return true;
    }
    __device__ __forceinline__ void a_ready(const Unit&) const {}
    __device__ __forceinline__ void done(const Unit&) const {}
};

typedef __bf16 nbf16v2 __attribute__((ext_vector_type(2))); typedef float nf32v2 __attribute__((ext_vector_type(2)));
__device__ __forceinline__ unsigned cvt_pk_bf16(float lo, float hi) { const nf32v2 v = {lo, hi}; return __builtin_bit_cast(unsigned, __builtin_convertvector(v, nbf16v2)); }
struct EpiSwiGLU {
    static constexpr bool PERM = true, AFTER_DRAIN = false;
    bf16_t* O; int ldc;
    __device__ __forceinline__ void operator()(const f32x4 (&acc)[2][2][4][2], const Unit& u, int wr, int wc, int fr, int fq) const {
        const int row0 = u.pm * BM + wr * 64 + fr; const int col0 = u.pn * HALF + wc * 32 + 8 * fq;
#pragma unroll
        for (int ai = 0; ai < 2; ++ai)
#pragma unroll
            for (int m = 0; m < 4; ++m) { bf16_t* rowp = O + (size_t)(row0 + ai * HALF + m * 16) * ldc + col0;
                float o[8];
#pragma unroll
                for (int n = 0; n < 2; ++n)
#pragma unroll
                    for (int j = 0; j < 4; ++j) { const float g = acc[ai][0][m][n][j], up = acc[ai][1][m][n][j];
                        const float sg = __builtin_amdgcn_rcpf(1.0f + __builtin_amdgcn_exp2f(-1.44269504089f * g)); o[n * 4 + j] = g * sg * up; }
                u32x4 w; w.x = cvt_pk_bf16(o[0], o[1]); w.y = cvt_pk_bf16(o[2], o[3]); w.z = cvt_pk_bf16(o[4], o[5]); w.w = cvt_pk_bf16(o[6], o[7]);
                *(u32x4*)rowp = w; }
    }
};
struct EpiStore {
    static constexpr bool PERM = true, AFTER_DRAIN = false;
    bf16_t* O; int ldc; int ncols;
    __device__ __forceinline__ void operator()(const f32x4 (&acc)[2][2][4][2], const Unit& u, int wr, int wc, int fr, int fq) const {
        const int row0 = u.pm * BM + wr * 64 + fr; const int col0 = u.pn * BM + wc * 32 + 8 * fq;
#pragma unroll
        for (int ai = 0; ai < 2; ++ai)
#pragma unroll
            for (int m = 0; m < 4; ++m) { bf16_t* rowp = O + (size_t)(row0 + ai * HALF + m * 16) * ldc + col0;
#pragma unroll
                for (int bj = 0; bj < 2; ++bj) { if (col0 + bj * HALF < ncols) { const f32x4 v0 = acc[ai][bj][m][0], v1 = acc[ai][bj][m][1];
                    u32x4 w; w.x = cvt_pk_bf16(v0[0], v0[1]); w.y = cvt_pk_bf16(v0[2], v0[3]); w.z = cvt_pk_bf16(v1[0], v1[1]); w.w = cvt_pk_bf16(v1[2], v1[3]);
                    *(u32x4*)(rowp + bj * HALF) = w; } } }
    }
};
template <class Epi, class Sched, bool ALIGN_EPI = false, bool SP2 = false>
__device__ __forceinline__ void gemm_phase(PG8_LAS unsigned char* lds, const Gemm g, const Sched& S, const Epi& E, const int tid) {
    const int wid = __builtin_amdgcn_readfirstlane(tid >> 6), lane = tid & 63, wr = wid >> 2, wc = wid & 3, fr = lane & 15, fq = lane >> 4;
    const int K = g.K, nt = K / BK;
    unsigned voffA[2], voffB[2];
#pragma unroll
    for (int i = 0; i < 2; ++i) { int R, C; stage_rc(tid * 16 + i * 8192, R, C); const int Rb = Epi::PERM ? ((R & ~31) + perm32(R & 31)) : R;
        voffA[i] = (unsigned)(R * K + C) * 2u; voffB[i] = (unsigned)(Rb * K + C) * 2u; }
    const size_t kstep = (size_t)(BK * 2);
    const size_t hstep = (size_t)HALF * K * 2;
    const size_t tstep = 2 * hstep;
    const unsigned ldsw = (unsigned)wid * 1024u;
    const int aoff = lds_byte(wr * 64 + fr, fq * 8), boff = lds_byte(wc * 32 + fr, fq * 8);
#define PG8_SA(b, h) (((b) * 2 + (h)) * HTB)
#define PG8_SB(b, h) ((4 + (b) * 2 + (h)) * HTB)
#define PG8_STAGE(bufoff, gbase, voff) do { _Pragma("unroll") for (int _i = 0; _i < 2; ++_i) \
        __builtin_amdgcn_global_load_lds((const unsigned*)((const char*)(gbase) + (voff)[_i]), (PG8_LAS unsigned*)(lds + (bufoff) + ldsw + _i * 8192), 16, 0, 0); } while (0)
#define PG8_LDA(dst, b, h) do { _Pragma("unroll") for (int m = 0; m < 4; ++m) _Pragma("unroll") for (int k = 0; k < 2; ++k) dst[m][k] = *(const PG8_LAS bf16x8*)(lds + PG8_SA(b, h) + aoff + m * 2048 + k * 1024); } while (0)
#define PG8_LDB(dst, b, h) do { _Pragma("unroll") for (int n = 0; n < 2; ++n) _Pragma("unroll") for (int k = 0; k < 2; ++k) dst[n][k] = *(const PG8_LAS bf16x8*)(lds + PG8_SB(b, h) + boff + n * 2048 + k * 1024); } while (0)
#define PG8_MMA(ai, bj, At, Bt) do { __builtin_amdgcn_s_setprio(1); _Pragma("unroll") for (int m = 0; m < 4; ++m) _Pragma("unroll") for (int n = 0; n < 2; ++n) _Pragma("unroll") for (int k = 0; k < 2; ++k) \
        acc[ai][bj][m][n] = __builtin_amdgcn_mfma_f32_16x16x32_bf16(Bt[n][k], At[m][k], acc[ai][bj][m][n], 0, 0, 0); __builtin_amdgcn_s_setprio(0); } while (0)
#define PG8_WAIT_V(n) asm volatile("s_waitcnt vmcnt(" #n ")" ::: "memory")
#define PG8_WAIT_L(n) asm volatile("s_waitcnt lgkmcnt(" #n ")" ::: "memory")
#define PG8_BAR __builtin_amdgcn_s_barrier()
#define PG8_SCHED __builtin_amdgcn_sched_barrier(0)
    Unit cur, nxt; int ui = 0;
    if (!S.next(0, cur)) return;
    f32x4 acc[2][2][4][2];
#pragma unroll
    for (int a = 0; a < 2; ++a)
#pragma unroll
        for (int b = 0; b < 2; ++b)
#pragma unroll
            for (int m = 0; m < 4; ++m)
#pragma unroll
                for (int n = 0; n < 2; ++n) acc[a][b][m][n] = (f32x4){0.f, 0.f, 0.f, 0.f};
    bf16x8 At[4][2], B0[2][2], B1[2][2];
    const char* cA = (const char*)g.A + (size_t)cur.pm * tstep; const char* cB = (const char*)g.Bt + (size_t)cur.pn * tstep;
    S.a_ready(cur);
    if constexpr (SP2) {
        PG8_STAGE(PG8_SB(0, 0), cB, voffB); PG8_STAGE(PG8_SB(0, 1), cB + hstep, voffB); PG8_STAGE(PG8_SA(0, 0), cA, voffA); PG8_STAGE(PG8_SA(0, 1), cA + hstep, voffA);
        if (wr == 1) PG8_BAR;
        PG8_WAIT_V(2); PG8_BAR;
        PG8_STAGE(PG8_SB(1, 0), cB + kstep, voffB); PG8_STAGE(PG8_SA(1, 0), cA + kstep, voffA); PG8_STAGE(PG8_SB(1, 1), cB + hstep + kstep, voffB);
        PG8_WAIT_V(6); PG8_BAR;
    } else {
        PG8_STAGE(PG8_SB(0, 0), cB, voffB); PG8_STAGE(PG8_SA(0, 0), cA, voffA); PG8_STAGE(PG8_SB(0, 1), cB + hstep, voffB); PG8_STAGE(PG8_SA(0, 1), cA + hstep, voffA);
        if (wr == 1) PG8_BAR;
        PG8_WAIT_V(4); PG8_BAR;
        PG8_STAGE(PG8_SB(1, 0), cB + kstep, voffB); PG8_STAGE(PG8_SA(1, 0), cA + kstep, voffA); PG8_STAGE(PG8_SB(1, 1), cB + hstep + kstep, voffB);
        PG8_WAIT_V(6); PG8_BAR;
    }
    for (;;) {
        const bool has_next = S.next(ui + 1, nxt);
        const char* nA = has_next ? (const char*)g.A + (size_t)nxt.pm * tstep : cA; const char* nB = has_next ? (const char*)g.Bt + (size_t)nxt.pn * tstep : cB;
        for (int t = 0; t < nt; t += 2) {
            const bool last = (t == nt - 2);
            const char* a1 = cA + (size_t)(t + 1) * kstep;
            const char* a2 = last ? nA : cA + (size_t)(t + 2) * kstep; const char* b2 = last ? nB : cB + (size_t)(t + 2) * kstep;
            const char* a3 = a2 + kstep; const char* b3 = b2 + kstep;
            if (last && has_next) S.a_ready(nxt);
            if constexpr (SP2) {
            PG8_LDB(B0, 0, 0); PG8_LDB(B1, 0, 1); PG8_SCHED; PG8_LDA(At, 0, 0); PG8_STAGE(PG8_SA(1, 1), a1 + hstep, voffA);
            PG8_WAIT_V(8); PG8_WAIT_L(0); PG8_BAR; PG8_MMA(0, 0, At, B0); PG8_MMA(0, 1, At, B1); PG8_BAR; PG8_SCHED;
            PG8_LDA(At, 0, 1); PG8_STAGE(PG8_SB(0, 0), b2, voffB); PG8_STAGE(PG8_SB(0, 1), b2 + hstep, voffB); PG8_STAGE(PG8_SA(0, 0), a2, voffA);
            PG8_WAIT_V(8); PG8_WAIT_L(0); PG8_BAR; PG8_MMA(1, 0, At, B0); PG8_MMA(1, 1, At, B1); PG8_BAR; PG8_SCHED;
            PG8_LDB(B0, 1, 0); PG8_LDB(B1, 1, 1); PG8_SCHED; PG8_LDA(At, 1, 0); PG8_STAGE(PG8_SA(0, 1), a2 + hstep, voffA);
            PG8_WAIT_V(8); PG8_WAIT_L(0); PG8_BAR; PG8_MMA(0, 0, At, B0); PG8_MMA(0, 1, At, B1); PG8_BAR; PG8_SCHED;
            PG8_LDA(At, 1, 1); PG8_STAGE(PG8_SB(1, 0), b3, voffB); PG8_STAGE(PG8_SB(1, 1), b3 + hstep, voffB); PG8_STAGE(PG8_SA(1, 0), a3, voffA);
            PG8_WAIT_V(8); PG8_WAIT_L(0); PG8_BAR; PG8_MMA(1, 0, At, B0); PG8_MMA(1, 1, At, B1); PG8_BAR; PG8_SCHED;
            } else {
            PG8_LDB(B0, 0, 0); PG8_SCHED; PG8_LDA(At, 0, 0); PG8_STAGE(PG8_SA(1, 1), a1 + hstep, voffA);
            PG8_WAIT_L(8); PG8_BAR; PG8_WAIT_L(0); PG8_MMA(0, 0, At, B0); PG8_BAR; PG8_SCHED;
            PG8_LDB(B1, 0, 1); PG8_STAGE(PG8_SB(0, 0), b2, voffB);
            PG8_BAR; PG8_WAIT_L(0); PG8_MMA(0, 1, At, B1); PG8_BAR;
            PG8_LDA(At, 0, 1); PG8_STAGE(PG8_SA(0, 0), a2, voffA);
            PG8_BAR; PG8_WAIT_L(0); PG8_MMA(1, 0, At, B0); PG8_BAR; PG8_SCHED;
            PG8_STAGE(PG8_SB(0, 1), b2 + hstep, voffB);
            PG8_WAIT_V(6); PG8_BAR; PG8_MMA(1, 1, At, B1); PG8_BAR;
            PG8_LDB(B0, 1, 0); PG8_SCHED; PG8_LDA(At, 1, 0); PG8_STAGE(PG8_SA(0, 1), a2 + hstep, voffA);
            PG8_WAIT_L(8); PG8_BAR; PG8_WAIT_L(0); PG8_MMA(0, 0, At, B0); PG8_BAR; PG8_SCHED;
            PG8_LDB(B1, 1, 1); PG8_STAGE(PG8_SB(1, 0), b3, voffB);
            PG8_BAR; PG8_WAIT_L(0); PG8_MMA(0, 1, At, B1); PG8_BAR;
            PG8_LDA(At, 1, 1); PG8_STAGE(PG8_SA(1, 0), a3, voffA);
            PG8_BAR; PG8_WAIT_L(0); PG8_MMA(1, 0, At, B0); PG8_BAR; PG8_SCHED;
            PG8_STAGE(PG8_SB(1, 1), b3 + hstep, voffB);
            PG8_WAIT_V(6); PG8_BAR; PG8_MMA(1, 1, At, B1); PG8_BAR;
            }
        }
        if constexpr (ALIGN_EPI) { if (wr == 0) PG8_BAR; }
        if constexpr (!Epi::AFTER_DRAIN) { E(acc, cur, wr, wc, fr, fq); S.done(cur); }
        if (!has_next) break;
#pragma unroll
        for (int a = 0; a < 2; ++a)
#pragma unroll
            for (int b = 0; b < 2; ++b)
#pragma unroll
                for (int m = 0; m < 4; ++m)
#pragma unroll
                    for (int n = 0; n < 2; ++n) acc[a][b][m][n] = (f32x4){0.f, 0.f, 0.f, 0.f};
        cur = nxt; cA = nA; cB = nB; ++ui;
        if constexpr (ALIGN_EPI) { if (wr == 1) PG8_BAR; }
    }
    PG8_WAIT_V(0);
    if constexpr (!ALIGN_EPI) { if (wr == 0) PG8_BAR; }
    PG8_BAR;
    if constexpr (Epi::AFTER_DRAIN) { E.fused(acc, cur, wr, wc, fr, fq, lds, wid, lane); S.done(cur); }
#undef PG8_SA
#undef PG8_SB
#undef PG8_STAGE
#undef PG8_LDA
#undef PG8_LDB
#undef PG8_MMA
#undef PG8_WAIT_V
#undef PG8_WAIT_L
#undef PG8_BAR
#undef PG8_SCHED
}
}
#define PG8_SP2 true
#define PG8_ALIGN true

constexpr int NWAVES = 8, NTHR = 512;
constexpr int D = 1024, NB = 8, T = 4096, TC = 256, DEPTH = 4, FF = 2816, ZP = 2608, ZPAD = 2816;
constexpr int NLAT = NB * T, NCTX = NB * TC, NROWS = NLAT + NCTX;
constexpr int MODW = 9 * D;
constexpr int NKEY = TC + T;
constexpr float NORM_EPS = 1e-6f;
constexpr int ZS5 = 0, ZCQ = 256, ZCKV = 512, ZKR = 640, ZRKV = 672, ZWD = 1440, ZAD = 1472, ZGD = 1504, ZMQK = 1568, ZMV = 2080, ZMO = 2336, ZMG = 2592;

constexpr size_t MiB = 1u << 20;
constexpr size_t WS_CTL = 0, CTL_ZERO_BYTES = 1 * MiB;
constexpr size_t WS_MODV = 1 * MiB;
constexpr size_t WS_ROPE = 3 * MiB;
constexpr size_t WS_SMALLW = 4 * MiB;
constexpr size_t SW_UQ = 0, SW_UKV = 196608, SW_GLU = 327680, SW_GUP = 458752;
constexpr size_t WS_WGU = 6 * MiB, WS_WDN = 17 * MiB, WS_WIN = 23 * MiB, WS_WOUT = 29 * MiB;
constexpr size_t WS_X = 31 * MiB;
constexpr size_t WS_Y = 167 * MiB;
constexpr size_t WS_Q = WS_Y, WS_K = WS_Y + (size_t)NROWS * 384 * 2, WS_VT = WS_K + (size_t)NROWS * 384 * 2;
constexpr size_t WS_H = 235 * MiB;
constexpr size_t WS_ACT = 303 * MiB;
constexpr size_t WS_YS5 = 490 * MiB, WS_YR = 524 * MiB, WS_YM = 558 * MiB, WS_END = 592 * MiB;
static_assert(WS_VT + (size_t)NB * 4 * 64 * NKEY * 2 <= WS_H, "qkv overlay");
static_assert(WS_WGU + (size_t)5632 * 1024 * 2 <= WS_WDN && WS_WDN + (size_t)1024 * 2816 * 2 <= WS_WIN && WS_WIN + (size_t)2816 * 1024 * 2 <= WS_WOUT && WS_WOUT + 2 * MiB <= WS_X, "weights");
static_assert(WS_X + (size_t)NROWS * D * 4 <= WS_Y && WS_Y + (size_t)NROWS * D * 2 <= WS_H && WS_H + (size_t)NROWS * D * 2 <= WS_ACT && WS_ACT + (size_t)NROWS * ZPAD * 2 <= WS_YS5, "map");
static_assert(WS_YS5 + (size_t)2 * NROWS * 256 * 2 <= WS_YR && WS_YM + (size_t)2 * NROWS * 256 * 2 <= WS_END, "map2");
constexpr int CW_BAR = 4096;

constexpr int RING_BYTES = 131072, LDSCTL_OFF = RING_BYTES, MISC_OFF = LDSCTL_OFF + 320, LDS_BYTES = 147456;

#define GAS __attribute__((address_space(1)))
#define LAS __attribute__((address_space(3)))
typedef unsigned short bf16;
typedef unsigned char uchar;
typedef unsigned v4u __attribute__((ext_vector_type(4)));
typedef unsigned v2u __attribute__((ext_vector_type(2)));
typedef float f32x4 __attribute__((ext_vector_type(4)));
typedef float f32x16 __attribute__((ext_vector_type(16)));
typedef short bf16x8 __attribute__((ext_vector_type(8)));
typedef short bf16x4 __attribute__((ext_vector_type(4)));
#define DI __device__ __forceinline__
DI unsigned f2bf(float f) { unsigned u = __builtin_bit_cast(unsigned, f); return (u + 0x7fffu + ((u >> 16) & 1u)) >> 16; }
DI unsigned pk2(float lo, float hi) { return pg8::cvt_pk_bf16(lo, hi); }
DI float bf2f(unsigned b) { return __builtin_bit_cast(float, b << 16); }
DI float bflo(unsigned w) { return __builtin_bit_cast(float, w << 16); }
DI float bfhi(unsigned w) { return __builtin_bit_cast(float, w & 0xffff0000u); }
DI float wave_sum(float v) {
#pragma unroll
    for (int o = 1; o < 64; o <<= 1) v += __shfl_xor(v, o);
    return v;
}
DI float wave_max(float v) {
#pragma unroll
    for (int o = 1; o < 64; o <<= 1) v = fmaxf(v, __shfl_xor(v, o));
    return v;
}
DI float fexp(float x) { return __builtin_amdgcn_exp2f(x * 1.44269504089f); }
DI float fsigmoid(float x) { return __builtin_amdgcn_rcpf(1.0f + fexp(-x)); }
DI f32x16 mfma32(bf16x8 a, bf16x8 b, f32x16 c) { return __builtin_amdgcn_mfma_f32_32x32x16_bf16(a, b, c, 0, 0, 0); }
DI f32x4 mfma16(bf16x8 a, bf16x8 b, f32x4 c) { return __builtin_amdgcn_mfma_f32_16x16x32_bf16(a, b, c, 0, 0, 0); }
DI int crow(int r, int h) { return (r & 3) + 8 * (r >> 2) + 4 * h; }
DI bf16x8 pack8(float a0, float a1, float a2, float a3, float a4, float a5, float a6, float a7) {
    typedef __bf16 nb8 __attribute__((ext_vector_type(8))); typedef float nf8 __attribute__((ext_vector_type(8)));
    const nf8 v = {a0, a1, a2, a3, a4, a5, a6, a7}; return __builtin_bit_cast(bf16x8, __builtin_convertvector(v, nb8));
}
DI void my_sincosf(float x, float& s, float& c) {
    const float k = __builtin_rintf(x * 0.63661977236758134f);
    float r = __builtin_fmaf(-k, 1.5703125f, x); r = __builtin_fmaf(-k, 4.837512969970703125e-4f, r); r = __builtin_fmaf(-k, 7.54978995489188216e-8f, r);
    const float r2 = r * r;
    const float ps = r + r * r2 * (-1.6666654611e-1f + r2 * (8.3321608736e-3f + r2 * (-1.9515295891e-4f)));
    const float pc = 1.0f - 0.5f * r2 + r2 * r2 * (4.166664568298827e-2f + r2 * (-1.388731625493765e-3f + r2 * 2.443315711809948e-5f));
    const int q = ((int)k) & 3;
    const float ss = (q & 1) ? pc : ps, cc = (q & 1) ? ps : pc;
    s = (q & 2) ? -ss : ss; c = ((q + 1) & 2) ? -cc : cc;
}

#define XB_TMO      128
#define XB_XCNT(j)  (256  + 64 * (j))
#define XB_XSUB(j)  (1280 + 64 * (j))
#define XB_XGEN(j)  (2304 + 64 * (j))
#define XB_TOP      3328
#define XB_TOPGEN   3392
#define XCD_BAR_WORDS 3456
#define XB_SPIN_CAP (1u << 22)
DI unsigned xb_ld(unsigned* p)              { return __hip_atomic_load(p, __ATOMIC_RELAXED, __HIP_MEMORY_SCOPE_AGENT); }
DI unsigned xb_add(unsigned* p, unsigned v) { return __hip_atomic_fetch_add(p, v, __ATOMIC_RELAXED, __HIP_MEMORY_SCOPE_AGENT); }
DI unsigned xb_xcc_id() { return (unsigned)__builtin_amdgcn_s_getreg((3 << 11) | 20) & 0xFu; }
#define XB_SPIN(cond, bar) do { unsigned _sp = 0; while (cond) { __builtin_amdgcn_s_sleep(1); \
    if ((++_sp & 255u) == 0u) { if (xb_ld(&(bar)[XB_TMO])) break; if (_sp > XB_SPIN_CAP) { atomicAdd(&(bar)[XB_TMO], 1u); break; } } } } while (0)
struct XcdBarrier { unsigned* bar; unsigned x; volatile LAS unsigned* st; };
DI XcdBarrier xcd_barrier_post(unsigned* bar, volatile LAS unsigned* st, bool t0) {
    XcdBarrier b; b.bar = bar; b.x = xb_xcc_id(); b.st = st;
    if (t0) (void)xb_add(&bar[XB_XCNT(b.x)], 1u);
    return b;
}
DI void xcd_barrier_complete(unsigned* bar, unsigned x, unsigned& nloc, unsigned& nx) {
    const unsigned G = gridDim.x * gridDim.y * gridDim.z;
    unsigned sum, cnt, mine, sp = 0u;
    for (;;) {
        sum = 0u; cnt = 0u; mine = 0u;
#pragma unroll
        for (unsigned j = 0; j < 16; ++j) { const unsigned c = xb_ld(&bar[XB_XCNT(j)]); sum += c; cnt += (c > 0u) ? 1u : 0u; mine = (j == x) ? c : mine; }
        if (sum == G) break;
        __builtin_amdgcn_s_sleep(1);
        if ((++sp & 255u) == 0u) { if (xb_ld(&bar[XB_TMO])) break; if (sp > XB_SPIN_CAP) { atomicAdd(&bar[XB_TMO], 1u); break; } }
    }
    nloc = mine > 0u ? mine : 1u; nx = cnt > 0u ? cnt : 1u;
}
DI void xcd_barrier(const XcdBarrier& b, bool t0) {
    asm volatile("s_waitcnt vmcnt(0)" ::: "memory");
    __syncthreads();
    if (t0) {
        unsigned* bar = b.bar;
        __builtin_amdgcn_s_waitcnt(0);
        unsigned nloc = b.st[0], nx = b.st[1];
        if (nloc == 0u) { xcd_barrier_complete(bar, b.x, nloc, nx); b.st[0] = nloc; b.st[1] = nx; }
        const unsigned old = xb_add(&bar[XB_XSUB(b.x)], 1u);
        const unsigned gen = old / nloc;
        if (old + 1u == (gen + 1u) * nloc) {
            __builtin_amdgcn_fence(__ATOMIC_RELEASE, "agent");
            asm volatile("s_waitcnt vmcnt(0)" ::: "memory");
            const unsigned og = xb_add(&bar[XB_TOP], 1u);
            const unsigned tg = og / nx;
            if (og + 1u == (tg + 1u) * nx) xb_add(&bar[XB_TOPGEN], 1u);
            else XB_SPIN(xb_ld(&bar[XB_TOPGEN]) == tg, bar);
            __builtin_amdgcn_fence(__ATOMIC_ACQUIRE, "agent");
            xb_add(&bar[XB_XGEN(b.x)], 1u);
            asm volatile("s_waitcnt vmcnt(0)" ::: "memory");
        } else {
            XB_SPIN(xb_ld(&bar[XB_XGEN(b.x)]) == gen, bar);
            __builtin_amdgcn_fence(__ATOMIC_ACQUIRE, "agent");
            asm volatile("s_waitcnt vmcnt(0)" ::: "memory");
        }
    }
    __syncthreads();
}

struct Args { const float* in[43]; float* out; unsigned char* ws; int ph_lo, ph_hi, use_bar, pad; };
typedef const __attribute__((address_space(4))) Args* KArgs;
enum { I_X = 0, I_C, I_CTX, I_CCTX, I_WADA, I_BADA, I_NPRE, I_NPOST, I_WG, I_WU, I_WD, I_WIN, I_WOUT, I_S5LRE, I_S5LIM, I_S5DT, I_S5BRE, I_S5BIM, I_S5CRE, I_S5CIM, I_S5D, I_S5GLU, I_S5BGLU,
       I_MQN, I_MKVN, I_MUQ, I_MUKV, I_RCW, I_RCB, I_RW0, I_RWUP, I_RA0, I_RAUP, I_RGUP, I_RKK, I_RKA, I_RRK, I_RLNW, I_RLNB, I_MCW, I_MCB, I_MGB, I_MNORM };

struct Ctx {
    LAS uchar* lds; int tid, lane, wave, vcu, G;
};
DI int tok_row(int b, int seg, int t) { return seg ? b * T + t : NLAT + b * TC + t; }
DI void phase_prologue(KArgs a, const Ctx& F) {
    LAS float* sc = (LAS float*)F.lds;
    LAS float* red = (LAS float*)(F.lds + 40960);
    const float* c = a->in[I_C]; const float* cc = a->in[I_CCTX];
    for (int i = F.tid; i < 9 * D; i += NTHR) { const float v = (i < 8 * D) ? c[i] : cc[i - 8 * D]; sc[i] = v * fsigmoid(v); }
    __syncthreads();
    const float* wada = a->in[I_WADA]; const float* bada = a->in[I_BADA];
    float* modv = (float*)(a->ws + WS_MODV);
    for (int task = F.vcu; task < DEPTH * 144; task += F.G) {
        const int l = task / 144, nb = task % 144, n = nb * 64 + F.lane;
        const float* wp = wada + ((size_t)l * D + F.wave * 128) * MODW + n;
        float acc[9];
#pragma unroll
        for (int m = 0; m < 9; ++m) acc[m] = 0.f;
#pragma unroll 8
        for (int k = 0; k < 128; ++k) { const float w = wp[(size_t)k * MODW];
#pragma unroll
            for (int m = 0; m < 9; ++m) acc[m] += sc[m * D + F.wave * 128 + k] * w; }
#pragma unroll
        for (int m = 0; m < 9; ++m) red[(F.wave * 9 + m) * 64 + F.lane] = acc[m];
        __syncthreads();
        for (int i = F.tid; i < 576; i += NTHR) { const int m = i >> 6, ln = i & 63; float s = 0.f;
#pragma unroll
            for (int w = 0; w < 8; ++w) s += red[(w * 9 + m) * 64 + ln];
            modv[((size_t)l * 9 + m) * MODW + nb * 64 + ln] = s + bada[l * MODW + nb * 64 + ln]; }
        __syncthreads();
    }
    float* rc = (float*)(a->ws + WS_ROPE); float* rs = rc + T * 16;
    for (int i = F.vcu * NTHR + F.tid; i < T * 16; i += F.G * NTHR) {
        const int t = i >> 4, f = i & 15, pos = f < 8 ? (t >> 6) : (t & 63), fi = f & 7;
        const float invf = (fi == 0) ? 1.0f : (fi == 1) ? 0.31622776601683794f : (fi == 2) ? 0.1f : (fi == 3) ? 0.031622776601683794f : (fi == 4) ? 0.01f : (fi == 5) ? 0.0031622776601683794f : (fi == 6) ? 0.001f : 0.00031622776601683794f;
        const float ang = (float)pos * invf; float s, co; my_sincosf(ang, s, co);
        rc[i] = co; rs[i] = s;
    }
}

DI void tr_item(const float* W, int K, int N, bf16* WT, int kb, int n0, int drow0, LAS float* scr, int lane) {
    const int k0 = 64 * kb, nn = n0 + (lane & 31);
#pragma unroll 8
    for (int i = 0; i < 32; ++i) { const int kk = 2 * i + (lane >> 5); scr[kk * 33 + (lane & 31)] = (nn < N) ? W[(size_t)(k0 + kk) * N + nn] : 0.f; }
    const int c = lane & 7;
#pragma unroll
    for (int j = 0; j < 4; ++j) { const int n = (lane >> 3) + 8 * j; const LAS float* s = scr + (8 * c) * 33 + n;
        v4u o; o.x = pk2(s[0 * 33], s[1 * 33]); o.y = pk2(s[2 * 33], s[3 * 33]); o.z = pk2(s[4 * 33], s[5 * 33]); o.w = pk2(s[6 * 33], s[7 * 33]);
        if (n0 + n < N) *(v4u*)(WT + (size_t)(drow0 + n) * K + k0 + 8 * c) = o; }
}
DI void convert_weights(KArgs a, const Ctx& F, int l, int set) {
    LAS float* scr = (LAS float*)(F.lds + F.wave * 8704);
    const int gw = F.vcu * NWAVES + F.wave, NGW = F.G * NWAVES;
    bf16* WGU = (bf16*)(a->ws + WS_WGU); bf16* WDN = (bf16*)(a->ws + WS_WDN); bf16* WIN = (bf16*)(a->ws + WS_WIN); bf16* WOUT = (bf16*)(a->ws + WS_WOUT);
    bf16* SW = (bf16*)(a->ws + WS_SMALLW);
    const int fl = l * 2 + set;
    const float* wg = a->in[I_WG] + (size_t)fl * D * FF; const float* wu = a->in[I_WU] + (size_t)fl * D * FF; const float* wd = a->in[I_WD] + (size_t)fl * FF * D;
    constexpr int I_G = 16 * 88, I_D = 44 * 32, I_IN = 16 * 82, I_O = 16 * 32, I_UQ = 4 * 12, I_UKV = 2 * 16, I_GLU = 4 * 8, I_GUP = 1 * 8;
    const int nitems = set == 0 ? (2 * I_G + I_D + I_IN + I_O + I_UQ + I_UKV + I_GLU + I_GUP) : (2 * I_G + I_D);
    for (int it = gw; it < nitems; it += NGW) {
        int r = it;
        if (r < I_G) { const int kb = r / 88, nb = r % 88, n0 = 32 * nb; tr_item(wg, D, FF, WGU, kb, n0, 256 * (n0 >> 7) + (n0 & 127), scr, F.lane); continue; } r -= I_G;
        if (r < I_G) { const int kb = r / 88, nb = r % 88, n0 = 32 * nb; tr_item(wu, D, FF, WGU, kb, n0, 256 * (n0 >> 7) + 128 + (n0 & 127), scr, F.lane); continue; } r -= I_G;
        if (r < I_D) { const int kb = r / 32, nb = r % 32; tr_item(wd, FF, D, WDN, kb, 32 * nb, 32 * nb, scr, F.lane); continue; } r -= I_D;
        if (r < I_IN) { const int kb = r / 82, nb = r % 82; tr_item(a->in[I_WIN] + (size_t)l * D * ZP, D, ZP, WIN, kb, 32 * nb, 32 * nb, scr, F.lane); continue; } r -= I_IN;
        if (r < I_O) { const int kb = r / 32, nb = r % 32; tr_item(a->in[I_WOUT] + (size_t)l * D * D, D, D, WOUT, kb, 32 * nb, 32 * nb, scr, F.lane); continue; } r -= I_O;
        if (r < I_UQ) { const int kb = r / 12, nb = r % 12; tr_item(a->in[I_MUQ] + (size_t)l * 256 * 384, 256, 384, (bf16*)((uchar*)SW + SW_UQ), kb, 32 * nb, 32 * nb, scr, F.lane); continue; } r -= I_UQ;
        if (r < I_UKV) { const int kb = r / 16, nb = r % 16; tr_item(a->in[I_MUKV] + (size_t)l * 128 * 512, 128, 512, (bf16*)((uchar*)SW + SW_UKV), kb, 32 * nb, 32 * nb, scr, F.lane); continue; } r -= I_UKV;
        if (r < I_GLU) { const int kb = r / 8, nb = r % 8; tr_item(a->in[I_S5GLU] + (size_t)l * 256 * 256, 256, 256, (bf16*)((uchar*)SW + SW_GLU), kb, 32 * nb, 32 * nb, scr, F.lane); continue; } r -= I_GLU;
        { const int nb = r; tr_item(a->in[I_RGUP] + (size_t)l * 64 * 256, 64, 256, (bf16*)((uchar*)SW + SW_GUP), 0, 32 * nb, 32 * nb, scr, F.lane); }
    }
    if (set == 0) {
        v4u z = {0u, 0u, 0u, 0u}; v4u* p = (v4u*)(WIN + (size_t)ZP * D);
        for (int i = F.vcu * NTHR + F.tid; i < (ZPAD - ZP) * D / 8; i += F.G * NTHR) p[i] = z;
    }
}

DI void norm_rows(KArgs a, const Ctx& F, bool p_first, bool p_hasY, bool p_hasH, bool p_final, int p_nrows, const float* p_modY, int p_gi, const float* p_pw, float p_coef, const float* p_modH, int p_si, const float* p_prew) {
    float* X = (float*)(a->ws + WS_X); const bf16* Y = (const bf16*)(a->ws + WS_Y); bf16* H = (bf16*)(a->ws + WS_H);
    const int gw = F.vcu * NWAVES + F.wave, NGW = F.G * NWAVES, lane = F.lane;
    for (int r = gw; r < p_nrows; r += NGW) {
        const int mr = r < NLAT ? (r >> 12) : 8;
        const float* xs = p_first ? (r < NLAT ? a->in[I_X] + (size_t)r * D : a->in[I_CTX] + (size_t)(r - NLAT) * D) : X + (size_t)r * D;
        f32x4 v[4];
#pragma unroll
        for (int j = 0; j < 4; ++j) v[j] = *(const f32x4*)(xs + 4 * lane + 256 * j);
        if (p_hasY) {
            f32x4 y[4]; float ss = 0.f;
#pragma unroll
            for (int j = 0; j < 4; ++j) { const v2u w = *(const v2u*)(Y + (size_t)r * D + 4 * lane + 256 * j); y[j] = (f32x4){bflo(w.x), bfhi(w.x), bflo(w.y), bfhi(w.y)};
                ss += (y[j].x * y[j].x + y[j].y * y[j].y) + (y[j].z * y[j].z + y[j].w * y[j].w); }
            const float rstd = 1.0f / sqrtf(wave_sum(ss) * (1.0f / D) + NORM_EPS);
            const float* g = p_modY + (size_t)mr * MODW + p_gi * D;
#pragma unroll
            for (int j = 0; j < 4; ++j) { const f32x4 gg = *(const f32x4*)(g + 4 * lane + 256 * j), ww = *(const f32x4*)(p_pw + 4 * lane + 256 * j);
                v[j] = v[j] + (gg * p_coef) * ((y[j] * rstd) * ww); }
        }
        if (p_final) {
#pragma unroll
            for (int j = 0; j < 4; ++j) *(f32x4*)(a->out + (size_t)r * D + 4 * lane + 256 * j) = v[j];
        } else if (p_hasY || p_first) {
#pragma unroll
            for (int j = 0; j < 4; ++j) *(f32x4*)(X + (size_t)r * D + 4 * lane + 256 * j) = v[j];
        }
        if (p_hasH) {
            float ss = 0.f;
#pragma unroll
            for (int j = 0; j < 4; ++j) ss += (v[j].x * v[j].x + v[j].y * v[j].y) + (v[j].z * v[j].z + v[j].w * v[j].w);
            const float rstd = 1.0f / sqrtf(wave_sum(ss) * (1.0f / D) + NORM_EPS);
            const float* sh = p_modH + (size_t)mr * MODW + p_si * D; const float* scp = sh + D;
#pragma unroll
            for (int j = 0; j < 4; ++j) { const f32x4 ww = *(const f32x4*)(p_prew + 4 * lane + 256 * j), s1 = *(const f32x4*)(scp + 4 * lane + 256 * j), s0 = *(const f32x4*)(sh + 4 * lane + 256 * j);
                const f32x4 h = ((v[j] * rstd) * ww) * (s1 + 1.0f) + s0;
                v2u o; o.x = pk2(h.x, h.y); o.y = pk2(h.z, h.w); *(v2u*)(H + (size_t)r * D + 4 * lane + 256 * j) = o; }
        }
    }
}
template <int K, int NBK, int MBK, bool TRANS>
DI void small_gemm(const LAS bf16* A, int apitch, const bf16* Wt, int n0w, f32x4 (&acc)[NBK][MBK], int lane) {
    const int lr = lane & 15, kq = lane >> 4;
#pragma unroll
    for (int nb = 0; nb < NBK; ++nb)
#pragma unroll
        for (int mb = 0; mb < MBK; ++mb) acc[nb][mb] = (f32x4){0.f, 0.f, 0.f, 0.f};
#pragma unroll 2
    for (int s = 0; s < K / 32; ++s) {
        bf16x8 av[MBK];
#pragma unroll
        for (int mb = 0; mb < MBK; ++mb) av[mb] = *(const LAS bf16x8*)(A + (16 * mb + lr) * apitch + 32 * s + 8 * kq);
#pragma unroll
        for (int nb = 0; nb < NBK; ++nb) { const bf16x8 w = *(const bf16x8*)(Wt + (size_t)(n0w + 16 * nb + lr) * K + 32 * s + 8 * kq);
#pragma unroll
            for (int mb = 0; mb < MBK; ++mb) acc[nb][mb] = TRANS ? mfma16(w, av[mb], acc[nb][mb]) : mfma16(av[mb], w, acc[nb][mb]); }
    }
}

DI void s5_coef(const float* lre, const float* lim, float dt, int nn, float& ar, float& ai, float& fr, float& fi) {
    const float lr = lre[nn], li = lim[nn], x = lr * dt;
    const float em = x * (1.0f + x * (0.5f + x * (0.16666667f + x * (0.041666668f + x * 0.0083333338f))));
    float sh, ch; my_sincosf(0.5f * li * dt, sh, ch);
    const float cm1 = -2.0f * sh * sh, sn = 2.0f * sh * ch;
    const float arm1 = em * (1.0f + cm1) + cm1;
    ai = (1.0f + em) * sn; ar = 1.0f + arm1;
    const float den = lr * lr + li * li;
    fr = (arm1 * lr + ai * li) / den; fi = (ai * lr - arm1 * li) / den;
}
DI void s5_scan_task(KArgs a, int l, int b, int dir, int g, LAS bf16* wl  , int lane) {
    const bf16* Z = (const bf16*)(a->ws + WS_ACT); bf16* YS = (bf16*)(a->ws + WS_YS5) + (size_t)dir * NROWS * 256;
    const int pg = (l * 2 + dir) * 16 + g;
    const float* lre = a->in[I_S5LRE] + pg * 64; const float* lim = a->in[I_S5LIM] + pg * 64;
    const float dt = __expf(a->in[I_S5DT][pg]);
    float ar, ai, tfr, tfi; s5_coef(lre, lim, dt, lane, ar, ai, tfr, tfi);
    bf16x8 Bf[4];
    { const int hh = lane >> 5;
#pragma unroll
      for (int nblk = 0; nblk < 2; ++nblk) { const int nn = 32 * nblk + (lane & 31); float xr, xi, fr, fi; s5_coef(lre, lim, dt, nn, xr, xi, fr, fi);
        const float* bre = a->in[I_S5BRE] + ((size_t)pg * 64 + nn) * 16 + 8 * hh; const float* bim = a->in[I_S5BIM] + ((size_t)pg * 64 + nn) * 16 + 8 * hh;
        float re[8], im[8];
#pragma unroll
        for (int j = 0; j < 8; ++j) { re[j] = fr * bre[j] - fi * bim[j]; im[j] = fi * bre[j] + fr * bim[j]; }
        Bf[nblk] = pack8(re[0], re[1], re[2], re[3], re[4], re[5], re[6], re[7]); Bf[2 + nblk] = pack8(im[0], im[1], im[2], im[3], im[4], im[5], im[6], im[7]); } }
    bf16x8 Cf[4];
    { const int p = lane & 15, q = lane >> 4;
#pragma unroll
      for (int s = 0; s < 4; ++s) { const int kc = 32 * s + 8 * q; float cv[8];
        const float* src = (s < 2) ? a->in[I_S5CRE] + ((size_t)pg * 16 + p) * 64 + kc : a->in[I_S5CIM] + ((size_t)pg * 16 + p) * 64 + (kc - 64);
        const float sg = (s < 2) ? 1.f : -1.f;
#pragma unroll
        for (int j = 0; j < 8; ++j) cv[j] = sg * src[j];
        Cf[s] = pack8(cv[0], cv[1], cv[2], cv[3], cv[4], cv[5], cv[6], cv[7]); } }
    float sr = 0.f, si = 0.f;
    const int hh = lane >> 5, li5 = lane & 31, q = lane >> 4, t16 = lane & 15;
    const f32x16 zero16 = {0.f, 0.f, 0.f, 0.f, 0.f, 0.f, 0.f, 0.f, 0.f, 0.f, 0.f, 0.f, 0.f, 0.f, 0.f, 0.f};
    for (int seg = 0; seg < 2; ++seg) {
        const int len = seg ? T : TC, nch = len / 32;
        for (int ch = 0; ch < nch; ++ch) {
            const int sidx = 32 * ch + li5, tt = dir ? (len - 1 - sidx) : sidx;
            const bf16x8 af = *(const bf16x8*)(Z + (size_t)tok_row(b, seg, tt) * ZP + ZS5 + g * 16 + 8 * hh);
            f32x16 d1 = mfma32(af, Bf[0], zero16), d2 = mfma32(af, Bf[1], zero16), d3 = mfma32(af, Bf[2], zero16), d4 = mfma32(af, Bf[3], zero16);
            float xa[16], xb[16], ya[16], yb[16];
#pragma unroll
            for (int r = 0; r < 16; ++r) {
                auto r1 = __builtin_amdgcn_permlane32_swap(__float_as_uint(d1[r]), __float_as_uint(d2[r]), false, false); xa[r] = __uint_as_float(r1[0]); xb[r] = __uint_as_float(r1[1]);
                auto r2 = __builtin_amdgcn_permlane32_swap(__float_as_uint(d3[r]), __float_as_uint(d4[r]), false, false); ya[r] = __uint_as_float(r2[0]); yb[r] = __uint_as_float(r2[1]); }
#pragma unroll
            for (int i = 0; i < 32; ++i) {
                const int r = 4 * (i >> 3) + (i & 3); const bool hi = (i >> 2) & 1;
                const float xre = hi ? xb[r] : xa[r], xim = hi ? yb[r] : ya[r];
                const float nsr = ar * sr - ai * si + xre, nsi = ar * si + ai * sr + xim; sr = nsr; si = nsi;
                wl[i * 136 + lane] = (bf16)f2bf(sr); wl[i * 136 + 64 + lane] = (bf16)f2bf(si);
            }
#pragma unroll
            for (int tb = 0; tb < 2; ++tb) {
                f32x4 acc = {0.f, 0.f, 0.f, 0.f};
#pragma unroll
                for (int s = 0; s < 4; ++s) { const bf16x8 bfr = *(const LAS bf16x8*)(wl + (16 * tb + t16) * 136 + 32 * s + 8 * q); acc = mfma16(Cf[s], bfr, acc); }
                const int so = 32 * ch + 16 * tb + t16, to = dir ? (len - 1 - so) : so;
                v2u o; o.x = pk2(acc[0], acc[1]); o.y = pk2(acc[2], acc[3]);
                *(v2u*)(YS + (size_t)tok_row(b, seg, to) * 256 + g * 16 + 4 * q) = o;
            }
        }
    }
}

DI void mla_prep_tile(KArgs a, const Ctx& F, int l, int tile) {
    const bf16* Z = (const bf16*)(a->ws + WS_ACT);
    bf16* Q = (bf16*)(a->ws + WS_Q); bf16* Kf = (bf16*)(a->ws + WS_K); bf16* Vt = (bf16*)(a->ws + WS_VT);
    const bf16* WUQ = (const bf16*)(a->ws + WS_SMALLW + SW_UQ); const bf16* WUKV = (const bf16*)(a->ws + WS_SMALLW + SW_UKV);
    const float* rc = (const float*)(a->ws + WS_ROPE); const float* rs = rc + T * 16;
    LAS bf16* Aq = (LAS bf16*)F.lds;
    LAS bf16* Akv = (LAS bf16*)(F.lds + 64 * 264 * 2);
    const int row0 = tile * 64, tid = F.tid, lane = F.lane, wave = F.wave;
    const bool lat = row0 < NLAT;
    {
        const int i = tid >> 3, part = tid & 7, row = row0 + i;
        const bf16* zr = Z + (size_t)row * ZP;
        float q[32], kv[16]; float sq = 0.f, sk = 0.f;
#pragma unroll
        for (int j = 0; j < 4; ++j) { const v4u w = *(const v4u*)(zr + ZCQ + part * 32 + 8 * j);
            q[8 * j + 0] = bflo(w.x); q[8 * j + 1] = bfhi(w.x); q[8 * j + 2] = bflo(w.y); q[8 * j + 3] = bfhi(w.y); q[8 * j + 4] = bflo(w.z); q[8 * j + 5] = bfhi(w.z); q[8 * j + 6] = bflo(w.w); q[8 * j + 7] = bfhi(w.w); }
#pragma unroll
        for (int j = 0; j < 2; ++j) { const v4u w = *(const v4u*)(zr + ZCKV + part * 16 + 8 * j);
            kv[8 * j + 0] = bflo(w.x); kv[8 * j + 1] = bfhi(w.x); kv[8 * j + 2] = bflo(w.y); kv[8 * j + 3] = bfhi(w.y); kv[8 * j + 4] = bflo(w.z); kv[8 * j + 5] = bfhi(w.z); kv[8 * j + 6] = bflo(w.w); kv[8 * j + 7] = bfhi(w.w); }
#pragma unroll
        for (int j = 0; j < 32; ++j) sq += q[j] * q[j];
#pragma unroll
        for (int j = 0; j < 16; ++j) sk += kv[j] * kv[j];
        sq += __shfl_xor(sq, 1); sq += __shfl_xor(sq, 2); sq += __shfl_xor(sq, 4);
        sk += __shfl_xor(sk, 1); sk += __shfl_xor(sk, 2); sk += __shfl_xor(sk, 4);
        const float rq = 1.0f / sqrtf(sq * (1.0f / 256.0f) + NORM_EPS), rk = 1.0f / sqrtf(sk * (1.0f / 128.0f) + NORM_EPS);
        const float* qn = a->in[I_MQN] + l * 256 + part * 32; const float* kn = a->in[I_MKVN] + l * 128 + part * 16;
#pragma unroll
        for (int j = 0; j < 32; j += 2) *(LAS unsigned*)(Aq + i * 264 + part * 32 + j) = pk2(q[j] * rq * qn[j], q[j + 1] * rq * qn[j + 1]);
#pragma unroll
        for (int j = 0; j < 16; j += 2) *(LAS unsigned*)(Akv + i * 136 + part * 16 + j) = pk2(kv[j] * rk * kn[j], kv[j + 1] * rk * kn[j + 1]);
        if (part == 0) {
            float kr[32];
#pragma unroll
            for (int j = 0; j < 4; ++j) { const v4u w = *(const v4u*)(zr + ZKR + 8 * j);
                kr[8 * j + 0] = bflo(w.x); kr[8 * j + 1] = bfhi(w.x); kr[8 * j + 2] = bflo(w.y); kr[8 * j + 3] = bfhi(w.y); kr[8 * j + 4] = bflo(w.z); kr[8 * j + 5] = bfhi(w.z); kr[8 * j + 6] = bflo(w.w); kr[8 * j + 7] = bfhi(w.w); }
            float o[32];
            if (lat) { const int t = row & (T - 1);
#pragma unroll
                for (int hf = 0; hf < 2; ++hf)
#pragma unroll
                    for (int j = 0; j < 8; ++j) { const float c = rc[t * 16 + hf * 8 + j], s = rs[t * 16 + hf * 8 + j]; const float x0 = kr[hf * 16 + j], x1 = kr[hf * 16 + 8 + j];
                        o[hf * 16 + j] = x0 * c - x1 * s; o[hf * 16 + 8 + j] = x1 * c + x0 * s; }
            } else {
#pragma unroll
                for (int j = 0; j < 32; ++j) o[j] = kr[j];
            }
#pragma unroll
            for (int hd = 0; hd < 4; ++hd) { bf16* kp = Kf + (size_t)row * 384 + hd * 96 + 64;
#pragma unroll
                for (int j = 0; j < 4; ++j) { v4u w; w.x = pk2(o[8 * j], o[8 * j + 1]); w.y = pk2(o[8 * j + 2], o[8 * j + 3]); w.z = pk2(o[8 * j + 4], o[8 * j + 5]); w.w = pk2(o[8 * j + 6], o[8 * j + 7]); *(v4u*)(kp + 8 * j) = w; } }
        }
    }
    __syncthreads();
    const int lr = lane & 15, kq = lane >> 4;
    {
        f32x4 acc[3][4];
        small_gemm<256, 3, 4, true>(Aq, 264, WUQ, 48 * wave, acc, lane);
        const float qs = 0.10206207261596577f * 1.44269504089f;
#pragma unroll
        for (int nb = 0; nb < 3; ++nb) { const int blk = 3 * wave + nb, hb = blk % 6;
#pragma unroll
            for (int mb = 0; mb < 4; ++mb) { const int row = row0 + 16 * mb + lr; f32x4 v = acc[nb][mb];
                if (hb >= 4) {
                    f32x4 pv; pv.x = __shfl_xor(v.x, 32); pv.y = __shfl_xor(v.y, 32); pv.z = __shfl_xor(v.z, 32); pv.w = __shfl_xor(v.w, 32);
                    if (lat) { const int t = row & (T - 1); const int fb = (hb - 4) * 8 + 4 * (kq & 1);
                        const f32x4 c = *(const f32x4*)(rc + t * 16 + fb), s = *(const f32x4*)(rs + t * 16 + fb);
                        v = (kq < 2) ? (v * c - pv * s) : (v * c + pv * s); }
                }
                v = v * qs;
                v2u o; o.x = pk2(v.x, v.y); o.y = pk2(v.z, v.w);
                *(v2u*)(Q + (size_t)row * 384 + 16 * blk + 4 * kq) = o; } }
    }
    {
        const int hd = wave >> 1;
        if ((wave & 1) == 0) {
            f32x4 acc[4][4];
            small_gemm<128, 4, 4, true>(Akv, 136, WUKV, 64 * wave, acc, lane);
#pragma unroll
            for (int nb = 0; nb < 4; ++nb)
#pragma unroll
                for (int mb = 0; mb < 4; ++mb) { const int row = row0 + 16 * mb + lr; const f32x4 v = acc[nb][mb];
                    v2u o; o.x = pk2(v.x, v.y); o.y = pk2(v.z, v.w);
                    *(v2u*)(Kf + (size_t)row * 384 + hd * 96 + 16 * nb + 4 * kq) = o; }
        } else {
            f32x4 acc[4][4];
            small_gemm<128, 4, 4, false>(Akv, 136, WUKV, 64 * wave, acc, lane);
            const int bb = lat ? (row0 >> 12) : ((row0 - NLAT) >> 8);
            const int key0 = lat ? (TC + (row0 & (T - 1))) : ((row0 - NLAT) & (TC - 1));
#pragma unroll
            for (int nb = 0; nb < 4; ++nb)
#pragma unroll
                for (int mb = 0; mb < 4; ++mb) { const f32x4 v = acc[nb][mb];
                    v2u o; o.x = pk2(v.x, v.y); o.y = pk2(v.z, v.w);
                    *(v2u*)(Vt + ((size_t)(bb * 4 + hd) * 64 + 16 * nb + lr) * NKEY + key0 + 16 * mb + 4 * kq) = o; }
        }
    }
    __syncthreads();
}

DI void attn_unit(KArgs a, const Ctx& F, int b, int hd, int qrow0, int nkeys) {
    const bf16* Q = (const bf16*)(a->ws + WS_Q); const bf16* Kf = (const bf16*)(a->ws + WS_K); const bf16* Vt = (const bf16*)(a->ws + WS_VT);
    bf16* MO = (bf16*)(a->ws + WS_H);
    constexpr int KP = 208, VP = 144, BUF = 64 * KP + 64 * VP;
    const int tid = F.tid, lane = F.lane, wave = F.wave, l31 = lane & 31, h2 = lane >> 5;
    const int qrow = qrow0 + 32 * wave + l31;
    bf16x8 Qf[6];
#pragma unroll
    for (int s = 0; s < 6; ++s) Qf[s] = *(const bf16x8*)(Q + (size_t)qrow * 384 + hd * 96 + 16 * s + 8 * h2);
    const int kc0 = tid, kc1 = tid + 512;
    const int kr0 = kc0 / 12, kcc0 = kc0 % 12, kr1 = kc1 / 12, kcc1 = kc1 % 12; const bool k1v = kc1 < 768;
    const int vd = tid >> 3, vcc = tid & 7;
    const bf16* vbase = Vt + ((size_t)(b * 4 + hd) * 64 + vd) * NKEY + vcc * 8;
    v4u gk0, gk1, gv;
    auto gload = [&](int kt) {
        const int key0 = 64 * kt; const int krow = key0 < TC ? (NLAT + b * TC + key0) : (b * T + key0 - TC);
        gk0 = *(const v4u*)(Kf + (size_t)(krow + kr0) * 384 + hd * 96 + kcc0 * 8);
        if (k1v) gk1 = *(const v4u*)(Kf + (size_t)(krow + kr1) * 384 + hd * 96 + kcc1 * 8);
        gv = *(const v4u*)(vbase + key0);
    };
    auto lstore = [&](int buf) {
        LAS uchar* base = F.lds + buf * BUF;
        *(LAS v4u*)(base + kr0 * KP + kcc0 * 16) = gk0;
        if (k1v) *(LAS v4u*)(base + kr1 * KP + kcc1 * 16) = gk1;
        *(LAS v4u*)(base + 64 * KP + vd * VP + vcc * 16) = gv;
    };
    const int nt = nkeys / 64;
    gload(0); lstore(0);
    __syncthreads();
    f32x16 O0, O1;
#pragma unroll
    for (int r = 0; r < 16; ++r) { O0[r] = 0.f; O1[r] = 0.f; }
    float m = -1e30f, lsum = 0.f;
    for (int kt = 0; kt < nt; ++kt) {
        const bool more = kt + 1 < nt;
        if (more) gload(kt + 1);
        const LAS uchar* kb_ = F.lds + (kt & 1) * BUF; const LAS uchar* vb_ = kb_ + 64 * KP;
        f32x16 s0, s1;
#pragma unroll
        for (int r = 0; r < 16; ++r) { s0[r] = 0.f; s1[r] = 0.f; }
#pragma unroll
        for (int s = 0; s < 6; ++s) {
            const bf16x8 ka = *(const LAS bf16x8*)(kb_ + l31 * KP + (16 * s + 8 * h2) * 2);
            const bf16x8 kb2 = *(const LAS bf16x8*)(kb_ + (32 + l31) * KP + (16 * s + 8 * h2) * 2);
            s0 = mfma32(ka, Qf[s], s0); s1 = mfma32(kb2, Qf[s], s1);
        }
        float mx = s0[0];
#pragma unroll
        for (int r = 1; r < 16; ++r) mx = fmaxf(mx, s0[r]);
#pragma unroll
        for (int r = 0; r < 16; ++r) mx = fmaxf(mx, s1[r]);
        mx = fmaxf(mx, __shfl_xor(mx, 32));
        const float mn = fmaxf(m, mx), alpha = __builtin_amdgcn_exp2f(m - mn); m = mn;
        float ps = 0.f;
#pragma unroll
        for (int r = 0; r < 16; ++r) { s0[r] = __builtin_amdgcn_exp2f(s0[r] - mn); s1[r] = __builtin_amdgcn_exp2f(s1[r] - mn); ps += s0[r] + s1[r]; }
        lsum = lsum * alpha + ps;
#pragma unroll
        for (int r = 0; r < 16; ++r) { O0[r] *= alpha; O1[r] *= alpha; }
#pragma unroll
        for (int kb = 0; kb < 2; ++kb)
#pragma unroll
            for (int sp = 0; sp < 2; ++sp) {
                const f32x16& sx = kb ? s1 : s0;
                const bf16x8 pf = pack8(sx[8 * sp + 0], sx[8 * sp + 1], sx[8 * sp + 2], sx[8 * sp + 3], sx[8 * sp + 4], sx[8 * sp + 5], sx[8 * sp + 6], sx[8 * sp + 7]);
                const int ko = (32 * kb + 16 * sp + 4 * h2) * 2;
                const bf16x4 a0 = *(const LAS bf16x4*)(vb_ + l31 * VP + ko), a1 = *(const LAS bf16x4*)(vb_ + l31 * VP + ko + 16);
                const bf16x4 c0 = *(const LAS bf16x4*)(vb_ + (32 + l31) * VP + ko), c1 = *(const LAS bf16x4*)(vb_ + (32 + l31) * VP + ko + 16);
                const bf16x8 va = __builtin_shufflevector(a0, a1, 0, 1, 2, 3, 4, 5, 6, 7), vc = __builtin_shufflevector(c0, c1, 0, 1, 2, 3, 4, 5, 6, 7);
                O0 = mfma32(va, pf, O0); O1 = mfma32(vc, pf, O1);
            }
        if (more) lstore((kt + 1) & 1);
        __syncthreads();
    }
    const float ltot = lsum + __shfl_xor(lsum, 32), inv = 1.0f / ltot;
    bf16* op = MO + (size_t)qrow * D + 256 + hd * 64;
#pragma unroll
    for (int gq = 0; gq < 4; ++gq) {
        v2u o; o.x = pk2(O0[4 * gq] * inv, O0[4 * gq + 1] * inv); o.y = pk2(O0[4 * gq + 2] * inv, O0[4 * gq + 3] * inv);
        *(v2u*)(op + 8 * gq + 4 * h2) = o;
        v2u o2; o2.x = pk2(O1[4 * gq] * inv, O1[4 * gq + 1] * inv); o2.y = pk2(O1[4 * gq + 2] * inv, O1[4 * gq + 3] * inv);
        *(v2u*)(op + 32 + 8 * gq + 4 * h2) = o2;
    }
}
DI float conv3(const bf16* Z, int b, int seg, int t, int len, int col, float w0, float w1, float w2, float cb) {
    const bf16* zp = Z + (size_t)tok_row(b, seg, t) * ZP + col;
    float y = cb + w1 * bf2f(zp[0]);
    if (t > 0) y += w0 * bf2f(zp[-ZP]);
    if (t + 1 < len) y += w2 * bf2f(zp[ZP]);
    return y;
}
DI void rwkv_scan_task(KArgs a, const Ctx& F, int l, int b, int hd, int dir) {
    const bf16* Z = (const bf16*)(a->ws + WS_ACT); bf16* YR = (bf16*)(a->ws + WS_YR) + (size_t)dir * NROWS * 256;
    LAS float* Sdec = (LAS float*)F.lds;
    LAS float* Skk = Sdec + 2048; LAS float* Sbb = Skk + 2048; LAS float* Ske = Sbb + 2048; LAS float* Sr = Ske + 2048; LAS float* Sv = Sr + 2048;
    LAS float* Sy = Sv + 2048;
    LAS float* Slw = Sy + 2048;
    const int tid = F.tid, lane = F.lane, wave = F.wave;
    const int c = lane, hc = hd * 64 + c;
    float wup[32], aup[32];
    { const float* wu = a->in[I_RWUP] + ((size_t)(l * 2 + dir) * 32) * 256 + hc; const float* au = a->in[I_RAUP] + ((size_t)(l * 2 + dir) * 32) * 256 + hc;
#pragma unroll
      for (int j = 0; j < 32; ++j) { wup[j] = wu[j * 256]; aup[j] = au[j * 256]; } }
    const float w0c = a->in[I_RW0][(l * 2 + dir) * 256 + hc], a0c = a->in[I_RA0][(l * 2 + dir) * 256 + hc];
    const float kkc = a->in[I_RKK][l * 256 + hc], kac = a->in[I_RKA][l * 256 + hc];
    const float* cw = a->in[I_RCW] + (size_t)l * 3 * 768; const float* cbp = a->in[I_RCB] + (size_t)l * 768;
    float cwr[3], cwk[3], cwv[3];
#pragma unroll
    for (int j = 0; j < 3; ++j) { cwr[j] = cw[j * 768 + hc]; cwk[j] = cw[j * 768 + 256 + hc]; cwv[j] = cw[j * 768 + 512 + hc]; }
    const float cbr = cbp[hc], cbk = cbp[256 + hc], cbv = cbp[512 + hc];
    float st[8];
#pragma unroll
    for (int j = 0; j < 8; ++j) st[j] = 0.f;
    const int sv = tid >> 3, kq = tid & 7;
    for (int seg = 0; seg < 2; ++seg) {
        const int len = seg ? T : TC, nch = len / 32;
        for (int ch = 0; ch < nch; ++ch) {
            {
                const int i = tid >> 4, q4 = (tid & 15) * 4, sidx = 32 * ch + i, t = dir ? (len - 1 - sidx) : sidx;
                const v2u w = *(const v2u*)(Z + (size_t)tok_row(b, seg, t) * ZP + ZWD + q4);
                float x0 = bflo(w.x), x1 = bfhi(w.x), x2 = bflo(w.y), x3 = bfhi(w.y);
                if (q4 < 32) { x0 = tanhf(x0); x1 = tanhf(x1); x2 = tanhf(x2); x3 = tanhf(x3); }
                *(LAS f32x4*)(Slw + i * 64 + q4) = (f32x4){x0, x1, x2, x3};
            }
            __syncthreads();
#pragma unroll 1
            for (int tt = 0; tt < 4; ++tt) {
                const int i = wave + 8 * tt, sidx = 32 * ch + i, t = dir ? (len - 1 - sidx) : sidx;
                const float rv = conv3(Z, b, seg, t, len, ZRKV + hc, cwr[0], cwr[1], cwr[2], cbr);
                const float kv = conv3(Z, b, seg, t, len, ZRKV + 256 + hc, cwk[0], cwk[1], cwk[2], cbk);
                const float vv = conv3(Z, b, seg, t, len, ZRKV + 512 + hc, cwv[0], cwv[1], cwv[2], cbv);
                const float kx = kv * kkc; const float nrm = sqrtf(wave_sum(kx * kx)); const float kn = kx / fmaxf(nrm, 1e-12f);
                float wl_ = w0c, al_ = a0c;
#pragma unroll
                for (int j = 0; j < 32; ++j) { wl_ += Slw[i * 64 + j] * wup[j]; al_ += Slw[i * 64 + 32 + j] * aup[j]; }
                const float xneg = -wl_; const float sp = fmaxf(xneg, 0.f) + log1pf(__expf(-fabsf(xneg)));
                const float dec = __expf(-__expf(-sp - 0.5f));
                const float av = 1.0f / (1.0f + __expf(-al_));
                Sdec[i * 64 + c] = dec; Skk[i * 64 + c] = kn; Sbb[i * 64 + c] = kn * av; Ske[i * 64 + c] = kv * (1.0f + (av - 1.0f) * kac); Sr[i * 64 + c] = rv; Sv[i * 64 + c] = vv;
            }
            __syncthreads();
#pragma unroll 2
            for (int i = 0; i < 32; ++i) {
                const f32x4 k0 = *(const LAS f32x4*)(Skk + i * 64 + 8 * kq), k1 = *(const LAS f32x4*)(Skk + i * 64 + 8 * kq + 4);
                const f32x4 d0 = *(const LAS f32x4*)(Sdec + i * 64 + 8 * kq), d1 = *(const LAS f32x4*)(Sdec + i * 64 + 8 * kq + 4);
                const f32x4 b0 = *(const LAS f32x4*)(Sbb + i * 64 + 8 * kq), b1 = *(const LAS f32x4*)(Sbb + i * 64 + 8 * kq + 4);
                const f32x4 e0 = *(const LAS f32x4*)(Ske + i * 64 + 8 * kq), e1 = *(const LAS f32x4*)(Ske + i * 64 + 8 * kq + 4);
                const f32x4 r0 = *(const LAS f32x4*)(Sr + i * 64 + 8 * kq), r1 = *(const LAS f32x4*)(Sr + i * 64 + 8 * kq + 4);
                const float vv = Sv[i * 64 + sv];
                float sa = (st[0] * k0.x + st[1] * k0.y) + (st[2] * k0.z + st[3] * k0.w) + (st[4] * k1.x + st[5] * k1.y) + (st[6] * k1.z + st[7] * k1.w);
                sa += __shfl_xor(sa, 1); sa += __shfl_xor(sa, 2); sa += __shfl_xor(sa, 4);
                st[0] = st[0] * d0.x - sa * b0.x + vv * e0.x; st[1] = st[1] * d0.y - sa * b0.y + vv * e0.y; st[2] = st[2] * d0.z - sa * b0.z + vv * e0.z; st[3] = st[3] * d0.w - sa * b0.w + vv * e0.w;
                st[4] = st[4] * d1.x - sa * b1.x + vv * e1.x; st[5] = st[5] * d1.y - sa * b1.y + vv * e1.y; st[6] = st[6] * d1.z - sa * b1.z + vv * e1.z; st[7] = st[7] * d1.w - sa * b1.w + vv * e1.w;
                float y = (st[0] * r0.x + st[1] * r0.y) + (st[2] * r0.z + st[3] * r0.w) + (st[4] * r1.x + st[5] * r1.y) + (st[6] * r1.z + st[7] * r1.w);
                y += __shfl_xor(y, 1); y += __shfl_xor(y, 2); y += __shfl_xor(y, 4);
                if (kq == 0) Sy[i * 64 + sv] = y;
            }
            __syncthreads();
            {
                const int i = tid >> 4, q4 = (tid & 15) * 4, sidx = 32 * ch + i, t = dir ? (len - 1 - sidx) : sidx;
                const f32x4 y = *(const LAS f32x4*)(Sy + i * 64 + q4);
                v2u o; o.x = pk2(y.x, y.y); o.y = pk2(y.z, y.w);
                *(v2u*)(YR + (size_t)tok_row(b, seg, t) * 256 + hd * 64 + q4) = o;
            }
        }
    }
    __syncthreads();
}

DI void mlstm_task(KArgs a, const Ctx& F, int l, int b, int hd) {
    const bf16* Z = (const bf16*)(a->ws + WS_ACT);
    const int tid = F.tid, lane = F.lane, wave = F.wave, dir = wave >> 2, w2 = wave & 3, tid2 = tid & 255, l31 = lane & 31, hh = lane >> 5;
    bf16* YM = (bf16*)(a->ws + WS_YM) + (size_t)dir * NROWS * 256;
    constexpr int HP = 72;
    LAS uchar* base = F.lds + dir * 53248;
    LAS bf16* Qc = (LAS bf16*)base; LAS bf16* Kc = Qc + 64 * HP; LAS bf16* KTw = Kc + 64 * HP; LAS bf16* VT = KTw + 64 * HP; LAS bf16* Cb = VT + 64 * HP;
    LAS float* fv = (LAS float*)(base + 5 * 9216);
    LAS float* Vgv = fv; LAS float* VMr = fv + 64; LAS float* Vwi = fv + 128; LAS float* Vem = fv + 192; LAS float* Vwk = fv + 256; LAS float* Vn = fv + 320; LAS float* Vsc = fv + 384;
    for (int i = tid2; i < 64 * HP; i += 256) Cb[i] = 0;
    if (tid2 < 64) Vn[tid2] = 0.f;
    if (tid2 == 0) { float one_ = 1.f, zero_ = 0.f; asm volatile("" : "+v"(one_), "+v"(zero_)); Vsc[0] = one_; Vsc[1] = zero_; }
    f32x16 accC;
#pragma unroll
    for (int r = 0; r < 16; ++r) accC[r] = 0.f;
    const int eb = w2 >> 1, lb = w2 & 1;
    const float* cw = a->in[I_MCW] + (size_t)l * 3 * 512; const float* cbp = a->in[I_MCB] + (size_t)l * 512;
    const float gbi = a->in[I_MGB][l * 16 + dir * 8 + hd], gbf = a->in[I_MGB][l * 16 + dir * 8 + 4 + hd];
    __syncthreads();
    for (int seg = 0; seg < 2; ++seg) {
        const int len = seg ? T : TC, nch = len / 64;
        for (int ch = 0; ch < nch; ++ch) {
            if (w2 == 0) {
                const int sidx = 64 * ch + lane, t = dir ? (len - 1 - sidx) : sidx;
                const bf16* zp = Z + (size_t)tok_row(b, seg, t) * ZP + ZMG + dir * 8 + hd;
                const float li = bf2f(zp[0]) + gbi, fraw = bf2f(zp[4]) + gbf;
                const float lf = fminf(fraw, 0.f) - log1pf(__expf(-fabsf(fraw)));
                float bc = lf;
#pragma unroll
                for (int o = 1; o < 64; o <<= 1) { const float n = __shfl_up(bc, o); if (lane >= o) bc += n; }
                const float g = li - bc; float pm = g;
#pragma unroll
                for (int o = 1; o < 64; o <<= 1) { const float n = __shfl_up(pm, o); if (lane >= o) pm = fmaxf(pm, n); }
                const float mprev = Vsc[1];
                const float blast = __shfl(bc, 63);
                const float lw = blast - bc + li;
                const float mnew = fmaxf(blast + mprev, wave_max(lw));
                const float Mr = fmaxf(mprev, pm);
                Vgv[lane] = g; VMr[lane] = Mr; Vwi[lane] = __expf(mprev - Mr); Vem[lane] = __expf(-bc - Mr); Vwk[lane] = __expf(lw - mnew);
                if (lane == 0) { Vsc[0] = __expf(blast + mprev - mnew); Vsc[2] = mnew; }
            }
            __syncthreads();
            {
                const int i = tid2 >> 2, qq = tid2 & 3, sidx = 64 * ch + i, t = dir ? (len - 1 - sidx) : sidx;
                const bf16* zr = Z + (size_t)tok_row(b, seg, t) * ZP;
                const float wk_i = Vwk[i];
                const int cq = hd * 64 + qq * 16;
                float qv[16], kvv[16];
#pragma unroll
                for (int j = 0; j < 16; ++j) {
                    float yq = cbp[cq + j] + cw[512 + cq + j] * bf2f(zr[ZMQK + cq + j]);
                    float yk = cbp[256 + cq + j] + cw[512 + 256 + cq + j] * bf2f(zr[ZMQK + 256 + cq + j]);
                    if (t > 0) { yq += cw[cq + j] * bf2f(zr[ZMQK + cq + j - ZP]); yk += cw[256 + cq + j] * bf2f(zr[ZMQK + 256 + cq + j - ZP]); }
                    if (t + 1 < len) { yq += cw[1024 + cq + j] * bf2f(zr[ZMQK + cq + j + ZP]); yk += cw[1024 + 256 + cq + j] * bf2f(zr[ZMQK + 256 + cq + j + ZP]); }
                    qv[j] = yq * fsigmoid(yq); kvv[j] = yk * fsigmoid(yk) * 0.125f;
                }
#pragma unroll
                for (int j = 0; j < 16; j += 2) { *(LAS unsigned*)(Qc + i * HP + qq * 16 + j) = pk2(qv[j], qv[j + 1]); *(LAS unsigned*)(Kc + i * HP + qq * 16 + j) = pk2(kvv[j], kvv[j + 1]); }
#pragma unroll
                for (int j = 0; j < 16; ++j) { KTw[(qq * 16 + j) * HP + i] = (bf16)f2bf(kvv[j] * wk_i); VT[(qq * 16 + j) * HP + i] = zr[ZMV + cq + j]; }
            }
            __syncthreads();
            {
                const int lidx = 32 * lb + l31;
                f32x16 accN, accI;
#pragma unroll
                for (int r = 0; r < 16; ++r) { accN[r] = 0.f; accI[r] = 0.f; }
                float dsum = 0.f;
                const float Mr = VMr[lidx];
#pragma unroll
                for (int sb = 0; sb < 2; ++sb) {
                    if (sb <= lb) {
                        f32x16 sT;
#pragma unroll
                        for (int r = 0; r < 16; ++r) sT[r] = 0.f;
#pragma unroll
                        for (int s = 0; s < 4; ++s) {
                            const bf16x8 ka = *(const LAS bf16x8*)(Kc + (32 * sb + l31) * HP + 16 * s + 8 * hh);
                            const bf16x8 qb = *(const LAS bf16x8*)(Qc + lidx * HP + 16 * s + 8 * hh);
                            sT = mfma32(ka, qb, sT);
                        }
#pragma unroll
                        for (int r = 0; r < 16; ++r) { const int sidx = 32 * sb + crow(r, hh);
                            const float p = (sidx <= lidx) ? sT[r] * __expf(Vgv[sidx] - Mr) : 0.f; sT[r] = p; dsum += p; }
#pragma unroll
                        for (int sp = 0; sp < 2; ++sp) {
                            const bf16x8 pf = pack8(sT[8 * sp + 0], sT[8 * sp + 1], sT[8 * sp + 2], sT[8 * sp + 3], sT[8 * sp + 4], sT[8 * sp + 5], sT[8 * sp + 6], sT[8 * sp + 7]);
                            const int ko = 32 * sb + 16 * sp + 4 * hh;
                            const bf16x4 a0 = *(const LAS bf16x4*)(VT + (32 * eb + l31) * HP + ko), a1 = *(const LAS bf16x4*)(VT + (32 * eb + l31) * HP + ko + 8);
                            accN = mfma32(__builtin_shufflevector(a0, a1, 0, 1, 2, 3, 4, 5, 6, 7), pf, accN);
                        }
                    }
                }
#pragma unroll
                for (int s = 0; s < 4; ++s) {
                    const bf16x8 ca = *(const LAS bf16x8*)(Cb + (32 * eb + l31) * HP + 16 * s + 8 * hh);
                    const bf16x8 qb = *(const LAS bf16x8*)(Qc + lidx * HP + 16 * s + 8 * hh);
                    accI = mfma32(ca, qb, accI);
                }
                dsum += __shfl_xor(dsum, 32);
                float nq = 0.f;
#pragma unroll
                for (int j = 0; j < 64; j += 2) { const unsigned w = *(const LAS unsigned*)(Qc + lidx * HP + j); nq += Vn[j] * bflo(w) + Vn[j + 1] * bfhi(w); }
                const float wi = Vwi[lidx];
                const float den = dsum + wi * nq, hden = fmaxf(fabsf(den), Vem[lidx]), inv = 1.0f / hden;
                const int sidx = 64 * ch + lidx, t = dir ? (len - 1 - sidx) : sidx;
                bf16* op = YM + (size_t)tok_row(b, seg, t) * 256 + hd * 64 + 32 * eb;
#pragma unroll
                for (int gq = 0; gq < 4; ++gq) {
                    const float h0 = (accN[4 * gq] + wi * accI[4 * gq]) * inv, h1 = (accN[4 * gq + 1] + wi * accI[4 * gq + 1]) * inv, h2 = (accN[4 * gq + 2] + wi * accI[4 * gq + 2]) * inv, h3 = (accN[4 * gq + 3] + wi * accI[4 * gq + 3]) * inv;
                    v2u o; o.x = pk2(h0, h1); o.y = pk2(h2, h3);
                    *(v2u*)(op + 8 * gq + 4 * hh) = o;
                }
            }
            __syncthreads();
            {
                const float sc = Vsc[0];
#pragma unroll
                for (int r = 0; r < 16; ++r) accC[r] *= sc;
#pragma unroll
                for (int s = 0; s < 4; ++s) {
                    const bf16x8 va = *(const LAS bf16x8*)(VT + (32 * eb + l31) * HP + 16 * s + 8 * hh);
                    const bf16x8 kb = *(const LAS bf16x8*)(KTw + (32 * lb + l31) * HP + 16 * s + 8 * hh);
                    accC = mfma32(va, kb, accC);
                }
#pragma unroll
                for (int r = 0; r < 16; ++r) Cb[(32 * eb + crow(r, hh)) * HP + 32 * lb + l31] = (bf16)f2bf(accC[r]);
                if (tid2 < 64) { float s = 0.f;
#pragma unroll
                    for (int j = 0; j < 64; j += 2) { const unsigned w = *(const LAS unsigned*)(KTw + tid2 * HP + j); s += bflo(w) + bfhi(w); }
                    Vn[tid2] = sc * Vn[tid2] + s; }
                if (tid2 == 0) Vsc[1] = Vsc[2];
            }
            __syncthreads();
        }
    }
}
DI float gelu_tanh(float x) { const float u = 0.7978845608028654f * (x + 0.044715f * x * x * x); const float e = __expf(2.0f * u); const float th = 1.0f - 2.0f / (e + 1.0f); return 0.5f * x * (1.0f + th); }
DI void fin_tile(KArgs a, const Ctx& F, int l, int tile) {
    const bf16* Z = (const bf16*)(a->ws + WS_ACT); bf16* MO = (bf16*)(a->ws + WS_H);
    const bf16* YS = (const bf16*)(a->ws + WS_YS5); const bf16* YR = (const bf16*)(a->ws + WS_YR); const bf16* YM = (const bf16*)(a->ws + WS_YM);
    const bf16* WGLU = (const bf16*)(a->ws + WS_SMALLW + SW_GLU); const bf16* WGUP = (const bf16*)(a->ws + WS_SMALLW + SW_GUP);
    LAS bf16* Az = (LAS bf16*)F.lds;
    LAS bf16* Ag = (LAS bf16*)(F.lds + 33792);
    LAS float* Pr = (LAS float*)(F.lds + 33792 + 9216);
    const int tid = F.tid, lane = F.lane, wave = F.wave, row0 = tile * 64;
    const int i = tid >> 3, part = tid & 7, row = row0 + i;
    const size_t DS = (size_t)NROWS * 256;
    {
        const float* dsk = a->in[I_S5D] + l * 256 + part * 32;
#pragma unroll
        for (int j = 0; j < 4; ++j) { const int c0 = part * 32 + 8 * j;
            const v4u y0 = *(const v4u*)(YS + (size_t)row * 256 + c0), y1 = *(const v4u*)(YS + DS + (size_t)row * 256 + c0), u = *(const v4u*)(Z + (size_t)row * ZP + ZS5 + c0);
            float z[8];
            z[0] = gelu_tanh(bflo(y0.x) + bflo(y1.x) + dsk[8 * j + 0] * bflo(u.x)); z[1] = gelu_tanh(bfhi(y0.x) + bfhi(y1.x) + dsk[8 * j + 1] * bfhi(u.x));
            z[2] = gelu_tanh(bflo(y0.y) + bflo(y1.y) + dsk[8 * j + 2] * bflo(u.y)); z[3] = gelu_tanh(bfhi(y0.y) + bfhi(y1.y) + dsk[8 * j + 3] * bfhi(u.y));
            z[4] = gelu_tanh(bflo(y0.z) + bflo(y1.z) + dsk[8 * j + 4] * bflo(u.z)); z[5] = gelu_tanh(bfhi(y0.z) + bfhi(y1.z) + dsk[8 * j + 5] * bfhi(u.z));
            z[6] = gelu_tanh(bflo(y0.w) + bflo(y1.w) + dsk[8 * j + 6] * bflo(u.w)); z[7] = gelu_tanh(bfhi(y0.w) + bfhi(y1.w) + dsk[8 * j + 7] * bfhi(u.w));
            v4u o; o.x = pk2(z[0], z[1]); o.y = pk2(z[2], z[3]); o.z = pk2(z[4], z[5]); o.w = pk2(z[6], z[7]);
            *(LAS v4u*)(Az + i * 264 + c0) = o; }
    }
    {
        const int hq = part >> 1, hf = part & 1, c0 = hq * 64 + hf * 32;
        const bool lat = row < NLAT; const int t = lat ? (row & (T - 1)) : ((row - NLAT) & (TC - 1)); const int len = lat ? T : TC;
        const bf16* zr = Z + (size_t)row * ZP;
        {
            float y[32]; float s = 0.f;
#pragma unroll
            for (int j = 0; j < 4; ++j) { const v4u y0 = *(const v4u*)(YM + (size_t)row * 256 + c0 + 8 * j), y1 = *(const v4u*)(YM + DS + (size_t)row * 256 + c0 + 8 * j);
                y[8 * j + 0] = bflo(y0.x) + bflo(y1.x); y[8 * j + 1] = bfhi(y0.x) + bfhi(y1.x); y[8 * j + 2] = bflo(y0.y) + bflo(y1.y); y[8 * j + 3] = bfhi(y0.y) + bfhi(y1.y);
                y[8 * j + 4] = bflo(y0.z) + bflo(y1.z); y[8 * j + 5] = bfhi(y0.z) + bfhi(y1.z); y[8 * j + 6] = bflo(y0.w) + bflo(y1.w); y[8 * j + 7] = bfhi(y0.w) + bfhi(y1.w); }
#pragma unroll
            for (int j = 0; j < 32; ++j) s += y[j];
            s += __shfl_xor(s, 1); const float mu = s * (1.0f / 64.0f); float q = 0.f;
#pragma unroll
            for (int j = 0; j < 32; ++j) { y[j] -= mu; q += y[j] * y[j]; }
            q += __shfl_xor(q, 1); const float rstd = 1.0f / sqrtf(q * (1.0f / 64.0f) + 1e-6f);
            const float* nw = a->in[I_MNORM] + l * 256 + c0;
#pragma unroll
            for (int j = 0; j < 4; ++j) { const v4u ov = *(const v4u*)(zr + ZMO + c0 + 8 * j); float o[8];
                o[0] = bflo(ov.x); o[1] = bfhi(ov.x); o[2] = bflo(ov.y); o[3] = bfhi(ov.y); o[4] = bflo(ov.z); o[5] = bfhi(ov.z); o[6] = bflo(ov.w); o[7] = bfhi(ov.w);
#pragma unroll
                for (int e = 0; e < 8; ++e) o[e] = y[8 * j + e] * rstd * nw[8 * j + e] * fsigmoid(o[e]);
                v4u w; w.x = pk2(o[0], o[1]); w.y = pk2(o[2], o[3]); w.z = pk2(o[4], o[5]); w.w = pk2(o[6], o[7]);
                *(v4u*)(MO + (size_t)row * D + 768 + c0 + 8 * j) = w; }
        }
        {
            float y[32]; float s = 0.f;
#pragma unroll
            for (int j = 0; j < 4; ++j) { const v4u y0 = *(const v4u*)(YR + (size_t)row * 256 + c0 + 8 * j), y1 = *(const v4u*)(YR + DS + (size_t)row * 256 + c0 + 8 * j);
                y[8 * j + 0] = bflo(y0.x) + bflo(y1.x); y[8 * j + 1] = bfhi(y0.x) + bfhi(y1.x); y[8 * j + 2] = bflo(y0.y) + bflo(y1.y); y[8 * j + 3] = bfhi(y0.y) + bfhi(y1.y);
                y[8 * j + 4] = bflo(y0.z) + bflo(y1.z); y[8 * j + 5] = bfhi(y0.z) + bfhi(y1.z); y[8 * j + 6] = bflo(y0.w) + bflo(y1.w); y[8 * j + 7] = bfhi(y0.w) + bfhi(y1.w); }
#pragma unroll
            for (int j = 0; j < 32; ++j) s += y[j];
            s += __shfl_xor(s, 1); const float mu = s * (1.0f / 64.0f); float q = 0.f;
#pragma unroll
            for (int j = 0; j < 32; ++j) { y[j] -= mu; q += y[j] * y[j]; }
            q += __shfl_xor(q, 1); const float rstd = 1.0f / sqrtf(q * (1.0f / 64.0f) + 64e-5f);
            const float* cw = a->in[I_RCW] + (size_t)l * 3 * 768; const float* cbp = a->in[I_RCB] + (size_t)l * 768;
            const float* rk = a->in[I_RRK] + l * 256 + c0; const float* lw = a->in[I_RLNW] + l * 256 + c0; const float* lb = a->in[I_RLNB] + l * 256 + c0;
            float vv[32]; float bs = 0.f;
#pragma unroll 4
            for (int j = 0; j < 32; ++j) { const int c = c0 + j;
                float rr = cbp[c] + cw[768 + c] * bf2f(zr[ZRKV + c]), kk = cbp[256 + c] + cw[768 + 256 + c] * bf2f(zr[ZRKV + 256 + c]), v = cbp[512 + c] + cw[768 + 512 + c] * bf2f(zr[ZRKV + 512 + c]);
                if (t > 0) { rr += cw[c] * bf2f(zr[ZRKV + c - ZP]); kk += cw[256 + c] * bf2f(zr[ZRKV + 256 + c - ZP]); v += cw[512 + c] * bf2f(zr[ZRKV + 512 + c - ZP]); }
                if (t + 1 < len) { rr += cw[1536 + c] * bf2f(zr[ZRKV + c + ZP]); kk += cw[1536 + 256 + c] * bf2f(zr[ZRKV + 256 + c + ZP]); v += cw[1536 + 512 + c] * bf2f(zr[ZRKV + 512 + c + ZP]); }
                bs += rr * kk * rk[j]; vv[j] = v; }
            bs += __shfl_xor(bs, 1);
#pragma unroll
            for (int j = 0; j < 32; ++j) Pr[i * 260 + c0 + j] = y[j] * rstd * lw[j] + lb[j] + bs * vv[j];
        }
        { const v4u gv = *(const v4u*)(zr + ZGD + part * 8);
          v4u o; o.x = pk2(fsigmoid(bflo(gv.x)), fsigmoid(bfhi(gv.x))); o.y = pk2(fsigmoid(bflo(gv.y)), fsigmoid(bfhi(gv.y))); o.z = pk2(fsigmoid(bflo(gv.z)), fsigmoid(bfhi(gv.z))); o.w = pk2(fsigmoid(bflo(gv.w)), fsigmoid(bfhi(gv.w)));
          *(LAS v4u*)(Ag + i * 72 + part * 8) = o; }
    }
    __syncthreads();
    const int lr = lane & 15, kq = lane >> 4;
    {
        f32x4 acc[2][4];
        small_gemm<256, 2, 4, true>(Az, 264, WGLU, 32 * wave, acc, lane);
        const float* bg = a->in[I_S5BGLU] + l * 256;
#pragma unroll
        for (int nb = 0; nb < 2; ++nb)
#pragma unroll
            for (int mb = 0; mb < 4; ++mb) { const int tk = 16 * mb + lr, n = 32 * wave + 16 * nb + 4 * kq; const f32x4 v = acc[nb][mb]; const f32x4 b4 = *(const f32x4*)(bg + n);
                const v2u zz = *(const LAS v2u*)(Az + tk * 264 + n);
                const float o0 = bflo(zz.x) * fsigmoid(v.x + b4.x), o1 = bfhi(zz.x) * fsigmoid(v.y + b4.y), o2 = bflo(zz.y) * fsigmoid(v.z + b4.z), o3 = bfhi(zz.y) * fsigmoid(v.w + b4.w);
                v2u o; o.x = pk2(o0, o1); o.y = pk2(o2, o3);
                *(v2u*)(MO + (size_t)(row0 + tk) * D + n) = o; }
    }
    {
        f32x4 acc[2][4];
        small_gemm<64, 2, 4, true>(Ag, 72, WGUP, 32 * wave, acc, lane);
#pragma unroll
        for (int nb = 0; nb < 2; ++nb)
#pragma unroll
            for (int mb = 0; mb < 4; ++mb) { const int tk = 16 * mb + lr, n = 32 * wave + 16 * nb + 4 * kq; const f32x4 v = acc[nb][mb];
                const f32x4 pr = *(const LAS f32x4*)(Pr + tk * 260 + n);
                v2u o; o.x = pk2(pr.x * v.x, pr.y * v.y); o.y = pk2(pr.z * v.z, pr.w * v.w);
                *(v2u*)(MO + (size_t)(row0 + tk) * D + 512 + n) = o; }
    }
    __syncthreads();
}

#ifndef MK_SPLIT
#define MK_SPLIT 1
#endif
#ifdef USE_NOINLINE
#define NI static __device__ __noinline__
#else
#define NI static __device__ __forceinline__
#endif
extern __shared__ __attribute__((aligned(16))) unsigned char lds_raw[];
DI Ctx make_ctx(int wave0) {
    Ctx F; F.lds = (LAS uchar*)lds_raw; { int ln_ = __builtin_amdgcn_mbcnt_hi(~0u, __builtin_amdgcn_mbcnt_lo(~0u, 0u)); asm volatile("" : "+v"(ln_)); F.lane = ln_; } F.wave = wave0; F.tid = wave0 * 64 + F.lane;
    F.G = gridDim.x; { int bx = blockIdx.x; asm volatile("" : "+s"(bx)); F.vcu = (F.G % 8 == 0) ? (bx % 8) * (F.G / 8) + bx / 8 : bx; }
    return F;
}
NI void ph_prologue(KArgs a_, int wave0) { KArgs a = a_; asm volatile("" : "+s"(a)); const Ctx F = make_ctx(wave0); phase_prologue(a, F); __syncthreads(); }
NI void ph_norm(KArgs a_, int wave0, int l, int kind) { KArgs a = a_; asm volatile("" : "+s"(a));
    const Ctx F = make_ctx(wave0);
    float* modv = (float*)(a->ws + WS_MODV);
    const bool last = (l == DEPTH - 1);
    if (kind == 0) convert_weights(a, F, l, 0);
    if (kind == 1) convert_weights(a, F, l, 1);
    const int lY = (kind == 0) ? (l > 0 ? l - 1 : 0) : l;
    const int gi = (kind == 0 || kind == 3) ? 8 : (kind == 1 ? 2 : 5);
    const int pi = (kind == 0 || kind == 3) ? 2 : (kind == 1 ? 0 : 1);
    const float coef = (kind == 2) ? 1.0f : 0.5f;
    const int si = (kind == 0) ? 0 : (kind == 1 ? 3 : 6);
    const int ni = (kind == 0) ? 0 : (kind == 1 ? 1 : 2);
    const bool first = (kind == 0 && l == 0), hasY = !(kind == 0 && l == 0), hasH = (kind != 3), fin = (kind == 3);
    const int nrows = (kind == 3 || (kind == 2 && last)) ? NLAT : NROWS;
    norm_rows(a, F, first, hasY, hasH, fin, nrows, modv + (size_t)lY * 9 * MODW, gi, a->in[I_NPOST] + (lY * 3 + pi) * D, coef, modv + (size_t)l * 9 * MODW, si, a->in[I_NPRE] + (l * 3 + ni) * D);
    __syncthreads();
}
NI void ph_gemm_swiglu(KArgs a_, int wave0, int M) { KArgs a = a_; asm volatile("" : "+s"(a));
    const Ctx F = make_ctx(wave0);
    pg8::Gemm g{(const bf16*)(a->ws + WS_H), (const bf16*)(a->ws + WS_WGU), M, 2 * FF, D}; pg8::StaticOrder S; S.init(M, 2 * FF, F.G, (int)blockIdx.x);
    pg8::EpiSwiGLU E{(bf16*)(a->ws + WS_ACT), FF};
    pg8::gemm_phase<pg8::EpiSwiGLU, pg8::StaticOrder, PG8_ALIGN, PG8_SP2>(F.lds, g, S, E, F.tid);
}
NI void ph_gemm_store(KArgs a_, int wave0, int which, int M) { KArgs a = a_; asm volatile("" : "+s"(a));
    const Ctx F = make_ctx(wave0);
    const bf16* A = (const bf16*)(a->ws + (which == 0 ? WS_ACT : WS_H));
    const bf16* W = (const bf16*)(a->ws + (which == 0 ? WS_WDN : which == 1 ? WS_WIN : WS_WOUT));
    const int N = which == 1 ? ZPAD : D, K = which == 0 ? FF : D;
    pg8::Gemm g{A, W, M, N, K}; pg8::StaticOrder S; S.init(M, N, F.G, (int)blockIdx.x);
    pg8::EpiStore E{(bf16*)(a->ws + (which == 1 ? WS_ACT : WS_Y)), which == 1 ? ZP : D, which == 1 ? ZP : D};
    pg8::gemm_phase<pg8::EpiStore, pg8::StaticOrder, PG8_ALIGN, PG8_SP2>(F.lds, g, S, E, F.tid);
}
NI void ph_mla_prep(KArgs a_, int wave0, int l) { KArgs a = a_; asm volatile("" : "+s"(a)); const Ctx F = make_ctx(wave0); for (int tile = F.vcu; tile < NROWS / 64; tile += F.G) mla_prep_tile(a, F, l, tile); }
NI void ph_rwkv(KArgs a_, int wave0, int l, int v) { KArgs a = a_; asm volatile("" : "+s"(a)); const Ctx F = make_ctx(wave0); rwkv_scan_task(a, F, l, v >> 3, (v >> 1) & 3, v & 1); }
NI void ph_mlstm(KArgs a_, int wave0, int l, int idx) { KArgs a = a_; asm volatile("" : "+s"(a)); const Ctx F = make_ctx(wave0); mlstm_task(a, F, l, idx >> 2, idx & 3); __syncthreads(); }
NI void ph_s5(KArgs a_, int wave0, int l, int wg) { KArgs a = a_; asm volatile("" : "+s"(a)); const Ctx F = make_ctx(wave0); const int tk = wg * 8 + F.wave; s5_scan_task(a, l, tk >> 5, (tk >> 4) & 1, tk & 15, (LAS bf16*)(F.lds + F.wave * 8704), F.lane); __syncthreads(); }
NI void ph_attn(KArgs a_, int wave0, int first, int stride) { KArgs a = a_; asm volatile("" : "+s"(a));
    const Ctx F = make_ctx(wave0);
    for (int u = first; u < 512 + 32; u += stride) {
        if (u < 512) { const int b = u >> 6, hd = (u >> 4) & 3, qb = u & 15; attn_unit(a, F, b, hd, b * T + qb * 256, NKEY); }
        else { const int c = u - 512, b = c >> 2, hd = c & 3; attn_unit(a, F, b, hd, NLAT + b * TC, TC); }
    }
}
NI void ph_fin(KArgs a_, int wave0, int l, int M) { KArgs a = a_; asm volatile("" : "+s"(a)); const Ctx F = make_ctx(wave0); for (int tile = F.vcu; tile < M / 64; tile += F.G) fin_tile(a, F, l, tile); }


#ifdef DBG_CUT
NI void ph_dump(KArgs a_, int wave0) { KArgs a = a_; asm volatile("" : "+s"(a)); const Ctx F = make_ctx(wave0);
    const float* X = (const float*)(a->ws + WS_X); const bf16* Z = (const bf16*)(a->ws + WS_ACT); const bf16* Q = (const bf16*)(a->ws + WS_Q); const bf16* Kf = (const bf16*)(a->ws + WS_K); const bf16* Vt = (const bf16*)(a->ws + WS_VT);
    const bf16* YS = (const bf16*)(a->ws + WS_YS5); const bf16* YR = (const bf16*)(a->ws + WS_YR); const bf16* YM = (const bf16*)(a->ws + WS_YM); const bf16* MO = (const bf16*)(a->ws + WS_H); const bf16* Y = (const bf16*)(a->ws + WS_Y);
    const size_t DS = (size_t)NROWS * 256;
    for (size_t i = (size_t)F.vcu * NTHR + F.tid; i < (size_t)NLAT * D; i += (size_t)F.G * NTHR) {
#ifdef DBG_CTX
        const size_t r = NLAT + ((i >> 10) % NCTX);
#else
        const size_t r = i >> 10;
#endif
        const int c = (int)(i & 1023); float v = 0.f;
        if (DBG_WHICH & 1) v += X[r * D + c];
        if (DBG_WHICH & 2) { v += bf2f(Z[r * ZP + c]) + bf2f(Z[r * ZP + 1024 + c]); if (c + 2048 < ZP) v += bf2f(Z[r * ZP + 2048 + c]); }
        if (DBG_WHICH & 4) { v += bf2f(Q[r * 384 + c % 384]) + bf2f(Kf[r * 384 + c % 384]) + bf2f(Vt[i % ((size_t)NB * 4 * 64 * NKEY)]); }
        if (DBG_WHICH & 256) v += bf2f(Q[r * 384 + c % 384]);
        if (DBG_WHICH & 512) v += bf2f(Kf[r * 384 + c % 384]);
        if (DBG_WHICH & 1024) v += bf2f(Vt[i % ((size_t)NB * 4 * 64 * NKEY)]);
        if (DBG_WHICH & 2048) { const float* rc = (const float*)(a->ws + WS_ROPE); const bf16* sw = (const bf16*)(a->ws + WS_SMALLW); v += rc[i % (T * 32)] + bf2f(sw[i % 245760]); }
        if (DBG_WHICH & 8) v += bf2f(YS[r * 256 + (c & 255)]) + bf2f(YS[DS + r * 256 + (c & 255)]);
        if (DBG_WHICH & 16) v += bf2f(YR[r * 256 + (c & 255)]) + bf2f(YR[DS + r * 256 + (c & 255)]);
        if (DBG_WHICH & 32) v += bf2f(YM[r * 256 + (c & 255)]) + bf2f(YM[DS + r * 256 + (c & 255)]);
        if (DBG_WHICH & 64) v += bf2f(MO[r * D + c]);
        if (DBG_WHICH & 128) v += bf2f(Y[r * D + c]);
        a->out[i] = v;
    }
}
#endif
#if !MK_SPLIT
#if defined(ONLY_PH)
#define PHON(k) ((k) == ONLY_PH)
#elif defined(NO_PH)
#define PHON(k) ((k) != NO_PH)
#else
#define PHON(k) true
#endif
#if defined(ONLY_ROLE)
#define ROLE(k) ((k) == ONLY_ROLE)
#elif defined(NO_ROLE)
#define ROLE(k) ((k) != NO_ROLE)
#else
#define ROLE(k) true
#endif
constexpr int NPH = 2 + 12 * DEPTH;
__global__ void __launch_bounds__(NTHR, 2) hybrid_fwd(Args args_byval) {
    KArgs a = (KArgs)__builtin_amdgcn_kernarg_segment_ptr();
    LAS uchar* lds = (LAS uchar*)lds_raw;
    const int tid = threadIdx.x; const int wave0 = __builtin_amdgcn_readfirstlane(tid >> 6);
    volatile LAS unsigned* MISC = (volatile LAS unsigned*)(lds + MISC_OFF);
    for (int u = tid; u < (LDS_BYTES - LDSCTL_OFF) / 4; u += NTHR) ((LAS unsigned*)(lds + LDSCTL_OFF))[u] = 0u;
    __syncthreads();
    unsigned* ctl = (unsigned*)(a->ws + WS_CTL);
    const int use_bar = a->use_bar;
    XcdBarrier bar; bar.bar = ctl + CW_BAR; bar.x = 0; bar.st = nullptr;
    if (use_bar) bar = xcd_barrier_post(ctl + CW_BAR, MISC + 8, tid == 0);
    const int lo = a->ph_lo, hi = a->ph_hi;
    const int G = gridDim.x; const int vcu = (G % 8 == 0) ? ((int)blockIdx.x % 8) * (G / 8) + (int)blockIdx.x / 8 : (int)blockIdx.x;
#ifdef DBG_CUT
#define IN(k) (lo <= (k) && (k) < hi && (k) < DBG_CUT)
#else
#define IN(k) (lo <= (k) && (k) < hi)
#endif
#define SEAM(k) do { if (use_bar && IN(k) && IN((k) + 1)) { int ln_ = __builtin_amdgcn_mbcnt_hi(~0u, __builtin_amdgcn_mbcnt_lo(~0u, 0u)); asm volatile("" : "+v"(ln_)); xcd_barrier(bar, wave0 == 0 && ln_ == 0); } } while (0)
    if (PHON(100) && IN(0)) ph_prologue(a, wave0);
    SEAM(0);
#pragma unroll 1
    for (int l = 0; l < DEPTH; ++l) {
        const int P = 1 + 12 * l;
        const int Mtail = (l == DEPTH - 1) ? NLAT : NROWS;
        if (PHON(0) && IN(P + 0)) ph_norm(a, wave0, l, 0);
        SEAM(P + 0);
        if (PHON(1) && IN(P + 1)) ph_gemm_swiglu(a, wave0, NROWS);
        SEAM(P + 1);
        if (PHON(2) && IN(P + 2)) ph_gemm_store(a, wave0, 0, NROWS);
        SEAM(P + 2);
        if (PHON(3) && IN(P + 3)) ph_norm(a, wave0, l, 1);
        SEAM(P + 3);
        if (PHON(4) && IN(P + 4)) ph_gemm_store(a, wave0, 1, NROWS);
        SEAM(P + 4);
        if (PHON(5) && IN(P + 5)) ph_mla_prep(a, wave0, l);
        SEAM(P + 5);
        if (PHON(6) && IN(P + 6) && G >= 256) {
            if (ROLE(0) && vcu < 64) ph_rwkv(a, wave0, l, vcu);
            else if (ROLE(1) && vcu < 96) ph_mlstm(a, wave0, l, vcu - 64);
            else if (ROLE(2) && vcu < 128) ph_s5(a, wave0, l, vcu - 96);
            else if (ROLE(3)) ph_attn(a, wave0, vcu - 128, G - 128);
        }
        SEAM(P + 6);
        if (PHON(7) && IN(P + 7)) ph_fin(a, wave0, l, Mtail);
        SEAM(P + 7);
        if (PHON(8) && IN(P + 8)) ph_gemm_store(a, wave0, 2, Mtail);
        SEAM(P + 8);
        if (PHON(9) && IN(P + 9)) ph_norm(a, wave0, l, 2);
        SEAM(P + 9);
        if (PHON(10) && IN(P + 10)) ph_gemm_swiglu(a, wave0, Mtail);
        SEAM(P + 10);
        if (PHON(11) && IN(P + 11)) ph_gemm_store(a, wave0, 0, Mtail);
        SEAM(P + 11);
    }
#ifdef DBG_CUT
    if (lo <= NPH - 1 && NPH - 1 < hi) ph_dump(a, wave0);
#else
    if (PHON(101) && IN(NPH - 1)) ph_norm(a, wave0, DEPTH - 1, 3);
#endif
#undef IN
#undef SEAM
}

#endif
#if MK_SPLIT
struct ArgsS { Args base; int kind, l, sub, M; };
typedef const __attribute__((address_space(4))) ArgsS* KArgsS;
template <int KIND>
__global__ void __launch_bounds__(NTHR, 2) phase_kernel(ArgsS args_byval) {
    KArgsS as = (KArgsS)__builtin_amdgcn_kernarg_segment_ptr();
    KArgs a = (KArgs)as;
    const int tid = threadIdx.x; const int wave0 = __builtin_amdgcn_readfirstlane(tid >> 6);
    const int l = as->l, sub = as->sub, M = as->M;
    const int G = gridDim.x; const int vcu = (G % 8 == 0) ? ((int)blockIdx.x % 8) * (G / 8) + (int)blockIdx.x / 8 : (int)blockIdx.x;
    if constexpr (KIND == 0) ph_prologue(a, wave0);
    if constexpr (KIND == 1) ph_norm(a, wave0, l, sub);
    if constexpr (KIND == 2) ph_gemm_swiglu(a, wave0, M);
    if constexpr (KIND == 3) ph_gemm_store(a, wave0, sub, M);
    if constexpr (KIND == 4) ph_mla_prep(a, wave0, l);
    if constexpr (KIND == 5) { if (vcu < 64) ph_rwkv(a, wave0, l, vcu); }
    if constexpr (KIND == 6) { if (vcu >= 64 && vcu < 96) ph_mlstm(a, wave0, l, vcu - 64); }
    if constexpr (KIND == 7) { if (vcu >= 96 && vcu < 128) ph_s5(a, wave0, l, vcu - 96); }
    if constexpr (KIND == 8) { if (vcu >= 128) ph_attn(a, wave0, vcu - 128, G - 128); }
    if constexpr (KIND == 9) ph_fin(a, wave0, l, M);
}
template <int KIND> static void launch_phase(int grid, hipStream_t stream, const Args& base, int l, int sub, int M) {
    static bool attr = false;
    if (!attr) { (void)hipFuncSetAttribute((const void*)phase_kernel<KIND>, hipFuncAttributeMaxDynamicSharedMemorySize, LDS_BYTES); attr = true; }
    ArgsS s{}; s.base = base; s.kind = KIND; s.l = l; s.sub = sub; s.M = M;
    hipLaunchKernelGGL(phase_kernel<KIND>, dim3(grid), dim3(NTHR), LDS_BYTES, stream, s);
}
static void launch_split(int grid, hipStream_t stream, const Args& a) {
    launch_phase<0>(grid, stream, a, 0, 0, 0);
    for (int l = 0; l < DEPTH; ++l) {
        const int Mtail = (l == DEPTH - 1) ? NLAT : NROWS;
        launch_phase<1>(grid, stream, a, l, 0, 0);
        launch_phase<2>(grid, stream, a, l, 0, NROWS);
        launch_phase<3>(grid, stream, a, l, 0, NROWS);
        launch_phase<1>(grid, stream, a, l, 1, 0);
        launch_phase<3>(grid, stream, a, l, 1, NROWS);
        launch_phase<4>(grid, stream, a, l, 0, 0);
        launch_phase<5>(grid, stream, a, l, 0, 0);
        launch_phase<6>(grid, stream, a, l, 0, 0);
        launch_phase<7>(grid, stream, a, l, 0, 0);
        launch_phase<8>(grid, stream, a, l, 0, 0);
        launch_phase<9>(grid, stream, a, l, 0, Mtail);
        launch_phase<3>(grid, stream, a, l, 2, Mtail);
        launch_phase<1>(grid, stream, a, l, 2, 0);
        launch_phase<2>(grid, stream, a, l, 0, Mtail);
        launch_phase<3>(grid, stream, a, l, 0, Mtail);
    }
    launch_phase<1>(grid, stream, a, DEPTH - 1, 3, 0);
}
#endif
extern "C" void kernel_launch(void* const* d_in, const int* in_sizes, int n_in, void* d_out, int out_size, void* d_ws, size_t ws_size, hipStream_t stream) {
    static int grid = 0;
    if (grid == 0) {
        if (n_in != 43 || out_size != NLAT * D || ws_size < WS_END) { fprintf(stderr, "kernel_launch: unexpected shapes: n_in %d out %d ws %zu (need %zu)\n", n_in, out_size, ws_size, (size_t)WS_END); grid = -1; return; }
        int dev = 0, cus = 0, per_cu = 0;
        if (hipGetDevice(&dev) != hipSuccess || hipDeviceGetAttribute(&cus, hipDeviceAttributeMultiprocessorCount, dev) != hipSuccess) { grid = -1; return; }
        if (false) { grid = -1; return; }
        (void)hipGetLastError();
        grid = cus;
    }
    if (grid < 0) return;
    (void)hipMemsetAsync((char*)d_ws + WS_CTL, 0, CTL_ZERO_BYTES, stream);
    Args a{};
    for (int i = 0; i < 43; ++i) a.in[i] = (const float*)d_in[i];
    a.out = (float*)d_out; a.ws = (unsigned char*)d_ws; a.pad = 0;
#if MK_SPLIT
    launch_split(grid, stream, a);
#else
    static bool attr1 = false; if (!attr1) { (void)hipFuncSetAttribute((const void*)hybrid_fwd, hipFuncAttributeMaxDynamicSharedMemorySize, LDS_BYTES); attr1 = true; }
    a.ph_lo = 0; a.ph_hi = NPH; a.use_bar = 1;
    hipLaunchKernelGGL(hybrid_fwd, dim3(grid), dim3(NTHR), LDS_BYTES, stream, a);
#endif
}
```

```cpp
#include <hip/hip_runtime.h>
#include <cstdio>
#include <cstdint>
#define MK_SPLIT 0
namespace pg8 {
#define PG8_LAS __attribute__((address_space(3)))
typedef unsigned short bf16_t;
typedef short bf16x8 __attribute__((ext_vector_type(8)));
typedef float f32x4 __attribute__((ext_vector_type(4)));
typedef unsigned u32x4 __attribute__((ext_vector_type(4)));
constexpr int BM = 256, BK = 64, HALF = 128, HTB = HALF * BK * 2  , STAGE_BYTES = 8 * HTB, NXCD = 8, WGM = 8;

__host__ __device__ __forceinline__ int lds_byte(int r, int c) { const int st = (r >> 4) * 2 + (c >> 5), rr = r & 15, cc = c & 31, ob = rr * 64 + cc * 2; return st * 1024 + (ob ^ (((ob >> 9) & 1) << 5)); }
__host__ __device__ __forceinline__ void stage_rc(int b, int& R, int& C) { const int st = b / 1024, sb = b % 1024, swz = sb ^ (((sb >> 9) & 1) << 5); R = (st >> 1) * 16 + swz / 64; C = (st & 1) * 32 + (swz % 64) / 2; }
__host__ __device__ __forceinline__ int perm32(int rho) { const int n = rho >> 4, i = rho & 15; return 8 * (i >> 2) + 4 * n + (i & 3); }

struct Unit { int pm, pn; };
struct Gemm { const bf16_t* A; const bf16_t* Bt; int M, N, K; };

struct StaticOrder {
    int nM, nN, nwg, G, c;
    __host__ __device__ void init(int M, int N, int G_, int c_) { nM = M / BM; nN = N / BM; nwg = nM * nN; G = G_; c = c_; }
    __host__ __device__ bool next(int i, Unit& u) const {
        const long L = (long)i * G + c; if (L >= nwg) return false;
        int wgid = (int)L; { const int q = nwg / NXCD, r = nwg % NXCD, xcd = wgid % NXCD, off = wgid / NXCD; wgid = (xcd < r ? xcd * (q + 1) : r * (q + 1) + (xcd - r) * q) + off; }
        const int nig = WGM * nN, gid = wgid / nig, fm = gid * WGM, gsz = (nM - fm) < WGM ? (nM - fm) : WGM;
        u.pm = fm + ((wgid % nig) % gsz); u.pn = (wgid % nig) / gsz; return true;
    }
    __device__ __forceinline__ void a_ready(const Unit&) const {}
    __device__ __forceinline__ void done(const Unit&) const {}
};

typedef __bf16 nbf16v2 __attribute__((ext_vector_type(2))); typedef float nf32v2 __attribute__((ext_vector_type(2)));
__device__ __forceinline__ unsigned cvt_pk_bf16(float lo, float hi) { const nf32v2 v = {lo, hi}; return __builtin_bit_cast(unsigned, __builtin_convertvector(v, nbf16v2)); }
struct EpiSwiGLU {
    static constexpr bool PERM = true, AFTER_DRAIN = false;
    bf16_t* O; int ldc;
    __device__ __forceinline__ void operator()(const f32x4 (&acc)[2][2][4][2], const Unit& u, int wr, int wc, int fr, int fq) const {
        const int row0 = u.pm * BM + wr * 64 + fr; const int col0 = u.pn * HALF + wc * 32 + 8 * fq;
#pragma unroll
        for (int ai = 0; ai < 2; ++ai)
#pragma unroll
            for (int m = 0; m < 4; ++m) { bf16_t* rowp = O + (size_t)(row0 + ai * HALF + m * 16) * ldc + col0;
                float o[8];
#pragma unroll
                for (int n = 0; n < 2; ++n)
#pragma unroll
                    for (int j = 0; j < 4; ++j) { const float g = acc[ai][0][m][n][j], up = acc[ai][1][m][n][j];
                        const float sg = __builtin_amdgcn_rcpf(1.0f + __builtin_amdgcn_exp2f(-1.44269504089f * g)); o[n * 4 + j] = g * sg * up; }
                u32x4 w; w.x = cvt_pk_bf16(o[0], o[1]); w.y = cvt_pk_bf16(o[2], o[3]); w.z = cvt_pk_bf16(o[4], o[5]); w.w = cvt_pk_bf16(o[6], o[7]);
                *(u32x4*)rowp = w; }
    }
};
struct EpiStore {
    static constexpr bool PERM = true, AFTER_DRAIN = false;
    bf16_t* O; int ldc; int ncols;
    __device__ __forceinline__ void operator()(const f32x4 (&acc)[2][2][4][2], const Unit& u, int wr, int wc, int fr, int fq) const {
        const int row0 = u.pm * BM + wr * 64 + fr; const int col0 = u.pn * BM + wc * 32 + 8 * fq;
#pragma unroll
        for (int ai = 0; ai < 2; ++ai)
#pragma unroll
            for (int m = 0; m < 4; ++m) { bf16_t* rowp = O + (size_t)(row0 + ai * HALF + m * 16) * ldc + col0;
#pragma unroll
                for (int bj = 0; bj < 2; ++bj) { if (col0 + bj * HALF < ncols) { const f32x4 v0 = acc[ai][bj][m][0], v1 = acc[ai][bj][m][1];
                    u32x4 w; w.x = cvt_pk_bf16(v0[0], v0[1]); w.y = cvt_pk_bf16(v0[2], v0[3]); w.z = cvt_pk_bf16(v1[0], v1[1]); w.w = cvt_pk_bf16(v1[2], v1[3]);
                    *(u32x4*)(rowp + bj * HALF) = w; } } }
    }
};
template <class Epi, class Sched, bool ALIGN_EPI = false, bool SP2 = false>
__device__ __forceinline__ void gemm_phase(PG8_LAS unsigned char* lds, const Gemm g, const Sched& S, const Epi& E, const int tid) {
    const int wid = __builtin_amdgcn_readfirstlane(tid >> 6), lane = tid & 63, wr = wid >> 2, wc = wid & 3, fr = lane & 15, fq = lane >> 4;
    const int K = g.K, nt = K / BK;
    unsigned voffA[2], voffB[2];
#pragma unroll
    for (int i = 0; i < 2; ++i) { int R, C; stage_rc(tid * 16 + i * 8192, R, C); const int Rb = Epi::PERM ? ((R & ~31) + perm32(R & 31)) : R;
        voffA[i] = (unsigned)(R * K + C) * 2u; voffB[i] = (unsigned)(Rb * K + C) * 2u; }
    const size_t kstep = (size_t)(BK * 2);
    const size_t hstep = (size_t)HALF * K * 2;
    const size_t tstep = 2 * hstep;
    const unsigned ldsw = (unsigned)wid * 1024u;
    const int aoff = lds_byte(wr * 64 + fr, fq * 8), boff = lds_byte(wc * 32 + fr, fq * 8);
#define PG8_SA(b, h) (((b) * 2 + (h)) * HTB)
#define PG8_SB(b, h) ((4 + (b) * 2 + (h)) * HTB)
#define PG8_STAGE(bufoff, gbase, voff) do { _Pragma("unroll") for (int _i = 0; _i < 2; ++_i) \
        __builtin_amdgcn_global_load_lds((const unsigned*)((const char*)(gbase) + (voff)[_i]), (PG8_LAS unsigned*)(lds + (bufoff) + ldsw + _i * 8192), 16, 0, 0); } while (0)
#define PG8_LDA(dst, b, h) do { _Pragma("unroll") for (int m = 0; m < 4; ++m) _Pragma("unroll") for (int k = 0; k < 2; ++k) dst[m][k] = *(const PG8_LAS bf16x8*)(lds + PG8_SA(b, h) + aoff + m * 2048 + k * 1024); } while (0)
#define PG8_LDB(dst, b, h) do { _Pragma("unroll") for (int n = 0; n < 2; ++n) _Pragma("unroll") for (int k = 0; k < 2; ++k) dst[n][k] = *(const PG8_LAS bf16x8*)(lds + PG8_SB(b, h) + boff + n * 2048 + k * 1024); } while (0)
#define PG8_MMA(ai, bj, At, Bt) do { __builtin_amdgcn_s_setprio(1); _Pragma("unroll") for (int m = 0; m < 4; ++m) _Pragma("unroll") for (int n = 0; n < 2; ++n) _Pragma("unroll") for (int k = 0; k < 2; ++k) \
        acc[ai][bj][m][n] = __builtin_amdgcn_mfma_f32_16x16x32_bf16(Bt[n][k], At[m][k], acc[ai][bj][m][n], 0, 0, 0); __builtin_amdgcn_s_setprio(0); } while (0)
#define PG8_WAIT_V(n) asm volatile("s_waitcnt vmcnt(" #n ")" ::: "memory")
#define PG8_WAIT_L(n) asm volatile("s_waitcnt lgkmcnt(" #n ")" ::: "memory")
#define PG8_BAR __builtin_amdgcn_s_barrier()
#define PG8_SCHED __builtin_amdgcn_sched_barrier(0)
    Unit cur, nxt; int ui = 0;
    if (!S.next(0, cur)) return;
    f32x4 acc[2][2][4][2];
#pragma unroll
    for (int a = 0; a < 2; ++a)
#pragma unroll
        for (int b = 0; b < 2; ++b)
#pragma unroll
            for (int m = 0; m < 4; ++m)
#pragma unroll
                for (int n = 0; n < 2; ++n) acc[a][b][m][n] = (f32x4){0.f, 0.f, 0.f, 0.f};
    bf16x8 At[4][2], B0[2][2], B1[2][2];
    const char* cA = (const char*)g.A + (size_t)cur.pm * tstep; const char* cB = (const char*)g.Bt + (size_t)cur.pn * tstep;
    S.a_ready(cur);
    if constexpr (SP2) {
        PG8_STAGE(PG8_SB(0, 0), cB, voffB); PG8_STAGE(PG8_SB(0, 1), cB + hstep, voffB); PG8_STAGE(PG8_SA(0, 0), cA, voffA); PG8_STAGE(PG8_SA(0, 1), cA + hstep, voffA);
        if (wr == 1) PG8_BAR;
        PG8_WAIT_V(2); PG8_BAR;
        PG8_STAGE(PG8_SB(1, 0), cB + kstep, voffB); PG8_STAGE(PG8_SA(1, 0), cA + kstep, voffA); PG8_STAGE(PG8_SB(1, 1), cB + hstep + kstep, voffB);
        PG8_WAIT_V(6); PG8_BAR;
    } else {
        PG8_STAGE(PG8_SB(0, 0), cB, voffB); PG8_STAGE(PG8_SA(0, 0), cA, voffA); PG8_STAGE(PG8_SB(0, 1), cB + hstep, voffB); PG8_STAGE(PG8_SA(0, 1), cA + hstep, voffA);
        if (wr == 1) PG8_BAR;
        PG8_WAIT_V(4); PG8_BAR;
        PG8_STAGE(PG8_SB(1, 0), cB + kstep, voffB); PG8_STAGE(PG8_SA(1, 0), cA + kstep, voffA); PG8_STAGE(PG8_SB(1, 1), cB + hstep + kstep, voffB);
        PG8_WAIT_V(6); PG8_BAR;
    }
    for (;;) {
        const bool has_next = S.next(ui + 1, nxt);
        const char* nA = has_next ? (const char*)g.A + (size_t)nxt.pm * tstep : cA; const char* nB = has_next ? (const char*)g.Bt + (size_t)nxt.pn * tstep : cB;
        for (int t = 0; t < nt; t += 2) {
            const bool last = (t == nt - 2);
            const char* a1 = cA + (size_t)(t + 1) * kstep;
            const char* a2 = last ? nA : cA + (size_t)(t + 2) * kstep; const char* b2 = last ? nB : cB + (size_t)(t + 2) * kstep;
            const char* a3 = a2 + kstep; const char* b3 = b2 + kstep;
            if (last && has_next) S.a_ready(nxt);
            if constexpr (SP2) {
            PG8_LDB(B0, 0, 0); PG8_LDB(B1, 0, 1); PG8_SCHED; PG8_LDA(At, 0, 0); PG8_STAGE(PG8_SA(1, 1), a1 + hstep, voffA);
            PG8_WAIT_V(8); PG8_WAIT_L(0); PG8_BAR; PG8_MMA(0, 0, At, B0); PG8_MMA(0, 1, At, B1); PG8_BAR; PG8_SCHED;
            PG8_LDA(At, 0, 1); PG8_STAGE(PG8_SB(0, 0), b2, voffB); PG8_STAGE(PG8_SB(0, 1), b2 + hstep, voffB); PG8_STAGE(PG8_SA(0, 0), a2, voffA);
            PG8_WAIT_V(8); PG8_WAIT_L(0); PG8_BAR; PG8_MMA(1, 0, At, B0); PG8_MMA(1, 1, At, B1); PG8_BAR; PG8_SCHED;
            PG8_LDB(B0, 1, 0); PG8_LDB(B1, 1, 1); PG8_SCHED; PG8_LDA(At, 1, 0); PG8_STAGE(PG8_SA(0, 1), a2 + hstep, voffA);
            PG8_WAIT_V(8); PG8_WAIT_L(0); PG8_BAR; PG8_MMA(0, 0, At, B0); PG8_MMA(0, 1, At, B1); PG8_BAR; PG8_SCHED;
            PG8_LDA(At, 1, 1); PG8_STAGE(PG8_SB(1, 0), b3, voffB); PG8_STAGE(PG8_SB(1, 1), b3 + hstep, voffB); PG8_STAGE(PG8_SA(1, 0), a3, voffA);
            PG8_WAIT_V(8); PG8_WAIT_L(0); PG8_BAR; PG8_MMA(1, 0, At, B0); PG8_MMA(1, 1, At, B1); PG8_BAR; PG8_SCHED;
            } else {
            PG8_LDB(B0, 0, 0); PG8_SCHED; PG8_LDA(At, 0, 0); PG8_STAGE(PG8_SA(1, 1), a1 + hstep, voffA);
            PG8_WAIT_L(8); PG8_BAR; PG8_WAIT_L(0); PG8_MMA(0, 0, At, B0); PG8_BAR; PG8_SCHED;
            PG8_LDB(B1, 0, 1); PG8_STAGE(PG8_SB(0, 0), b2, voffB);
            PG8_BAR; PG8_WAIT_L(0); PG8_MMA(0, 1, At, B1); PG8_BAR;
            PG8_LDA(At, 0, 1); PG8_STAGE(PG8_SA(0, 0), a2, voffA);
            PG8_BAR; PG8_WAIT_L(0); PG8_MMA(1, 0, At, B0); PG8_BAR; PG8_SCHED;
            PG8_STAGE(PG8_SB(0, 1), b2 + hstep, voffB);
            PG8_WAIT_V(6); PG8_BAR; PG8_MMA(1, 1, At, B1); PG8_BAR;
            PG8_LDB(B0, 1, 0); PG8_SCHED; PG8_LDA(At, 1, 0); PG8_STAGE(PG8_SA(0, 1), a2 + hstep, voffA);
            PG8_WAIT_L(8); PG8_BAR; PG8_WAIT_L(0); PG8_MMA(0, 0, At, B0); PG8_BAR; PG8_SCHED;
            PG8_LDB(B1, 1, 1); PG8_STAGE(PG8_SB(1, 0), b3, voffB);
            PG8_BAR; PG8_WAIT_L(0); PG8_MMA(0, 1, At, B1); PG8_BAR;
            PG8_LDA(At, 1, 1); PG8_STAGE(PG8_SA(1, 0), a3, voffA);
            PG8_BAR; PG8_WAIT_L(0); PG8_MMA(1, 0, At, B0); PG8_BAR; PG8_SCHED;
            PG8_STAGE(PG8_SB(1, 1), b3 + hstep, voffB);
            PG8_WAIT_V(6); PG8_BAR; PG8_MMA(1, 1, At, B1); PG8_BAR;
            }
        }
        if constexpr (ALIGN_EPI) { if (wr == 0) PG8_BAR; }
        if constexpr (!Epi::AFTER_DRAIN) { E(acc, cur, wr, wc, fr, fq); S.done(cur); }
        if (!has_next) break;
#pragma unroll
        for (int a = 0; a < 2; ++a)
#pragma unroll
            for (int b = 0; b < 2; ++b)
#pragma unroll
                for (int m = 0; m < 4; ++m)
#pragma unroll
                    for (int n = 0; n < 2; ++n) acc[a][b][m][n] = (f32x4){0.f, 0.f, 0.f, 0.f};
        cur = nxt; cA = nA; cB = nB; ++ui;
        if constexpr (ALIGN_EPI) { if (wr == 1) PG8_BAR; }
    }
    PG8_WAIT_V(0);
    if constexpr (!ALIGN_EPI) { if (wr == 0) PG8_BAR; }
    PG8_BAR;
    if constexpr (Epi::AFTER_DRAIN) { E.fused(acc, cur, wr, wc, fr, fq, lds, wid, lane); S.done(cur); }
#undef PG8_SA
#undef PG8_SB
#undef PG8_STAGE
#undef PG8_LDA
#undef PG8_LDB
#undef PG8_MMA
#undef PG8_WAIT_V
#undef PG8_WAIT_L
#undef PG8_BAR
#undef PG8_SCHED
}
}
#define PG8_SP2 true
#define PG8_ALIGN true

constexpr int NWAVES = 8, NTHR = 512;
constexpr int D = 1024, NB = 8, T = 4096, TC = 256, DEPTH = 4, FF = 2816, ZP = 2608, ZPAD = 2816;
constexpr int NLAT = NB * T, NCTX = NB * TC, NROWS = NLAT + NCTX;
constexpr int MODW = 9 * D;
constexpr int NKEY = TC + T;
constexpr float NORM_EPS = 1e-6f;
constexpr int ZS5 = 0, ZCQ = 256, ZCKV = 512, ZKR = 640, ZRKV = 672, ZWD = 1440, ZAD = 1472, ZGD = 1504, ZMQK = 1568, ZMV = 2080, ZMO = 2336, ZMG = 2592;

constexpr size_t MiB = 1u << 20;
constexpr size_t WS_CTL = 0, CTL_ZERO_BYTES = 1 * MiB;
constexpr size_t WS_MODV = 1 * MiB;
constexpr size_t WS_ROPE = 3 * MiB;
constexpr size_t WS_SMALLW = 4 * MiB;
constexpr size_t SW_UQ = 0, SW_UKV = 196608, SW_GLU = 327680, SW_GUP = 458752;
constexpr size_t WS_WGU = 6 * MiB, WS_WDN = 17 * MiB, WS_WIN = 23 * MiB, WS_WOUT = 29 * MiB;
constexpr size_t WS_X = 31 * MiB;
constexpr size_t WS_Y = 167 * MiB;
constexpr size_t WS_Q = WS_Y, WS_K = WS_Y + (size_t)NROWS * 384 * 2, WS_VT = WS_K + (size_t)NROWS * 384 * 2;
constexpr size_t WS_H = 235 * MiB;
constexpr size_t WS_ACT = 303 * MiB;
constexpr size_t WS_YS5 = 490 * MiB, WS_YR = 524 * MiB, WS_YM = 558 * MiB, WS_END = 592 * MiB;
static_assert(WS_VT + (size_t)NB * 4 * 64 * NKEY * 2 <= WS_H, "qkv overlay");
static_assert(WS_WGU + (size_t)5632 * 1024 * 2 <= WS_WDN && WS_WDN + (size_t)1024 * 2816 * 2 <= WS_WIN && WS_WIN + (size_t)2816 * 1024 * 2 <= WS_WOUT && WS_WOUT + 2 * MiB <= WS_X, "weights");
static_assert(WS_X + (size_t)NROWS * D * 4 <= WS_Y && WS_Y + (size_t)NROWS * D * 2 <= WS_H && WS_H + (size_t)NROWS * D * 2 <= WS_ACT && WS_ACT + (size_t)NROWS * ZPAD * 2 <= WS_YS5, "map");
static_assert(WS_YS5 + (size_t)2 * NROWS * 256 * 2 <= WS_YR && WS_YM + (size_t)2 * NROWS * 256 * 2 <= WS_END, "map2");
constexpr int CW_BAR = 4096;

constexpr int RING_BYTES = 131072, LDS_BYTES = 147456, LDSCTL_OFF = LDS_BYTES - 512, MISC_OFF = LDSCTL_OFF + 320;

#define GAS __attribute__((address_space(1)))
#define LAS __attribute__((address_space(3)))
typedef unsigned short bf16;
typedef unsigned char uchar;
typedef unsigned v4u __attribute__((ext_vector_type(4)));
typedef unsigned v2u __attribute__((ext_vector_type(2)));
typedef float f32x4 __attribute__((ext_vector_type(4)));
typedef float f32x16 __attribute__((ext_vector_type(16)));
typedef short bf16x8 __attribute__((ext_vector_type(8)));
typedef short bf16x4 __attribute__((ext_vector_type(4)));
#define DI __device__ __forceinline__
DI unsigned f2bf(float f) { unsigned u = __builtin_bit_cast(unsigned, f); return (u + 0x7fffu + ((u >> 16) & 1u)) >> 16; }
DI unsigned pk2(float lo, float hi) { return pg8::cvt_pk_bf16(lo, hi); }
DI float bf2f(unsigned b) { return __builtin_bit_cast(float, b << 16); }
DI float bflo(unsigned w) { return __builtin_bit_cast(float, w << 16); }
DI float bfhi(unsigned w) { return __builtin_bit_cast(float, w & 0xffff0000u); }
template <int CTRL> DI float dpp_f(float x) { return __builtin_bit_cast(float, __builtin_amdgcn_update_dpp(0, __builtin_bit_cast(int, x), CTRL, 0xf, 0xf, true)); }
DI float sum8(float x) { x += dpp_f<0xB1>(x); x += dpp_f<0x4E>(x); x += dpp_f<0x141>(x); return x; }
DI float sum16(float x) { x = sum8(x); x += dpp_f<0x140>(x); return x; }
DI float wave_sum(float v) { v = sum16(v); v += __shfl_xor(v, 16); v += __shfl_xor(v, 32); return v; }
DI float wave_max(float v) {
#pragma unroll
    for (int o = 1; o < 64; o <<= 1) v = fmaxf(v, __shfl_xor(v, o));
    return v;
}
DI float fexp(float x) { return __builtin_amdgcn_exp2f(x * 1.44269504089f); }
DI float fsigmoid(float x) { return __builtin_amdgcn_rcpf(1.0f + fexp(-x)); }
DI f32x16 mfma32(bf16x8 a, bf16x8 b, f32x16 c) { return __builtin_amdgcn_mfma_f32_32x32x16_bf16(a, b, c, 0, 0, 0); }
DI f32x4 mfma16(bf16x8 a, bf16x8 b, f32x4 c) { return __builtin_amdgcn_mfma_f32_16x16x32_bf16(a, b, c, 0, 0, 0); }
DI int crow(int r, int h) { return (r & 3) + 8 * (r >> 2) + 4 * h; }
DI bf16x8 pack8(float a0, float a1, float a2, float a3, float a4, float a5, float a6, float a7) {
    typedef __bf16 nb8 __attribute__((ext_vector_type(8))); typedef float nf8 __attribute__((ext_vector_type(8)));
    const nf8 v = {a0, a1, a2, a3, a4, a5, a6, a7}; return __builtin_bit_cast(bf16x8, __builtin_convertvector(v, nb8));
}
DI void my_sincosf(float x, float& s, float& c) {
    const float k = __builtin_rintf(x * 0.63661977236758134f);
    float r = __builtin_fmaf(-k, 1.5703125f, x); r = __builtin_fmaf(-k, 4.837512969970703125e-4f, r); r = __builtin_fmaf(-k, 7.54978995489188216e-8f, r);
    const float r2 = r * r;
    const float ps = r + r * r2 * (-1.6666654611e-1f + r2 * (8.3321608736e-3f + r2 * (-1.9515295891e-4f)));
    const float pc = 1.0f - 0.5f * r2 + r2 * r2 * (4.166664568298827e-2f + r2 * (-1.388731625493765e-3f + r2 * 2.443315711809948e-5f));
    const int q = ((int)k) & 3;
    const float ss = (q & 1) ? pc : ps, cc = (q & 1) ? ps : pc;
    s = (q & 2) ? -ss : ss; c = ((q + 1) & 2) ? -cc : cc;
}

#define XB_TMO      128
#define XB_XCNT(j)  (256  + 64 * (j))
#define XB_XSUB(j)  (1280 + 64 * (j))
#define XB_XGEN(j)  (2304 + 64 * (j))
#define XB_TOP      3328
#define XB_TOPGEN   3392
#define XCD_BAR_WORDS 3456
#define XB_SPIN_CAP (1u << 22)
DI unsigned xb_ld(unsigned* p)              { return __hip_atomic_load(p, __ATOMIC_RELAXED, __HIP_MEMORY_SCOPE_AGENT); }
DI unsigned xb_add(unsigned* p, unsigned v) { return __hip_atomic_fetch_add(p, v, __ATOMIC_RELAXED, __HIP_MEMORY_SCOPE_AGENT); }
DI unsigned xb_xcc_id() { return (unsigned)__builtin_amdgcn_s_getreg((3 << 11) | 20) & 0xFu; }
#define XB_SPIN(cond, bar) do { unsigned _sp = 0; while (cond) { __builtin_amdgcn_s_sleep(1); \
    if ((++_sp & 255u) == 0u) { if (xb_ld(&(bar)[XB_TMO])) break; if (_sp > XB_SPIN_CAP) { atomicAdd(&(bar)[XB_TMO], 1u); break; } } } } while (0)
struct XcdBarrier { unsigned* bar; unsigned x; volatile LAS unsigned* st; };
DI XcdBarrier xcd_barrier_post(unsigned* bar, volatile LAS unsigned* st, bool t0) {
    XcdBarrier b; b.bar = bar; b.x = xb_xcc_id(); b.st = st;
    if (t0) (void)xb_add(&bar[XB_XCNT(b.x)], 1u);
    return b;
}
DI void xcd_barrier_complete(unsigned* bar, unsigned x, unsigned& nloc, unsigned& nx) {
    const unsigned G = gridDim.x * gridDim.y * gridDim.z;
    unsigned sum, cnt, mine, sp = 0u;
    for (;;) {
        sum = 0u; cnt = 0u; mine = 0u;
#pragma unroll
        for (unsigned j = 0; j < 16; ++j) { const unsigned c = xb_ld(&bar[XB_XCNT(j)]); sum += c; cnt += (c > 0u) ? 1u : 0u; mine = (j == x) ? c : mine; }
        if (sum == G) break;
        __builtin_amdgcn_s_sleep(1);
        if ((++sp & 255u) == 0u) { if (xb_ld(&bar[XB_TMO])) break; if (sp > XB_SPIN_CAP) { atomicAdd(&bar[XB_TMO], 1u); break; } }
    }
    nloc = mine > 0u ? mine : 1u; nx = cnt > 0u ? cnt : 1u;
}
DI void xcd_barrier(const XcdBarrier& b, bool t0) {
    asm volatile("s_waitcnt vmcnt(0)" ::: "memory");
    __syncthreads();
    if (t0) {
        unsigned* bar = b.bar;
        __builtin_amdgcn_s_waitcnt(0);
        unsigned nloc = b.st[0], nx = b.st[1];
        if (nloc == 0u) { xcd_barrier_complete(bar, b.x, nloc, nx); b.st[0] = nloc; b.st[1] = nx; }
        const unsigned old = xb_add(&bar[XB_XSUB(b.x)], 1u);
        const unsigned gen = old / nloc;
        if (old + 1u == (gen + 1u) * nloc) {
            __builtin_amdgcn_fence(__ATOMIC_RELEASE, "agent");
            asm volatile("s_waitcnt vmcnt(0)" ::: "memory");
            const unsigned og = xb_add(&bar[XB_TOP], 1u);
            const unsigned tg = og / nx;
            if (og + 1u == (tg + 1u) * nx) xb_add(&bar[XB_TOPGEN], 1u);
            else XB_SPIN(xb_ld(&bar[XB_TOPGEN]) == tg, bar);
            __builtin_amdgcn_fence(__ATOMIC_ACQUIRE, "agent");
            xb_add(&bar[XB_XGEN(b.x)], 1u);
            asm volatile("s_waitcnt vmcnt(0)" ::: "memory");
        } else {
            XB_SPIN(xb_ld(&bar[XB_XGEN(b.x)]) == gen, bar);
            __builtin_amdgcn_fence(__ATOMIC_ACQUIRE, "agent");
            asm volatile("s_waitcnt vmcnt(0)" ::: "memory");
        }
    }
    __syncthreads();
}

struct Args { const float* in[43]; float* out; unsigned char* ws; int ph_lo, ph_hi, use_bar, pad; };
typedef const __attribute__((address_space(4))) Args* KArgs;
enum { I_X = 0, I_C, I_CTX, I_CCTX, I_WADA, I_BADA, I_NPRE, I_NPOST, I_WG, I_WU, I_WD, I_WIN, I_WOUT, I_S5LRE, I_S5LIM, I_S5DT, I_S5BRE, I_S5BIM, I_S5CRE, I_S5CIM, I_S5D, I_S5GLU, I_S5BGLU,
       I_MQN, I_MKVN, I_MUQ, I_MUKV, I_RCW, I_RCB, I_RW0, I_RWUP, I_RA0, I_RAUP, I_RGUP, I_RKK, I_RKA, I_RRK, I_RLNW, I_RLNB, I_MCW, I_MCB, I_MGB, I_MNORM };

struct Ctx {
    LAS uchar* lds; int tid, lane, wave, vcu, G;
};
DI int tok_row(int b, int seg, int t) { return seg ? b * T + t : NLAT + b * TC + t; }
DI void phase_prologue(KArgs a, const Ctx& F) {
    LAS float* sc = (LAS float*)F.lds;
    LAS float* red = (LAS float*)(F.lds + 40960);
    const float* c = a->in[I_C]; const float* cc = a->in[I_CCTX];
    for (int i = F.tid; i < 9 * D; i += NTHR) { const float v = (i < 8 * D) ? c[i] : cc[i - 8 * D]; sc[i] = v * fsigmoid(v); }
    __syncthreads();
    const float* wada = a->in[I_WADA]; const float* bada = a->in[I_BADA];
    float* modv = (float*)(a->ws + WS_MODV);
    for (int task = F.vcu; task < DEPTH * 144; task += F.G) {
        const int l = task / 144, nb = task % 144, n = nb * 64 + F.lane;
        const float* wp = wada + ((size_t)l * D + F.wave * 128) * MODW + n;
        float acc[9];
#pragma unroll
        for (int m = 0; m < 9; ++m) acc[m] = 0.f;
#pragma unroll 8
        for (int k = 0; k < 128; ++k) { const float w = wp[(size_t)k * MODW];
#pragma unroll
            for (int m = 0; m < 9; ++m) acc[m] += sc[m * D + F.wave * 128 + k] * w; }
#pragma unroll
        for (int m = 0; m < 9; ++m) red[(F.wave * 9 + m) * 64 + F.lane] = acc[m];
        __syncthreads();
        for (int i = F.tid; i < 576; i += NTHR) { const int m = i >> 6, ln = i & 63; float s = 0.f;
#pragma unroll
            for (int w = 0; w < 8; ++w) s += red[(w * 9 + m) * 64 + ln];
            modv[((size_t)l * 9 + m) * MODW + nb * 64 + ln] = s + bada[l * MODW + nb * 64 + ln]; }
        __syncthreads();
    }
    float* rc = (float*)(a->ws + WS_ROPE); float* rs = rc + T * 16;
    for (int i = F.vcu * NTHR + F.tid; i < T * 16; i += F.G * NTHR) {
        const int t = i >> 4, f = i & 15, pos = f < 8 ? (t >> 6) : (t & 63), fi = f & 7;
        const float invf = (fi == 0) ? 1.0f : (fi == 1) ? 0.31622776601683794f : (fi == 2) ? 0.1f : (fi == 3) ? 0.031622776601683794f : (fi == 4) ? 0.01f : (fi == 5) ? 0.0031622776601683794f : (fi == 6) ? 0.001f : 0.00031622776601683794f;
        const float ang = (float)pos * invf; float s, co; my_sincosf(ang, s, co);
        rc[i] = co; rs[i] = s;
    }
}

DI void tr_item(const float* W, int K, int N, bf16* WT, int kb, int n0, int drow0, LAS float* scr, int lane) {
    const int k0 = 64 * kb, nn = n0 + (lane & 31);
#pragma unroll 8
    for (int i = 0; i < 32; ++i) { const int kk = 2 * i + (lane >> 5); scr[kk * 33 + (lane & 31)] = (nn < N) ? W[(size_t)(k0 + kk) * N + nn] : 0.f; }
    const int c = lane & 7;
#pragma unroll
    for (int j = 0; j < 4; ++j) { const int n = (lane >> 3) + 8 * j; const LAS float* s = scr + (8 * c) * 33 + n;
        v4u o; o.x = pk2(s[0 * 33], s[1 * 33]); o.y = pk2(s[2 * 33], s[3 * 33]); o.z = pk2(s[4 * 33], s[5 * 33]); o.w = pk2(s[6 * 33], s[7 * 33]);
        if (n0 + n < N) *(v4u*)(WT + (size_t)(drow0 + n) * K + k0 + 8 * c) = o; }
}
DI void convert_weights(KArgs a, const Ctx& F, int l, int set) {
    LAS float* scr = (LAS float*)(F.lds + F.wave * 8704);
    const int gw = F.vcu * NWAVES + F.wave, NGW = F.G * NWAVES;
    bf16* WGU = (bf16*)(a->ws + WS_WGU); bf16* WDN = (bf16*)(a->ws + WS_WDN); bf16* WIN = (bf16*)(a->ws + WS_WIN); bf16* WOUT = (bf16*)(a->ws + WS_WOUT);
    bf16* SW = (bf16*)(a->ws + WS_SMALLW);
    const int fl = l * 2 + set;
    const float* wg = a->in[I_WG] + (size_t)fl * D * FF; const float* wu = a->in[I_WU] + (size_t)fl * D * FF; const float* wd = a->in[I_WD] + (size_t)fl * FF * D;
    constexpr int I_G = 16 * 88, I_D = 44 * 32, I_IN = 16 * 82, I_O = 16 * 32, I_UQ = 4 * 12, I_UKV = 2 * 16, I_GLU = 4 * 8, I_GUP = 1 * 8;
    const int nitems = set == 0 ? (2 * I_G + I_D + I_IN + I_O + I_UQ + I_UKV + I_GLU + I_GUP) : (2 * I_G + I_D);
    for (int it = gw; it < nitems; it += NGW) {
        int r = it;
        if (r < I_G) { const int kb = r / 88, nb = r % 88, n0 = 32 * nb; tr_item(wg, D, FF, WGU, kb, n0, 256 * (n0 >> 7) + (n0 & 127), scr, F.lane); continue; } r -= I_G;
        if (r < I_G) { const int kb = r / 88, nb = r % 88, n0 = 32 * nb; tr_item(wu, D, FF, WGU, kb, n0, 256 * (n0 >> 7) + 128 + (n0 & 127), scr, F.lane); continue; } r -= I_G;
        if (r < I_D) { const int kb = r / 32, nb = r % 32; tr_item(wd, FF, D, WDN, kb, 32 * nb, 32 * nb, scr, F.lane); continue; } r -= I_D;
        if (r < I_IN) { const int kb = r / 82, nb = r % 82; tr_item(a->in[I_WIN] + (size_t)l * D * ZP, D, ZP, WIN, kb, 32 * nb, 32 * nb, scr, F.lane); continue; } r -= I_IN;
        if (r < I_O) { const int kb = r / 32, nb = r % 32; tr_item(a->in[I_WOUT] + (size_t)l * D * D, D, D, WOUT, kb, 32 * nb, 32 * nb, scr, F.lane); continue; } r -= I_O;
        if (r < I_UQ) { const int kb = r / 12, nb = r % 12; tr_item(a->in[I_MUQ] + (size_t)l * 256 * 384, 256, 384, (bf16*)((uchar*)SW + SW_UQ), kb, 32 * nb, 32 * nb, scr, F.lane); continue; } r -= I_UQ;
        if (r < I_UKV) { const int kb = r / 16, nb = r % 16; tr_item(a->in[I_MUKV] + (size_t)l * 128 * 512, 128, 512, (bf16*)((uchar*)SW + SW_UKV), kb, 32 * nb, 32 * nb, scr, F.lane); continue; } r -= I_UKV;
        if (r < I_GLU) { const int kb = r / 8, nb = r % 8; tr_item(a->in[I_S5GLU] + (size_t)l * 256 * 256, 256, 256, (bf16*)((uchar*)SW + SW_GLU), kb, 32 * nb, 32 * nb, scr, F.lane); continue; } r -= I_GLU;
        { const int nb = r; tr_item(a->in[I_RGUP] + (size_t)l * 64 * 256, 64, 256, (bf16*)((uchar*)SW + SW_GUP), 0, 32 * nb, 32 * nb, scr, F.lane); }
    }
    if (set == 0) {
        unsigned zz_ = 0u; asm volatile("" : "+v"(zz_)); v4u z = {zz_, zz_, zz_, zz_}; v4u* p = (v4u*)(WIN + (size_t)ZP * D);
        for (int i = F.vcu * NTHR + F.tid; i < (ZPAD - ZP) * D / 8; i += F.G * NTHR) p[i] = z;
    }
}

DI void norm_rows(KArgs a, const Ctx& F, bool p_first, bool p_hasY, bool p_hasH, bool p_final, int p_nrows, const float* p_modY, int p_gi, const float* p_pw, float p_coef, const float* p_modH, int p_si, const float* p_prew) {
    float* X = (float*)(a->ws + WS_X); const bf16* Y = (const bf16*)(a->ws + WS_Y); bf16* H = (bf16*)(a->ws + WS_H);
    const int gw = F.vcu * NWAVES + F.wave, NGW = F.G * NWAVES, lane = F.lane;
    for (int r = gw; r < p_nrows; r += NGW) {
        const int mr = r < NLAT ? (r >> 12) : 8;
        const float* xs = p_first ? (r < NLAT ? a->in[I_X] + (size_t)r * D : a->in[I_CTX] + (size_t)(r - NLAT) * D) : X + (size_t)r * D;
        f32x4 v[4];
#pragma unroll
        for (int j = 0; j < 4; ++j) v[j] = *(const f32x4*)(xs + 4 * lane + 256 * j);
        if (p_hasY) {
            f32x4 y[4]; float ss = 0.f;
#pragma unroll
            for (int j = 0; j < 4; ++j) { const v2u w = *(const v2u*)(Y + (size_t)r * D + 4 * lane + 256 * j); y[j] = (f32x4){bflo(w.x), bfhi(w.x), bflo(w.y), bfhi(w.y)};
                ss += (y[j].x * y[j].x + y[j].y * y[j].y) + (y[j].z * y[j].z + y[j].w * y[j].w); }
            const float rstd = 1.0f / sqrtf(wave_sum(ss) * (1.0f / D) + NORM_EPS);
            const float* g = p_modY + (size_t)mr * MODW + p_gi * D;
#pragma unroll
            for (int j = 0; j < 4; ++j) { const f32x4 gg = *(const f32x4*)(g + 4 * lane + 256 * j), ww = *(const f32x4*)(p_pw + 4 * lane + 256 * j);
                v[j] = v[j] + (gg * p_coef) * ((y[j] * rstd) * ww); }
        }
        if (p_final) {
#pragma unroll
            for (int j = 0; j < 4; ++j) *(f32x4*)(a->out + (size_t)r * D + 4 * lane + 256 * j) = v[j];
        } else if (p_hasY || p_first) {
#pragma unroll
            for (int j = 0; j < 4; ++j) *(f32x4*)(X + (size_t)r * D + 4 * lane + 256 * j) = v[j];
        }
        if (p_hasH) {
            float ss = 0.f;
#pragma unroll
            for (int j = 0; j < 4; ++j) ss += (v[j].x * v[j].x + v[j].y * v[j].y) + (v[j].z * v[j].z + v[j].w * v[j].w);
            const float rstd = 1.0f / sqrtf(wave_sum(ss) * (1.0f / D) + NORM_EPS);
            const float* sh = p_modH + (size_t)mr * MODW + p_si * D; const float* scp = sh + D;
#pragma unroll
            for (int j = 0; j < 4; ++j) { const f32x4 ww = *(const f32x4*)(p_prew + 4 * lane + 256 * j), s1 = *(const f32x4*)(scp + 4 * lane + 256 * j), s0 = *(const f32x4*)(sh + 4 * lane + 256 * j);
                const f32x4 h = ((v[j] * rstd) * ww) * (s1 + 1.0f) + s0;
                v2u o; o.x = pk2(h.x, h.y); o.y = pk2(h.z, h.w); *(v2u*)(H + (size_t)r * D + 4 * lane + 256 * j) = o; }
        }
    }
}
template <int K, int NBK, int MBK, bool TRANS>
DI void small_gemm(const LAS bf16* A, int apitch, const bf16* Wt, int n0w, f32x4 (&acc)[NBK][MBK], int lane) {
    const int lr = lane & 15, kq = lane >> 4;
#pragma unroll
    for (int nb = 0; nb < NBK; ++nb)
#pragma unroll
        for (int mb = 0; mb < MBK; ++mb) acc[nb][mb] = (f32x4){0.f, 0.f, 0.f, 0.f};
#pragma unroll 2
    for (int s = 0; s < K / 32; ++s) {
        bf16x8 av[MBK];
#pragma unroll
        for (int mb = 0; mb < MBK; ++mb) av[mb] = *(const LAS bf16x8*)(A + (16 * mb + lr) * apitch + 32 * s + 8 * kq);
#pragma unroll
        for (int nb = 0; nb < NBK; ++nb) { const bf16x8 w = *(const bf16x8*)(Wt + (size_t)(n0w + 16 * nb + lr) * K + 32 * s + 8 * kq);
#pragma unroll
            for (int mb = 0; mb < MBK; ++mb) acc[nb][mb] = TRANS ? mfma16(w, av[mb], acc[nb][mb]) : mfma16(av[mb], w, acc[nb][mb]); }
    }
}

struct S5C { float ar, ai, fr, fi; };
static __device__ __noinline__ S5C s5_coef(const float* lre, const float* lim, float dt, int nn) {
    const float lr = lre[nn], li = lim[nn], x = lr * dt;
    const float em = x * (1.0f + x * (0.5f + x * (0.16666667f + x * (0.041666668f + x * 0.0083333338f))));
    float sh, ch; my_sincosf(0.5f * li * dt, sh, ch);
    const float cm1 = -2.0f * sh * sh, sn = 2.0f * sh * ch;
    const float arm1 = em * (1.0f + cm1) + cm1;
    S5C o; o.ai = (1.0f + em) * sn; o.ar = 1.0f + arm1;
    const float den = lr * lr + li * li;
    o.fr = (arm1 * lr + o.ai * li) / den; o.fi = (o.ai * lr - arm1 * li) / den;
    return o;
}
DI void s5_scan_task(KArgs a, int l, int b, int dir, int g, LAS bf16* wl  , int lane) {
    const bf16* Z = (const bf16*)(a->ws + WS_ACT); bf16* YS = (bf16*)(a->ws + WS_YS5) + (size_t)dir * NROWS * 256;
    const int pg = (l * 2 + dir) * 16 + g;
    const float* lre = a->in[I_S5LRE] + pg * 64; const float* lim = a->in[I_S5LIM] + pg * 64;
    const float dt = __expf(a->in[I_S5DT][pg]);
    const S5C c0_ = s5_coef(lre, lim, dt, lane); const float ar = c0_.ar, ai = c0_.ai;
    bf16x8 Bf[4];
    { const int hh = lane >> 5;
#pragma unroll
      for (int nblk = 0; nblk < 2; ++nblk) { const int nn = 32 * nblk + (lane & 31); const S5C cn_ = s5_coef(lre, lim, dt, nn); const float fr = cn_.fr, fi = cn_.fi;
        const float* bre = a->in[I_S5BRE] + ((size_t)pg * 64 + nn) * 16 + 8 * hh; const float* bim = a->in[I_S5BIM] + ((size_t)pg * 64 + nn) * 16 + 8 * hh;
        float re[8], im[8];
#pragma unroll
        for (int j = 0; j < 8; ++j) { re[j] = fr * bre[j] - fi * bim[j]; im[j] = fi * bre[j] + fr * bim[j]; }
        Bf[nblk] = pack8(re[0], re[1], re[2], re[3], re[4], re[5], re[6], re[7]); Bf[2 + nblk] = pack8(im[0], im[1], im[2], im[3], im[4], im[5], im[6], im[7]); } }
    bf16x8 Cf[4];
    { const int p = lane & 15, q = lane >> 4;
#pragma unroll
      for (int s = 0; s < 4; ++s) { const int kc = 32 * s + 8 * q; float cv[8];
        const float* src = (s < 2) ? a->in[I_S5CRE] + ((size_t)pg * 16 + p) * 64 + kc : a->in[I_S5CIM] + ((size_t)pg * 16 + p) * 64 + (kc - 64);
        const float sg = (s < 2) ? 1.f : -1.f;
#pragma unroll
        for (int j = 0; j < 8; ++j) cv[j] = sg * src[j];
        Cf[s] = pack8(cv[0], cv[1], cv[2], cv[3], cv[4], cv[5], cv[6], cv[7]); } }
    float sr = 0.f, si = 0.f;
    const int hh = lane >> 5, li5 = lane & 31, q = lane >> 4, t16 = lane & 15;
    const f32x16 zero16 = {0.f, 0.f, 0.f, 0.f, 0.f, 0.f, 0.f, 0.f, 0.f, 0.f, 0.f, 0.f, 0.f, 0.f, 0.f, 0.f};
    const int nchC = TC / 32, nchT = nchC + T / 32;
    auto afload = [&](int gc) -> bf16x8 {
        const int seg = gc >= nchC, ch = seg ? gc - nchC : gc, len = seg ? T : TC;
        const int sidx = 32 * ch + li5, tt = dir ? (len - 1 - sidx) : sidx;
        return *(const bf16x8*)(Z + (size_t)tok_row(b, seg, tt) * ZP + ZS5 + g * 16 + 8 * hh);
    };
    bf16x8 afn = afload(0);
    for (int gc = 0; gc < nchT; ++gc) {
        const int seg = gc >= nchC, ch = seg ? gc - nchC : gc, len = seg ? T : TC;
        {
            const bf16x8 af = afn;
            if (gc + 1 < nchT) afn = afload(gc + 1);
            f32x16 d1 = mfma32(af, Bf[0], zero16), d2 = mfma32(af, Bf[1], zero16), d3 = mfma32(af, Bf[2], zero16), d4 = mfma32(af, Bf[3], zero16);
            float xa[16], xb[16], ya[16], yb[16];
#pragma unroll
            for (int r = 0; r < 16; ++r) {
                auto r1 = __builtin_amdgcn_permlane32_swap(__float_as_uint(d1[r]), __float_as_uint(d2[r]), false, false); xa[r] = __uint_as_float(r1[0]); xb[r] = __uint_as_float(r1[1]);
                auto r2 = __builtin_amdgcn_permlane32_swap(__float_as_uint(d3[r]), __float_as_uint(d4[r]), false, false); ya[r] = __uint_as_float(r2[0]); yb[r] = __uint_as_float(r2[1]); }
#pragma unroll
            for (int i = 0; i < 32; ++i) {
                const int r = 4 * (i >> 3) + (i & 3); const bool hi = (i >> 2) & 1;
                const float xre = hi ? xb[r] : xa[r], xim = hi ? yb[r] : ya[r];
                const float nsr = ar * sr - ai * si + xre, nsi = ar * si + ai * sr + xim; sr = nsr; si = nsi;
                wl[i * 136 + lane] = (bf16)f2bf(sr); wl[i * 136 + 64 + lane] = (bf16)f2bf(si);
            }
#pragma unroll
            for (int tb = 0; tb < 2; ++tb) {
                f32x4 acc = {0.f, 0.f, 0.f, 0.f};
#pragma unroll
                for (int s = 0; s < 4; ++s) { const bf16x8 bfr = *(const LAS bf16x8*)(wl + (16 * tb + t16) * 136 + 32 * s + 8 * q); acc = mfma16(Cf[s], bfr, acc); }
                const int so = 32 * ch + 16 * tb + t16, to = dir ? (len - 1 - so) : so;
                v2u o; o.x = pk2(acc[0], acc[1]); o.y = pk2(acc[2], acc[3]);
                *(v2u*)(YS + (size_t)tok_row(b, seg, to) * 256 + g * 16 + 4 * q) = o;
            }
        }
    }
}

DI void mla_prep_tile(KArgs a, const Ctx& F, int l, int tile) {
    const bf16* Z = (const bf16*)(a->ws + WS_ACT);
    bf16* Q = (bf16*)(a->ws + WS_Q); bf16* Kf = (bf16*)(a->ws + WS_K); bf16* Vt = (bf16*)(a->ws + WS_VT);
    const bf16* WUQ = (const bf16*)(a->ws + WS_SMALLW + SW_UQ); const bf16* WUKV = (const bf16*)(a->ws + WS_SMALLW + SW_UKV);
    const float* rc = (const float*)(a->ws + WS_ROPE); const float* rs = rc + T * 16;
    LAS bf16* Aq = (LAS bf16*)F.lds;
    LAS bf16* Akv = (LAS bf16*)(F.lds + 64 * 264 * 2);
    const int row0 = tile * 64, tid = F.tid, lane = F.lane, wave = F.wave;
    const bool lat = row0 < NLAT;
    {
        const int i = tid >> 3, part = tid & 7, row = row0 + i;
        const bf16* zr = Z + (size_t)row * ZP;
        float q[32], kv[16]; float sq = 0.f, sk = 0.f;
#pragma unroll
        for (int j = 0; j < 4; ++j) { const v4u w = *(const v4u*)(zr + ZCQ + part * 32 + 8 * j);
            q[8 * j + 0] = bflo(w.x); q[8 * j + 1] = bfhi(w.x); q[8 * j + 2] = bflo(w.y); q[8 * j + 3] = bfhi(w.y); q[8 * j + 4] = bflo(w.z); q[8 * j + 5] = bfhi(w.z); q[8 * j + 6] = bflo(w.w); q[8 * j + 7] = bfhi(w.w); }
#pragma unroll
        for (int j = 0; j < 2; ++j) { const v4u w = *(const v4u*)(zr + ZCKV + part * 16 + 8 * j);
            kv[8 * j + 0] = bflo(w.x); kv[8 * j + 1] = bfhi(w.x); kv[8 * j + 2] = bflo(w.y); kv[8 * j + 3] = bfhi(w.y); kv[8 * j + 4] = bflo(w.z); kv[8 * j + 5] = bfhi(w.z); kv[8 * j + 6] = bflo(w.w); kv[8 * j + 7] = bfhi(w.w); }
#pragma unroll
        for (int j = 0; j < 32; ++j) sq += q[j] * q[j];
#pragma unroll
        for (int j = 0; j < 16; ++j) sk += kv[j] * kv[j];
        sq += __shfl_xor(sq, 1); sq += __shfl_xor(sq, 2); sq += __shfl_xor(sq, 4);
        sk += __shfl_xor(sk, 1); sk += __shfl_xor(sk, 2); sk += __shfl_xor(sk, 4);
        const float rq = 1.0f / sqrtf(sq * (1.0f / 256.0f) + NORM_EPS), rk = 1.0f / sqrtf(sk * (1.0f / 128.0f) + NORM_EPS);
        const float* qn = a->in[I_MQN] + l * 256 + part * 32; const float* kn = a->in[I_MKVN] + l * 128 + part * 16;
#pragma unroll
        for (int j = 0; j < 32; j += 2) *(LAS unsigned*)(Aq + i * 264 + part * 32 + j) = pk2(q[j] * rq * qn[j], q[j + 1] * rq * qn[j + 1]);
#pragma unroll
        for (int j = 0; j < 16; j += 2) *(LAS unsigned*)(Akv + i * 136 + part * 16 + j) = pk2(kv[j] * rk * kn[j], kv[j + 1] * rk * kn[j + 1]);
        if (part == 0) {
            float kr[32];
#pragma unroll
            for (int j = 0; j < 4; ++j) { const v4u w = *(const v4u*)(zr + ZKR + 8 * j);
                kr[8 * j + 0] = bflo(w.x); kr[8 * j + 1] = bfhi(w.x); kr[8 * j + 2] = bflo(w.y); kr[8 * j + 3] = bfhi(w.y); kr[8 * j + 4] = bflo(w.z); kr[8 * j + 5] = bfhi(w.z); kr[8 * j + 6] = bflo(w.w); kr[8 * j + 7] = bfhi(w.w); }
            float o[32];
            if (lat) { const int t = row & (T - 1);
#pragma unroll
                for (int hf = 0; hf < 2; ++hf)
#pragma unroll
                    for (int j = 0; j < 8; ++j) { const float c = rc[t * 16 + hf * 8 + j], s = rs[t * 16 + hf * 8 + j]; const float x0 = kr[hf * 16 + j], x1 = kr[hf * 16 + 8 + j];
                        o[hf * 16 + j] = x0 * c - x1 * s; o[hf * 16 + 8 + j] = x1 * c + x0 * s; }
            } else {
#pragma unroll
                for (int j = 0; j < 32; ++j) o[j] = kr[j];
            }
#pragma unroll
            for (int hd = 0; hd < 4; ++hd) { bf16* kp = Kf + (size_t)row * 384 + hd * 96 + 64;
#pragma unroll
                for (int j = 0; j < 4; ++j) { v4u w; w.x = pk2(o[8 * j], o[8 * j + 1]); w.y = pk2(o[8 * j + 2], o[8 * j + 3]); w.z = pk2(o[8 * j + 4], o[8 * j + 5]); w.w = pk2(o[8 * j + 6], o[8 * j + 7]); *(v4u*)(kp + 8 * j) = w; } }
        }
    }
    __syncthreads();
    const int lr = lane & 15, kq = lane >> 4;
    {
        f32x4 acc[3][4];
        small_gemm<256, 3, 4, true>(Aq, 264, WUQ, 48 * wave, acc, lane);
        const float qs = 0.10206207261596577f * 1.44269504089f;
#pragma unroll
        for (int nb = 0; nb < 3; ++nb) { const int blk = 3 * wave + nb, hb = blk % 6;
#pragma unroll
            for (int mb = 0; mb < 4; ++mb) { const int row = row0 + 16 * mb + lr; f32x4 v = acc[nb][mb];
                if (hb >= 4) {
                    f32x4 pv; pv.x = __shfl_xor(v.x, 32); pv.y = __shfl_xor(v.y, 32); pv.z = __shfl_xor(v.z, 32); pv.w = __shfl_xor(v.w, 32);
                    if (lat) { const int t = row & (T - 1); const int fb = (hb - 4) * 8 + 4 * (kq & 1);
                        const f32x4 c = *(const f32x4*)(rc + t * 16 + fb), s = *(const f32x4*)(rs + t * 16 + fb);
                        v = (kq < 2) ? (v * c - pv * s) : (v * c + pv * s); }
                }
                v = v * qs;
                v2u o; o.x = pk2(v.x, v.y); o.y = pk2(v.z, v.w);
                *(v2u*)(Q + (size_t)row * 384 + 16 * blk + 4 * kq) = o; } }
    }
    {
        const int hd = wave >> 1;
        if ((wave & 1) == 0) {
            f32x4 acc[4][4];
            small_gemm<128, 4, 4, true>(Akv, 136, WUKV, 64 * wave, acc, lane);
#pragma unroll
            for (int nb = 0; nb < 4; ++nb)
#pragma unroll
                for (int mb = 0; mb < 4; ++mb) { const int row = row0 + 16 * mb + lr; const f32x4 v = acc[nb][mb];
                    v2u o; o.x = pk2(v.x, v.y); o.y = pk2(v.z, v.w);
                    *(v2u*)(Kf + (size_t)row * 384 + hd * 96 + 16 * nb + 4 * kq) = o; }
        } else {
            f32x4 acc[4][4];
            small_gemm<128, 4, 4, false>(Akv, 136, WUKV, 64 * wave, acc, lane);
            const int bb = lat ? (row0 >> 12) : ((row0 - NLAT) >> 8);
            const int key0 = lat ? (TC + (row0 & (T - 1))) : ((row0 - NLAT) & (TC - 1));
#pragma unroll
            for (int nb = 0; nb < 4; ++nb)
#pragma unroll
                for (int mb = 0; mb < 4; ++mb) { const f32x4 v = acc[nb][mb];
                    v2u o; o.x = pk2(v.x, v.y); o.y = pk2(v.z, v.w);
                    *(v2u*)(Vt + ((size_t)(bb * 4 + hd) * 64 + 16 * nb + lr) * NKEY + key0 + 16 * mb + 4 * kq) = o; }
        }
    }
    __syncthreads();
}

DI void attn_unit(KArgs a, const Ctx& F, int b, int hd, int qrow0, int nkeys) {
    const bf16* Q = (const bf16*)(a->ws + WS_Q); const bf16* Kf = (const bf16*)(a->ws + WS_K); const bf16* Vt = (const bf16*)(a->ws + WS_VT);
    bf16* MO = (bf16*)(a->ws + WS_H);
    constexpr int KP = 208, VP = 144, BUF = 64 * KP + 64 * VP;
    const int tid = F.tid, lane = F.lane, wave = F.wave, l31 = lane & 31, h2 = lane >> 5;
    const int qrow = qrow0 + 32 * wave + l31;
    bf16x8 Qf[6];
#pragma unroll
    for (int s = 0; s < 6; ++s) Qf[s] = *(const bf16x8*)(Q + (size_t)qrow * 384 + hd * 96 + 16 * s + 8 * h2);
    const int kc0 = tid, kc1 = tid + 512;
    const int kr0 = kc0 / 12, kcc0 = kc0 % 12, kr1 = kc1 / 12, kcc1 = kc1 % 12; const bool k1v = kc1 < 768;
    const int vd = tid >> 3, vcc = tid & 7;
    const bf16* vbase = Vt + ((size_t)(b * 4 + hd) * 64 + vd) * NKEY + vcc * 8;
    v4u gk0, gk1, gv;
    auto gload = [&](int kt) {
        const int key0 = 64 * kt; const int krow = key0 < TC ? (NLAT + b * TC + key0) : (b * T + key0 - TC);
        gk0 = *(const v4u*)(Kf + (size_t)(krow + kr0) * 384 + hd * 96 + kcc0 * 8);
        if (k1v) gk1 = *(const v4u*)(Kf + (size_t)(krow + kr1) * 384 + hd * 96 + kcc1 * 8);
        gv = *(const v4u*)(vbase + key0);
    };
    auto lstore = [&](int buf) {
        LAS uchar* base = F.lds + buf * BUF;
        *(LAS v4u*)(base + kr0 * KP + kcc0 * 16) = gk0;
        if (k1v) *(LAS v4u*)(base + kr1 * KP + kcc1 * 16) = gk1;
        *(LAS v4u*)(base + 64 * KP + vd * VP + vcc * 16) = gv;
    };
    const int nt = nkeys / 64;
    gload(0); lstore(0);
    __syncthreads();
    f32x16 O0, O1;
#pragma unroll
    for (int r = 0; r < 16; ++r) { O0[r] = 0.f; O1[r] = 0.f; }
    float m = -1e30f, lsum = 0.f;
    for (int kt = 0; kt < nt; ++kt) {
        const bool more = kt + 1 < nt;
        if (more) gload(kt + 1);
        const LAS uchar* kb_ = F.lds + (kt & 1) * BUF; const LAS uchar* vb_ = kb_ + 64 * KP;
        f32x16 s0, s1;
#pragma unroll
        for (int r = 0; r < 16; ++r) { s0[r] = 0.f; s1[r] = 0.f; }
#pragma unroll
        for (int s = 0; s < 6; ++s) {
            const bf16x8 ka = *(const LAS bf16x8*)(kb_ + l31 * KP + (16 * s + 8 * h2) * 2);
            const bf16x8 kb2 = *(const LAS bf16x8*)(kb_ + (32 + l31) * KP + (16 * s + 8 * h2) * 2);
            s0 = mfma32(ka, Qf[s], s0); s1 = mfma32(kb2, Qf[s], s1);
        }
        float mx = s0[0];
#pragma unroll
        for (int r = 1; r < 16; ++r) mx = fmaxf(mx, s0[r]);
#pragma unroll
        for (int r = 0; r < 16; ++r) mx = fmaxf(mx, s1[r]);
        mx = fmaxf(mx, __shfl_xor(mx, 32));
        const float mn = fmaxf(m, mx), alpha = __builtin_amdgcn_exp2f(m - mn); m = mn;
        float ps = 0.f;
#pragma unroll
        for (int r = 0; r < 16; ++r) { s0[r] = __builtin_amdgcn_exp2f(s0[r] - mn); s1[r] = __builtin_amdgcn_exp2f(s1[r] - mn); ps += s0[r] + s1[r]; }
        lsum = lsum * alpha + ps;
#pragma unroll
        for (int r = 0; r < 16; ++r) { O0[r] *= alpha; O1[r] *= alpha; }
#pragma unroll
        for (int kb = 0; kb < 2; ++kb)
#pragma unroll
            for (int sp = 0; sp < 2; ++sp) {
                const f32x16& sx = kb ? s1 : s0;
                const bf16x8 pf = pack8(sx[8 * sp + 0], sx[8 * sp + 1], sx[8 * sp + 2], sx[8 * sp + 3], sx[8 * sp + 4], sx[8 * sp + 5], sx[8 * sp + 6], sx[8 * sp + 7]);
                const int ko = (32 * kb + 16 * sp + 4 * h2) * 2;
                const bf16x4 a0 = *(const LAS bf16x4*)(vb_ + l31 * VP + ko), a1 = *(const LAS bf16x4*)(vb_ + l31 * VP + ko + 16);
                const bf16x4 c0 = *(const LAS bf16x4*)(vb_ + (32 + l31) * VP + ko), c1 = *(const LAS bf16x4*)(vb_ + (32 + l31) * VP + ko + 16);
                const bf16x8 va = __builtin_shufflevector(a0, a1, 0, 1, 2, 3, 4, 5, 6, 7), vc = __builtin_shufflevector(c0, c1, 0, 1, 2, 3, 4, 5, 6, 7);
                O0 = mfma32(va, pf, O0); O1 = mfma32(vc, pf, O1);
            }
        if (more) lstore((kt + 1) & 1);
        __syncthreads();
    }
    const float ltot = lsum + __shfl_xor(lsum, 32), inv = 1.0f / ltot;
    bf16* op = MO + (size_t)qrow * D + 256 + hd * 64;
#pragma unroll
    for (int gq = 0; gq < 4; ++gq) {
        v2u o; o.x = pk2(O0[4 * gq] * inv, O0[4 * gq + 1] * inv); o.y = pk2(O0[4 * gq + 2] * inv, O0[4 * gq + 3] * inv);
        *(v2u*)(op + 8 * gq + 4 * h2) = o;
        v2u o2; o2.x = pk2(O1[4 * gq] * inv, O1[4 * gq + 1] * inv); o2.y = pk2(O1[4 * gq + 2] * inv, O1[4 * gq + 3] * inv);
        *(v2u*)(op + 32 + 8 * gq + 4 * h2) = o2;
    }
}
DI float conv3(const bf16* Z, int b, int seg, int t, int len, int col, float w0, float w1, float w2, float cb) {
    const bf16* zp = Z + (size_t)tok_row(b, seg, t) * ZP + col;
    float y = cb + w1 * bf2f(zp[0]);
    if (t > 0) y += w0 * bf2f(zp[-ZP]);
    if (t + 1 < len) y += w2 * bf2f(zp[ZP]);
    return y;
}
DI bf16x8 ldperm(const LAS bf16* rowp, int k0, int hh) { const bf16x4 a0 = *(const LAS bf16x4*)(rowp + k0 + 4 * hh), a1 = *(const LAS bf16x4*)(rowp + k0 + 8 + 4 * hh); return __builtin_shufflevector(a0, a1, 0, 1, 2, 3, 4, 5, 6, 7); }
DI bf16x8 pack_acc(const f32x16& x, int s) { return s ? pack8(x[8], x[9], x[10], x[11], x[12], x[13], x[14], x[15]) : pack8(x[0], x[1], x[2], x[3], x[4], x[5], x[6], x[7]); }
DI void rwkv_scan_task(KArgs a, const Ctx& F, int l, int b, int hd, int dir) {
    const bf16* Z = (const bf16*)(a->ws + WS_ACT); bf16* YR = (bf16*)(a->ws + WS_YR) + (size_t)dir * NROWS * 256;
    LAS bf16* Raw = (LAS bf16*)F.lds;
    LAS bf16* LwB = (LAS bf16*)(F.lds + 13056);
    LAS float* WL = (LAS float*)(F.lds + 13056 + 4608);
    LAS float* AL = WL + 2048;
    LAS float* Alw = AL + 2048;
    LAS float* Akap = Alw + 2048; LAS float* Abet = Akap + 2048; LAS float* Akt = Abet + 2048; LAS float* Arr = Akt + 2048;
    LAS bf16* KhT = (LAS bf16*)(Arr + 2048);
    LAS bf16* BhT = KhT + 32 * 72; LAS bf16* KkT = BhT + 32 * 72; LAS bf16* RhT = KkT + 32 * 72;
    LAS bf16* Kh = RhT + 32 * 72;
    LAS bf16* nBh = Kh + 64 * 40; LAS bf16* VT = nBh + 64 * 40;
    LAS bf16* TT = VT + 64 * 40;
    LAS float* Ab = (LAS float*)(TT + 32 * 40);
    LAS float* GL = Ab + 1024;
    const int tid = F.tid, lane = F.lane, wave = F.wave;
    const int hc = hd * 64 + lane;
    bf16x8 lf0 = {0, 0, 0, 0, 0, 0, 0, 0}, lf1 = lf0;
    if (wave < 4) { const int l31 = lane & 31, hh = lane >> 5; const float* up = a->in[(wave >> 1) ? I_RAUP : I_RWUP] + ((size_t)(l * 2 + dir) * 32) * 256 + hd * 64 + 32 * (wave & 1) + l31;
        float u[16];
#pragma unroll
        for (int s = 0; s < 2; ++s)
#pragma unroll
            for (int j = 0; j < 8; ++j) u[8 * s + j] = up[(size_t)(16 * s + 8 * hh + j) * 256];
        lf0 = pack8(u[0], u[1], u[2], u[3], u[4], u[5], u[6], u[7]); lf1 = pack8(u[8], u[9], u[10], u[11], u[12], u[13], u[14], u[15]); }
    LAS float* CST = GL + 64;
    if (wave == 0) {
        const float* cw = a->in[I_RCW] + (size_t)l * 3 * 768; const float* cbp = a->in[I_RCB] + (size_t)l * 768;
        CST[0 * 64 + lane] = a->in[I_RW0][(l * 2 + dir) * 256 + hc]; CST[1 * 64 + lane] = a->in[I_RA0][(l * 2 + dir) * 256 + hc];
        CST[2 * 64 + lane] = a->in[I_RKK][l * 256 + hc]; CST[3 * 64 + lane] = a->in[I_RKA][l * 256 + hc];
#pragma unroll
        for (int j = 0; j < 3; ++j) { CST[(4 + j) * 64 + lane] = cw[j * 768 + hc]; CST[(7 + j) * 64 + lane] = cw[j * 768 + 256 + hc]; CST[(10 + j) * 64 + lane] = cw[j * 768 + 512 + hc]; }
        CST[13 * 64 + lane] = cbp[hc]; CST[14 * 64 + lane] = cbp[256 + hc]; CST[15 * 64 + lane] = cbp[512 + hc];
    }
    f32x16 ST0, ST1;
#pragma unroll
    for (int r = 0; r < 16; ++r) { ST0[r] = 0.f; ST1[r] = 0.f; }
    const int c0r = tid / 24, c0s = (tid % 24) >> 3, c0c = (tid % 24) & 7;
    const int c1 = tid + 512, c1r = c1 / 24, c1s = (c1 % 24) >> 3, c1c = (c1 % 24) & 7; const bool c1v = c1 < 816;
    const int lr_ = tid >> 3, lc_ = tid & 7;
    v4u g0, g1, g2;
    unsigned zz_ = 0u; asm volatile("" : "+v"(zz_)); const v4u zero4 = {zz_, zz_, zz_, zz_};
    const int nchC = TC / 32, nchT = nchC + T / 32;
    auto gload = [&](int gc) {
        const int seg = gc >= nchC, ch = seg ? gc - nchC : gc, len = seg ? T : TC;
        const int tbase = dir ? (len - 32 * (ch + 1)) : 32 * ch;
        { const int t = tbase - 1 + c0r; g0 = (t >= 0 && t < len) ? *(const v4u*)(Z + (size_t)tok_row(b, seg, t) * ZP + ZRKV + c0s * 256 + hd * 64 + c0c * 8) : zero4; }
        if (c1v) { const int t = tbase - 1 + c1r; g1 = (t >= 0 && t < len) ? *(const v4u*)(Z + (size_t)tok_row(b, seg, t) * ZP + ZRKV + c1s * 256 + hd * 64 + c1c * 8) : zero4; }
        if (tid < 256) { const int t = tbase + lr_; g2 = *(const v4u*)(Z + (size_t)tok_row(b, seg, t) * ZP + ZWD + lc_ * 8); }
    };
    auto lstore = [&]() {
        *(LAS v4u*)(Raw + c0r * 192 + c0s * 64 + c0c * 8) = g0;
        if (c1v) *(LAS v4u*)(Raw + c1r * 192 + c1s * 64 + c1c * 8) = g1;
        if (tid < 256) { float x[8] = {bflo(g2.x), bfhi(g2.x), bflo(g2.y), bfhi(g2.y), bflo(g2.z), bfhi(g2.z), bflo(g2.w), bfhi(g2.w)};
            if (lc_ < 4) {
#pragma unroll
                for (int j = 0; j < 8; ++j) x[j] = tanhf(x[j]); }
            v4u w; w.x = pk2(x[0], x[1]); w.y = pk2(x[2], x[3]); w.z = pk2(x[4], x[5]); w.w = pk2(x[6], x[7]);
            *(LAS v4u*)(LwB + lr_ * 72 + lc_ * 8) = w; }
    };
    gload(0); lstore();
    __syncthreads();
    for (int gc = 0; gc < nchT; ++gc) {
        const int seg = gc >= nchC, ch = seg ? gc - nchC : gc, len = seg ? T : TC;
        const int tbase = dir ? (len - 32 * (ch + 1)) : 32 * ch;
        if (gc + 1 < nchT) gload(gc + 1);
        int ln_ = lane; asm volatile("" : "+v"(ln_));
        const int l31 = ln_ & 31, hh = ln_ >> 5, c = ln_;
        if (wave < 4) {
            f32x16 acc;
#pragma unroll
            for (int r = 0; r < 16; ++r) acc[r] = 0.f;
            const int ko = (wave >> 1) * 32;
            acc = mfma32(*(const LAS bf16x8*)(LwB + l31 * 72 + ko + 8 * hh), lf0, acc);
            acc = mfma32(*(const LAS bf16x8*)(LwB + l31 * 72 + ko + 16 + 8 * hh), lf1, acc);
            LAS float* dst = (wave >> 1) ? AL : WL;
#pragma unroll
            for (int r = 0; r < 16; ++r) dst[crow(r, hh) * 64 + 32 * (wave & 1) + l31] = acc[r];
        }
        __syncthreads();
#pragma unroll 1
        for (int tt = 0; tt < 4; ++tt) {
            const int i = wave + 8 * tt, jr = dir ? (32 - i) : (i + 1), li = dir ? (31 - i) : i;
            const LAS bf16* rp = Raw + jr * 192 + c;
            const float rv = CST[13 * 64 + c] + CST[4 * 64 + c] * bf2f(rp[-192]) + CST[5 * 64 + c] * bf2f(rp[0]) + CST[6 * 64 + c] * bf2f(rp[192]);
            const float kv = CST[14 * 64 + c] + CST[7 * 64 + c] * bf2f(rp[64 - 192]) + CST[8 * 64 + c] * bf2f(rp[64]) + CST[9 * 64 + c] * bf2f(rp[64 + 192]);
            const float vv = CST[15 * 64 + c] + CST[10 * 64 + c] * bf2f(rp[128 - 192]) + CST[11 * 64 + c] * bf2f(rp[128]) + CST[12 * 64 + c] * bf2f(rp[128 + 192]);
            const float w0c = CST[c], a0c = CST[64 + c], kkc = CST[128 + c], kac = CST[192 + c];
            const float kx = kv * kkc; const float nrm = sqrtf(wave_sum(kx * kx)); const float kn = kx / fmaxf(nrm, 1e-12f);
            const float wl_ = w0c + WL[li * 64 + c], al_ = a0c + AL[li * 64 + c];
            const float xneg = -wl_; const float sp = fmaxf(xneg, 0.f) + log1pf(__expf(-fabsf(xneg)));
            const float lw = -__expf(-sp - 0.5f);
            const float av = 1.0f / (1.0f + __expf(-al_));
            Alw[i * 64 + c] = lw; Akap[i * 64 + c] = kn; Abet[i * 64 + c] = kn * av; Akt[i * 64 + c] = kv * (1.0f + (av - 1.0f) * kac); Arr[i * 64 + c] = rv;
            VT[c * 40 + i] = (bf16)f2bf(vv);
        }
        __syncthreads();
        if (wave == 0) {
            float x[32];
#pragma unroll
            for (int i = 0; i < 32; ++i) x[i] = Alw[i * 64 + c];
#pragma unroll
            for (int i = 1; i < 32; ++i) x[i] += x[i - 1];
#pragma unroll
            for (int i = 0; i < 32; ++i) Alw[i * 64 + c] = x[i];
            GL[c] = __expf(x[31]);
        }
        __syncthreads();
        {
            const int i = tid >> 4, c4 = (tid & 15) * 4;
            const f32x4 cum = *(const LAS f32x4*)(Alw + i * 64 + c4);
            f32x4 cpv = {0.f, 0.f, 0.f, 0.f}; if (i > 0) cpv = *(const LAS f32x4*)(Alw + (i - 1) * 64 + c4);
            const f32x4 kt = *(const LAS f32x4*)(Akt + i * 64 + c4), bt = *(const LAS f32x4*)(Abet + i * 64 + c4), kp = *(const LAS f32x4*)(Akap + i * 64 + c4), rr = *(const LAS f32x4*)(Arr + i * 64 + c4);
            float kh[4], bh[4], kk_[4], rh[4];
#pragma unroll
            for (int e = 0; e < 4; ++e) { const float en = __expf(-cum[e]), ep = __expf(cum[e]), epv = __expf(cpv[e]);
                kh[e] = kt[e] * en; bh[e] = bt[e] * en; kk_[e] = kp[e] * epv; rh[e] = rr[e] * ep; }
            v2u o;
            o.x = pk2(kh[0], kh[1]); o.y = pk2(kh[2], kh[3]); *(LAS v2u*)(KhT + i * 72 + c4) = o;
            o.x = pk2(bh[0], bh[1]); o.y = pk2(bh[2], bh[3]); *(LAS v2u*)(BhT + i * 72 + c4) = o;
            o.x = pk2(kk_[0], kk_[1]); o.y = pk2(kk_[2], kk_[3]); *(LAS v2u*)(KkT + i * 72 + c4) = o;
            o.x = pk2(rh[0], rh[1]); o.y = pk2(rh[2], rh[3]); *(LAS v2u*)(RhT + i * 72 + c4) = o;
#pragma unroll
            for (int e = 0; e < 4; ++e) { Kh[(c4 + e) * 40 + i] = (bf16)f2bf(kh[e]); nBh[(c4 + e) * 40 + i] = (bf16)f2bf(-bh[e]); }
        }
        __syncthreads();
        f32x16 accP, accY, accBb;
        const int vcol = 32 * wave + l31;
        if (wave == 2) {
            f32x16 P, PT, Tm, TTm;
#pragma unroll
            for (int r = 0; r < 16; ++r) { P[r] = 0.f; PT[r] = 0.f; }
#pragma unroll
            for (int s = 0; s < 4; ++s) { const bf16x8 bh_ = *(const LAS bf16x8*)(BhT + l31 * 72 + 16 * s + 8 * hh), kk_ = *(const LAS bf16x8*)(KkT + l31 * 72 + 16 * s + 8 * hh);
                P = mfma32(bh_, kk_, P); PT = mfma32(kk_, bh_, PT); }
#pragma unroll
            for (int r = 0; r < 16; ++r) { const int j = crow(r, hh);
                P[r] = (j < l31) ? P[r] : 0.f; PT[r] = (j > l31) ? PT[r] : 0.f;
                const float idv = (j == l31) ? 1.f : 0.f; Tm[r] = idv - P[r]; TTm[r] = idv - PT[r]; }
#pragma unroll
            for (int it = 0; it < 4; ++it) {
                const bf16x8 p0 = pack_acc(P, 0), p1 = pack_acc(P, 1), q0 = pack_acc(PT, 0), q1 = pack_acc(PT, 1);
                f32x16 P2, P2T;
#pragma unroll
                for (int r = 0; r < 16; ++r) { P2[r] = 0.f; P2T[r] = 0.f; }
                P2 = mfma32(q0, p0, P2); P2 = mfma32(q1, p1, P2);
                P2T = mfma32(p0, q0, P2T); P2T = mfma32(p1, q1, P2T);
                const bf16x8 t0 = pack_acc(Tm, 0), t1 = pack_acc(Tm, 1), u0 = pack_acc(TTm, 0), u1 = pack_acc(TTm, 1);
                const bf16x8 a0 = pack_acc(P2, 0), a1 = pack_acc(P2, 1);
                Tm = mfma32(u0, a0, Tm); Tm = mfma32(u1, a1, Tm);
                TTm = mfma32(a0, u0, TTm); TTm = mfma32(a1, u1, TTm);
                P = P2; PT = P2T;
                (void)t0; (void)t1;
            }
#pragma unroll
            for (int r = 0; r < 16; ++r) TT[l31 * 40 + crow(r, hh)] = (bf16)f2bf(Tm[r]);
        } else if (wave < 2) {
#pragma unroll
            for (int r = 0; r < 16; ++r) { accP[r] = 0.f; accY[r] = 0.f; }
#pragma unroll
            for (int kb = 0; kb < 2; ++kb)
#pragma unroll
                for (int s = 0; s < 2; ++s) { const bf16x8 sb = pack_acc(kb ? ST1 : ST0, s);
                    accP = mfma32(ldperm(KkT + l31 * 72, 32 * kb + 16 * s, hh), sb, accP);
                    accY = mfma32(ldperm(RhT + l31 * 72, 32 * kb + 16 * s, hh), sb, accY); }
            {
                f32x16 acc;
#pragma unroll
                for (int r = 0; r < 16; ++r) acc[r] = 0.f;
#pragma unroll
                for (int s = 0; s < 4; ++s) acc = mfma32(*(const LAS bf16x8*)(KhT + l31 * 72 + 16 * s + 8 * hh), *(const LAS bf16x8*)(KkT + l31 * 72 + 16 * s + 8 * hh), acc);
#pragma unroll
                for (int r = 0; r < 16; ++r) acc[r] = (crow(r, hh) < l31) ? acc[r] : 0.f;
#pragma unroll
                for (int s = 0; s < 2; ++s) accP = mfma32(pack_acc(acc, s), ldperm(VT + vcol * 40, 16 * s, hh), accP);
            }
            __builtin_amdgcn_sched_barrier(0);
            {
                f32x16 acc;
#pragma unroll
                for (int r = 0; r < 16; ++r) acc[r] = 0.f;
#pragma unroll
                for (int s = 0; s < 4; ++s) acc = mfma32(*(const LAS bf16x8*)(KhT + l31 * 72 + 16 * s + 8 * hh), *(const LAS bf16x8*)(RhT + l31 * 72 + 16 * s + 8 * hh), acc);
#pragma unroll
                for (int r = 0; r < 16; ++r) acc[r] = (crow(r, hh) <= l31) ? acc[r] : 0.f;
#pragma unroll
                for (int s = 0; s < 2; ++s) accY = mfma32(pack_acc(acc, s), ldperm(VT + vcol * 40, 16 * s, hh), accY);
            }
            __builtin_amdgcn_sched_barrier(0);
            {
#pragma unroll
                for (int r = 0; r < 16; ++r) accBb[r] = 0.f;
#pragma unroll
                for (int s = 0; s < 4; ++s) accBb = mfma32(*(const LAS bf16x8*)(BhT + l31 * 72 + 16 * s + 8 * hh), *(const LAS bf16x8*)(RhT + l31 * 72 + 16 * s + 8 * hh), accBb);
#pragma unroll
                for (int r = 0; r < 16; ++r) accBb[r] = (crow(r, hh) <= l31) ? -accBb[r] : 0.f;
            }
        }
        __syncthreads();
        if (wave < 2) {
            f32x16 accC;
#pragma unroll
            for (int r = 0; r < 16; ++r) accC[r] = 0.f;
#pragma unroll
            for (int s = 0; s < 2; ++s) accC = mfma32(ldperm(TT + l31 * 40, 16 * s, hh), pack_acc(accP, s), accC);
#pragma unroll
            for (int s = 0; s < 2; ++s) accY = mfma32(pack_acc(accBb, s), pack_acc(accC, s), accY);
#pragma unroll
            for (int s = 0; s < 2; ++s) { const bf16x8 vb_ = *(const LAS bf16x8*)(VT + vcol * 40 + 16 * s + 8 * hh); const bf16x8 cb_ = pack_acc(accC, s);
                ST0 = mfma32(*(const LAS bf16x8*)(Kh + l31 * 40 + 16 * s + 8 * hh), vb_, ST0);
                ST1 = mfma32(*(const LAS bf16x8*)(Kh + (32 + l31) * 40 + 16 * s + 8 * hh), vb_, ST1);
                ST0 = mfma32(ldperm(nBh + l31 * 40, 16 * s, hh), cb_, ST0);
                ST1 = mfma32(ldperm(nBh + (32 + l31) * 40, 16 * s, hh), cb_, ST1); }
#pragma unroll
            for (int r = 0; r < 16; ++r) { ST0[r] *= GL[crow(r, hh)]; ST1[r] *= GL[32 + crow(r, hh)]; }
#pragma unroll
            for (int r = 0; r < 16; ++r) { const int i = crow(r, hh), t = dir ? (tbase + 31 - i) : (tbase + i);
                YR[(size_t)tok_row(b, seg, t) * 256 + hd * 64 + vcol] = (bf16)f2bf(accY[r]); }
        }
        if (gc + 1 < nchT) lstore();
        __syncthreads();
    }
}

DI void mlstm_task(KArgs a, const Ctx& F, int l, int b, int hd) {
    const bf16* Z = (const bf16*)(a->ws + WS_ACT);
    const int tid = F.tid, lane = F.lane, wave = F.wave, dir = wave >> 2, w2 = wave & 3, tid2 = tid & 255, l31 = lane & 31, hh = lane >> 5;
    bf16* YM = (bf16*)(a->ws + WS_YM) + (size_t)dir * NROWS * 256;
    constexpr int HP = 72;
    constexpr int HALF_LDS = 67328;
    LAS uchar* base = F.lds + dir * HALF_LDS;
    LAS bf16* Qc = (LAS bf16*)base; LAS bf16* Kc = Qc + 64 * HP; LAS bf16* KTw = Kc + 64 * HP; LAS bf16* VT = KTw + 64 * HP; LAS bf16* Cb = VT + 64 * HP;
    LAS float* fv = (LAS float*)(base + 5 * 9216);
    LAS float* Vgv = fv; LAS float* VMr = fv + 64; LAS float* Vwi = fv + 128; LAS float* Vem = fv + 192; LAS float* Vwk = fv + 256; LAS float* Vn = fv + 320; LAS float* Vsc = fv + 384;
    LAS bf16* Rq = (LAS bf16*)(base + 47872);
    LAS float* Gt = (LAS float*)(base + 47872 + 16896);
    LAS float* Cw = Gt + 128;
    for (int i = tid2; i < 64 * HP; i += 256) Cb[i] = 0;
    if (tid2 < 64) Vn[tid2] = 0.f;
    if (tid2 == 0) { float one_ = 1.f, zero_ = 0.f; asm volatile("" : "+v"(one_), "+v"(zero_)); Vsc[0] = one_; Vsc[1] = zero_; }
    { const float* cw = a->in[I_MCW] + (size_t)l * 3 * 512; const float* cbp = a->in[I_MCB] + (size_t)l * 512;
      for (int i = tid2; i < 512; i += 256) { const int tap = i >> 7, cc = i & 127, col = (cc < 64) ? (hd * 64 + cc) : (256 + hd * 64 + cc - 64);
          Cw[i] = (tap < 3) ? cw[tap * 512 + col] : cbp[col]; } }
    f32x16 accC;
#pragma unroll
    for (int r = 0; r < 16; ++r) accC[r] = 0.f;
    const int eb = w2 >> 1, lb = w2 & 1;
    const float gbi = a->in[I_MGB][l * 16 + dir * 8 + hd], gbf = a->in[I_MGB][l * 16 + dir * 8 + 4 + hd];
    const int nchC = TC / 64, nchT = nchC + T / 64;
    v4u gq[5], gv[2]; float gg0 = 0.f, gg1 = 0.f;
    unsigned zz_ = 0u; asm volatile("" : "+v"(zz_)); const v4u zero4 = {zz_, zz_, zz_, zz_};
    auto gload = [&](int gc) {
        const int seg = gc >= nchC, ch = seg ? gc - nchC : gc, len = seg ? T : TC;
        const int tbase = dir ? (len - 64 * (ch + 1)) : 64 * ch;
#pragma unroll
        for (int n = 0; n < 5; ++n) { const int cidx = tid2 + 256 * n; if (cidx < 1056) { const int row = cidx >> 4, cc = cidx & 15, t = tbase - 1 + row;
            gq[n] = (t >= 0 && t < len) ? *(const v4u*)(Z + (size_t)tok_row(b, seg, t) * ZP + ZMQK + (cc >> 3) * 256 + hd * 64 + (cc & 7) * 8) : zero4; } }
#pragma unroll
        for (int n = 0; n < 2; ++n) { const int cidx = tid2 + 256 * n, row = cidx >> 3, cc = cidx & 7; gv[n] = *(const v4u*)(Z + (size_t)tok_row(b, seg, tbase + row) * ZP + ZMV + hd * 64 + cc * 8); }
        if (tid2 < 64) { const bf16* zp = Z + (size_t)tok_row(b, seg, tbase + tid2) * ZP + ZMG + dir * 8 + hd; gg0 = bf2f(zp[0]); gg1 = bf2f(zp[4]); }
    };
    auto lstore = [&]() {
#pragma unroll
        for (int n = 0; n < 5; ++n) { const int cidx = tid2 + 256 * n; if (cidx < 1056) *(LAS v4u*)(Rq + (cidx >> 4) * 128 + (cidx & 15) * 8) = gq[n]; }
#pragma unroll
        for (int n = 0; n < 2; ++n) { const int cidx = tid2 + 256 * n, row = cidx >> 3, cc = cidx & 7;
            const int stp = dir ? (63 - row) : row; const unsigned w[4] = {gv[n].x, gv[n].y, gv[n].z, gv[n].w};
#pragma unroll
            for (int j = 0; j < 4; ++j) { VT[(cc * 8 + 2 * j) * HP + stp] = (bf16)(w[j] & 0xffffu); VT[(cc * 8 + 2 * j + 1) * HP + stp] = (bf16)(w[j] >> 16); } }
        if (tid2 < 64) { Gt[tid2 * 2] = gg0; Gt[tid2 * 2 + 1] = gg1; }
    };
    gload(0);
    __syncthreads();
    lstore();
    __syncthreads();
    for (int gc = 0; gc < nchT; ++gc) {
        const int seg = gc >= nchC, ch = seg ? gc - nchC : gc, len = seg ? T : TC;
        const int tbase = dir ? (len - 64 * (ch + 1)) : 64 * ch;
        if (gc + 1 < nchT) gload(gc + 1);
        if (w2 == 0) {
            const int jt = dir ? (63 - lane) : lane;
            const float li = Gt[jt * 2] + gbi, fraw = Gt[jt * 2 + 1] + gbf;
            const float lf = fminf(fraw, 0.f) - log1pf(__expf(-fabsf(fraw)));
            float bc = lf;
#pragma unroll
            for (int o = 1; o < 64; o <<= 1) { const float n = __shfl_up(bc, o); if (lane >= o) bc += n; }
            const float g = li - bc; float pm = g;
#pragma unroll
            for (int o = 1; o < 64; o <<= 1) { const float n = __shfl_up(pm, o); if (lane >= o) pm = fmaxf(pm, n); }
            const float mprev = Vsc[1];
            const float blast = __shfl(bc, 63);
            const float lw = blast - bc + li;
            const float mnew = fmaxf(blast + mprev, wave_max(lw));
            const float Mr = fmaxf(mprev, pm);
            Vgv[lane] = g; VMr[lane] = Mr; Vwi[lane] = __expf(mprev - Mr); Vem[lane] = __expf(-bc - Mr); Vwk[lane] = __expf(lw - mnew);
            if (lane == 0) { Vsc[0] = __expf(blast + mprev - mnew); Vsc[2] = mnew; }
        }
        __syncthreads();
        {
            const int i = tid2 >> 2, qq = tid2 & 3, jr = dir ? (64 - i) : (i + 1);
            const float wk_i = Vwk[i];
            float qv[16], kvv[16];
#pragma unroll
            for (int j = 0; j < 16; ++j) { qv[j] = Cw[384 + qq * 16 + j]; kvv[j] = Cw[384 + 64 + qq * 16 + j]; }
#pragma unroll
            for (int tap = 0; tap < 3; ++tap) {
                const LAS bf16* rp = Rq + (jr - 1 + tap) * 128 + qq * 16;
                const v4u q0 = *(const LAS v4u*)rp, q1 = *(const LAS v4u*)(rp + 8), k0 = *(const LAS v4u*)(rp + 64), k1 = *(const LAS v4u*)(rp + 72);
                const unsigned qw[8] = {q0.x, q0.y, q0.z, q0.w, q1.x, q1.y, q1.z, q1.w}, kw[8] = {k0.x, k0.y, k0.z, k0.w, k1.x, k1.y, k1.z, k1.w};
#pragma unroll
                for (int j = 0; j < 8; ++j) { qv[2 * j] += Cw[tap * 128 + qq * 16 + 2 * j] * bflo(qw[j]); qv[2 * j + 1] += Cw[tap * 128 + qq * 16 + 2 * j + 1] * bfhi(qw[j]);
                    kvv[2 * j] += Cw[tap * 128 + 64 + qq * 16 + 2 * j] * bflo(kw[j]); kvv[2 * j + 1] += Cw[tap * 128 + 64 + qq * 16 + 2 * j + 1] * bfhi(kw[j]); }
            }
#pragma unroll
            for (int j = 0; j < 16; ++j) { qv[j] = qv[j] * fsigmoid(qv[j]); kvv[j] = kvv[j] * fsigmoid(kvv[j]) * 0.125f; }
#pragma unroll
            for (int j = 0; j < 16; j += 2) { *(LAS unsigned*)(Qc + i * HP + qq * 16 + j) = pk2(qv[j], qv[j + 1]); *(LAS unsigned*)(Kc + i * HP + qq * 16 + j) = pk2(kvv[j], kvv[j + 1]); }
#pragma unroll
            for (int j = 0; j < 16; ++j) KTw[(qq * 16 + j) * HP + i] = (bf16)f2bf(kvv[j] * wk_i);
        }
        __syncthreads();
        {
            const int lidx = 32 * lb + l31;
            f32x16 accN, accI;
#pragma unroll
            for (int r = 0; r < 16; ++r) { accN[r] = 0.f; accI[r] = 0.f; }
            float dsum = 0.f;
            const float Mr = VMr[lidx];
#pragma unroll
            for (int sb = 0; sb < 2; ++sb) {
                if (sb <= lb) {
                    f32x16 sT;
#pragma unroll
                    for (int r = 0; r < 16; ++r) sT[r] = 0.f;
#pragma unroll
                    for (int s = 0; s < 4; ++s) {
                        const bf16x8 ka = *(const LAS bf16x8*)(Kc + (32 * sb + l31) * HP + 16 * s + 8 * hh);
                        const bf16x8 qb = *(const LAS bf16x8*)(Qc + lidx * HP + 16 * s + 8 * hh);
                        sT = mfma32(ka, qb, sT);
                    }
#pragma unroll
                    for (int r = 0; r < 16; ++r) { const int sidx = 32 * sb + crow(r, hh);
                        const float p = (sidx <= lidx) ? sT[r] * __expf(Vgv[sidx] - Mr) : 0.f; sT[r] = p; dsum += p; }
#pragma unroll
                    for (int sp = 0; sp < 2; ++sp) {
                        const bf16x8 pf = pack8(sT[8 * sp + 0], sT[8 * sp + 1], sT[8 * sp + 2], sT[8 * sp + 3], sT[8 * sp + 4], sT[8 * sp + 5], sT[8 * sp + 6], sT[8 * sp + 7]);
                        const int ko = 32 * sb + 16 * sp + 4 * hh;
                        const bf16x4 a0 = *(const LAS bf16x4*)(VT + (32 * eb + l31) * HP + ko), a1 = *(const LAS bf16x4*)(VT + (32 * eb + l31) * HP + ko + 8);
                        accN = mfma32(__builtin_shufflevector(a0, a1, 0, 1, 2, 3, 4, 5, 6, 7), pf, accN);
                    }
                }
            }
#pragma unroll
            for (int s = 0; s < 4; ++s) {
                const bf16x8 ca = *(const LAS bf16x8*)(Cb + (32 * eb + l31) * HP + 16 * s + 8 * hh);
                const bf16x8 qb = *(const LAS bf16x8*)(Qc + lidx * HP + 16 * s + 8 * hh);
                accI = mfma32(ca, qb, accI);
            }
            dsum += __shfl_xor(dsum, 32);
            float nq = 0.f;
#pragma unroll
            for (int j = 0; j < 64; j += 2) { const unsigned w = *(const LAS unsigned*)(Qc + lidx * HP + j); nq += Vn[j] * bflo(w) + Vn[j + 1] * bfhi(w); }
            const float wi = Vwi[lidx];
            const float den = dsum + wi * nq, hden = fmaxf(fabsf(den), Vem[lidx]), inv = 1.0f / hden;
            const int t = dir ? (tbase + 63 - lidx) : (tbase + lidx);
            bf16* op = YM + (size_t)tok_row(b, seg, t) * 256 + hd * 64 + 32 * eb;
#pragma unroll
            for (int gq_ = 0; gq_ < 4; ++gq_) {
                const float h0 = (accN[4 * gq_] + wi * accI[4 * gq_]) * inv, h1 = (accN[4 * gq_ + 1] + wi * accI[4 * gq_ + 1]) * inv, h2 = (accN[4 * gq_ + 2] + wi * accI[4 * gq_ + 2]) * inv, h3 = (accN[4 * gq_ + 3] + wi * accI[4 * gq_ + 3]) * inv;
                v2u o; o.x = pk2(h0, h1); o.y = pk2(h2, h3);
                *(v2u*)(op + 8 * gq_ + 4 * hh) = o;
            }
        }
        __syncthreads();
        {
            const float sc = Vsc[0];
#pragma unroll
            for (int r = 0; r < 16; ++r) accC[r] *= sc;
#pragma unroll
            for (int s = 0; s < 4; ++s) {
                const bf16x8 va = *(const LAS bf16x8*)(VT + (32 * eb + l31) * HP + 16 * s + 8 * hh);
                const bf16x8 kb = *(const LAS bf16x8*)(KTw + (32 * lb + l31) * HP + 16 * s + 8 * hh);
                accC = mfma32(va, kb, accC);
            }
#pragma unroll
            for (int r = 0; r < 16; ++r) Cb[(32 * eb + crow(r, hh)) * HP + 32 * lb + l31] = (bf16)f2bf(accC[r]);
            if (tid2 < 64) { float s = 0.f;
#pragma unroll
                for (int j = 0; j < 64; j += 2) { const unsigned w = *(const LAS unsigned*)(KTw + tid2 * HP + j); s += bflo(w) + bfhi(w); }
                Vn[tid2] = sc * Vn[tid2] + s; }
            if (tid2 == 0) Vsc[1] = Vsc[2];
        }
        __syncthreads();
        if (gc + 1 < nchT) lstore();
        __syncthreads();
    }
}
DI float gelu_tanh(float x) { const float u = 0.7978845608028654f * (x + 0.044715f * x * x * x); const float e = __expf(2.0f * u); const float th = 1.0f - 2.0f / (e + 1.0f); return 0.5f * x * (1.0f + th); }
DI void unpack8(const v4u w, float (&o)[8]) { o[0] = bflo(w.x); o[1] = bfhi(w.x); o[2] = bflo(w.y); o[3] = bfhi(w.y); o[4] = bflo(w.z); o[5] = bfhi(w.z); o[6] = bflo(w.w); o[7] = bfhi(w.w); }
DI v4u pack8u(const float (&o)[8]) { v4u w; w.x = pk2(o[0], o[1]); w.y = pk2(o[2], o[3]); w.z = pk2(o[4], o[5]); w.w = pk2(o[6], o[7]); return w; }
DI void fin_tile(KArgs a, const Ctx& F, int l, int tile) {
    const bf16* Z = (const bf16*)(a->ws + WS_ACT); bf16* MO = (bf16*)(a->ws + WS_H);
    const bf16* YS = (const bf16*)(a->ws + WS_YS5); const bf16* YR = (const bf16*)(a->ws + WS_YR); const bf16* YM = (const bf16*)(a->ws + WS_YM);
    const bf16* WGLU = (const bf16*)(a->ws + WS_SMALLW + SW_GLU); const bf16* WGUP = (const bf16*)(a->ws + WS_SMALLW + SW_GUP);
    LAS bf16* Az = (LAS bf16*)F.lds;
    LAS bf16* Ag = (LAS bf16*)(F.lds + 16896);
    LAS float* Pr = (LAS float*)(F.lds + 16896 + 4608);
    int tl_ = F.tid; asm volatile("" : "+v"(tl_));
    const int tid = tl_, lane = tid & 63, wave = F.wave, row0 = tile * 32;
    const int i = tid >> 4, part = tid & 15, row = row0 + i;
    const size_t DS = (size_t)NROWS * 256;
    const bf16* zr = Z + (size_t)row * ZP;
    {
        const float* dsk = a->in[I_S5D] + l * 256 + part * 16;
#pragma unroll
        for (int j = 0; j < 2; ++j) { const int c0 = part * 16 + 8 * j; float y0[8], y1[8], u[8], z[8];
            unpack8(*(const v4u*)(YS + (size_t)row * 256 + c0), y0); unpack8(*(const v4u*)(YS + DS + (size_t)row * 256 + c0), y1); unpack8(*(const v4u*)(zr + ZS5 + c0), u);
#pragma unroll
            for (int e = 0; e < 8; ++e) z[e] = gelu_tanh(y0[e] + y1[e] + dsk[8 * j + e] * u[e]);
            *(LAS v4u*)(Az + i * 264 + c0) = pack8u(z); }
    }
    const int hq = part >> 2, c0 = hq * 64 + (part & 3) * 16;
    const bool lat = row < NLAT; const int t = lat ? (row & (T - 1)) : ((row - NLAT) & (TC - 1)); const int len = lat ? T : TC;
    {
        float y[16]; float s = 0.f;
#pragma unroll
        for (int j = 0; j < 2; ++j) { float y0[8], y1[8]; unpack8(*(const v4u*)(YM + (size_t)row * 256 + c0 + 8 * j), y0); unpack8(*(const v4u*)(YM + DS + (size_t)row * 256 + c0 + 8 * j), y1);
#pragma unroll
            for (int e = 0; e < 8; ++e) { y[8 * j + e] = y0[e] + y1[e]; s += y[8 * j + e]; } }
        s += __shfl_xor(s, 1); s += __shfl_xor(s, 2); const float mu = s * (1.0f / 64.0f); float q = 0.f;
#pragma unroll
        for (int j = 0; j < 16; ++j) { y[j] -= mu; q += y[j] * y[j]; }
        q += __shfl_xor(q, 1); q += __shfl_xor(q, 2); const float rstd = 1.0f / sqrtf(q * (1.0f / 64.0f) + 1e-6f);
        const float* nw = a->in[I_MNORM] + l * 256 + c0;
#pragma unroll
        for (int j = 0; j < 2; ++j) { float o[8]; unpack8(*(const v4u*)(zr + ZMO + c0 + 8 * j), o);
#pragma unroll
            for (int e = 0; e < 8; ++e) o[e] = y[8 * j + e] * rstd * nw[8 * j + e] * fsigmoid(o[e]);
            *(v4u*)(MO + (size_t)row * D + 768 + c0 + 8 * j) = pack8u(o); }
    }
    {
        float y[16]; float s = 0.f;
#pragma unroll
        for (int j = 0; j < 2; ++j) { float y0[8], y1[8]; unpack8(*(const v4u*)(YR + (size_t)row * 256 + c0 + 8 * j), y0); unpack8(*(const v4u*)(YR + DS + (size_t)row * 256 + c0 + 8 * j), y1);
#pragma unroll
            for (int e = 0; e < 8; ++e) { y[8 * j + e] = y0[e] + y1[e]; s += y[8 * j + e]; } }
        s += __shfl_xor(s, 1); s += __shfl_xor(s, 2); const float mu = s * (1.0f / 64.0f); float q = 0.f;
#pragma unroll
        for (int j = 0; j < 16; ++j) { y[j] -= mu; q += y[j] * y[j]; }
        q += __shfl_xor(q, 1); q += __shfl_xor(q, 2); const float rstd = 1.0f / sqrtf(q * (1.0f / 64.0f) + 64e-5f);
        const float* cw = a->in[I_RCW] + (size_t)l * 3 * 768; const float* cbp = a->in[I_RCB] + (size_t)l * 768;
        const float* rk = a->in[I_RRK] + l * 256 + c0; const float* lw = a->in[I_RLNW] + l * 256 + c0; const float* lb = a->in[I_RLNB] + l * 256 + c0;
        float vv[16]; float bs = 0.f;
#pragma unroll
        for (int j = 0; j < 2; ++j) { const int c = c0 + 8 * j;
            float rr[8], kk[8], v[8], x[8];
#pragma unroll
            for (int e = 0; e < 8; ++e) { rr[e] = cbp[c + e]; kk[e] = cbp[256 + c + e]; v[e] = cbp[512 + c + e]; }
#pragma unroll
            for (int tap = 0; tap < 3; ++tap) { const int tt = t - 1 + tap;
                if (tt >= 0 && tt < len) { const bf16* zp = zr + (tap - 1) * ZP + ZRKV + c;
                    unpack8(*(const v4u*)zp, x);
#pragma unroll
                    for (int e = 0; e < 8; ++e) rr[e] += cw[tap * 768 + c + e] * x[e];
                    unpack8(*(const v4u*)(zp + 256), x);
#pragma unroll
                    for (int e = 0; e < 8; ++e) kk[e] += cw[tap * 768 + 256 + c + e] * x[e];
                    unpack8(*(const v4u*)(zp + 512), x);
#pragma unroll
                    for (int e = 0; e < 8; ++e) v[e] += cw[tap * 768 + 512 + c + e] * x[e]; } }
#pragma unroll
            for (int e = 0; e < 8; ++e) { bs += rr[e] * kk[e] * rk[8 * j + e]; vv[8 * j + e] = v[e]; } }
        bs += __shfl_xor(bs, 1); bs += __shfl_xor(bs, 2);
#pragma unroll
        for (int j = 0; j < 16; j += 4) *(LAS f32x4*)(Pr + i * 260 + c0 + j) = (f32x4){y[j] * rstd * lw[j] + lb[j] + bs * vv[j], y[j + 1] * rstd * lw[j + 1] + lb[j + 1] + bs * vv[j + 1], y[j + 2] * rstd * lw[j + 2] + lb[j + 2] + bs * vv[j + 2], y[j + 3] * rstd * lw[j + 3] + lb[j + 3] + bs * vv[j + 3]};
    }
    {
        const v2u gv = *(const v2u*)(zr + ZGD + part * 4);
        v2u o; o.x = pk2(fsigmoid(bflo(gv.x)), fsigmoid(bfhi(gv.x))); o.y = pk2(fsigmoid(bflo(gv.y)), fsigmoid(bfhi(gv.y)));
        *(LAS v2u*)(Ag + i * 72 + part * 4) = o;
    }
    __syncthreads();
    const int lr = lane & 15, kq = lane >> 4;
    {
        f32x4 acc[2][2];
        small_gemm<256, 2, 2, true>(Az, 264, WGLU, 32 * wave, acc, lane);
        const float* bg = a->in[I_S5BGLU] + l * 256;
#pragma unroll
        for (int nb = 0; nb < 2; ++nb)
#pragma unroll
            for (int mb = 0; mb < 2; ++mb) { const int tk = 16 * mb + lr, n = 32 * wave + 16 * nb + 4 * kq; const f32x4 v = acc[nb][mb]; const f32x4 b4 = *(const f32x4*)(bg + n);
                const v2u zz = *(const LAS v2u*)(Az + tk * 264 + n);
                const float o0 = bflo(zz.x) * fsigmoid(v.x + b4.x), o1 = bfhi(zz.x) * fsigmoid(v.y + b4.y), o2 = bflo(zz.y) * fsigmoid(v.z + b4.z), o3 = bfhi(zz.y) * fsigmoid(v.w + b4.w);
                v2u o; o.x = pk2(o0, o1); o.y = pk2(o2, o3);
                *(v2u*)(MO + (size_t)(row0 + tk) * D + n) = o; }
    }
    {
        f32x4 acc[2][2];
        small_gemm<64, 2, 2, true>(Ag, 72, WGUP, 32 * wave, acc, lane);
#pragma unroll
        for (int nb = 0; nb < 2; ++nb)
#pragma unroll
            for (int mb = 0; mb < 2; ++mb) { const int tk = 16 * mb + lr, n = 32 * wave + 16 * nb + 4 * kq; const f32x4 v = acc[nb][mb];
                const f32x4 pr = *(const LAS f32x4*)(Pr + tk * 260 + n);
                v2u o; o.x = pk2(pr.x * v.x, pr.y * v.y); o.y = pk2(pr.z * v.z, pr.w * v.w);
                *(v2u*)(MO + (size_t)(row0 + tk) * D + 512 + n) = o; }
    }
    __syncthreads();
}
#ifndef MK_SPLIT
#define MK_SPLIT 1
#endif
#ifdef USE_NOINLINE
#define NI static __device__ __noinline__
#else
#define NI static __device__ __forceinline__
#endif
extern __shared__ __attribute__((aligned(16))) unsigned char lds_raw[];
DI Ctx make_ctx(int wave0) {
    Ctx F; F.lds = (LAS uchar*)lds_raw; { int ln_ = __builtin_amdgcn_mbcnt_hi(~0u, __builtin_amdgcn_mbcnt_lo(~0u, 0u)); asm volatile("" : "+v"(ln_)); F.lane = ln_; } F.wave = wave0; F.tid = wave0 * 64 + F.lane;
    F.G = gridDim.x; { int bx = blockIdx.x; asm volatile("" : "+s"(bx)); F.vcu = (F.G % 8 == 0) ? (bx % 8) * (F.G / 8) + bx / 8 : bx; }
    return F;
}
NI void ph_prologue(KArgs a_, int wave0) { KArgs a = a_; asm volatile("" : "+s"(a)); const Ctx F = make_ctx(wave0); phase_prologue(a, F); __syncthreads(); }
NI void ph_norm(KArgs a_, int wave0, int l, int kind) { KArgs a = a_; asm volatile("" : "+s"(a));
    const Ctx F = make_ctx(wave0);
    float* modv = (float*)(a->ws + WS_MODV);
    const bool last = (l == DEPTH - 1);
    if (kind == 0) convert_weights(a, F, l, 0);
    if (kind == 1) convert_weights(a, F, l, 1);
    const int lY = (kind == 0) ? (l > 0 ? l - 1 : 0) : l;
    const int gi = (kind == 0 || kind == 3) ? 8 : (kind == 1 ? 2 : 5);
    const int pi = (kind == 0 || kind == 3) ? 2 : (kind == 1 ? 0 : 1);
    const float coef = (kind == 2) ? 1.0f : 0.5f;
    const int si = (kind == 0) ? 0 : (kind == 1 ? 3 : 6);
    const int ni = (kind == 0) ? 0 : (kind == 1 ? 1 : 2);
    const bool first = (kind == 0 && l == 0), hasY = !(kind == 0 && l == 0), hasH = (kind != 3), fin = (kind == 3);
    const int nrows = (kind == 3 || (kind == 2 && last)) ? NLAT : NROWS;
    norm_rows(a, F, first, hasY, hasH, fin, nrows, modv + (size_t)lY * 9 * MODW, gi, a->in[I_NPOST] + (lY * 3 + pi) * D, coef, modv + (size_t)l * 9 * MODW, si, a->in[I_NPRE] + (l * 3 + ni) * D);
    __syncthreads();
}
NI void ph_gemm_swiglu(KArgs a_, int wave0, int M) { KArgs a = a_; asm volatile("" : "+s"(a));
    const Ctx F = make_ctx(wave0);
    pg8::Gemm g{(const bf16*)(a->ws + WS_H), (const bf16*)(a->ws + WS_WGU), M, 2 * FF, D}; pg8::StaticOrder S; S.init(M, 2 * FF, F.G, (int)blockIdx.x);
    pg8::EpiSwiGLU E{(bf16*)(a->ws + WS_ACT), FF};
    pg8::gemm_phase<pg8::EpiSwiGLU, pg8::StaticOrder, PG8_ALIGN, PG8_SP2>(F.lds, g, S, E, F.tid);
}
NI void ph_gemm_store(KArgs a_, int wave0, int which, int M) { KArgs a = a_; asm volatile("" : "+s"(a));
    const Ctx F = make_ctx(wave0);
    const bf16* A = (const bf16*)(a->ws + (which == 0 ? WS_ACT : WS_H));
    const bf16* W = (const bf16*)(a->ws + (which == 0 ? WS_WDN : which == 1 ? WS_WIN : WS_WOUT));
    const int N = which == 1 ? ZPAD : D, K = which == 0 ? FF : D;
    pg8::Gemm g{A, W, M, N, K}; pg8::StaticOrder S; S.init(M, N, F.G, (int)blockIdx.x);
    pg8::EpiStore E{(bf16*)(a->ws + (which == 1 ? WS_ACT : WS_Y)), which == 1 ? ZP : D, which == 1 ? ZP : D};
    pg8::gemm_phase<pg8::EpiStore, pg8::StaticOrder, PG8_ALIGN, PG8_SP2>(F.lds, g, S, E, F.tid);
}
NI void ph_mla_prep(KArgs a_, int wave0, int l) { KArgs a = a_; asm volatile("" : "+s"(a)); const Ctx F = make_ctx(wave0); for (int tile = F.vcu; tile < NROWS / 64; tile += F.G) mla_prep_tile(a, F, l, tile); }
NI void ph_rwkv(KArgs a_, int wave0, int l, int v) { KArgs a = a_; asm volatile("" : "+s"(a)); const Ctx F = make_ctx(wave0); rwkv_scan_task(a, F, l, v >> 3, (v >> 1) & 3, v & 1); }
NI void ph_mlstm(KArgs a_, int wave0, int l, int idx) { KArgs a = a_; asm volatile("" : "+s"(a)); const Ctx F = make_ctx(wave0); mlstm_task(a, F, l, idx >> 2, idx & 3); __syncthreads(); }
NI void ph_s5(KArgs a_, int wave0, int l, int wg) { KArgs a = a_; asm volatile("" : "+s"(a)); const Ctx F = make_ctx(wave0); const int tk = wg * 8 + F.wave; s5_scan_task(a, l, tk >> 5, (tk >> 4) & 1, tk & 15, (LAS bf16*)(F.lds + F.wave * 8704), F.lane); __syncthreads(); }
NI void ph_attn(KArgs a_, int wave0, int first, int stride) { KArgs a = a_; asm volatile("" : "+s"(a));
    const Ctx F = make_ctx(wave0);
    for (int u = first; u < 512 + 32; u += stride) {
        if (u < 512) { const int b = u >> 6, hd = (u >> 4) & 3, qb = u & 15; attn_unit(a, F, b, hd, b * T + qb * 256, NKEY); }
        else { const int c = u - 512, b = c >> 2, hd = c & 3; attn_unit(a, F, b, hd, NLAT + b * TC, TC); }
    }
}
NI void ph_fin(KArgs a_, int wave0, int l, int M) { KArgs a = a_; asm volatile("" : "+s"(a)); const Ctx F = make_ctx(wave0); for (int tile = F.vcu; tile < M / 32; tile += F.G) fin_tile(a, F, l, tile); }


#ifdef DBG_CUT
NI void ph_dump(KArgs a_, int wave0) { KArgs a = a_; asm volatile("" : "+s"(a)); const Ctx F = make_ctx(wave0);
    const float* X = (const float*)(a->ws + WS_X); const bf16* Z = (const bf16*)(a->ws + WS_ACT); const bf16* Q = (const bf16*)(a->ws + WS_Q); const bf16* Kf = (const bf16*)(a->ws + WS_K); const bf16* Vt = (const bf16*)(a->ws + WS_VT);
    const bf16* YS = (const bf16*)(a->ws + WS_YS5); const bf16* YR = (const bf16*)(a->ws + WS_YR); const bf16* YM = (const bf16*)(a->ws + WS_YM); const bf16* MO = (const bf16*)(a->ws + WS_H); const bf16* Y = (const bf16*)(a->ws + WS_Y);
    const size_t DS = (size_t)NROWS * 256;
    for (size_t i = (size_t)F.vcu * NTHR + F.tid; i < (size_t)NLAT * D; i += (size_t)F.G * NTHR) {
#ifdef DBG_CTX
        const size_t r = NLAT + ((i >> 10) % NCTX);
#else
        const size_t r = i >> 10;
#endif
        const int c = (int)(i & 1023); float v = 0.f;
        if (DBG_WHICH & 1) v += X[r * D + c];
        if (DBG_WHICH & 2) { v += bf2f(Z[r * ZP + c]) + bf2f(Z[r * ZP + 1024 + c]); if (c + 2048 < ZP) v += bf2f(Z[r * ZP + 2048 + c]); }
        if (DBG_WHICH & 4) { v += bf2f(Q[r * 384 + c % 384]) + bf2f(Kf[r * 384 + c % 384]) + bf2f(Vt[i % ((size_t)NB * 4 * 64 * NKEY)]); }
        if (DBG_WHICH & 256) v += bf2f(Q[r * 384 + c % 384]);
        if (DBG_WHICH & 512) v += bf2f(Kf[r * 384 + c % 384]);
        if (DBG_WHICH & 1024) v += bf2f(Vt[i % ((size_t)NB * 4 * 64 * NKEY)]);
        if (DBG_WHICH & 2048) { const float* rc = (const float*)(a->ws + WS_ROPE); const bf16* sw = (const bf16*)(a->ws + WS_SMALLW); v += rc[i % (T * 32)] + bf2f(sw[i % 245760]); }
        if (DBG_WHICH & 8) v += bf2f(YS[r * 256 + (c & 255)]) + bf2f(YS[DS + r * 256 + (c & 255)]);
        if (DBG_WHICH & 16) v += bf2f(YR[r * 256 + (c & 255)]) + bf2f(YR[DS + r * 256 + (c & 255)]);
        if (DBG_WHICH & 32) v += bf2f(YM[r * 256 + (c & 255)]) + bf2f(YM[DS + r * 256 + (c & 255)]);
        if (DBG_WHICH & 64) v += bf2f(MO[r * D + c]);
        if (DBG_WHICH & 128) v += bf2f(Y[r * D + c]);
        a->out[i] = v;
    }
}
#endif
#if !MK_SPLIT
#if defined(ONLY_PH)
#define PHON(k) ((k) == ONLY_PH)
#elif defined(NO_PH)
#define PHON(k) ((k) != NO_PH)
#else
#define PHON(k) true
#endif
#if defined(ONLY_ROLE)
#define ROLE(k) ((k) == ONLY_ROLE)
#elif defined(NO_ROLE)
#define ROLE(k) ((k) != NO_ROLE)
#else
#define ROLE(k) true
#endif
#ifdef DUP_ROLE
#ifndef DUP_N
#define DUP_N 2
#endif
#define NREPR(k) ((k) == DUP_ROLE ? DUP_N : 1)
#else
#define NREPR(k) 1
#endif
#ifdef DUP_PH
#define NREP(k) ((k) == DUP_PH ? 2 : 1)
#else
#define NREP(k) 1
#endif
constexpr int NPH = 2 + 12 * DEPTH;
__global__ void __launch_bounds__(NTHR, 2) hybrid_fwd(Args args_byval) {
    KArgs a = (KArgs)__builtin_amdgcn_kernarg_segment_ptr();
    LAS uchar* lds = (LAS uchar*)lds_raw;
    const int tid = threadIdx.x; const int wave0 = __builtin_amdgcn_readfirstlane(tid >> 6);
    volatile LAS unsigned* MISC = (volatile LAS unsigned*)(lds + MISC_OFF);
    for (int u = tid; u < (LDS_BYTES - LDSCTL_OFF) / 4; u += NTHR) ((LAS unsigned*)(lds + LDSCTL_OFF))[u] = 0u;
    __syncthreads();
    unsigned* ctl = (unsigned*)(a->ws + WS_CTL);
    const int use_bar = a->use_bar;
    XcdBarrier bar; bar.bar = ctl + CW_BAR; bar.x = 0; bar.st = nullptr;
    if (use_bar) bar = xcd_barrier_post(ctl + CW_BAR, MISC + 8, tid == 0);
    const int lo = a->ph_lo, hi = a->ph_hi;
    const int G = gridDim.x; const int vcu = (G % 8 == 0) ? ((int)blockIdx.x % 8) * (G / 8) + (int)blockIdx.x / 8 : (int)blockIdx.x;
#ifdef DBG_CUT
#define IN(k) (lo <= (k) && (k) < hi && (k) < DBG_CUT)
#else
#define IN(k) (lo <= (k) && (k) < hi)
#endif
#define SEAM(k) do { if (use_bar && IN(k) && IN((k) + 1)) { int ln_ = __builtin_amdgcn_mbcnt_hi(~0u, __builtin_amdgcn_mbcnt_lo(~0u, 0u)); asm volatile("" : "+v"(ln_)); xcd_barrier(bar, wave0 == 0 && ln_ == 0); } } while (0)
    if (PHON(100) && IN(0)) ph_prologue(a, wave0);
    SEAM(0);
#pragma unroll 1
    for (int l = 0; l < DEPTH; ++l) {
        const int P = 1 + 12 * l;
        const int Mtail = (l == DEPTH - 1) ? NLAT : NROWS;
        if (PHON(0) && IN(P + 0)) ph_norm(a, wave0, l, 0);
        SEAM(P + 0);
        if (PHON(1) && IN(P + 1)) for (int rep_ = 0; rep_ < NREP(1); ++rep_) ph_gemm_swiglu(a, wave0, NROWS);
        SEAM(P + 1);
        if (PHON(2) && IN(P + 2)) for (int rep_ = 0; rep_ < NREP(2); ++rep_) ph_gemm_store(a, wave0, 0, NROWS);
        SEAM(P + 2);
        if (PHON(3) && IN(P + 3)) ph_norm(a, wave0, l, 1);
        SEAM(P + 3);
        if (PHON(4) && IN(P + 4)) for (int rep_ = 0; rep_ < NREP(4); ++rep_) ph_gemm_store(a, wave0, 1, NROWS);
        SEAM(P + 4);
        if (PHON(5) && IN(P + 5)) for (int rep_ = 0; rep_ < NREP(5); ++rep_) ph_mla_prep(a, wave0, l);
        SEAM(P + 5);
        if (PHON(6) && IN(P + 6) && G >= 256) for (int rep_ = 0; rep_ < NREP(6); ++rep_) {
            if (ROLE(0) && vcu < 64) { for (int rr_ = 0; rr_ < NREPR(0); ++rr_) ph_rwkv(a, wave0, l, vcu); }
            else if (ROLE(1) && vcu < 96) { for (int rr_ = 0; rr_ < NREPR(1); ++rr_) ph_mlstm(a, wave0, l, vcu - 64); }
            else if (ROLE(2) && vcu < 128) { for (int rr_ = 0; rr_ < NREPR(2); ++rr_) ph_s5(a, wave0, l, vcu - 96); }
            else if (ROLE(3)) { for (int rr_ = 0; rr_ < NREPR(3); ++rr_) ph_attn(a, wave0, vcu - 128, G - 128); }
        }
        SEAM(P + 6);
        if (PHON(7) && IN(P + 7)) for (int rep_ = 0; rep_ < NREP(7); ++rep_) ph_fin(a, wave0, l, Mtail);
        SEAM(P + 7);
        if (PHON(8) && IN(P + 8)) for (int rep_ = 0; rep_ < NREP(8); ++rep_) ph_gemm_store(a, wave0, 2, Mtail);
        SEAM(P + 8);
        if (PHON(9) && IN(P + 9)) ph_norm(a, wave0, l, 2);
        SEAM(P + 9);
        if (PHON(10) && IN(P + 10)) ph_gemm_swiglu(a, wave0, Mtail);
        SEAM(P + 10);
        if (PHON(11) && IN(P + 11)) ph_gemm_store(a, wave0, 0, Mtail);
        SEAM(P + 11);
    }
#ifdef DBG_CUT
    if (lo <= NPH - 1 && NPH - 1 < hi) ph_dump(a, wave0);
#else
    if (PHON(101) && IN(NPH - 1)) ph_norm(a, wave0, DEPTH - 1, 3);
#endif
#undef IN
#undef SEAM
}

#endif
#if MK_SPLIT
struct ArgsS { Args base; int kind, l, sub, M; };
typedef const __attribute__((address_space(4))) ArgsS* KArgsS;
template <int KIND>
__global__ void __launch_bounds__(NTHR, 2) phase_kernel(ArgsS args_byval) {
    KArgsS as = (KArgsS)__builtin_amdgcn_kernarg_segment_ptr();
    KArgs a = (KArgs)as;
    const int tid = threadIdx.x; const int wave0 = __builtin_amdgcn_readfirstlane(tid >> 6);
    const int l = as->l, sub = as->sub, M = as->M;
    const int G = gridDim.x; const int vcu = (G % 8 == 0) ? ((int)blockIdx.x % 8) * (G / 8) + (int)blockIdx.x / 8 : (int)blockIdx.x;
    if constexpr (KIND == 0) ph_prologue(a, wave0);
    if constexpr (KIND == 1) ph_norm(a, wave0, l, sub);
    if constexpr (KIND == 2) ph_gemm_swiglu(a, wave0, M);
    if constexpr (KIND == 3) ph_gemm_store(a, wave0, sub, M);
    if constexpr (KIND == 4) ph_mla_prep(a, wave0, l);
    if constexpr (KIND == 5) { if (vcu < 64) ph_rwkv(a, wave0, l, vcu); }
    if constexpr (KIND == 6) { if (vcu >= 64 && vcu < 96) ph_mlstm(a, wave0, l, vcu - 64); }
    if constexpr (KIND == 7) { if (vcu >= 96 && vcu < 128) ph_s5(a, wave0, l, vcu - 96); }
    if constexpr (KIND == 8) { if (vcu >= 128) ph_attn(a, wave0, vcu - 128, G - 128); }
    if constexpr (KIND == 9) ph_fin(a, wave0, l, M);
}
template <int KIND> static void launch_phase(int grid, hipStream_t stream, const Args& base, int l, int sub, int M) {
    static bool attr = false;
    if (!attr) { (void)hipFuncSetAttribute((const void*)phase_kernel<KIND>, hipFuncAttributeMaxDynamicSharedMemorySize, LDS_BYTES); attr = true; }
    ArgsS s{}; s.base = base; s.kind = KIND; s.l = l; s.sub = sub; s.M = M;
    hipLaunchKernelGGL(phase_kernel<KIND>, dim3(grid), dim3(NTHR), LDS_BYTES, stream, s);
}
static void launch_split(int grid, hipStream_t stream, const Args& a) {
    launch_phase<0>(grid, stream, a, 0, 0, 0);
    for (int l = 0; l < DEPTH; ++l) {
        const int Mtail = (l == DEPTH - 1) ? NLAT : NROWS;
        launch_phase<1>(grid, stream, a, l, 0, 0);
        launch_phase<2>(grid, stream, a, l, 0, NROWS);
        launch_phase<3>(grid, stream, a, l, 0, NROWS);
        launch_phase<1>(grid, stream, a, l, 1, 0);
        launch_phase<3>(grid, stream, a, l, 1, NROWS);
        launch_phase<4>(grid, stream, a, l, 0, 0);
        launch_phase<5>(grid, stream, a, l, 0, 0);
        launch_phase<6>(grid, stream, a, l, 0, 0);
        launch_phase<7>(grid, stream, a, l, 0, 0);
        launch_phase<8>(grid, stream, a, l, 0, 0);
        launch_phase<9>(grid, stream, a, l, 0, Mtail);
        launch_phase<3>(grid, stream, a, l, 2, Mtail);
        launch_phase<1>(grid, stream, a, l, 2, 0);
        launch_phase<2>(grid, stream, a, l, 0, Mtail);
        launch_phase<3>(grid, stream, a, l, 0, Mtail);
    }
    launch_phase<1>(grid, stream, a, DEPTH - 1, 3, 0);
}
#endif
extern "C" void kernel_launch(void* const* d_in, const int* in_sizes, int n_in, void* d_out, int out_size, void* d_ws, size_t ws_size, hipStream_t stream) {
    static int grid = 0;
    if (grid == 0) {
        if (n_in != 43 || out_size != NLAT * D || ws_size < WS_END) { fprintf(stderr, "kernel_launch: unexpected shapes: n_in %d out %d ws %zu (need %zu)\n", n_in, out_size, ws_size, (size_t)WS_END); grid = -1; return; }
        int dev = 0, cus = 0, per_cu = 0;
        if (hipGetDevice(&dev) != hipSuccess || hipDeviceGetAttribute(&cus, hipDeviceAttributeMultiprocessorCount, dev) != hipSuccess) { grid = -1; return; }
        if (false) { grid = -1; return; }
        (void)hipGetLastError();
        grid = cus;
    }
    if (grid < 0) return;
    (void)hipMemsetAsync((char*)d_ws + WS_CTL, 0, CTL_ZERO_BYTES, stream);
    Args a{};
    for (int i = 0; i < 43; ++i) a.in[i] = (const float*)d_in[i];
    a.out = (float*)d_out; a.ws = (unsigned char*)d_ws; a.pad = 0;
#if MK_SPLIT
    launch_split(grid, stream, a);
#else
    static bool attr1 = false; if (!attr1) { (void)hipFuncSetAttribute((const void*)hybrid_fwd, hipFuncAttributeMaxDynamicSharedMemorySize, LDS_BYTES); attr1 = true; }
    a.ph_lo = 0; a.ph_hi = NPH; a.use_bar = 1;
    hipLaunchKernelGGL(hybrid_fwd, dim3(grid), dim3(NTHR), LDS_BYTES, stream, a);
#endif
}
```

```cpp
#include <hip/hip_runtime.h>
#include <cstdio>
#include <cstdint>
#define MK_SPLIT 0
namespace pg8 {
#define PG8_LAS __attribute__((address_space(3)))
typedef unsigned short bf16_t;
typedef short bf16x8 __attribute__((ext_vector_type(8)));
typedef float f32x4 __attribute__((ext_vector_type(4)));
typedef unsigned u32x4 __attribute__((ext_vector_type(4)));
constexpr int BM = 256, BK = 64, HALF = 128, HTB = HALF * BK * 2  , STAGE_BYTES = 8 * HTB, NXCD = 8, WGM = 8;

__host__ __device__ __forceinline__ int lds_byte(int r, int c) { const int st = (r >> 4) * 2 + (c >> 5), rr = r & 15, cc = c & 31, ob = rr * 64 + cc * 2; return st * 1024 + (ob ^ (((ob >> 9) & 1) << 5)); }
__host__ __device__ __forceinline__ void stage_rc(int b, int& R, int& C) { const int st = b / 1024, sb = b % 1024, swz = sb ^ (((sb >> 9) & 1) << 5); R = (st >> 1) * 16 + swz / 64; C = (st & 1) * 32 + (swz % 64) / 2; }
__host__ __device__ __forceinline__ int perm32(int rho) { const int n = rho >> 4, i = rho & 15; return 8 * (i >> 2) + 4 * n + (i & 3); }

struct Unit { int pm, pn; };
struct Gemm { const bf16_t* A; const bf16_t* Bt; int M, N, K; };

struct StaticOrder {
    int nM, nN, nwg, G, c;
    __host__ __device__ void init(int M, int N, int G_, int c_) { nM = M / BM; nN = N / BM; nwg = nM * nN; G = G_; c = c_; }
    __host__ __device__ bool next(int i, Unit& u) const {
        const long L = (long)i * G + c; if (L >= nwg) return false;
        int wgid = (int)L; { const int q = nwg / NXCD, r = nwg % NXCD, xcd = wgid % NXCD, off = wgid / NXCD; wgid = (xcd < r ? xcd * (q + 1) : r * (q + 1) + (xcd - r) * q) + off; }
        const int nig = WGM * nN, gid = wgid / nig, fm = gid * WGM, gsz = (nM - fm) < WGM ? (nM - fm) : WGM;
        u.pm = fm + ((wgid % nig) % gsz); u.pn = (wgid % nig) / gsz; return true;
    }
    __device__ __forceinline__ void a_ready(const Unit&) const {}
    __device__ __forceinline__ void done(const Unit&) const {}
};

typedef __bf16 nbf16v2 __attribute__((ext_vector_type(2))); typedef float nf32v2 __attribute__((ext_vector_type(2)));
__device__ __forceinline__ unsigned cvt_pk_bf16(float lo, float hi) { const nf32v2 v = {lo, hi}; return __builtin_bit_cast(unsigned, __builtin_convertvector(v, nbf16v2)); }
struct EpiSwiGLU {
    static constexpr bool PERM = true, AFTER_DRAIN = false;
    bf16_t* O; int ldc;
    __device__ __forceinline__ void operator()(const f32x4 (&acc)[2][2][4][2], const Unit& u, int wr, int wc, int fr, int fq) const {
        const int row0 = u.pm * BM + wr * 64 + fr; const int col0 = u.pn * HALF + wc * 32 + 8 * fq;
#pragma unroll
        for (int ai = 0; ai < 2; ++ai)
#pragma unroll
            for (int m = 0; m < 4; ++m) { bf16_t* rowp = O + (size_t)(row0 + ai * HALF + m * 16) * ldc + col0;
                float o[8];
#pragma unroll
                for (int n = 0; n < 2; ++n)
#pragma unroll
                    for (int j = 0; j < 4; ++j) { const float g = acc[ai][0][m][n][j], up = acc[ai][1][m][n][j];
                        const float sg = __builtin_amdgcn_rcpf(1.0f + __builtin_amdgcn_exp2f(-1.44269504089f * g)); o[n * 4 + j] = g * sg * up; }
                u32x4 w; w.x = cvt_pk_bf16(o[0], o[1]); w.y = cvt_pk_bf16(o[2], o[3]); w.z = cvt_pk_bf16(o[4], o[5]); w.w = cvt_pk_bf16(o[6], o[7]);
                *(u32x4*)rowp = w; }
    }
};
struct EpiStore {
    static constexpr bool PERM = true, AFTER_DRAIN = false;
    bf16_t* O; int ldc; int ncols;
    __device__ __forceinline__ void operator()(const f32x4 (&acc)[2][2][4][2], const Unit& u, int wr, int wc, int fr, int fq) const {
        const int row0 = u.pm * BM + wr * 64 + fr; const int col0 = u.pn * BM + wc * 32 + 8 * fq;
#pragma unroll
        for (int ai = 0; ai < 2; ++ai)
#pragma unroll
            for (int m = 0; m < 4; ++m) { bf16_t* rowp = O + (size_t)(row0 + ai * HALF + m * 16) * ldc + col0;
#pragma unroll
                for (int bj = 0; bj < 2; ++bj) { if (col0 + bj * HALF < ncols) { const f32x4 v0 = acc[ai][bj][m][0], v1 = acc[ai][bj][m][1];
                    u32x4 w; w.x = cvt_pk_bf16(v0[0], v0[1]); w.y = cvt_pk_bf16(v0[2], v0[3]); w.z = cvt_pk_bf16(v1[0], v1[1]); w.w = cvt_pk_bf16(v1[2], v1[3]);
                    *(u32x4*)(rowp + bj * HALF) = w; } } }
    }
};
template <class Epi, class Sched, bool ALIGN_EPI = false, bool SP2 = false>
__device__ __forceinline__ void gemm_phase(PG8_LAS unsigned char* lds, const Gemm g, const Sched& S, const Epi& E, const int tid) {
    const int wid = __builtin_amdgcn_readfirstlane(tid >> 6), lane = tid & 63, wr = wid >> 2, wc = wid & 3, fr = lane & 15, fq = lane >> 4;
    const int K = g.K, nt = K / BK;
    unsigned voffA[2], voffB[2];
#pragma unroll
    for (int i = 0; i < 2; ++i) { int R, C; stage_rc(tid * 16 + i * 8192, R, C); const int Rb = Epi::PERM ? ((R & ~31) + perm32(R & 31)) : R;
        voffA[i] = (unsigned)(R * K + C) * 2u; voffB[i] = (unsigned)(Rb * K + C) * 2u; }
    const size_t kstep = (size_t)(BK * 2);
    const size_t hstep = (size_t)HALF * K * 2;
    const size_t tstep = 2 * hstep;
    const unsigned ldsw = (unsigned)wid * 1024u;
    const int aoff = lds_byte(wr * 64 + fr, fq * 8), boff = lds_byte(wc * 32 + fr, fq * 8);
#define PG8_SA(b, h) (((b) * 2 + (h)) * HTB)
#define PG8_SB(b, h) ((4 + (b) * 2 + (h)) * HTB)
#define PG8_STAGE(bufoff, gbase, voff) do { _Pragma("unroll") for (int _i = 0; _i < 2; ++_i) \
        __builtin_amdgcn_global_load_lds((const unsigned*)((const char*)(gbase) + (voff)[_i]), (PG8_LAS unsigned*)(lds + (bufoff) + ldsw + _i * 8192), 16, 0, 0); } while (0)
#define PG8_LDA(dst, b, h) do { _Pragma("unroll") for (int m = 0; m < 4; ++m) _Pragma("unroll") for (int k = 0; k < 2; ++k) dst[m][k] = *(const PG8_LAS bf16x8*)(lds + PG8_SA(b, h) + aoff + m * 2048 + k * 1024); } while (0)
#define PG8_LDB(dst, b, h) do { _Pragma("unroll") for (int n = 0; n < 2; ++n) _Pragma("unroll") for (int k = 0; k < 2; ++k) dst[n][k] = *(const PG8_LAS bf16x8*)(lds + PG8_SB(b, h) + boff + n * 2048 + k * 1024); } while (0)
#define PG8_MMA(ai, bj, At, Bt) do { __builtin_amdgcn_s_setprio(1); _Pragma("unroll") for (int m = 0; m < 4; ++m) _Pragma("unroll") for (int n = 0; n < 2; ++n) _Pragma("unroll") for (int k = 0; k < 2; ++k) \
        acc[ai][bj][m][n] = __builtin_amdgcn_mfma_f32_16x16x32_bf16(Bt[n][k], At[m][k], acc[ai][bj][m][n], 0, 0, 0); __builtin_amdgcn_s_setprio(0); } while (0)
#define PG8_WAIT_V(n) asm volatile("s_waitcnt vmcnt(" #n ")" ::: "memory")
#define PG8_WAIT_L(n) asm volatile("s_waitcnt lgkmcnt(" #n ")" ::: "memory")
#define PG8_BAR __builtin_amdgcn_s_barrier()
#define PG8_SCHED __builtin_amdgcn_sched_barrier(0)
    Unit cur, nxt; int ui = 0;
    if (!S.next(0, cur)) return;
    f32x4 acc[2][2][4][2];
#pragma unroll
    for (int a = 0; a < 2; ++a)
#pragma unroll
        for (int b = 0; b < 2; ++b)
#pragma unroll
            for (int m = 0; m < 4; ++m)
#pragma unroll
                for (int n = 0; n < 2; ++n) acc[a][b][m][n] = (f32x4){0.f, 0.f, 0.f, 0.f};
    bf16x8 At[4][2], B0[2][2], B1[2][2];
    const char* cA = (const char*)g.A + (size_t)cur.pm * tstep; const char* cB = (const char*)g.Bt + (size_t)cur.pn * tstep;
    S.a_ready(cur);
    if constexpr (SP2) {
        PG8_STAGE(PG8_SB(0, 0), cB, voffB); PG8_STAGE(PG8_SB(0, 1), cB + hstep, voffB); PG8_STAGE(PG8_SA(0, 0), cA, voffA); PG8_STAGE(PG8_SA(0, 1), cA + hstep, voffA);
        if (wr == 1) PG8_BAR;
        PG8_WAIT_V(2); PG8_BAR;
        PG8_STAGE(PG8_SB(1, 0), cB + kstep, voffB); PG8_STAGE(PG8_SA(1, 0), cA + kstep, voffA); PG8_STAGE(PG8_SB(1, 1), cB + hstep + kstep, voffB);
        PG8_WAIT_V(6); PG8_BAR;
    } else {
        PG8_STAGE(PG8_SB(0, 0), cB, voffB); PG8_STAGE(PG8_SA(0, 0), cA, voffA); PG8_STAGE(PG8_SB(0, 1), cB + hstep, voffB); PG8_STAGE(PG8_SA(0, 1), cA + hstep, voffA);
        if (wr == 1) PG8_BAR;
        PG8_WAIT_V(4); PG8_BAR;
        PG8_STAGE(PG8_SB(1, 0), cB + kstep, voffB); PG8_STAGE(PG8_SA(1, 0), cA + kstep, voffA); PG8_STAGE(PG8_SB(1, 1), cB + hstep + kstep, voffB);
        PG8_WAIT_V(6); PG8_BAR;
    }
    for (;;) {
        const bool has_next = S.next(ui + 1, nxt);
        const char* nA = has_next ? (const char*)g.A + (size_t)nxt.pm * tstep : cA; const char* nB = has_next ? (const char*)g.Bt + (size_t)nxt.pn * tstep : cB;
        for (int t = 0; t < nt; t += 2) {
            const bool last = (t == nt - 2);
            const char* a1 = cA + (size_t)(t + 1) * kstep;
            const char* a2 = last ? nA : cA + (size_t)(t + 2) * kstep; const char* b2 = last ? nB : cB + (size_t)(t + 2) * kstep;
            const char* a3 = a2 + kstep; const char* b3 = b2 + kstep;
            if (last && has_next) S.a_ready(nxt);
            if constexpr (SP2) {
            PG8_LDB(B0, 0, 0); PG8_LDB(B1, 0, 1); PG8_SCHED; PG8_LDA(At, 0, 0); PG8_STAGE(PG8_SA(1, 1), a1 + hstep, voffA);
            PG8_WAIT_V(8); PG8_WAIT_L(0); PG8_BAR; PG8_MMA(0, 0, At, B0); PG8_MMA(0, 1, At, B1); PG8_BAR; PG8_SCHED;
            PG8_LDA(At, 0, 1); PG8_STAGE(PG8_SB(0, 0), b2, voffB); PG8_STAGE(PG8_SB(0, 1), b2 + hstep, voffB); PG8_STAGE(PG8_SA(0, 0), a2, voffA);
            PG8_WAIT_V(8); PG8_WAIT_L(0); PG8_BAR; PG8_MMA(1, 0, At, B0); PG8_MMA(1, 1, At, B1); PG8_BAR; PG8_SCHED;
            PG8_LDB(B0, 1, 0); PG8_LDB(B1, 1, 1); PG8_SCHED; PG8_LDA(At, 1, 0); PG8_STAGE(PG8_SA(0, 1), a2 + hstep, voffA);
            PG8_WAIT_V(8); PG8_WAIT_L(0); PG8_BAR; PG8_MMA(0, 0, At, B0); PG8_MMA(0, 1, At, B1); PG8_BAR; PG8_SCHED;
            PG8_LDA(At, 1, 1); PG8_STAGE(PG8_SB(1, 0), b3, voffB); PG8_STAGE(PG8_SB(1, 1), b3 + hstep, voffB); PG8_STAGE(PG8_SA(1, 0), a3, voffA);
            PG8_WAIT_V(8); PG8_WAIT_L(0); PG8_BAR; PG8_MMA(1, 0, At, B0); PG8_MMA(1, 1, At, B1); PG8_BAR; PG8_SCHED;
            } else {
            PG8_LDB(B0, 0, 0); PG8_SCHED; PG8_LDA(At, 0, 0); PG8_STAGE(PG8_SA(1, 1), a1 + hstep, voffA);
            PG8_WAIT_L(8); PG8_BAR; PG8_WAIT_L(0); PG8_MMA(0, 0, At, B0); PG8_BAR; PG8_SCHED;
            PG8_LDB(B1, 0, 1); PG8_STAGE(PG8_SB(0, 0), b2, voffB);
            PG8_BAR; PG8_WAIT_L(0); PG8_MMA(0, 1, At, B1); PG8_BAR;
            PG8_LDA(At, 0, 1); PG8_STAGE(PG8_SA(0, 0), a2, voffA);
            PG8_BAR; PG8_WAIT_L(0); PG8_MMA(1, 0, At, B0); PG8_BAR; PG8_SCHED;
            PG8_STAGE(PG8_SB(0, 1), b2 + hstep, voffB);
            PG8_WAIT_V(6); PG8_BAR; PG8_MMA(1, 1, At, B1); PG8_BAR;
            PG8_LDB(B0, 1, 0); PG8_SCHED; PG8_LDA(At, 1, 0); PG8_STAGE(PG8_SA(0, 1), a2 + hstep, voffA);
            PG8_WAIT_L(8); PG8_BAR; PG8_WAIT_L(0); PG8_MMA(0, 0, At, B0); PG8_BAR; PG8_SCHED;
            PG8_LDB(B1, 1, 1); PG8_STAGE(PG8_SB(1, 0), b3, voffB);
            PG8_BAR; PG8_WAIT_L(0); PG8_MMA(0, 1, At, B1); PG8_BAR;
            PG8_LDA(At, 1, 1); PG8_STAGE(PG8_SA(1, 0), a3, voffA);
            PG8_BAR; PG8_WAIT_L(0); PG8_MMA(1, 0, At, B0); PG8_BAR; PG8_SCHED;
            PG8_STAGE(PG8_SB(1, 1), b3 + hstep, voffB);
            PG8_WAIT_V(6); PG8_BAR; PG8_MMA(1, 1, At, B1); PG8_BAR;
            }
        }
        if constexpr (ALIGN_EPI) { if (wr == 0) PG8_BAR; }
        if constexpr (!Epi::AFTER_DRAIN) { E(acc, cur, wr, wc, fr, fq); S.done(cur); }
        if (!has_next) break;
#pragma unroll
        for (int a = 0; a < 2; ++a)
#pragma unroll
            for (int b = 0; b < 2; ++b)
#pragma unroll
                for (int m = 0; m < 4; ++m)
#pragma unroll
                    for (int n = 0; n < 2; ++n) acc[a][b][m][n] = (f32x4){0.f, 0.f, 0.f, 0.f};
        cur = nxt; cA = nA; cB = nB; ++ui;
        if constexpr (ALIGN_EPI) { if (wr == 1) PG8_BAR; }
    }
    PG8_WAIT_V(0);
    if constexpr (!ALIGN_EPI) { if (wr == 0) PG8_BAR; }
    PG8_BAR;
    if constexpr (Epi::AFTER_DRAIN) { E.fused(acc, cur, wr, wc, fr, fq, lds, wid, lane); S.done(cur); }
#undef PG8_SA
#undef PG8_SB
#undef PG8_STAGE
#undef PG8_LDA
#undef PG8_LDB
#undef PG8_MMA
#undef PG8_WAIT_V
#undef PG8_WAIT_L
#undef PG8_BAR
#undef PG8_SCHED
}
}
#define PG8_SP2 true
#define PG8_ALIGN true

constexpr int NWAVES = 8, NTHR = 512;
constexpr int D = 1024, NB = 8, T = 4096, TC = 256, DEPTH = 4, FF = 2816, ZP = 2608, ZPAD = 2816;
constexpr int NLAT = NB * T, NCTX = NB * TC, NROWS = NLAT + NCTX;
constexpr int MODW = 9 * D;
constexpr int NKEY = TC + T;
constexpr float NORM_EPS = 1e-6f;
constexpr int ZS5 = 0, ZCQ = 256, ZCKV = 512, ZKR = 640, ZRKV = 672, ZWD = 1440, ZAD = 1472, ZGD = 1504, ZMQK = 1568, ZMV = 2080, ZMO = 2336, ZMG = 2592;

constexpr size_t MiB = 1u << 20;
constexpr size_t WS_CTL = 0, CTL_ZERO_BYTES = 1 * MiB;
constexpr size_t WS_MODV = 1 * MiB;
constexpr size_t WS_ROPE = 3 * MiB;
constexpr size_t WS_SMALLW = 4 * MiB;
constexpr size_t SW_UQ = 0, SW_UKV = 196608, SW_GLU = 327680, SW_GUP = 458752;
constexpr size_t WS_WGU = 6 * MiB, WS_WDN = 17 * MiB, WS_WIN = 23 * MiB, WS_WOUT = 29 * MiB;
constexpr size_t WS_X = 31 * MiB;
constexpr size_t WS_Y = 167 * MiB;
constexpr size_t WS_Q = WS_Y, WS_K = WS_Y + (size_t)NROWS * 384 * 2, WS_VT = WS_K + (size_t)NROWS * 384 * 2;
constexpr size_t WS_H = 235 * MiB;
constexpr size_t WS_ACT = 303 * MiB;
constexpr size_t WS_YS5 = 490 * MiB, WS_YR = 524 * MiB, WS_YM = 558 * MiB, WS_END = 592 * MiB;
static_assert(WS_VT + (size_t)NB * 4 * 64 * NKEY * 2 <= WS_H, "qkv overlay");
static_assert(WS_WGU + (size_t)5632 * 1024 * 2 <= WS_WDN && WS_WDN + (size_t)1024 * 2816 * 2 <= WS_WIN && WS_WIN + (size_t)2816 * 1024 * 2 <= WS_WOUT && WS_WOUT + 2 * MiB <= WS_X, "weights");
static_assert(WS_X + (size_t)NROWS * D * 4 <= WS_Y && WS_Y + (size_t)NROWS * D * 2 <= WS_H && WS_H + (size_t)NROWS * D * 2 <= WS_ACT && WS_ACT + (size_t)NROWS * ZPAD * 2 <= WS_YS5, "map");
static_assert(WS_YS5 + (size_t)2 * NROWS * 256 * 2 <= WS_YR && WS_YM + (size_t)2 * NROWS * 256 * 2 <= WS_END, "map2");
constexpr int CW_BAR = 4096;

constexpr int RING_BYTES = 131072, LDS_BYTES = 147456, LDSCTL_OFF = LDS_BYTES - 512, MISC_OFF = LDSCTL_OFF + 320;

#define GAS __attribute__((address_space(1)))
#define LAS __attribute__((address_space(3)))
typedef unsigned short bf16;
typedef unsigned char uchar;
typedef unsigned v4u __attribute__((ext_vector_type(4)));
typedef unsigned v2u __attribute__((ext_vector_type(2)));
typedef float f32x4 __attribute__((ext_vector_type(4)));
typedef float f32x16 __attribute__((ext_vector_type(16)));
typedef short bf16x8 __attribute__((ext_vector_type(8)));
typedef short bf16x4 __attribute__((ext_vector_type(4)));
#define DI __device__ __forceinline__
DI unsigned f2bf(float f) { unsigned u = __builtin_bit_cast(unsigned, f); return (u + 0x7fffu + ((u >> 16) & 1u)) >> 16; }
DI unsigned pk2(float lo, float hi) { return pg8::cvt_pk_bf16(lo, hi); }
DI float bf2f(unsigned b) { return __builtin_bit_cast(float, b << 16); }
DI float bflo(unsigned w) { return __builtin_bit_cast(float, w << 16); }
DI float bfhi(unsigned w) { return __builtin_bit_cast(float, w & 0xffff0000u); }
template <int CTRL> DI float dpp_f(float x) { return __builtin_bit_cast(float, __builtin_amdgcn_update_dpp(0, __builtin_bit_cast(int, x), CTRL, 0xf, 0xf, true)); }
DI float sum8(float x) { x += dpp_f<0xB1>(x); x += dpp_f<0x4E>(x); x += dpp_f<0x141>(x); return x; }
DI float sum16(float x) { x = sum8(x); x += dpp_f<0x140>(x); return x; }
template <int CTRL, int RM> DI float dpp_z(float x) { return __builtin_bit_cast(float, __builtin_amdgcn_update_dpp(0, __builtin_bit_cast(int, x), CTRL, RM, 0xf, true)); }
template <int CTRL, int RM> DI float dpp_o(float old, float x) { return __builtin_bit_cast(float, __builtin_amdgcn_update_dpp(__builtin_bit_cast(int, old), __builtin_bit_cast(int, x), CTRL, RM, 0xf, false)); }
DI float wave_scan_sum(float x) {
    x += dpp_z<0x111, 0xf>(x); x += dpp_z<0x112, 0xf>(x); x += dpp_z<0x114, 0xf>(x); x += dpp_z<0x118, 0xf>(x);
    x += dpp_z<0x142, 0xa>(x); x += dpp_z<0x143, 0xc>(x); return x;
}
DI float wave_scan_max(float x) {
    const float ninf = -3.0e38f;
    x = fmaxf(x, dpp_o<0x111, 0xf>(ninf, x)); x = fmaxf(x, dpp_o<0x112, 0xf>(ninf, x)); x = fmaxf(x, dpp_o<0x114, 0xf>(ninf, x)); x = fmaxf(x, dpp_o<0x118, 0xf>(ninf, x));
    x = fmaxf(x, dpp_o<0x142, 0xa>(ninf, x)); x = fmaxf(x, dpp_o<0x143, 0xc>(ninf, x)); return x;
}
DI float wave_sum(float v) { v = sum16(v); v += __shfl_xor(v, 16); v += __shfl_xor(v, 32); return v; }
DI float wave_max(float v) {
#pragma unroll
    for (int o = 1; o < 64; o <<= 1) v = fmaxf(v, __shfl_xor(v, o));
    return v;
}
DI void lds_barrier() { asm volatile("s_waitcnt lgkmcnt(0)" ::: "memory"); __builtin_amdgcn_s_barrier(); asm volatile("" ::: "memory"); }
DI float fexp(float x) { return __builtin_amdgcn_exp2f(x * 1.44269504089f); }
DI float fsigmoid(float x) { return __builtin_amdgcn_rcpf(1.0f + fexp(-x)); }
DI f32x16 mfma32(bf16x8 a, bf16x8 b, f32x16 c) { return __builtin_amdgcn_mfma_f32_32x32x16_bf16(a, b, c, 0, 0, 0); }
DI f32x4 mfma16(bf16x8 a, bf16x8 b, f32x4 c) { return __builtin_amdgcn_mfma_f32_16x16x32_bf16(a, b, c, 0, 0, 0); }
DI int crow(int r, int h) { return (r & 3) + 8 * (r >> 2) + 4 * h; }
DI bf16x8 pack8(float a0, float a1, float a2, float a3, float a4, float a5, float a6, float a7) {
    typedef __bf16 nb8 __attribute__((ext_vector_type(8))); typedef float nf8 __attribute__((ext_vector_type(8)));
    const nf8 v = {a0, a1, a2, a3, a4, a5, a6, a7}; return __builtin_bit_cast(bf16x8, __builtin_convertvector(v, nb8));
}
DI void my_sincosf(float x, float& s, float& c) {
    const float k = __builtin_rintf(x * 0.63661977236758134f);
    float r = __builtin_fmaf(-k, 1.5703125f, x); r = __builtin_fmaf(-k, 4.837512969970703125e-4f, r); r = __builtin_fmaf(-k, 7.54978995489188216e-8f, r);
    const float r2 = r * r;
    const float ps = r + r * r2 * (-1.6666654611e-1f + r2 * (8.3321608736e-3f + r2 * (-1.9515295891e-4f)));
    const float pc = 1.0f - 0.5f * r2 + r2 * r2 * (4.166664568298827e-2f + r2 * (-1.388731625493765e-3f + r2 * 2.443315711809948e-5f));
    const int q = ((int)k) & 3;
    const float ss = (q & 1) ? pc : ps, cc = (q & 1) ? ps : pc;
    s = (q & 2) ? -ss : ss; c = ((q + 1) & 2) ? -cc : cc;
}

#define XB_TMO      128
#define XB_XCNT(j)  (256  + 64 * (j))
#define XB_XSUB(j)  (1280 + 64 * (j))
#define XB_XGEN(j)  (2304 + 64 * (j))
#define XB_TOP      3328
#define XB_TOPGEN   3392
#define XCD_BAR_WORDS 3456
#define XB_SPIN_CAP (1u << 22)
DI unsigned xb_ld(unsigned* p)              { return __hip_atomic_load(p, __ATOMIC_RELAXED, __HIP_MEMORY_SCOPE_AGENT); }
DI unsigned xb_add(unsigned* p, unsigned v) { return __hip_atomic_fetch_add(p, v, __ATOMIC_RELAXED, __HIP_MEMORY_SCOPE_AGENT); }
DI unsigned xb_xcc_id() { return (unsigned)__builtin_amdgcn_s_getreg((3 << 11) | 20) & 0xFu; }
#define XB_SPIN(cond, bar) do { unsigned _sp = 0; while (cond) { __builtin_amdgcn_s_sleep(1); \
    if ((++_sp & 255u) == 0u) { if (xb_ld(&(bar)[XB_TMO])) break; if (_sp > XB_SPIN_CAP) { atomicAdd(&(bar)[XB_TMO], 1u); break; } } } } while (0)
struct XcdBarrier { unsigned* bar; unsigned x; volatile LAS unsigned* st; };
DI XcdBarrier xcd_barrier_post(unsigned* bar, volatile LAS unsigned* st, bool t0) {
    XcdBarrier b; b.bar = bar; b.x = xb_xcc_id(); b.st = st;
    if (t0) (void)xb_add(&bar[XB_XCNT(b.x)], 1u);
    return b;
}
DI void xcd_barrier_complete(unsigned* bar, unsigned x, unsigned& nloc, unsigned& nx) {
    const unsigned G = gridDim.x * gridDim.y * gridDim.z;
    unsigned sum, cnt, mine, sp = 0u;
    for (;;) {
        sum = 0u; cnt = 0u; mine = 0u;
#pragma unroll
        for (unsigned j = 0; j < 16; ++j) { const unsigned c = xb_ld(&bar[XB_XCNT(j)]); sum += c; cnt += (c > 0u) ? 1u : 0u; mine = (j == x) ? c : mine; }
        if (sum == G) break;
        __builtin_amdgcn_s_sleep(1);
        if ((++sp & 255u) == 0u) { if (xb_ld(&bar[XB_TMO])) break; if (sp > XB_SPIN_CAP) { atomicAdd(&bar[XB_TMO], 1u); break; } }
    }
    nloc = mine > 0u ? mine : 1u; nx = cnt > 0u ? cnt : 1u;
}
DI void xcd_barrier(const XcdBarrier& b, bool t0) {
    asm volatile("s_waitcnt vmcnt(0)" ::: "memory");
    __syncthreads();
    if (t0) {
        unsigned* bar = b.bar;
        __builtin_amdgcn_s_waitcnt(0);
        unsigned nloc = b.st[0], nx = b.st[1];
        if (nloc == 0u) { xcd_barrier_complete(bar, b.x, nloc, nx); b.st[0] = nloc; b.st[1] = nx; }
        const unsigned old = xb_add(&bar[XB_XSUB(b.x)], 1u);
        const unsigned gen = old / nloc;
        if (old + 1u == (gen + 1u) * nloc) {
            __builtin_amdgcn_fence(__ATOMIC_RELEASE, "agent");
            asm volatile("s_waitcnt vmcnt(0)" ::: "memory");
            const unsigned og = xb_add(&bar[XB_TOP], 1u);
            const unsigned tg = og / nx;
            if (og + 1u == (tg + 1u) * nx) xb_add(&bar[XB_TOPGEN], 1u);
            else XB_SPIN(xb_ld(&bar[XB_TOPGEN]) == tg, bar);
            __builtin_amdgcn_fence(__ATOMIC_ACQUIRE, "agent");
            xb_add(&bar[XB_XGEN(b.x)], 1u);
            asm volatile("s_waitcnt vmcnt(0)" ::: "memory");
        } else {
            XB_SPIN(xb_ld(&bar[XB_XGEN(b.x)]) == gen, bar);
            __builtin_amdgcn_fence(__ATOMIC_ACQUIRE, "agent");
            asm volatile("s_waitcnt vmcnt(0)" ::: "memory");
        }
    }
    __syncthreads();
}

struct Args { const float* in[43]; float* out; unsigned char* ws; int ph_lo, ph_hi, use_bar, pad; };
typedef const __attribute__((address_space(4))) Args* KArgs;
enum { I_X = 0, I_C, I_CTX, I_CCTX, I_WADA, I_BADA, I_NPRE, I_NPOST, I_WG, I_WU, I_WD, I_WIN, I_WOUT, I_S5LRE, I_S5LIM, I_S5DT, I_S5BRE, I_S5BIM, I_S5CRE, I_S5CIM, I_S5D, I_S5GLU, I_S5BGLU,
       I_MQN, I_MKVN, I_MUQ, I_MUKV, I_RCW, I_RCB, I_RW0, I_RWUP, I_RA0, I_RAUP, I_RGUP, I_RKK, I_RKA, I_RRK, I_RLNW, I_RLNB, I_MCW, I_MCB, I_MGB, I_MNORM };

struct Ctx {
    LAS uchar* lds; int tid, lane, wave, vcu, G;
};
DI int tok_row(int b, int seg, int t) { return seg ? b * T + t : NLAT + b * TC + t; }
DI void phase_prologue(KArgs a, const Ctx& F) {
    LAS float* sc = (LAS float*)F.lds;
    LAS float* red = (LAS float*)(F.lds + 40960);
    const float* c = a->in[I_C]; const float* cc = a->in[I_CCTX];
    for (int i = F.tid; i < 9 * D; i += NTHR) { const float v = (i < 8 * D) ? c[i] : cc[i - 8 * D]; sc[i] = v * fsigmoid(v); }
    __syncthreads();
    const float* wada = a->in[I_WADA]; const float* bada = a->in[I_BADA];
    float* modv = (float*)(a->ws + WS_MODV);
    for (int task = F.vcu; task < DEPTH * 144; task += F.G) {
        const int l = task / 144, nb = task % 144, n = nb * 64 + F.lane;
        const float* wp = wada + ((size_t)l * D + F.wave * 128) * MODW + n;
        float acc[9];
#pragma unroll
        for (int m = 0; m < 9; ++m) acc[m] = 0.f;
#pragma unroll 8
        for (int k = 0; k < 128; ++k) { const float w = wp[(size_t)k * MODW];
#pragma unroll
            for (int m = 0; m < 9; ++m) acc[m] += sc[m * D + F.wave * 128 + k] * w; }
#pragma unroll
        for (int m = 0; m < 9; ++m) red[(F.wave * 9 + m) * 64 + F.lane] = acc[m];
        __syncthreads();
        for (int i = F.tid; i < 576; i += NTHR) { const int m = i >> 6, ln = i & 63; float s = 0.f;
#pragma unroll
            for (int w = 0; w < 8; ++w) s += red[(w * 9 + m) * 64 + ln];
            modv[((size_t)l * 9 + m) * MODW + nb * 64 + ln] = s + bada[l * MODW + nb * 64 + ln]; }
        __syncthreads();
    }
    float* rc = (float*)(a->ws + WS_ROPE); float* rs = rc + T * 16;
    for (int i = F.vcu * NTHR + F.tid; i < T * 16; i += F.G * NTHR) {
        const int t = i >> 4, f = i & 15, pos = f < 8 ? (t >> 6) : (t & 63), fi = f & 7;
        const float invf = (fi == 0) ? 1.0f : (fi == 1) ? 0.31622776601683794f : (fi == 2) ? 0.1f : (fi == 3) ? 0.031622776601683794f : (fi == 4) ? 0.01f : (fi == 5) ? 0.0031622776601683794f : (fi == 6) ? 0.001f : 0.00031622776601683794f;
        const float ang = (float)pos * invf; float s, co; my_sincosf(ang, s, co);
        rc[i] = co; rs[i] = s;
    }
}

DI void tr_item(const float* W, int K, int N, bf16* WT, int kb, int n0, int drow0, LAS float* scr, int lane) {
    const int k0 = 64 * kb, nn = n0 + (lane & 31);
#pragma unroll 8
    for (int i = 0; i < 32; ++i) { const int kk = 2 * i + (lane >> 5); scr[kk * 33 + (lane & 31)] = (nn < N) ? W[(size_t)(k0 + kk) * N + nn] : 0.f; }
    const int c = lane & 7;
#pragma unroll
    for (int j = 0; j < 4; ++j) { const int n = (lane >> 3) + 8 * j; const LAS float* s = scr + (8 * c) * 33 + n;
        v4u o; o.x = pk2(s[0 * 33], s[1 * 33]); o.y = pk2(s[2 * 33], s[3 * 33]); o.z = pk2(s[4 * 33], s[5 * 33]); o.w = pk2(s[6 * 33], s[7 * 33]);
        if (n0 + n < N) *(v4u*)(WT + (size_t)(drow0 + n) * K + k0 + 8 * c) = o; }
}
DI void convert_weights(KArgs a, const Ctx& F, int l, int set) {
    LAS float* scr = (LAS float*)(F.lds + F.wave * 8704);
    const int gw = F.vcu * NWAVES + F.wave, NGW = F.G * NWAVES;
    bf16* WGU = (bf16*)(a->ws + WS_WGU); bf16* WDN = (bf16*)(a->ws + WS_WDN); bf16* WIN = (bf16*)(a->ws + WS_WIN); bf16* WOUT = (bf16*)(a->ws + WS_WOUT);
    bf16* SW = (bf16*)(a->ws + WS_SMALLW);
    const int fl = l * 2 + set;
    const float* wg = a->in[I_WG] + (size_t)fl * D * FF; const float* wu = a->in[I_WU] + (size_t)fl * D * FF; const float* wd = a->in[I_WD] + (size_t)fl * FF * D;
    constexpr int I_G = 16 * 88, I_D = 44 * 32, I_IN = 16 * 82, I_O = 16 * 32, I_UQ = 4 * 12, I_UKV = 2 * 16, I_GLU = 4 * 8, I_GUP = 1 * 8;
    const int nitems = set == 0 ? (2 * I_G + I_D + I_IN + I_O + I_UQ + I_UKV + I_GLU + I_GUP) : (2 * I_G + I_D);
    for (int it = gw; it < nitems; it += NGW) {
        int r = it;
        if (r < I_G) { const int kb = r / 88, nb = r % 88, n0 = 32 * nb; tr_item(wg, D, FF, WGU, kb, n0, 256 * (n0 >> 7) + (n0 & 127), scr, F.lane); continue; } r -= I_G;
        if (r < I_G) { const int kb = r / 88, nb = r % 88, n0 = 32 * nb; tr_item(wu, D, FF, WGU, kb, n0, 256 * (n0 >> 7) + 128 + (n0 & 127), scr, F.lane); continue; } r -= I_G;
        if (r < I_D) { const int kb = r / 32, nb = r % 32; tr_item(wd, FF, D, WDN, kb, 32 * nb, 32 * nb, scr, F.lane); continue; } r -= I_D;
        if (r < I_IN) { const int kb = r / 82, nb = r % 82; tr_item(a->in[I_WIN] + (size_t)l * D * ZP, D, ZP, WIN, kb, 32 * nb, 32 * nb, scr, F.lane); continue; } r -= I_IN;
        if (r < I_O) { const int kb = r / 32, nb = r % 32; tr_item(a->in[I_WOUT] + (size_t)l * D * D, D, D, WOUT, kb, 32 * nb, 32 * nb, scr, F.lane); continue; } r -= I_O;
        if (r < I_UQ) { const int kb = r / 12, nb = r % 12; tr_item(a->in[I_MUQ] + (size_t)l * 256 * 384, 256, 384, (bf16*)((uchar*)SW + SW_UQ), kb, 32 * nb, 32 * nb, scr, F.lane); continue; } r -= I_UQ;
        if (r < I_UKV) { const int kb = r / 16, nb = r % 16; tr_item(a->in[I_MUKV] + (size_t)l * 128 * 512, 128, 512, (bf16*)((uchar*)SW + SW_UKV), kb, 32 * nb, 32 * nb, scr, F.lane); continue; } r -= I_UKV;
        if (r < I_GLU) { const int kb = r / 8, nb = r % 8; tr_item(a->in[I_S5GLU] + (size_t)l * 256 * 256, 256, 256, (bf16*)((uchar*)SW + SW_GLU), kb, 32 * nb, 32 * nb, scr, F.lane); continue; } r -= I_GLU;
        { const int nb = r; tr_item(a->in[I_RGUP] + (size_t)l * 64 * 256, 64, 256, (bf16*)((uchar*)SW + SW_GUP), 0, 32 * nb, 32 * nb, scr, F.lane); }
    }
    if (set == 0) {
        unsigned zz_ = 0u; asm volatile("" : "+v"(zz_)); v4u z = {zz_, zz_, zz_, zz_}; v4u* p = (v4u*)(WIN + (size_t)ZP * D);
        for (int i = F.vcu * NTHR + F.tid; i < (ZPAD - ZP) * D / 8; i += F.G * NTHR) p[i] = z;
    }
}

DI void norm_rows(KArgs a, const Ctx& F, bool p_first, bool p_hasY, bool p_hasH, bool p_final, int p_nrows, const float* p_modY, int p_gi, const float* p_pw, float p_coef, const float* p_modH, int p_si, const float* p_prew) {
    float* X = (float*)(a->ws + WS_X); const bf16* Y = (const bf16*)(a->ws + WS_Y); bf16* H = (bf16*)(a->ws + WS_H);
    const int gw = F.vcu * NWAVES + F.wave, NGW = F.G * NWAVES, lane = F.lane;
    const int rpw = (p_nrows + NGW - 1) / NGW, r0 = gw * rpw, r1 = (r0 + rpw < p_nrows) ? (r0 + rpw) : p_nrows;
    if (r0 >= r1) return;
    f32x4 cA[4], cB[4], cC[4];
    int cur_mr = -1;
    f32x4 vn[4]; v2u yn[4];
    auto issue = [&](int r) {
        const float* xs = p_first ? (r < NLAT ? a->in[I_X] + (size_t)r * D : a->in[I_CTX] + (size_t)(r - NLAT) * D) : X + (size_t)r * D;
#pragma unroll
        for (int j = 0; j < 4; ++j) vn[j] = *(const f32x4*)(xs + 4 * lane + 256 * j);
        if (p_hasY) {
#pragma unroll
            for (int j = 0; j < 4; ++j) yn[j] = *(const v2u*)(Y + (size_t)r * D + 4 * lane + 256 * j);
        }
    };
    issue(r0);
    for (int r = r0; r < r1; ++r) {
        const int mr = r < NLAT ? (r >> 12) : 8;
        if (mr != cur_mr) { cur_mr = mr;
            const float* g = p_modY + (size_t)mr * MODW + p_gi * D; const float* sh = p_modH + (size_t)mr * MODW + p_si * D; const float* scp = sh + D;
#pragma unroll
            for (int j = 0; j < 4; ++j) { const int o = 4 * lane + 256 * j;
                cA[j] = p_hasY ? (*(const f32x4*)(g + o) * p_coef) * *(const f32x4*)(p_pw + o) : (f32x4){0.f, 0.f, 0.f, 0.f};
                if (p_hasH) { cB[j] = *(const f32x4*)(p_prew + o) * (*(const f32x4*)(scp + o) + 1.0f); cC[j] = *(const f32x4*)(sh + o); } else { cB[j] = cA[j]; cC[j] = cA[j]; } } }
        f32x4 v[4]; v2u yw[4];
#pragma unroll
        for (int j = 0; j < 4; ++j) { v[j] = vn[j]; yw[j] = yn[j]; }
        if (r + 1 < r1) issue(r + 1);
        if (p_hasY) {
            f32x4 y[4]; float ss = 0.f;
#pragma unroll
            for (int j = 0; j < 4; ++j) { y[j] = (f32x4){bflo(yw[j].x), bfhi(yw[j].x), bflo(yw[j].y), bfhi(yw[j].y)};
                ss += (y[j].x * y[j].x + y[j].y * y[j].y) + (y[j].z * y[j].z + y[j].w * y[j].w); }
            const float rstd = __builtin_amdgcn_rsqf(wave_sum(ss) * (1.0f / D) + NORM_EPS);
#pragma unroll
            for (int j = 0; j < 4; ++j) v[j] = v[j] + cA[j] * (y[j] * rstd);
        }
        if (p_final) {
#pragma unroll
            for (int j = 0; j < 4; ++j) *(f32x4*)(a->out + (size_t)r * D + 4 * lane + 256 * j) = v[j];
        } else if (p_hasY || p_first) {
#pragma unroll
            for (int j = 0; j < 4; ++j) *(f32x4*)(X + (size_t)r * D + 4 * lane + 256 * j) = v[j];
        }
        if (p_hasH) {
            float ss = 0.f;
#pragma unroll
            for (int j = 0; j < 4; ++j) ss += (v[j].x * v[j].x + v[j].y * v[j].y) + (v[j].z * v[j].z + v[j].w * v[j].w);
            const float rstd = __builtin_amdgcn_rsqf(wave_sum(ss) * (1.0f / D) + NORM_EPS);
#pragma unroll
            for (int j = 0; j < 4; ++j) { const f32x4 h = (v[j] * rstd) * cB[j] + cC[j];
                v2u o; o.x = pk2(h.x, h.y); o.y = pk2(h.z, h.w); *(v2u*)(H + (size_t)r * D + 4 * lane + 256 * j) = o; }
        }
    }
}
template <int K, int NBK, int MBK, bool TRANS>
DI void small_gemm(const LAS bf16* A, int apitch, const bf16* Wt, int n0w, f32x4 (&acc)[NBK][MBK], int lane) {
    const int lr = lane & 15, kq = lane >> 4;
#pragma unroll
    for (int nb = 0; nb < NBK; ++nb)
#pragma unroll
        for (int mb = 0; mb < MBK; ++mb) acc[nb][mb] = (f32x4){0.f, 0.f, 0.f, 0.f};
#pragma unroll 2
    for (int s = 0; s < K / 32; ++s) {
        bf16x8 av[MBK];
#pragma unroll
        for (int mb = 0; mb < MBK; ++mb) av[mb] = *(const LAS bf16x8*)(A + (16 * mb + lr) * apitch + 32 * s + 8 * kq);
#pragma unroll
        for (int nb = 0; nb < NBK; ++nb) { const bf16x8 w = *(const bf16x8*)(Wt + (size_t)(n0w + 16 * nb + lr) * K + 32 * s + 8 * kq);
#pragma unroll
            for (int mb = 0; mb < MBK; ++mb) acc[nb][mb] = TRANS ? mfma16(w, av[mb], acc[nb][mb]) : mfma16(av[mb], w, acc[nb][mb]); }
    }
}

struct S5C { float ar, ai, fr, fi; };
static __device__ __noinline__ S5C s5_coef(const float* lre, const float* lim, float dt, int nn) {
    const float lr = lre[nn], li = lim[nn], x = lr * dt;
    const float em = x * (1.0f + x * (0.5f + x * (0.16666667f + x * (0.041666668f + x * 0.0083333338f))));
    float sh, ch; my_sincosf(0.5f * li * dt, sh, ch);
    const float cm1 = -2.0f * sh * sh, sn = 2.0f * sh * ch;
    const float arm1 = em * (1.0f + cm1) + cm1;
    S5C o; o.ai = (1.0f + em) * sn; o.ar = 1.0f + arm1;
    const float den = lr * lr + li * li;
    o.fr = (arm1 * lr + o.ai * li) / den; o.fi = (o.ai * lr - arm1 * li) / den;
    return o;
}
DI void s5_scan_task(KArgs a, int l, int b, int dir, int g, LAS bf16* wl  , int lane) {
    const bf16* Z = (const bf16*)(a->ws + WS_ACT); bf16* YS = (bf16*)(a->ws + WS_YS5) + (size_t)dir * NROWS * 256;
    const int pg = (l * 2 + dir) * 16 + g;
    const float* lre = a->in[I_S5LRE] + pg * 64; const float* lim = a->in[I_S5LIM] + pg * 64;
    const float dt = __expf(a->in[I_S5DT][pg]);
    const S5C c0_ = s5_coef(lre, lim, dt, lane); const float ar = c0_.ar, ai = c0_.ai;
    bf16x8 Bf[4];
    { const int hh = lane >> 5;
#pragma unroll
      for (int nblk = 0; nblk < 2; ++nblk) { const int nn = 32 * nblk + (lane & 31); const S5C cn_ = s5_coef(lre, lim, dt, nn); const float fr = cn_.fr, fi = cn_.fi;
        const float* bre = a->in[I_S5BRE] + ((size_t)pg * 64 + nn) * 16 + 8 * hh; const float* bim = a->in[I_S5BIM] + ((size_t)pg * 64 + nn) * 16 + 8 * hh;
        float re[8], im[8];
#pragma unroll
        for (int j = 0; j < 8; ++j) { re[j] = fr * bre[j] - fi * bim[j]; im[j] = fi * bre[j] + fr * bim[j]; }
        Bf[nblk] = pack8(re[0], re[1], re[2], re[3], re[4], re[5], re[6], re[7]); Bf[2 + nblk] = pack8(im[0], im[1], im[2], im[3], im[4], im[5], im[6], im[7]); } }
    bf16x8 Cf[4];
    { const int p = lane & 15, q = lane >> 4;
#pragma unroll
      for (int s = 0; s < 4; ++s) { const int kc = 32 * s + 8 * q; float cv[8];
        const float* src = (s < 2) ? a->in[I_S5CRE] + ((size_t)pg * 16 + p) * 64 + kc : a->in[I_S5CIM] + ((size_t)pg * 16 + p) * 64 + (kc - 64);
        const float sg = (s < 2) ? 1.f : -1.f;
#pragma unroll
        for (int j = 0; j < 8; ++j) cv[j] = sg * src[j];
        Cf[s] = pack8(cv[0], cv[1], cv[2], cv[3], cv[4], cv[5], cv[6], cv[7]); } }
    float sr = 0.f, si = 0.f;
    const int hh = lane >> 5, li5 = lane & 31, q = lane >> 4, t16 = lane & 15;
    const f32x16 zero16 = {0.f, 0.f, 0.f, 0.f, 0.f, 0.f, 0.f, 0.f, 0.f, 0.f, 0.f, 0.f, 0.f, 0.f, 0.f, 0.f};
    const int nchC = TC / 32, nchT = nchC + T / 32;
    auto afload = [&](int gc) -> bf16x8 {
        const int seg = gc >= nchC, ch = seg ? gc - nchC : gc, len = seg ? T : TC;
        const int sidx = 32 * ch + li5, tt = dir ? (len - 1 - sidx) : sidx;
        return *(const bf16x8*)(Z + (size_t)tok_row(b, seg, tt) * ZP + ZS5 + g * 16 + 8 * hh);
    };
    bf16x8 afn = afload(0);
    for (int gc = 0; gc < nchT; ++gc) {
        const int seg = gc >= nchC, ch = seg ? gc - nchC : gc, len = seg ? T : TC;
        {
            const bf16x8 af = afn;
            if (gc + 1 < nchT) afn = afload(gc + 1);
            f32x16 d1 = mfma32(af, Bf[0], zero16), d2 = mfma32(af, Bf[1], zero16), d3 = mfma32(af, Bf[2], zero16), d4 = mfma32(af, Bf[3], zero16);
            float xa[16], xb[16], ya[16], yb[16];
#pragma unroll
            for (int r = 0; r < 16; ++r) {
                auto r1 = __builtin_amdgcn_permlane32_swap(__float_as_uint(d1[r]), __float_as_uint(d2[r]), false, false); xa[r] = __uint_as_float(r1[0]); xb[r] = __uint_as_float(r1[1]);
                auto r2 = __builtin_amdgcn_permlane32_swap(__float_as_uint(d3[r]), __float_as_uint(d4[r]), false, false); ya[r] = __uint_as_float(r2[0]); yb[r] = __uint_as_float(r2[1]); }
#pragma unroll
            for (int i = 0; i < 32; ++i) {
                const int r = 4 * (i >> 3) + (i & 3); const bool hi = (i >> 2) & 1;
                const float xre = hi ? xb[r] : xa[r], xim = hi ? yb[r] : ya[r];
                const float nsr = ar * sr - ai * si + xre, nsi = ar * si + ai * sr + xim; sr = nsr; si = nsi;
                wl[i * 136 + lane] = (bf16)f2bf(sr); wl[i * 136 + 64 + lane] = (bf16)f2bf(si);
            }
#pragma unroll
            for (int tb = 0; tb < 2; ++tb) {
                f32x4 acc = {0.f, 0.f, 0.f, 0.f};
#pragma unroll
                for (int s = 0; s < 4; ++s) { const bf16x8 bfr = *(const LAS bf16x8*)(wl + (16 * tb + t16) * 136 + 32 * s + 8 * q); acc = mfma16(Cf[s], bfr, acc); }
                const int so = 32 * ch + 16 * tb + t16, to = dir ? (len - 1 - so) : so;
                v2u o; o.x = pk2(acc[0], acc[1]); o.y = pk2(acc[2], acc[3]);
                *(v2u*)(YS + (size_t)tok_row(b, seg, to) * 256 + g * 16 + 4 * q) = o;
            }
        }
    }
}

DI void mla_prep_tile(KArgs a, const Ctx& F, int l, int tile) {
    const bf16* Z = (const bf16*)(a->ws + WS_ACT);
    bf16* Q = (bf16*)(a->ws + WS_Q); bf16* Kf = (bf16*)(a->ws + WS_K); bf16* Vt = (bf16*)(a->ws + WS_VT);
    const bf16* WUQ = (const bf16*)(a->ws + WS_SMALLW + SW_UQ); const bf16* WUKV = (const bf16*)(a->ws + WS_SMALLW + SW_UKV);
    const float* rc = (const float*)(a->ws + WS_ROPE); const float* rs = rc + T * 16;
    LAS bf16* Aq = (LAS bf16*)F.lds;
    LAS bf16* Akv = (LAS bf16*)(F.lds + 64 * 264 * 2);
    const int row0 = tile * 64, tid = F.tid, lane = F.lane, wave = F.wave;
    const bool lat = row0 < NLAT;
    {
        const int i = tid >> 3, part = tid & 7, row = row0 + i;
        const bf16* zr = Z + (size_t)row * ZP;
        float q[32], kv[16]; float sq = 0.f, sk = 0.f;
#pragma unroll
        for (int j = 0; j < 4; ++j) { const v4u w = *(const v4u*)(zr + ZCQ + part * 32 + 8 * j);
            q[8 * j + 0] = bflo(w.x); q[8 * j + 1] = bfhi(w.x); q[8 * j + 2] = bflo(w.y); q[8 * j + 3] = bfhi(w.y); q[8 * j + 4] = bflo(w.z); q[8 * j + 5] = bfhi(w.z); q[8 * j + 6] = bflo(w.w); q[8 * j + 7] = bfhi(w.w); }
#pragma unroll
        for (int j = 0; j < 2; ++j) { const v4u w = *(const v4u*)(zr + ZCKV + part * 16 + 8 * j);
            kv[8 * j + 0] = bflo(w.x); kv[8 * j + 1] = bfhi(w.x); kv[8 * j + 2] = bflo(w.y); kv[8 * j + 3] = bfhi(w.y); kv[8 * j + 4] = bflo(w.z); kv[8 * j + 5] = bfhi(w.z); kv[8 * j + 6] = bflo(w.w); kv[8 * j + 7] = bfhi(w.w); }
#pragma unroll
        for (int j = 0; j < 32; ++j) sq += q[j] * q[j];
#pragma unroll
        for (int j = 0; j < 16; ++j) sk += kv[j] * kv[j];
        sq += __shfl_xor(sq, 1); sq += __shfl_xor(sq, 2); sq += __shfl_xor(sq, 4);
        sk += __shfl_xor(sk, 1); sk += __shfl_xor(sk, 2); sk += __shfl_xor(sk, 4);
        const float rq = 1.0f / sqrtf(sq * (1.0f / 256.0f) + NORM_EPS), rk = 1.0f / sqrtf(sk * (1.0f / 128.0f) + NORM_EPS);
        const float* qn = a->in[I_MQN] + l * 256 + part * 32; const float* kn = a->in[I_MKVN] + l * 128 + part * 16;
#pragma unroll
        for (int j = 0; j < 32; j += 2) *(LAS unsigned*)(Aq + i * 264 + part * 32 + j) = pk2(q[j] * rq * qn[j], q[j + 1] * rq * qn[j + 1]);
#pragma unroll
        for (int j = 0; j < 16; j += 2) *(LAS unsigned*)(Akv + i * 136 + part * 16 + j) = pk2(kv[j] * rk * kn[j], kv[j + 1] * rk * kn[j + 1]);
        if (part == 0) {
            float kr[32];
#pragma unroll
            for (int j = 0; j < 4; ++j) { const v4u w = *(const v4u*)(zr + ZKR + 8 * j);
                kr[8 * j + 0] = bflo(w.x); kr[8 * j + 1] = bfhi(w.x); kr[8 * j + 2] = bflo(w.y); kr[8 * j + 3] = bfhi(w.y); kr[8 * j + 4] = bflo(w.z); kr[8 * j + 5] = bfhi(w.z); kr[8 * j + 6] = bflo(w.w); kr[8 * j + 7] = bfhi(w.w); }
            float o[32];
            if (lat) { const int t = row & (T - 1);
#pragma unroll
                for (int hf = 0; hf < 2; ++hf)
#pragma unroll
                    for (int j = 0; j < 8; ++j) { const float c = rc[t * 16 + hf * 8 + j], s = rs[t * 16 + hf * 8 + j]; const float x0 = kr[hf * 16 + j], x1 = kr[hf * 16 + 8 + j];
                        o[hf * 16 + j] = x0 * c - x1 * s; o[hf * 16 + 8 + j] = x1 * c + x0 * s; }
            } else {
#pragma unroll
                for (int j = 0; j < 32; ++j) o[j] = kr[j];
            }
#pragma unroll
            for (int hd = 0; hd < 4; ++hd) { bf16* kp = Kf + (size_t)row * 384 + hd * 96 + 64;
#pragma unroll
                for (int j = 0; j < 4; ++j) { v4u w; w.x = pk2(o[8 * j], o[8 * j + 1]); w.y = pk2(o[8 * j + 2], o[8 * j + 3]); w.z = pk2(o[8 * j + 4], o[8 * j + 5]); w.w = pk2(o[8 * j + 6], o[8 * j + 7]); *(v4u*)(kp + 8 * j) = w; } }
        }
    }
    __syncthreads();
    const int lr = lane & 15, kq = lane >> 4;
    {
        f32x4 acc[3][4];
        small_gemm<256, 3, 4, true>(Aq, 264, WUQ, 48 * wave, acc, lane);
        const float qs = 0.10206207261596577f * 1.44269504089f;
#pragma unroll
        for (int nb = 0; nb < 3; ++nb) { const int blk = 3 * wave + nb, hb = blk % 6;
#pragma unroll
            for (int mb = 0; mb < 4; ++mb) { const int row = row0 + 16 * mb + lr; f32x4 v = acc[nb][mb];
                if (hb >= 4) {
                    f32x4 pv; pv.x = __shfl_xor(v.x, 32); pv.y = __shfl_xor(v.y, 32); pv.z = __shfl_xor(v.z, 32); pv.w = __shfl_xor(v.w, 32);
                    if (lat) { const int t = row & (T - 1); const int fb = (hb - 4) * 8 + 4 * (kq & 1);
                        const f32x4 c = *(const f32x4*)(rc + t * 16 + fb), s = *(const f32x4*)(rs + t * 16 + fb);
                        v = (kq < 2) ? (v * c - pv * s) : (v * c + pv * s); }
                }
                v = v * qs;
                v2u o; o.x = pk2(v.x, v.y); o.y = pk2(v.z, v.w);
                *(v2u*)(Q + (size_t)row * 384 + 16 * blk + 4 * kq) = o; } }
    }
    {
        const int hd = wave >> 1;
        if ((wave & 1) == 0) {
            f32x4 acc[4][4];
            small_gemm<128, 4, 4, true>(Akv, 136, WUKV, 64 * wave, acc, lane);
#pragma unroll
            for (int nb = 0; nb < 4; ++nb)
#pragma unroll
                for (int mb = 0; mb < 4; ++mb) { const int row = row0 + 16 * mb + lr; const f32x4 v = acc[nb][mb];
                    v2u o; o.x = pk2(v.x, v.y); o.y = pk2(v.z, v.w);
                    *(v2u*)(Kf + (size_t)row * 384 + hd * 96 + 16 * nb + 4 * kq) = o; }
        } else {
            f32x4 acc[4][4];
            small_gemm<128, 4, 4, false>(Akv, 136, WUKV, 64 * wave, acc, lane);
            const int bb = lat ? (row0 >> 12) : ((row0 - NLAT) >> 8);
            const int key0 = lat ? (TC + (row0 & (T - 1))) : ((row0 - NLAT) & (TC - 1));
#pragma unroll
            for (int nb = 0; nb < 4; ++nb)
#pragma unroll
                for (int mb = 0; mb < 4; ++mb) { const f32x4 v = acc[nb][mb];
                    v2u o; o.x = pk2(v.x, v.y); o.y = pk2(v.z, v.w);
                    *(v2u*)(Vt + ((size_t)(bb * 4 + hd) * 64 + 16 * nb + lr) * NKEY + key0 + 16 * mb + 4 * kq) = o; }
        }
    }
    __syncthreads();
}

DI void attn_unit(KArgs a, const Ctx& F, int b, int hd, int qrow0, int nkeys) {
    const bf16* Q = (const bf16*)(a->ws + WS_Q); const bf16* Kf = (const bf16*)(a->ws + WS_K); const bf16* Vt = (const bf16*)(a->ws + WS_VT);
    bf16* MO = (bf16*)(a->ws + WS_H);
    constexpr int KP = 208, VP = 144, BUF = 64 * KP + 64 * VP;
    const int tid = F.tid, lane = F.lane, wave = F.wave, l31 = lane & 31, h2 = lane >> 5;
    const int qrow = qrow0 + 32 * wave + l31;
    bf16x8 Qf[6];
#pragma unroll
    for (int s = 0; s < 6; ++s) Qf[s] = *(const bf16x8*)(Q + (size_t)qrow * 384 + hd * 96 + 16 * s + 8 * h2);
    const int kc0 = tid, kc1 = tid + 512;
    const int kr0 = kc0 / 12, kcc0 = kc0 % 12, kr1 = kc1 / 12, kcc1 = kc1 % 12; const bool k1v = kc1 < 768;
    const int vd = tid >> 3, vcc = tid & 7;
    const bf16* vbase = Vt + ((size_t)(b * 4 + hd) * 64 + vd) * NKEY + vcc * 8;
    v4u gk0, gk1, gv;
    auto gload = [&](int kt) {
        const int key0 = 64 * kt; const int krow = key0 < TC ? (NLAT + b * TC + key0) : (b * T + key0 - TC);
        gk0 = *(const v4u*)(Kf + (size_t)(krow + kr0) * 384 + hd * 96 + kcc0 * 8);
        if (k1v) gk1 = *(const v4u*)(Kf + (size_t)(krow + kr1) * 384 + hd * 96 + kcc1 * 8);
        gv = *(const v4u*)(vbase + key0);
    };
    auto lstore = [&](int buf) {
        LAS uchar* base = F.lds + buf * BUF;
        *(LAS v4u*)(base + kr0 * KP + kcc0 * 16) = gk0;
        if (k1v) *(LAS v4u*)(base + kr1 * KP + kcc1 * 16) = gk1;
        *(LAS v4u*)(base + 64 * KP + vd * VP + vcc * 16) = gv;
    };
    const int nt = nkeys / 64;
    gload(0); lstore(0);
    __syncthreads();
    f32x16 O0, O1;
#pragma unroll
    for (int r = 0; r < 16; ++r) { O0[r] = 0.f; O1[r] = 0.f; }
    float m = -1e30f, lsum = 0.f;
    for (int kt = 0; kt < nt; ++kt) {
        const bool more = kt + 1 < nt;
        if (more) gload(kt + 1);
        const LAS uchar* kb_ = F.lds + (kt & 1) * BUF; const LAS uchar* vb_ = kb_ + 64 * KP;
        f32x16 s0, s1;
#pragma unroll
        for (int r = 0; r < 16; ++r) { s0[r] = 0.f; s1[r] = 0.f; }
#pragma unroll
        for (int s = 0; s < 6; ++s) {
            const bf16x8 ka = *(const LAS bf16x8*)(kb_ + l31 * KP + (16 * s + 8 * h2) * 2);
            const bf16x8 kb2 = *(const LAS bf16x8*)(kb_ + (32 + l31) * KP + (16 * s + 8 * h2) * 2);
            s0 = mfma32(ka, Qf[s], s0); s1 = mfma32(kb2, Qf[s], s1);
        }
        float mx = s0[0];
#pragma unroll
        for (int r = 1; r < 16; ++r) mx = fmaxf(mx, s0[r]);
#pragma unroll
        for (int r = 0; r < 16; ++r) mx = fmaxf(mx, s1[r]);
        mx = fmaxf(mx, __shfl_xor(mx, 32));
        const float mn = fmaxf(m, mx), alpha = __builtin_amdgcn_exp2f(m - mn); m = mn;
        float ps = 0.f;
#pragma unroll
        for (int r = 0; r < 16; ++r) { s0[r] = __builtin_amdgcn_exp2f(s0[r] - mn); s1[r] = __builtin_amdgcn_exp2f(s1[r] - mn); ps += s0[r] + s1[r]; }
        lsum = lsum * alpha + ps;
#pragma unroll
        for (int r = 0; r < 16; ++r) { O0[r] *= alpha; O1[r] *= alpha; }
#pragma unroll
        for (int kb = 0; kb < 2; ++kb)
#pragma unroll
            for (int sp = 0; sp < 2; ++sp) {
                const f32x16& sx = kb ? s1 : s0;
                const bf16x8 pf = pack8(sx[8 * sp + 0], sx[8 * sp + 1], sx[8 * sp + 2], sx[8 * sp + 3], sx[8 * sp + 4], sx[8 * sp + 5], sx[8 * sp + 6], sx[8 * sp + 7]);
                const int ko = (32 * kb + 16 * sp + 4 * h2) * 2;
                const bf16x4 a0 = *(const LAS bf16x4*)(vb_ + l31 * VP + ko), a1 = *(const LAS bf16x4*)(vb_ + l31 * VP + ko + 16);
                const bf16x4 c0 = *(const LAS bf16x4*)(vb_ + (32 + l31) * VP + ko), c1 = *(const LAS bf16x4*)(vb_ + (32 + l31) * VP + ko + 16);
                const bf16x8 va = __builtin_shufflevector(a0, a1, 0, 1, 2, 3, 4, 5, 6, 7), vc = __builtin_shufflevector(c0, c1, 0, 1, 2, 3, 4, 5, 6, 7);
                O0 = mfma32(va, pf, O0); O1 = mfma32(vc, pf, O1);
            }
        if (more) lstore((kt + 1) & 1);
        __syncthreads();
    }
    const float ltot = lsum + __shfl_xor(lsum, 32), inv = 1.0f / ltot;
    bf16* op = MO + (size_t)qrow * D + 256 + hd * 64;
#pragma unroll
    for (int gq = 0; gq < 4; ++gq) {
        v2u o; o.x = pk2(O0[4 * gq] * inv, O0[4 * gq + 1] * inv); o.y = pk2(O0[4 * gq + 2] * inv, O0[4 * gq + 3] * inv);
        *(v2u*)(op + 8 * gq + 4 * h2) = o;
        v2u o2; o2.x = pk2(O1[4 * gq] * inv, O1[4 * gq + 1] * inv); o2.y = pk2(O1[4 * gq + 2] * inv, O1[4 * gq + 3] * inv);
        *(v2u*)(op + 32 + 8 * gq + 4 * h2) = o2;
    }
}
DI float conv3(const bf16* Z, int b, int seg, int t, int len, int col, float w0, float w1, float w2, float cb) {
    const bf16* zp = Z + (size_t)tok_row(b, seg, t) * ZP + col;
    float y = cb + w1 * bf2f(zp[0]);
    if (t > 0) y += w0 * bf2f(zp[-ZP]);
    if (t + 1 < len) y += w2 * bf2f(zp[ZP]);
    return y;
}
DI bf16x8 ldperm(const LAS bf16* rowp, int k0, int hh) { const bf16x4 a0 = *(const LAS bf16x4*)(rowp + k0 + 4 * hh), a1 = *(const LAS bf16x4*)(rowp + k0 + 8 + 4 * hh); return __builtin_shufflevector(a0, a1, 0, 1, 2, 3, 4, 5, 6, 7); }
DI bf16x8 pack_acc(const f32x16& x, int s) { return s ? pack8(x[8], x[9], x[10], x[11], x[12], x[13], x[14], x[15]) : pack8(x[0], x[1], x[2], x[3], x[4], x[5], x[6], x[7]); }
DI void rwkv_scan_task(KArgs a, const Ctx& F, int l, int b, int hd, int dir) {
    const bf16* Z = (const bf16*)(a->ws + WS_ACT); bf16* YR = (bf16*)(a->ws + WS_YR) + (size_t)dir * NROWS * 256;
    constexpr int RAWSZ = 13056 + 4608;
    constexpr int SETSZ = 4 * 4608 + 3 * 5120 + 256 + 2560;
    LAS uchar* const RAW0 = F.lds;
    LAS float* WL = (LAS float*)(F.lds + 2 * RAWSZ);
    LAS float* AL = WL + 2048;
    LAS float* Alw = AL + 2048;
    LAS float* CST = Alw + 512;
    LAS uchar* const SET0 = (LAS uchar*)(CST + 1024);
    const int tid = F.tid, lane = F.lane, wave = F.wave;
    const int hc = hd * 64 + lane;
    bf16x8 lf0 = {0, 0, 0, 0, 0, 0, 0, 0}, lf1 = lf0;
    if (wave >= 4) { const int w4 = wave - 4, l31 = lane & 31, hh = lane >> 5; const float* up = a->in[(w4 >> 1) ? I_RAUP : I_RWUP] + ((size_t)(l * 2 + dir) * 32) * 256 + hd * 64 + 32 * (w4 & 1) + l31;
        float u[16];
#pragma unroll
        for (int s = 0; s < 2; ++s)
#pragma unroll
            for (int j = 0; j < 8; ++j) u[8 * s + j] = up[(size_t)(16 * s + 8 * hh + j) * 256];
        lf0 = pack8(u[0], u[1], u[2], u[3], u[4], u[5], u[6], u[7]); lf1 = pack8(u[8], u[9], u[10], u[11], u[12], u[13], u[14], u[15]); }
    if (wave == 0) {
        const float* cw = a->in[I_RCW] + (size_t)l * 3 * 768; const float* cbp = a->in[I_RCB] + (size_t)l * 768;
        CST[0 * 64 + lane] = a->in[I_RW0][(l * 2 + dir) * 256 + hc]; CST[1 * 64 + lane] = a->in[I_RA0][(l * 2 + dir) * 256 + hc];
        CST[2 * 64 + lane] = a->in[I_RKK][l * 256 + hc]; CST[3 * 64 + lane] = a->in[I_RKA][l * 256 + hc];
#pragma unroll
        for (int j = 0; j < 3; ++j) { CST[(4 + j) * 64 + lane] = cw[j * 768 + hc]; CST[(7 + j) * 64 + lane] = cw[j * 768 + 256 + hc]; CST[(10 + j) * 64 + lane] = cw[j * 768 + 512 + hc]; }
        CST[13 * 64 + lane] = cbp[hc]; CST[14 * 64 + lane] = cbp[256 + hc]; CST[15 * 64 + lane] = cbp[512 + hc];
    }
    f32x16 ST0, ST1;
#pragma unroll
    for (int r = 0; r < 16; ++r) { ST0[r] = 0.f; ST1[r] = 0.f; }
    const int c0r = tid / 24, c0s = (tid % 24) >> 3, c0c = (tid % 24) & 7;
    const int c1 = tid + 512, c1r = c1 / 24, c1s = (c1 % 24) >> 3, c1c = (c1 % 24) & 7; const bool c1v = c1 < 816;
    const int lr_ = tid >> 3, lc_ = tid & 7;
    v4u g0, g1, g2;
    unsigned zz_ = 0u; asm volatile("" : "+v"(zz_)); const v4u zero4 = {zz_, zz_, zz_, zz_};
    const int nchC = TC / 32, nchT = nchC + T / 32;
    auto gload = [&](int gc) {
        const int seg = gc >= nchC, ch = seg ? gc - nchC : gc, len = seg ? T : TC;
        const int tbase = dir ? (len - 32 * (ch + 1)) : 32 * ch;
        { const int t = tbase - 1 + c0r; g0 = (t >= 0 && t < len) ? *(const v4u*)(Z + (size_t)tok_row(b, seg, t) * ZP + ZRKV + c0s * 256 + hd * 64 + c0c * 8) : zero4; }
        if (c1v) { const int t = tbase - 1 + c1r; g1 = (t >= 0 && t < len) ? *(const v4u*)(Z + (size_t)tok_row(b, seg, t) * ZP + ZRKV + c1s * 256 + hd * 64 + c1c * 8) : zero4; }
        if (tid < 256) { const int t = tbase + lr_; g2 = *(const v4u*)(Z + (size_t)tok_row(b, seg, t) * ZP + ZWD + lc_ * 8); }
    };
    auto lstore = [&](int par) {
        LAS bf16* Raw = (LAS bf16*)(RAW0 + par * RAWSZ); LAS bf16* LwB = (LAS bf16*)(RAW0 + par * RAWSZ + 13056);
        *(LAS v4u*)(Raw + c0r * 192 + c0s * 64 + c0c * 8) = g0;
        if (c1v) *(LAS v4u*)(Raw + c1r * 192 + c1s * 64 + c1c * 8) = g1;
        if (tid < 256) { float x[8] = {bflo(g2.x), bfhi(g2.x), bflo(g2.y), bfhi(g2.y), bflo(g2.z), bfhi(g2.z), bflo(g2.w), bfhi(g2.w)};
            if (lc_ < 4) {
#pragma unroll
                for (int j = 0; j < 8; ++j) x[j] = 1.0f - 2.0f * __builtin_amdgcn_rcpf(1.0f + fexp(2.0f * x[j])); }
            v4u w; w.x = pk2(x[0], x[1]); w.y = pk2(x[2], x[3]); w.z = pk2(x[4], x[5]); w.w = pk2(x[6], x[7]);
            *(LAS v4u*)(LwB + lr_ * 72 + lc_ * 8) = w; }
    };
    gload(0); lstore(0);
    __syncthreads();
    for (int n = -2; n < nchT; ++n) {
        if (n + 3 < nchT) gload(n + 3);
        int ln_ = lane; asm volatile("" : "+v"(ln_));
        const int l31 = ln_ & 31, hh = ln_ >> 5;
        if (wave < 2) {
            if (n >= 0) {
                const int seg = n >= nchC, ch = seg ? n - nchC : n, len = seg ? T : TC;
                const int tbase = dir ? (len - 32 * (ch + 1)) : 32 * ch;
                LAS uchar* sp = SET0 + (n & 1) * SETSZ;
                LAS bf16* KhT = (LAS bf16*)sp; LAS bf16* BhT = KhT + 32 * 72; LAS bf16* KkT = BhT + 32 * 72; LAS bf16* RhT = KkT + 32 * 72;
                LAS bf16* Kh = RhT + 32 * 72; LAS bf16* nBh = Kh + 64 * 40; LAS bf16* VT = nBh + 64 * 40; LAS float* GL = (LAS float*)(VT + 64 * 40); LAS bf16* TT = (LAS bf16*)(GL + 64);
                const int vcol = 32 * wave + l31;
                f32x16 accP, accY, accBb;
#pragma unroll
                for (int r = 0; r < 16; ++r) { accP[r] = 0.f; accY[r] = 0.f; }
#pragma unroll
                for (int kb = 0; kb < 2; ++kb)
#pragma unroll
                    for (int s = 0; s < 2; ++s) { const bf16x8 sb = pack_acc(kb ? ST1 : ST0, s);
                        accP = mfma32(ldperm(KkT + l31 * 72, 32 * kb + 16 * s, hh), sb, accP);
                        accY = mfma32(ldperm(RhT + l31 * 72, 32 * kb + 16 * s, hh), sb, accY); }
                {
                    f32x16 acc;
#pragma unroll
                    for (int r = 0; r < 16; ++r) acc[r] = 0.f;
#pragma unroll
                    for (int s = 0; s < 4; ++s) acc = mfma32(*(const LAS bf16x8*)(KhT + l31 * 72 + 16 * s + 8 * hh), *(const LAS bf16x8*)(KkT + l31 * 72 + 16 * s + 8 * hh), acc);
#pragma unroll
                    for (int r = 0; r < 16; ++r) acc[r] = (crow(r, hh) < l31) ? acc[r] : 0.f;
#pragma unroll
                    for (int s = 0; s < 2; ++s) accP = mfma32(pack_acc(acc, s), ldperm(VT + vcol * 40, 16 * s, hh), accP);
                }
                __builtin_amdgcn_sched_barrier(0);
                {
                    f32x16 acc;
#pragma unroll
                    for (int r = 0; r < 16; ++r) acc[r] = 0.f;
#pragma unroll
                    for (int s = 0; s < 4; ++s) acc = mfma32(*(const LAS bf16x8*)(KhT + l31 * 72 + 16 * s + 8 * hh), *(const LAS bf16x8*)(RhT + l31 * 72 + 16 * s + 8 * hh), acc);
#pragma unroll
                    for (int r = 0; r < 16; ++r) acc[r] = (crow(r, hh) <= l31) ? acc[r] : 0.f;
#pragma unroll
                    for (int s = 0; s < 2; ++s) accY = mfma32(pack_acc(acc, s), ldperm(VT + vcol * 40, 16 * s, hh), accY);
                }
                __builtin_amdgcn_sched_barrier(0);
                {
#pragma unroll
                    for (int r = 0; r < 16; ++r) accBb[r] = 0.f;
#pragma unroll
                    for (int s = 0; s < 4; ++s) accBb = mfma32(*(const LAS bf16x8*)(BhT + l31 * 72 + 16 * s + 8 * hh), *(const LAS bf16x8*)(RhT + l31 * 72 + 16 * s + 8 * hh), accBb);
#pragma unroll
                    for (int r = 0; r < 16; ++r) accBb[r] = (crow(r, hh) <= l31) ? -accBb[r] : 0.f;
                }
                f32x16 accC;
#pragma unroll
                for (int r = 0; r < 16; ++r) accC[r] = 0.f;
#pragma unroll
                for (int s = 0; s < 2; ++s) accC = mfma32(ldperm(TT + l31 * 40, 16 * s, hh), pack_acc(accP, s), accC);
#pragma unroll
                for (int s = 0; s < 2; ++s) accY = mfma32(pack_acc(accBb, s), pack_acc(accC, s), accY);
#pragma unroll
                for (int s = 0; s < 2; ++s) { const bf16x8 vb_ = *(const LAS bf16x8*)(VT + vcol * 40 + 16 * s + 8 * hh); const bf16x8 cb_ = pack_acc(accC, s);
                    ST0 = mfma32(*(const LAS bf16x8*)(Kh + l31 * 40 + 16 * s + 8 * hh), vb_, ST0);
                    ST1 = mfma32(*(const LAS bf16x8*)(Kh + (32 + l31) * 40 + 16 * s + 8 * hh), vb_, ST1);
                    ST0 = mfma32(ldperm(nBh + l31 * 40, 16 * s, hh), cb_, ST0);
                    ST1 = mfma32(ldperm(nBh + (32 + l31) * 40, 16 * s, hh), cb_, ST1); }
#pragma unroll
                for (int r = 0; r < 16; ++r) { ST0[r] *= GL[crow(r, hh)]; ST1[r] *= GL[32 + crow(r, hh)]; }
#pragma unroll
                for (int r = 0; r < 16; ++r) { const int i = crow(r, hh), t = dir ? (tbase + 31 - i) : (tbase + i);
                    YR[(size_t)tok_row(b, seg, t) * 256 + hd * 64 + vcol] = (bf16)f2bf(accY[r]); }
            }
        } else if (wave == 2) {
            if (n + 1 >= 0 && n + 1 < nchT) {
                LAS uchar* sp = SET0 + ((n + 1) & 1) * SETSZ;
                LAS bf16* BhT = (LAS bf16*)sp + 32 * 72; LAS bf16* KkT = BhT + 32 * 72; LAS bf16* TT = (LAS bf16*)(sp + 4 * 4608 + 3 * 5120 + 256);
                f32x16 P, PT, Tm, TTm;
#pragma unroll
                for (int r = 0; r < 16; ++r) { P[r] = 0.f; PT[r] = 0.f; }
#pragma unroll
                for (int s = 0; s < 4; ++s) { const bf16x8 bh_ = *(const LAS bf16x8*)(BhT + l31 * 72 + 16 * s + 8 * hh), kk_ = *(const LAS bf16x8*)(KkT + l31 * 72 + 16 * s + 8 * hh);
                    P = mfma32(bh_, kk_, P); PT = mfma32(kk_, bh_, PT); }
#pragma unroll
                for (int r = 0; r < 16; ++r) { const int j = crow(r, hh);
                    P[r] = (j < l31) ? P[r] : 0.f; PT[r] = (j > l31) ? PT[r] : 0.f;
                    const float idv = (j == l31) ? 1.f : 0.f; Tm[r] = idv - P[r]; TTm[r] = idv - PT[r]; }
#pragma unroll
                for (int it = 0; it < 4; ++it) {
                    const bf16x8 p0 = pack_acc(P, 0), p1 = pack_acc(P, 1), q0 = pack_acc(PT, 0), q1 = pack_acc(PT, 1);
                    f32x16 P2, P2T;
#pragma unroll
                    for (int r = 0; r < 16; ++r) { P2[r] = 0.f; P2T[r] = 0.f; }
                    P2 = mfma32(q0, p0, P2); P2 = mfma32(q1, p1, P2);
                    if (it < 3) { P2T = mfma32(p0, q0, P2T); P2T = mfma32(p1, q1, P2T); }
                    const bf16x8 u0 = pack_acc(TTm, 0), u1 = pack_acc(TTm, 1);
                    const bf16x8 a0 = pack_acc(P2, 0), a1 = pack_acc(P2, 1);
                    Tm = mfma32(u0, a0, Tm); Tm = mfma32(u1, a1, Tm);
                    if (it < 3) { TTm = mfma32(a0, u0, TTm); TTm = mfma32(a1, u1, TTm); }
                    P = P2; PT = P2T;
                }
#pragma unroll
                for (int r = 0; r < 16; ++r) TT[l31 * 40 + crow(r, hh)] = (bf16)f2bf(Tm[r]);
            }
        } else if (wave >= 4) {
            if (n + 2 < nchT) {
                const int w4 = wave - 4;
                const LAS bf16* LwB = (const LAS bf16*)(RAW0 + ((n + 2) & 1) * RAWSZ + 13056);
                f32x16 acc;
#pragma unroll
                for (int r = 0; r < 16; ++r) acc[r] = 0.f;
                const int ko = (w4 >> 1) * 32;
                acc = mfma32(*(const LAS bf16x8*)(LwB + l31 * 72 + ko + 8 * hh), lf0, acc);
                acc = mfma32(*(const LAS bf16x8*)(LwB + l31 * 72 + ko + 16 + 8 * hh), lf1, acc);
                LAS float* dst = (w4 >> 1) ? AL : WL;
#pragma unroll
                for (int r = 0; r < 16; ++r) dst[crow(r, hh) * 64 + 32 * (w4 & 1) + l31] = acc[r];
            }
        }
        lds_barrier();
        const bool pv = n + 2 < nchT;
        const int pi = tid >> 4, c4 = (ln_ & 15) * 4, pli = dir ? (31 - pi) : pi, pjr = dir ? (32 - pi) : (pi + 1);
        f32x4 lwi = {0.f, 0.f, 0.f, 0.f}, cuml = lwi;
        if (pv) {
            const f32x4 wl4 = *(const LAS f32x4*)(WL + pli * 64 + c4) + *(const LAS f32x4*)(CST + c4);
#pragma unroll
            for (int e = 0; e < 4; ++e) { const float xneg = -wl4[e]; const float sp = fmaxf(xneg, 0.f) + 0.69314718056f * __builtin_amdgcn_logf(1.0f + fexp(-fabsf(xneg))); lwi[e] = -fexp(-sp - 0.5f); }
            cuml = lwi;
#pragma unroll
            for (int e = 0; e < 4; ++e) { float y = __shfl_up(cuml[e], 16); if (ln_ >= 16) cuml[e] += y; }
#pragma unroll
            for (int e = 0; e < 4; ++e) { float y = __shfl_up(cuml[e], 32); if (ln_ >= 32) cuml[e] += y; }
            if (ln_ >= 48) *(LAS f32x4*)(Alw + wave * 64 + c4) = cuml;
        }
        lds_barrier();
        if (pv) {
            LAS uchar* sp = SET0 + (n & 1) * SETSZ;
            LAS bf16* KhT = (LAS bf16*)sp; LAS bf16* BhT = KhT + 32 * 72; LAS bf16* KkT = BhT + 32 * 72; LAS bf16* RhT = KkT + 32 * 72;
            LAS bf16* Kh = RhT + 32 * 72; LAS bf16* nBh = Kh + 64 * 40; LAS bf16* VT = nBh + 64 * 40; LAS float* GL = (LAS float*)(VT + 64 * 40);
            const LAS bf16* Raw = (const LAS bf16*)(RAW0 + (n & 1) * RAWSZ);
            f32x4 cum = cuml;
#pragma unroll
            for (int w2 = 0; w2 < 7; ++w2) { const f32x4 x = *(const LAS f32x4*)(Alw + w2 * 64 + c4); if (w2 < wave) cum = cum + x; }
            const f32x4 cpv = cum - lwi;
            float rr[4], kv[4], vv[4];
            { const f32x4 br = *(const LAS f32x4*)(CST + 13 * 64 + c4), bk = *(const LAS f32x4*)(CST + 14 * 64 + c4), bv = *(const LAS f32x4*)(CST + 15 * 64 + c4);
#pragma unroll
              for (int e = 0; e < 4; ++e) { rr[e] = br[e]; kv[e] = bk[e]; vv[e] = bv[e]; } }
#pragma unroll
            for (int tap = 0; tap < 3; ++tap) {
                const LAS bf16* rp = Raw + (pjr - 1 + tap) * 192 + c4;
                const v2u xr = *(const LAS v2u*)rp, xk = *(const LAS v2u*)(rp + 64), xv = *(const LAS v2u*)(rp + 128);
                const f32x4 wr = *(const LAS f32x4*)(CST + (4 + tap) * 64 + c4), wk = *(const LAS f32x4*)(CST + (7 + tap) * 64 + c4), wv = *(const LAS f32x4*)(CST + (10 + tap) * 64 + c4);
                rr[0] += wr[0] * bflo(xr.x); rr[1] += wr[1] * bfhi(xr.x); rr[2] += wr[2] * bflo(xr.y); rr[3] += wr[3] * bfhi(xr.y);
                kv[0] += wk[0] * bflo(xk.x); kv[1] += wk[1] * bfhi(xk.x); kv[2] += wk[2] * bflo(xk.y); kv[3] += wk[3] * bfhi(xk.y);
                vv[0] += wv[0] * bflo(xv.x); vv[1] += wv[1] * bfhi(xv.x); vv[2] += wv[2] * bflo(xv.y); vv[3] += wv[3] * bfhi(xv.y);
            }
            const f32x4 kkc4 = *(const LAS f32x4*)(CST + 2 * 64 + c4), kac4 = *(const LAS f32x4*)(CST + 3 * 64 + c4);
            const f32x4 al4 = *(const LAS f32x4*)(AL + pli * 64 + c4) + *(const LAS f32x4*)(CST + 64 + c4);
            float kx[4]; float ss = 0.f;
#pragma unroll
            for (int e = 0; e < 4; ++e) { kx[e] = kv[e] * kkc4[e]; ss += kx[e] * kx[e]; }
            ss = sum16(ss);
            const float rn = __builtin_amdgcn_rcpf(fmaxf(__builtin_amdgcn_sqrtf(ss), 1e-12f));
            float kh[4], bh[4], kk_[4], rh[4];
#pragma unroll
            for (int e = 0; e < 4; ++e) { const float av = __builtin_amdgcn_rcpf(1.0f + fexp(-al4[e])), kn = kx[e] * rn, en = fexp(-cum[e]), ep = fexp(cum[e]), epv = fexp(cpv[e]);
                kh[e] = kv[e] * (1.0f + (av - 1.0f) * kac4[e]) * en; bh[e] = kn * av * en; kk_[e] = kn * epv; rh[e] = rr[e] * ep; }
            v2u o;
            o.x = pk2(kh[0], kh[1]); o.y = pk2(kh[2], kh[3]); *(LAS v2u*)(KhT + pi * 72 + c4) = o;
            o.x = pk2(bh[0], bh[1]); o.y = pk2(bh[2], bh[3]); *(LAS v2u*)(BhT + pi * 72 + c4) = o;
            o.x = pk2(kk_[0], kk_[1]); o.y = pk2(kk_[2], kk_[3]); *(LAS v2u*)(KkT + pi * 72 + c4) = o;
            o.x = pk2(rh[0], rh[1]); o.y = pk2(rh[2], rh[3]); *(LAS v2u*)(RhT + pi * 72 + c4) = o;
#pragma unroll
            for (int e = 0; e < 4; ++e) { Kh[(c4 + e) * 40 + pi] = (bf16)f2bf(kh[e]); nBh[(c4 + e) * 40 + pi] = (bf16)f2bf(-bh[e]); VT[(c4 + e) * 40 + pi] = (bf16)f2bf(vv[e]); }
            if (pi == 31) *(LAS f32x4*)(GL + c4) = (f32x4){fexp(cum[0]), fexp(cum[1]), fexp(cum[2]), fexp(cum[3])};
        }
        if (n + 3 < nchT) lstore((n + 3) & 1);
        lds_barrier();
    }
}

DI void mlstm_task(KArgs a, const Ctx& F, int l, int b, int hd) {
    const bf16* Z = (const bf16*)(a->ws + WS_ACT);
    const int tid = F.tid, lane = F.lane, wave = F.wave, dir = wave >> 2, w2 = wave & 3, tid2 = tid & 255, l31 = lane & 31, hh = lane >> 5;
    bf16* YM = (bf16*)(a->ws + WS_YM) + (size_t)dir * NROWS * 256;
    constexpr int HP = 72;
    constexpr int HALF_LDS = 67328;
    LAS uchar* base = F.lds + dir * HALF_LDS;
    LAS bf16* Qc = (LAS bf16*)base; LAS bf16* Kc = Qc + 64 * HP; LAS bf16* KTw = Kc + 64 * HP; LAS bf16* VT = KTw + 64 * HP; LAS bf16* Cb = VT + 64 * HP;
    LAS float* fv = (LAS float*)(base + 5 * 9216);
    LAS float* Vgv = fv; LAS float* VMr = fv + 64; LAS float* Vwi = fv + 128; LAS float* Vem = fv + 192; LAS float* Vwk = fv + 256; LAS float* Vn = fv + 320; LAS float* Vsc = fv + 384;
    LAS bf16* Rq = (LAS bf16*)(base + 47872);
    LAS float* Gt = (LAS float*)(base + 47872 + 16896);
    LAS float* Cw = Gt + 128;
    for (int i = tid2; i < 64 * HP; i += 256) Cb[i] = 0;
    if (tid2 < 64) Vn[tid2] = 0.f;
    if (tid2 == 0) { float one_ = 1.f, zero_ = 0.f; asm volatile("" : "+v"(one_), "+v"(zero_)); Vsc[0] = one_; Vsc[1] = zero_; }
    { const float* cw = a->in[I_MCW] + (size_t)l * 3 * 512; const float* cbp = a->in[I_MCB] + (size_t)l * 512;
      for (int i = tid2; i < 512; i += 256) { const int tap = i >> 7, cc = i & 127, col = (cc < 64) ? (hd * 64 + cc) : (256 + hd * 64 + cc - 64);
          Cw[i] = (tap < 3) ? cw[tap * 512 + col] : cbp[col]; } }
    f32x16 accC;
#pragma unroll
    for (int r = 0; r < 16; ++r) accC[r] = 0.f;
    const int eb = w2 >> 1, lb = w2 & 1;
    const float gbi = a->in[I_MGB][l * 16 + dir * 8 + hd], gbf = a->in[I_MGB][l * 16 + dir * 8 + 4 + hd];
    const int nchC = TC / 64, nchT = nchC + T / 64;
    v4u gq[5], gv[2]; unsigned gr0 = 0u, gr1 = 0u;
    unsigned zz_ = 0u; asm volatile("" : "+v"(zz_)); const v4u zero4 = {zz_, zz_, zz_, zz_};
    auto gload = [&](int gc) {
        const int seg = gc >= nchC, ch = seg ? gc - nchC : gc, len = seg ? T : TC;
        const int tbase = dir ? (len - 64 * (ch + 1)) : 64 * ch;
#pragma unroll
        for (int n = 0; n < 5; ++n) { const int cidx = tid2 + 256 * n; if (cidx < 1056) { const int row = cidx >> 4, cc = cidx & 15, t = tbase - 1 + row;
            gq[n] = (t >= 0 && t < len) ? *(const v4u*)(Z + (size_t)tok_row(b, seg, t) * ZP + ZMQK + (cc >> 3) * 256 + hd * 64 + (cc & 7) * 8) : zero4; } }
#pragma unroll
        for (int n = 0; n < 2; ++n) { const int cidx = tid2 + 256 * n, row = cidx >> 3, cc = cidx & 7; gv[n] = *(const v4u*)(Z + (size_t)tok_row(b, seg, tbase + row) * ZP + ZMV + hd * 64 + cc * 8); }
        if (tid2 < 64) { const bf16* zp = Z + (size_t)tok_row(b, seg, tbase + tid2) * ZP + ZMG + dir * 8 + hd; gr0 = zp[0]; gr1 = zp[4]; }
    };
    auto lstore = [&]() {
#pragma unroll
        for (int n = 0; n < 5; ++n) { const int cidx = tid2 + 256 * n; if (cidx < 1056) *(LAS v4u*)(Rq + (cidx >> 4) * 128 + (cidx & 15) * 8) = gq[n]; }
#pragma unroll
        for (int n = 0; n < 2; ++n) { const int cidx = tid2 + 256 * n, row = cidx >> 3, cc = cidx & 7;
            const int stp = dir ? (63 - row) : row; const unsigned w[4] = {gv[n].x, gv[n].y, gv[n].z, gv[n].w};
#pragma unroll
            for (int j = 0; j < 4; ++j) { VT[(cc * 8 + 2 * j) * HP + stp] = (bf16)(w[j] & 0xffffu); VT[(cc * 8 + 2 * j + 1) * HP + stp] = (bf16)(w[j] >> 16); } }
    };
    auto stage0 = [&]() {
        if (w2 == 0) {
            float li = bf2f(gr0) + gbi; const float fraw = bf2f(gr1) + gbf;
            float lf = fminf(fraw, 0.f) - log1pf(__expf(-fabsf(fraw)));
            if (dir) { li = __shfl(li, 63 - lane); lf = __shfl(lf, 63 - lane); }
            const float bc = wave_scan_sum(lf);
            const float g = li - bc; const float pm = wave_scan_max(g);
            const float mprev = Vsc[1];
            const float blast = __shfl(bc, 63);
            const float lw = blast - bc + li;
            const float mnew = fmaxf(blast + mprev, wave_max(lw));
            const float Mr = fmaxf(mprev, pm);
            Vgv[lane] = g; VMr[lane] = Mr; Vwi[lane] = __expf(mprev - Mr); Vem[lane] = __expf(-bc - Mr); Vwk[lane] = __expf(lw - mnew);
            if (lane == 0) { Vsc[0] = __expf(blast + mprev - mnew); Vsc[2] = mnew; }
        }
    };
    gload(0);
    __syncthreads();
    lstore(); stage0();
    __syncthreads();
    for (int gc = 0; gc < nchT; ++gc) {
        const int seg = gc >= nchC, ch = seg ? gc - nchC : gc, len = seg ? T : TC;
        const int tbase = dir ? (len - 64 * (ch + 1)) : 64 * ch;
        if (gc + 1 < nchT) gload(gc + 1);
#ifdef DBG_REP_M1
        for (int rp_ = 0; rp_ < 2; ++rp_)
#endif
        {
            const int i = tid2 >> 2, qq = tid2 & 3, jr = dir ? (64 - i) : (i + 1);
            const float wk_i = Vwk[i];
            float qv[16], kvv[16];
#pragma unroll
            for (int j = 0; j < 16; ++j) { qv[j] = Cw[384 + qq * 16 + j]; kvv[j] = Cw[384 + 64 + qq * 16 + j]; }
#pragma unroll
            for (int tap = 0; tap < 3; ++tap) {
                const LAS bf16* rp = Rq + (jr - 1 + tap) * 128 + qq * 16;
                const v4u q0 = *(const LAS v4u*)rp, q1 = *(const LAS v4u*)(rp + 8), k0 = *(const LAS v4u*)(rp + 64), k1 = *(const LAS v4u*)(rp + 72);
                const unsigned qw[8] = {q0.x, q0.y, q0.z, q0.w, q1.x, q1.y, q1.z, q1.w}, kw[8] = {k0.x, k0.y, k0.z, k0.w, k1.x, k1.y, k1.z, k1.w};
#pragma unroll
                for (int j = 0; j < 8; ++j) { qv[2 * j] += Cw[tap * 128 + qq * 16 + 2 * j] * bflo(qw[j]); qv[2 * j + 1] += Cw[tap * 128 + qq * 16 + 2 * j + 1] * bfhi(qw[j]);
                    kvv[2 * j] += Cw[tap * 128 + 64 + qq * 16 + 2 * j] * bflo(kw[j]); kvv[2 * j + 1] += Cw[tap * 128 + 64 + qq * 16 + 2 * j + 1] * bfhi(kw[j]); }
            }
#pragma unroll
            for (int j = 0; j < 16; ++j) { qv[j] = qv[j] * fsigmoid(qv[j]); kvv[j] = kvv[j] * fsigmoid(kvv[j]) * 0.125f; }
#pragma unroll
            for (int j = 0; j < 16; j += 2) { *(LAS unsigned*)(Qc + i * HP + qq * 16 + j) = pk2(qv[j], qv[j + 1]); *(LAS unsigned*)(Kc + i * HP + qq * 16 + j) = pk2(kvv[j], kvv[j + 1]); }
#pragma unroll
            for (int j = 0; j < 16; ++j) KTw[(qq * 16 + j) * HP + i] = (bf16)f2bf(kvv[j] * wk_i);
        }
        lds_barrier();
#ifdef DBG_REP_MA
        for (int rp_ = 0; rp_ < 2; ++rp_)
#endif
        {
            const int lidx = 32 * lb + l31;
            f32x16 accN, accI;
#pragma unroll
            for (int r = 0; r < 16; ++r) { accN[r] = 0.f; accI[r] = 0.f; }
            float dsum = 0.f;
            const float Mr = VMr[lidx];
#pragma unroll
            for (int sb = 0; sb < 2; ++sb) {
                if (sb <= lb) {
                    f32x16 sT;
#pragma unroll
                    for (int r = 0; r < 16; ++r) sT[r] = 0.f;
#pragma unroll
                    for (int s = 0; s < 4; ++s) {
                        const bf16x8 ka = *(const LAS bf16x8*)(Kc + (32 * sb + l31) * HP + 16 * s + 8 * hh);
                        const bf16x8 qb = *(const LAS bf16x8*)(Qc + lidx * HP + 16 * s + 8 * hh);
                        sT = mfma32(ka, qb, sT);
                    }
#pragma unroll
                    for (int g4 = 0; g4 < 4; ++g4) { const f32x4 gv4 = *(const LAS f32x4*)(Vgv + 32 * sb + 8 * g4 + 4 * hh);
#pragma unroll
                        for (int e = 0; e < 4; ++e) { const int r = 4 * g4 + e, sidx = 32 * sb + 8 * g4 + 4 * hh + e;
                            const float ex = fexp(fminf(gv4[e] - Mr, 0.f));
                            const float p = (sidx <= lidx) ? sT[r] * ex : 0.f; sT[r] = p; dsum += p; } }
#pragma unroll
                    for (int sp = 0; sp < 2; ++sp) {
                        const bf16x8 pf = pack8(sT[8 * sp + 0], sT[8 * sp + 1], sT[8 * sp + 2], sT[8 * sp + 3], sT[8 * sp + 4], sT[8 * sp + 5], sT[8 * sp + 6], sT[8 * sp + 7]);
                        const int ko = 32 * sb + 16 * sp + 4 * hh;
                        const bf16x4 a0 = *(const LAS bf16x4*)(VT + (32 * eb + l31) * HP + ko), a1 = *(const LAS bf16x4*)(VT + (32 * eb + l31) * HP + ko + 8);
                        accN = mfma32(__builtin_shufflevector(a0, a1, 0, 1, 2, 3, 4, 5, 6, 7), pf, accN);
                    }
                }
            }
#pragma unroll
            for (int s = 0; s < 4; ++s) {
                const bf16x8 ca = *(const LAS bf16x8*)(Cb + (32 * eb + l31) * HP + 16 * s + 8 * hh);
                const bf16x8 qb = *(const LAS bf16x8*)(Qc + lidx * HP + 16 * s + 8 * hh);
                accI = mfma32(ca, qb, accI);
            }
            dsum += __shfl_xor(dsum, 32);
            float nq = 0.f;
#pragma unroll
            for (int j = 0; j < 64; j += 8) { const v4u w = *(const LAS v4u*)(Qc + lidx * HP + j); const f32x4 n0 = *(const LAS f32x4*)(Vn + j), n1 = *(const LAS f32x4*)(Vn + j + 4);
                nq += (n0[0] * bflo(w.x) + n0[1] * bfhi(w.x)) + (n0[2] * bflo(w.y) + n0[3] * bfhi(w.y)) + (n1[0] * bflo(w.z) + n1[1] * bfhi(w.z)) + (n1[2] * bflo(w.w) + n1[3] * bfhi(w.w)); }
            const float wi = Vwi[lidx];
            const float den = dsum + wi * nq, hden = fmaxf(fabsf(den), Vem[lidx]), inv = 1.0f / hden;
            const int t = dir ? (tbase + 63 - lidx) : (tbase + lidx);
            bf16* op = YM + (size_t)tok_row(b, seg, t) * 256 + hd * 64 + 32 * eb;
#pragma unroll
            for (int gq_ = 0; gq_ < 4; ++gq_) {
                const float h0 = (accN[4 * gq_] + wi * accI[4 * gq_]) * inv, h1 = (accN[4 * gq_ + 1] + wi * accI[4 * gq_ + 1]) * inv, h2 = (accN[4 * gq_ + 2] + wi * accI[4 * gq_ + 2]) * inv, h3 = (accN[4 * gq_ + 3] + wi * accI[4 * gq_ + 3]) * inv;
                v2u o; o.x = pk2(h0, h1); o.y = pk2(h2, h3);
                *(v2u*)(op + 8 * gq_ + 4 * hh) = o;
            }
        }
        lds_barrier();
        {
            const float sc = Vsc[0];
#pragma unroll
            for (int r = 0; r < 16; ++r) accC[r] *= sc;
#pragma unroll
            for (int s = 0; s < 4; ++s) {
                const bf16x8 va = *(const LAS bf16x8*)(VT + (32 * eb + l31) * HP + 16 * s + 8 * hh);
                const bf16x8 kb = *(const LAS bf16x8*)(KTw + (32 * lb + l31) * HP + 16 * s + 8 * hh);
                accC = mfma32(va, kb, accC);
            }
#pragma unroll
            for (int r = 0; r < 16; ++r) Cb[(32 * eb + crow(r, hh)) * HP + 32 * lb + l31] = (bf16)f2bf(accC[r]);
            if (tid2 < 64) { float s = 0.f;
#pragma unroll
                for (int j = 0; j < 64; j += 8) { const v4u w = *(const LAS v4u*)(KTw + tid2 * HP + j); s += (bflo(w.x) + bfhi(w.x)) + (bflo(w.y) + bfhi(w.y)) + (bflo(w.z) + bfhi(w.z)) + (bflo(w.w) + bfhi(w.w)); }
                Vn[tid2] = sc * Vn[tid2] + s; }
            if (tid2 == 0) Vsc[1] = Vsc[2];
        }
        lds_barrier();
#ifdef DBG_REP_ML
        for (int rp_ = 0; rp_ < 2; ++rp_)
#endif
        if (gc + 1 < nchT) { lstore(); stage0(); }
        lds_barrier();
    }
}
DI float gelu_tanh(float x) { const float u = 0.7978845608028654f * (x + 0.044715f * x * x * x); const float e = __expf(2.0f * u); const float th = 1.0f - 2.0f / (e + 1.0f); return 0.5f * x * (1.0f + th); }
DI void unpack8(const v4u w, float (&o)[8]) { o[0] = bflo(w.x); o[1] = bfhi(w.x); o[2] = bflo(w.y); o[3] = bfhi(w.y); o[4] = bflo(w.z); o[5] = bfhi(w.z); o[6] = bflo(w.w); o[7] = bfhi(w.w); }
DI v4u pack8u(const float (&o)[8]) { v4u w; w.x = pk2(o[0], o[1]); w.y = pk2(o[2], o[3]); w.z = pk2(o[4], o[5]); w.w = pk2(o[6], o[7]); return w; }
DI void fin_tile(KArgs a, const Ctx& F, int l, int tile) {
    const bf16* Z = (const bf16*)(a->ws + WS_ACT); bf16* MO = (bf16*)(a->ws + WS_H);
    const bf16* YS = (const bf16*)(a->ws + WS_YS5); const bf16* YR = (const bf16*)(a->ws + WS_YR); const bf16* YM = (const bf16*)(a->ws + WS_YM);
    const bf16* WGLU = (const bf16*)(a->ws + WS_SMALLW + SW_GLU); const bf16* WGUP = (const bf16*)(a->ws + WS_SMALLW + SW_GUP);
    LAS bf16* Az = (LAS bf16*)F.lds;
    LAS bf16* Ag = (LAS bf16*)(F.lds + 16896);
    LAS float* Pr = (LAS float*)(F.lds + 16896 + 4608);
    int tl_ = F.tid; asm volatile("" : "+v"(tl_));
    const int tid = tl_, lane = tid & 63, wave = F.wave, row0 = tile * 32;
    const int i = tid >> 4, part = tid & 15, row = row0 + i;
    const size_t DS = (size_t)NROWS * 256;
    const bf16* zr = Z + (size_t)row * ZP;
    {
        const float* dsk = a->in[I_S5D] + l * 256 + part * 16;
#pragma unroll
        for (int j = 0; j < 2; ++j) { const int c0 = part * 16 + 8 * j; float y0[8], y1[8], u[8], z[8];
            unpack8(*(const v4u*)(YS + (size_t)row * 256 + c0), y0); unpack8(*(const v4u*)(YS + DS + (size_t)row * 256 + c0), y1); unpack8(*(const v4u*)(zr + ZS5 + c0), u);
#pragma unroll
            for (int e = 0; e < 8; ++e) z[e] = gelu_tanh(y0[e] + y1[e] + dsk[8 * j + e] * u[e]);
            *(LAS v4u*)(Az + i * 264 + c0) = pack8u(z); }
    }
    const int hq = part >> 2, c0 = hq * 64 + (part & 3) * 16;
    const bool lat = row < NLAT; const int t = lat ? (row & (T - 1)) : ((row - NLAT) & (TC - 1)); const int len = lat ? T : TC;
    {
        float y[16]; float s = 0.f;
#pragma unroll
        for (int j = 0; j < 2; ++j) { float y0[8], y1[8]; unpack8(*(const v4u*)(YM + (size_t)row * 256 + c0 + 8 * j), y0); unpack8(*(const v4u*)(YM + DS + (size_t)row * 256 + c0 + 8 * j), y1);
#pragma unroll
            for (int e = 0; e < 8; ++e) { y[8 * j + e] = y0[e] + y1[e]; s += y[8 * j + e]; } }
        s += __shfl_xor(s, 1); s += __shfl_xor(s, 2); const float mu = s * (1.0f / 64.0f); float q = 0.f;
#pragma unroll
        for (int j = 0; j < 16; ++j) { y[j] -= mu; q += y[j] * y[j]; }
        q += __shfl_xor(q, 1); q += __shfl_xor(q, 2); const float rstd = 1.0f / sqrtf(q * (1.0f / 64.0f) + 1e-6f);
        const float* nw = a->in[I_MNORM] + l * 256 + c0;
#pragma unroll
        for (int j = 0; j < 2; ++j) { float o[8]; unpack8(*(const v4u*)(zr + ZMO + c0 + 8 * j), o);
#pragma unroll
            for (int e = 0; e < 8; ++e) o[e] = y[8 * j + e] * rstd * nw[8 * j + e] * fsigmoid(o[e]);
            *(v4u*)(MO + (size_t)row * D + 768 + c0 + 8 * j) = pack8u(o); }
    }
    {
        float y[16]; float s = 0.f;
#pragma unroll
        for (int j = 0; j < 2; ++j) { float y0[8], y1[8]; unpack8(*(const v4u*)(YR + (size_t)row * 256 + c0 + 8 * j), y0); unpack8(*(const v4u*)(YR + DS + (size_t)row * 256 + c0 + 8 * j), y1);
#pragma unroll
            for (int e = 0; e < 8; ++e) { y[8 * j + e] = y0[e] + y1[e]; s += y[8 * j + e]; } }
        s += __shfl_xor(s, 1); s += __shfl_xor(s, 2); const float mu = s * (1.0f / 64.0f); float q = 0.f;
#pragma unroll
        for (int j = 0; j < 16; ++j) { y[j] -= mu; q += y[j] * y[j]; }
        q += __shfl_xor(q, 1); q += __shfl_xor(q, 2); const float rstd = 1.0f / sqrtf(q * (1.0f / 64.0f) + 64e-5f);
        const float* cw = a->in[I_RCW] + (size_t)l * 3 * 768; const float* cbp = a->in[I_RCB] + (size_t)l * 768;
        const float* rk = a->in[I_RRK] + l * 256 + c0; const float* lw = a->in[I_RLNW] + l * 256 + c0; const float* lb = a->in[I_RLNB] + l * 256 + c0;
        float vv[16]; float bs = 0.f;
#pragma unroll
        for (int j = 0; j < 2; ++j) { const int c = c0 + 8 * j;
            float rr[8], kk[8], v[8], x[8];
#pragma unroll
            for (int e = 0; e < 8; ++e) { rr[e] = cbp[c + e]; kk[e] = cbp[256 + c + e]; v[e] = cbp[512 + c + e]; }
#pragma unroll
            for (int tap = 0; tap < 3; ++tap) { const int tt = t - 1 + tap;
                if (tt >= 0 && tt < len) { const bf16* zp = zr + (tap - 1) * ZP + ZRKV + c;
                    unpack8(*(const v4u*)zp, x);
#pragma unroll
                    for (int e = 0; e < 8; ++e) rr[e] += cw[tap * 768 + c + e] * x[e];
                    unpack8(*(const v4u*)(zp + 256), x);
#pragma unroll
                    for (int e = 0; e < 8; ++e) kk[e] += cw[tap * 768 + 256 + c + e] * x[e];
                    unpack8(*(const v4u*)(zp + 512), x);
#pragma unroll
                    for (int e = 0; e < 8; ++e) v[e] += cw[tap * 768 + 512 + c + e] * x[e]; } }
#pragma unroll
            for (int e = 0; e < 8; ++e) { bs += rr[e] * kk[e] * rk[8 * j + e]; vv[8 * j + e] = v[e]; } }
        bs += __shfl_xor(bs, 1); bs += __shfl_xor(bs, 2);
#pragma unroll
        for (int j = 0; j < 16; j += 4) *(LAS f32x4*)(Pr + i * 260 + c0 + j) = (f32x4){y[j] * rstd * lw[j] + lb[j] + bs * vv[j], y[j + 1] * rstd * lw[j + 1] + lb[j + 1] + bs * vv[j + 1], y[j + 2] * rstd * lw[j + 2] + lb[j + 2] + bs * vv[j + 2], y[j + 3] * rstd * lw[j + 3] + lb[j + 3] + bs * vv[j + 3]};
    }
    {
        const v2u gv = *(const v2u*)(zr + ZGD + part * 4);
        v2u o; o.x = pk2(fsigmoid(bflo(gv.x)), fsigmoid(bfhi(gv.x))); o.y = pk2(fsigmoid(bflo(gv.y)), fsigmoid(bfhi(gv.y)));
        *(LAS v2u*)(Ag + i * 72 + part * 4) = o;
    }
    __syncthreads();
    const int lr = lane & 15, kq = lane >> 4;
    {
        f32x4 acc[2][2];
        small_gemm<256, 2, 2, true>(Az, 264, WGLU, 32 * wave, acc, lane);
        const float* bg = a->in[I_S5BGLU] + l * 256;
#pragma unroll
        for (int nb = 0; nb < 2; ++nb)
#pragma unroll
            for (int mb = 0; mb < 2; ++mb) { const int tk = 16 * mb + lr, n = 32 * wave + 16 * nb + 4 * kq; const f32x4 v = acc[nb][mb]; const f32x4 b4 = *(const f32x4*)(bg + n);
                const v2u zz = *(const LAS v2u*)(Az + tk * 264 + n);
                const float o0 = bflo(zz.x) * fsigmoid(v.x + b4.x), o1 = bfhi(zz.x) * fsigmoid(v.y + b4.y), o2 = bflo(zz.y) * fsigmoid(v.z + b4.z), o3 = bfhi(zz.y) * fsigmoid(v.w + b4.w);
                v2u o; o.x = pk2(o0, o1); o.y = pk2(o2, o3);
                *(v2u*)(MO + (size_t)(row0 + tk) * D + n) = o; }
    }
    {
        f32x4 acc[2][2];
        small_gemm<64, 2, 2, true>(Ag, 72, WGUP, 32 * wave, acc, lane);
#pragma unroll
        for (int nb = 0; nb < 2; ++nb)
#pragma unroll
            for (int mb = 0; mb < 2; ++mb) { const int tk = 16 * mb + lr, n = 32 * wave + 16 * nb + 4 * kq; const f32x4 v = acc[nb][mb];
                const f32x4 pr = *(const LAS f32x4*)(Pr + tk * 260 + n);
                v2u o; o.x = pk2(pr.x * v.x, pr.y * v.y); o.y = pk2(pr.z * v.z, pr.w * v.w);
                *(v2u*)(MO + (size_t)(row0 + tk) * D + 512 + n) = o; }
    }
    __syncthreads();
}
#ifndef MK_SPLIT
#define MK_SPLIT 1
#endif
#ifdef USE_NOINLINE
#define NI static __device__ __noinline__
#else
#define NI static __device__ __forceinline__
#endif
extern __shared__ __attribute__((aligned(16))) unsigned char lds_raw[];
DI Ctx make_ctx(int wave0) {
    Ctx F; F.lds = (LAS uchar*)lds_raw; { int ln_ = __builtin_amdgcn_mbcnt_hi(~0u, __builtin_amdgcn_mbcnt_lo(~0u, 0u)); asm volatile("" : "+v"(ln_)); F.lane = ln_; } F.wave = wave0; F.tid = wave0 * 64 + F.lane;
    F.G = gridDim.x; { int bx = blockIdx.x; asm volatile("" : "+s"(bx)); F.vcu = (F.G % 8 == 0) ? (bx % 8) * (F.G / 8) + bx / 8 : bx; }
    return F;
}
NI void ph_prologue(KArgs a_, int wave0) { KArgs a = a_; asm volatile("" : "+s"(a)); const Ctx F = make_ctx(wave0); phase_prologue(a, F); __syncthreads(); }
NI void ph_norm(KArgs a_, int wave0, int l, int kind) { KArgs a = a_; asm volatile("" : "+s"(a));
    const Ctx F = make_ctx(wave0);
    float* modv = (float*)(a->ws + WS_MODV);
    const bool last = (l == DEPTH - 1);
    if (kind == 0) convert_weights(a, F, l, 0);
    if (kind == 1) convert_weights(a, F, l, 1);
    const int lY = (kind == 0) ? (l > 0 ? l - 1 : 0) : l;
    const int gi = (kind == 0 || kind == 3) ? 8 : (kind == 1 ? 2 : 5);
    const int pi = (kind == 0 || kind == 3) ? 2 : (kind == 1 ? 0 : 1);
    const float coef = (kind == 2) ? 1.0f : 0.5f;
    const int si = (kind == 0) ? 0 : (kind == 1 ? 3 : 6);
    const int ni = (kind == 0) ? 0 : (kind == 1 ? 1 : 2);
    const bool first = (kind == 0 && l == 0), hasY = !(kind == 0 && l == 0), hasH = (kind != 3), fin = (kind == 3);
    const int nrows = (kind == 3 || (kind == 2 && last)) ? NLAT : NROWS;
    norm_rows(a, F, first, hasY, hasH, fin, nrows, modv + (size_t)lY * 9 * MODW, gi, a->in[I_NPOST] + (lY * 3 + pi) * D, coef, modv + (size_t)l * 9 * MODW, si, a->in[I_NPRE] + (l * 3 + ni) * D);
    __syncthreads();
}
NI void ph_gemm_swiglu(KArgs a_, int wave0, int M) { KArgs a = a_; asm volatile("" : "+s"(a));
    const Ctx F = make_ctx(wave0);
    pg8::Gemm g{(const bf16*)(a->ws + WS_H), (const bf16*)(a->ws + WS_WGU), M, 2 * FF, D}; pg8::StaticOrder S; S.init(M, 2 * FF, F.G, (int)blockIdx.x);
    pg8::EpiSwiGLU E{(bf16*)(a->ws + WS_ACT), FF};
    pg8::gemm_phase<pg8::EpiSwiGLU, pg8::StaticOrder, PG8_ALIGN, PG8_SP2>(F.lds, g, S, E, F.tid);
}
NI void ph_gemm_store(KArgs a_, int wave0, int which, int M) { KArgs a = a_; asm volatile("" : "+s"(a));
    const Ctx F = make_ctx(wave0);
    const bf16* A = (const bf16*)(a->ws + (which == 0 ? WS_ACT : WS_H));
    const bf16* W = (const bf16*)(a->ws + (which == 0 ? WS_WDN : which == 1 ? WS_WIN : WS_WOUT));
    const int N = which == 1 ? ZPAD : D, K = which == 0 ? FF : D;
    pg8::Gemm g{A, W, M, N, K}; pg8::StaticOrder S; S.init(M, N, F.G, (int)blockIdx.x);
    pg8::EpiStore E{(bf16*)(a->ws + (which == 1 ? WS_ACT : WS_Y)), which == 1 ? ZP : D, which == 1 ? ZP : D};
    pg8::gemm_phase<pg8::EpiStore, pg8::StaticOrder, PG8_ALIGN, PG8_SP2>(F.lds, g, S, E, F.tid);
}
NI void ph_mla_prep(KArgs a_, int wave0, int l) { KArgs a = a_; asm volatile("" : "+s"(a)); const Ctx F = make_ctx(wave0); for (int tile = F.vcu; tile < NROWS / 64; tile += F.G) mla_prep_tile(a, F, l, tile); }
NI void ph_rwkv(KArgs a_, int wave0, int l, int v) { KArgs a = a_; asm volatile("" : "+s"(a)); const Ctx F = make_ctx(wave0); rwkv_scan_task(a, F, l, v >> 3, (v >> 1) & 3, v & 1); }
NI void ph_mlstm(KArgs a_, int wave0, int l, int idx) { KArgs a = a_; asm volatile("" : "+s"(a)); const Ctx F = make_ctx(wave0); mlstm_task(a, F, l, idx >> 2, idx & 3); __syncthreads(); }
NI void ph_s5(KArgs a_, int wave0, int l, int wg) { KArgs a = a_; asm volatile("" : "+s"(a)); const Ctx F = make_ctx(wave0); const int tk = wg * 8 + F.wave; s5_scan_task(a, l, tk >> 5, (tk >> 4) & 1, tk & 15, (LAS bf16*)(F.lds + F.wave * 8704), F.lane); __syncthreads(); }
NI void ph_attn(KArgs a_, int wave0, int first, int stride) { KArgs a = a_; asm volatile("" : "+s"(a));
    const Ctx F = make_ctx(wave0);
    for (int u = first; u < 512 + 32; u += stride) {
        if (u < 512) { const int b = u >> 6, hd = (u >> 4) & 3, qb = u & 15; attn_unit(a, F, b, hd, b * T + qb * 256, NKEY); }
        else { const int c = u - 512, b = c >> 2, hd = c & 3; attn_unit(a, F, b, hd, NLAT + b * TC, TC); }
    }
}
NI void ph_fin(KArgs a_, int wave0, int l, int M) { KArgs a = a_; asm volatile("" : "+s"(a)); const Ctx F = make_ctx(wave0); for (int tile = F.vcu; tile < M / 32; tile += F.G) fin_tile(a, F, l, tile); }


#ifdef DBG_CUT
NI void ph_dump(KArgs a_, int wave0) { KArgs a = a_; asm volatile("" : "+s"(a)); const Ctx F = make_ctx(wave0);
    const float* X = (const float*)(a->ws + WS_X); const bf16* Z = (const bf16*)(a->ws + WS_ACT); const bf16* Q = (const bf16*)(a->ws + WS_Q); const bf16* Kf = (const bf16*)(a->ws + WS_K); const bf16* Vt = (const bf16*)(a->ws + WS_VT);
    const bf16* YS = (const bf16*)(a->ws + WS_YS5); const bf16* YR = (const bf16*)(a->ws + WS_YR); const bf16* YM = (const bf16*)(a->ws + WS_YM); const bf16* MO = (const bf16*)(a->ws + WS_H); const bf16* Y = (const bf16*)(a->ws + WS_Y);
    const size_t DS = (size_t)NROWS * 256;
    for (size_t i = (size_t)F.vcu * NTHR + F.tid; i < (size_t)NLAT * D; i += (size_t)F.G * NTHR) {
#ifdef DBG_CTX
        const size_t r = NLAT + ((i >> 10) % NCTX);
#else
        const size_t r = i >> 10;
#endif
        const int c = (int)(i & 1023); float v = 0.f;
        if (DBG_WHICH & 1) v += X[r * D + c];
        if (DBG_WHICH & 2) { v += bf2f(Z[r * ZP + c]) + bf2f(Z[r * ZP + 1024 + c]); if (c + 2048 < ZP) v += bf2f(Z[r * ZP + 2048 + c]); }
        if (DBG_WHICH & 4) { v += bf2f(Q[r * 384 + c % 384]) + bf2f(Kf[r * 384 + c % 384]) + bf2f(Vt[i % ((size_t)NB * 4 * 64 * NKEY)]); }
        if (DBG_WHICH & 256) v += bf2f(Q[r * 384 + c % 384]);
        if (DBG_WHICH & 512) v += bf2f(Kf[r * 384 + c % 384]);
        if (DBG_WHICH & 1024) v += bf2f(Vt[i % ((size_t)NB * 4 * 64 * NKEY)]);
        if (DBG_WHICH & 2048) { const float* rc = (const float*)(a->ws + WS_ROPE); const bf16* sw = (const bf16*)(a->ws + WS_SMALLW); v += rc[i % (T * 32)] + bf2f(sw[i % 245760]); }
        if (DBG_WHICH & 8) v += bf2f(YS[r * 256 + (c & 255)]) + bf2f(YS[DS + r * 256 + (c & 255)]);
        if (DBG_WHICH & 16) v += bf2f(YR[r * 256 + (c & 255)]) + bf2f(YR[DS + r * 256 + (c & 255)]);
        if (DBG_WHICH & 32) v += bf2f(YM[r * 256 + (c & 255)]) + bf2f(YM[DS + r * 256 + (c & 255)]);
        if (DBG_WHICH & 64) v += bf2f(MO[r * D + c]);
        if (DBG_WHICH & 128) v += bf2f(Y[r * D + c]);
        a->out[i] = v;
    }
}
#endif
#if !MK_SPLIT
#if defined(ONLY_PH)
#define PHON(k) ((k) == ONLY_PH)
#elif defined(NO_PH)
#define PHON(k) ((k) != NO_PH)
#else
#define PHON(k) true
#endif
#if defined(ONLY_ROLE)
#define ROLE(k) ((k) == ONLY_ROLE)
#elif defined(NO_ROLE)
#define ROLE(k) ((k) != NO_ROLE)
#else
#define ROLE(k) true
#endif
#ifdef DUP_ROLE
#ifndef DUP_N
#define DUP_N 2
#endif
#define NREPR(k) ((k) == DUP_ROLE ? DUP_N : 1)
#else
#define NREPR(k) 1
#endif
#ifdef DUP_PH
#define NREP(k) ((k) == DUP_PH ? 2 : 1)
#else
#define NREP(k) 1
#endif
constexpr int NPH = 2 + 12 * DEPTH;
__global__ void __launch_bounds__(NTHR, 2) hybrid_fwd(Args args_byval) {
    KArgs a = (KArgs)__builtin_amdgcn_kernarg_segment_ptr();
    LAS uchar* lds = (LAS uchar*)lds_raw;
    const int tid = threadIdx.x; const int wave0 = __builtin_amdgcn_readfirstlane(tid >> 6);
    volatile LAS unsigned* MISC = (volatile LAS unsigned*)(lds + MISC_OFF);
    for (int u = tid; u < (LDS_BYTES - LDSCTL_OFF) / 4; u += NTHR) ((LAS unsigned*)(lds + LDSCTL_OFF))[u] = 0u;
    __syncthreads();
    unsigned* ctl = (unsigned*)(a->ws + WS_CTL);
    const int use_bar = a->use_bar;
    XcdBarrier bar; bar.bar = ctl + CW_BAR; bar.x = 0; bar.st = nullptr;
    if (use_bar) bar = xcd_barrier_post(ctl + CW_BAR, MISC + 8, tid == 0);
    const int lo = a->ph_lo, hi = a->ph_hi;
    const int G = gridDim.x; const int vcu = (G % 8 == 0) ? ((int)blockIdx.x % 8) * (G / 8) + (int)blockIdx.x / 8 : (int)blockIdx.x;
#ifdef DBG_CUT
#define IN(k) (lo <= (k) && (k) < hi && (k) < DBG_CUT)
#else
#define IN(k) (lo <= (k) && (k) < hi)
#endif
#define SEAM(k) do { if (use_bar && IN(k) && IN((k) + 1)) { int ln_ = __builtin_amdgcn_mbcnt_hi(~0u, __builtin_amdgcn_mbcnt_lo(~0u, 0u)); asm volatile("" : "+v"(ln_)); xcd_barrier(bar, wave0 == 0 && ln_ == 0); } } while (0)
    if (PHON(100) && IN(0)) ph_prologue(a, wave0);
    SEAM(0);
#pragma unroll 1
    for (int l = 0; l < DEPTH; ++l) {
        const int P = 1 + 12 * l;
        const int Mtail = (l == DEPTH - 1) ? NLAT : NROWS;
        if (PHON(0) && IN(P + 0)) ph_norm(a, wave0, l, 0);
        SEAM(P + 0);
        if (PHON(1) && IN(P + 1)) for (int rep_ = 0; rep_ < NREP(1); ++rep_) ph_gemm_swiglu(a, wave0, NROWS);
        SEAM(P + 1);
        if (PHON(2) && IN(P + 2)) for (int rep_ = 0; rep_ < NREP(2); ++rep_) ph_gemm_store(a, wave0, 0, NROWS);
        SEAM(P + 2);
        if (PHON(3) && IN(P + 3)) ph_norm(a, wave0, l, 1);
        SEAM(P + 3);
        if (PHON(4) && IN(P + 4)) for (int rep_ = 0; rep_ < NREP(4); ++rep_) ph_gemm_store(a, wave0, 1, NROWS);
        SEAM(P + 4);
        if (PHON(5) && IN(P + 5)) for (int rep_ = 0; rep_ < NREP(5); ++rep_) ph_mla_prep(a, wave0, l);
        SEAM(P + 5);
        if (PHON(6) && IN(P + 6) && G >= 256) for (int rep_ = 0; rep_ < NREP(6); ++rep_) {
            if (ROLE(0) && vcu < 64) { for (int rr_ = 0; rr_ < NREPR(0); ++rr_) ph_rwkv(a, wave0, l, vcu); }
            else if (ROLE(1) && vcu < 96) { for (int rr_ = 0; rr_ < NREPR(1); ++rr_) ph_mlstm(a, wave0, l, vcu - 64); }
            else if (ROLE(2) && vcu < 128) { for (int rr_ = 0; rr_ < NREPR(2); ++rr_) ph_s5(a, wave0, l, vcu - 96); }
            else if (ROLE(3)) { for (int rr_ = 0; rr_ < NREPR(3); ++rr_) ph_attn(a, wave0, vcu - 128, G - 128); }
        }
        SEAM(P + 6);
        if (PHON(7) && IN(P + 7)) for (int rep_ = 0; rep_ < NREP(7); ++rep_) ph_fin(a, wave0, l, Mtail);
        SEAM(P + 7);
        if (PHON(8) && IN(P + 8)) for (int rep_ = 0; rep_ < NREP(8); ++rep_) ph_gemm_store(a, wave0, 2, Mtail);
        SEAM(P + 8);
        if (PHON(9) && IN(P + 9)) ph_norm(a, wave0, l, 2);
        SEAM(P + 9);
        if (PHON(10) && IN(P + 10)) ph_gemm_swiglu(a, wave0, Mtail);
        SEAM(P + 10);
        if (PHON(11) && IN(P + 11)) ph_gemm_store(a, wave0, 0, Mtail);
        SEAM(P + 11);
    }
#ifdef DBG_CUT
    if (lo <= NPH - 1 && NPH - 1 < hi) ph_dump(a, wave0);
#else
    if (PHON(101) && IN(NPH - 1)) ph_norm(a, wave0, DEPTH - 1, 3);
#endif
#undef IN
#undef SEAM
}

#endif
#if MK_SPLIT
struct ArgsS { Args base; int kind, l, sub, M; };
typedef const __attribute__((address_space(4))) ArgsS* KArgsS;
template <int KIND>
__global__ void __launch_bounds__(NTHR, 2) phase_kernel(ArgsS args_byval) {
    KArgsS as = (KArgsS)__builtin_amdgcn_kernarg_segment_ptr();
    KArgs a = (KArgs)as;
    const int tid = threadIdx.x; const int wave0 = __builtin_amdgcn_readfirstlane(tid >> 6);
    const int l = as->l, sub = as->sub, M = as->M;
    const int G = gridDim.x; const int vcu = (G % 8 == 0) ? ((int)blockIdx.x % 8) * (G / 8) + (int)blockIdx.x / 8 : (int)blockIdx.x;
    if constexpr (KIND == 0) ph_prologue(a, wave0);
    if constexpr (KIND == 1) ph_norm(a, wave0, l, sub);
    if constexpr (KIND == 2) ph_gemm_swiglu(a, wave0, M);
    if constexpr (KIND == 3) ph_gemm_store(a, wave0, sub, M);
    if constexpr (KIND == 4) ph_mla_prep(a, wave0, l);
    if constexpr (KIND == 5) { if (vcu < 64) ph_rwkv(a, wave0, l, vcu); }
    if constexpr (KIND == 6) { if (vcu >= 64 && vcu < 96) ph_mlstm(a, wave0, l, vcu - 64); }
    if constexpr (KIND == 7) { if (vcu >= 96 && vcu < 128) ph_s5(a, wave0, l, vcu - 96); }
    if constexpr (KIND == 8) { if (vcu >= 128) ph_attn(a, wave0, vcu - 128, G - 128); }
    if constexpr (KIND == 9) ph_fin(a, wave0, l, M);
}
template <int KIND> static void launch_phase(int grid, hipStream_t stream, const Args& base, int l, int sub, int M) {
    static bool attr = false;
    if (!attr) { (void)hipFuncSetAttribute((const void*)phase_kernel<KIND>, hipFuncAttributeMaxDynamicSharedMemorySize, LDS_BYTES); attr = true; }
    ArgsS s{}; s.base = base; s.kind = KIND; s.l = l; s.sub = sub; s.M = M;
    hipLaunchKernelGGL(phase_kernel<KIND>, dim3(grid), dim3(NTHR), LDS_BYTES, stream, s);
}
static void launch_split(int grid, hipStream_t stream, const Args& a) {
    launch_phase<0>(grid, stream, a, 0, 0, 0);
    for (int l = 0; l < DEPTH; ++l) {
        const int Mtail = (l == DEPTH - 1) ? NLAT : NROWS;
        launch_phase<1>(grid, stream, a, l, 0, 0);
        launch_phase<2>(grid, stream, a, l, 0, NROWS);
        launch_phase<3>(grid, stream, a, l, 0, NROWS);
        launch_phase<1>(grid, stream, a, l, 1, 0);
        launch_phase<3>(grid, stream, a, l, 1, NROWS);
        launch_phase<4>(grid, stream, a, l, 0, 0);
        launch_phase<5>(grid, stream, a, l, 0, 0);
        launch_phase<6>(grid, stream, a, l, 0, 0);
        launch_phase<7>(grid, stream, a, l, 0, 0);
        launch_phase<8>(grid, stream, a, l, 0, 0);
        launch_phase<9>(grid, stream, a, l, 0, Mtail);
        launch_phase<3>(grid, stream, a, l, 2, Mtail);
        launch_phase<1>(grid, stream, a, l, 2, 0);
        launch_phase<2>(grid, stream, a, l, 0, Mtail);
        launch_phase<3>(grid, stream, a, l, 0, Mtail);
    }
    launch_phase<1>(grid, stream, a, DEPTH - 1, 3, 0);
}
#endif
extern "C" void kernel_launch(void* const* d_in, const int* in_sizes, int n_in, void* d_out, int out_size, void* d_ws, size_t ws_size, hipStream_t stream) {
    static int grid = 0;
    if (grid == 0) {
        if (n_in != 43 || out_size != NLAT * D || ws_size < WS_END) { fprintf(stderr, "kernel_launch: unexpected shapes: n_in %d out %d ws %zu (need %zu)\n", n_in, out_size, ws_size, (size_t)WS_END); grid = -1; return; }
        int dev = 0, cus = 0, per_cu = 0;
        if (hipGetDevice(&dev) != hipSuccess || hipDeviceGetAttribute(&cus, hipDeviceAttributeMultiprocessorCount, dev) != hipSuccess) { grid = -1; return; }
        if (false) { grid = -1; return; }
        (void)hipGetLastError();
        grid = cus;
    }
    if (grid < 0) return;
    (void)hipMemsetAsync((char*)d_ws + WS_CTL, 0, CTL_ZERO_BYTES, stream);
    Args a{};
    for (int i = 0; i < 43; ++i) a.in[i] = (const float*)d_in[i];
    a.out = (float*)d_out; a.ws = (unsigned char*)d_ws; a.pad = 0;
#if MK_SPLIT
    launch_split(grid, stream, a);
#else
    static bool attr1 = false; if (!attr1) { (void)hipFuncSetAttribute((const void*)hybrid_fwd, hipFuncAttributeMaxDynamicSharedMemorySize, LDS_BYTES); attr1 = true; }
    a.ph_lo = 0; a.ph_hi = NPH; a.use_bar = 1;
    hipLaunchKernelGGL(hybrid_fwd, dim3(grid), dim3(NTHR), LDS_BYTES, stream, a);
#endif
}
```

```cpp
#include <hip/hip_runtime.h>
#include <cstdio>
#include <cstdint>
#define MK_SPLIT 0
namespace pg8 {
#define PG8_LAS __attribute__((address_space(3)))
typedef unsigned short bf16_t;
typedef short bf16x8 __attribute__((ext_vector_type(8)));
typedef float f32x4 __attribute__((ext_vector_type(4)));
typedef unsigned u32x4 __attribute__((ext_vector_type(4)));
constexpr int BM = 256, BK = 64, HALF = 128, HTB = HALF * BK * 2  , STAGE_BYTES = 8 * HTB, NXCD = 8, WGM = 8;

__host__ __device__ __forceinline__ int lds_byte(int r, int c) { const int st = (r >> 4) * 2 + (c >> 5), rr = r & 15, cc = c & 31, ob = rr * 64 + cc * 2; return st * 1024 + (ob ^ (((ob >> 9) & 1) << 5)); }
__host__ __device__ __forceinline__ void stage_rc(int b, int& R, int& C) { const int st = b / 1024, sb = b % 1024, swz = sb ^ (((sb >> 9) & 1) << 5); R = (st >> 1) * 16 + swz / 64; C = (st & 1) * 32 + (swz % 64) / 2; }
__host__ __device__ __forceinline__ int perm32(int rho) { const int n = rho >> 4, i = rho & 15; return 8 * (i >> 2) + 4 * n + (i & 3); }

struct Unit { int pm, pn; };
struct Gemm { const bf16_t* A; const bf16_t* Bt; int M, N, K; };

struct StaticOrder {
    int nM, nN, nwg, G, c;
    __host__ __device__ void init(int M, int N, int G_, int c_) { nM = M / BM; nN = N / BM; nwg = nM * nN; G = G_; c = c_; }
    __host__ __device__ bool next(int i, Unit& u) const {
        const long L = (long)i * G + c; if (L >= nwg) return false;
        int wgid = (int)L; { const int q = nwg / NXCD, r = nwg % NXCD, xcd = wgid % NXCD, off = wgid / NXCD; wgid = (xcd < r ? xcd * (q + 1) : r * (q + 1) + (xcd - r) * q) + off; }
        const int nig = WGM * nN, gid = wgid / nig, fm = gid * WGM, gsz = (nM - fm) < WGM ? (nM - fm) : WGM;
        u.pm = fm + ((wgid % nig) % gsz); u.pn = (wgid % nig) / gsz; return true;
    }
    __device__ __forceinline__ void a_ready(const Unit&) const {}
    __device__ __forceinline__ void done(const Unit&) const {}
};

typedef __bf16 nbf16v2 __attribute__((ext_vector_type(2))); typedef float nf32v2 __attribute__((ext_vector_type(2)));
__device__ __forceinline__ unsigned cvt_pk_bf16(float lo, float hi) { const nf32v2 v = {lo, hi}; return __builtin_bit_cast(unsigned, __builtin_convertvector(v, nbf16v2)); }
struct EpiSwiGLU {
    static constexpr bool PERM = true, AFTER_DRAIN = false;
    bf16_t* O; int ldc;
    __device__ __forceinline__ void operator()(const f32x4 (&acc)[2][2][4][2], const Unit& u, int wr, int wc, int fr, int fq) const {
        const int row0 = u.pm * BM + wr * 64 + fr; const int col0 = u.pn * HALF + wc * 32 + 8 * fq;
#pragma unroll
        for (int ai = 0; ai < 2; ++ai)
#pragma unroll
            for (int m = 0; m < 4; ++m) { bf16_t* rowp = O + (size_t)(row0 + ai * HALF + m * 16) * ldc + col0;
                float o[8];
#pragma unroll
                for (int n = 0; n < 2; ++n)
#pragma unroll
                    for (int j = 0; j < 4; ++j) { const float g = acc[ai][0][m][n][j], up = acc[ai][1][m][n][j];
                        const float sg = __builtin_amdgcn_rcpf(1.0f + __builtin_amdgcn_exp2f(-1.44269504089f * g)); o[n * 4 + j] = g * sg * up; }
                u32x4 w; w.x = cvt_pk_bf16(o[0], o[1]); w.y = cvt_pk_bf16(o[2], o[3]); w.z = cvt_pk_bf16(o[4], o[5]); w.w = cvt_pk_bf16(o[6], o[7]);
                *(u32x4*)rowp = w; }
    }
};
struct EpiStore {
    static constexpr bool PERM = true, AFTER_DRAIN = false;
    bf16_t* O; int ldc; int ncols;
    __device__ __forceinline__ void operator()(const f32x4 (&acc)[2][2][4][2], const Unit& u, int wr, int wc, int fr, int fq) const {
        const int row0 = u.pm * BM + wr * 64 + fr; const int col0 = u.pn * BM + wc * 32 + 8 * fq;
#pragma unroll
        for (int ai = 0; ai < 2; ++ai)
#pragma unroll
            for (int m = 0; m < 4; ++m) { bf16_t* rowp = O + (size_t)(row0 + ai * HALF + m * 16) * ldc + col0;
#pragma unroll
                for (int bj = 0; bj < 2; ++bj) { if (col0 + bj * HALF < ncols) { const f32x4 v0 = acc[ai][bj][m][0], v1 = acc[ai][bj][m][1];
                    u32x4 w; w.x = cvt_pk_bf16(v0[0], v0[1]); w.y = cvt_pk_bf16(v0[2], v0[3]); w.z = cvt_pk_bf16(v1[0], v1[1]); w.w = cvt_pk_bf16(v1[2], v1[3]);
                    *(u32x4*)(rowp + bj * HALF) = w; } } }
    }
};
template <class Epi, class Sched, bool ALIGN_EPI = false, bool SP2 = false>
__device__ __forceinline__ void gemm_phase(PG8_LAS unsigned char* lds, const Gemm g, const Sched& S, const Epi& E, const int tid) {
    const int wid = __builtin_amdgcn_readfirstlane(tid >> 6), lane = tid & 63, wr = wid >> 2, wc = wid & 3, fr = lane & 15, fq = lane >> 4;
    const int K = g.K, nt = K / BK;
    unsigned voffA[2], voffB[2];
#pragma unroll
    for (int i = 0; i < 2; ++i) { int R, C; stage_rc(tid * 16 + i * 8192, R, C); const int Rb = Epi::PERM ? ((R & ~31) + perm32(R & 31)) : R;
        voffA[i] = (unsigned)(R * K + C) * 2u; voffB[i] = (unsigned)(Rb * K + C) * 2u; }
    const size_t kstep = (size_t)(BK * 2);
    const size_t hstep = (size_t)HALF * K * 2;
    const size_t tstep = 2 * hstep;
    const unsigned ldsw = (unsigned)wid * 1024u;
    const int aoff = lds_byte(wr * 64 + fr, fq * 8), boff = lds_byte(wc * 32 + fr, fq * 8);
#define PG8_SA(b, h) (((b) * 2 + (h)) * HTB)
#define PG8_SB(b, h) ((4 + (b) * 2 + (h)) * HTB)
#define PG8_STAGE(bufoff, gbase, voff) do { _Pragma("unroll") for (int _i = 0; _i < 2; ++_i) \
        __builtin_amdgcn_global_load_lds((const unsigned*)((const char*)(gbase) + (voff)[_i]), (PG8_LAS unsigned*)(lds + (bufoff) + ldsw + _i * 8192), 16, 0, 0); } while (0)
#define PG8_LDA(dst, b, h) do { _Pragma("unroll") for (int m = 0; m < 4; ++m) _Pragma("unroll") for (int k = 0; k < 2; ++k) dst[m][k] = *(const PG8_LAS bf16x8*)(lds + PG8_SA(b, h) + aoff + m * 2048 + k * 1024); } while (0)
#define PG8_LDB(dst, b, h) do { _Pragma("unroll") for (int n = 0; n < 2; ++n) _Pragma("unroll") for (int k = 0; k < 2; ++k) dst[n][k] = *(const PG8_LAS bf16x8*)(lds + PG8_SB(b, h) + boff + n * 2048 + k * 1024); } while (0)
#define PG8_MMA(ai, bj, At, Bt) do { __builtin_amdgcn_s_setprio(1); _Pragma("unroll") for (int m = 0; m < 4; ++m) _Pragma("unroll") for (int n = 0; n < 2; ++n) _Pragma("unroll") for (int k = 0; k < 2; ++k) \
        acc[ai][bj][m][n] = __builtin_amdgcn_mfma_f32_16x16x32_bf16(Bt[n][k], At[m][k], acc[ai][bj][m][n], 0, 0, 0); __builtin_amdgcn_s_setprio(0); } while (0)
#define PG8_WAIT_V(n) asm volatile("s_waitcnt vmcnt(" #n ")" ::: "memory")
#define PG8_WAIT_L(n) asm volatile("s_waitcnt lgkmcnt(" #n ")" ::: "memory")
#define PG8_BAR __builtin_amdgcn_s_barrier()
#define PG8_SCHED __builtin_amdgcn_sched_barrier(0)
    Unit cur, nxt; int ui = 0;
    if (!S.next(0, cur)) return;
    f32x4 acc[2][2][4][2];
#pragma unroll
    for (int a = 0; a < 2; ++a)
#pragma unroll
        for (int b = 0; b < 2; ++b)
#pragma unroll
            for (int m = 0; m < 4; ++m)
#pragma unroll
                for (int n = 0; n < 2; ++n) acc[a][b][m][n] = (f32x4){0.f, 0.f, 0.f, 0.f};
    bf16x8 At[4][2], B0[2][2], B1[2][2];
    const char* cA = (const char*)g.A + (size_t)cur.pm * tstep; const char* cB = (const char*)g.Bt + (size_t)cur.pn * tstep;
    S.a_ready(cur);
    if constexpr (SP2) {
        PG8_STAGE(PG8_SB(0, 0), cB, voffB); PG8_STAGE(PG8_SB(0, 1), cB + hstep, voffB); PG8_STAGE(PG8_SA(0, 0), cA, voffA); PG8_STAGE(PG8_SA(0, 1), cA + hstep, voffA);
        if (wr == 1) PG8_BAR;
        PG8_WAIT_V(2); PG8_BAR;
        PG8_STAGE(PG8_SB(1, 0), cB + kstep, voffB); PG8_STAGE(PG8_SA(1, 0), cA + kstep, voffA); PG8_STAGE(PG8_SB(1, 1), cB + hstep + kstep, voffB);
        PG8_WAIT_V(6); PG8_BAR;
    } else {
        PG8_STAGE(PG8_SB(0, 0), cB, voffB); PG8_STAGE(PG8_SA(0, 0), cA, voffA); PG8_STAGE(PG8_SB(0, 1), cB + hstep, voffB); PG8_STAGE(PG8_SA(0, 1), cA + hstep, voffA);
        if (wr == 1) PG8_BAR;
        PG8_WAIT_V(4); PG8_BAR;
        PG8_STAGE(PG8_SB(1, 0), cB + kstep, voffB); PG8_STAGE(PG8_SA(1, 0), cA + kstep, voffA); PG8_STAGE(PG8_SB(1, 1), cB + hstep + kstep, voffB);
        PG8_WAIT_V(6); PG8_BAR;
    }
    for (;;) {
        const bool has_next = S.next(ui + 1, nxt);
        const char* nA = has_next ? (const char*)g.A + (size_t)nxt.pm * tstep : cA; const char* nB = has_next ? (const char*)g.Bt + (size_t)nxt.pn * tstep : cB;
        for (int t = 0; t < nt; t += 2) {
            const bool last = (t == nt - 2);
            const char* a1 = cA + (size_t)(t + 1) * kstep;
            const char* a2 = last ? nA : cA + (size_t)(t + 2) * kstep; const char* b2 = last ? nB : cB + (size_t)(t + 2) * kstep;
            const char* a3 = a2 + kstep; const char* b3 = b2 + kstep;
            if (last && has_next) S.a_ready(nxt);
            if constexpr (SP2) {
            PG8_LDB(B0, 0, 0); PG8_LDB(B1, 0, 1); PG8_SCHED; PG8_LDA(At, 0, 0); PG8_STAGE(PG8_SA(1, 1), a1 + hstep, voffA);
            PG8_WAIT_V(8); PG8_WAIT_L(0); PG8_BAR; PG8_MMA(0, 0, At, B0); PG8_MMA(0, 1, At, B1); PG8_BAR; PG8_SCHED;
            PG8_LDA(At, 0, 1); PG8_STAGE(PG8_SB(0, 0), b2, voffB); PG8_STAGE(PG8_SB(0, 1), b2 + hstep, voffB); PG8_STAGE(PG8_SA(0, 0), a2, voffA);
            PG8_WAIT_V(8); PG8_WAIT_L(0); PG8_BAR; PG8_MMA(1, 0, At, B0); PG8_MMA(1, 1, At, B1); PG8_BAR; PG8_SCHED;
            PG8_LDB(B0, 1, 0); PG8_LDB(B1, 1, 1); PG8_SCHED; PG8_LDA(At, 1, 0); PG8_STAGE(PG8_SA(0, 1), a2 + hstep, voffA);
            PG8_WAIT_V(8); PG8_WAIT_L(0); PG8_BAR; PG8_MMA(0, 0, At, B0); PG8_MMA(0, 1, At, B1); PG8_BAR; PG8_SCHED;
            PG8_LDA(At, 1, 1); PG8_STAGE(PG8_SB(1, 0), b3, voffB); PG8_STAGE(PG8_SB(1, 1), b3 + hstep, voffB); PG8_STAGE(PG8_SA(1, 0), a3, voffA);
            PG8_WAIT_V(8); PG8_WAIT_L(0); PG8_BAR; PG8_MMA(1, 0, At, B0); PG8_MMA(1, 1, At, B1); PG8_BAR; PG8_SCHED;
            } else {
            PG8_LDB(B0, 0, 0); PG8_SCHED; PG8_LDA(At, 0, 0); PG8_STAGE(PG8_SA(1, 1), a1 + hstep, voffA);
            PG8_WAIT_L(8); PG8_BAR; PG8_WAIT_L(0); PG8_MMA(0, 0, At, B0); PG8_BAR; PG8_SCHED;
            PG8_LDB(B1, 0, 1); PG8_STAGE(PG8_SB(0, 0), b2, voffB);
            PG8_BAR; PG8_WAIT_L(0); PG8_MMA(0, 1, At, B1); PG8_BAR;
            PG8_LDA(At, 0, 1); PG8_STAGE(PG8_SA(0, 0), a2, voffA);
            PG8_BAR; PG8_WAIT_L(0); PG8_MMA(1, 0, At, B0); PG8_BAR; PG8_SCHED;
            PG8_STAGE(PG8_SB(0, 1), b2 + hstep, voffB);
            PG8_WAIT_V(6); PG8_BAR; PG8_MMA(1, 1, At, B1); PG8_BAR;
            PG8_LDB(B0, 1, 0); PG8_SCHED; PG8_LDA(At, 1, 0); PG8_STAGE(PG8_SA(0, 1), a2 + hstep, voffA);
            PG8_WAIT_L(8); PG8_BAR; PG8_WAIT_L(0); PG8_MMA(0, 0, At, B0); PG8_BAR; PG8_SCHED;
            PG8_LDB(B1, 1, 1); PG8_STAGE(PG8_SB(1, 0), b3, voffB);
            PG8_BAR; PG8_WAIT_L(0); PG8_MMA(0, 1, At, B1); PG8_BAR;
            PG8_LDA(At, 1, 1); PG8_STAGE(PG8_SA(1, 0), a3, voffA);
            PG8_BAR; PG8_WAIT_L(0); PG8_MMA(1, 0, At, B0); PG8_BAR; PG8_SCHED;
            PG8_STAGE(PG8_SB(1, 1), b3 + hstep, voffB);
            PG8_WAIT_V(6); PG8_BAR; PG8_MMA(1, 1, At, B1); PG8_BAR;
            }
        }
        if constexpr (ALIGN_EPI) { if (wr == 0) PG8_BAR; }
        if constexpr (!Epi::AFTER_DRAIN) { E(acc, cur, wr, wc, fr, fq); S.done(cur); }
        if (!has_next) break;
#pragma unroll
        for (int a = 0; a < 2; ++a)
#pragma unroll
            for (int b = 0; b < 2; ++b)
#pragma unroll
                for (int m = 0; m < 4; ++m)
#pragma unroll
                    for (int n = 0; n < 2; ++n) acc[a][b][m][n] = (f32x4){0.f, 0.f, 0.f, 0.f};
        cur = nxt; cA = nA; cB = nB; ++ui;
        if constexpr (ALIGN_EPI) { if (wr == 1) PG8_BAR; }
    }
    PG8_WAIT_V(0);
    if constexpr (!ALIGN_EPI) { if (wr == 0) PG8_BAR; }
    PG8_BAR;
    if constexpr (Epi::AFTER_DRAIN) { E.fused(acc, cur, wr, wc, fr, fq, lds, wid, lane); S.done(cur); }
#undef PG8_SA
#undef PG8_SB
#undef PG8_STAGE
#undef PG8_LDA
#undef PG8_LDB
#undef PG8_MMA
#undef PG8_WAIT_V
#undef PG8_WAIT_L
#undef PG8_BAR
#undef PG8_SCHED
}
}
#define PG8_SP2 true
#define PG8_ALIGN true

constexpr int NWAVES = 8, NTHR = 512;
constexpr int D = 1024, NB = 8, T = 4096, TC = 256, DEPTH = 4, FF = 2816, ZP = 2608, ZPAD = 2816;
constexpr int NLAT = NB * T, NCTX = NB * TC, NROWS = NLAT + NCTX;
constexpr int MODW = 9 * D;
constexpr int NKEY = TC + T;
constexpr float NORM_EPS = 1e-6f;
constexpr int ZS5 = 0, ZCQ = 256, ZCKV = 512, ZKR = 640, ZRKV = 672, ZWD = 1440, ZAD = 1472, ZGD = 1504, ZMQK = 1568, ZMV = 2080, ZMO = 2336, ZMG = 2592;

constexpr size_t MiB = 1u << 20;
constexpr size_t WS_CTL = 0, CTL_ZERO_BYTES = 1 * MiB;
constexpr size_t WS_MODV = 1 * MiB;
constexpr size_t WS_ROPE = 3 * MiB;
constexpr size_t WS_SMALLW = 4 * MiB;
constexpr size_t SW_UQ = 0, SW_UKV = 196608, SW_GLU = 327680, SW_GUP = 458752;
constexpr size_t WS_WGU = 6 * MiB, WS_WDN = 17 * MiB, WS_WIN = 23 * MiB, WS_WOUT = 29 * MiB;
constexpr size_t WS_X = 31 * MiB;
constexpr size_t WS_Y = 167 * MiB;
constexpr size_t WS_Q = WS_Y, WS_K = WS_Y + (size_t)NROWS * 384 * 2, WS_VT = WS_K + (size_t)NROWS * 384 * 2;
constexpr size_t WS_H = 235 * MiB;
constexpr size_t WS_ACT = 303 * MiB;
constexpr size_t WS_YS5 = 490 * MiB, WS_YR = 524 * MiB, WS_YM = 558 * MiB, WS_END = 592 * MiB;
static_assert(WS_VT + (size_t)NB * 4 * 64 * NKEY * 2 <= WS_H, "qkv overlay");
static_assert(WS_WGU + (size_t)5632 * 1024 * 2 <= WS_WDN && WS_WDN + (size_t)1024 * 2816 * 2 <= WS_WIN && WS_WIN + (size_t)2816 * 1024 * 2 <= WS_WOUT && WS_WOUT + 2 * MiB <= WS_X, "weights");
static_assert(WS_X + (size_t)NROWS * D * 4 <= WS_Y && WS_Y + (size_t)NROWS * D * 2 <= WS_H && WS_H + (size_t)NROWS * D * 2 <= WS_ACT && WS_ACT + (size_t)NROWS * ZPAD * 2 <= WS_YS5, "map");
static_assert(WS_YS5 + (size_t)2 * NROWS * 256 * 2 <= WS_YR && WS_YM + (size_t)2 * NROWS * 256 * 2 <= WS_END, "map2");
constexpr int CW_BAR = 4096;

constexpr int RING_BYTES = 131072, LDS_BYTES = 147456, LDSCTL_OFF = LDS_BYTES - 512, MISC_OFF = LDSCTL_OFF + 320;

#define GAS __attribute__((address_space(1)))
#define LAS __attribute__((address_space(3)))
typedef unsigned short bf16;
typedef unsigned char uchar;
typedef unsigned v4u __attribute__((ext_vector_type(4)));
typedef unsigned v2u __attribute__((ext_vector_type(2)));
typedef float f32x4 __attribute__((ext_vector_type(4)));
typedef float f32x16 __attribute__((ext_vector_type(16)));
typedef short bf16x8 __attribute__((ext_vector_type(8)));
typedef short bf16x4 __attribute__((ext_vector_type(4)));
#define DI __device__ __forceinline__
DI unsigned f2bf(float f) { unsigned u = __builtin_bit_cast(unsigned, f); return (u + 0x7fffu + ((u >> 16) & 1u)) >> 16; }
DI unsigned pk2(float lo, float hi) { return pg8::cvt_pk_bf16(lo, hi); }
DI float bf2f(unsigned b) { return __builtin_bit_cast(float, b << 16); }
DI float bflo(unsigned w) { return __builtin_bit_cast(float, w << 16); }
DI float bfhi(unsigned w) { return __builtin_bit_cast(float, w & 0xffff0000u); }
template <int CTRL> DI float dpp_f(float x) { return __builtin_bit_cast(float, __builtin_amdgcn_update_dpp(0, __builtin_bit_cast(int, x), CTRL, 0xf, 0xf, true)); }
DI float sum8(float x) { x += dpp_f<0xB1>(x); x += dpp_f<0x4E>(x); x += dpp_f<0x141>(x); return x; }
DI float sum16(float x) { x = sum8(x); x += dpp_f<0x140>(x); return x; }
template <int CTRL, int RM> DI float dpp_z(float x) { return __builtin_bit_cast(float, __builtin_amdgcn_update_dpp(0, __builtin_bit_cast(int, x), CTRL, RM, 0xf, true)); }
template <int CTRL, int RM> DI float dpp_o(float old, float x) { return __builtin_bit_cast(float, __builtin_amdgcn_update_dpp(__builtin_bit_cast(int, old), __builtin_bit_cast(int, x), CTRL, RM, 0xf, false)); }
DI float wave_scan_sum(float x) {
    x += dpp_z<0x111, 0xf>(x); x += dpp_z<0x112, 0xf>(x); x += dpp_z<0x114, 0xf>(x); x += dpp_z<0x118, 0xf>(x);
    x += dpp_z<0x142, 0xa>(x); x += dpp_z<0x143, 0xc>(x); return x;
}
DI float wave_scan_max(float x) {
    const float ninf = -3.0e38f;
    x = fmaxf(x, dpp_o<0x111, 0xf>(ninf, x)); x = fmaxf(x, dpp_o<0x112, 0xf>(ninf, x)); x = fmaxf(x, dpp_o<0x114, 0xf>(ninf, x)); x = fmaxf(x, dpp_o<0x118, 0xf>(ninf, x));
    x = fmaxf(x, dpp_o<0x142, 0xa>(ninf, x)); x = fmaxf(x, dpp_o<0x143, 0xc>(ninf, x)); return x;
}
DI float wave_sum(float v) { v = sum16(v); v += __shfl_xor(v, 16); v += __shfl_xor(v, 32); return v; }
DI float wave_max(float v) {
#pragma unroll
    for (int o = 1; o < 64; o <<= 1) v = fmaxf(v, __shfl_xor(v, o));
    return v;
}
DI void lds_barrier() { asm volatile("s_waitcnt lgkmcnt(0)" ::: "memory"); __builtin_amdgcn_s_barrier(); asm volatile("" ::: "memory"); }
DI float fexp(float x) { return __builtin_amdgcn_exp2f(x * 1.44269504089f); }
DI float fsigmoid(float x) { return __builtin_amdgcn_rcpf(1.0f + fexp(-x)); }
DI f32x16 mfma32(bf16x8 a, bf16x8 b, f32x16 c) { return __builtin_amdgcn_mfma_f32_32x32x16_bf16(a, b, c, 0, 0, 0); }
DI f32x4 mfma16(bf16x8 a, bf16x8 b, f32x4 c) { return __builtin_amdgcn_mfma_f32_16x16x32_bf16(a, b, c, 0, 0, 0); }
DI int crow(int r, int h) { return (r & 3) + 8 * (r >> 2) + 4 * h; }
DI bf16x8 pack8(float a0, float a1, float a2, float a3, float a4, float a5, float a6, float a7) {
    typedef __bf16 nb8 __attribute__((ext_vector_type(8))); typedef float nf8 __attribute__((ext_vector_type(8)));
    const nf8 v = {a0, a1, a2, a3, a4, a5, a6, a7}; return __builtin_bit_cast(bf16x8, __builtin_convertvector(v, nb8));
}
DI void my_sincosf(float x, float& s, float& c) {
    const float k = __builtin_rintf(x * 0.63661977236758134f);
    float r = __builtin_fmaf(-k, 1.5703125f, x); r = __builtin_fmaf(-k, 4.837512969970703125e-4f, r); r = __builtin_fmaf(-k, 7.54978995489188216e-8f, r);
    const float r2 = r * r;
    const float ps = r + r * r2 * (-1.6666654611e-1f + r2 * (8.3321608736e-3f + r2 * (-1.9515295891e-4f)));
    const float pc = 1.0f - 0.5f * r2 + r2 * r2 * (4.166664568298827e-2f + r2 * (-1.388731625493765e-3f + r2 * 2.443315711809948e-5f));
    const int q = ((int)k) & 3;
    const float ss = (q & 1) ? pc : ps, cc = (q & 1) ? ps : pc;
    s = (q & 2) ? -ss : ss; c = ((q + 1) & 2) ? -cc : cc;
}

#define XB_TMO      128
#define XB_XCNT(j)  (256  + 64 * (j))
#define XB_XSUB(j)  (1280 + 64 * (j))
#define XB_XGEN(j)  (2304 + 64 * (j))
#define XB_TOP      3328
#define XB_TOPGEN   3392
#define XCD_BAR_WORDS 3456
#define XB_SPIN_CAP (1u << 22)
DI unsigned xb_ld(unsigned* p)              { return __hip_atomic_load(p, __ATOMIC_RELAXED, __HIP_MEMORY_SCOPE_AGENT); }
DI unsigned xb_add(unsigned* p, unsigned v) { return __hip_atomic_fetch_add(p, v, __ATOMIC_RELAXED, __HIP_MEMORY_SCOPE_AGENT); }
DI unsigned xb_xcc_id() { return (unsigned)__builtin_amdgcn_s_getreg((3 << 11) | 20) & 0xFu; }
#define XB_SPIN(cond, bar) do { unsigned _sp = 0; while (cond) { __builtin_amdgcn_s_sleep(1); \
    if ((++_sp & 255u) == 0u) { if (xb_ld(&(bar)[XB_TMO])) break; if (_sp > XB_SPIN_CAP) { atomicAdd(&(bar)[XB_TMO], 1u); break; } } } } while (0)
struct XcdBarrier { unsigned* bar; unsigned x; volatile LAS unsigned* st; };
DI XcdBarrier xcd_barrier_post(unsigned* bar, volatile LAS unsigned* st, bool t0) {
    XcdBarrier b; b.bar = bar; b.x = xb_xcc_id(); b.st = st;
    if (t0) (void)xb_add(&bar[XB_XCNT(b.x)], 1u);
    return b;
}
DI void xcd_barrier_complete(unsigned* bar, unsigned x, unsigned& nloc, unsigned& nx) {
    const unsigned G = gridDim.x * gridDim.y * gridDim.z;
    unsigned sum, cnt, mine, sp = 0u;
    for (;;) {
        sum = 0u; cnt = 0u; mine = 0u;
#pragma unroll
        for (unsigned j = 0; j < 16; ++j) { const unsigned c = xb_ld(&bar[XB_XCNT(j)]); sum += c; cnt += (c > 0u) ? 1u : 0u; mine = (j == x) ? c : mine; }
        if (sum == G) break;
        __builtin_amdgcn_s_sleep(1);
        if ((++sp & 255u) == 0u) { if (xb_ld(&bar[XB_TMO])) break; if (sp > XB_SPIN_CAP) { atomicAdd(&bar[XB_TMO], 1u); break; } }
    }
    nloc = mine > 0u ? mine : 1u; nx = cnt > 0u ? cnt : 1u;
}
DI void xcd_barrier(const XcdBarrier& b, bool t0) {
    asm volatile("s_waitcnt vmcnt(0)" ::: "memory");
    __syncthreads();
    if (t0) {
        unsigned* bar = b.bar;
        __builtin_amdgcn_s_waitcnt(0);
        unsigned nloc = b.st[0], nx = b.st[1];
        if (nloc == 0u) { xcd_barrier_complete(bar, b.x, nloc, nx); b.st[0] = nloc; b.st[1] = nx; }
        const unsigned old = xb_add(&bar[XB_XSUB(b.x)], 1u);
        const unsigned gen = old / nloc;
        if (old + 1u == (gen + 1u) * nloc) {
            __builtin_amdgcn_fence(__ATOMIC_RELEASE, "agent");
            asm volatile("s_waitcnt vmcnt(0)" ::: "memory");
            const unsigned og = xb_add(&bar[XB_TOP], 1u);
            const unsigned tg = og / nx;
            if (og + 1u == (tg + 1u) * nx) xb_add(&bar[XB_TOPGEN], 1u);
            else XB_SPIN(xb_ld(&bar[XB_TOPGEN]) == tg, bar);
            __builtin_amdgcn_fence(__ATOMIC_ACQUIRE, "agent");
            xb_add(&bar[XB_XGEN(b.x)], 1u);
            asm volatile("s_waitcnt vmcnt(0)" ::: "memory");
        } else {
            XB_SPIN(xb_ld(&bar[XB_XGEN(b.x)]) == gen, bar);
            __builtin_amdgcn_fence(__ATOMIC_ACQUIRE, "agent");
            asm volatile("s_waitcnt vmcnt(0)" ::: "memory");
        }
    }
    __syncthreads();
}

struct Args { const float* in[43]; float* out; unsigned char* ws; int ph_lo, ph_hi, use_bar, pad; };
typedef const __attribute__((address_space(4))) Args* KArgs;
enum { I_X = 0, I_C, I_CTX, I_CCTX, I_WADA, I_BADA, I_NPRE, I_NPOST, I_WG, I_WU, I_WD, I_WIN, I_WOUT, I_S5LRE, I_S5LIM, I_S5DT, I_S5BRE, I_S5BIM, I_S5CRE, I_S5CIM, I_S5D, I_S5GLU, I_S5BGLU,
       I_MQN, I_MKVN, I_MUQ, I_MUKV, I_RCW, I_RCB, I_RW0, I_RWUP, I_RA0, I_RAUP, I_RGUP, I_RKK, I_RKA, I_RRK, I_RLNW, I_RLNB, I_MCW, I_MCB, I_MGB, I_MNORM };

struct Ctx {
    LAS uchar* lds; int tid, lane, wave, vcu, G;
};
DI int tok_row(int b, int seg, int t) { return seg ? b * T + t : NLAT + b * TC + t; }
DI void phase_prologue(KArgs a, const Ctx& F) {
    LAS float* sc = (LAS float*)F.lds;
    LAS float* red = (LAS float*)(F.lds + 40960);
    const float* c = a->in[I_C]; const float* cc = a->in[I_CCTX];
    for (int i = F.tid; i < 9 * D; i += NTHR) { const float v = (i < 8 * D) ? c[i] : cc[i - 8 * D]; sc[i] = v * fsigmoid(v); }
    __syncthreads();
    const float* wada = a->in[I_WADA]; const float* bada = a->in[I_BADA];
    float* modv = (float*)(a->ws + WS_MODV);
    for (int task = F.vcu; task < DEPTH * 144; task += F.G) {
        const int l = task / 144, nb = task % 144, n = nb * 64 + F.lane;
        const float* wp = wada + ((size_t)l * D + F.wave * 128) * MODW + n;
        float acc[9];
#pragma unroll
        for (int m = 0; m < 9; ++m) acc[m] = 0.f;
#pragma unroll 8
        for (int k = 0; k < 128; ++k) { const float w = wp[(size_t)k * MODW];
#pragma unroll
            for (int m = 0; m < 9; ++m) acc[m] += sc[m * D + F.wave * 128 + k] * w; }
#pragma unroll
        for (int m = 0; m < 9; ++m) red[(F.wave * 9 + m) * 64 + F.lane] = acc[m];
        __syncthreads();
        for (int i = F.tid; i < 576; i += NTHR) { const int m = i >> 6, ln = i & 63; float s = 0.f;
#pragma unroll
            for (int w = 0; w < 8; ++w) s += red[(w * 9 + m) * 64 + ln];
            modv[((size_t)l * 9 + m) * MODW + nb * 64 + ln] = s + bada[l * MODW + nb * 64 + ln]; }
        __syncthreads();
    }
    float* rc = (float*)(a->ws + WS_ROPE); float* rs = rc + T * 16;
    for (int i = F.vcu * NTHR + F.tid; i < T * 16; i += F.G * NTHR) {
        const int t = i >> 4, f = i & 15, pos = f < 8 ? (t >> 6) : (t & 63), fi = f & 7;
        const float invf = (fi == 0) ? 1.0f : (fi == 1) ? 0.31622776601683794f : (fi == 2) ? 0.1f : (fi == 3) ? 0.031622776601683794f : (fi == 4) ? 0.01f : (fi == 5) ? 0.0031622776601683794f : (fi == 6) ? 0.001f : 0.00031622776601683794f;
        const float ang = (float)pos * invf; float s, co; my_sincosf(ang, s, co);
        rc[i] = co; rs[i] = s;
    }
}

DI void tr_item(const float* W, int K, int N, bf16* WT, int kb, int n0, int drow0, LAS float* scr, int lane) {
    const int k0 = 64 * kb, nn = n0 + (lane & 31);
#pragma unroll 8
    for (int i = 0; i < 32; ++i) { const int kk = 2 * i + (lane >> 5); scr[kk * 33 + (lane & 31)] = (nn < N) ? W[(size_t)(k0 + kk) * N + nn] : 0.f; }
    const int c = lane & 7;
#pragma unroll
    for (int j = 0; j < 4; ++j) { const int n = (lane >> 3) + 8 * j; const LAS float* s = scr + (8 * c) * 33 + n;
        v4u o; o.x = pk2(s[0 * 33], s[1 * 33]); o.y = pk2(s[2 * 33], s[3 * 33]); o.z = pk2(s[4 * 33], s[5 * 33]); o.w = pk2(s[6 * 33], s[7 * 33]);
        if (n0 + n < N) *(v4u*)(WT + (size_t)(drow0 + n) * K + k0 + 8 * c) = o; }
}
DI void convert_weights(KArgs a, const Ctx& F, int l, int set) {
    LAS float* scr = (LAS float*)(F.lds + F.wave * 8704);
    const int gw = F.vcu * NWAVES + F.wave, NGW = F.G * NWAVES;
    bf16* WGU = (bf16*)(a->ws + WS_WGU); bf16* WDN = (bf16*)(a->ws + WS_WDN); bf16* WIN = (bf16*)(a->ws + WS_WIN); bf16* WOUT = (bf16*)(a->ws + WS_WOUT);
    bf16* SW = (bf16*)(a->ws + WS_SMALLW);
    const int fl = l * 2 + set;
    const float* wg = a->in[I_WG] + (size_t)fl * D * FF; const float* wu = a->in[I_WU] + (size_t)fl * D * FF; const float* wd = a->in[I_WD] + (size_t)fl * FF * D;
    constexpr int I_G = 16 * 88, I_D = 44 * 32, I_IN = 16 * 82, I_O = 16 * 32, I_UQ = 4 * 12, I_UKV = 2 * 16, I_GLU = 4 * 8, I_GUP = 1 * 8;
    const int nitems = set == 0 ? (2 * I_G + I_D + I_IN + I_O + I_UQ + I_UKV + I_GLU + I_GUP) : (2 * I_G + I_D);
    for (int it = gw; it < nitems; it += NGW) {
        int r = it;
        if (r < I_G) { const int kb = r / 88, nb = r % 88, n0 = 32 * nb; tr_item(wg, D, FF, WGU, kb, n0, 256 * (n0 >> 7) + (n0 & 127), scr, F.lane); continue; } r -= I_G;
        if (r < I_G) { const int kb = r / 88, nb = r % 88, n0 = 32 * nb; tr_item(wu, D, FF, WGU, kb, n0, 256 * (n0 >> 7) + 128 + (n0 & 127), scr, F.lane); continue; } r -= I_G;
        if (r < I_D) { const int kb = r / 32, nb = r % 32; tr_item(wd, FF, D, WDN, kb, 32 * nb, 32 * nb, scr, F.lane); continue; } r -= I_D;
        if (r < I_IN) { const int kb = r / 82, nb = r % 82; tr_item(a->in[I_WIN] + (size_t)l * D * ZP, D, ZP, WIN, kb, 32 * nb, 32 * nb, scr, F.lane); continue; } r -= I_IN;
        if (r < I_O) { const int kb = r / 32, nb = r % 32; tr_item(a->in[I_WOUT] + (size_t)l * D * D, D, D, WOUT, kb, 32 * nb, 32 * nb, scr, F.lane); continue; } r -= I_O;
        if (r < I_UQ) { const int kb = r / 12, nb = r % 12; tr_item(a->in[I_MUQ] + (size_t)l * 256 * 384, 256, 384, (bf16*)((uchar*)SW + SW_UQ), kb, 32 * nb, 32 * nb, scr, F.lane); continue; } r -= I_UQ;
        if (r < I_UKV) { const int kb = r / 16, nb = r % 16; tr_item(a->in[I_MUKV] + (size_t)l * 128 * 512, 128, 512, (bf16*)((uchar*)SW + SW_UKV), kb, 32 * nb, 32 * nb, scr, F.lane); continue; } r -= I_UKV;
        if (r < I_GLU) { const int kb = r / 8, nb = r % 8; tr_item(a->in[I_S5GLU] + (size_t)l * 256 * 256, 256, 256, (bf16*)((uchar*)SW + SW_GLU), kb, 32 * nb, 32 * nb, scr, F.lane); continue; } r -= I_GLU;
        { const int nb = r; tr_item(a->in[I_RGUP] + (size_t)l * 64 * 256, 64, 256, (bf16*)((uchar*)SW + SW_GUP), 0, 32 * nb, 32 * nb, scr, F.lane); }
    }
    if (set == 0) {
        unsigned zz_ = 0u; asm volatile("" : "+v"(zz_)); v4u z = {zz_, zz_, zz_, zz_}; v4u* p = (v4u*)(WIN + (size_t)ZP * D);
        for (int i = F.vcu * NTHR + F.tid; i < (ZPAD - ZP) * D / 8; i += F.G * NTHR) p[i] = z;
    }
}

DI void norm_rows(KArgs a, const Ctx& F, bool p_first, bool p_hasY, bool p_hasH, bool p_final, int p_nrows, const float* p_modY, int p_gi, const float* p_pw, float p_coef, const float* p_modH, int p_si, const float* p_prew) {
    float* X = (float*)(a->ws + WS_X); const bf16* Y = (const bf16*)(a->ws + WS_Y); bf16* H = (bf16*)(a->ws + WS_H);
    const int gw = F.vcu * NWAVES + F.wave, NGW = F.G * NWAVES, lane = F.lane;
    const int rpw = (p_nrows + NGW - 1) / NGW, r0 = gw * rpw, r1 = (r0 + rpw < p_nrows) ? (r0 + rpw) : p_nrows;
    if (r0 >= r1) return;
    f32x4 cA[4], cB[4], cC[4];
    int cur_mr = -1;
    f32x4 vn[4]; v2u yn[4];
    auto issue = [&](int r) {
        const float* xs = p_first ? (r < NLAT ? a->in[I_X] + (size_t)r * D : a->in[I_CTX] + (size_t)(r - NLAT) * D) : X + (size_t)r * D;
#pragma unroll
        for (int j = 0; j < 4; ++j) vn[j] = *(const f32x4*)(xs + 4 * lane + 256 * j);
        if (p_hasY) {
#pragma unroll
            for (int j = 0; j < 4; ++j) yn[j] = *(const v2u*)(Y + (size_t)r * D + 4 * lane + 256 * j);
        }
    };
    issue(r0);
    for (int r = r0; r < r1; ++r) {
        const int mr = r < NLAT ? (r >> 12) : 8;
        if (mr != cur_mr) { cur_mr = mr;
            const float* g = p_modY + (size_t)mr * MODW + p_gi * D; const float* sh = p_modH + (size_t)mr * MODW + p_si * D; const float* scp = sh + D;
#pragma unroll
            for (int j = 0; j < 4; ++j) { const int o = 4 * lane + 256 * j;
                cA[j] = p_hasY ? (*(const f32x4*)(g + o) * p_coef) * *(const f32x4*)(p_pw + o) : (f32x4){0.f, 0.f, 0.f, 0.f};
                if (p_hasH) { cB[j] = *(const f32x4*)(p_prew + o) * (*(const f32x4*)(scp + o) + 1.0f); cC[j] = *(const f32x4*)(sh + o); } else { cB[j] = cA[j]; cC[j] = cA[j]; } } }
        f32x4 v[4]; v2u yw[4];
#pragma unroll
        for (int j = 0; j < 4; ++j) { v[j] = vn[j]; yw[j] = yn[j]; }
        if (r + 1 < r1) issue(r + 1);
        if (p_hasY) {
            f32x4 y[4]; float ss = 0.f;
#pragma unroll
            for (int j = 0; j < 4; ++j) { y[j] = (f32x4){bflo(yw[j].x), bfhi(yw[j].x), bflo(yw[j].y), bfhi(yw[j].y)};
                ss += (y[j].x * y[j].x + y[j].y * y[j].y) + (y[j].z * y[j].z + y[j].w * y[j].w); }
            const float rstd = __builtin_amdgcn_rsqf(wave_sum(ss) * (1.0f / D) + NORM_EPS);
#pragma unroll
            for (int j = 0; j < 4; ++j) v[j] = v[j] + cA[j] * (y[j] * rstd);
        }
        if (p_final) {
#pragma unroll
            for (int j = 0; j < 4; ++j) *(f32x4*)(a->out + (size_t)r * D + 4 * lane + 256 * j) = v[j];
        } else if (p_hasY || p_first) {
#pragma unroll
            for (int j = 0; j < 4; ++j) *(f32x4*)(X + (size_t)r * D + 4 * lane + 256 * j) = v[j];
        }
        if (p_hasH) {
            float ss = 0.f;
#pragma unroll
            for (int j = 0; j < 4; ++j) ss += (v[j].x * v[j].x + v[j].y * v[j].y) + (v[j].z * v[j].z + v[j].w * v[j].w);
            const float rstd = __builtin_amdgcn_rsqf(wave_sum(ss) * (1.0f / D) + NORM_EPS);
#pragma unroll
            for (int j = 0; j < 4; ++j) { const f32x4 h = (v[j] * rstd) * cB[j] + cC[j];
                v2u o; o.x = pk2(h.x, h.y); o.y = pk2(h.z, h.w); *(v2u*)(H + (size_t)r * D + 4 * lane + 256 * j) = o; }
        }
    }
}
template <int K, int NBK, int MBK, bool TRANS, bool ZERO = true>
DI void small_gemm(const LAS bf16* A, int apitch, const bf16* Wt, int n0w, f32x4 (&acc)[NBK][MBK], int lane, int wpitch = K) {
    const int lr = lane & 15, kq = lane >> 4;
    if (ZERO) {
#pragma unroll
        for (int nb = 0; nb < NBK; ++nb)
#pragma unroll
            for (int mb = 0; mb < MBK; ++mb) acc[nb][mb] = (f32x4){0.f, 0.f, 0.f, 0.f};
    }
#pragma unroll 2
    for (int s = 0; s < K / 32; ++s) {
        bf16x8 av[MBK];
#pragma unroll
        for (int mb = 0; mb < MBK; ++mb) av[mb] = *(const LAS bf16x8*)(A + (16 * mb + lr) * apitch + 32 * s + 8 * kq);
#pragma unroll
        for (int nb = 0; nb < NBK; ++nb) { const bf16x8 w = *(const bf16x8*)(Wt + (size_t)(n0w + 16 * nb + lr) * wpitch + 32 * s + 8 * kq);
#pragma unroll
            for (int mb = 0; mb < MBK; ++mb) acc[nb][mb] = TRANS ? mfma16(w, av[mb], acc[nb][mb]) : mfma16(av[mb], w, acc[nb][mb]); }
    }
}
DI void ctx_gemm_block(const Ctx& F, const bf16* A, const bf16* Wt, int K, bf16* Yo) {
    const int bi = F.vcu; if (bi >= 256) return;
    const int rb = bi >> 3, cb = bi & 7, row0 = NLAT + 64 * rb;
    const int tid = F.tid, lane = F.lane, wave = F.wave;
    LAS bf16* As = (LAS bf16*)F.lds;
    const int nch = K / 256;
    v4u g[4];
    auto gload = [&](int ch) {
#pragma unroll
        for (int j = 0; j < 4; ++j) { const int cidx = tid + 512 * j, r = cidx >> 5, cc = cidx & 31; g[j] = *(const v4u*)(A + (size_t)(row0 + r) * K + ch * 256 + cc * 8); }
    };
    auto lstore = [&](int buf) {
#pragma unroll
        for (int j = 0; j < 4; ++j) { const int cidx = tid + 512 * j, r = cidx >> 5, cc = cidx & 31; *(LAS v4u*)(As + buf * 64 * 264 + r * 264 + cc * 8) = g[j]; }
    };
    f32x4 acc[1][4];
#pragma unroll
    for (int mb = 0; mb < 4; ++mb) acc[0][mb] = (f32x4){0.f, 0.f, 0.f, 0.f};
    const int lr_ = lane & 15, kq_ = lane >> 4;
    const bf16* wrow = Wt + (size_t)(128 * cb + 16 * wave + lr_) * K + 8 * kq_;
    bf16x8 wc[8], wn[8];
#pragma unroll
    for (int s = 0; s < 8; ++s) wc[s] = *(const bf16x8*)(wrow + 32 * s);
    gload(0); lstore(0);
    __syncthreads();
    for (int ch = 0; ch < nch; ++ch) {
        if (ch + 1 < nch) { gload(ch + 1);
#pragma unroll
            for (int s = 0; s < 8; ++s) wn[s] = *(const bf16x8*)(wrow + (ch + 1) * 256 + 32 * s); }
        const LAS bf16* Ab = As + (ch & 1) * 64 * 264;
#pragma unroll
        for (int s = 0; s < 8; ++s) {
#pragma unroll
            for (int mb = 0; mb < 4; ++mb) acc[0][mb] = mfma16(wc[s], *(const LAS bf16x8*)(Ab + (16 * mb + lr_) * 264 + 32 * s + 8 * kq_), acc[0][mb]);
        }
        if (ch + 1 < nch) { lstore((ch + 1) & 1);
#pragma unroll
            for (int s = 0; s < 8; ++s) wc[s] = wn[s]; }
        __syncthreads();
    }
    const int lr = lane & 15, kq = lane >> 4;
#pragma unroll
    for (int mb = 0; mb < 4; ++mb) { const f32x4 v = acc[0][mb]; v2u o; o.x = pk2(v.x, v.y); o.y = pk2(v.z, v.w);
        *(v2u*)(Yo + (size_t)(row0 + 16 * mb + lr) * D + 128 * cb + 16 * wave + 4 * kq) = o; }
}

struct S5C { float ar, ai, fr, fi; };
static __device__ __noinline__ S5C s5_coef(const float* lre, const float* lim, float dt, int nn) {
    const float lr = lre[nn], li = lim[nn], x = lr * dt;
    const float em = x * (1.0f + x * (0.5f + x * (0.16666667f + x * (0.041666668f + x * 0.0083333338f))));
    float sh, ch; my_sincosf(0.5f * li * dt, sh, ch);
    const float cm1 = -2.0f * sh * sh, sn = 2.0f * sh * ch;
    const float arm1 = em * (1.0f + cm1) + cm1;
    S5C o; o.ai = (1.0f + em) * sn; o.ar = 1.0f + arm1;
    const float den = lr * lr + li * li;
    o.fr = (arm1 * lr + o.ai * li) / den; o.fi = (o.ai * lr - arm1 * li) / den;
    return o;
}
DI void s5_scan_task(KArgs a, int l, int b, int dir, int g, LAS bf16* wl  , int lane) {
    const bf16* Z = (const bf16*)(a->ws + WS_ACT); bf16* YS = (bf16*)(a->ws + WS_YS5) + (size_t)dir * NROWS * 256;
    const int pg = (l * 2 + dir) * 16 + g;
    const float* lre = a->in[I_S5LRE] + pg * 64; const float* lim = a->in[I_S5LIM] + pg * 64;
    const float dt = __expf(a->in[I_S5DT][pg]);
    const S5C c0_ = s5_coef(lre, lim, dt, lane); const float ar = c0_.ar, ai = c0_.ai;
    bf16x8 Bf[4];
    { const int hh = lane >> 5;
#pragma unroll
      for (int nblk = 0; nblk < 2; ++nblk) { const int nn = 32 * nblk + (lane & 31); const S5C cn_ = s5_coef(lre, lim, dt, nn); const float fr = cn_.fr, fi = cn_.fi;
        const float* bre = a->in[I_S5BRE] + ((size_t)pg * 64 + nn) * 16 + 8 * hh; const float* bim = a->in[I_S5BIM] + ((size_t)pg * 64 + nn) * 16 + 8 * hh;
        float re[8], im[8];
#pragma unroll
        for (int j = 0; j < 8; ++j) { re[j] = fr * bre[j] - fi * bim[j]; im[j] = fi * bre[j] + fr * bim[j]; }
        Bf[nblk] = pack8(re[0], re[1], re[2], re[3], re[4], re[5], re[6], re[7]); Bf[2 + nblk] = pack8(im[0], im[1], im[2], im[3], im[4], im[5], im[6], im[7]); } }
    bf16x8 Cf[4];
    { const int p = lane & 15, q = lane >> 4;
#pragma unroll
      for (int s = 0; s < 4; ++s) { const int kc = 32 * s + 8 * q; float cv[8];
        const float* src = (s < 2) ? a->in[I_S5CRE] + ((size_t)pg * 16 + p) * 64 + kc : a->in[I_S5CIM] + ((size_t)pg * 16 + p) * 64 + (kc - 64);
        const float sg = (s < 2) ? 1.f : -1.f;
#pragma unroll
        for (int j = 0; j < 8; ++j) cv[j] = sg * src[j];
        Cf[s] = pack8(cv[0], cv[1], cv[2], cv[3], cv[4], cv[5], cv[6], cv[7]); } }
    float sr = 0.f, si = 0.f;
    const int hh = lane >> 5, li5 = lane & 31, q = lane >> 4, t16 = lane & 15;
    const f32x16 zero16 = {0.f, 0.f, 0.f, 0.f, 0.f, 0.f, 0.f, 0.f, 0.f, 0.f, 0.f, 0.f, 0.f, 0.f, 0.f, 0.f};
    const int nchC = TC / 32, nchT = nchC + T / 32;
    auto afload = [&](int gc) -> bf16x8 {
        const int seg = gc >= nchC, ch = seg ? gc - nchC : gc, len = seg ? T : TC;
        const int sidx = 32 * ch + li5, tt = dir ? (len - 1 - sidx) : sidx;
        return *(const bf16x8*)(Z + (size_t)tok_row(b, seg, tt) * ZP + ZS5 + g * 16 + 8 * hh);
    };
    bf16x8 afn = afload(0);
    for (int gc = 0; gc < nchT; ++gc) {
        const int seg = gc >= nchC, ch = seg ? gc - nchC : gc, len = seg ? T : TC;
        {
            const bf16x8 af = afn;
            if (gc + 1 < nchT) afn = afload(gc + 1);
            f32x16 d1 = mfma32(af, Bf[0], zero16), d2 = mfma32(af, Bf[1], zero16), d3 = mfma32(af, Bf[2], zero16), d4 = mfma32(af, Bf[3], zero16);
            float xa[16], xb[16], ya[16], yb[16];
#pragma unroll
            for (int r = 0; r < 16; ++r) {
                auto r1 = __builtin_amdgcn_permlane32_swap(__float_as_uint(d1[r]), __float_as_uint(d2[r]), false, false); xa[r] = __uint_as_float(r1[0]); xb[r] = __uint_as_float(r1[1]);
                auto r2 = __builtin_amdgcn_permlane32_swap(__float_as_uint(d3[r]), __float_as_uint(d4[r]), false, false); ya[r] = __uint_as_float(r2[0]); yb[r] = __uint_as_float(r2[1]); }
#pragma unroll
            for (int i = 0; i < 32; ++i) {
                const int r = 4 * (i >> 3) + (i & 3); const bool hi = (i >> 2) & 1;
                const float xre = hi ? xb[r] : xa[r], xim = hi ? yb[r] : ya[r];
                const float nsr = ar * sr - ai * si + xre, nsi = ar * si + ai * sr + xim; sr = nsr; si = nsi;
                wl[i * 136 + lane] = (bf16)f2bf(sr); wl[i * 136 + 64 + lane] = (bf16)f2bf(si);
            }
#pragma unroll
            for (int tb = 0; tb < 2; ++tb) {
                f32x4 acc = {0.f, 0.f, 0.f, 0.f};
#pragma unroll
                for (int s = 0; s < 4; ++s) { const bf16x8 bfr = *(const LAS bf16x8*)(wl + (16 * tb + t16) * 136 + 32 * s + 8 * q); acc = mfma16(Cf[s], bfr, acc); }
                const int so = 32 * ch + 16 * tb + t16, to = dir ? (len - 1 - so) : so;
                v2u o; o.x = pk2(acc[0], acc[1]); o.y = pk2(acc[2], acc[3]);
                *(v2u*)(YS + (size_t)tok_row(b, seg, to) * 256 + g * 16 + 4 * q) = o;
            }
        }
    }
}

DI void mla_prep_tile(KArgs a, const Ctx& F, int l, int tile) {
    const bf16* Z = (const bf16*)(a->ws + WS_ACT);
    bf16* Q = (bf16*)(a->ws + WS_Q); bf16* Kf = (bf16*)(a->ws + WS_K); bf16* Vt = (bf16*)(a->ws + WS_VT);
    const bf16* WUQ = (const bf16*)(a->ws + WS_SMALLW + SW_UQ); const bf16* WUKV = (const bf16*)(a->ws + WS_SMALLW + SW_UKV);
    const float* rc = (const float*)(a->ws + WS_ROPE); const float* rs = rc + T * 16;
    LAS bf16* Aq = (LAS bf16*)F.lds;
    LAS bf16* Akv = (LAS bf16*)(F.lds + 64 * 264 * 2);
    const int row0 = tile * 64, tid = F.tid, lane = F.lane, wave = F.wave;
    const bool lat = row0 < NLAT;
    {
        const int i = tid >> 3, part = tid & 7, row = row0 + i;
        const bf16* zr = Z + (size_t)row * ZP;
        float q[32], kv[16]; float sq = 0.f, sk = 0.f;
#pragma unroll
        for (int j = 0; j < 4; ++j) { const v4u w = *(const v4u*)(zr + ZCQ + part * 32 + 8 * j);
            q[8 * j + 0] = bflo(w.x); q[8 * j + 1] = bfhi(w.x); q[8 * j + 2] = bflo(w.y); q[8 * j + 3] = bfhi(w.y); q[8 * j + 4] = bflo(w.z); q[8 * j + 5] = bfhi(w.z); q[8 * j + 6] = bflo(w.w); q[8 * j + 7] = bfhi(w.w); }
#pragma unroll
        for (int j = 0; j < 2; ++j) { const v4u w = *(const v4u*)(zr + ZCKV + part * 16 + 8 * j);
            kv[8 * j + 0] = bflo(w.x); kv[8 * j + 1] = bfhi(w.x); kv[8 * j + 2] = bflo(w.y); kv[8 * j + 3] = bfhi(w.y); kv[8 * j + 4] = bflo(w.z); kv[8 * j + 5] = bfhi(w.z); kv[8 * j + 6] = bflo(w.w); kv[8 * j + 7] = bfhi(w.w); }
#pragma unroll
        for (int j = 0; j < 32; ++j) sq += q[j] * q[j];
#pragma unroll
        for (int j = 0; j < 16; ++j) sk += kv[j] * kv[j];
        sq += __shfl_xor(sq, 1); sq += __shfl_xor(sq, 2); sq += __shfl_xor(sq, 4);
        sk += __shfl_xor(sk, 1); sk += __shfl_xor(sk, 2); sk += __shfl_xor(sk, 4);
        const float rq = 1.0f / sqrtf(sq * (1.0f / 256.0f) + NORM_EPS), rk = 1.0f / sqrtf(sk * (1.0f / 128.0f) + NORM_EPS);
        const float* qn = a->in[I_MQN] + l * 256 + part * 32; const float* kn = a->in[I_MKVN] + l * 128 + part * 16;
#pragma unroll
        for (int j = 0; j < 32; j += 2) *(LAS unsigned*)(Aq + i * 264 + part * 32 + j) = pk2(q[j] * rq * qn[j], q[j + 1] * rq * qn[j + 1]);
#pragma unroll
        for (int j = 0; j < 16; j += 2) *(LAS unsigned*)(Akv + i * 136 + part * 16 + j) = pk2(kv[j] * rk * kn[j], kv[j + 1] * rk * kn[j + 1]);
        if (part == 0) {
            float kr[32];
#pragma unroll
            for (int j = 0; j < 4; ++j) { const v4u w = *(const v4u*)(zr + ZKR + 8 * j);
                kr[8 * j + 0] = bflo(w.x); kr[8 * j + 1] = bfhi(w.x); kr[8 * j + 2] = bflo(w.y); kr[8 * j + 3] = bfhi(w.y); kr[8 * j + 4] = bflo(w.z); kr[8 * j + 5] = bfhi(w.z); kr[8 * j + 6] = bflo(w.w); kr[8 * j + 7] = bfhi(w.w); }
            float o[32];
            if (lat) { const int t = row & (T - 1);
#pragma unroll
                for (int hf = 0; hf < 2; ++hf)
#pragma unroll
                    for (int j = 0; j < 8; ++j) { const float c = rc[t * 16 + hf * 8 + j], s = rs[t * 16 + hf * 8 + j]; const float x0 = kr[hf * 16 + j], x1 = kr[hf * 16 + 8 + j];
                        o[hf * 16 + j] = x0 * c - x1 * s; o[hf * 16 + 8 + j] = x1 * c + x0 * s; }
            } else {
#pragma unroll
                for (int j = 0; j < 32; ++j) o[j] = kr[j];
            }
#pragma unroll
            for (int hd = 0; hd < 4; ++hd) { bf16* kp = Kf + (size_t)row * 384 + hd * 96 + 64;
#pragma unroll
                for (int j = 0; j < 4; ++j) { v4u w; w.x = pk2(o[8 * j], o[8 * j + 1]); w.y = pk2(o[8 * j + 2], o[8 * j + 3]); w.z = pk2(o[8 * j + 4], o[8 * j + 5]); w.w = pk2(o[8 * j + 6], o[8 * j + 7]); *(v4u*)(kp + 8 * j) = w; } }
        }
    }
    __syncthreads();
    const int lr = lane & 15, kq = lane >> 4;
    {
        f32x4 acc[3][4];
        small_gemm<256, 3, 4, true>(Aq, 264, WUQ, 48 * wave, acc, lane);
        const float qs = 0.10206207261596577f * 1.44269504089f;
#pragma unroll
        for (int nb = 0; nb < 3; ++nb) { const int blk = 3 * wave + nb, hb = blk % 6;
#pragma unroll
            for (int mb = 0; mb < 4; ++mb) { const int row = row0 + 16 * mb + lr; f32x4 v = acc[nb][mb];
                if (hb >= 4) {
                    f32x4 pv; pv.x = __shfl_xor(v.x, 32); pv.y = __shfl_xor(v.y, 32); pv.z = __shfl_xor(v.z, 32); pv.w = __shfl_xor(v.w, 32);
                    if (lat) { const int t = row & (T - 1); const int fb = (hb - 4) * 8 + 4 * (kq & 1);
                        const f32x4 c = *(const f32x4*)(rc + t * 16 + fb), s = *(const f32x4*)(rs + t * 16 + fb);
                        v = (kq < 2) ? (v * c - pv * s) : (v * c + pv * s); }
                }
                v = v * qs;
                v2u o; o.x = pk2(v.x, v.y); o.y = pk2(v.z, v.w);
                *(v2u*)(Q + (size_t)row * 384 + 16 * blk + 4 * kq) = o; } }
    }
    {
        const int hd = wave >> 1;
        if ((wave & 1) == 0) {
            f32x4 acc[4][4];
            small_gemm<128, 4, 4, true>(Akv, 136, WUKV, 64 * wave, acc, lane);
#pragma unroll
            for (int nb = 0; nb < 4; ++nb)
#pragma unroll
                for (int mb = 0; mb < 4; ++mb) { const int row = row0 + 16 * mb + lr; const f32x4 v = acc[nb][mb];
                    v2u o; o.x = pk2(v.x, v.y); o.y = pk2(v.z, v.w);
                    *(v2u*)(Kf + (size_t)row * 384 + hd * 96 + 16 * nb + 4 * kq) = o; }
        } else {
            f32x4 acc[4][4];
            small_gemm<128, 4, 4, false>(Akv, 136, WUKV, 64 * wave, acc, lane);
            const int bb = lat ? (row0 >> 12) : ((row0 - NLAT) >> 8);
            const int key0 = lat ? (TC + (row0 & (T - 1))) : ((row0 - NLAT) & (TC - 1));
#pragma unroll
            for (int nb = 0; nb < 4; ++nb)
#pragma unroll
                for (int mb = 0; mb < 4; ++mb) { const f32x4 v = acc[nb][mb];
                    v2u o; o.x = pk2(v.x, v.y); o.y = pk2(v.z, v.w);
                    *(v2u*)(Vt + ((size_t)(bb * 4 + hd) * 64 + 16 * nb + lr) * NKEY + key0 + 16 * mb + 4 * kq) = o; }
        }
    }
    __syncthreads();
}

DI void attn_unit(KArgs a, const Ctx& F, int b, int hd, int qrow0, int nkeys) {
    const bf16* Q = (const bf16*)(a->ws + WS_Q); const bf16* Kf = (const bf16*)(a->ws + WS_K); const bf16* Vt = (const bf16*)(a->ws + WS_VT);
    bf16* MO = (bf16*)(a->ws + WS_H);
    constexpr int KP = 208, VP = 144, BUF = 64 * KP + 64 * VP;
    const int tid = F.tid, lane = F.lane, wave = F.wave, l31 = lane & 31, h2 = lane >> 5;
    const int qrow = qrow0 + 32 * wave + l31;
    bf16x8 Qf[6];
#pragma unroll
    for (int s = 0; s < 6; ++s) Qf[s] = *(const bf16x8*)(Q + (size_t)qrow * 384 + hd * 96 + 16 * s + 8 * h2);
    const int kc0 = tid, kc1 = tid + 512;
    const int kr0 = kc0 / 12, kcc0 = kc0 % 12, kr1 = kc1 / 12, kcc1 = kc1 % 12; const bool k1v = kc1 < 768;
    const int vd = tid >> 3, vcc = tid & 7;
    const bf16* vbase = Vt + ((size_t)(b * 4 + hd) * 64 + vd) * NKEY + vcc * 8;
    v4u gk0, gk1, gv;
    auto gload = [&](int kt) {
        const int key0 = 64 * kt; const int krow = key0 < TC ? (NLAT + b * TC + key0) : (b * T + key0 - TC);
        gk0 = *(const v4u*)(Kf + (size_t)(krow + kr0) * 384 + hd * 96 + kcc0 * 8);
        if (k1v) gk1 = *(const v4u*)(Kf + (size_t)(krow + kr1) * 384 + hd * 96 + kcc1 * 8);
        gv = *(const v4u*)(vbase + key0);
    };
    auto lstore = [&](int buf) {
        LAS uchar* base = F.lds + buf * BUF;
        *(LAS v4u*)(base + kr0 * KP + kcc0 * 16) = gk0;
        if (k1v) *(LAS v4u*)(base + kr1 * KP + kcc1 * 16) = gk1;
        *(LAS v4u*)(base + 64 * KP + vd * VP + vcc * 16) = gv;
    };
    const int nt = nkeys / 64;
    gload(0); lstore(0);
    __syncthreads();
    f32x16 O0, O1;
#pragma unroll
    for (int r = 0; r < 16; ++r) { O0[r] = 0.f; O1[r] = 0.f; }
    float m = -1e30f, lsum = 0.f;
    for (int kt = 0; kt < nt; ++kt) {
        const bool more = kt + 1 < nt;
        if (more) gload(kt + 1);
        const LAS uchar* kb_ = F.lds + (kt & 1) * BUF; const LAS uchar* vb_ = kb_ + 64 * KP;
        f32x16 s0, s1;
#pragma unroll
        for (int r = 0; r < 16; ++r) { s0[r] = 0.f; s1[r] = 0.f; }
#pragma unroll
        for (int s = 0; s < 6; ++s) {
            const bf16x8 ka = *(const LAS bf16x8*)(kb_ + l31 * KP + (16 * s + 8 * h2) * 2);
            const bf16x8 kb2 = *(const LAS bf16x8*)(kb_ + (32 + l31) * KP + (16 * s + 8 * h2) * 2);
            s0 = mfma32(ka, Qf[s], s0); s1 = mfma32(kb2, Qf[s], s1);
        }
        float mx = s0[0];
#pragma unroll
        for (int r = 1; r < 16; ++r) mx = fmaxf(mx, s0[r]);
#pragma unroll
        for (int r = 0; r < 16; ++r) mx = fmaxf(mx, s1[r]);
        mx = fmaxf(mx, __shfl_xor(mx, 32));
        const float mn = fmaxf(m, mx), alpha = __builtin_amdgcn_exp2f(m - mn); m = mn;
        float ps = 0.f;
#pragma unroll
        for (int r = 0; r < 16; ++r) { s0[r] = __builtin_amdgcn_exp2f(s0[r] - mn); s1[r] = __builtin_amdgcn_exp2f(s1[r] - mn); ps += s0[r] + s1[r]; }
        lsum = lsum * alpha + ps;
#pragma unroll
        for (int r = 0; r < 16; ++r) { O0[r] *= alpha; O1[r] *= alpha; }
#pragma unroll
        for (int kb = 0; kb < 2; ++kb)
#pragma unroll
            for (int sp = 0; sp < 2; ++sp) {
                const f32x16& sx = kb ? s1 : s0;
                const bf16x8 pf = pack8(sx[8 * sp + 0], sx[8 * sp + 1], sx[8 * sp + 2], sx[8 * sp + 3], sx[8 * sp + 4], sx[8 * sp + 5], sx[8 * sp + 6], sx[8 * sp + 7]);
                const int ko = (32 * kb + 16 * sp + 4 * h2) * 2;
                const bf16x4 a0 = *(const LAS bf16x4*)(vb_ + l31 * VP + ko), a1 = *(const LAS bf16x4*)(vb_ + l31 * VP + ko + 16);
                const bf16x4 c0 = *(const LAS bf16x4*)(vb_ + (32 + l31) * VP + ko), c1 = *(const LAS bf16x4*)(vb_ + (32 + l31) * VP + ko + 16);
                const bf16x8 va = __builtin_shufflevector(a0, a1, 0, 1, 2, 3, 4, 5, 6, 7), vc = __builtin_shufflevector(c0, c1, 0, 1, 2, 3, 4, 5, 6, 7);
                O0 = mfma32(va, pf, O0); O1 = mfma32(vc, pf, O1);
            }
        if (more) lstore((kt + 1) & 1);
        __syncthreads();
    }
    const float ltot = lsum + __shfl_xor(lsum, 32), inv = 1.0f / ltot;
    bf16* op = MO + (size_t)qrow * D + 256 + hd * 64;
#pragma unroll
    for (int gq = 0; gq < 4; ++gq) {
        v2u o; o.x = pk2(O0[4 * gq] * inv, O0[4 * gq + 1] * inv); o.y = pk2(O0[4 * gq + 2] * inv, O0[4 * gq + 3] * inv);
        *(v2u*)(op + 8 * gq + 4 * h2) = o;
        v2u o2; o2.x = pk2(O1[4 * gq] * inv, O1[4 * gq + 1] * inv); o2.y = pk2(O1[4 * gq + 2] * inv, O1[4 * gq + 3] * inv);
        *(v2u*)(op + 32 + 8 * gq + 4 * h2) = o2;
    }
}
DI float conv3(const bf16* Z, int b, int seg, int t, int len, int col, float w0, float w1, float w2, float cb) {
    const bf16* zp = Z + (size_t)tok_row(b, seg, t) * ZP + col;
    float y = cb + w1 * bf2f(zp[0]);
    if (t > 0) y += w0 * bf2f(zp[-ZP]);
    if (t + 1 < len) y += w2 * bf2f(zp[ZP]);
    return y;
}
DI bf16x8 ldperm(const LAS bf16* rowp, int k0, int hh) { const bf16x4 a0 = *(const LAS bf16x4*)(rowp + k0 + 4 * hh), a1 = *(const LAS bf16x4*)(rowp + k0 + 8 + 4 * hh); return __builtin_shufflevector(a0, a1, 0, 1, 2, 3, 4, 5, 6, 7); }
DI bf16x8 pack_acc(const f32x16& x, int s) { return s ? pack8(x[8], x[9], x[10], x[11], x[12], x[13], x[14], x[15]) : pack8(x[0], x[1], x[2], x[3], x[4], x[5], x[6], x[7]); }
DI void rwkv_scan_task(KArgs a, const Ctx& F, int l, int b, int hd, int dir) {
    const bf16* Z = (const bf16*)(a->ws + WS_ACT); bf16* YR = (bf16*)(a->ws + WS_YR) + (size_t)dir * NROWS * 256;
    constexpr int RAWSZ = 13056 + 4608;
    constexpr int SETSZ = 4 * 4608 + 3 * 5120 + 256 + 2560;
    LAS uchar* const RAW0 = F.lds;
    LAS float* WL = (LAS float*)(F.lds + 2 * RAWSZ);
    LAS float* AL = WL + 2048;
    LAS float* Alw = AL + 2048;
    LAS float* CST = Alw + 512;
    LAS uchar* const SET0 = (LAS uchar*)(CST + 1024);
    const int tid = F.tid, lane = F.lane, wave = F.wave;
    const int hc = hd * 64 + lane;
    bf16x8 lf0 = {0, 0, 0, 0, 0, 0, 0, 0}, lf1 = lf0;
    if (wave >= 4) { const int w4 = wave - 4, l31 = lane & 31, hh = lane >> 5; const float* up = a->in[(w4 >> 1) ? I_RAUP : I_RWUP] + ((size_t)(l * 2 + dir) * 32) * 256 + hd * 64 + 32 * (w4 & 1) + l31;
        float u[16];
#pragma unroll
        for (int s = 0; s < 2; ++s)
#pragma unroll
            for (int j = 0; j < 8; ++j) u[8 * s + j] = up[(size_t)(16 * s + 8 * hh + j) * 256];
        lf0 = pack8(u[0], u[1], u[2], u[3], u[4], u[5], u[6], u[7]); lf1 = pack8(u[8], u[9], u[10], u[11], u[12], u[13], u[14], u[15]); }
    if (wave == 0) {
        const float* cw = a->in[I_RCW] + (size_t)l * 3 * 768; const float* cbp = a->in[I_RCB] + (size_t)l * 768;
        CST[0 * 64 + lane] = a->in[I_RW0][(l * 2 + dir) * 256 + hc]; CST[1 * 64 + lane] = a->in[I_RA0][(l * 2 + dir) * 256 + hc];
        CST[2 * 64 + lane] = a->in[I_RKK][l * 256 + hc]; CST[3 * 64 + lane] = a->in[I_RKA][l * 256 + hc];
#pragma unroll
        for (int j = 0; j < 3; ++j) { CST[(4 + j) * 64 + lane] = cw[j * 768 + hc]; CST[(7 + j) * 64 + lane] = cw[j * 768 + 256 + hc]; CST[(10 + j) * 64 + lane] = cw[j * 768 + 512 + hc]; }
        CST[13 * 64 + lane] = cbp[hc]; CST[14 * 64 + lane] = cbp[256 + hc]; CST[15 * 64 + lane] = cbp[512 + hc];
    }
    f32x16 ST0, ST1;
#pragma unroll
    for (int r = 0; r < 16; ++r) { ST0[r] = 0.f; ST1[r] = 0.f; }
    const int c0r = tid / 24, c0s = (tid % 24) >> 3, c0c = (tid % 24) & 7;
    const int c1 = tid + 512, c1r = c1 / 24, c1s = (c1 % 24) >> 3, c1c = (c1 % 24) & 7; const bool c1v = c1 < 816;
    const int lr_ = tid >> 3, lc_ = tid & 7;
    v4u g0, g1, g2;
    unsigned zz_ = 0u; asm volatile("" : "+v"(zz_)); const v4u zero4 = {zz_, zz_, zz_, zz_};
    const int nchC = TC / 32, nchT = nchC + T / 32;
    auto gload = [&](int gc) {
        const int seg = gc >= nchC, ch = seg ? gc - nchC : gc, len = seg ? T : TC;
        const int tbase = dir ? (len - 32 * (ch + 1)) : 32 * ch;
        { const int t = tbase - 1 + c0r; g0 = (t >= 0 && t < len) ? *(const v4u*)(Z + (size_t)tok_row(b, seg, t) * ZP + ZRKV + c0s * 256 + hd * 64 + c0c * 8) : zero4; }
        if (c1v) { const int t = tbase - 1 + c1r; g1 = (t >= 0 && t < len) ? *(const v4u*)(Z + (size_t)tok_row(b, seg, t) * ZP + ZRKV + c1s * 256 + hd * 64 + c1c * 8) : zero4; }
        if (tid < 256) { const int t = tbase + lr_; g2 = *(const v4u*)(Z + (size_t)tok_row(b, seg, t) * ZP + ZWD + lc_ * 8); }
    };
    auto lstore = [&](int par) {
        LAS bf16* Raw = (LAS bf16*)(RAW0 + par * RAWSZ); LAS bf16* LwB = (LAS bf16*)(RAW0 + par * RAWSZ + 13056);
        *(LAS v4u*)(Raw + c0r * 192 + c0s * 64 + c0c * 8) = g0;
        if (c1v) *(LAS v4u*)(Raw + c1r * 192 + c1s * 64 + c1c * 8) = g1;
        if (tid < 256) { float x[8] = {bflo(g2.x), bfhi(g2.x), bflo(g2.y), bfhi(g2.y), bflo(g2.z), bfhi(g2.z), bflo(g2.w), bfhi(g2.w)};
            if (lc_ < 4) {
#pragma unroll
                for (int j = 0; j < 8; ++j) x[j] = 1.0f - 2.0f * __builtin_amdgcn_rcpf(1.0f + fexp(2.0f * x[j])); }
            v4u w; w.x = pk2(x[0], x[1]); w.y = pk2(x[2], x[3]); w.z = pk2(x[4], x[5]); w.w = pk2(x[6], x[7]);
            *(LAS v4u*)(LwB + lr_ * 72 + lc_ * 8) = w; }
    };
    gload(0); lstore(0);
    __syncthreads();
    for (int n = -2; n < nchT; ++n) {
        if (n + 3 < nchT) gload(n + 3);
        int ln_ = lane; asm volatile("" : "+v"(ln_));
        const int l31 = ln_ & 31, hh = ln_ >> 5;
        if (wave < 2) {
            if (n >= 0) {
                const int seg = n >= nchC, ch = seg ? n - nchC : n, len = seg ? T : TC;
                const int tbase = dir ? (len - 32 * (ch + 1)) : 32 * ch;
                LAS uchar* sp = SET0 + (n & 1) * SETSZ;
                LAS bf16* KhT = (LAS bf16*)sp; LAS bf16* BhT = KhT + 32 * 72; LAS bf16* KkT = BhT + 32 * 72; LAS bf16* RhT = KkT + 32 * 72;
                LAS bf16* Kh = RhT + 32 * 72; LAS bf16* nBh = Kh + 64 * 40; LAS bf16* VT = nBh + 64 * 40; LAS float* GL = (LAS float*)(VT + 64 * 40); LAS bf16* TT = (LAS bf16*)(GL + 64);
                const int vcol = 32 * wave + l31;
                f32x16 accP, accY, accBb;
#pragma unroll
                for (int r = 0; r < 16; ++r) { accP[r] = 0.f; accY[r] = 0.f; }
#pragma unroll
                for (int kb = 0; kb < 2; ++kb)
#pragma unroll
                    for (int s = 0; s < 2; ++s) { const bf16x8 sb = pack_acc(kb ? ST1 : ST0, s);
                        accP = mfma32(ldperm(KkT + l31 * 72, 32 * kb + 16 * s, hh), sb, accP);
                        accY = mfma32(ldperm(RhT + l31 * 72, 32 * kb + 16 * s, hh), sb, accY); }
                {
                    f32x16 acc;
#pragma unroll
                    for (int r = 0; r < 16; ++r) acc[r] = 0.f;
#pragma unroll
                    for (int s = 0; s < 4; ++s) acc = mfma32(*(const LAS bf16x8*)(KhT + l31 * 72 + 16 * s + 8 * hh), *(const LAS bf16x8*)(KkT + l31 * 72 + 16 * s + 8 * hh), acc);
#pragma unroll
                    for (int r = 0; r < 16; ++r) acc[r] = (crow(r, hh) < l31) ? acc[r] : 0.f;
#pragma unroll
                    for (int s = 0; s < 2; ++s) accP = mfma32(pack_acc(acc, s), ldperm(VT + vcol * 40, 16 * s, hh), accP);
                }
                __builtin_amdgcn_sched_barrier(0);
                {
                    f32x16 acc;
#pragma unroll
                    for (int r = 0; r < 16; ++r) acc[r] = 0.f;
#pragma unroll
                    for (int s = 0; s < 4; ++s) acc = mfma32(*(const LAS bf16x8*)(KhT + l31 * 72 + 16 * s + 8 * hh), *(const LAS bf16x8*)(RhT + l31 * 72 + 16 * s + 8 * hh), acc);
#pragma unroll
                    for (int r = 0; r < 16; ++r) acc[r] = (crow(r, hh) <= l31) ? acc[r] : 0.f;
#pragma unroll
                    for (int s = 0; s < 2; ++s) accY = mfma32(pack_acc(acc, s), ldperm(VT + vcol * 40, 16 * s, hh), accY);
                }
                __builtin_amdgcn_sched_barrier(0);
                {
#pragma unroll
                    for (int r = 0; r < 16; ++r) accBb[r] = 0.f;
#pragma unroll
                    for (int s = 0; s < 4; ++s) accBb = mfma32(*(const LAS bf16x8*)(BhT + l31 * 72 + 16 * s + 8 * hh), *(const LAS bf16x8*)(RhT + l31 * 72 + 16 * s + 8 * hh), accBb);
#pragma unroll
                    for (int r = 0; r < 16; ++r) accBb[r] = (crow(r, hh) <= l31) ? -accBb[r] : 0.f;
                }
                f32x16 accC;
#pragma unroll
                for (int r = 0; r < 16; ++r) accC[r] = 0.f;
#pragma unroll
                for (int s = 0; s < 2; ++s) accC = mfma32(ldperm(TT + l31 * 40, 16 * s, hh), pack_acc(accP, s), accC);
#pragma unroll
                for (int s = 0; s < 2; ++s) accY = mfma32(pack_acc(accBb, s), pack_acc(accC, s), accY);
#pragma unroll
                for (int s = 0; s < 2; ++s) { const bf16x8 vb_ = *(const LAS bf16x8*)(VT + vcol * 40 + 16 * s + 8 * hh); const bf16x8 cb_ = pack_acc(accC, s);
                    ST0 = mfma32(*(const LAS bf16x8*)(Kh + l31 * 40 + 16 * s + 8 * hh), vb_, ST0);
                    ST1 = mfma32(*(const LAS bf16x8*)(Kh + (32 + l31) * 40 + 16 * s + 8 * hh), vb_, ST1);
                    ST0 = mfma32(ldperm(nBh + l31 * 40, 16 * s, hh), cb_, ST0);
                    ST1 = mfma32(ldperm(nBh + (32 + l31) * 40, 16 * s, hh), cb_, ST1); }
#pragma unroll
                for (int r = 0; r < 16; ++r) { ST0[r] *= GL[crow(r, hh)]; ST1[r] *= GL[32 + crow(r, hh)]; }
#pragma unroll
                for (int r = 0; r < 16; ++r) { const int i = crow(r, hh), t = dir ? (tbase + 31 - i) : (tbase + i);
                    YR[(size_t)tok_row(b, seg, t) * 256 + hd * 64 + vcol] = (bf16)f2bf(accY[r]); }
            }
        } else if (wave == 2) {
            if (n + 1 >= 0 && n + 1 < nchT) {
                LAS uchar* sp = SET0 + ((n + 1) & 1) * SETSZ;
                LAS bf16* BhT = (LAS bf16*)sp + 32 * 72; LAS bf16* KkT = BhT + 32 * 72; LAS bf16* TT = (LAS bf16*)(sp + 4 * 4608 + 3 * 5120 + 256);
                f32x16 P, PT, Tm, TTm;
#pragma unroll
                for (int r = 0; r < 16; ++r) { P[r] = 0.f; PT[r] = 0.f; }
#pragma unroll
                for (int s = 0; s < 4; ++s) { const bf16x8 bh_ = *(const LAS bf16x8*)(BhT + l31 * 72 + 16 * s + 8 * hh), kk_ = *(const LAS bf16x8*)(KkT + l31 * 72 + 16 * s + 8 * hh);
                    P = mfma32(bh_, kk_, P); PT = mfma32(kk_, bh_, PT); }
#pragma unroll
                for (int r = 0; r < 16; ++r) { const int j = crow(r, hh);
                    P[r] = (j < l31) ? P[r] : 0.f; PT[r] = (j > l31) ? PT[r] : 0.f;
                    const float idv = (j == l31) ? 1.f : 0.f; Tm[r] = idv - P[r]; TTm[r] = idv - PT[r]; }
#pragma unroll
                for (int it = 0; it < 4; ++it) {
                    const bf16x8 p0 = pack_acc(P, 0), p1 = pack_acc(P, 1), q0 = pack_acc(PT, 0), q1 = pack_acc(PT, 1);
                    f32x16 P2, P2T;
#pragma unroll
                    for (int r = 0; r < 16; ++r) { P2[r] = 0.f; P2T[r] = 0.f; }
                    P2 = mfma32(q0, p0, P2); P2 = mfma32(q1, p1, P2);
                    if (it < 3) { P2T = mfma32(p0, q0, P2T); P2T = mfma32(p1, q1, P2T); }
                    const bf16x8 u0 = pack_acc(TTm, 0), u1 = pack_acc(TTm, 1);
                    const bf16x8 a0 = pack_acc(P2, 0), a1 = pack_acc(P2, 1);
                    Tm = mfma32(u0, a0, Tm); Tm = mfma32(u1, a1, Tm);
                    if (it < 3) { TTm = mfma32(a0, u0, TTm); TTm = mfma32(a1, u1, TTm); }
                    P = P2; PT = P2T;
                }
#pragma unroll
                for (int r = 0; r < 16; ++r) TT[l31 * 40 + crow(r, hh)] = (bf16)f2bf(Tm[r]);
            }
        } else if (wave >= 4) {
            if (n + 2 < nchT) {
                const int w4 = wave - 4;
                const LAS bf16* LwB = (const LAS bf16*)(RAW0 + ((n + 2) & 1) * RAWSZ + 13056);
                f32x16 acc;
#pragma unroll
                for (int r = 0; r < 16; ++r) acc[r] = 0.f;
                const int ko = (w4 >> 1) * 32;
                acc = mfma32(*(const LAS bf16x8*)(LwB + l31 * 72 + ko + 8 * hh), lf0, acc);
                acc = mfma32(*(const LAS bf16x8*)(LwB + l31 * 72 + ko + 16 + 8 * hh), lf1, acc);
                LAS float* dst = (w4 >> 1) ? AL : WL;
#pragma unroll
                for (int r = 0; r < 16; ++r) dst[crow(r, hh) * 64 + 32 * (w4 & 1) + l31] = acc[r];
            }
        }
        lds_barrier();
        const bool pv = n + 2 < nchT;
        const int pi = tid >> 4, c4 = (ln_ & 15) * 4, pli = dir ? (31 - pi) : pi, pjr = dir ? (32 - pi) : (pi + 1);
        f32x4 lwi = {0.f, 0.f, 0.f, 0.f}, cuml = lwi;
        if (pv) {
            const f32x4 wl4 = *(const LAS f32x4*)(WL + pli * 64 + c4) + *(const LAS f32x4*)(CST + c4);
#pragma unroll
            for (int e = 0; e < 4; ++e) { const float xneg = -wl4[e]; const float sp = fmaxf(xneg, 0.f) + 0.69314718056f * __builtin_amdgcn_logf(1.0f + fexp(-fabsf(xneg))); lwi[e] = -fexp(-sp - 0.5f); }
            cuml = lwi;
#pragma unroll
            for (int e = 0; e < 4; ++e) { float y = __shfl_up(cuml[e], 16); if (ln_ >= 16) cuml[e] += y; }
#pragma unroll
            for (int e = 0; e < 4; ++e) { float y = __shfl_up(cuml[e], 32); if (ln_ >= 32) cuml[e] += y; }
            if (ln_ >= 48) *(LAS f32x4*)(Alw + wave * 64 + c4) = cuml;
        }
        lds_barrier();
        if (pv) {
            LAS uchar* sp = SET0 + (n & 1) * SETSZ;
            LAS bf16* KhT = (LAS bf16*)sp; LAS bf16* BhT = KhT + 32 * 72; LAS bf16* KkT = BhT + 32 * 72; LAS bf16* RhT = KkT + 32 * 72;
            LAS bf16* Kh = RhT + 32 * 72; LAS bf16* nBh = Kh + 64 * 40; LAS bf16* VT = nBh + 64 * 40; LAS float* GL = (LAS float*)(VT + 64 * 40);
            const LAS bf16* Raw = (const LAS bf16*)(RAW0 + (n & 1) * RAWSZ);
            f32x4 cum = cuml;
#pragma unroll
            for (int w2 = 0; w2 < 7; ++w2) { const f32x4 x = *(const LAS f32x4*)(Alw + w2 * 64 + c4); if (w2 < wave) cum = cum + x; }
            const f32x4 cpv = cum - lwi;
            float rr[4], kv[4], vv[4];
            { const f32x4 br = *(const LAS f32x4*)(CST + 13 * 64 + c4), bk = *(const LAS f32x4*)(CST + 14 * 64 + c4), bv = *(const LAS f32x4*)(CST + 15 * 64 + c4);
#pragma unroll
              for (int e = 0; e < 4; ++e) { rr[e] = br[e]; kv[e] = bk[e]; vv[e] = bv[e]; } }
#pragma unroll
            for (int tap = 0; tap < 3; ++tap) {
                const LAS bf16* rp = Raw + (pjr - 1 + tap) * 192 + c4;
                const v2u xr = *(const LAS v2u*)rp, xk = *(const LAS v2u*)(rp + 64), xv = *(const LAS v2u*)(rp + 128);
                const f32x4 wr = *(const LAS f32x4*)(CST + (4 + tap) * 64 + c4), wk = *(const LAS f32x4*)(CST + (7 + tap) * 64 + c4), wv = *(const LAS f32x4*)(CST + (10 + tap) * 64 + c4);
                rr[0] += wr[0] * bflo(xr.x); rr[1] += wr[1] * bfhi(xr.x); rr[2] += wr[2] * bflo(xr.y); rr[3] += wr[3] * bfhi(xr.y);
                kv[0] += wk[0] * bflo(xk.x); kv[1] += wk[1] * bfhi(xk.x); kv[2] += wk[2] * bflo(xk.y); kv[3] += wk[3] * bfhi(xk.y);
                vv[0] += wv[0] * bflo(xv.x); vv[1] += wv[1] * bfhi(xv.x); vv[2] += wv[2] * bflo(xv.y); vv[3] += wv[3] * bfhi(xv.y);
            }
            const f32x4 kkc4 = *(const LAS f32x4*)(CST + 2 * 64 + c4), kac4 = *(const LAS f32x4*)(CST + 3 * 64 + c4);
            const f32x4 al4 = *(const LAS f32x4*)(AL + pli * 64 + c4) + *(const LAS f32x4*)(CST + 64 + c4);
            float kx[4]; float ss = 0.f;
#pragma unroll
            for (int e = 0; e < 4; ++e) { kx[e] = kv[e] * kkc4[e]; ss += kx[e] * kx[e]; }
            ss = sum16(ss);
            const float rn = __builtin_amdgcn_rcpf(fmaxf(__builtin_amdgcn_sqrtf(ss), 1e-12f));
            float kh[4], bh[4], kk_[4], rh[4];
#pragma unroll
            for (int e = 0; e < 4; ++e) { const float av = __builtin_amdgcn_rcpf(1.0f + fexp(-al4[e])), kn = kx[e] * rn, en = fexp(-cum[e]), ep = fexp(cum[e]), epv = fexp(cpv[e]);
                kh[e] = kv[e] * (1.0f + (av - 1.0f) * kac4[e]) * en; bh[e] = kn * av * en; kk_[e] = kn * epv; rh[e] = rr[e] * ep; }
            v2u o;
            o.x = pk2(kh[0], kh[1]); o.y = pk2(kh[2], kh[3]); *(LAS v2u*)(KhT + pi * 72 + c4) = o;
            o.x = pk2(bh[0], bh[1]); o.y = pk2(bh[2], bh[3]); *(LAS v2u*)(BhT + pi * 72 + c4) = o;
            o.x = pk2(kk_[0], kk_[1]); o.y = pk2(kk_[2], kk_[3]); *(LAS v2u*)(KkT + pi * 72 + c4) = o;
            o.x = pk2(rh[0], rh[1]); o.y = pk2(rh[2], rh[3]); *(LAS v2u*)(RhT + pi * 72 + c4) = o;
#pragma unroll
            for (int e = 0; e < 4; ++e) { Kh[(c4 + e) * 40 + pi] = (bf16)f2bf(kh[e]); nBh[(c4 + e) * 40 + pi] = (bf16)f2bf(-bh[e]); VT[(c4 + e) * 40 + pi] = (bf16)f2bf(vv[e]); }
            if (pi == 31) *(LAS f32x4*)(GL + c4) = (f32x4){fexp(cum[0]), fexp(cum[1]), fexp(cum[2]), fexp(cum[3])};
        }
        if (n + 3 < nchT) lstore((n + 3) & 1);
        lds_barrier();
    }
}

DI void mlstm_task(KArgs a, const Ctx& F, int l, int b, int hd) {
    const bf16* Z = (const bf16*)(a->ws + WS_ACT);
    const int tid = F.tid, lane = F.lane, wave = F.wave, dir = wave >> 2, w2 = wave & 3, tid2 = tid & 255, l31 = lane & 31, hh = lane >> 5;
    bf16* YM = (bf16*)(a->ws + WS_YM) + (size_t)dir * NROWS * 256;
    constexpr int HP = 72;
    constexpr int HALF_LDS = 67328;
    LAS uchar* base = F.lds + dir * HALF_LDS;
    LAS bf16* Qc = (LAS bf16*)base; LAS bf16* Kc = Qc + 64 * HP; LAS bf16* KTw = Kc + 64 * HP; LAS bf16* VT = KTw + 64 * HP; LAS bf16* Cb = VT + 64 * HP;
    LAS float* fv = (LAS float*)(base + 5 * 9216);
    LAS float* Vgv = fv; LAS float* VMr = fv + 64; LAS float* Vwi = fv + 128; LAS float* Vem = fv + 192; LAS float* Vwk = fv + 256; LAS float* Vn = fv + 320; LAS float* Vsc = fv + 384;
    LAS bf16* Rq = (LAS bf16*)(base + 47872);
    LAS float* Gt = (LAS float*)(base + 47872 + 16896);
    LAS float* Cw = Gt + 128;
    for (int i = tid2; i < 64 * HP; i += 256) Cb[i] = 0;
    if (tid2 < 64) Vn[tid2] = 0.f;
    if (tid2 == 0) { float one_ = 1.f, zero_ = 0.f; asm volatile("" : "+v"(one_), "+v"(zero_)); Vsc[0] = one_; Vsc[1] = zero_; }
    { const float* cw = a->in[I_MCW] + (size_t)l * 3 * 512; const float* cbp = a->in[I_MCB] + (size_t)l * 512;
      for (int i = tid2; i < 512; i += 256) { const int tap = i >> 7, cc = i & 127, col = (cc < 64) ? (hd * 64 + cc) : (256 + hd * 64 + cc - 64);
          Cw[i] = (tap < 3) ? cw[tap * 512 + col] : cbp[col]; } }
    f32x16 accC;
#pragma unroll
    for (int r = 0; r < 16; ++r) accC[r] = 0.f;
    const int eb = w2 >> 1, lb = w2 & 1;
    const float gbi = a->in[I_MGB][l * 16 + dir * 8 + hd], gbf = a->in[I_MGB][l * 16 + dir * 8 + 4 + hd];
    const int nchC = TC / 64, nchT = nchC + T / 64;
    v4u gq[5], gv[2]; unsigned gr0 = 0u, gr1 = 0u;
    unsigned zz_ = 0u; asm volatile("" : "+v"(zz_)); const v4u zero4 = {zz_, zz_, zz_, zz_};
    auto gload = [&](int gc) {
        const int seg = gc >= nchC, ch = seg ? gc - nchC : gc, len = seg ? T : TC;
        const int tbase = dir ? (len - 64 * (ch + 1)) : 64 * ch;
#pragma unroll
        for (int n = 0; n < 5; ++n) { const int cidx = tid2 + 256 * n; if (cidx < 1056) { const int row = cidx >> 4, cc = cidx & 15, t = tbase - 1 + row;
            gq[n] = (t >= 0 && t < len) ? *(const v4u*)(Z + (size_t)tok_row(b, seg, t) * ZP + ZMQK + (cc >> 3) * 256 + hd * 64 + (cc & 7) * 8) : zero4; } }
#pragma unroll
        for (int n = 0; n < 2; ++n) { const int cidx = tid2 + 256 * n, row = cidx >> 3, cc = cidx & 7; gv[n] = *(const v4u*)(Z + (size_t)tok_row(b, seg, tbase + row) * ZP + ZMV + hd * 64 + cc * 8); }
        if (tid2 < 64) { const bf16* zp = Z + (size_t)tok_row(b, seg, tbase + tid2) * ZP + ZMG + dir * 8 + hd; gr0 = zp[0]; gr1 = zp[4]; }
    };
    auto lstore = [&]() {
#pragma unroll
        for (int n = 0; n < 5; ++n) { const int cidx = tid2 + 256 * n; if (cidx < 1056) *(LAS v4u*)(Rq + (cidx >> 4) * 128 + (cidx & 15) * 8) = gq[n]; }
#pragma unroll
        for (int n = 0; n < 2; ++n) { const int cidx = tid2 + 256 * n, row = cidx >> 3, cc = cidx & 7;
            const int stp = dir ? (63 - row) : row; const unsigned w[4] = {gv[n].x, gv[n].y, gv[n].z, gv[n].w};
#pragma unroll
            for (int j = 0; j < 4; ++j) { VT[(cc * 8 + 2 * j) * HP + stp] = (bf16)(w[j] & 0xffffu); VT[(cc * 8 + 2 * j + 1) * HP + stp] = (bf16)(w[j] >> 16); } }
    };
    auto stage0 = [&]() {
        if (w2 == 0) {
            float li = bf2f(gr0) + gbi; const float fraw = bf2f(gr1) + gbf;
            float lf = fminf(fraw, 0.f) - log1pf(__expf(-fabsf(fraw)));
            if (dir) { li = __shfl(li, 63 - lane); lf = __shfl(lf, 63 - lane); }
            const float bc = wave_scan_sum(lf);
            const float g = li - bc; const float pm = wave_scan_max(g);
            const float mprev = Vsc[1];
            const float blast = __shfl(bc, 63);
            const float lw = blast - bc + li;
            const float mnew = fmaxf(blast + mprev, wave_max(lw));
            const float Mr = fmaxf(mprev, pm);
            Vgv[lane] = g; VMr[lane] = Mr; Vwi[lane] = __expf(mprev - Mr); Vem[lane] = __expf(-bc - Mr); Vwk[lane] = __expf(lw - mnew);
            if (lane == 0) { Vsc[0] = __expf(blast + mprev - mnew); Vsc[2] = mnew; }
        }
    };
    gload(0);
    __syncthreads();
    lstore(); stage0();
    __syncthreads();
    for (int gc = 0; gc < nchT; ++gc) {
        const int seg = gc >= nchC, ch = seg ? gc - nchC : gc, len = seg ? T : TC;
        const int tbase = dir ? (len - 64 * (ch + 1)) : 64 * ch;
        if (gc + 1 < nchT) gload(gc + 1);
#ifdef DBG_REP_M1
        for (int rp_ = 0; rp_ < 2; ++rp_)
#endif
        {
            const int i = tid2 >> 2, qq = tid2 & 3, jr = dir ? (64 - i) : (i + 1);
            const float wk_i = Vwk[i];
            float qv[16], kvv[16];
#pragma unroll
            for (int j = 0; j < 16; ++j) { qv[j] = Cw[384 + qq * 16 + j]; kvv[j] = Cw[384 + 64 + qq * 16 + j]; }
#pragma unroll
            for (int tap = 0; tap < 3; ++tap) {
                const LAS bf16* rp = Rq + (jr - 1 + tap) * 128 + qq * 16;
                const v4u q0 = *(const LAS v4u*)rp, q1 = *(const LAS v4u*)(rp + 8), k0 = *(const LAS v4u*)(rp + 64), k1 = *(const LAS v4u*)(rp + 72);
                const unsigned qw[8] = {q0.x, q0.y, q0.z, q0.w, q1.x, q1.y, q1.z, q1.w}, kw[8] = {k0.x, k0.y, k0.z, k0.w, k1.x, k1.y, k1.z, k1.w};
#pragma unroll
                for (int j = 0; j < 8; ++j) { qv[2 * j] += Cw[tap * 128 + qq * 16 + 2 * j] * bflo(qw[j]); qv[2 * j + 1] += Cw[tap * 128 + qq * 16 + 2 * j + 1] * bfhi(qw[j]);
                    kvv[2 * j] += Cw[tap * 128 + 64 + qq * 16 + 2 * j] * bflo(kw[j]); kvv[2 * j + 1] += Cw[tap * 128 + 64 + qq * 16 + 2 * j + 1] * bfhi(kw[j]); }
            }
#pragma unroll
            for (int j = 0; j < 16; ++j) { qv[j] = qv[j] * fsigmoid(qv[j]); kvv[j] = kvv[j] * fsigmoid(kvv[j]) * 0.125f; }
#pragma unroll
            for (int j = 0; j < 16; j += 2) { *(LAS unsigned*)(Qc + i * HP + qq * 16 + j) = pk2(qv[j], qv[j + 1]); *(LAS unsigned*)(Kc + i * HP + qq * 16 + j) = pk2(kvv[j], kvv[j + 1]); }
#pragma unroll
            for (int j = 0; j < 16; ++j) KTw[(qq * 16 + j) * HP + i] = (bf16)f2bf(kvv[j] * wk_i);
        }
        lds_barrier();
#ifdef DBG_REP_MA
        for (int rp_ = 0; rp_ < 2; ++rp_)
#endif
        {
            const int lidx = 32 * lb + l31;
            f32x16 accN, accI;
#pragma unroll
            for (int r = 0; r < 16; ++r) { accN[r] = 0.f; accI[r] = 0.f; }
            float dsum = 0.f;
            const float Mr = VMr[lidx];
#pragma unroll
            for (int sb = 0; sb < 2; ++sb) {
                if (sb <= lb) {
                    f32x16 sT;
#pragma unroll
                    for (int r = 0; r < 16; ++r) sT[r] = 0.f;
#pragma unroll
                    for (int s = 0; s < 4; ++s) {
                        const bf16x8 ka = *(const LAS bf16x8*)(Kc + (32 * sb + l31) * HP + 16 * s + 8 * hh);
                        const bf16x8 qb = *(const LAS bf16x8*)(Qc + lidx * HP + 16 * s + 8 * hh);
                        sT = mfma32(ka, qb, sT);
                    }
#pragma unroll
                    for (int g4 = 0; g4 < 4; ++g4) { const f32x4 gv4 = *(const LAS f32x4*)(Vgv + 32 * sb + 8 * g4 + 4 * hh);
#pragma unroll
                        for (int e = 0; e < 4; ++e) { const int r = 4 * g4 + e, sidx = 32 * sb + 8 * g4 + 4 * hh + e;
                            const float ex = fexp(fminf(gv4[e] - Mr, 0.f));
                            const float p = (sidx <= lidx) ? sT[r] * ex : 0.f; sT[r] = p; dsum += p; } }
#pragma unroll
                    for (int sp = 0; sp < 2; ++sp) {
                        const bf16x8 pf = pack8(sT[8 * sp + 0], sT[8 * sp + 1], sT[8 * sp + 2], sT[8 * sp + 3], sT[8 * sp + 4], sT[8 * sp + 5], sT[8 * sp + 6], sT[8 * sp + 7]);
                        const int ko = 32 * sb + 16 * sp + 4 * hh;
                        const bf16x4 a0 = *(const LAS bf16x4*)(VT + (32 * eb + l31) * HP + ko), a1 = *(const LAS bf16x4*)(VT + (32 * eb + l31) * HP + ko + 8);
                        accN = mfma32(__builtin_shufflevector(a0, a1, 0, 1, 2, 3, 4, 5, 6, 7), pf, accN);
                    }
                }
            }
#pragma unroll
            for (int s = 0; s < 4; ++s) {
                const bf16x8 ca = *(const LAS bf16x8*)(Cb + (32 * eb + l31) * HP + 16 * s + 8 * hh);
                const bf16x8 qb = *(const LAS bf16x8*)(Qc + lidx * HP + 16 * s + 8 * hh);
                accI = mfma32(ca, qb, accI);
            }
            dsum += __shfl_xor(dsum, 32);
            float nq = 0.f;
#pragma unroll
            for (int j = 0; j < 64; j += 8) { const v4u w = *(const LAS v4u*)(Qc + lidx * HP + j); const f32x4 n0 = *(const LAS f32x4*)(Vn + j), n1 = *(const LAS f32x4*)(Vn + j + 4);
                nq += (n0[0] * bflo(w.x) + n0[1] * bfhi(w.x)) + (n0[2] * bflo(w.y) + n0[3] * bfhi(w.y)) + (n1[0] * bflo(w.z) + n1[1] * bfhi(w.z)) + (n1[2] * bflo(w.w) + n1[3] * bfhi(w.w)); }
            const float wi = Vwi[lidx];
            const float den = dsum + wi * nq, hden = fmaxf(fabsf(den), Vem[lidx]), inv = 1.0f / hden;
            const int t = dir ? (tbase + 63 - lidx) : (tbase + lidx);
            bf16* op = YM + (size_t)tok_row(b, seg, t) * 256 + hd * 64 + 32 * eb;
#pragma unroll
            for (int gq_ = 0; gq_ < 4; ++gq_) {
                const float h0 = (accN[4 * gq_] + wi * accI[4 * gq_]) * inv, h1 = (accN[4 * gq_ + 1] + wi * accI[4 * gq_ + 1]) * inv, h2 = (accN[4 * gq_ + 2] + wi * accI[4 * gq_ + 2]) * inv, h3 = (accN[4 * gq_ + 3] + wi * accI[4 * gq_ + 3]) * inv;
                v2u o; o.x = pk2(h0, h1); o.y = pk2(h2, h3);
                *(v2u*)(op + 8 * gq_ + 4 * hh) = o;
            }
        }
        lds_barrier();
        {
            const float sc = Vsc[0];
#pragma unroll
            for (int r = 0; r < 16; ++r) accC[r] *= sc;
#pragma unroll
            for (int s = 0; s < 4; ++s) {
                const bf16x8 va = *(const LAS bf16x8*)(VT + (32 * eb + l31) * HP + 16 * s + 8 * hh);
                const bf16x8 kb = *(const LAS bf16x8*)(KTw + (32 * lb + l31) * HP + 16 * s + 8 * hh);
                accC = mfma32(va, kb, accC);
            }
#pragma unroll
            for (int r = 0; r < 16; ++r) Cb[(32 * eb + crow(r, hh)) * HP + 32 * lb + l31] = (bf16)f2bf(accC[r]);
            if (tid2 < 64) { float s = 0.f;
#pragma unroll
                for (int j = 0; j < 64; j += 8) { const v4u w = *(const LAS v4u*)(KTw + tid2 * HP + j); s += (bflo(w.x) + bfhi(w.x)) + (bflo(w.y) + bfhi(w.y)) + (bflo(w.z) + bfhi(w.z)) + (bflo(w.w) + bfhi(w.w)); }
                Vn[tid2] = sc * Vn[tid2] + s; }
            if (tid2 == 0) Vsc[1] = Vsc[2];
        }
        lds_barrier();
#ifdef DBG_REP_ML
        for (int rp_ = 0; rp_ < 2; ++rp_)
#endif
        if (gc + 1 < nchT) { lstore(); stage0(); }
        lds_barrier();
    }
}
DI float gelu_tanh(float x) { const float u = 0.7978845608028654f * (x + 0.044715f * x * x * x); const float e = __expf(2.0f * u); const float th = 1.0f - 2.0f / (e + 1.0f); return 0.5f * x * (1.0f + th); }
DI void unpack8(const v4u w, float (&o)[8]) { o[0] = bflo(w.x); o[1] = bfhi(w.x); o[2] = bflo(w.y); o[3] = bfhi(w.y); o[4] = bflo(w.z); o[5] = bfhi(w.z); o[6] = bflo(w.w); o[7] = bfhi(w.w); }
DI v4u pack8u(const float (&o)[8]) { v4u w; w.x = pk2(o[0], o[1]); w.y = pk2(o[2], o[3]); w.z = pk2(o[4], o[5]); w.w = pk2(o[6], o[7]); return w; }
constexpr int FIN_CST_OFF = 56320;
DI void fin_load_consts(KArgs a, const Ctx& F, int l) {
    LAS float* C = (LAS float*)(F.lds + FIN_CST_OFF);
    for (int i = F.tid; i < 4608; i += NTHR) {
        float v;
        if (i < 2304) v = a->in[I_RCW][(size_t)l * 2304 + i];
        else if (i < 3072) v = a->in[I_RCB][(size_t)l * 768 + (i - 2304)];
        else if (i < 3328) v = a->in[I_RRK][l * 256 + (i - 3072)];
        else if (i < 3584) v = a->in[I_RLNW][l * 256 + (i - 3328)];
        else if (i < 3840) v = a->in[I_RLNB][l * 256 + (i - 3584)];
        else if (i < 4096) v = a->in[I_MNORM][l * 256 + (i - 3840)];
        else if (i < 4352) v = a->in[I_S5D][l * 256 + (i - 4096)];
        else v = a->in[I_S5BGLU][l * 256 + (i - 4352)];
        C[i] = v;
    }
    __syncthreads();
}
DI void fin_tile(KArgs a, const Ctx& F, int l, int tile) {
    const LAS float* CT = (const LAS float*)(F.lds + FIN_CST_OFF);
    const bf16* Z = (const bf16*)(a->ws + WS_ACT); bf16* MO = (bf16*)(a->ws + WS_H);
    const bf16* YS = (const bf16*)(a->ws + WS_YS5); const bf16* YR = (const bf16*)(a->ws + WS_YR); const bf16* YM = (const bf16*)(a->ws + WS_YM);
    const bf16* WGLU = (const bf16*)(a->ws + WS_SMALLW + SW_GLU); const bf16* WGUP = (const bf16*)(a->ws + WS_SMALLW + SW_GUP);
    LAS bf16* Az = (LAS bf16*)F.lds;
    LAS bf16* Ag = (LAS bf16*)(F.lds + 16896);
    LAS float* Pr = (LAS float*)(F.lds + 16896 + 4608);
    int tl_ = F.tid; asm volatile("" : "+v"(tl_));
    const int tid = tl_, lane = tid & 63, wave = F.wave, row0 = tile * 32;
    const int i = tid >> 4, part = tid & 15, row = row0 + i;
    const size_t DS = (size_t)NROWS * 256;
    const bf16* zr = Z + (size_t)row * ZP;
    {
        const LAS float* dsk = CT + 4096 + part * 16;
#pragma unroll
        for (int j = 0; j < 2; ++j) { const int c0 = part * 16 + 8 * j; float y0[8], y1[8], u[8], z[8];
            unpack8(*(const v4u*)(YS + (size_t)row * 256 + c0), y0); unpack8(*(const v4u*)(YS + DS + (size_t)row * 256 + c0), y1); unpack8(*(const v4u*)(zr + ZS5 + c0), u);
#pragma unroll
            for (int e = 0; e < 8; ++e) z[e] = gelu_tanh(y0[e] + y1[e] + dsk[8 * j + e] * u[e]);
            *(LAS v4u*)(Az + i * 264 + c0) = pack8u(z); }
    }
    const int hq = part >> 2, c0 = hq * 64 + (part & 3) * 16;
    const bool lat = row < NLAT; const int t = lat ? (row & (T - 1)) : ((row - NLAT) & (TC - 1)); const int len = lat ? T : TC;
    {
        float y[16]; float s = 0.f;
#pragma unroll
        for (int j = 0; j < 2; ++j) { float y0[8], y1[8]; unpack8(*(const v4u*)(YM + (size_t)row * 256 + c0 + 8 * j), y0); unpack8(*(const v4u*)(YM + DS + (size_t)row * 256 + c0 + 8 * j), y1);
#pragma unroll
            for (int e = 0; e < 8; ++e) { y[8 * j + e] = y0[e] + y1[e]; s += y[8 * j + e]; } }
        s += __shfl_xor(s, 1); s += __shfl_xor(s, 2); const float mu = s * (1.0f / 64.0f); float q = 0.f;
#pragma unroll
        for (int j = 0; j < 16; ++j) { y[j] -= mu; q += y[j] * y[j]; }
        q += __shfl_xor(q, 1); q += __shfl_xor(q, 2); const float rstd = 1.0f / sqrtf(q * (1.0f / 64.0f) + 1e-6f);
        const LAS float* nw = CT + 3840 + c0;
#pragma unroll
        for (int j = 0; j < 2; ++j) { float o[8]; unpack8(*(const v4u*)(zr + ZMO + c0 + 8 * j), o);
#pragma unroll
            for (int e = 0; e < 8; ++e) o[e] = y[8 * j + e] * rstd * nw[8 * j + e] * fsigmoid(o[e]);
            *(v4u*)(MO + (size_t)row * D + 768 + c0 + 8 * j) = pack8u(o); }
    }
    {
        float y[16]; float s = 0.f;
#pragma unroll
        for (int j = 0; j < 2; ++j) { float y0[8], y1[8]; unpack8(*(const v4u*)(YR + (size_t)row * 256 + c0 + 8 * j), y0); unpack8(*(const v4u*)(YR + DS + (size_t)row * 256 + c0 + 8 * j), y1);
#pragma unroll
            for (int e = 0; e < 8; ++e) { y[8 * j + e] = y0[e] + y1[e]; s += y[8 * j + e]; } }
        s += __shfl_xor(s, 1); s += __shfl_xor(s, 2); const float mu = s * (1.0f / 64.0f); float q = 0.f;
#pragma unroll
        for (int j = 0; j < 16; ++j) { y[j] -= mu; q += y[j] * y[j]; }
        q += __shfl_xor(q, 1); q += __shfl_xor(q, 2); const float rstd = 1.0f / sqrtf(q * (1.0f / 64.0f) + 64e-5f);
        const LAS float* cw = CT; const LAS float* cbp = CT + 2304;
        const LAS float* rk = CT + 3072 + c0; const LAS float* lw = CT + 3328 + c0; const LAS float* lb = CT + 3584 + c0;
        float vv[16]; float bs = 0.f;
#pragma unroll
        for (int j = 0; j < 2; ++j) { const int c = c0 + 8 * j;
            float rr[8], kk[8], v[8], x[8];
#pragma unroll
            for (int e = 0; e < 8; ++e) { rr[e] = cbp[c + e]; kk[e] = cbp[256 + c + e]; v[e] = cbp[512 + c + e]; }
#pragma unroll
            for (int tap = 0; tap < 3; ++tap) { const int tt = t - 1 + tap;
                if (tt >= 0 && tt < len) { const bf16* zp = zr + (tap - 1) * ZP + ZRKV + c;
                    unpack8(*(const v4u*)zp, x);
#pragma unroll
                    for (int e = 0; e < 8; ++e) rr[e] += cw[tap * 768 + c + e] * x[e];
                    unpack8(*(const v4u*)(zp + 256), x);
#pragma unroll
                    for (int e = 0; e < 8; ++e) kk[e] += cw[tap * 768 + 256 + c + e] * x[e];
                    unpack8(*(const v4u*)(zp + 512), x);
#pragma unroll
                    for (int e = 0; e < 8; ++e) v[e] += cw[tap * 768 + 512 + c + e] * x[e]; } }
#pragma unroll
            for (int e = 0; e < 8; ++e) { bs += rr[e] * kk[e] * rk[8 * j + e]; vv[8 * j + e] = v[e]; } }
        bs += __shfl_xor(bs, 1); bs += __shfl_xor(bs, 2);
#pragma unroll
        for (int j = 0; j < 16; j += 4) *(LAS f32x4*)(Pr + i * 260 + c0 + j) = (f32x4){y[j] * rstd * lw[j] + lb[j] + bs * vv[j], y[j + 1] * rstd * lw[j + 1] + lb[j + 1] + bs * vv[j + 1], y[j + 2] * rstd * lw[j + 2] + lb[j + 2] + bs * vv[j + 2], y[j + 3] * rstd * lw[j + 3] + lb[j + 3] + bs * vv[j + 3]};
    }
    {
        const v2u gv = *(const v2u*)(zr + ZGD + part * 4);
        v2u o; o.x = pk2(fsigmoid(bflo(gv.x)), fsigmoid(bfhi(gv.x))); o.y = pk2(fsigmoid(bflo(gv.y)), fsigmoid(bfhi(gv.y)));
        *(LAS v2u*)(Ag + i * 72 + part * 4) = o;
    }
    __syncthreads();
    const int lr = lane & 15, kq = lane >> 4;
    {
        f32x4 acc[2][2];
        small_gemm<256, 2, 2, true>(Az, 264, WGLU, 32 * wave, acc, lane);
        const LAS float* bg = CT + 4352;
#pragma unroll
        for (int nb = 0; nb < 2; ++nb)
#pragma unroll
            for (int mb = 0; mb < 2; ++mb) { const int tk = 16 * mb + lr, n = 32 * wave + 16 * nb + 4 * kq; const f32x4 v = acc[nb][mb]; const f32x4 b4 = *(const LAS f32x4*)(bg + n);
                const v2u zz = *(const LAS v2u*)(Az + tk * 264 + n);
                const float o0 = bflo(zz.x) * fsigmoid(v.x + b4.x), o1 = bfhi(zz.x) * fsigmoid(v.y + b4.y), o2 = bflo(zz.y) * fsigmoid(v.z + b4.z), o3 = bfhi(zz.y) * fsigmoid(v.w + b4.w);
                v2u o; o.x = pk2(o0, o1); o.y = pk2(o2, o3);
                *(v2u*)(MO + (size_t)(row0 + tk) * D + n) = o; }
    }
    {
        f32x4 acc[2][2];
        small_gemm<64, 2, 2, true>(Ag, 72, WGUP, 32 * wave, acc, lane);
#pragma unroll
        for (int nb = 0; nb < 2; ++nb)
#pragma unroll
            for (int mb = 0; mb < 2; ++mb) { const int tk = 16 * mb + lr, n = 32 * wave + 16 * nb + 4 * kq; const f32x4 v = acc[nb][mb];
                const f32x4 pr = *(const LAS f32x4*)(Pr + tk * 260 + n);
                v2u o; o.x = pk2(pr.x * v.x, pr.y * v.y); o.y = pk2(pr.z * v.z, pr.w * v.w);
                *(v2u*)(MO + (size_t)(row0 + tk) * D + 512 + n) = o; }
    }
    __syncthreads();
}
#ifndef MK_SPLIT
#define MK_SPLIT 1
#endif
#ifdef USE_NOINLINE
#define NI static __device__ __noinline__
#else
#define NI static __device__ __forceinline__
#endif
extern __shared__ __attribute__((aligned(16))) unsigned char lds_raw[];
DI Ctx make_ctx(int wave0) {
    Ctx F; F.lds = (LAS uchar*)lds_raw; { int ln_ = __builtin_amdgcn_mbcnt_hi(~0u, __builtin_amdgcn_mbcnt_lo(~0u, 0u)); asm volatile("" : "+v"(ln_)); F.lane = ln_; } F.wave = wave0; F.tid = wave0 * 64 + F.lane;
    F.G = gridDim.x; { int bx = blockIdx.x; asm volatile("" : "+s"(bx)); F.vcu = (F.G % 8 == 0) ? (bx % 8) * (F.G / 8) + bx / 8 : bx; }
    return F;
}
NI void ph_prologue(KArgs a_, int wave0) { KArgs a = a_; asm volatile("" : "+s"(a)); const Ctx F = make_ctx(wave0); phase_prologue(a, F); __syncthreads(); }
NI void ph_norm(KArgs a_, int wave0, int l, int kind) { KArgs a = a_; asm volatile("" : "+s"(a));
    const Ctx F = make_ctx(wave0);
    float* modv = (float*)(a->ws + WS_MODV);
    const bool last = (l == DEPTH - 1);
    if (kind == 0) convert_weights(a, F, l, 0);
    if (kind == 1) convert_weights(a, F, l, 1);
    const int lY = (kind == 0) ? (l > 0 ? l - 1 : 0) : l;
    const int gi = (kind == 0 || kind == 3) ? 8 : (kind == 1 ? 2 : 5);
    const int pi = (kind == 0 || kind == 3) ? 2 : (kind == 1 ? 0 : 1);
    const float coef = (kind == 2) ? 1.0f : 0.5f;
    const int si = (kind == 0) ? 0 : (kind == 1 ? 3 : 6);
    const int ni = (kind == 0) ? 0 : (kind == 1 ? 1 : 2);
    const bool first = (kind == 0 && l == 0), hasY = !(kind == 0 && l == 0), hasH = (kind != 3), fin = (kind == 3);
    const int nrows = (kind == 3 || (kind == 2 && last)) ? NLAT : NROWS;
    norm_rows(a, F, first, hasY, hasH, fin, nrows, modv + (size_t)lY * 9 * MODW, gi, a->in[I_NPOST] + (lY * 3 + pi) * D, coef, modv + (size_t)l * 9 * MODW, si, a->in[I_NPRE] + (l * 3 + ni) * D);
    __syncthreads();
}
NI void ph_gemm_swiglu(KArgs a_, int wave0, int M) { KArgs a = a_; asm volatile("" : "+s"(a));
    const Ctx F = make_ctx(wave0);
    pg8::Gemm g{(const bf16*)(a->ws + WS_H), (const bf16*)(a->ws + WS_WGU), M, 2 * FF, D}; pg8::StaticOrder S; S.init(M, 2 * FF, F.G, (int)blockIdx.x);
    pg8::EpiSwiGLU E{(bf16*)(a->ws + WS_ACT), FF};
    pg8::gemm_phase<pg8::EpiSwiGLU, pg8::StaticOrder, PG8_ALIGN, PG8_SP2>(F.lds, g, S, E, F.tid);
}
NI void ph_gemm_store(KArgs a_, int wave0, int which, int M) { KArgs a = a_; asm volatile("" : "+s"(a));
    const Ctx F = make_ctx(wave0);
    const bf16* A = (const bf16*)(a->ws + (which == 0 ? WS_ACT : WS_H));
    const bf16* W = (const bf16*)(a->ws + (which == 0 ? WS_WDN : which == 1 ? WS_WIN : WS_WOUT));
    const int N = which == 1 ? ZPAD : D, K = which == 0 ? FF : D;
    const bool split_ctx = (which != 1) && (M == NROWS);
    const int Mg = split_ctx ? NLAT : M;
    pg8::Gemm g{A, W, Mg, N, K}; pg8::StaticOrder S; S.init(Mg, N, F.G, (int)blockIdx.x);
    pg8::EpiStore E{(bf16*)(a->ws + (which == 1 ? WS_ACT : WS_Y)), which == 1 ? ZP : D, which == 1 ? ZP : D};
    pg8::gemm_phase<pg8::EpiStore, pg8::StaticOrder, PG8_ALIGN, PG8_SP2>(F.lds, g, S, E, F.tid);
    if (split_ctx) { __syncthreads(); ctx_gemm_block(F, A, W, K, (bf16*)(a->ws + WS_Y)); }
}
NI void ph_mla_prep(KArgs a_, int wave0, int l) { KArgs a = a_; asm volatile("" : "+s"(a)); const Ctx F = make_ctx(wave0); for (int tile = F.vcu; tile < NROWS / 64; tile += F.G) mla_prep_tile(a, F, l, tile); }
NI void ph_rwkv(KArgs a_, int wave0, int l, int v) { KArgs a = a_; asm volatile("" : "+s"(a)); const Ctx F = make_ctx(wave0); rwkv_scan_task(a, F, l, v >> 3, (v >> 1) & 3, v & 1); }
NI void ph_mlstm(KArgs a_, int wave0, int l, int idx) { KArgs a = a_; asm volatile("" : "+s"(a)); const Ctx F = make_ctx(wave0); mlstm_task(a, F, l, idx >> 2, idx & 3); __syncthreads(); }
NI void ph_s5(KArgs a_, int wave0, int l, int wg) { KArgs a = a_; asm volatile("" : "+s"(a)); const Ctx F = make_ctx(wave0); const int tk = wg * 8 + F.wave; s5_scan_task(a, l, tk >> 5, (tk >> 4) & 1, tk & 15, (LAS bf16*)(F.lds + F.wave * 8704), F.lane); __syncthreads(); }
NI void ph_attn(KArgs a_, int wave0, int first, int stride) { KArgs a = a_; asm volatile("" : "+s"(a));
    const Ctx F = make_ctx(wave0);
    for (int u = first; u < 512 + 32; u += stride) {
        if (u < 512) { const int b = u >> 6, hd = (u >> 4) & 3, qb = u & 15; attn_unit(a, F, b, hd, b * T + qb * 256, NKEY); }
        else { const int c = u - 512, b = c >> 2, hd = c & 3; attn_unit(a, F, b, hd, NLAT + b * TC, TC); }
    }
}
NI void ph_fin(KArgs a_, int wave0, int l, int M) { KArgs a = a_; asm volatile("" : "+s"(a)); const Ctx F = make_ctx(wave0); fin_load_consts(a, F, l); for (int tile = F.vcu; tile < M / 32; tile += F.G) fin_tile(a, F, l, tile); }


#ifdef DBG_CUT
NI void ph_dump(KArgs a_, int wave0) { KArgs a = a_; asm volatile("" : "+s"(a)); const Ctx F = make_ctx(wave0);
    const float* X = (const float*)(a->ws + WS_X); const bf16* Z = (const bf16*)(a->ws + WS_ACT); const bf16* Q = (const bf16*)(a->ws + WS_Q); const bf16* Kf = (const bf16*)(a->ws + WS_K); const bf16* Vt = (const bf16*)(a->ws + WS_VT);
    const bf16* YS = (const bf16*)(a->ws + WS_YS5); const bf16* YR = (const bf16*)(a->ws + WS_YR); const bf16* YM = (const bf16*)(a->ws + WS_YM); const bf16* MO = (const bf16*)(a->ws + WS_H); const bf16* Y = (const bf16*)(a->ws + WS_Y);
    const size_t DS = (size_t)NROWS * 256;
    for (size_t i = (size_t)F.vcu * NTHR + F.tid; i < (size_t)NLAT * D; i += (size_t)F.G * NTHR) {
#ifdef DBG_CTX
        const size_t r = NLAT + ((i >> 10) % NCTX);
#else
        const size_t r = i >> 10;
#endif
        const int c = (int)(i & 1023); float v = 0.f;
        if (DBG_WHICH & 1) v += X[r * D + c];
        if (DBG_WHICH & 2) { v += bf2f(Z[r * ZP + c]) + bf2f(Z[r * ZP + 1024 + c]); if (c + 2048 < ZP) v += bf2f(Z[r * ZP + 2048 + c]); }
        if (DBG_WHICH & 4) { v += bf2f(Q[r * 384 + c % 384]) + bf2f(Kf[r * 384 + c % 384]) + bf2f(Vt[i % ((size_t)NB * 4 * 64 * NKEY)]); }
        if (DBG_WHICH & 256) v += bf2f(Q[r * 384 + c % 384]);
        if (DBG_WHICH & 512) v += bf2f(Kf[r * 384 + c % 384]);
        if (DBG_WHICH & 1024) v += bf2f(Vt[i % ((size_t)NB * 4 * 64 * NKEY)]);
        if (DBG_WHICH & 2048) { const float* rc = (const float*)(a->ws + WS_ROPE); const bf16* sw = (const bf16*)(a->ws + WS_SMALLW); v += rc[i % (T * 32)] + bf2f(sw[i % 245760]); }
        if (DBG_WHICH & 8) v += bf2f(YS[r * 256 + (c & 255)]) + bf2f(YS[DS + r * 256 + (c & 255)]);
        if (DBG_WHICH & 16) v += bf2f(YR[r * 256 + (c & 255)]) + bf2f(YR[DS + r * 256 + (c & 255)]);
        if (DBG_WHICH & 32) v += bf2f(YM[r * 256 + (c & 255)]) + bf2f(YM[DS + r * 256 + (c & 255)]);
        if (DBG_WHICH & 64) v += bf2f(MO[r * D + c]);
        if (DBG_WHICH & 128) v += bf2f(Y[r * D + c]);
        a->out[i] = v;
    }
}
#endif
#if !MK_SPLIT
#if defined(ONLY_PH)
#define PHON(k) ((k) == ONLY_PH)
#elif defined(NO_PH)
#define PHON(k) ((k) != NO_PH)
#else
#define PHON(k) true
#endif
#if defined(ONLY_ROLE)
#define ROLE(k) ((k) == ONLY_ROLE)
#elif defined(NO_ROLE)
#define ROLE(k) ((k) != NO_ROLE)
#else
#define ROLE(k) true
#endif
#ifdef DUP_ROLE
#ifndef DUP_N
#define DUP_N 2
#endif
#define NREPR(k) ((k) == DUP_ROLE ? DUP_N : 1)
#else
#define NREPR(k) 1
#endif
#ifdef DUP_PH
#define NREP(k) ((k) == DUP_PH ? 2 : 1)
#else
#define NREP(k) 1
#endif
constexpr int NPH = 2 + 12 * DEPTH;
__global__ void __launch_bounds__(NTHR, 2) hybrid_fwd(Args args_byval) {
    KArgs a = (KArgs)__builtin_amdgcn_kernarg_segment_ptr();
    LAS uchar* lds = (LAS uchar*)lds_raw;
    const int tid = threadIdx.x; const int wave0 = __builtin_amdgcn_readfirstlane(tid >> 6);
    volatile LAS unsigned* MISC = (volatile LAS unsigned*)(lds + MISC_OFF);
    for (int u = tid; u < (LDS_BYTES - LDSCTL_OFF) / 4; u += NTHR) ((LAS unsigned*)(lds + LDSCTL_OFF))[u] = 0u;
    __syncthreads();
    unsigned* ctl = (unsigned*)(a->ws + WS_CTL);
    const int use_bar = a->use_bar;
    XcdBarrier bar; bar.bar = ctl + CW_BAR; bar.x = 0; bar.st = nullptr;
    if (use_bar) bar = xcd_barrier_post(ctl + CW_BAR, MISC + 8, tid == 0);
    const int lo = a->ph_lo, hi = a->ph_hi;
    const int G = gridDim.x; const int vcu = (G % 8 == 0) ? ((int)blockIdx.x % 8) * (G / 8) + (int)blockIdx.x / 8 : (int)blockIdx.x;
#ifdef DBG_CUT
#define IN(k) (lo <= (k) && (k) < hi && (k) < DBG_CUT)
#else
#define IN(k) (lo <= (k) && (k) < hi)
#endif
#define SEAM(k) do { if (use_bar && IN(k) && IN((k) + 1)) { int ln_ = __builtin_amdgcn_mbcnt_hi(~0u, __builtin_amdgcn_mbcnt_lo(~0u, 0u)); asm volatile("" : "+v"(ln_)); xcd_barrier(bar, wave0 == 0 && ln_ == 0); } } while (0)
    if (PHON(100) && IN(0)) ph_prologue(a, wave0);
    SEAM(0);
#pragma unroll 1
    for (int l = 0; l < DEPTH; ++l) {
        const int P = 1 + 12 * l;
        const int Mtail = (l == DEPTH - 1) ? NLAT : NROWS;
        if (PHON(0) && IN(P + 0)) { ph_norm(a, wave0, l, 0);
#ifdef DUP_FIRSTNORM
            if (l == 0) for (int rr_ = 0; rr_ < DUP_FIRSTNORM; ++rr_) ph_norm(a, wave0, l, 0);
#endif
        }
        SEAM(P + 0);
        if (PHON(1) && IN(P + 1)) for (int rep_ = 0; rep_ < NREP(1); ++rep_) ph_gemm_swiglu(a, wave0, NROWS);
        SEAM(P + 1);
        if (PHON(2) && IN(P + 2)) for (int rep_ = 0; rep_ < NREP(2); ++rep_) ph_gemm_store(a, wave0, 0, NROWS);
        SEAM(P + 2);
        if (PHON(3) && IN(P + 3)) ph_norm(a, wave0, l, 1);
        SEAM(P + 3);
        if (PHON(4) && IN(P + 4)) for (int rep_ = 0; rep_ < NREP(4); ++rep_) ph_gemm_store(a, wave0, 1, NROWS);
        SEAM(P + 4);
        if (PHON(5) && IN(P + 5)) for (int rep_ = 0; rep_ < NREP(5); ++rep_) ph_mla_prep(a, wave0, l);
        SEAM(P + 5);
        if (PHON(6) && IN(P + 6) && G >= 256) for (int rep_ = 0; rep_ < NREP(6); ++rep_) {
            if (ROLE(0) && vcu < 64) { for (int rr_ = 0; rr_ < NREPR(0); ++rr_) ph_rwkv(a, wave0, l, vcu); }
            else if (ROLE(1) && vcu < 96) { for (int rr_ = 0; rr_ < NREPR(1); ++rr_) ph_mlstm(a, wave0, l, vcu - 64); }
            else if (ROLE(2) && vcu < 128) { for (int rr_ = 0; rr_ < NREPR(2); ++rr_) ph_s5(a, wave0, l, vcu - 96); }
            else if (ROLE(3)) { for (int rr_ = 0; rr_ < NREPR(3); ++rr_) ph_attn(a, wave0, vcu - 128, G - 128); }
        }
        SEAM(P + 6);
        if (PHON(7) && IN(P + 7)) for (int rep_ = 0; rep_ < NREP(7); ++rep_) ph_fin(a, wave0, l, Mtail);
        SEAM(P + 7);
        if (PHON(8) && IN(P + 8)) for (int rep_ = 0; rep_ < NREP(8); ++rep_) ph_gemm_store(a, wave0, 2, Mtail);
        SEAM(P + 8);
        if (PHON(9) && IN(P + 9)) ph_norm(a, wave0, l, 2);
        SEAM(P + 9);
        if (PHON(10) && IN(P + 10)) ph_gemm_swiglu(a, wave0, Mtail);
        SEAM(P + 10);
        if (PHON(11) && IN(P + 11)) ph_gemm_store(a, wave0, 0, Mtail);
        SEAM(P + 11);
    }
#ifdef DBG_CUT
    if (lo <= NPH - 1 && NPH - 1 < hi) ph_dump(a, wave0);
#else
    if (PHON(101) && IN(NPH - 1)) ph_norm(a, wave0, DEPTH - 1, 3);
#endif
#undef IN
#undef SEAM
}

#endif
#if MK_SPLIT
struct ArgsS { Args base; int kind, l, sub, M; };
typedef const __attribute__((address_space(4))) ArgsS* KArgsS;
template <int KIND>
__global__ void __launch_bounds__(NTHR, 2) phase_kernel(ArgsS args_byval) {
    KArgsS as = (KArgsS)__builtin_amdgcn_kernarg_segment_ptr();
    KArgs a = (KArgs)as;
    const int tid = threadIdx.x; const int wave0 = __builtin_amdgcn_readfirstlane(tid >> 6);
    const int l = as->l, sub = as->sub, M = as->M;
    const int G = gridDim.x; const int vcu = (G % 8 == 0) ? ((int)blockIdx.x % 8) * (G / 8) + (int)blockIdx.x / 8 : (int)blockIdx.x;
    if constexpr (KIND == 0) ph_prologue(a, wave0);
    if constexpr (KIND == 1) ph_norm(a, wave0, l, sub);
    if constexpr (KIND == 2) ph_gemm_swiglu(a, wave0, M);
    if constexpr (KIND == 3) ph_gemm_store(a, wave0, sub, M);
    if constexpr (KIND == 4) ph_mla_prep(a, wave0, l);
    if constexpr (KIND == 5) { if (vcu < 64) ph_rwkv(a, wave0, l, vcu); }
    if constexpr (KIND == 6) { if (vcu >= 64 && vcu < 96) ph_mlstm(a, wave0, l, vcu - 64); }
    if constexpr (KIND == 7) { if (vcu >= 96 && vcu < 128) ph_s5(a, wave0, l, vcu - 96); }
    if constexpr (KIND == 8) { if (vcu >= 128) ph_attn(a, wave0, vcu - 128, G - 128); }
    if constexpr (KIND == 9) ph_fin(a, wave0, l, M);
}
template <int KIND> static void launch_phase(int grid, hipStream_t stream, const Args& base, int l, int sub, int M) {
    static bool attr = false;
    if (!attr) { (void)hipFuncSetAttribute((const void*)phase_kernel<KIND>, hipFuncAttributeMaxDynamicSharedMemorySize, LDS_BYTES); attr = true; }
    ArgsS s{}; s.base = base; s.kind = KIND; s.l = l; s.sub = sub; s.M = M;
    hipLaunchKernelGGL(phase_kernel<KIND>, dim3(grid), dim3(NTHR), LDS_BYTES, stream, s);
}
static void launch_split(int grid, hipStream_t stream, const Args& a) {
    launch_phase<0>(grid, stream, a, 0, 0, 0);
    for (int l = 0; l < DEPTH; ++l) {
        const int Mtail = (l == DEPTH - 1) ? NLAT : NROWS;
        launch_phase<1>(grid, stream, a, l, 0, 0);
        launch_phase<2>(grid, stream, a, l, 0, NROWS);
        launch_phase<3>(grid, stream, a, l, 0, NROWS);
        launch_phase<1>(grid, stream, a, l, 1, 0);
        launch_phase<3>(grid, stream, a, l, 1, NROWS);
        launch_phase<4>(grid, stream, a, l, 0, 0);
        launch_phase<5>(grid, stream, a, l, 0, 0);
        launch_phase<6>(grid, stream, a, l, 0, 0);
        launch_phase<7>(grid, stream, a, l, 0, 0);
        launch_phase<8>(grid, stream, a, l, 0, 0);
        launch_phase<9>(grid, stream, a, l, 0, Mtail);
        launch_phase<3>(grid, stream, a, l, 2, Mtail);
        launch_phase<1>(grid, stream, a, l, 2, 0);
        launch_phase<2>(grid, stream, a, l, 0, Mtail);
        launch_phase<3>(grid, stream, a, l, 0, Mtail);
    }
    launch_phase<1>(grid, stream, a, DEPTH - 1, 3, 0);
}
#endif
extern "C" void kernel_launch(void* const* d_in, const int* in_sizes, int n_in, void* d_out, int out_size, void* d_ws, size_t ws_size, hipStream_t stream) {
    static int grid = 0;
    if (grid == 0) {
        if (n_in != 43 || out_size != NLAT * D || ws_size < WS_END) { fprintf(stderr, "kernel_launch: unexpected shapes: n_in %d out %d ws %zu (need %zu)\n", n_in, out_size, ws_size, (size_t)WS_END); grid = -1; return; }
        int dev = 0, cus = 0, per_cu = 0;
        if (hipGetDevice(&dev) != hipSuccess || hipDeviceGetAttribute(&cus, hipDeviceAttributeMultiprocessorCount, dev) != hipSuccess) { grid = -1; return; }
        if (false) { grid = -1; return; }
        (void)hipGetLastError();
        grid = cus;
    }
    if (grid < 0) return;
    (void)hipMemsetAsync((char*)d_ws + WS_CTL, 0, CTL_ZERO_BYTES, stream);
    Args a{};
    for (int i = 0; i < 43; ++i) a.in[i] = (const float*)d_in[i];
    a.out = (float*)d_out; a.ws = (unsigned char*)d_ws; a.pad = 0;
#if MK_SPLIT
    launch_split(grid, stream, a);
#else
    static bool attr1 = false; if (!attr1) { (void)hipFuncSetAttribute((const void*)hybrid_fwd, hipFuncAttributeMaxDynamicSharedMemorySize, LDS_BYTES); attr1 = true; }
    a.ph_lo = 0; a.ph_hi = NPH; a.use_bar = 1;
    hipLaunchKernelGGL(hybrid_fwd, dim3(grid), dim3(NTHR), LDS_BYTES, stream, a);
#endif
}
```

```cpp
#include <hip/hip_runtime.h>
#include <cstdio>
#include <cstdint>
#define MK_SPLIT 0
namespace pg8 {
#define PG8_LAS __attribute__((address_space(3)))
typedef unsigned short bf16_t;
typedef short bf16x8 __attribute__((ext_vector_type(8)));
typedef float f32x4 __attribute__((ext_vector_type(4)));
typedef unsigned u32x4 __attribute__((ext_vector_type(4)));
constexpr int BM = 256, BK = 64, HALF = 128, HTB = HALF * BK * 2  , STAGE_BYTES = 8 * HTB, NXCD = 8, WGM = 8;

__host__ __device__ __forceinline__ int lds_byte(int r, int c) { const int st = (r >> 4) * 2 + (c >> 5), rr = r & 15, cc = c & 31, ob = rr * 64 + cc * 2; return st * 1024 + (ob ^ (((ob >> 9) & 1) << 5)); }
__host__ __device__ __forceinline__ void stage_rc(int b, int& R, int& C) { const int st = b / 1024, sb = b % 1024, swz = sb ^ (((sb >> 9) & 1) << 5); R = (st >> 1) * 16 + swz / 64; C = (st & 1) * 32 + (swz % 64) / 2; }
__host__ __device__ __forceinline__ int perm32(int rho) { const int n = rho >> 4, i = rho & 15; return 8 * (i >> 2) + 4 * n + (i & 3); }

struct Unit { int pm, pn; };
struct Gemm { const bf16_t* A; const bf16_t* Bt; int M, N, K; };

struct StaticOrder {
    int nM, nN, nwg, G, c;
    __host__ __device__ void init(int M, int N, int G_, int c_) { nM = M / BM; nN = N / BM; nwg = nM * nN; G = G_; c = c_; }
    __host__ __device__ bool next(int i, Unit& u) const {
        const long L = (long)i * G + c; if (L >= nwg) return false;
        int wgid = (int)L; { const int q = nwg / NXCD, r = nwg % NXCD, xcd = wgid % NXCD, off = wgid / NXCD; wgid = (xcd < r ? xcd * (q + 1) : r * (q + 1) + (xcd - r) * q) + off; }
        const int nig = WGM * nN, gid = wgid / nig, fm = gid * WGM, gsz = (nM - fm) < WGM ? (nM - fm) : WGM;
        u.pm = fm + ((wgid % nig) % gsz); u.pn = (wgid % nig) / gsz; return true;
    }
    __device__ __forceinline__ void a_ready(const Unit&) const {}
    __device__ __forceinline__ void done(const Unit&) const {}
};

typedef __bf16 nbf16v2 __attribute__((ext_vector_type(2))); typedef float nf32v2 __attribute__((ext_vector_type(2)));
__device__ __forceinline__ unsigned cvt_pk_bf16(float lo, float hi) { const nf32v2 v = {lo, hi}; return __builtin_bit_cast(unsigned, __builtin_convertvector(v, nbf16v2)); }
struct EpiSwiGLU {
    static constexpr bool PERM = true, AFTER_DRAIN = false;
    bf16_t* O; int ldc;
    __device__ __forceinline__ void operator()(const f32x4 (&acc)[2][2][4][2], const Unit& u, int wr, int wc, int fr, int fq) const {
        const int row0 = u.pm * BM + wr * 64 + fr; const int col0 = u.pn * HALF + wc * 32 + 8 * fq;
#pragma unroll
        for (int ai = 0; ai < 2; ++ai)
#pragma unroll
            for (int m = 0; m < 4; ++m) { bf16_t* rowp = O + (size_t)(row0 + ai * HALF + m * 16) * ldc + col0;
                float o[8];
#pragma unroll
                for (int n = 0; n < 2; ++n)
#pragma unroll
                    for (int j = 0; j < 4; ++j) { const float g = acc[ai][0][m][n][j], up = acc[ai][1][m][n][j];
                        const float sg = __builtin_amdgcn_rcpf(1.0f + __builtin_amdgcn_exp2f(-1.44269504089f * g)); o[n * 4 + j] = g * sg * up; }
                u32x4 w; w.x = cvt_pk_bf16(o[0], o[1]); w.y = cvt_pk_bf16(o[2], o[3]); w.z = cvt_pk_bf16(o[4], o[5]); w.w = cvt_pk_bf16(o[6], o[7]);
                *(u32x4*)rowp = w; }
    }
};
struct EpiStore {
    static constexpr bool PERM = true, AFTER_DRAIN = false;
    bf16_t* O; int ldc; int ncols;
    __device__ __forceinline__ void operator()(const f32x4 (&acc)[2][2][4][2], const Unit& u, int wr, int wc, int fr, int fq) const {
        const int row0 = u.pm * BM + wr * 64 + fr; const int col0 = u.pn * BM + wc * 32 + 8 * fq;
#pragma unroll
        for (int ai = 0; ai < 2; ++ai)
#pragma unroll
            for (int m = 0; m < 4; ++m) { bf16_t* rowp = O + (size_t)(row0 + ai * HALF + m * 16) * ldc + col0;
#pragma unroll
                for (int bj = 0; bj < 2; ++bj) { if (col0 + bj * HALF < ncols) { const f32x4 v0 = acc[ai][bj][m][0], v1 = acc[ai][bj][m][1];
                    u32x4 w; w.x = cvt_pk_bf16(v0[0], v0[1]); w.y = cvt_pk_bf16(v0[2], v0[3]); w.z = cvt_pk_bf16(v1[0], v1[1]); w.w = cvt_pk_bf16(v1[2], v1[3]);
                    *(u32x4*)(rowp + bj * HALF) = w; } } }
    }
};
template <class Epi, class Sched, bool ALIGN_EPI = false, bool SP2 = false>
__device__ __forceinline__ void gemm_phase(PG8_LAS unsigned char* lds, const Gemm g, const Sched& S, const Epi& E, const int tid) {
    const int wid = __builtin_amdgcn_readfirstlane(tid >> 6), lane = tid & 63, wr = wid >> 2, wc = wid & 3, fr = lane & 15, fq = lane >> 4;
    const int K = g.K, nt = K / BK;
    unsigned voffA[2], voffB[2];
#pragma unroll
    for (int i = 0; i < 2; ++i) { int R, C; stage_rc(tid * 16 + i * 8192, R, C); const int Rb = Epi::PERM ? ((R & ~31) + perm32(R & 31)) : R;
        voffA[i] = (unsigned)(R * K + C) * 2u; voffB[i] = (unsigned)(Rb * K + C) * 2u; }
    const size_t kstep = (size_t)(BK * 2);
    const size_t hstep = (size_t)HALF * K * 2;
    const size_t tstep = 2 * hstep;
    const unsigned ldsw = (unsigned)wid * 1024u;
    const int aoff = lds_byte(wr * 64 + fr, fq * 8), boff = lds_byte(wc * 32 + fr, fq * 8);
#define PG8_SA(b, h) (((b) * 2 + (h)) * HTB)
#define PG8_SB(b, h) ((4 + (b) * 2 + (h)) * HTB)
#define PG8_STAGE(bufoff, gbase, voff) do { _Pragma("unroll") for (int _i = 0; _i < 2; ++_i) \
        __builtin_amdgcn_global_load_lds((const unsigned*)((const char*)(gbase) + (voff)[_i]), (PG8_LAS unsigned*)(lds + (bufoff) + ldsw + _i * 8192), 16, 0, 0); } while (0)
#define PG8_LDA(dst, b, h) do { _Pragma("unroll") for (int m = 0; m < 4; ++m) _Pragma("unroll") for (int k = 0; k < 2; ++k) dst[m][k] = *(const PG8_LAS bf16x8*)(lds + PG8_SA(b, h) + aoff + m * 2048 + k * 1024); } while (0)
#define PG8_LDB(dst, b, h) do { _Pragma("unroll") for (int n = 0; n < 2; ++n) _Pragma("unroll") for (int k = 0; k < 2; ++k) dst[n][k] = *(const PG8_LAS bf16x8*)(lds + PG8_SB(b, h) + boff + n * 2048 + k * 1024); } while (0)
#define PG8_MMA(ai, bj, At, Bt) do { __builtin_amdgcn_s_setprio(1); _Pragma("unroll") for (int m = 0; m < 4; ++m) _Pragma("unroll") for (int n = 0; n < 2; ++n) _Pragma("unroll") for (int k = 0; k < 2; ++k) \
        acc[ai][bj][m][n] = __builtin_amdgcn_mfma_f32_16x16x32_bf16(Bt[n][k], At[m][k], acc[ai][bj][m][n], 0, 0, 0); __builtin_amdgcn_s_setprio(0); } while (0)
#define PG8_WAIT_V(n) asm volatile("s_waitcnt vmcnt(" #n ")" ::: "memory")
#define PG8_WAIT_L(n) asm volatile("s_waitcnt lgkmcnt(" #n ")" ::: "memory")
#define PG8_BAR __builtin_amdgcn_s_barrier()
#define PG8_SCHED __builtin_amdgcn_sched_barrier(0)
    Unit cur, nxt; int ui = 0;
    if (!S.next(0, cur)) return;
    f32x4 acc[2][2][4][2];
#pragma unroll
    for (int a = 0; a < 2; ++a)
#pragma unroll
        for (int b = 0; b < 2; ++b)
#pragma unroll
            for (int m = 0; m < 4; ++m)
#pragma unroll
                for (int n = 0; n < 2; ++n) acc[a][b][m][n] = (f32x4){0.f, 0.f, 0.f, 0.f};
    bf16x8 At[4][2], B0[2][2], B1[2][2];
    const char* cA = (const char*)g.A + (size_t)cur.pm * tstep; const char* cB = (const char*)g.Bt + (size_t)cur.pn * tstep;
    S.a_ready(cur);
    if constexpr (SP2) {
        PG8_STAGE(PG8_SB(0, 0), cB, voffB); PG8_STAGE(PG8_SB(0, 1), cB + hstep, voffB); PG8_STAGE(PG8_SA(0, 0), cA, voffA); PG8_STAGE(PG8_SA(0, 1), cA + hstep, voffA);
        if (wr == 1) PG8_BAR;
        PG8_WAIT_V(2); PG8_BAR;
        PG8_STAGE(PG8_SB(1, 0), cB + kstep, voffB); PG8_STAGE(PG8_SA(1, 0), cA + kstep, voffA); PG8_STAGE(PG8_SB(1, 1), cB + hstep + kstep, voffB);
        PG8_WAIT_V(6); PG8_BAR;
    } else {
        PG8_STAGE(PG8_SB(0, 0), cB, voffB); PG8_STAGE(PG8_SA(0, 0), cA, voffA); PG8_STAGE(PG8_SB(0, 1), cB + hstep, voffB); PG8_STAGE(PG8_SA(0, 1), cA + hstep, voffA);
        if (wr == 1) PG8_BAR;
        PG8_WAIT_V(4); PG8_BAR;
        PG8_STAGE(PG8_SB(1, 0), cB + kstep, voffB); PG8_STAGE(PG8_SA(1, 0), cA + kstep, voffA); PG8_STAGE(PG8_SB(1, 1), cB + hstep + kstep, voffB);
        PG8_WAIT_V(6); PG8_BAR;
    }
    for (;;) {
        const bool has_next = S.next(ui + 1, nxt);
        const char* nA = has_next ? (const char*)g.A + (size_t)nxt.pm * tstep : cA; const char* nB = has_next ? (const char*)g.Bt + (size_t)nxt.pn * tstep : cB;
        for (int t = 0; t < nt; t += 2) {
            const bool last = (t == nt - 2);
            const char* a1 = cA + (size_t)(t + 1) * kstep;
            const char* a2 = last ? nA : cA + (size_t)(t + 2) * kstep; const char* b2 = last ? nB : cB + (size_t)(t + 2) * kstep;
            const char* a3 = a2 + kstep; const char* b3 = b2 + kstep;
            if (last && has_next) S.a_ready(nxt);
            if constexpr (SP2) {
            PG8_LDB(B0, 0, 0); PG8_LDB(B1, 0, 1); PG8_SCHED; PG8_LDA(At, 0, 0); PG8_STAGE(PG8_SA(1, 1), a1 + hstep, voffA);
            PG8_WAIT_V(8); PG8_WAIT_L(0); PG8_BAR; PG8_MMA(0, 0, At, B0); PG8_MMA(0, 1, At, B1); PG8_BAR; PG8_SCHED;
            PG8_LDA(At, 0, 1); PG8_STAGE(PG8_SB(0, 0), b2, voffB); PG8_STAGE(PG8_SB(0, 1), b2 + hstep, voffB); PG8_STAGE(PG8_SA(0, 0), a2, voffA);
            PG8_WAIT_V(8); PG8_WAIT_L(0); PG8_BAR; PG8_MMA(1, 0, At, B0); PG8_MMA(1, 1, At, B1); PG8_BAR; PG8_SCHED;
            PG8_LDB(B0, 1, 0); PG8_LDB(B1, 1, 1); PG8_SCHED; PG8_LDA(At, 1, 0); PG8_STAGE(PG8_SA(0, 1), a2 + hstep, voffA);
            PG8_WAIT_V(8); PG8_WAIT_L(0); PG8_BAR; PG8_MMA(0, 0, At, B0); PG8_MMA(0, 1, At, B1); PG8_BAR; PG8_SCHED;
            PG8_LDA(At, 1, 1); PG8_STAGE(PG8_SB(1, 0), b3, voffB); PG8_STAGE(PG8_SB(1, 1), b3 + hstep, voffB); PG8_STAGE(PG8_SA(1, 0), a3, voffA);
            PG8_WAIT_V(8); PG8_WAIT_L(0); PG8_BAR; PG8_MMA(1, 0, At, B0); PG8_MMA(1, 1, At, B1); PG8_BAR; PG8_SCHED;
            } else {
            PG8_LDB(B0, 0, 0); PG8_SCHED; PG8_LDA(At, 0, 0); PG8_STAGE(PG8_SA(1, 1), a1 + hstep, voffA);
            PG8_WAIT_L(8); PG8_BAR; PG8_WAIT_L(0); PG8_MMA(0, 0, At, B0); PG8_BAR; PG8_SCHED;
            PG8_LDB(B1, 0, 1); PG8_STAGE(PG8_SB(0, 0), b2, voffB);
            PG8_BAR; PG8_WAIT_L(0); PG8_MMA(0, 1, At, B1); PG8_BAR;
            PG8_LDA(At, 0, 1); PG8_STAGE(PG8_SA(0, 0), a2, voffA);
            PG8_BAR; PG8_WAIT_L(0); PG8_MMA(1, 0, At, B0); PG8_BAR; PG8_SCHED;
            PG8_STAGE(PG8_SB(0, 1), b2 + hstep, voffB);
            PG8_WAIT_V(6); PG8_BAR; PG8_MMA(1, 1, At, B1); PG8_BAR;
            PG8_LDB(B0, 1, 0); PG8_SCHED; PG8_LDA(At, 1, 0); PG8_STAGE(PG8_SA(0, 1), a2 + hstep, voffA);
            PG8_WAIT_L(8); PG8_BAR; PG8_WAIT_L(0); PG8_MMA(0, 0, At, B0); PG8_BAR; PG8_SCHED;
            PG8_LDB(B1, 1, 1); PG8_STAGE(PG8_SB(1, 0), b3, voffB);
            PG8_BAR; PG8_WAIT_L(0); PG8_MMA(0, 1, At, B1); PG8_BAR;
            PG8_LDA(At, 1, 1); PG8_STAGE(PG8_SA(1, 0), a3, voffA);
            PG8_BAR; PG8_WAIT_L(0); PG8_MMA(1, 0, At, B0); PG8_BAR; PG8_SCHED;
            PG8_STAGE(PG8_SB(1, 1), b3 + hstep, voffB);
            PG8_WAIT_V(6); PG8_BAR; PG8_MMA(1, 1, At, B1); PG8_BAR;
            }
        }
        if constexpr (ALIGN_EPI) { if (wr == 0) PG8_BAR; }
        if constexpr (!Epi::AFTER_DRAIN) { E(acc, cur, wr, wc, fr, fq); S.done(cur); }
        if (!has_next) break;
#pragma unroll
        for (int a = 0; a < 2; ++a)
#pragma unroll
            for (int b = 0; b < 2; ++b)
#pragma unroll
                for (int m = 0; m < 4; ++m)
#pragma unroll
                    for (int n = 0; n < 2; ++n) acc[a][b][m][n] = (f32x4){0.f, 0.f, 0.f, 0.f};
        cur = nxt; cA = nA; cB = nB; ++ui;
        if constexpr (ALIGN_EPI) { if (wr == 1) PG8_BAR; }
    }
    PG8_WAIT_V(0);
    if constexpr (!ALIGN_EPI) { if (wr == 0) PG8_BAR; }
    PG8_BAR;
    if constexpr (Epi::AFTER_DRAIN) { E.fused(acc, cur, wr, wc, fr, fq, lds, wid, lane); S.done(cur); }
#undef PG8_SA
#undef PG8_SB
#undef PG8_STAGE
#undef PG8_LDA
#undef PG8_LDB
#undef PG8_MMA
#undef PG8_WAIT_V
#undef PG8_WAIT_L
#undef PG8_BAR
#undef PG8_SCHED
}
}
#define PG8_SP2 true
#define PG8_ALIGN true

constexpr int NWAVES = 8, NTHR = 512;
constexpr int D = 1024, NB = 8, T = 4096, TC = 256, DEPTH = 4, FF = 2816, ZP = 2608, ZPAD = 2816;
constexpr int NLAT = NB * T, NCTX = NB * TC, NROWS = NLAT + NCTX;
constexpr int MODW = 9 * D;
constexpr int NKEY = TC + T;
constexpr float NORM_EPS = 1e-6f;
constexpr int ZS5 = 0, ZCQ = 256, ZCKV = 512, ZKR = 640, ZRKV = 672, ZWD = 1440, ZAD = 1472, ZGD = 1504, ZMQK = 1568, ZMV = 2080, ZMO = 2336, ZMG = 2592;

constexpr size_t MiB = 1u << 20;
constexpr size_t WS_CTL = 0, CTL_ZERO_BYTES = 1 * MiB;
constexpr size_t WS_MODV = 1 * MiB;
constexpr size_t WS_ROPE = 3 * MiB;
constexpr size_t WS_SMALLW = 4 * MiB;
constexpr size_t SW_UQ = 0, SW_UKV = 196608, SW_GLU = 327680, SW_GUP = 458752;
constexpr size_t WS_WGU = 6 * MiB, WS_WDN = 17 * MiB, WS_WIN = 23 * MiB, WS_WOUT = 29 * MiB;
constexpr size_t WS_X = 31 * MiB;
constexpr size_t WS_Y = 167 * MiB;
constexpr size_t WS_Q = WS_Y, WS_K = WS_Y + (size_t)NROWS * 384 * 2, WS_VT = WS_K + (size_t)NROWS * 384 * 2;
constexpr size_t WS_H = 235 * MiB;
constexpr size_t WS_ACT = 303 * MiB;
constexpr size_t WS_YS5 = 490 * MiB, WS_YR = 524 * MiB, WS_YM = 558 * MiB, WS_END = 592 * MiB;
static_assert(WS_VT + (size_t)NB * 4 * 64 * NKEY * 2 <= WS_H, "qkv overlay");
static_assert(WS_WGU + (size_t)5632 * 1024 * 2 <= WS_WDN && WS_WDN + (size_t)1024 * 2816 * 2 <= WS_WIN && WS_WIN + (size_t)2816 * 1024 * 2 <= WS_WOUT && WS_WOUT + 2 * MiB <= WS_X, "weights");
static_assert(WS_X + (size_t)NROWS * D * 4 <= WS_Y && WS_Y + (size_t)NROWS * D * 2 <= WS_H && WS_H + (size_t)NROWS * D * 2 <= WS_ACT && WS_ACT + (size_t)NROWS * ZPAD * 2 <= WS_YS5, "map");
static_assert(WS_YS5 + (size_t)2 * NROWS * 256 * 2 <= WS_YR && WS_YM + (size_t)2 * NROWS * 256 * 2 <= WS_END, "map2");
constexpr int CW_BAR = 4096;

constexpr int RING_BYTES = 131072, LDS_BYTES = 147456, LDSCTL_OFF = LDS_BYTES - 512, MISC_OFF = LDSCTL_OFF + 320;

#define GAS __attribute__((address_space(1)))
#define LAS __attribute__((address_space(3)))
typedef unsigned short bf16;
typedef unsigned char uchar;
typedef unsigned v4u __attribute__((ext_vector_type(4)));
typedef unsigned v2u __attribute__((ext_vector_type(2)));
typedef float f32x4 __attribute__((ext_vector_type(4)));
typedef float f32x16 __attribute__((ext_vector_type(16)));
typedef short bf16x8 __attribute__((ext_vector_type(8)));
typedef short bf16x4 __attribute__((ext_vector_type(4)));
#define DI __device__ __forceinline__
DI unsigned f2bf(float f) { unsigned u = __builtin_bit_cast(unsigned, f); return (u + 0x7fffu + ((u >> 16) & 1u)) >> 16; }
DI unsigned pk2(float lo, float hi) { return pg8::cvt_pk_bf16(lo, hi); }
DI float bf2f(unsigned b) { return __builtin_bit_cast(float, b << 16); }
DI float bflo(unsigned w) { return __builtin_bit_cast(float, w << 16); }
DI float bfhi(unsigned w) { return __builtin_bit_cast(float, w & 0xffff0000u); }
template <int CTRL> DI float dpp_f(float x) { return __builtin_bit_cast(float, __builtin_amdgcn_update_dpp(0, __builtin_bit_cast(int, x), CTRL, 0xf, 0xf, true)); }
DI float sum8(float x) { x += dpp_f<0xB1>(x); x += dpp_f<0x4E>(x); x += dpp_f<0x141>(x); return x; }
DI float sum16(float x) { x = sum8(x); x += dpp_f<0x140>(x); return x; }
template <int CTRL, int RM> DI float dpp_z(float x) { return __builtin_bit_cast(float, __builtin_amdgcn_update_dpp(0, __builtin_bit_cast(int, x), CTRL, RM, 0xf, true)); }
template <int CTRL, int RM> DI float dpp_o(float old, float x) { return __builtin_bit_cast(float, __builtin_amdgcn_update_dpp(__builtin_bit_cast(int, old), __builtin_bit_cast(int, x), CTRL, RM, 0xf, false)); }
DI float wave_scan_sum(float x) {
    x += dpp_z<0x111, 0xf>(x); x += dpp_z<0x112, 0xf>(x); x += dpp_z<0x114, 0xf>(x); x += dpp_z<0x118, 0xf>(x);
    x += dpp_z<0x142, 0xa>(x); x += dpp_z<0x143, 0xc>(x); return x;
}
DI float wave_scan_max(float x) {
    const float ninf = -3.0e38f;
    x = fmaxf(x, dpp_o<0x111, 0xf>(ninf, x)); x = fmaxf(x, dpp_o<0x112, 0xf>(ninf, x)); x = fmaxf(x, dpp_o<0x114, 0xf>(ninf, x)); x = fmaxf(x, dpp_o<0x118, 0xf>(ninf, x));
    x = fmaxf(x, dpp_o<0x142, 0xa>(ninf, x)); x = fmaxf(x, dpp_o<0x143, 0xc>(ninf, x)); return x;
}
DI float wave_sum(float v) { v = sum16(v); v += __shfl_xor(v, 16); v += __shfl_xor(v, 32); return v; }
DI float wave_max(float v) {
#pragma unroll
    for (int o = 1; o < 64; o <<= 1) v = fmaxf(v, __shfl_xor(v, o));
    return v;
}
DI void lds_barrier() { asm volatile("s_waitcnt lgkmcnt(0)" ::: "memory"); __builtin_amdgcn_s_barrier(); asm volatile("" ::: "memory"); }
DI float fexp(float x) { return __builtin_amdgcn_exp2f(x * 1.44269504089f); }
DI float fsigmoid(float x) { return __builtin_amdgcn_rcpf(1.0f + fexp(-x)); }
DI f32x16 mfma32(bf16x8 a, bf16x8 b, f32x16 c) { return __builtin_amdgcn_mfma_f32_32x32x16_bf16(a, b, c, 0, 0, 0); }
DI f32x4 mfma16(bf16x8 a, bf16x8 b, f32x4 c) { return __builtin_amdgcn_mfma_f32_16x16x32_bf16(a, b, c, 0, 0, 0); }
DI int crow(int r, int h) { return (r & 3) + 8 * (r >> 2) + 4 * h; }
DI bf16x8 pack8(float a0, float a1, float a2, float a3, float a4, float a5, float a6, float a7) {
    typedef __bf16 nb8 __attribute__((ext_vector_type(8))); typedef float nf8 __attribute__((ext_vector_type(8)));
    const nf8 v = {a0, a1, a2, a3, a4, a5, a6, a7}; return __builtin_bit_cast(bf16x8, __builtin_convertvector(v, nb8));
}
DI void my_sincosf(float x, float& s, float& c) {
    const float k = __builtin_rintf(x * 0.63661977236758134f);
    float r = __builtin_fmaf(-k, 1.5703125f, x); r = __builtin_fmaf(-k, 4.837512969970703125e-4f, r); r = __builtin_fmaf(-k, 7.54978995489188216e-8f, r);
    const float r2 = r * r;
    const float ps = r + r * r2 * (-1.6666654611e-1f + r2 * (8.3321608736e-3f + r2 * (-1.9515295891e-4f)));
    const float pc = 1.0f - 0.5f * r2 + r2 * r2 * (4.166664568298827e-2f + r2 * (-1.388731625493765e-3f + r2 * 2.443315711809948e-5f));
    const int q = ((int)k) & 3;
    const float ss = (q & 1) ? pc : ps, cc = (q & 1) ? ps : pc;
    s = (q & 2) ? -ss : ss; c = ((q + 1) & 2) ? -cc : cc;
}

#define XB_TMO      128
#define XB_XCNT(j)  (256  + 64 * (j))
#define XB_XSUB(j)  (1280 + 64 * (j))
#define XB_XGEN(j)  (2304 + 64 * (j))
#define XB_TOP      3328
#define XB_TOPGEN   3392
#define XCD_BAR_WORDS 3456
#define XB_SPIN_CAP (1u << 22)
DI unsigned xb_ld(unsigned* p)              { return __hip_atomic_load(p, __ATOMIC_RELAXED, __HIP_MEMORY_SCOPE_AGENT); }
DI unsigned xb_add(unsigned* p, unsigned v) { return __hip_atomic_fetch_add(p, v, __ATOMIC_RELAXED, __HIP_MEMORY_SCOPE_AGENT); }
DI unsigned xb_xcc_id() { return (unsigned)__builtin_amdgcn_s_getreg((3 << 11) | 20) & 0xFu; }
#define XB_SPIN(cond, bar) do { unsigned _sp = 0; while (cond) { __builtin_amdgcn_s_sleep(1); \
    if ((++_sp & 255u) == 0u) { if (xb_ld(&(bar)[XB_TMO])) break; if (_sp > XB_SPIN_CAP) { atomicAdd(&(bar)[XB_TMO], 1u); break; } } } } while (0)
struct XcdBarrier { unsigned* bar; unsigned x; volatile LAS unsigned* st; };
DI XcdBarrier xcd_barrier_post(unsigned* bar, volatile LAS unsigned* st, bool t0) {
    XcdBarrier b; b.bar = bar; b.x = xb_xcc_id(); b.st = st;
    if (t0) (void)xb_add(&bar[XB_XCNT(b.x)], 1u);
    return b;
}
DI void xcd_barrier_complete(unsigned* bar, unsigned x, unsigned& nloc, unsigned& nx) {
    const unsigned G = gridDim.x * gridDim.y * gridDim.z;
    unsigned sum, cnt, mine, sp = 0u;
    for (;;) {
        sum = 0u; cnt = 0u; mine = 0u;
#pragma unroll
        for (unsigned j = 0; j < 16; ++j) { const unsigned c = xb_ld(&bar[XB_XCNT(j)]); sum += c; cnt += (c > 0u) ? 1u : 0u; mine = (j == x) ? c : mine; }
        if (sum == G) break;
        __builtin_amdgcn_s_sleep(1);
        if ((++sp & 255u) == 0u) { if (xb_ld(&bar[XB_TMO])) break; if (sp > XB_SPIN_CAP) { atomicAdd(&bar[XB_TMO], 1u); break; } }
    }
    nloc = mine > 0u ? mine : 1u; nx = cnt > 0u ? cnt : 1u;
}
DI void xcd_barrier(const XcdBarrier& b, bool t0) {
    asm volatile("s_waitcnt vmcnt(0)" ::: "memory");
    __syncthreads();
    if (t0) {
        unsigned* bar = b.bar;
        __builtin_amdgcn_s_waitcnt(0);
        unsigned nloc = b.st[0], nx = b.st[1];
        if (nloc == 0u) { xcd_barrier_complete(bar, b.x, nloc, nx); b.st[0] = nloc; b.st[1] = nx; }
        const unsigned old = xb_add(&bar[XB_XSUB(b.x)], 1u);
        const unsigned gen = old / nloc;
        if (old + 1u == (gen + 1u) * nloc) {
            __builtin_amdgcn_fence(__ATOMIC_RELEASE, "agent");
            asm volatile("s_waitcnt vmcnt(0)" ::: "memory");
            const unsigned og = xb_add(&bar[XB_TOP], 1u);
            const unsigned tg = og / nx;
            if (og + 1u == (tg + 1u) * nx) xb_add(&bar[XB_TOPGEN], 1u);
            else XB_SPIN(xb_ld(&bar[XB_TOPGEN]) == tg, bar);
            __builtin_amdgcn_fence(__ATOMIC_ACQUIRE, "agent");
            xb_add(&bar[XB_XGEN(b.x)], 1u);
            asm volatile("s_waitcnt vmcnt(0)" ::: "memory");
        } else {
            XB_SPIN(xb_ld(&bar[XB_XGEN(b.x)]) == gen, bar);
            __builtin_amdgcn_fence(__ATOMIC_ACQUIRE, "agent");
            asm volatile("s_waitcnt vmcnt(0)" ::: "memory");
        }
    }
    __syncthreads();
}

struct Args { const float* in[43]; float* out; unsigned char* ws; int ph_lo, ph_hi, use_bar, pad; };
typedef const __attribute__((address_space(4))) Args* KArgs;
enum { I_X = 0, I_C, I_CTX, I_CCTX, I_WADA, I_BADA, I_NPRE, I_NPOST, I_WG, I_WU, I_WD, I_WIN, I_WOUT, I_S5LRE, I_S5LIM, I_S5DT, I_S5BRE, I_S5BIM, I_S5CRE, I_S5CIM, I_S5D, I_S5GLU, I_S5BGLU,
       I_MQN, I_MKVN, I_MUQ, I_MUKV, I_RCW, I_RCB, I_RW0, I_RWUP, I_RA0, I_RAUP, I_RGUP, I_RKK, I_RKA, I_RRK, I_RLNW, I_RLNB, I_MCW, I_MCB, I_MGB, I_MNORM };

struct Ctx {
    LAS uchar* lds; int tid, lane, wave, vcu, G;
};
DI int tok_row(int b, int seg, int t) { return seg ? b * T + t : NLAT + b * TC + t; }
DI void phase_prologue(KArgs a, const Ctx& F) {
    LAS float* sc = (LAS float*)F.lds;
    LAS float* red = (LAS float*)(F.lds + 40960);
    const float* c = a->in[I_C]; const float* cc = a->in[I_CCTX];
    for (int i = F.tid; i < 9 * D; i += NTHR) { const float v = (i < 8 * D) ? c[i] : cc[i - 8 * D]; sc[i] = v * fsigmoid(v); }
    __syncthreads();
    const float* wada = a->in[I_WADA]; const float* bada = a->in[I_BADA];
    float* modv = (float*)(a->ws + WS_MODV);
    for (int task = F.vcu; task < DEPTH * 144; task += F.G) {
        const int l = task / 144, nb = task % 144, n = nb * 64 + F.lane;
        const float* wp = wada + ((size_t)l * D + F.wave * 128) * MODW + n;
        float acc[9];
#pragma unroll
        for (int m = 0; m < 9; ++m) acc[m] = 0.f;
#pragma unroll 8
        for (int k = 0; k < 128; ++k) { const float w = wp[(size_t)k * MODW];
#pragma unroll
            for (int m = 0; m < 9; ++m) acc[m] += sc[m * D + F.wave * 128 + k] * w; }
#pragma unroll
        for (int m = 0; m < 9; ++m) red[(F.wave * 9 + m) * 64 + F.lane] = acc[m];
        __syncthreads();
        for (int i = F.tid; i < 576; i += NTHR) { const int m = i >> 6, ln = i & 63; float s = 0.f;
#pragma unroll
            for (int w = 0; w < 8; ++w) s += red[(w * 9 + m) * 64 + ln];
            modv[((size_t)l * 9 + m) * MODW + nb * 64 + ln] = s + bada[l * MODW + nb * 64 + ln]; }
        __syncthreads();
    }
    float* rc = (float*)(a->ws + WS_ROPE); float* rs = rc + T * 16;
    for (int i = F.vcu * NTHR + F.tid; i < T * 16; i += F.G * NTHR) {
        const int t = i >> 4, f = i & 15, pos = f < 8 ? (t >> 6) : (t & 63), fi = f & 7;
        const float invf = (fi == 0) ? 1.0f : (fi == 1) ? 0.31622776601683794f : (fi == 2) ? 0.1f : (fi == 3) ? 0.031622776601683794f : (fi == 4) ? 0.01f : (fi == 5) ? 0.0031622776601683794f : (fi == 6) ? 0.001f : 0.00031622776601683794f;
        const float ang = (float)pos * invf; float s, co; my_sincosf(ang, s, co);
        rc[i] = co; rs[i] = s;
    }
}

DI void tr_item(const float* W, int K, int N, bf16* WT, int kb, int n0, int drow0, LAS float* scr, int lane) {
    const int k0 = 64 * kb, nn = n0 + (lane & 31);
#pragma unroll 8
    for (int i = 0; i < 32; ++i) { const int kk = 2 * i + (lane >> 5); scr[kk * 33 + (lane & 31)] = (nn < N) ? W[(size_t)(k0 + kk) * N + nn] : 0.f; }
    const int c = lane & 7;
#pragma unroll
    for (int j = 0; j < 4; ++j) { const int n = (lane >> 3) + 8 * j; const LAS float* s = scr + (8 * c) * 33 + n;
        v4u o; o.x = pk2(s[0 * 33], s[1 * 33]); o.y = pk2(s[2 * 33], s[3 * 33]); o.z = pk2(s[4 * 33], s[5 * 33]); o.w = pk2(s[6 * 33], s[7 * 33]);
        if (n0 + n < N) *(v4u*)(WT + (size_t)(drow0 + n) * K + k0 + 8 * c) = o; }
}
DI void convert_weights(KArgs a, const Ctx& F, int l, int set) {
    LAS float* scr = (LAS float*)(F.lds + F.wave * 8704);
    const int gw = F.vcu * NWAVES + F.wave, NGW = F.G * NWAVES;
    bf16* WGU = (bf16*)(a->ws + WS_WGU); bf16* WDN = (bf16*)(a->ws + WS_WDN); bf16* WIN = (bf16*)(a->ws + WS_WIN); bf16* WOUT = (bf16*)(a->ws + WS_WOUT);
    bf16* SW = (bf16*)(a->ws + WS_SMALLW);
    const int fl = l * 2 + set;
    const float* wg = a->in[I_WG] + (size_t)fl * D * FF; const float* wu = a->in[I_WU] + (size_t)fl * D * FF; const float* wd = a->in[I_WD] + (size_t)fl * FF * D;
    constexpr int I_G = 16 * 88, I_D = 44 * 32, I_IN = 16 * 82, I_O = 16 * 32, I_UQ = 4 * 12, I_UKV = 2 * 16, I_GLU = 4 * 8, I_GUP = 1 * 8;
    const int nitems = set == 0 ? (2 * I_G + I_D + I_IN + I_O + I_UQ + I_UKV + I_GLU + I_GUP) : (2 * I_G + I_D);
    for (int it = gw; it < nitems; it += NGW) {
        int r = it;
        if (r < I_G) { const int kb = r / 88, nb = r % 88, n0 = 32 * nb; tr_item(wg, D, FF, WGU, kb, n0, 256 * (n0 >> 7) + (n0 & 127), scr, F.lane); continue; } r -= I_G;
        if (r < I_G) { const int kb = r / 88, nb = r % 88, n0 = 32 * nb; tr_item(wu, D, FF, WGU, kb, n0, 256 * (n0 >> 7) + 128 + (n0 & 127), scr, F.lane); continue; } r -= I_G;
        if (r < I_D) { const int kb = r / 32, nb = r % 32; tr_item(wd, FF, D, WDN, kb, 32 * nb, 32 * nb, scr, F.lane); continue; } r -= I_D;
        if (r < I_IN) { const int kb = r / 82, nb = r % 82; tr_item(a->in[I_WIN] + (size_t)l * D * ZP, D, ZP, WIN, kb, 32 * nb, 32 * nb, scr, F.lane); continue; } r -= I_IN;
        if (r < I_O) { const int kb = r / 32, nb = r % 32; tr_item(a->in[I_WOUT] + (size_t)l * D * D, D, D, WOUT, kb, 32 * nb, 32 * nb, scr, F.lane); continue; } r -= I_O;
        if (r < I_UQ) { const int kb = r / 12, nb = r % 12; tr_item(a->in[I_MUQ] + (size_t)l * 256 * 384, 256, 384, (bf16*)((uchar*)SW + SW_UQ), kb, 32 * nb, 32 * nb, scr, F.lane); continue; } r -= I_UQ;
        if (r < I_UKV) { const int kb = r / 16, nb = r % 16; tr_item(a->in[I_MUKV] + (size_t)l * 128 * 512, 128, 512, (bf16*)((uchar*)SW + SW_UKV), kb, 32 * nb, 32 * nb, scr, F.lane); continue; } r -= I_UKV;
        if (r < I_GLU) { const int kb = r / 8, nb = r % 8; tr_item(a->in[I_S5GLU] + (size_t)l * 256 * 256, 256, 256, (bf16*)((uchar*)SW + SW_GLU), kb, 32 * nb, 32 * nb, scr, F.lane); continue; } r -= I_GLU;
        { const int nb = r; tr_item(a->in[I_RGUP] + (size_t)l * 64 * 256, 64, 256, (bf16*)((uchar*)SW + SW_GUP), 0, 32 * nb, 32 * nb, scr, F.lane); }
    }
    if (set == 0) {
        unsigned zz_ = 0u; asm volatile("" : "+v"(zz_)); v4u z = {zz_, zz_, zz_, zz_}; v4u* p = (v4u*)(WIN + (size_t)ZP * D);
        for (int i = F.vcu * NTHR + F.tid; i < (ZPAD - ZP) * D / 8; i += F.G * NTHR) p[i] = z;
    }
}

DI void norm_rows(KArgs a, const Ctx& F, bool p_first, bool p_hasY, bool p_hasH, bool p_final, int p_nrows, const float* p_modY, int p_gi, const float* p_pw, float p_coef, const float* p_modH, int p_si, const float* p_prew) {
    float* X = (float*)(a->ws + WS_X); const bf16* Y = (const bf16*)(a->ws + WS_Y); bf16* H = (bf16*)(a->ws + WS_H);
    const int gw = F.vcu * NWAVES + F.wave, NGW = F.G * NWAVES, lane = F.lane;
    const int rpw = (p_nrows + NGW - 1) / NGW, r0 = gw * rpw, r1 = (r0 + rpw < p_nrows) ? (r0 + rpw) : p_nrows;
    if (r0 >= r1) return;
    f32x4 cA[4], cB[4], cC[4];
    int cur_mr = -1;
    f32x4 vn[4]; v2u yn[4];
    auto issue = [&](int r) {
        const float* xs = p_first ? (r < NLAT ? a->in[I_X] + (size_t)r * D : a->in[I_CTX] + (size_t)(r - NLAT) * D) : X + (size_t)r * D;
#pragma unroll
        for (int j = 0; j < 4; ++j) vn[j] = *(const f32x4*)(xs + 4 * lane + 256 * j);
        if (p_hasY) {
#pragma unroll
            for (int j = 0; j < 4; ++j) yn[j] = *(const v2u*)(Y + (size_t)r * D + 4 * lane + 256 * j);
        }
    };
    issue(r0);
    for (int r = r0; r < r1; ++r) {
        const int mr = r < NLAT ? (r >> 12) : 8;
        if (mr != cur_mr) { cur_mr = mr;
            const float* g = p_modY + (size_t)mr * MODW + p_gi * D; const float* sh = p_modH + (size_t)mr * MODW + p_si * D; const float* scp = sh + D;
#pragma unroll
            for (int j = 0; j < 4; ++j) { const int o = 4 * lane + 256 * j;
                cA[j] = p_hasY ? (*(const f32x4*)(g + o) * p_coef) * *(const f32x4*)(p_pw + o) : (f32x4){0.f, 0.f, 0.f, 0.f};
                if (p_hasH) { cB[j] = *(const f32x4*)(p_prew + o) * (*(const f32x4*)(scp + o) + 1.0f); cC[j] = *(const f32x4*)(sh + o); } else { cB[j] = cA[j]; cC[j] = cA[j]; } } }
        f32x4 v[4]; v2u yw[4];
#pragma unroll
        for (int j = 0; j < 4; ++j) { v[j] = vn[j]; yw[j] = yn[j]; }
        if (r + 1 < r1) issue(r + 1);
        if (p_hasY) {
            f32x4 y[4]; float ss = 0.f;
#pragma unroll
            for (int j = 0; j < 4; ++j) { y[j] = (f32x4){bflo(yw[j].x), bfhi(yw[j].x), bflo(yw[j].y), bfhi(yw[j].y)};
                ss += (y[j].x * y[j].x + y[j].y * y[j].y) + (y[j].z * y[j].z + y[j].w * y[j].w); }
            const float rstd = __builtin_amdgcn_rsqf(wave_sum(ss) * (1.0f / D) + NORM_EPS);
#pragma unroll
            for (int j = 0; j < 4; ++j) v[j] = v[j] + cA[j] * (y[j] * rstd);
        }
        if (p_final) {
#pragma unroll
            for (int j = 0; j < 4; ++j) *(f32x4*)(a->out + (size_t)r * D + 4 * lane + 256 * j) = v[j];
        } else if (p_hasY || p_first) {
#pragma unroll
            for (int j = 0; j < 4; ++j) *(f32x4*)(X + (size_t)r * D + 4 * lane + 256 * j) = v[j];
        }
        if (p_hasH) {
            float ss = 0.f;
#pragma unroll
            for (int j = 0; j < 4; ++j) ss += (v[j].x * v[j].x + v[j].y * v[j].y) + (v[j].z * v[j].z + v[j].w * v[j].w);
            const float rstd = __builtin_amdgcn_rsqf(wave_sum(ss) * (1.0f / D) + NORM_EPS);
#pragma unroll
            for (int j = 0; j < 4; ++j) { const f32x4 h = (v[j] * rstd) * cB[j] + cC[j];
                v2u o; o.x = pk2(h.x, h.y); o.y = pk2(h.z, h.w); *(v2u*)(H + (size_t)r * D + 4 * lane + 256 * j) = o; }
        }
    }
}
template <int K, int NBK, int MBK, bool TRANS, bool ZERO = true>
DI void small_gemm(const LAS bf16* A, int apitch, const bf16* Wt, int n0w, f32x4 (&acc)[NBK][MBK], int lane, int wpitch = K) {
    const int lr = lane & 15, kq = lane >> 4;
    if (ZERO) {
#pragma unroll
        for (int nb = 0; nb < NBK; ++nb)
#pragma unroll
            for (int mb = 0; mb < MBK; ++mb) acc[nb][mb] = (f32x4){0.f, 0.f, 0.f, 0.f};
    }
#pragma unroll 2
    for (int s = 0; s < K / 32; ++s) {
        bf16x8 av[MBK];
#pragma unroll
        for (int mb = 0; mb < MBK; ++mb) av[mb] = *(const LAS bf16x8*)(A + (16 * mb + lr) * apitch + 32 * s + 8 * kq);
#pragma unroll
        for (int nb = 0; nb < NBK; ++nb) { const bf16x8 w = *(const bf16x8*)(Wt + (size_t)(n0w + 16 * nb + lr) * wpitch + 32 * s + 8 * kq);
#pragma unroll
            for (int mb = 0; mb < MBK; ++mb) acc[nb][mb] = TRANS ? mfma16(w, av[mb], acc[nb][mb]) : mfma16(av[mb], w, acc[nb][mb]); }
    }
}
DI void ctx_gemm_block(const Ctx& F, const bf16* A, const bf16* Wt, int K, bf16* Yo) {
    const int bi = F.vcu; if (bi >= 256) return;
    const int rb = bi >> 3, cb = bi & 7, row0 = NLAT + 64 * rb;
    const int tid = F.tid, lane = F.lane, wave = F.wave;
    LAS bf16* As = (LAS bf16*)F.lds;
    const int nch = K / 256;
    v4u g[4];
    auto gload = [&](int ch) {
#pragma unroll
        for (int j = 0; j < 4; ++j) { const int cidx = tid + 512 * j, r = cidx >> 5, cc = cidx & 31; g[j] = *(const v4u*)(A + (size_t)(row0 + r) * K + ch * 256 + cc * 8); }
    };
    auto lstore = [&](int buf) {
#pragma unroll
        for (int j = 0; j < 4; ++j) { const int cidx = tid + 512 * j, r = cidx >> 5, cc = cidx & 31; *(LAS v4u*)(As + buf * 64 * 264 + r * 264 + cc * 8) = g[j]; }
    };
    f32x4 acc[1][4];
#pragma unroll
    for (int mb = 0; mb < 4; ++mb) acc[0][mb] = (f32x4){0.f, 0.f, 0.f, 0.f};
    const int lr_ = lane & 15, kq_ = lane >> 4;
    const bf16* wrow = Wt + (size_t)(128 * cb + 16 * wave + lr_) * K + 8 * kq_;
    bf16x8 wc[8], wn[8];
#pragma unroll
    for (int s = 0; s < 8; ++s) wc[s] = *(const bf16x8*)(wrow + 32 * s);
    gload(0); lstore(0);
    __syncthreads();
    for (int ch = 0; ch < nch; ++ch) {
        if (ch + 1 < nch) { gload(ch + 1);
#pragma unroll
            for (int s = 0; s < 8; ++s) wn[s] = *(const bf16x8*)(wrow + (ch + 1) * 256 + 32 * s); }
        const LAS bf16* Ab = As + (ch & 1) * 64 * 264;
#pragma unroll
        for (int s = 0; s < 8; ++s) {
#pragma unroll
            for (int mb = 0; mb < 4; ++mb) acc[0][mb] = mfma16(wc[s], *(const LAS bf16x8*)(Ab + (16 * mb + lr_) * 264 + 32 * s + 8 * kq_), acc[0][mb]);
        }
        if (ch + 1 < nch) { lstore((ch + 1) & 1);
#pragma unroll
            for (int s = 0; s < 8; ++s) wc[s] = wn[s]; }
        __syncthreads();
    }
    const int lr = lane & 15, kq = lane >> 4;
#pragma unroll
    for (int mb = 0; mb < 4; ++mb) { const f32x4 v = acc[0][mb]; v2u o; o.x = pk2(v.x, v.y); o.y = pk2(v.z, v.w);
        *(v2u*)(Yo + (size_t)(row0 + 16 * mb + lr) * D + 128 * cb + 16 * wave + 4 * kq) = o; }
}

struct S5C { float ar, ai, fr, fi; };
static __device__ __noinline__ S5C s5_coef(const float* lre, const float* lim, float dt, int nn) {
    const float lr = lre[nn], li = lim[nn], x = lr * dt;
    const float em = x * (1.0f + x * (0.5f + x * (0.16666667f + x * (0.041666668f + x * 0.0083333338f))));
    float sh, ch; my_sincosf(0.5f * li * dt, sh, ch);
    const float cm1 = -2.0f * sh * sh, sn = 2.0f * sh * ch;
    const float arm1 = em * (1.0f + cm1) + cm1;
    S5C o; o.ai = (1.0f + em) * sn; o.ar = 1.0f + arm1;
    const float den = lr * lr + li * li;
    o.fr = (arm1 * lr + o.ai * li) / den; o.fi = (o.ai * lr - arm1 * li) / den;
    return o;
}
DI void s5_scan_task(KArgs a, int l, int b, int dir, int g, LAS bf16* wl  , int lane) {
    const bf16* Z = (const bf16*)(a->ws + WS_ACT); bf16* YS = (bf16*)(a->ws + WS_YS5) + (size_t)dir * NROWS * 256;
    const int pg = (l * 2 + dir) * 16 + g;
    const float* lre = a->in[I_S5LRE] + pg * 64; const float* lim = a->in[I_S5LIM] + pg * 64;
    const float dt = __expf(a->in[I_S5DT][pg]);
    const S5C c0_ = s5_coef(lre, lim, dt, lane); const float ar = c0_.ar, ai = c0_.ai;
    bf16x8 Bf[4];
    { const int hh = lane >> 5;
#pragma unroll
      for (int nblk = 0; nblk < 2; ++nblk) { const int nn = 32 * nblk + (lane & 31); const S5C cn_ = s5_coef(lre, lim, dt, nn); const float fr = cn_.fr, fi = cn_.fi;
        const float* bre = a->in[I_S5BRE] + ((size_t)pg * 64 + nn) * 16 + 8 * hh; const float* bim = a->in[I_S5BIM] + ((size_t)pg * 64 + nn) * 16 + 8 * hh;
        float re[8], im[8];
#pragma unroll
        for (int j = 0; j < 8; ++j) { re[j] = fr * bre[j] - fi * bim[j]; im[j] = fi * bre[j] + fr * bim[j]; }
        Bf[nblk] = pack8(re[0], re[1], re[2], re[3], re[4], re[5], re[6], re[7]); Bf[2 + nblk] = pack8(im[0], im[1], im[2], im[3], im[4], im[5], im[6], im[7]); } }
    bf16x8 Cf[4];
    { const int p = lane & 15, q = lane >> 4;
#pragma unroll
      for (int s = 0; s < 4; ++s) { const int kc = 32 * s + 8 * q; float cv[8];
        const float* src = (s < 2) ? a->in[I_S5CRE] + ((size_t)pg * 16 + p) * 64 + kc : a->in[I_S5CIM] + ((size_t)pg * 16 + p) * 64 + (kc - 64);
        const float sg = (s < 2) ? 1.f : -1.f;
#pragma unroll
        for (int j = 0; j < 8; ++j) cv[j] = sg * src[j];
        Cf[s] = pack8(cv[0], cv[1], cv[2], cv[3], cv[4], cv[5], cv[6], cv[7]); } }
    float sr = 0.f, si = 0.f;
    const int hh = lane >> 5, li5 = lane & 31, q = lane >> 4, t16 = lane & 15;
    const f32x16 zero16 = {0.f, 0.f, 0.f, 0.f, 0.f, 0.f, 0.f, 0.f, 0.f, 0.f, 0.f, 0.f, 0.f, 0.f, 0.f, 0.f};
    const int nchC = TC / 32, nchT = nchC + T / 32;
    auto afload = [&](int gc) -> bf16x8 {
        const int seg = gc >= nchC, ch = seg ? gc - nchC : gc, len = seg ? T : TC;
        const int sidx = 32 * ch + li5, tt = dir ? (len - 1 - sidx) : sidx;
        return *(const bf16x8*)(Z + (size_t)tok_row(b, seg, tt) * ZP + ZS5 + g * 16 + 8 * hh);
    };
    bf16x8 afn = afload(0);
    for (int gc = 0; gc < nchT; ++gc) {
        const int seg = gc >= nchC, ch = seg ? gc - nchC : gc, len = seg ? T : TC;
        {
            const bf16x8 af = afn;
            if (gc + 1 < nchT) afn = afload(gc + 1);
            f32x16 d1 = mfma32(af, Bf[0], zero16), d2 = mfma32(af, Bf[1], zero16), d3 = mfma32(af, Bf[2], zero16), d4 = mfma32(af, Bf[3], zero16);
            float xa[16], xb[16], ya[16], yb[16];
#pragma unroll
            for (int r = 0; r < 16; ++r) {
                auto r1 = __builtin_amdgcn_permlane32_swap(__float_as_uint(d1[r]), __float_as_uint(d2[r]), false, false); xa[r] = __uint_as_float(r1[0]); xb[r] = __uint_as_float(r1[1]);
                auto r2 = __builtin_amdgcn_permlane32_swap(__float_as_uint(d3[r]), __float_as_uint(d4[r]), false, false); ya[r] = __uint_as_float(r2[0]); yb[r] = __uint_as_float(r2[1]); }
#pragma unroll
            for (int i = 0; i < 32; ++i) {
                const int r = 4 * (i >> 3) + (i & 3); const bool hi = (i >> 2) & 1;
                const float xre = hi ? xb[r] : xa[r], xim = hi ? yb[r] : ya[r];
                const float nsr = ar * sr - ai * si + xre, nsi = ar * si + ai * sr + xim; sr = nsr; si = nsi;
                wl[i * 136 + lane] = (bf16)f2bf(sr); wl[i * 136 + 64 + lane] = (bf16)f2bf(si);
            }
#pragma unroll
            for (int tb = 0; tb < 2; ++tb) {
                f32x4 acc = {0.f, 0.f, 0.f, 0.f};
#pragma unroll
                for (int s = 0; s < 4; ++s) { const bf16x8 bfr = *(const LAS bf16x8*)(wl + (16 * tb + t16) * 136 + 32 * s + 8 * q); acc = mfma16(Cf[s], bfr, acc); }
                const int so = 32 * ch + 16 * tb + t16, to = dir ? (len - 1 - so) : so;
                v2u o; o.x = pk2(acc[0], acc[1]); o.y = pk2(acc[2], acc[3]);
                *(v2u*)(YS + (size_t)tok_row(b, seg, to) * 256 + g * 16 + 4 * q) = o;
            }
        }
    }
}

DI void mla_prep_tile(KArgs a, const Ctx& F, int l, int tile) {
    const bf16* Z = (const bf16*)(a->ws + WS_ACT);
    bf16* Q = (bf16*)(a->ws + WS_Q); bf16* Kf = (bf16*)(a->ws + WS_K); bf16* Vt = (bf16*)(a->ws + WS_VT);
    const bf16* WUQ = (const bf16*)(a->ws + WS_SMALLW + SW_UQ); const bf16* WUKV = (const bf16*)(a->ws + WS_SMALLW + SW_UKV);
    const float* rc = (const float*)(a->ws + WS_ROPE); const float* rs = rc + T * 16;
    LAS bf16* Aq = (LAS bf16*)F.lds;
    LAS bf16* Akv = (LAS bf16*)(F.lds + 64 * 264 * 2);
    const int row0 = tile * 64, tid = F.tid, lane = F.lane, wave = F.wave;
    const bool lat = row0 < NLAT;
    {
        const int i = tid >> 3, part = tid & 7, row = row0 + i;
        const bf16* zr = Z + (size_t)row * ZP;
        float q[32], kv[16]; float sq = 0.f, sk = 0.f;
#pragma unroll
        for (int j = 0; j < 4; ++j) { const v4u w = *(const v4u*)(zr + ZCQ + part * 32 + 8 * j);
            q[8 * j + 0] = bflo(w.x); q[8 * j + 1] = bfhi(w.x); q[8 * j + 2] = bflo(w.y); q[8 * j + 3] = bfhi(w.y); q[8 * j + 4] = bflo(w.z); q[8 * j + 5] = bfhi(w.z); q[8 * j + 6] = bflo(w.w); q[8 * j + 7] = bfhi(w.w); }
#pragma unroll
        for (int j = 0; j < 2; ++j) { const v4u w = *(const v4u*)(zr + ZCKV + part * 16 + 8 * j);
            kv[8 * j + 0] = bflo(w.x); kv[8 * j + 1] = bfhi(w.x); kv[8 * j + 2] = bflo(w.y); kv[8 * j + 3] = bfhi(w.y); kv[8 * j + 4] = bflo(w.z); kv[8 * j + 5] = bfhi(w.z); kv[8 * j + 6] = bflo(w.w); kv[8 * j + 7] = bfhi(w.w); }
#pragma unroll
        for (int j = 0; j < 32; ++j) sq += q[j] * q[j];
#pragma unroll
        for (int j = 0; j < 16; ++j) sk += kv[j] * kv[j];
        sq += __shfl_xor(sq, 1); sq += __shfl_xor(sq, 2); sq += __shfl_xor(sq, 4);
        sk += __shfl_xor(sk, 1); sk += __shfl_xor(sk, 2); sk += __shfl_xor(sk, 4);
        const float rq = 1.0f / sqrtf(sq * (1.0f / 256.0f) + NORM_EPS), rk = 1.0f / sqrtf(sk * (1.0f / 128.0f) + NORM_EPS);
        const float* qn = a->in[I_MQN] + l * 256 + part * 32; const float* kn = a->in[I_MKVN] + l * 128 + part * 16;
#pragma unroll
        for (int j = 0; j < 32; j += 2) *(LAS unsigned*)(Aq + i * 264 + part * 32 + j) = pk2(q[j] * rq * qn[j], q[j + 1] * rq * qn[j + 1]);
#pragma unroll
        for (int j = 0; j < 16; j += 2) *(LAS unsigned*)(Akv + i * 136 + part * 16 + j) = pk2(kv[j] * rk * kn[j], kv[j + 1] * rk * kn[j + 1]);
        if (part == 0) {
            float kr[32];
#pragma unroll
            for (int j = 0; j < 4; ++j) { const v4u w = *(const v4u*)(zr + ZKR + 8 * j);
                kr[8 * j + 0] = bflo(w.x); kr[8 * j + 1] = bfhi(w.x); kr[8 * j + 2] = bflo(w.y); kr[8 * j + 3] = bfhi(w.y); kr[8 * j + 4] = bflo(w.z); kr[8 * j + 5] = bfhi(w.z); kr[8 * j + 6] = bflo(w.w); kr[8 * j + 7] = bfhi(w.w); }
            float o[32];
            if (lat) { const int t = row & (T - 1);
#pragma unroll
                for (int hf = 0; hf < 2; ++hf)
#pragma unroll
                    for (int j = 0; j < 8; ++j) { const float c = rc[t * 16 + hf * 8 + j], s = rs[t * 16 + hf * 8 + j]; const float x0 = kr[hf * 16 + j], x1 = kr[hf * 16 + 8 + j];
                        o[hf * 16 + j] = x0 * c - x1 * s; o[hf * 16 + 8 + j] = x1 * c + x0 * s; }
            } else {
#pragma unroll
                for (int j = 0; j < 32; ++j) o[j] = kr[j];
            }
#pragma unroll
            for (int hd = 0; hd < 4; ++hd) { bf16* kp = Kf + (size_t)row * 384 + hd * 96 + 64;
#pragma unroll
                for (int j = 0; j < 4; ++j) { v4u w; w.x = pk2(o[8 * j], o[8 * j + 1]); w.y = pk2(o[8 * j + 2], o[8 * j + 3]); w.z = pk2(o[8 * j + 4], o[8 * j + 5]); w.w = pk2(o[8 * j + 6], o[8 * j + 7]); *(v4u*)(kp + 8 * j) = w; } }
        }
    }
    __syncthreads();
    const int lr = lane & 15, kq = lane >> 4;
    {
        f32x4 acc[3][4];
        small_gemm<256, 3, 4, true>(Aq, 264, WUQ, 48 * wave, acc, lane);
        const float qs = 0.10206207261596577f * 1.44269504089f;
#pragma unroll
        for (int nb = 0; nb < 3; ++nb) { const int blk = 3 * wave + nb, hb = blk % 6;
#pragma unroll
            for (int mb = 0; mb < 4; ++mb) { const int row = row0 + 16 * mb + lr; f32x4 v = acc[nb][mb];
                if (hb >= 4) {
                    f32x4 pv; pv.x = __shfl_xor(v.x, 32); pv.y = __shfl_xor(v.y, 32); pv.z = __shfl_xor(v.z, 32); pv.w = __shfl_xor(v.w, 32);
                    if (lat) { const int t = row & (T - 1); const int fb = (hb - 4) * 8 + 4 * (kq & 1);
                        const f32x4 c = *(const f32x4*)(rc + t * 16 + fb), s = *(const f32x4*)(rs + t * 16 + fb);
                        v = (kq < 2) ? (v * c - pv * s) : (v * c + pv * s); }
                }
                v = v * qs;
                v2u o; o.x = pk2(v.x, v.y); o.y = pk2(v.z, v.w);
                *(v2u*)(Q + (size_t)row * 384 + 16 * blk + 4 * kq) = o; } }
    }
    {
        const int hd = wave >> 1;
        if ((wave & 1) == 0) {
            f32x4 acc[4][4];
            small_gemm<128, 4, 4, true>(Akv, 136, WUKV, 64 * wave, acc, lane);
#pragma unroll
            for (int nb = 0; nb < 4; ++nb)
#pragma unroll
                for (int mb = 0; mb < 4; ++mb) { const int row = row0 + 16 * mb + lr; const f32x4 v = acc[nb][mb];
                    v2u o; o.x = pk2(v.x, v.y); o.y = pk2(v.z, v.w);
                    *(v2u*)(Kf + (size_t)row * 384 + hd * 96 + 16 * nb + 4 * kq) = o; }
        } else {
            f32x4 acc[4][4];
            small_gemm<128, 4, 4, false>(Akv, 136, WUKV, 64 * wave, acc, lane);
            const int bb = lat ? (row0 >> 12) : ((row0 - NLAT) >> 8);
            const int key0 = lat ? (TC + (row0 & (T - 1))) : ((row0 - NLAT) & (TC - 1));
#pragma unroll
            for (int nb = 0; nb < 4; ++nb)
#pragma unroll
                for (int mb = 0; mb < 4; ++mb) { const f32x4 v = acc[nb][mb];
                    v2u o; o.x = pk2(v.x, v.y); o.y = pk2(v.z, v.w);
                    *(v2u*)(Vt + ((size_t)(bb * 4 + hd) * 64 + 16 * nb + lr) * NKEY + key0 + 16 * mb + 4 * kq) = o; }
        }
    }
    __syncthreads();
}

DI void attn_unit(KArgs a, const Ctx& F, int b, int hd, int qrow0, int nkeys) {
    const bf16* Q = (const bf16*)(a->ws + WS_Q); const bf16* Kf = (const bf16*)(a->ws + WS_K); const bf16* Vt = (const bf16*)(a->ws + WS_VT);
    bf16* MO = (bf16*)(a->ws + WS_H);
    constexpr int KP = 208, VP = 144, BUF = 64 * KP + 64 * VP;
    const int tid = F.tid, lane = F.lane, wave = F.wave, l31 = lane & 31, h2 = lane >> 5;
    const int qrow = qrow0 + 32 * wave + l31;
    bf16x8 Qf[6];
#pragma unroll
    for (int s = 0; s < 6; ++s) Qf[s] = *(const bf16x8*)(Q + (size_t)qrow * 384 + hd * 96 + 16 * s + 8 * h2);
    const int kc0 = tid, kc1 = tid + 512;
    const int kr0 = kc0 / 12, kcc0 = kc0 % 12, kr1 = kc1 / 12, kcc1 = kc1 % 12; const bool k1v = kc1 < 768;
    const int vd = tid >> 3, vcc = tid & 7;
    const bf16* vbase = Vt + ((size_t)(b * 4 + hd) * 64 + vd) * NKEY + vcc * 8;
    v4u gk0, gk1, gv;
    auto gload = [&](int kt) {
        const int key0 = 64 * kt; const int krow = key0 < TC ? (NLAT + b * TC + key0) : (b * T + key0 - TC);
        gk0 = *(const v4u*)(Kf + (size_t)(krow + kr0) * 384 + hd * 96 + kcc0 * 8);
        if (k1v) gk1 = *(const v4u*)(Kf + (size_t)(krow + kr1) * 384 + hd * 96 + kcc1 * 8);
        gv = *(const v4u*)(vbase + key0);
    };
    auto lstore = [&](int buf) {
        LAS uchar* base = F.lds + buf * BUF;
        *(LAS v4u*)(base + kr0 * KP + kcc0 * 16) = gk0;
        if (k1v) *(LAS v4u*)(base + kr1 * KP + kcc1 * 16) = gk1;
        *(LAS v4u*)(base + 64 * KP + vd * VP + vcc * 16) = gv;
    };
    const int nt = nkeys / 64;
    gload(0); lstore(0);
    __syncthreads();
    f32x16 O0, O1;
#pragma unroll
    for (int r = 0; r < 16; ++r) { O0[r] = 0.f; O1[r] = 0.f; }
    float m = -1e30f, lsum = 0.f;
    for (int kt = 0; kt < nt; ++kt) {
        const bool more = kt + 1 < nt;
        if (more) gload(kt + 1);
        const LAS uchar* kb_ = F.lds + (kt & 1) * BUF; const LAS uchar* vb_ = kb_ + 64 * KP;
        f32x16 s0, s1;
#pragma unroll
        for (int r = 0; r < 16; ++r) { s0[r] = 0.f; s1[r] = 0.f; }
#pragma unroll
        for (int s = 0; s < 6; ++s) {
            const bf16x8 ka = *(const LAS bf16x8*)(kb_ + l31 * KP + (16 * s + 8 * h2) * 2);
            const bf16x8 kb2 = *(const LAS bf16x8*)(kb_ + (32 + l31) * KP + (16 * s + 8 * h2) * 2);
            s0 = mfma32(ka, Qf[s], s0); s1 = mfma32(kb2, Qf[s], s1);
        }
        float mx = s0[0];
#pragma unroll
        for (int r = 1; r < 16; ++r) mx = fmaxf(mx, s0[r]);
#pragma unroll
        for (int r = 0; r < 16; ++r) mx = fmaxf(mx, s1[r]);
        mx = fmaxf(mx, __shfl_xor(mx, 32));
        const float mn = fmaxf(m, mx), alpha = __builtin_amdgcn_exp2f(m - mn); m = mn;
        float ps = 0.f;
#pragma unroll
        for (int r = 0; r < 16; ++r) { s0[r] = __builtin_amdgcn_exp2f(s0[r] - mn); s1[r] = __builtin_amdgcn_exp2f(s1[r] - mn); ps += s0[r] + s1[r]; }
        lsum = lsum * alpha + ps;
#pragma unroll
        for (int r = 0; r < 16; ++r) { O0[r] *= alpha; O1[r] *= alpha; }
#pragma unroll
        for (int kb = 0; kb < 2; ++kb)
#pragma unroll
            for (int sp = 0; sp < 2; ++sp) {
                const f32x16& sx = kb ? s1 : s0;
                const bf16x8 pf = pack8(sx[8 * sp + 0], sx[8 * sp + 1], sx[8 * sp + 2], sx[8 * sp + 3], sx[8 * sp + 4], sx[8 * sp + 5], sx[8 * sp + 6], sx[8 * sp + 7]);
                const int ko = (32 * kb + 16 * sp + 4 * h2) * 2;
                const bf16x4 a0 = *(const LAS bf16x4*)(vb_ + l31 * VP + ko), a1 = *(const LAS bf16x4*)(vb_ + l31 * VP + ko + 16);
                const bf16x4 c0 = *(const LAS bf16x4*)(vb_ + (32 + l31) * VP + ko), c1 = *(const LAS bf16x4*)(vb_ + (32 + l31) * VP + ko + 16);
                const bf16x8 va = __builtin_shufflevector(a0, a1, 0, 1, 2, 3, 4, 5, 6, 7), vc = __builtin_shufflevector(c0, c1, 0, 1, 2, 3, 4, 5, 6, 7);
                O0 = mfma32(va, pf, O0); O1 = mfma32(vc, pf, O1);
            }
        if (more) lstore((kt + 1) & 1);
        __syncthreads();
    }
    const float ltot = lsum + __shfl_xor(lsum, 32), inv = 1.0f / ltot;
    bf16* op = MO + (size_t)qrow * D + 256 + hd * 64;
#pragma unroll
    for (int gq = 0; gq < 4; ++gq) {
        v2u o; o.x = pk2(O0[4 * gq] * inv, O0[4 * gq + 1] * inv); o.y = pk2(O0[4 * gq + 2] * inv, O0[4 * gq + 3] * inv);
        *(v2u*)(op + 8 * gq + 4 * h2) = o;
        v2u o2; o2.x = pk2(O1[4 * gq] * inv, O1[4 * gq + 1] * inv); o2.y = pk2(O1[4 * gq + 2] * inv, O1[4 * gq + 3] * inv);
        *(v2u*)(op + 32 + 8 * gq + 4 * h2) = o2;
    }
}
DI float conv3(const bf16* Z, int b, int seg, int t, int len, int col, float w0, float w1, float w2, float cb) {
    const bf16* zp = Z + (size_t)tok_row(b, seg, t) * ZP + col;
    float y = cb + w1 * bf2f(zp[0]);
    if (t > 0) y += w0 * bf2f(zp[-ZP]);
    if (t + 1 < len) y += w2 * bf2f(zp[ZP]);
    return y;
}
DI bf16x8 ldperm(const LAS bf16* rowp, int k0, int hh) { const bf16x4 a0 = *(const LAS bf16x4*)(rowp + k0 + 4 * hh), a1 = *(const LAS bf16x4*)(rowp + k0 + 8 + 4 * hh); return __builtin_shufflevector(a0, a1, 0, 1, 2, 3, 4, 5, 6, 7); }
DI bf16x8 pack_acc(const f32x16& x, int s) { return s ? pack8(x[8], x[9], x[10], x[11], x[12], x[13], x[14], x[15]) : pack8(x[0], x[1], x[2], x[3], x[4], x[5], x[6], x[7]); }
DI void rwkv_scan_task(KArgs a, const Ctx& F, int l, int b, int hd, int dir) {
    const bf16* Z = (const bf16*)(a->ws + WS_ACT); bf16* YR = (bf16*)(a->ws + WS_YR) + (size_t)dir * NROWS * 256;
    constexpr int RAWSZ = 13056 + 4608;
    constexpr int SETSZ = 4 * 4608 + 3 * 5120 + 256 + 2560;
    LAS uchar* const RAW0 = F.lds;
    LAS float* WL = (LAS float*)(F.lds + 2 * RAWSZ);
    LAS float* AL = WL + 2048;
    LAS float* Alw = AL + 2048;
    LAS float* CST = Alw + 512;
    LAS uchar* const SET0 = (LAS uchar*)(CST + 1024);
    const int tid = F.tid, lane = F.lane, wave = F.wave;
    const int hc = hd * 64 + lane;
    bf16x8 lf0 = {0, 0, 0, 0, 0, 0, 0, 0}, lf1 = lf0;
    if (wave >= 4) { const int w4 = wave - 4, l31 = lane & 31, hh = lane >> 5; const float* up = a->in[(w4 >> 1) ? I_RAUP : I_RWUP] + ((size_t)(l * 2 + dir) * 32) * 256 + hd * 64 + 32 * (w4 & 1) + l31;
        float u[16];
#pragma unroll
        for (int s = 0; s < 2; ++s)
#pragma unroll
            for (int j = 0; j < 8; ++j) u[8 * s + j] = up[(size_t)(16 * s + 8 * hh + j) * 256];
        lf0 = pack8(u[0], u[1], u[2], u[3], u[4], u[5], u[6], u[7]); lf1 = pack8(u[8], u[9], u[10], u[11], u[12], u[13], u[14], u[15]); }
    if (wave == 0) {
        const float* cw = a->in[I_RCW] + (size_t)l * 3 * 768; const float* cbp = a->in[I_RCB] + (size_t)l * 768;
        CST[0 * 64 + lane] = a->in[I_RW0][(l * 2 + dir) * 256 + hc]; CST[1 * 64 + lane] = a->in[I_RA0][(l * 2 + dir) * 256 + hc];
        CST[2 * 64 + lane] = a->in[I_RKK][l * 256 + hc]; CST[3 * 64 + lane] = a->in[I_RKA][l * 256 + hc];
#pragma unroll
        for (int j = 0; j < 3; ++j) { CST[(4 + j) * 64 + lane] = cw[j * 768 + hc]; CST[(7 + j) * 64 + lane] = cw[j * 768 + 256 + hc]; CST[(10 + j) * 64 + lane] = cw[j * 768 + 512 + hc]; }
        CST[13 * 64 + lane] = cbp[hc]; CST[14 * 64 + lane] = cbp[256 + hc]; CST[15 * 64 + lane] = cbp[512 + hc];
    }
    f32x16 ST0, ST1;
#pragma unroll
    for (int r = 0; r < 16; ++r) { ST0[r] = 0.f; ST1[r] = 0.f; }
    const int c0r = tid / 24, c0s = (tid % 24) >> 3, c0c = (tid % 24) & 7;
    const int c1 = tid + 512, c1r = c1 / 24, c1s = (c1 % 24) >> 3, c1c = (c1 % 24) & 7; const bool c1v = c1 < 816;
    const int lr_ = tid >> 3, lc_ = tid & 7;
    v4u g0, g1, g2;
    unsigned zz_ = 0u; asm volatile("" : "+v"(zz_)); const v4u zero4 = {zz_, zz_, zz_, zz_};
    const int nchC = TC / 32, nchT = nchC + T / 32;
    auto gload = [&](int gc) {
        const int seg = gc >= nchC, ch = seg ? gc - nchC : gc, len = seg ? T : TC;
        const int tbase = dir ? (len - 32 * (ch + 1)) : 32 * ch;
        { const int t = tbase - 1 + c0r; g0 = (t >= 0 && t < len) ? *(const v4u*)(Z + (size_t)tok_row(b, seg, t) * ZP + ZRKV + c0s * 256 + hd * 64 + c0c * 8) : zero4; }
        if (c1v) { const int t = tbase - 1 + c1r; g1 = (t >= 0 && t < len) ? *(const v4u*)(Z + (size_t)tok_row(b, seg, t) * ZP + ZRKV + c1s * 256 + hd * 64 + c1c * 8) : zero4; }
        if (tid < 256) { const int t = tbase + lr_; g2 = *(const v4u*)(Z + (size_t)tok_row(b, seg, t) * ZP + ZWD + lc_ * 8); }
    };
    auto lstore = [&](int par) {
        LAS bf16* Raw = (LAS bf16*)(RAW0 + par * RAWSZ); LAS bf16* LwB = (LAS bf16*)(RAW0 + par * RAWSZ + 13056);
        *(LAS v4u*)(Raw + c0r * 192 + c0s * 64 + c0c * 8) = g0;
        if (c1v) *(LAS v4u*)(Raw + c1r * 192 + c1s * 64 + c1c * 8) = g1;
        if (tid < 256) { float x[8] = {bflo(g2.x), bfhi(g2.x), bflo(g2.y), bfhi(g2.y), bflo(g2.z), bfhi(g2.z), bflo(g2.w), bfhi(g2.w)};
            if (lc_ < 4) {
#pragma unroll
                for (int j = 0; j < 8; ++j) x[j] = 1.0f - 2.0f * __builtin_amdgcn_rcpf(1.0f + fexp(2.0f * x[j])); }
            v4u w; w.x = pk2(x[0], x[1]); w.y = pk2(x[2], x[3]); w.z = pk2(x[4], x[5]); w.w = pk2(x[6], x[7]);
            *(LAS v4u*)(LwB + lr_ * 72 + lc_ * 8) = w; }
    };
    gload(0); lstore(0);
    __syncthreads();
    for (int n = -2; n < nchT; ++n) {
        if (n + 3 < nchT) gload(n + 3);
        int ln_ = lane; asm volatile("" : "+v"(ln_));
        const int l31 = ln_ & 31, hh = ln_ >> 5;
        if (wave < 2) {
            if (n >= 0) {
                const int seg = n >= nchC, ch = seg ? n - nchC : n, len = seg ? T : TC;
                const int tbase = dir ? (len - 32 * (ch + 1)) : 32 * ch;
                LAS uchar* sp = SET0 + (n & 1) * SETSZ;
                LAS bf16* KhT = (LAS bf16*)sp; LAS bf16* BhT = KhT + 32 * 72; LAS bf16* KkT = BhT + 32 * 72; LAS bf16* RhT = KkT + 32 * 72;
                LAS bf16* Kh = RhT + 32 * 72; LAS bf16* nBh = Kh + 64 * 40; LAS bf16* VT = nBh + 64 * 40; LAS float* GL = (LAS float*)(VT + 64 * 40); LAS bf16* TT = (LAS bf16*)(GL + 64);
                const int vcol = 32 * wave + l31;
                f32x16 accP, accY, accBb;
#pragma unroll
                for (int r = 0; r < 16; ++r) { accP[r] = 0.f; accY[r] = 0.f; }
#pragma unroll
                for (int kb = 0; kb < 2; ++kb)
#pragma unroll
                    for (int s = 0; s < 2; ++s) { const bf16x8 sb = pack_acc(kb ? ST1 : ST0, s);
                        accP = mfma32(ldperm(KkT + l31 * 72, 32 * kb + 16 * s, hh), sb, accP);
                        accY = mfma32(ldperm(RhT + l31 * 72, 32 * kb + 16 * s, hh), sb, accY); }
                {
                    f32x16 acc;
#pragma unroll
                    for (int r = 0; r < 16; ++r) acc[r] = 0.f;
#pragma unroll
                    for (int s = 0; s < 4; ++s) acc = mfma32(*(const LAS bf16x8*)(KhT + l31 * 72 + 16 * s + 8 * hh), *(const LAS bf16x8*)(KkT + l31 * 72 + 16 * s + 8 * hh), acc);
#pragma unroll
                    for (int r = 0; r < 16; ++r) acc[r] = (crow(r, hh) < l31) ? acc[r] : 0.f;
#pragma unroll
                    for (int s = 0; s < 2; ++s) accP = mfma32(pack_acc(acc, s), ldperm(VT + vcol * 40, 16 * s, hh), accP);
                }
                __builtin_amdgcn_sched_barrier(0);
                {
                    f32x16 acc;
#pragma unroll
                    for (int r = 0; r < 16; ++r) acc[r] = 0.f;
#pragma unroll
                    for (int s = 0; s < 4; ++s) acc = mfma32(*(const LAS bf16x8*)(KhT + l31 * 72 + 16 * s + 8 * hh), *(const LAS bf16x8*)(RhT + l31 * 72 + 16 * s + 8 * hh), acc);
#pragma unroll
                    for (int r = 0; r < 16; ++r) acc[r] = (crow(r, hh) <= l31) ? acc[r] : 0.f;
#pragma unroll
                    for (int s = 0; s < 2; ++s) accY = mfma32(pack_acc(acc, s), ldperm(VT + vcol * 40, 16 * s, hh), accY);
                }
                __builtin_amdgcn_sched_barrier(0);
                {
#pragma unroll
                    for (int r = 0; r < 16; ++r) accBb[r] = 0.f;
#pragma unroll
                    for (int s = 0; s < 4; ++s) accBb = mfma32(*(const LAS bf16x8*)(BhT + l31 * 72 + 16 * s + 8 * hh), *(const LAS bf16x8*)(RhT + l31 * 72 + 16 * s + 8 * hh), accBb);
#pragma unroll
                    for (int r = 0; r < 16; ++r) accBb[r] = (crow(r, hh) <= l31) ? -accBb[r] : 0.f;
                }
                f32x16 accC;
#pragma unroll
                for (int r = 0; r < 16; ++r) accC[r] = 0.f;
#pragma unroll
                for (int s = 0; s < 2; ++s) accC = mfma32(ldperm(TT + l31 * 40, 16 * s, hh), pack_acc(accP, s), accC);
#pragma unroll
                for (int s = 0; s < 2; ++s) accY = mfma32(pack_acc(accBb, s), pack_acc(accC, s), accY);
#pragma unroll
                for (int s = 0; s < 2; ++s) { const bf16x8 vb_ = *(const LAS bf16x8*)(VT + vcol * 40 + 16 * s + 8 * hh); const bf16x8 cb_ = pack_acc(accC, s);
                    ST0 = mfma32(*(const LAS bf16x8*)(Kh + l31 * 40 + 16 * s + 8 * hh), vb_, ST0);
                    ST1 = mfma32(*(const LAS bf16x8*)(Kh + (32 + l31) * 40 + 16 * s + 8 * hh), vb_, ST1);
                    ST0 = mfma32(ldperm(nBh + l31 * 40, 16 * s, hh), cb_, ST0);
                    ST1 = mfma32(ldperm(nBh + (32 + l31) * 40, 16 * s, hh), cb_, ST1); }
#pragma unroll
                for (int r = 0; r < 16; ++r) { ST0[r] *= GL[crow(r, hh)]; ST1[r] *= GL[32 + crow(r, hh)]; }
#pragma unroll
                for (int r = 0; r < 16; ++r) { const int i = crow(r, hh), t = dir ? (tbase + 31 - i) : (tbase + i);
                    YR[(size_t)tok_row(b, seg, t) * 256 + hd * 64 + vcol] = (bf16)f2bf(accY[r]); }
            }
        } else if (wave == 2) {
            if (n + 1 >= 0 && n + 1 < nchT) {
                LAS uchar* sp = SET0 + ((n + 1) & 1) * SETSZ;
                LAS bf16* BhT = (LAS bf16*)sp + 32 * 72; LAS bf16* KkT = BhT + 32 * 72; LAS bf16* TT = (LAS bf16*)(sp + 4 * 4608 + 3 * 5120 + 256);
                f32x16 P, PT, Tm, TTm;
#pragma unroll
                for (int r = 0; r < 16; ++r) { P[r] = 0.f; PT[r] = 0.f; }
#pragma unroll
                for (int s = 0; s < 4; ++s) { const bf16x8 bh_ = *(const LAS bf16x8*)(BhT + l31 * 72 + 16 * s + 8 * hh), kk_ = *(const LAS bf16x8*)(KkT + l31 * 72 + 16 * s + 8 * hh);
                    P = mfma32(bh_, kk_, P); PT = mfma32(kk_, bh_, PT); }
#pragma unroll
                for (int r = 0; r < 16; ++r) { const int j = crow(r, hh);
                    P[r] = (j < l31) ? P[r] : 0.f; PT[r] = (j > l31) ? PT[r] : 0.f;
                    const float idv = (j == l31) ? 1.f : 0.f; Tm[r] = idv - P[r]; TTm[r] = idv - PT[r]; }
#pragma unroll
                for (int it = 0; it < 4; ++it) {
                    const bf16x8 p0 = pack_acc(P, 0), p1 = pack_acc(P, 1), q0 = pack_acc(PT, 0), q1 = pack_acc(PT, 1);
                    f32x16 P2, P2T;
#pragma unroll
                    for (int r = 0; r < 16; ++r) { P2[r] = 0.f; P2T[r] = 0.f; }
                    P2 = mfma32(q0, p0, P2); P2 = mfma32(q1, p1, P2);
                    if (it < 3) { P2T = mfma32(p0, q0, P2T); P2T = mfma32(p1, q1, P2T); }
                    const bf16x8 u0 = pack_acc(TTm, 0), u1 = pack_acc(TTm, 1);
                    const bf16x8 a0 = pack_acc(P2, 0), a1 = pack_acc(P2, 1);
                    Tm = mfma32(u0, a0, Tm); Tm = mfma32(u1, a1, Tm);
                    if (it < 3) { TTm = mfma32(a0, u0, TTm); TTm = mfma32(a1, u1, TTm); }
                    P = P2; PT = P2T;
                }
#pragma unroll
                for (int r = 0; r < 16; ++r) TT[l31 * 40 + crow(r, hh)] = (bf16)f2bf(Tm[r]);
            }
        } else if (wave >= 4) {
            if (n + 2 < nchT) {
                const int w4 = wave - 4;
                const LAS bf16* LwB = (const LAS bf16*)(RAW0 + ((n + 2) & 1) * RAWSZ + 13056);
                f32x16 acc;
#pragma unroll
                for (int r = 0; r < 16; ++r) acc[r] = 0.f;
                const int ko = (w4 >> 1) * 32;
                acc = mfma32(*(const LAS bf16x8*)(LwB + l31 * 72 + ko + 8 * hh), lf0, acc);
                acc = mfma32(*(const LAS bf16x8*)(LwB + l31 * 72 + ko + 16 + 8 * hh), lf1, acc);
                LAS float* dst = (w4 >> 1) ? AL : WL;
#pragma unroll
                for (int r = 0; r < 16; ++r) dst[crow(r, hh) * 64 + 32 * (w4 & 1) + l31] = acc[r];
            }
        }
        lds_barrier();
        const bool pv = n + 2 < nchT;
        const int pi = tid >> 4, c4 = (ln_ & 15) * 4, pli = dir ? (31 - pi) : pi, pjr = dir ? (32 - pi) : (pi + 1);
        f32x4 lwi = {0.f, 0.f, 0.f, 0.f}, cuml = lwi;
        if (pv) {
            const f32x4 wl4 = *(const LAS f32x4*)(WL + pli * 64 + c4) + *(const LAS f32x4*)(CST + c4);
#pragma unroll
            for (int e = 0; e < 4; ++e) { const float xneg = -wl4[e]; const float sp = fmaxf(xneg, 0.f) + 0.69314718056f * __builtin_amdgcn_logf(1.0f + fexp(-fabsf(xneg))); lwi[e] = -fexp(-sp - 0.5f); }
            cuml = lwi;
#pragma unroll
            for (int e = 0; e < 4; ++e) { float y = __shfl_up(cuml[e], 16); if (ln_ >= 16) cuml[e] += y; }
#pragma unroll
            for (int e = 0; e < 4; ++e) { float y = __shfl_up(cuml[e], 32); if (ln_ >= 32) cuml[e] += y; }
            if (ln_ >= 48) *(LAS f32x4*)(Alw + wave * 64 + c4) = cuml;
        }
        lds_barrier();
        if (pv) {
            LAS uchar* sp = SET0 + (n & 1) * SETSZ;
            LAS bf16* KhT = (LAS bf16*)sp; LAS bf16* BhT = KhT + 32 * 72; LAS bf16* KkT = BhT + 32 * 72; LAS bf16* RhT = KkT + 32 * 72;
            LAS bf16* Kh = RhT + 32 * 72; LAS bf16* nBh = Kh + 64 * 40; LAS bf16* VT = nBh + 64 * 40; LAS float* GL = (LAS float*)(VT + 64 * 40);
            const LAS bf16* Raw = (const LAS bf16*)(RAW0 + (n & 1) * RAWSZ);
            f32x4 cum = cuml;
#pragma unroll
            for (int w2 = 0; w2 < 7; ++w2) { const f32x4 x = *(const LAS f32x4*)(Alw + w2 * 64 + c4); if (w2 < wave) cum = cum + x; }
            const f32x4 cpv = cum - lwi;
            float rr[4], kv[4], vv[4];
            { const f32x4 br = *(const LAS f32x4*)(CST + 13 * 64 + c4), bk = *(const LAS f32x4*)(CST + 14 * 64 + c4), bv = *(const LAS f32x4*)(CST + 15 * 64 + c4);
#pragma unroll
              for (int e = 0; e < 4; ++e) { rr[e] = br[e]; kv[e] = bk[e]; vv[e] = bv[e]; } }
#pragma unroll
            for (int tap = 0; tap < 3; ++tap) {
                const LAS bf16* rp = Raw + (pjr - 1 + tap) * 192 + c4;
                const v2u xr = *(const LAS v2u*)rp, xk = *(const LAS v2u*)(rp + 64), xv = *(const LAS v2u*)(rp + 128);
                const f32x4 wr = *(const LAS f32x4*)(CST + (4 + tap) * 64 + c4), wk = *(const LAS f32x4*)(CST + (7 + tap) * 64 + c4), wv = *(const LAS f32x4*)(CST + (10 + tap) * 64 + c4);
                rr[0] += wr[0] * bflo(xr.x); rr[1] += wr[1] * bfhi(xr.x); rr[2] += wr[2] * bflo(xr.y); rr[3] += wr[3] * bfhi(xr.y);
                kv[0] += wk[0] * bflo(xk.x); kv[1] += wk[1] * bfhi(xk.x); kv[2] += wk[2] * bflo(xk.y); kv[3] += wk[3] * bfhi(xk.y);
                vv[0] += wv[0] * bflo(xv.x); vv[1] += wv[1] * bfhi(xv.x); vv[2] += wv[2] * bflo(xv.y); vv[3] += wv[3] * bfhi(xv.y);
            }
            const f32x4 kkc4 = *(const LAS f32x4*)(CST + 2 * 64 + c4), kac4 = *(const LAS f32x4*)(CST + 3 * 64 + c4);
            const f32x4 al4 = *(const LAS f32x4*)(AL + pli * 64 + c4) + *(const LAS f32x4*)(CST + 64 + c4);
            float kx[4]; float ss = 0.f;
#pragma unroll
            for (int e = 0; e < 4; ++e) { kx[e] = kv[e] * kkc4[e]; ss += kx[e] * kx[e]; }
            ss = sum16(ss);
            const float rn = __builtin_amdgcn_rcpf(fmaxf(__builtin_amdgcn_sqrtf(ss), 1e-12f));
            float kh[4], bh[4], kk_[4], rh[4];
#pragma unroll
            for (int e = 0; e < 4; ++e) { const float av = __builtin_amdgcn_rcpf(1.0f + fexp(-al4[e])), kn = kx[e] * rn, en = fexp(-cum[e]), ep = fexp(cum[e]), epv = fexp(cpv[e]);
                kh[e] = kv[e] * (1.0f + (av - 1.0f) * kac4[e]) * en; bh[e] = kn * av * en; kk_[e] = kn * epv; rh[e] = rr[e] * ep; }
            v2u o;
            o.x = pk2(kh[0], kh[1]); o.y = pk2(kh[2], kh[3]); *(LAS v2u*)(KhT + pi * 72 + c4) = o;
            o.x = pk2(bh[0], bh[1]); o.y = pk2(bh[2], bh[3]); *(LAS v2u*)(BhT + pi * 72 + c4) = o;
            o.x = pk2(kk_[0], kk_[1]); o.y = pk2(kk_[2], kk_[3]); *(LAS v2u*)(KkT + pi * 72 + c4) = o;
            o.x = pk2(rh[0], rh[1]); o.y = pk2(rh[2], rh[3]); *(LAS v2u*)(RhT + pi * 72 + c4) = o;
#pragma unroll
            for (int e = 0; e < 4; ++e) { Kh[(c4 + e) * 40 + pi] = (bf16)f2bf(kh[e]); nBh[(c4 + e) * 40 + pi] = (bf16)f2bf(-bh[e]); VT[(c4 + e) * 40 + pi] = (bf16)f2bf(vv[e]); }
            if (pi == 31) *(LAS f32x4*)(GL + c4) = (f32x4){fexp(cum[0]), fexp(cum[1]), fexp(cum[2]), fexp(cum[3])};
        }
        if (n + 3 < nchT) lstore((n + 3) & 1);
        lds_barrier();
    }
}

DI void mlstm_task(KArgs a, const Ctx& F, int l, int b, int hd) {
    const bf16* Z = (const bf16*)(a->ws + WS_ACT);
    const int tid = F.tid, lane = F.lane, wave = F.wave, dir = wave >> 2, w2 = wave & 3, tid2 = tid & 255, l31 = lane & 31, hh = lane >> 5;
    bf16* YM = (bf16*)(a->ws + WS_YM) + (size_t)dir * NROWS * 256;
    constexpr int HP = 72;
    constexpr int HALF_LDS = 67328;
    LAS uchar* base = F.lds + dir * HALF_LDS;
    LAS bf16* Qc = (LAS bf16*)base; LAS bf16* Kc = Qc + 64 * HP; LAS bf16* KTw = Kc + 64 * HP; LAS bf16* VT = KTw + 64 * HP; LAS bf16* Cb = VT + 64 * HP;
    LAS float* fv = (LAS float*)(base + 5 * 9216);
    LAS float* Vgv = fv; LAS float* VMr = fv + 64; LAS float* Vwi = fv + 128; LAS float* Vem = fv + 192; LAS float* Vwk = fv + 256; LAS float* Vn = fv + 320; LAS float* Vsc = fv + 384;
    LAS bf16* Rq = (LAS bf16*)(base + 47872);
    LAS float* Gt = (LAS float*)(base + 47872 + 16896);
    LAS float* Cw = Gt + 128;
    for (int i = tid2; i < 64 * HP; i += 256) Cb[i] = 0;
    if (tid2 < 64) Vn[tid2] = 0.f;
    if (tid2 == 0) { float one_ = 1.f, zero_ = 0.f; asm volatile("" : "+v"(one_), "+v"(zero_)); Vsc[0] = one_; Vsc[1] = zero_; }
    { const float* cw = a->in[I_MCW] + (size_t)l * 3 * 512; const float* cbp = a->in[I_MCB] + (size_t)l * 512;
      for (int i = tid2; i < 512; i += 256) { const int tap = i >> 7, cc = i & 127, col = (cc < 64) ? (hd * 64 + cc) : (256 + hd * 64 + cc - 64);
          Cw[i] = (tap < 3) ? cw[tap * 512 + col] : cbp[col]; } }
    f32x16 accC;
#pragma unroll
    for (int r = 0; r < 16; ++r) accC[r] = 0.f;
    const int eb = w2 >> 1, lb = w2 & 1;
    const float gbi = a->in[I_MGB][l * 16 + dir * 8 + hd], gbf = a->in[I_MGB][l * 16 + dir * 8 + 4 + hd];
    const int nchC = TC / 64, nchT = nchC + T / 64;
    v4u gq[5], gv[2]; unsigned gr0 = 0u, gr1 = 0u;
    unsigned zz_ = 0u; asm volatile("" : "+v"(zz_)); const v4u zero4 = {zz_, zz_, zz_, zz_};
    auto gload = [&](int gc) {
        const int seg = gc >= nchC, ch = seg ? gc - nchC : gc, len = seg ? T : TC;
        const int tbase = dir ? (len - 64 * (ch + 1)) : 64 * ch;
#pragma unroll
        for (int n = 0; n < 5; ++n) { const int cidx = tid2 + 256 * n; if (cidx < 1056) { const int row = cidx >> 4, cc = cidx & 15, t = tbase - 1 + row;
            gq[n] = (t >= 0 && t < len) ? *(const v4u*)(Z + (size_t)tok_row(b, seg, t) * ZP + ZMQK + (cc >> 3) * 256 + hd * 64 + (cc & 7) * 8) : zero4; } }
#pragma unroll
        for (int n = 0; n < 2; ++n) { const int cidx = tid2 + 256 * n, row = cidx >> 3, cc = cidx & 7; gv[n] = *(const v4u*)(Z + (size_t)tok_row(b, seg, tbase + row) * ZP + ZMV + hd * 64 + cc * 8); }
        if (tid2 < 64) { const bf16* zp = Z + (size_t)tok_row(b, seg, tbase + tid2) * ZP + ZMG + dir * 8 + hd; gr0 = zp[0]; gr1 = zp[4]; }
    };
    auto lstore = [&]() {
#pragma unroll
        for (int n = 0; n < 5; ++n) { const int cidx = tid2 + 256 * n; if (cidx < 1056) *(LAS v4u*)(Rq + (cidx >> 4) * 128 + (cidx & 15) * 8) = gq[n]; }
#pragma unroll
        for (int n = 0; n < 2; ++n) { const int cidx = tid2 + 256 * n, row = cidx >> 3, cc = cidx & 7;
            const int stp = dir ? (63 - row) : row; const unsigned w[4] = {gv[n].x, gv[n].y, gv[n].z, gv[n].w};
#pragma unroll
            for (int j = 0; j < 4; ++j) { VT[(cc * 8 + 2 * j) * HP + stp] = (bf16)(w[j] & 0xffffu); VT[(cc * 8 + 2 * j + 1) * HP + stp] = (bf16)(w[j] >> 16); } }
    };
    auto stage0 = [&]() {
        if (w2 == 0) {
            float li = bf2f(gr0) + gbi; const float fraw = bf2f(gr1) + gbf;
            float lf = fminf(fraw, 0.f) - log1pf(__expf(-fabsf(fraw)));
            if (dir) { li = __shfl(li, 63 - lane); lf = __shfl(lf, 63 - lane); }
            const float bc = wave_scan_sum(lf);
            const float g = li - bc; const float pm = wave_scan_max(g);
            const float mprev = Vsc[1];
            const float blast = __shfl(bc, 63);
            const float lw = blast - bc + li;
            const float mnew = fmaxf(blast + mprev, wave_max(lw));
            const float Mr = fmaxf(mprev, pm);
            Vgv[lane] = g; VMr[lane] = Mr; Vwi[lane] = __expf(mprev - Mr); Vem[lane] = __expf(-bc - Mr); Vwk[lane] = __expf(lw - mnew);
            if (lane == 0) { Vsc[0] = __expf(blast + mprev - mnew); Vsc[2] = mnew; }
        }
    };
    gload(0);
    __syncthreads();
    lstore(); stage0();
    __syncthreads();
    for (int gc = 0; gc < nchT; ++gc) {
        const int seg = gc >= nchC, ch = seg ? gc - nchC : gc, len = seg ? T : TC;
        const int tbase = dir ? (len - 64 * (ch + 1)) : 64 * ch;
        if (gc + 1 < nchT) gload(gc + 1);
#ifdef DBG_REP_M1
        for (int rp_ = 0; rp_ < 2; ++rp_)
#endif
        {
            const int i = tid2 >> 2, qq = tid2 & 3, jr = dir ? (64 - i) : (i + 1);
            const float wk_i = Vwk[i];
            float qv[16], kvv[16];
#pragma unroll
            for (int j = 0; j < 16; ++j) { qv[j] = Cw[384 + qq * 16 + j]; kvv[j] = Cw[384 + 64 + qq * 16 + j]; }
#pragma unroll
            for (int tap = 0; tap < 3; ++tap) {
                const LAS bf16* rp = Rq + (jr - 1 + tap) * 128 + qq * 16;
                const v4u q0 = *(const LAS v4u*)rp, q1 = *(const LAS v4u*)(rp + 8), k0 = *(const LAS v4u*)(rp + 64), k1 = *(const LAS v4u*)(rp + 72);
                const unsigned qw[8] = {q0.x, q0.y, q0.z, q0.w, q1.x, q1.y, q1.z, q1.w}, kw[8] = {k0.x, k0.y, k0.z, k0.w, k1.x, k1.y, k1.z, k1.w};
#pragma unroll
                for (int j = 0; j < 8; ++j) { qv[2 * j] += Cw[tap * 128 + qq * 16 + 2 * j] * bflo(qw[j]); qv[2 * j + 1] += Cw[tap * 128 + qq * 16 + 2 * j + 1] * bfhi(qw[j]);
                    kvv[2 * j] += Cw[tap * 128 + 64 + qq * 16 + 2 * j] * bflo(kw[j]); kvv[2 * j + 1] += Cw[tap * 128 + 64 + qq * 16 + 2 * j + 1] * bfhi(kw[j]); }
            }
#pragma unroll
            for (int j = 0; j < 16; ++j) { qv[j] = qv[j] * fsigmoid(qv[j]); kvv[j] = kvv[j] * fsigmoid(kvv[j]) * 0.125f; }
#pragma unroll
            for (int j = 0; j < 16; j += 2) { *(LAS unsigned*)(Qc + i * HP + qq * 16 + j) = pk2(qv[j], qv[j + 1]); *(LAS unsigned*)(Kc + i * HP + qq * 16 + j) = pk2(kvv[j], kvv[j + 1]); }
#pragma unroll
            for (int j = 0; j < 16; ++j) KTw[(qq * 16 + j) * HP + i] = (bf16)f2bf(kvv[j] * wk_i);
        }
        lds_barrier();
#ifdef DBG_REP_MA
        for (int rp_ = 0; rp_ < 2; ++rp_)
#endif
        {
            const int lidx = 32 * lb + l31;
            f32x16 accN, accI;
#pragma unroll
            for (int r = 0; r < 16; ++r) { accN[r] = 0.f; accI[r] = 0.f; }
            float dsum = 0.f;
            const float Mr = VMr[lidx];
#pragma unroll
            for (int sb = 0; sb < 2; ++sb) {
                if (sb <= lb) {
                    f32x16 sT;
#pragma unroll
                    for (int r = 0; r < 16; ++r) sT[r] = 0.f;
#pragma unroll
                    for (int s = 0; s < 4; ++s) {
                        const bf16x8 ka = *(const LAS bf16x8*)(Kc + (32 * sb + l31) * HP + 16 * s + 8 * hh);
                        const bf16x8 qb = *(const LAS bf16x8*)(Qc + lidx * HP + 16 * s + 8 * hh);
                        sT = mfma32(ka, qb, sT);
                    }
#pragma unroll
                    for (int g4 = 0; g4 < 4; ++g4) { const f32x4 gv4 = *(const LAS f32x4*)(Vgv + 32 * sb + 8 * g4 + 4 * hh);
#pragma unroll
                        for (int e = 0; e < 4; ++e) { const int r = 4 * g4 + e, sidx = 32 * sb + 8 * g4 + 4 * hh + e;
                            const float ex = fexp(fminf(gv4[e] - Mr, 0.f));
                            const float p = (sidx <= lidx) ? sT[r] * ex : 0.f; sT[r] = p; dsum += p; } }
#pragma unroll
                    for (int sp = 0; sp < 2; ++sp) {
                        const bf16x8 pf = pack8(sT[8 * sp + 0], sT[8 * sp + 1], sT[8 * sp + 2], sT[8 * sp + 3], sT[8 * sp + 4], sT[8 * sp + 5], sT[8 * sp + 6], sT[8 * sp + 7]);
                        const int ko = 32 * sb + 16 * sp + 4 * hh;
                        const bf16x4 a0 = *(const LAS bf16x4*)(VT + (32 * eb + l31) * HP + ko), a1 = *(const LAS bf16x4*)(VT + (32 * eb + l31) * HP + ko + 8);
                        accN = mfma32(__builtin_shufflevector(a0, a1, 0, 1, 2, 3, 4, 5, 6, 7), pf, accN);
                    }
                }
            }
#pragma unroll
            for (int s = 0; s < 4; ++s) {
                const bf16x8 ca = *(const LAS bf16x8*)(Cb + (32 * eb + l31) * HP + 16 * s + 8 * hh);
                const bf16x8 qb = *(const LAS bf16x8*)(Qc + lidx * HP + 16 * s + 8 * hh);
                accI = mfma32(ca, qb, accI);
            }
            dsum += __shfl_xor(dsum, 32);
            float nq = 0.f;
#pragma unroll
            for (int j = 0; j < 64; j += 8) { const v4u w = *(const LAS v4u*)(Qc + lidx * HP + j); const f32x4 n0 = *(const LAS f32x4*)(Vn + j), n1 = *(const LAS f32x4*)(Vn + j + 4);
                nq += (n0[0] * bflo(w.x) + n0[1] * bfhi(w.x)) + (n0[2] * bflo(w.y) + n0[3] * bfhi(w.y)) + (n1[0] * bflo(w.z) + n1[1] * bfhi(w.z)) + (n1[2] * bflo(w.w) + n1[3] * bfhi(w.w)); }
            const float wi = Vwi[lidx];
            const float den = dsum + wi * nq, hden = fmaxf(fabsf(den), Vem[lidx]), inv = 1.0f / hden;
            const int t = dir ? (tbase + 63 - lidx) : (tbase + lidx);
            bf16* op = YM + (size_t)tok_row(b, seg, t) * 256 + hd * 64 + 32 * eb;
#pragma unroll
            for (int gq_ = 0; gq_ < 4; ++gq_) {
                const float h0 = (accN[4 * gq_] + wi * accI[4 * gq_]) * inv, h1 = (accN[4 * gq_ + 1] + wi * accI[4 * gq_ + 1]) * inv, h2 = (accN[4 * gq_ + 2] + wi * accI[4 * gq_ + 2]) * inv, h3 = (accN[4 * gq_ + 3] + wi * accI[4 * gq_ + 3]) * inv;
                v2u o; o.x = pk2(h0, h1); o.y = pk2(h2, h3);
                *(v2u*)(op + 8 * gq_ + 4 * hh) = o;
            }
        }
        lds_barrier();
        {
            const float sc = Vsc[0];
#pragma unroll
            for (int r = 0; r < 16; ++r) accC[r] *= sc;
#pragma unroll
            for (int s = 0; s < 4; ++s) {
                const bf16x8 va = *(const LAS bf16x8*)(VT + (32 * eb + l31) * HP + 16 * s + 8 * hh);
                const bf16x8 kb = *(const LAS bf16x8*)(KTw + (32 * lb + l31) * HP + 16 * s + 8 * hh);
                accC = mfma32(va, kb, accC);
            }
#pragma unroll
            for (int r = 0; r < 16; ++r) Cb[(32 * eb + crow(r, hh)) * HP + 32 * lb + l31] = (bf16)f2bf(accC[r]);
            if (tid2 < 64) { float s = 0.f;
#pragma unroll
                for (int j = 0; j < 64; j += 8) { const v4u w = *(const LAS v4u*)(KTw + tid2 * HP + j); s += (bflo(w.x) + bfhi(w.x)) + (bflo(w.y) + bfhi(w.y)) + (bflo(w.z) + bfhi(w.z)) + (bflo(w.w) + bfhi(w.w)); }
                Vn[tid2] = sc * Vn[tid2] + s; }
            if (tid2 == 0) Vsc[1] = Vsc[2];
        }
        lds_barrier();
#ifdef DBG_REP_MB
        {
            f32x16 accD = accC; LAS bf16* CbD = (LAS bf16*)(F.lds + 134656); LAS float* VnD = (LAS float*)(F.lds + 134656 + 9216);
            const float sc = Vsc[0];
#pragma unroll
            for (int r = 0; r < 16; ++r) accD[r] *= sc;
#pragma unroll
            for (int s = 0; s < 4; ++s) {
                const bf16x8 va = *(const LAS bf16x8*)(VT + (32 * eb + l31) * HP + 16 * s + 8 * hh);
                const bf16x8 kb = *(const LAS bf16x8*)(KTw + (32 * lb + l31) * HP + 16 * s + 8 * hh);
                accD = mfma32(va, kb, accD);
            }
#pragma unroll
            for (int r = 0; r < 16; ++r) CbD[(32 * eb + crow(r, hh)) * HP + 32 * lb + l31] = (bf16)f2bf(accD[r]);
            if (tid2 < 64) { float s = 0.f;
#pragma unroll
                for (int j = 0; j < 64; j += 8) { const v4u w = *(const LAS v4u*)(KTw + tid2 * HP + j); s += (bflo(w.x) + bfhi(w.x)) + (bflo(w.y) + bfhi(w.y)) + (bflo(w.z) + bfhi(w.z)) + (bflo(w.w) + bfhi(w.w)); }
                VnD[tid2] = sc * Vn[tid2] + s; }

            asm volatile("" :: "v"(accD[0]));
        }
        lds_barrier();
#endif
#ifdef DBG_REP_ML
        for (int rp_ = 0; rp_ < 2; ++rp_)
#endif
        if (gc + 1 < nchT) { lstore(); stage0(); }
        lds_barrier();
    }
}
DI float gelu_tanh(float x) { const float u = 0.7978845608028654f * (x + 0.044715f * x * x * x); const float e = __expf(2.0f * u); const float th = 1.0f - 2.0f / (e + 1.0f); return 0.5f * x * (1.0f + th); }
DI void unpack8(const v4u w, float (&o)[8]) { o[0] = bflo(w.x); o[1] = bfhi(w.x); o[2] = bflo(w.y); o[3] = bfhi(w.y); o[4] = bflo(w.z); o[5] = bfhi(w.z); o[6] = bflo(w.w); o[7] = bfhi(w.w); }
DI v4u pack8u(const float (&o)[8]) { v4u w; w.x = pk2(o[0], o[1]); w.y = pk2(o[2], o[3]); w.z = pk2(o[4], o[5]); w.w = pk2(o[6], o[7]); return w; }
constexpr int FIN_CST_OFF = 56320;
DI void fin_load_consts(KArgs a, const Ctx& F, int l) {
    LAS float* C = (LAS float*)(F.lds + FIN_CST_OFF);
    for (int i = F.tid; i < 4608; i += NTHR) {
        float v;
        if (i < 2304) v = a->in[I_RCW][(size_t)l * 2304 + i];
        else if (i < 3072) v = a->in[I_RCB][(size_t)l * 768 + (i - 2304)];
        else if (i < 3328) v = a->in[I_RRK][l * 256 + (i - 3072)];
        else if (i < 3584) v = a->in[I_RLNW][l * 256 + (i - 3328)];
        else if (i < 3840) v = a->in[I_RLNB][l * 256 + (i - 3584)];
        else if (i < 4096) v = a->in[I_MNORM][l * 256 + (i - 3840)];
        else if (i < 4352) v = a->in[I_S5D][l * 256 + (i - 4096)];
        else v = a->in[I_S5BGLU][l * 256 + (i - 4352)];
        C[i] = v;
    }
    __syncthreads();
}
DI void fin_tile(KArgs a, const Ctx& F, int l, int tile) {
    const LAS float* CT = (const LAS float*)(F.lds + FIN_CST_OFF);
    const bf16* Z = (const bf16*)(a->ws + WS_ACT); bf16* MO = (bf16*)(a->ws + WS_H);
    const bf16* YS = (const bf16*)(a->ws + WS_YS5); const bf16* YR = (const bf16*)(a->ws + WS_YR); const bf16* YM = (const bf16*)(a->ws + WS_YM);
    const bf16* WGLU = (const bf16*)(a->ws + WS_SMALLW + SW_GLU); const bf16* WGUP = (const bf16*)(a->ws + WS_SMALLW + SW_GUP);
    LAS bf16* Az = (LAS bf16*)F.lds;
    LAS bf16* Ag = (LAS bf16*)(F.lds + 16896);
    LAS float* Pr = (LAS float*)(F.lds + 16896 + 4608);
    int tl_ = F.tid; asm volatile("" : "+v"(tl_));
    const int tid = tl_, lane = tid & 63, wave = F.wave, row0 = tile * 32;
    const int i = tid >> 4, part = tid & 15, row = row0 + i;
    const size_t DS = (size_t)NROWS * 256;
    const bf16* zr = Z + (size_t)row * ZP;
    {
        const LAS float* dsk = CT + 4096 + part * 16;
#pragma unroll
        for (int j = 0; j < 2; ++j) { const int c0 = part * 16 + 8 * j; float y0[8], y1[8], u[8], z[8];
            unpack8(*(const v4u*)(YS + (size_t)row * 256 + c0), y0); unpack8(*(const v4u*)(YS + DS + (size_t)row * 256 + c0), y1); unpack8(*(const v4u*)(zr + ZS5 + c0), u);
#pragma unroll
            for (int e = 0; e < 8; ++e) z[e] = gelu_tanh(y0[e] + y1[e] + dsk[8 * j + e] * u[e]);
            *(LAS v4u*)(Az + i * 264 + c0) = pack8u(z); }
    }
    const int hq = part >> 2, c0 = hq * 64 + (part & 3) * 16;
    const bool lat = row < NLAT; const int t = lat ? (row & (T - 1)) : ((row - NLAT) & (TC - 1)); const int len = lat ? T : TC;
    {
        float y[16]; float s = 0.f;
#pragma unroll
        for (int j = 0; j < 2; ++j) { float y0[8], y1[8]; unpack8(*(const v4u*)(YM + (size_t)row * 256 + c0 + 8 * j), y0); unpack8(*(const v4u*)(YM + DS + (size_t)row * 256 + c0 + 8 * j), y1);
#pragma unroll
            for (int e = 0; e < 8; ++e) { y[8 * j + e] = y0[e] + y1[e]; s += y[8 * j + e]; } }
        s += __shfl_xor(s, 1); s += __shfl_xor(s, 2); const float mu = s * (1.0f / 64.0f); float q = 0.f;
#pragma unroll
        for (int j = 0; j < 16; ++j) { y[j] -= mu; q += y[j] * y[j]; }
        q += __shfl_xor(q, 1); q += __shfl_xor(q, 2); const float rstd = 1.0f / sqrtf(q * (1.0f / 64.0f) + 1e-6f);
        const LAS float* nw = CT + 3840 + c0;
#pragma unroll
        for (int j = 0; j < 2; ++j) { float o[8]; unpack8(*(const v4u*)(zr + ZMO + c0 + 8 * j), o);
#pragma unroll
            for (int e = 0; e < 8; ++e) o[e] = y[8 * j + e] * rstd * nw[8 * j + e] * fsigmoid(o[e]);
            *(v4u*)(MO + (size_t)row * D + 768 + c0 + 8 * j) = pack8u(o); }
    }
    {
        float y[16]; float s = 0.f;
#pragma unroll
        for (int j = 0; j < 2; ++j) { float y0[8], y1[8]; unpack8(*(const v4u*)(YR + (size_t)row * 256 + c0 + 8 * j), y0); unpack8(*(const v4u*)(YR + DS + (size_t)row * 256 + c0 + 8 * j), y1);
#pragma unroll
            for (int e = 0; e < 8; ++e) { y[8 * j + e] = y0[e] + y1[e]; s += y[8 * j + e]; } }
        s += __shfl_xor(s, 1); s += __shfl_xor(s, 2); const float mu = s * (1.0f / 64.0f); float q = 0.f;
#pragma unroll
        for (int j = 0; j < 16; ++j) { y[j] -= mu; q += y[j] * y[j]; }
        q += __shfl_xor(q, 1); q += __shfl_xor(q, 2); const float rstd = 1.0f / sqrtf(q * (1.0f / 64.0f) + 64e-5f);
        const LAS float* cw = CT; const LAS float* cbp = CT + 2304;
        const LAS float* rk = CT + 3072 + c0; const LAS float* lw = CT + 3328 + c0; const LAS float* lb = CT + 3584 + c0;
        float vv[16]; float bs = 0.f;
#pragma unroll
        for (int j = 0; j < 2; ++j) { const int c = c0 + 8 * j;
            float rr[8], kk[8], v[8], x[8];
#pragma unroll
            for (int e = 0; e < 8; ++e) { rr[e] = cbp[c + e]; kk[e] = cbp[256 + c + e]; v[e] = cbp[512 + c + e]; }
#pragma unroll
            for (int tap = 0; tap < 3; ++tap) { const int tt = t - 1 + tap;
                if (tt >= 0 && tt < len) { const bf16* zp = zr + (tap - 1) * ZP + ZRKV + c;
                    unpack8(*(const v4u*)zp, x);
#pragma unroll
                    for (int e = 0; e < 8; ++e) rr[e] += cw[tap * 768 + c + e] * x[e];
                    unpack8(*(const v4u*)(zp + 256), x);
#pragma unroll
                    for (int e = 0; e < 8; ++e) kk[e] += cw[tap * 768 + 256 + c + e] * x[e];
                    unpack8(*(const v4u*)(zp + 512), x);
#pragma unroll
                    for (int e = 0; e < 8; ++e) v[e] += cw[tap * 768 + 512 + c + e] * x[e]; } }
#pragma unroll
            for (int e = 0; e < 8; ++e) { bs += rr[e] * kk[e] * rk[8 * j + e]; vv[8 * j + e] = v[e]; } }
        bs += __shfl_xor(bs, 1); bs += __shfl_xor(bs, 2);
#pragma unroll
        for (int j = 0; j < 16; j += 4) *(LAS f32x4*)(Pr + i * 260 + c0 + j) = (f32x4){y[j] * rstd * lw[j] + lb[j] + bs * vv[j], y[j + 1] * rstd * lw[j + 1] + lb[j + 1] + bs * vv[j + 1], y[j + 2] * rstd * lw[j + 2] + lb[j + 2] + bs * vv[j + 2], y[j + 3] * rstd * lw[j + 3] + lb[j + 3] + bs * vv[j + 3]};
    }
    {
        const v2u gv = *(const v2u*)(zr + ZGD + part * 4);
        v2u o; o.x = pk2(fsigmoid(bflo(gv.x)), fsigmoid(bfhi(gv.x))); o.y = pk2(fsigmoid(bflo(gv.y)), fsigmoid(bfhi(gv.y)));
        *(LAS v2u*)(Ag + i * 72 + part * 4) = o;
    }
    __syncthreads();
    const int lr = lane & 15, kq = lane >> 4;
    {
        f32x4 acc[2][2];
        small_gemm<256, 2, 2, true>(Az, 264, WGLU, 32 * wave, acc, lane);
        const LAS float* bg = CT + 4352;
#pragma unroll
        for (int nb = 0; nb < 2; ++nb)
#pragma unroll
            for (int mb = 0; mb < 2; ++mb) { const int tk = 16 * mb + lr, n = 32 * wave + 16 * nb + 4 * kq; const f32x4 v = acc[nb][mb]; const f32x4 b4 = *(const LAS f32x4*)(bg + n);
                const v2u zz = *(const LAS v2u*)(Az + tk * 264 + n);
                const float o0 = bflo(zz.x) * fsigmoid(v.x + b4.x), o1 = bfhi(zz.x) * fsigmoid(v.y + b4.y), o2 = bflo(zz.y) * fsigmoid(v.z + b4.z), o3 = bfhi(zz.y) * fsigmoid(v.w + b4.w);
                v2u o; o.x = pk2(o0, o1); o.y = pk2(o2, o3);
                *(v2u*)(MO + (size_t)(row0 + tk) * D + n) = o; }
    }
    {
        f32x4 acc[2][2];
        small_gemm<64, 2, 2, true>(Ag, 72, WGUP, 32 * wave, acc, lane);
#pragma unroll
        for (int nb = 0; nb < 2; ++nb)
#pragma unroll
            for (int mb = 0; mb < 2; ++mb) { const int tk = 16 * mb + lr, n = 32 * wave + 16 * nb + 4 * kq; const f32x4 v = acc[nb][mb];
                const f32x4 pr = *(const LAS f32x4*)(Pr + tk * 260 + n);
                v2u o; o.x = pk2(pr.x * v.x, pr.y * v.y); o.y = pk2(pr.z * v.z, pr.w * v.w);
                *(v2u*)(MO + (size_t)(row0 + tk) * D + 512 + n) = o; }
    }
    __syncthreads();
}
#ifndef MK_SPLIT
#define MK_SPLIT 1
#endif
#ifdef USE_NOINLINE
#define NI static __device__ __noinline__
#else
#define NI static __device__ __forceinline__
#endif
extern __shared__ __attribute__((aligned(16))) unsigned char lds_raw[];
DI Ctx make_ctx(int wave0) {
    Ctx F; F.lds = (LAS uchar*)lds_raw; { int ln_ = __builtin_amdgcn_mbcnt_hi(~0u, __builtin_amdgcn_mbcnt_lo(~0u, 0u)); asm volatile("" : "+v"(ln_)); F.lane = ln_; } F.wave = wave0; F.tid = wave0 * 64 + F.lane;
    F.G = gridDim.x; { int bx = blockIdx.x; asm volatile("" : "+s"(bx)); F.vcu = (F.G % 8 == 0) ? (bx % 8) * (F.G / 8) + bx / 8 : bx; }
    return F;
}
NI void ph_prologue(KArgs a_, int wave0) { KArgs a = a_; asm volatile("" : "+s"(a)); const Ctx F = make_ctx(wave0); phase_prologue(a, F); __syncthreads(); }
NI void ph_norm(KArgs a_, int wave0, int l, int kind) { KArgs a = a_; asm volatile("" : "+s"(a));
    const Ctx F = make_ctx(wave0);
    float* modv = (float*)(a->ws + WS_MODV);
    const bool last = (l == DEPTH - 1);
    if (kind == 0) convert_weights(a, F, l, 0);
    if (kind == 1) convert_weights(a, F, l, 1);
    const int lY = (kind == 0) ? (l > 0 ? l - 1 : 0) : l;
    const int gi = (kind == 0 || kind == 3) ? 8 : (kind == 1 ? 2 : 5);
    const int pi = (kind == 0 || kind == 3) ? 2 : (kind == 1 ? 0 : 1);
    const float coef = (kind == 2) ? 1.0f : 0.5f;
    const int si = (kind == 0) ? 0 : (kind == 1 ? 3 : 6);
    const int ni = (kind == 0) ? 0 : (kind == 1 ? 1 : 2);
    const bool first = (kind == 0 && l == 0), hasY = !(kind == 0 && l == 0), hasH = (kind != 3), fin = (kind == 3);
    const int nrows = (kind == 3 || (kind == 2 && last)) ? NLAT : NROWS;
    norm_rows(a, F, first, hasY, hasH, fin, nrows, modv + (size_t)lY * 9 * MODW, gi, a->in[I_NPOST] + (lY * 3 + pi) * D, coef, modv + (size_t)l * 9 * MODW, si, a->in[I_NPRE] + (l * 3 + ni) * D);
    __syncthreads();
}
NI void ph_gemm_swiglu(KArgs a_, int wave0, int M) { KArgs a = a_; asm volatile("" : "+s"(a));
    const Ctx F = make_ctx(wave0);
    pg8::Gemm g{(const bf16*)(a->ws + WS_H), (const bf16*)(a->ws + WS_WGU), M, 2 * FF, D}; pg8::StaticOrder S; S.init(M, 2 * FF, F.G, (int)blockIdx.x);
    pg8::EpiSwiGLU E{(bf16*)(a->ws + WS_ACT), FF};
    pg8::gemm_phase<pg8::EpiSwiGLU, pg8::StaticOrder, PG8_ALIGN, PG8_SP2>(F.lds, g, S, E, F.tid);
}
NI void ph_gemm_store(KArgs a_, int wave0, int which, int M) { KArgs a = a_; asm volatile("" : "+s"(a));
    const Ctx F = make_ctx(wave0);
    const bf16* A = (const bf16*)(a->ws + (which == 0 ? WS_ACT : WS_H));
    const bf16* W = (const bf16*)(a->ws + (which == 0 ? WS_WDN : which == 1 ? WS_WIN : WS_WOUT));
    const int N = which == 1 ? ZPAD : D, K = which == 0 ? FF : D;
    const bool split_ctx = (which != 1) && (M == NROWS);
    const int Mg = split_ctx ? NLAT : M;
    pg8::Gemm g{A, W, Mg, N, K}; pg8::StaticOrder S; S.init(Mg, N, F.G, (int)blockIdx.x);
    pg8::EpiStore E{(bf16*)(a->ws + (which == 1 ? WS_ACT : WS_Y)), which == 1 ? ZP : D, which == 1 ? ZP : D};
    pg8::gemm_phase<pg8::EpiStore, pg8::StaticOrder, PG8_ALIGN, PG8_SP2>(F.lds, g, S, E, F.tid);
    if (split_ctx) { __syncthreads(); ctx_gemm_block(F, A, W, K, (bf16*)(a->ws + WS_Y)); }
}
NI void ph_mla_prep(KArgs a_, int wave0, int l) { KArgs a = a_; asm volatile("" : "+s"(a)); const Ctx F = make_ctx(wave0); for (int tile = F.vcu; tile < NROWS / 64; tile += F.G) mla_prep_tile(a, F, l, tile); }
NI void ph_rwkv(KArgs a_, int wave0, int l, int v) { KArgs a = a_; asm volatile("" : "+s"(a)); const Ctx F = make_ctx(wave0); rwkv_scan_task(a, F, l, v >> 3, (v >> 1) & 3, v & 1); }
NI void ph_mlstm(KArgs a_, int wave0, int l, int idx) { KArgs a = a_; asm volatile("" : "+s"(a)); const Ctx F = make_ctx(wave0); mlstm_task(a, F, l, idx >> 2, idx & 3); __syncthreads(); }
NI void ph_s5(KArgs a_, int wave0, int l, int wg) { KArgs a = a_; asm volatile("" : "+s"(a)); const Ctx F = make_ctx(wave0); const int tk = wg * 8 + F.wave; s5_scan_task(a, l, tk >> 5, (tk >> 4) & 1, tk & 15, (LAS bf16*)(F.lds + F.wave * 8704), F.lane); __syncthreads(); }
NI void ph_attn(KArgs a_, int wave0, int first, int stride) { KArgs a = a_; asm volatile("" : "+s"(a));
    const Ctx F = make_ctx(wave0);
    for (int u = first; u < 512 + 32; u += stride) {
        if (u < 512) { const int b = u >> 6, hd = (u >> 4) & 3, qb = u & 15; attn_unit(a, F, b, hd, b * T + qb * 256, NKEY); }
        else { const int c = u - 512, b = c >> 2, hd = c & 3; attn_unit(a, F, b, hd, NLAT + b * TC, TC); }
    }
}
NI void ph_fin(KArgs a_, int wave0, int l, int M) { KArgs a = a_; asm volatile("" : "+s"(a)); const Ctx F = make_ctx(wave0); fin_load_consts(a, F, l); for (int tile = F.vcu; tile < M / 32; tile += F.G) fin_tile(a, F, l, tile); }


#ifdef DBG_CUT
NI void ph_dump(KArgs a_, int wave0) { KArgs a = a_; asm volatile("" : "+s"(a)); const Ctx F = make_ctx(wave0);
    const float* X = (const float*)(a->ws + WS_X); const bf16* Z = (const bf16*)(a->ws + WS_ACT); const bf16* Q = (const bf16*)(a->ws + WS_Q); const bf16* Kf = (const bf16*)(a->ws + WS_K); const bf16* Vt = (const bf16*)(a->ws + WS_VT);
    const bf16* YS = (const bf16*)(a->ws + WS_YS5); const bf16* YR = (const bf16*)(a->ws + WS_YR); const bf16* YM = (const bf16*)(a->ws + WS_YM); const bf16* MO = (const bf16*)(a->ws + WS_H); const bf16* Y = (const bf16*)(a->ws + WS_Y);
    const size_t DS = (size_t)NROWS * 256;
    for (size_t i = (size_t)F.vcu * NTHR + F.tid; i < (size_t)NLAT * D; i += (size_t)F.G * NTHR) {
#ifdef DBG_CTX
        const size_t r = NLAT + ((i >> 10) % NCTX);
#else
        const size_t r = i >> 10;
#endif
        const int c = (int)(i & 1023); float v = 0.f;
        if (DBG_WHICH & 1) v += X[r * D + c];
        if (DBG_WHICH & 2) { v += bf2f(Z[r * ZP + c]) + bf2f(Z[r * ZP + 1024 + c]); if (c + 2048 < ZP) v += bf2f(Z[r * ZP + 2048 + c]); }
        if (DBG_WHICH & 4) { v += bf2f(Q[r * 384 + c % 384]) + bf2f(Kf[r * 384 + c % 384]) + bf2f(Vt[i % ((size_t)NB * 4 * 64 * NKEY)]); }
        if (DBG_WHICH & 256) v += bf2f(Q[r * 384 + c % 384]);
        if (DBG_WHICH & 512) v += bf2f(Kf[r * 384 + c % 384]);
        if (DBG_WHICH & 1024) v += bf2f(Vt[i % ((size_t)NB * 4 * 64 * NKEY)]);
        if (DBG_WHICH & 2048) { const float* rc = (const float*)(a->ws + WS_ROPE); const bf16* sw = (const bf16*)(a->ws + WS_SMALLW); v += rc[i % (T * 32)] + bf2f(sw[i % 245760]); }
        if (DBG_WHICH & 8) v += bf2f(YS[r * 256 + (c & 255)]) + bf2f(YS[DS + r * 256 + (c & 255)]);
        if (DBG_WHICH & 16) v += bf2f(YR[r * 256 + (c & 255)]) + bf2f(YR[DS + r * 256 + (c & 255)]);
        if (DBG_WHICH & 32) v += bf2f(YM[r * 256 + (c & 255)]) + bf2f(YM[DS + r * 256 + (c & 255)]);
        if (DBG_WHICH & 64) v += bf2f(MO[r * D + c]);
        if (DBG_WHICH & 128) v += bf2f(Y[r * D + c]);
        a->out[i] = v;
    }
}
#endif
#if !MK_SPLIT
#if defined(ONLY_PH)
#define PHON(k) ((k) == ONLY_PH)
#elif defined(NO_PH)
#define PHON(k) ((k) != NO_PH)
#else
#define PHON(k) true
#endif
#if defined(ONLY_ROLE)
#define ROLE(k) ((k) == ONLY_ROLE)
#elif defined(NO_ROLE)
#define ROLE(k) ((k) != NO_ROLE)
#else
#define ROLE(k) true
#endif
#ifdef DUP_ROLE
#ifndef DUP_N
#define DUP_N 2
#endif
#define NREPR(k) ((k) == DUP_ROLE ? DUP_N : 1)
#else
#define NREPR(k) 1
#endif
#ifdef DUP_PH
#define NREP(k) ((k) == DUP_PH ? 2 : 1)
#else
#define NREP(k) 1
#endif
constexpr int NPH = 2 + 12 * DEPTH;
__global__ void __launch_bounds__(NTHR, 2) hybrid_fwd(Args args_byval) {
    KArgs a = (KArgs)__builtin_amdgcn_kernarg_segment_ptr();
    LAS uchar* lds = (LAS uchar*)lds_raw;
    const int tid = threadIdx.x; const int wave0 = __builtin_amdgcn_readfirstlane(tid >> 6);
    volatile LAS unsigned* MISC = (volatile LAS unsigned*)(lds + MISC_OFF);
    for (int u = tid; u < (LDS_BYTES - LDSCTL_OFF) / 4; u += NTHR) ((LAS unsigned*)(lds + LDSCTL_OFF))[u] = 0u;
    __syncthreads();
    unsigned* ctl = (unsigned*)(a->ws + WS_CTL);
    const int use_bar = a->use_bar;
    XcdBarrier bar; bar.bar = ctl + CW_BAR; bar.x = 0; bar.st = nullptr;
    if (use_bar) bar = xcd_barrier_post(ctl + CW_BAR, MISC + 8, tid == 0);
    const int lo = a->ph_lo, hi = a->ph_hi;
    const int G = gridDim.x; const int vcu = (G % 8 == 0) ? ((int)blockIdx.x % 8) * (G / 8) + (int)blockIdx.x / 8 : (int)blockIdx.x;
#ifdef DBG_CUT
#define IN(k) (lo <= (k) && (k) < hi && (k) < DBG_CUT)
#else
#define IN(k) (lo <= (k) && (k) < hi)
#endif
#define SEAM(k) do { if (use_bar && IN(k) && IN((k) + 1)) { int ln_ = __builtin_amdgcn_mbcnt_hi(~0u, __builtin_amdgcn_mbcnt_lo(~0u, 0u)); asm volatile("" : "+v"(ln_)); xcd_barrier(bar, wave0 == 0 && ln_ == 0); } } while (0)
    if (PHON(100) && IN(0)) ph_prologue(a, wave0);
    SEAM(0);
#pragma unroll 1
    for (int l = 0; l < DEPTH; ++l) {
        const int P = 1 + 12 * l;
        const int Mtail = (l == DEPTH - 1) ? NLAT : NROWS;
        if (PHON(0) && IN(P + 0)) { ph_norm(a, wave0, l, 0);
#ifdef DUP_FIRSTNORM
            if (l == 0) for (int rr_ = 0; rr_ < DUP_FIRSTNORM; ++rr_) ph_norm(a, wave0, l, 0);
#endif
        }
        SEAM(P + 0);
        if (PHON(1) && IN(P + 1)) for (int rep_ = 0; rep_ < NREP(1); ++rep_) ph_gemm_swiglu(a, wave0, NROWS);
        SEAM(P + 1);
        if (PHON(2) && IN(P + 2)) for (int rep_ = 0; rep_ < NREP(2); ++rep_) ph_gemm_store(a, wave0, 0, NROWS);
        SEAM(P + 2);
        if (PHON(3) && IN(P + 3)) ph_norm(a, wave0, l, 1);
        SEAM(P + 3);
        if (PHON(4) && IN(P + 4)) for (int rep_ = 0; rep_ < NREP(4); ++rep_) ph_gemm_store(a, wave0, 1, NROWS);
        SEAM(P + 4);
        if (PHON(5) && IN(P + 5)) for (int rep_ = 0; rep_ < NREP(5); ++rep_) ph_mla_prep(a, wave0, l);
        SEAM(P + 5);
        if (PHON(6) && IN(P + 6) && G >= 256) for (int rep_ = 0; rep_ < NREP(6); ++rep_) {
            if (ROLE(0) && vcu < 64) { for (int rr_ = 0; rr_ < NREPR(0); ++rr_) ph_rwkv(a, wave0, l, vcu); }
            else if (ROLE(1) && vcu < 96) { for (int rr_ = 0; rr_ < NREPR(1); ++rr_) ph_mlstm(a, wave0, l, vcu - 64); }
            else if (ROLE(2) && vcu < 128) { for (int rr_ = 0; rr_ < NREPR(2); ++rr_) ph_s5(a, wave0, l, vcu - 96); }
            else if (ROLE(3)) { for (int rr_ = 0; rr_ < NREPR(3); ++rr_) ph_attn(a, wave0, vcu - 128, G - 128); }
        }
        SEAM(P + 6);
        if (PHON(7) && IN(P + 7)) for (int rep_ = 0; rep_ < NREP(7); ++rep_) ph_fin(a, wave0, l, Mtail);
        SEAM(P + 7);
        if (PHON(8) && IN(P + 8)) for (int rep_ = 0; rep_ < NREP(8); ++rep_) ph_gemm_store(a, wave0, 2, Mtail);
        SEAM(P + 8);
        if (PHON(9) && IN(P + 9)) ph_norm(a, wave0, l, 2);
        SEAM(P + 9);
        if (PHON(10) && IN(P + 10)) ph_gemm_swiglu(a, wave0, Mtail);
        SEAM(P + 10);
        if (PHON(11) && IN(P + 11)) ph_gemm_store(a, wave0, 0, Mtail);
        SEAM(P + 11);
    }
#ifdef DBG_CUT
    if (lo <= NPH - 1 && NPH - 1 < hi) ph_dump(a, wave0);
#else
    if (PHON(101) && IN(NPH - 1)) ph_norm(a, wave0, DEPTH - 1, 3);
#endif
#undef IN
#undef SEAM
}

#endif
#if MK_SPLIT
struct ArgsS { Args base; int kind, l, sub, M; };
typedef const __attribute__((address_space(4))) ArgsS* KArgsS;
template <int KIND>
__global__ void __launch_bounds__(NTHR, 2) phase_kernel(ArgsS args_byval) {
    KArgsS as = (KArgsS)__builtin_amdgcn_kernarg_segment_ptr();
    KArgs a = (KArgs)as;
    const int tid = threadIdx.x; const int wave0 = __builtin_amdgcn_readfirstlane(tid >> 6);
    const int l = as->l, sub = as->sub, M = as->M;
    const int G = gridDim.x; const int vcu = (G % 8 == 0) ? ((int)blockIdx.x % 8) * (G / 8) + (int)blockIdx.x / 8 : (int)blockIdx.x;
    if constexpr (KIND == 0) ph_prologue(a, wave0);
    if constexpr (KIND == 1) ph_norm(a, wave0, l, sub);
    if constexpr (KIND == 2) ph_gemm_swiglu(a, wave0, M);
    if constexpr (KIND == 3) ph_gemm_store(a, wave0, sub, M);
    if constexpr (KIND == 4) ph_mla_prep(a, wave0, l);
    if constexpr (KIND == 5) { if (vcu < 64) ph_rwkv(a, wave0, l, vcu); }
    if constexpr (KIND == 6) { if (vcu >= 64 && vcu < 96) ph_mlstm(a, wave0, l, vcu - 64); }
    if constexpr (KIND == 7) { if (vcu >= 96 && vcu < 128) ph_s5(a, wave0, l, vcu - 96); }
    if constexpr (KIND == 8) { if (vcu >= 128) ph_attn(a, wave0, vcu - 128, G - 128); }
    if constexpr (KIND == 9) ph_fin(a, wave0, l, M);
}
template <int KIND> static void launch_phase(int grid, hipStream_t stream, const Args& base, int l, int sub, int M) {
    static bool attr = false;
    if (!attr) { (void)hipFuncSetAttribute((const void*)phase_kernel<KIND>, hipFuncAttributeMaxDynamicSharedMemorySize, LDS_BYTES); attr = true; }
    ArgsS s{}; s.base = base; s.kind = KIND; s.l = l; s.sub = sub; s.M = M;
    hipLaunchKernelGGL(phase_kernel<KIND>, dim3(grid), dim3(NTHR), LDS_BYTES, stream, s);
}
static void launch_split(int grid, hipStream_t stream, const Args& a) {
    launch_phase<0>(grid, stream, a, 0, 0, 0);
    for (int l = 0; l < DEPTH; ++l) {
        const int Mtail = (l == DEPTH - 1) ? NLAT : NROWS;
        launch_phase<1>(grid, stream, a, l, 0, 0);
        launch_phase<2>(grid, stream, a, l, 0, NROWS);
        launch_phase<3>(grid, stream, a, l, 0, NROWS);
        launch_phase<1>(grid, stream, a, l, 1, 0);
        launch_phase<3>(grid, stream, a, l, 1, NROWS);
        launch_phase<4>(grid, stream, a, l, 0, 0);
        launch_phase<5>(grid, stream, a, l, 0, 0);
        launch_phase<6>(grid, stream, a, l, 0, 0);
        launch_phase<7>(grid, stream, a, l, 0, 0);
        launch_phase<8>(grid, stream, a, l, 0, 0);
        launch_phase<9>(grid, stream, a, l, 0, Mtail);
        launch_phase<3>(grid, stream, a, l, 2, Mtail);
        launch_phase<1>(grid, stream, a, l, 2, 0);
        launch_phase<2>(grid, stream, a, l, 0, Mtail);
        launch_phase<3>(grid, stream, a, l, 0, Mtail);
    }
    launch_phase<1>(grid, stream, a, DEPTH - 1, 3, 0);
}
#endif
extern "C" void kernel_launch(void* const* d_in, const int* in_sizes, int n_in, void* d_out, int out_size, void* d_ws, size_t ws_size, hipStream_t stream) {
    static int grid = 0;
    if (grid == 0) {
        if (n_in != 43 || out_size != NLAT * D || ws_size < WS_END) { fprintf(stderr, "kernel_launch: unexpected shapes: n_in %d out %d ws %zu (need %zu)\n", n_in, out_size, ws_size, (size_t)WS_END); grid = -1; return; }
        int dev = 0, cus = 0, per_cu = 0;
        if (hipGetDevice(&dev) != hipSuccess || hipDeviceGetAttribute(&cus, hipDeviceAttributeMultiprocessorCount, dev) != hipSuccess) { grid = -1; return; }
        if (false) { grid = -1; return; }
        (void)hipGetLastError();
        grid = cus;
    }
    if (grid < 0) return;
    (void)hipMemsetAsync((char*)d_ws + WS_CTL, 0, CTL_ZERO_BYTES, stream);
    Args a{};
    for (int i = 0; i < 43; ++i) a.in[i] = (const float*)d_in[i];
    a.out = (float*)d_out; a.ws = (unsigned char*)d_ws; a.pad = 0;
#if MK_SPLIT
    launch_split(grid, stream, a);
#else
    static bool attr1 = false; if (!attr1) { (void)hipFuncSetAttribute((const void*)hybrid_fwd, hipFuncAttributeMaxDynamicSharedMemorySize, LDS_BYTES); attr1 = true; }
    a.ph_lo = 0; a.ph_hi = NPH; a.use_bar = 1;
    hipLaunchKernelGGL(hybrid_fwd, dim3(grid), dim3(NTHR), LDS_BYTES, stream, a);
#endif
}
```

```cpp
#include <hip/hip_runtime.h>
#include <cstdio>
#include <cstdint>
#define MK_SPLIT 0
namespace pg8 {
#define PG8_LAS __attribute__((address_space(3)))
typedef unsigned short bf16_t;
typedef short bf16x8 __attribute__((ext_vector_type(8)));
typedef float f32x4 __attribute__((ext_vector_type(4)));
typedef unsigned u32x4 __attribute__((ext_vector_type(4)));
constexpr int BM = 256, BK = 64, HALF = 128, HTB = HALF * BK * 2  , STAGE_BYTES = 8 * HTB, NXCD = 8, WGM = 8;

__host__ __device__ __forceinline__ int lds_byte(int r, int c) { const int st = (r >> 4) * 2 + (c >> 5), rr = r & 15, cc = c & 31, ob = rr * 64 + cc * 2; return st * 1024 + (ob ^ (((ob >> 9) & 1) << 5)); }
__host__ __device__ __forceinline__ void stage_rc(int b, int& R, int& C) { const int st = b / 1024, sb = b % 1024, swz = sb ^ (((sb >> 9) & 1) << 5); R = (st >> 1) * 16 + swz / 64; C = (st & 1) * 32 + (swz % 64) / 2; }
__host__ __device__ __forceinline__ int perm32(int rho) { const int n = rho >> 4, i = rho & 15; return 8 * (i >> 2) + 4 * n + (i & 3); }

struct Unit { int pm, pn; };
struct Gemm { const bf16_t* A; const bf16_t* Bt; int M, N, K; };

struct StaticOrder {
    int nM, nN, nwg, G, c;
    __host__ __device__ void init(int M, int N, int G_, int c_) { nM = M / BM; nN = N / BM; nwg = nM * nN; G = G_; c = c_; }
    __host__ __device__ bool next(int i, Unit& u) const {
        const long L = (long)i * G + c; if (L >= nwg) return false;
        int wgid = (int)L; { const int q = nwg / NXCD, r = nwg % NXCD, xcd = wgid % NXCD, off = wgid / NXCD; wgid = (xcd < r ? xcd * (q + 1) : r * (q + 1) + (xcd - r) * q) + off; }
        const int nig = WGM * nN, gid = wgid / nig, fm = gid * WGM, gsz = (nM - fm) < WGM ? (nM - fm) : WGM;
        u.pm = fm + ((wgid % nig) % gsz); u.pn = (wgid % nig) / gsz; return true;
    }
    __device__ __forceinline__ void a_ready(const Unit&) const {}
    __device__ __forceinline__ void done(const Unit&) const {}
};

typedef __bf16 nbf16v2 __attribute__((ext_vector_type(2))); typedef float nf32v2 __attribute__((ext_vector_type(2)));
__device__ __forceinline__ unsigned cvt_pk_bf16(float lo, float hi) { const nf32v2 v = {lo, hi}; return __builtin_bit_cast(unsigned, __builtin_convertvector(v, nbf16v2)); }
struct EpiSwiGLU {
    static constexpr bool PERM = true, AFTER_DRAIN = false;
    bf16_t* O; int ldc;
    __device__ __forceinline__ void operator()(const f32x4 (&acc)[2][2][4][2], const Unit& u, int wr, int wc, int fr, int fq) const {
        const int row0 = u.pm * BM + wr * 64 + fr; const int col0 = u.pn * HALF + wc * 32 + 8 * fq;
#pragma unroll
        for (int ai = 0; ai < 2; ++ai)
#pragma unroll
            for (int m = 0; m < 4; ++m) { bf16_t* rowp = O + (size_t)(row0 + ai * HALF + m * 16) * ldc + col0;
                float o[8];
#pragma unroll
                for (int n = 0; n < 2; ++n)
#pragma unroll
                    for (int j = 0; j < 4; ++j) { const float g = acc[ai][0][m][n][j], up = acc[ai][1][m][n][j];
                        const float sg = __builtin_amdgcn_rcpf(1.0f + __builtin_amdgcn_exp2f(-1.44269504089f * g)); o[n * 4 + j] = g * sg * up; }
                u32x4 w; w.x = cvt_pk_bf16(o[0], o[1]); w.y = cvt_pk_bf16(o[2], o[3]); w.z = cvt_pk_bf16(o[4], o[5]); w.w = cvt_pk_bf16(o[6], o[7]);
                *(u32x4*)rowp = w; }
    }
};
struct EpiStore {
    static constexpr bool PERM = true, AFTER_DRAIN = false;
    bf16_t* O; int ldc; int ncols;
    __device__ __forceinline__ void operator()(const f32x4 (&acc)[2][2][4][2], const Unit& u, int wr, int wc, int fr, int fq) const {
        const int row0 = u.pm * BM + wr * 64 + fr; const int col0 = u.pn * BM + wc * 32 + 8 * fq;
#pragma unroll
        for (int ai = 0; ai < 2; ++ai)
#pragma unroll
            for (int m = 0; m < 4; ++m) { bf16_t* rowp = O + (size_t)(row0 + ai * HALF + m * 16) * ldc + col0;
#pragma unroll
                for (int bj = 0; bj < 2; ++bj) { if (col0 + bj * HALF < ncols) { const f32x4 v0 = acc[ai][bj][m][0], v1 = acc[ai][bj][m][1];
                    u32x4 w; w.x = cvt_pk_bf16(v0[0], v0[1]); w.y = cvt_pk_bf16(v0[2], v0[3]); w.z = cvt_pk_bf16(v1[0], v1[1]); w.w = cvt_pk_bf16(v1[2], v1[3]);
                    *(u32x4*)(rowp + bj * HALF) = w; } } }
    }
};
template <class Epi, class Sched, bool ALIGN_EPI = false, bool SP2 = false>
__device__ __forceinline__ void gemm_phase(PG8_LAS unsigned char* lds, const Gemm g, const Sched& S, const Epi& E, const int tid) {
    const int wid = __builtin_amdgcn_readfirstlane(tid >> 6), lane = tid & 63, wr = wid >> 2, wc = wid & 3, fr = lane & 15, fq = lane >> 4;
    const int K = g.K, nt = K / BK;
    unsigned voffA[2], voffB[2];
#pragma unroll
    for (int i = 0; i < 2; ++i) { int R, C; stage_rc(tid * 16 + i * 8192, R, C); const int Rb = Epi::PERM ? ((R & ~31) + perm32(R & 31)) : R;
        voffA[i] = (unsigned)(R * K + C) * 2u; voffB[i] = (unsigned)(Rb * K + C) * 2u; }
    const size_t kstep = (size_t)(BK * 2);
    const size_t hstep = (size_t)HALF * K * 2;
    const size_t tstep = 2 * hstep;
    const unsigned ldsw = (unsigned)wid * 1024u;
    const int aoff = lds_byte(wr * 64 + fr, fq * 8), boff = lds_byte(wc * 32 + fr, fq * 8);
#define PG8_SA(b, h) (((b) * 2 + (h)) * HTB)
#define PG8_SB(b, h) ((4 + (b) * 2 + (h)) * HTB)
#define PG8_STAGE(bufoff, gbase, voff) do { _Pragma("unroll") for (int _i = 0; _i < 2; ++_i) \
        __builtin_amdgcn_global_load_lds((const unsigned*)((const char*)(gbase) + (voff)[_i]), (PG8_LAS unsigned*)(lds + (bufoff) + ldsw + _i * 8192), 16, 0, 0); } while (0)
#define PG8_LDA(dst, b, h) do { _Pragma("unroll") for (int m = 0; m < 4; ++m) _Pragma("unroll") for (int k = 0; k < 2; ++k) dst[m][k] = *(const PG8_LAS bf16x8*)(lds + PG8_SA(b, h) + aoff + m * 2048 + k * 1024); } while (0)
#define PG8_LDB(dst, b, h) do { _Pragma("unroll") for (int n = 0; n < 2; ++n) _Pragma("unroll") for (int k = 0; k < 2; ++k) dst[n][k] = *(const PG8_LAS bf16x8*)(lds + PG8_SB(b, h) + boff + n * 2048 + k * 1024); } while (0)
#define PG8_MMA(ai, bj, At, Bt) do { __builtin_amdgcn_s_setprio(1); _Pragma("unroll") for (int m = 0; m < 4; ++m) _Pragma("unroll") for (int n = 0; n < 2; ++n) _Pragma("unroll") for (int k = 0; k < 2; ++k) \
        acc[ai][bj][m][n] = __builtin_amdgcn_mfma_f32_16x16x32_bf16(Bt[n][k], At[m][k], acc[ai][bj][m][n], 0, 0, 0); __builtin_amdgcn_s_setprio(0); } while (0)
#define PG8_WAIT_V(n) asm volatile("s_waitcnt vmcnt(" #n ")" ::: "memory")
#define PG8_WAIT_L(n) asm volatile("s_waitcnt lgkmcnt(" #n ")" ::: "memory")
#define PG8_BAR __builtin_amdgcn_s_barrier()
#define PG8_SCHED __builtin_amdgcn_sched_barrier(0)
    Unit cur, nxt; int ui = 0;
    if (!S.next(0, cur)) return;
    f32x4 acc[2][2][4][2];
#pragma unroll
    for (int a = 0; a < 2; ++a)
#pragma unroll
        for (int b = 0; b < 2; ++b)
#pragma unroll
            for (int m = 0; m < 4; ++m)
#pragma unroll
                for (int n = 0; n < 2; ++n) acc[a][b][m][n] = (f32x4){0.f, 0.f, 0.f, 0.f};
    bf16x8 At[4][2], B0[2][2], B1[2][2];
    const char* cA = (const char*)g.A + (size_t)cur.pm * tstep; const char* cB = (const char*)g.Bt + (size_t)cur.pn * tstep;
    S.a_ready(cur);
    if constexpr (SP2) {
        PG8_STAGE(PG8_SB(0, 0), cB, voffB); PG8_STAGE(PG8_SB(0, 1), cB + hstep, voffB); PG8_STAGE(PG8_SA(0, 0), cA, voffA); PG8_STAGE(PG8_SA(0, 1), cA + hstep, voffA);
        if (wr == 1) PG8_BAR;
        PG8_WAIT_V(2); PG8_BAR;
        PG8_STAGE(PG8_SB(1, 0), cB + kstep, voffB); PG8_STAGE(PG8_SA(1, 0), cA + kstep, voffA); PG8_STAGE(PG8_SB(1, 1), cB + hstep + kstep, voffB);
        PG8_WAIT_V(6); PG8_BAR;
    } else {
        PG8_STAGE(PG8_SB(0, 0), cB, voffB); PG8_STAGE(PG8_SA(0, 0), cA, voffA); PG8_STAGE(PG8_SB(0, 1), cB + hstep, voffB); PG8_STAGE(PG8_SA(0, 1), cA + hstep, voffA);
        if (wr == 1) PG8_BAR;
        PG8_WAIT_V(4); PG8_BAR;
        PG8_STAGE(PG8_SB(1, 0), cB + kstep, voffB); PG8_STAGE(PG8_SA(1, 0), cA + kstep, voffA); PG8_STAGE(PG8_SB(1, 1), cB + hstep + kstep, voffB);
        PG8_WAIT_V(6); PG8_BAR;
    }
    for (;;) {
        const bool has_next = S.next(ui + 1, nxt);
        const char* nA = has_next ? (const char*)g.A + (size_t)nxt.pm * tstep : cA; const char* nB = has_next ? (const char*)g.Bt + (size_t)nxt.pn * tstep : cB;
        for (int t = 0; t < nt; t += 2) {
            const bool last = (t == nt - 2);
            const char* a1 = cA + (size_t)(t + 1) * kstep;
            const char* a2 = last ? nA : cA + (size_t)(t + 2) * kstep; const char* b2 = last ? nB : cB + (size_t)(t + 2) * kstep;
            const char* a3 = a2 + kstep; const char* b3 = b2 + kstep;
            if (last && has_next) S.a_ready(nxt);
            if constexpr (SP2) {
            PG8_LDB(B0, 0, 0); PG8_LDB(B1, 0, 1); PG8_SCHED; PG8_LDA(At, 0, 0); PG8_STAGE(PG8_SA(1, 1), a1 + hstep, voffA);
            PG8_WAIT_V(8); PG8_WAIT_L(0); PG8_BAR; PG8_MMA(0, 0, At, B0); PG8_MMA(0, 1, At, B1); PG8_BAR; PG8_SCHED;
            PG8_LDA(At, 0, 1); PG8_STAGE(PG8_SB(0, 0), b2, voffB); PG8_STAGE(PG8_SB(0, 1), b2 + hstep, voffB); PG8_STAGE(PG8_SA(0, 0), a2, voffA);
            PG8_WAIT_V(8); PG8_WAIT_L(0); PG8_BAR; PG8_MMA(1, 0, At, B0); PG8_MMA(1, 1, At, B1); PG8_BAR; PG8_SCHED;
            PG8_LDB(B0, 1, 0); PG8_LDB(B1, 1, 1); PG8_SCHED; PG8_LDA(At, 1, 0); PG8_STAGE(PG8_SA(0, 1), a2 + hstep, voffA);
            PG8_WAIT_V(8); PG8_WAIT_L(0); PG8_BAR; PG8_MMA(0, 0, At, B0); PG8_MMA(0, 1, At, B1); PG8_BAR; PG8_SCHED;
            PG8_LDA(At, 1, 1); PG8_STAGE(PG8_SB(1, 0), b3, voffB); PG8_STAGE(PG8_SB(1, 1), b3 + hstep, voffB); PG8_STAGE(PG8_SA(1, 0), a3, voffA);
            PG8_WAIT_V(8); PG8_WAIT_L(0); PG8_BAR; PG8_MMA(1, 0, At, B0); PG8_MMA(1, 1, At, B1); PG8_BAR; PG8_SCHED;
            } else {
            PG8_LDB(B0, 0, 0); PG8_SCHED; PG8_LDA(At, 0, 0); PG8_STAGE(PG8_SA(1, 1), a1 + hstep, voffA);
            PG8_WAIT_L(8); PG8_BAR; PG8_WAIT_L(0); PG8_MMA(0, 0, At, B0); PG8_BAR; PG8_SCHED;
            PG8_LDB(B1, 0, 1); PG8_STAGE(PG8_SB(0, 0), b2, voffB);
            PG8_BAR; PG8_WAIT_L(0); PG8_MMA(0, 1, At, B1); PG8_BAR;
            PG8_LDA(At, 0, 1); PG8_STAGE(PG8_SA(0, 0), a2, voffA);
            PG8_BAR; PG8_WAIT_L(0); PG8_MMA(1, 0, At, B0); PG8_BAR; PG8_SCHED;
            PG8_STAGE(PG8_SB(0, 1), b2 + hstep, voffB);
            PG8_WAIT_V(6); PG8_BAR; PG8_MMA(1, 1, At, B1); PG8_BAR;
            PG8_LDB(B0, 1, 0); PG8_SCHED; PG8_LDA(At, 1, 0); PG8_STAGE(PG8_SA(0, 1), a2 + hstep, voffA);
            PG8_WAIT_L(8); PG8_BAR; PG8_WAIT_L(0); PG8_MMA(0, 0, At, B0); PG8_BAR; PG8_SCHED;
            PG8_LDB(B1, 1, 1); PG8_STAGE(PG8_SB(1, 0), b3, voffB);
            PG8_BAR; PG8_WAIT_L(0); PG8_MMA(0, 1, At, B1); PG8_BAR;
            PG8_LDA(At, 1, 1); PG8_STAGE(PG8_SA(1, 0), a3, voffA);
            PG8_BAR; PG8_WAIT_L(0); PG8_MMA(1, 0, At, B0); PG8_BAR; PG8_SCHED;
            PG8_STAGE(PG8_SB(1, 1), b3 + hstep, voffB);
            PG8_WAIT_V(6); PG8_BAR; PG8_MMA(1, 1, At, B1); PG8_BAR;
            }
        }
        if constexpr (ALIGN_EPI) { if (wr == 0) PG8_BAR; }
        if constexpr (!Epi::AFTER_DRAIN) { E(acc, cur, wr, wc, fr, fq); S.done(cur); }
        if (!has_next) break;
#pragma unroll
        for (int a = 0; a < 2; ++a)
#pragma unroll
            for (int b = 0; b < 2; ++b)
#pragma unroll
                for (int m = 0; m < 4; ++m)
#pragma unroll
                    for (int n = 0; n < 2; ++n) acc[a][b][m][n] = (f32x4){0.f, 0.f, 0.f, 0.f};
        cur = nxt; cA = nA; cB = nB; ++ui;
        if constexpr (ALIGN_EPI) { if (wr == 1) PG8_BAR; }
    }
    PG8_WAIT_V(0);
    if constexpr (!ALIGN_EPI) { if (wr == 0) PG8_BAR; }
    PG8_BAR;
    if constexpr (Epi::AFTER_DRAIN) { E.fused(acc, cur, wr, wc, fr, fq, lds, wid, lane); S.done(cur); }
#undef PG8_SA
#undef PG8_SB
#undef PG8_STAGE
#undef PG8_LDA
#undef PG8_LDB
#undef PG8_MMA
#undef PG8_WAIT_V
#undef PG8_WAIT_L
#undef PG8_BAR
#undef PG8_SCHED
}
}
#ifndef PG8_SP2
#define PG8_SP2 true
#endif
#ifndef PG8_ALIGN
#define PG8_ALIGN true
#endif

constexpr int NWAVES = 8, NTHR = 512;
constexpr int D = 1024, NB = 8, T = 4096, TC = 256, DEPTH = 4, FF = 2816, ZP = 2608, ZPAD = 2816;
constexpr int NLAT = NB * T, NCTX = NB * TC, NROWS = NLAT + NCTX;
constexpr int MODW = 9 * D;
constexpr int NKEY = TC + T;
constexpr float NORM_EPS = 1e-6f;
constexpr int ZS5 = 0, ZCQ = 256, ZCKV = 512, ZKR = 640, ZRKV = 672, ZWD = 1440, ZAD = 1472, ZGD = 1504, ZMQK = 1568, ZMV = 2080, ZMO = 2336, ZMG = 2592;

constexpr size_t MiB = 1u << 20;
constexpr size_t WS_CTL = 0, CTL_ZERO_BYTES = 1 * MiB;
constexpr size_t WS_MODV = 1 * MiB;
constexpr size_t WS_ROPE = 3 * MiB;
constexpr size_t WS_SMALLW = 4 * MiB;
constexpr size_t SW_UQ = 0, SW_UKV = 196608, SW_GLU = 327680, SW_GUP = 458752;
constexpr size_t WS_WGU = 6 * MiB, WS_WDN = 17 * MiB, WS_WIN = 23 * MiB, WS_WOUT = 29 * MiB;
constexpr size_t WS_X = 31 * MiB;
constexpr size_t WS_Y = 167 * MiB;
constexpr size_t WS_Q = WS_Y, WS_K = WS_Y + (size_t)NROWS * 384 * 2, WS_VT = WS_K + (size_t)NROWS * 384 * 2;
constexpr size_t WS_H = 235 * MiB;
constexpr size_t WS_ACT = 303 * MiB;
constexpr size_t WS_YS5 = 490 * MiB, WS_YR = 524 * MiB, WS_YM = 558 * MiB, WS_END = 592 * MiB;
static_assert(WS_VT + (size_t)NB * 4 * 64 * NKEY * 2 <= WS_H, "qkv overlay");
static_assert(WS_WGU + (size_t)5632 * 1024 * 2 <= WS_WDN && WS_WDN + (size_t)1024 * 2816 * 2 <= WS_WIN && WS_WIN + (size_t)2816 * 1024 * 2 <= WS_WOUT && WS_WOUT + 2 * MiB <= WS_X, "weights");
static_assert(WS_X + (size_t)NROWS * D * 4 <= WS_Y && WS_Y + (size_t)NROWS * D * 2 <= WS_H && WS_H + (size_t)NROWS * D * 2 <= WS_ACT && WS_ACT + (size_t)NROWS * ZPAD * 2 <= WS_YS5, "map");
static_assert(WS_YS5 + (size_t)2 * NROWS * 256 * 2 <= WS_YR && WS_YM + (size_t)2 * NROWS * 256 * 2 <= WS_END, "map2");
constexpr int CW_BAR = 4096, CW_SUB = 8192;

constexpr int RING_BYTES = 131072, LDS_BYTES = 147456, LDSCTL_OFF = LDS_BYTES - 512, MISC_OFF = LDSCTL_OFF + 320;

#define GAS __attribute__((address_space(1)))
#define LAS __attribute__((address_space(3)))
typedef unsigned short bf16;
typedef unsigned char uchar;
typedef unsigned v4u __attribute__((ext_vector_type(4)));
typedef unsigned v2u __attribute__((ext_vector_type(2)));
typedef float f32x4 __attribute__((ext_vector_type(4)));
typedef float f32x16 __attribute__((ext_vector_type(16)));
typedef short bf16x8 __attribute__((ext_vector_type(8)));
typedef short bf16x4 __attribute__((ext_vector_type(4)));
#define DI __device__ __forceinline__
DI unsigned f2bf(float f) { unsigned u = __builtin_bit_cast(unsigned, f); return (u + 0x7fffu + ((u >> 16) & 1u)) >> 16; }
DI unsigned pk2(float lo, float hi) { return pg8::cvt_pk_bf16(lo, hi); }
DI float bf2f(unsigned b) { return __builtin_bit_cast(float, b << 16); }
DI float bflo(unsigned w) { return __builtin_bit_cast(float, w << 16); }
DI float bfhi(unsigned w) { return __builtin_bit_cast(float, w & 0xffff0000u); }
template <int CTRL> DI float dpp_f(float x) { return __builtin_bit_cast(float, __builtin_amdgcn_update_dpp(0, __builtin_bit_cast(int, x), CTRL, 0xf, 0xf, true)); }
DI float sum8(float x) { x += dpp_f<0xB1>(x); x += dpp_f<0x4E>(x); x += dpp_f<0x141>(x); return x; }
DI float sum16(float x) { x = sum8(x); x += dpp_f<0x140>(x); return x; }
template <int CTRL, int RM> DI float dpp_z(float x) { return __builtin_bit_cast(float, __builtin_amdgcn_update_dpp(0, __builtin_bit_cast(int, x), CTRL, RM, 0xf, true)); }
template <int CTRL, int RM> DI float dpp_o(float old, float x) { return __builtin_bit_cast(float, __builtin_amdgcn_update_dpp(__builtin_bit_cast(int, old), __builtin_bit_cast(int, x), CTRL, RM, 0xf, false)); }
DI float wave_scan_sum(float x) {
    x += dpp_z<0x111, 0xf>(x); x += dpp_z<0x112, 0xf>(x); x += dpp_z<0x114, 0xf>(x); x += dpp_z<0x118, 0xf>(x);
    x += dpp_z<0x142, 0xa>(x); x += dpp_z<0x143, 0xc>(x); return x;
}
DI float wave_scan_max(float x) {
    const float ninf = -3.0e38f;
    x = fmaxf(x, dpp_o<0x111, 0xf>(ninf, x)); x = fmaxf(x, dpp_o<0x112, 0xf>(ninf, x)); x = fmaxf(x, dpp_o<0x114, 0xf>(ninf, x)); x = fmaxf(x, dpp_o<0x118, 0xf>(ninf, x));
    x = fmaxf(x, dpp_o<0x142, 0xa>(ninf, x)); x = fmaxf(x, dpp_o<0x143, 0xc>(ninf, x)); return x;
}
DI float wave_sum(float v) { v = sum16(v); v += __shfl_xor(v, 16); v += __shfl_xor(v, 32); return v; }
DI float wave_max(float v) {
#pragma unroll
    for (int o = 1; o < 64; o <<= 1) v = fmaxf(v, __shfl_xor(v, o));
    return v;
}
DI void lds_barrier() { asm volatile("s_waitcnt lgkmcnt(0)" ::: "memory"); __builtin_amdgcn_s_barrier(); asm volatile("" ::: "memory"); }
DI float fexp(float x) { return __builtin_amdgcn_exp2f(x * 1.44269504089f); }
DI float fsigmoid(float x) { return __builtin_amdgcn_rcpf(1.0f + fexp(-x)); }
DI f32x16 mfma32(bf16x8 a, bf16x8 b, f32x16 c) { return __builtin_amdgcn_mfma_f32_32x32x16_bf16(a, b, c, 0, 0, 0); }
DI f32x4 mfma16(bf16x8 a, bf16x8 b, f32x4 c) { return __builtin_amdgcn_mfma_f32_16x16x32_bf16(a, b, c, 0, 0, 0); }
DI int crow(int r, int h) { return (r & 3) + 8 * (r >> 2) + 4 * h; }
DI bf16x8 pack8(float a0, float a1, float a2, float a3, float a4, float a5, float a6, float a7) {
    typedef __bf16 nb8 __attribute__((ext_vector_type(8))); typedef float nf8 __attribute__((ext_vector_type(8)));
    const nf8 v = {a0, a1, a2, a3, a4, a5, a6, a7}; return __builtin_bit_cast(bf16x8, __builtin_convertvector(v, nb8));
}
DI void my_sincosf(float x, float& s, float& c) {
    const float k = __builtin_rintf(x * 0.63661977236758134f);
    float r = __builtin_fmaf(-k, 1.5703125f, x); r = __builtin_fmaf(-k, 4.837512969970703125e-4f, r); r = __builtin_fmaf(-k, 7.54978995489188216e-8f, r);
    const float r2 = r * r;
    const float ps = r + r * r2 * (-1.6666654611e-1f + r2 * (8.3321608736e-3f + r2 * (-1.9515295891e-4f)));
    const float pc = 1.0f - 0.5f * r2 + r2 * r2 * (4.166664568298827e-2f + r2 * (-1.388731625493765e-3f + r2 * 2.443315711809948e-5f));
    const int q = ((int)k) & 3;
    const float ss = (q & 1) ? pc : ps, cc = (q & 1) ? ps : pc;
    s = (q & 2) ? -ss : ss; c = ((q + 1) & 2) ? -cc : cc;
}

#define XB_TMO      128
#define XB_XCNT(j)  (256  + 64 * (j))
#define XB_XSUB(j)  (1280 + 64 * (j))
#define XB_XGEN(j)  (2304 + 64 * (j))
#define XB_TOP      3328
#define XB_TOPGEN   3392
#define XCD_BAR_WORDS 3456
#define XB_SPIN_CAP (1u << 22)
DI unsigned xb_ld(unsigned* p)              { return __hip_atomic_load(p, __ATOMIC_RELAXED, __HIP_MEMORY_SCOPE_AGENT); }
DI unsigned xb_add(unsigned* p, unsigned v) { return __hip_atomic_fetch_add(p, v, __ATOMIC_RELAXED, __HIP_MEMORY_SCOPE_AGENT); }
DI unsigned xb_xcc_id() { return (unsigned)__builtin_amdgcn_s_getreg((3 << 11) | 20) & 0xFu; }
#define XB_SPIN(cond, bar) do { unsigned _sp = 0; while (cond) { __builtin_amdgcn_s_sleep(1); \
    if ((++_sp & 255u) == 0u) { if (xb_ld(&(bar)[XB_TMO])) break; if (_sp > XB_SPIN_CAP) { atomicAdd(&(bar)[XB_TMO], 1u); break; } } } } while (0)
struct XcdBarrier { unsigned* bar; unsigned x; volatile LAS unsigned* st; };
DI XcdBarrier xcd_barrier_post(unsigned* bar, volatile LAS unsigned* st, bool t0) {
    XcdBarrier b; b.bar = bar; b.x = xb_xcc_id(); b.st = st;
    if (t0) (void)xb_add(&bar[XB_XCNT(b.x)], 1u);
    return b;
}
DI void xcd_barrier_complete(unsigned* bar, unsigned x, unsigned& nloc, unsigned& nx) {
    const unsigned G = gridDim.x * gridDim.y * gridDim.z;
    unsigned sum, cnt, mine, sp = 0u;
    for (;;) {
        sum = 0u; cnt = 0u; mine = 0u;
#pragma unroll
        for (unsigned j = 0; j < 16; ++j) { const unsigned c = xb_ld(&bar[XB_XCNT(j)]); sum += c; cnt += (c > 0u) ? 1u : 0u; mine = (j == x) ? c : mine; }
        if (sum == G) break;
        __builtin_amdgcn_s_sleep(1);
        if ((++sp & 255u) == 0u) { if (xb_ld(&bar[XB_TMO])) break; if (sp > XB_SPIN_CAP) { atomicAdd(&bar[XB_TMO], 1u); break; } }
    }
    nloc = mine > 0u ? mine : 1u; nx = cnt > 0u ? cnt : 1u;
}
DI void xcd_barrier(const XcdBarrier& b, bool t0) {
    asm volatile("s_waitcnt vmcnt(0)" ::: "memory");
    __syncthreads();
    if (t0) {
        unsigned* bar = b.bar;
        __builtin_amdgcn_s_waitcnt(0);
        unsigned nloc = b.st[0], nx = b.st[1];
        if (nloc == 0u) { xcd_barrier_complete(bar, b.x, nloc, nx); b.st[0] = nloc; b.st[1] = nx; }
        const unsigned old = xb_add(&bar[XB_XSUB(b.x)], 1u);
        const unsigned gen = old / nloc;
        if (old + 1u == (gen + 1u) * nloc) {
            __builtin_amdgcn_fence(__ATOMIC_RELEASE, "agent");
            asm volatile("s_waitcnt vmcnt(0)" ::: "memory");
            const unsigned og = xb_add(&bar[XB_TOP], 1u);
            const unsigned tg = og / nx;
            if (og + 1u == (tg + 1u) * nx) xb_add(&bar[XB_TOPGEN], 1u);
            else XB_SPIN(xb_ld(&bar[XB_TOPGEN]) == tg, bar);
            __builtin_amdgcn_fence(__ATOMIC_ACQUIRE, "agent");
            xb_add(&bar[XB_XGEN(b.x)], 1u);
            asm volatile("s_waitcnt vmcnt(0)" ::: "memory");
        } else {
            XB_SPIN(xb_ld(&bar[XB_XGEN(b.x)]) == gen, bar);
            __builtin_amdgcn_fence(__ATOMIC_ACQUIRE, "agent");
            asm volatile("s_waitcnt vmcnt(0)" ::: "memory");
        }
    }
    __syncthreads();
}

struct Args { const float* in[43]; float* out; unsigned char* ws; int ph_lo, ph_hi, use_bar, pad; };
typedef const __attribute__((address_space(4))) Args* KArgs;
enum { I_X = 0, I_C, I_CTX, I_CCTX, I_WADA, I_BADA, I_NPRE, I_NPOST, I_WG, I_WU, I_WD, I_WIN, I_WOUT, I_S5LRE, I_S5LIM, I_S5DT, I_S5BRE, I_S5BIM, I_S5CRE, I_S5CIM, I_S5D, I_S5GLU, I_S5BGLU,
       I_MQN, I_MKVN, I_MUQ, I_MUKV, I_RCW, I_RCB, I_RW0, I_RWUP, I_RA0, I_RAUP, I_RGUP, I_RKK, I_RKA, I_RRK, I_RLNW, I_RLNB, I_MCW, I_MCB, I_MGB, I_MNORM };

struct Ctx {
    LAS uchar* lds; int tid, lane, wave, vcu, G;
};
DI int tok_row(int b, int seg, int t) { return seg ? b * T + t : NLAT + b * TC + t; }
DI void phase_prologue(KArgs a, const Ctx& F) {
    LAS float* sc = (LAS float*)F.lds;
    LAS float* red = (LAS float*)(F.lds + 40960);
    const float* c = a->in[I_C]; const float* cc = a->in[I_CCTX];
    for (int i = F.tid; i < 9 * D; i += NTHR) { const float v = (i < 8 * D) ? c[i] : cc[i - 8 * D]; sc[i] = v * fsigmoid(v); }
    __syncthreads();
    const float* wada = a->in[I_WADA]; const float* bada = a->in[I_BADA];
    float* modv = (float*)(a->ws + WS_MODV);
    for (int task = F.vcu; task < DEPTH * 144; task += F.G) {
        const int l = task / 144, nb = task % 144, n = nb * 64 + F.lane;
        const float* wp = wada + ((size_t)l * D + F.wave * 128) * MODW + n;
        float acc[9];
#pragma unroll
        for (int m = 0; m < 9; ++m) acc[m] = 0.f;
#pragma unroll 8
        for (int k = 0; k < 128; ++k) { const float w = wp[(size_t)k * MODW];
#pragma unroll
            for (int m = 0; m < 9; ++m) acc[m] += sc[m * D + F.wave * 128 + k] * w; }
#pragma unroll
        for (int m = 0; m < 9; ++m) red[(F.wave * 9 + m) * 64 + F.lane] = acc[m];
        __syncthreads();
        for (int i = F.tid; i < 576; i += NTHR) { const int m = i >> 6, ln = i & 63; float s = 0.f;
#pragma unroll
            for (int w = 0; w < 8; ++w) s += red[(w * 9 + m) * 64 + ln];
            modv[((size_t)l * 9 + m) * MODW + nb * 64 + ln] = s + bada[l * MODW + nb * 64 + ln]; }
        __syncthreads();
    }
    float* rc = (float*)(a->ws + WS_ROPE); float* rs = rc + T * 16;
    for (int i = F.vcu * NTHR + F.tid; i < T * 16; i += F.G * NTHR) {
        const int t = i >> 4, f = i & 15, pos = f < 8 ? (t >> 6) : (t & 63), fi = f & 7;
        const float invf = (fi == 0) ? 1.0f : (fi == 1) ? 0.31622776601683794f : (fi == 2) ? 0.1f : (fi == 3) ? 0.031622776601683794f : (fi == 4) ? 0.01f : (fi == 5) ? 0.0031622776601683794f : (fi == 6) ? 0.001f : 0.00031622776601683794f;
        const float ang = (float)pos * invf; float s, co; my_sincosf(ang, s, co);
        rc[i] = co; rs[i] = s;
    }
}

DI void tr_item(const float* W, int K, int N, bf16* WT, int kb, int n0, int drow0, LAS float* scr, int lane) {
    const int k0 = 64 * kb, nn = n0 + (lane & 31);
#pragma unroll 8
    for (int i = 0; i < 32; ++i) { const int kk = 2 * i + (lane >> 5); scr[kk * 33 + (lane & 31)] = (nn < N) ? W[(size_t)(k0 + kk) * N + nn] : 0.f; }
    const int c = lane & 7;
#pragma unroll
    for (int j = 0; j < 4; ++j) { const int n = (lane >> 3) + 8 * j; const LAS float* s = scr + (8 * c) * 33 + n;
        v4u o; o.x = pk2(s[0 * 33], s[1 * 33]); o.y = pk2(s[2 * 33], s[3 * 33]); o.z = pk2(s[4 * 33], s[5 * 33]); o.w = pk2(s[6 * 33], s[7 * 33]);
        if (n0 + n < N) *(v4u*)(WT + (size_t)(drow0 + n) * K + k0 + 8 * c) = o; }
}
DI void convert_weights(KArgs a, const Ctx& F, int l, int set) {
    LAS float* scr = (LAS float*)(F.lds + F.wave * 8704);
    const int gw = F.vcu * NWAVES + F.wave, NGW = F.G * NWAVES;
    bf16* WGU = (bf16*)(a->ws + WS_WGU); bf16* WDN = (bf16*)(a->ws + WS_WDN); bf16* WIN = (bf16*)(a->ws + WS_WIN); bf16* WOUT = (bf16*)(a->ws + WS_WOUT);
    bf16* SW = (bf16*)(a->ws + WS_SMALLW);
    const int fl = l * 2 + set;
    const float* wg = a->in[I_WG] + (size_t)fl * D * FF; const float* wu = a->in[I_WU] + (size_t)fl * D * FF; const float* wd = a->in[I_WD] + (size_t)fl * FF * D;
    constexpr int I_G = 16 * 88, I_D = 44 * 32, I_IN = 16 * 82, I_O = 16 * 32, I_UQ = 4 * 12, I_UKV = 2 * 16, I_GLU = 4 * 8, I_GUP = 1 * 8;
    const int nitems = set == 0 ? (2 * I_G + I_D + I_IN + I_O + I_UQ + I_UKV + I_GLU + I_GUP) : (2 * I_G + I_D);
    for (int it = gw; it < nitems; it += NGW) {
        int r = it;
        if (r < I_G) { const int kb = r / 88, nb = r % 88, n0 = 32 * nb; tr_item(wg, D, FF, WGU, kb, n0, 256 * (n0 >> 7) + (n0 & 127), scr, F.lane); continue; } r -= I_G;
        if (r < I_G) { const int kb = r / 88, nb = r % 88, n0 = 32 * nb; tr_item(wu, D, FF, WGU, kb, n0, 256 * (n0 >> 7) + 128 + (n0 & 127), scr, F.lane); continue; } r -= I_G;
        if (r < I_D) { const int kb = r / 32, nb = r % 32; tr_item(wd, FF, D, WDN, kb, 32 * nb, 32 * nb, scr, F.lane); continue; } r -= I_D;
        if (r < I_IN) { const int kb = r / 82, nb = r % 82; tr_item(a->in[I_WIN] + (size_t)l * D * ZP, D, ZP, WIN, kb, 32 * nb, 32 * nb, scr, F.lane); continue; } r -= I_IN;
        if (r < I_O) { const int kb = r / 32, nb = r % 32; tr_item(a->in[I_WOUT] + (size_t)l * D * D, D, D, WOUT, kb, 32 * nb, 32 * nb, scr, F.lane); continue; } r -= I_O;
        if (r < I_UQ) { const int kb = r / 12, nb = r % 12; tr_item(a->in[I_MUQ] + (size_t)l * 256 * 384, 256, 384, (bf16*)((uchar*)SW + SW_UQ), kb, 32 * nb, 32 * nb, scr, F.lane); continue; } r -= I_UQ;
        if (r < I_UKV) { const int kb = r / 16, nb = r % 16; tr_item(a->in[I_MUKV] + (size_t)l * 128 * 512, 128, 512, (bf16*)((uchar*)SW + SW_UKV), kb, 32 * nb, 32 * nb, scr, F.lane); continue; } r -= I_UKV;
        if (r < I_GLU) { const int kb = r / 8, nb = r % 8; tr_item(a->in[I_S5GLU] + (size_t)l * 256 * 256, 256, 256, (bf16*)((uchar*)SW + SW_GLU), kb, 32 * nb, 32 * nb, scr, F.lane); continue; } r -= I_GLU;
        { const int nb = r; tr_item(a->in[I_RGUP] + (size_t)l * 64 * 256, 64, 256, (bf16*)((uchar*)SW + SW_GUP), 0, 32 * nb, 32 * nb, scr, F.lane); }
    }
    if (set == 0) {
        unsigned zz_ = 0u; asm volatile("" : "+v"(zz_)); v4u z = {zz_, zz_, zz_, zz_}; v4u* p = (v4u*)(WIN + (size_t)ZP * D);
        for (int i = F.vcu * NTHR + F.tid; i < (ZPAD - ZP) * D / 8; i += F.G * NTHR) p[i] = z;
    }
}

DI void norm_rows(KArgs a, const Ctx& F, bool p_first, bool p_hasY, bool p_hasH, bool p_final, int p_nrows, const float* p_modY, int p_gi, const float* p_pw, float p_coef, const float* p_modH, int p_si, const float* p_prew) {
    float* X = (float*)(a->ws + WS_X); const bf16* Y = (const bf16*)(a->ws + WS_Y); bf16* H = (bf16*)(a->ws + WS_H);
    const int gw = F.vcu * NWAVES + F.wave, NGW = F.G * NWAVES, lane = F.lane;
    const int rpw = (p_nrows + NGW - 1) / NGW, r0 = gw * rpw, r1 = (r0 + rpw < p_nrows) ? (r0 + rpw) : p_nrows;
    if (r0 >= r1) return;
    f32x4 cA[4], cB[4], cC[4];
    int cur_mr = -1;
    f32x4 vn[4]; v2u yn[4];
    auto issue = [&](int r) {
        const float* xs = p_first ? (r < NLAT ? a->in[I_X] + (size_t)r * D : a->in[I_CTX] + (size_t)(r - NLAT) * D) : X + (size_t)r * D;
#pragma unroll
        for (int j = 0; j < 4; ++j) vn[j] = *(const f32x4*)(xs + 4 * lane + 256 * j);
        if (p_hasY) {
#pragma unroll
            for (int j = 0; j < 4; ++j) yn[j] = *(const v2u*)(Y + (size_t)r * D + 4 * lane + 256 * j);
        }
    };
    issue(r0);
    for (int r = r0; r < r1; ++r) {
        const int mr = r < NLAT ? (r >> 12) : 8;
        if (mr != cur_mr) { cur_mr = mr;
            const float* g = p_modY + (size_t)mr * MODW + p_gi * D; const float* sh = p_modH + (size_t)mr * MODW + p_si * D; const float* scp = sh + D;
#pragma unroll
            for (int j = 0; j < 4; ++j) { const int o = 4 * lane + 256 * j;
                cA[j] = p_hasY ? (*(const f32x4*)(g + o) * p_coef) * *(const f32x4*)(p_pw + o) : (f32x4){0.f, 0.f, 0.f, 0.f};
                if (p_hasH) { cB[j] = *(const f32x4*)(p_prew + o) * (*(const f32x4*)(scp + o) + 1.0f); cC[j] = *(const f32x4*)(sh + o); } else { cB[j] = cA[j]; cC[j] = cA[j]; } } }
        f32x4 v[4]; v2u yw[4];
#pragma unroll
        for (int j = 0; j < 4; ++j) { v[j] = vn[j]; yw[j] = yn[j]; }
        if (r + 1 < r1) issue(r + 1);
        if (p_hasY) {
            f32x4 y[4]; float ss = 0.f;
#pragma unroll
            for (int j = 0; j < 4; ++j) { y[j] = (f32x4){bflo(yw[j].x), bfhi(yw[j].x), bflo(yw[j].y), bfhi(yw[j].y)};
                ss += (y[j].x * y[j].x + y[j].y * y[j].y) + (y[j].z * y[j].z + y[j].w * y[j].w); }
            const float rstd = __builtin_amdgcn_rsqf(wave_sum(ss) * (1.0f / D) + NORM_EPS);
#pragma unroll
            for (int j = 0; j < 4; ++j) v[j] = v[j] + cA[j] * (y[j] * rstd);
        }
        if (p_final) {
#pragma unroll
            for (int j = 0; j < 4; ++j) *(f32x4*)(a->out + (size_t)r * D + 4 * lane + 256 * j) = v[j];
        } else if (p_hasY || p_first) {
#pragma unroll
            for (int j = 0; j < 4; ++j) *(f32x4*)(X + (size_t)r * D + 4 * lane + 256 * j) = v[j];
        }
        if (p_hasH) {
            float ss = 0.f;
#pragma unroll
            for (int j = 0; j < 4; ++j) ss += (v[j].x * v[j].x + v[j].y * v[j].y) + (v[j].z * v[j].z + v[j].w * v[j].w);
            const float rstd = __builtin_amdgcn_rsqf(wave_sum(ss) * (1.0f / D) + NORM_EPS);
#pragma unroll
            for (int j = 0; j < 4; ++j) { const f32x4 h = (v[j] * rstd) * cB[j] + cC[j];
                v2u o; o.x = pk2(h.x, h.y); o.y = pk2(h.z, h.w); *(v2u*)(H + (size_t)r * D + 4 * lane + 256 * j) = o; }
        }
    }
}
template <int K, int NBK, int MBK, bool TRANS, bool ZERO = true>
DI void small_gemm(const LAS bf16* A, int apitch, const bf16* Wt, int n0w, f32x4 (&acc)[NBK][MBK], int lane, int wpitch = K) {
    const int lr = lane & 15, kq = lane >> 4;
    if (ZERO) {
#pragma unroll
        for (int nb = 0; nb < NBK; ++nb)
#pragma unroll
            for (int mb = 0; mb < MBK; ++mb) acc[nb][mb] = (f32x4){0.f, 0.f, 0.f, 0.f};
    }
#pragma unroll 2
    for (int s = 0; s < K / 32; ++s) {
        bf16x8 av[MBK];
#pragma unroll
        for (int mb = 0; mb < MBK; ++mb) av[mb] = *(const LAS bf16x8*)(A + (16 * mb + lr) * apitch + 32 * s + 8 * kq);
#pragma unroll
        for (int nb = 0; nb < NBK; ++nb) { const bf16x8 w = *(const bf16x8*)(Wt + (size_t)(n0w + 16 * nb + lr) * wpitch + 32 * s + 8 * kq);
#pragma unroll
            for (int mb = 0; mb < MBK; ++mb) acc[nb][mb] = TRANS ? mfma16(w, av[mb], acc[nb][mb]) : mfma16(av[mb], w, acc[nb][mb]); }
    }
}
DI void ctx_gemm_block(const Ctx& F, const bf16* A, const bf16* Wt, int K, bf16* Yo) {
    const int bi = F.vcu; if (bi >= 256) return;
    const int rb = bi >> 3, cb = bi & 7, row0 = NLAT + 64 * rb;
    const int tid = F.tid, lane = F.lane, wave = F.wave;
    LAS bf16* As = (LAS bf16*)F.lds;
    const int nch = K / 256;
    v4u g[4];
    auto gload = [&](int ch) {
#pragma unroll
        for (int j = 0; j < 4; ++j) { const int cidx = tid + 512 * j, r = cidx >> 5, cc = cidx & 31; g[j] = *(const v4u*)(A + (size_t)(row0 + r) * K + ch * 256 + cc * 8); }
    };
    auto lstore = [&](int buf) {
#pragma unroll
        for (int j = 0; j < 4; ++j) { const int cidx = tid + 512 * j, r = cidx >> 5, cc = cidx & 31; *(LAS v4u*)(As + buf * 64 * 264 + r * 264 + cc * 8) = g[j]; }
    };
    f32x4 acc[1][4];
#pragma unroll
    for (int mb = 0; mb < 4; ++mb) acc[0][mb] = (f32x4){0.f, 0.f, 0.f, 0.f};
    const int lr_ = lane & 15, kq_ = lane >> 4;
    const bf16* wrow = Wt + (size_t)(128 * cb + 16 * wave + lr_) * K + 8 * kq_;
    bf16x8 wc[8], wn[8];
#pragma unroll
    for (int s = 0; s < 8; ++s) wc[s] = *(const bf16x8*)(wrow + 32 * s);
    gload(0); lstore(0);
    __syncthreads();
    for (int ch = 0; ch < nch; ++ch) {
        if (ch + 1 < nch) { gload(ch + 1);
#pragma unroll
            for (int s = 0; s < 8; ++s) wn[s] = *(const bf16x8*)(wrow + (ch + 1) * 256 + 32 * s); }
        const LAS bf16* Ab = As + (ch & 1) * 64 * 264;
#pragma unroll
        for (int s = 0; s < 8; ++s) {
#pragma unroll
            for (int mb = 0; mb < 4; ++mb) acc[0][mb] = mfma16(wc[s], *(const LAS bf16x8*)(Ab + (16 * mb + lr_) * 264 + 32 * s + 8 * kq_), acc[0][mb]);
        }
        if (ch + 1 < nch) { lstore((ch + 1) & 1);
#pragma unroll
            for (int s = 0; s < 8; ++s) wc[s] = wn[s]; }
        __syncthreads();
    }
    const int lr = lane & 15, kq = lane >> 4;
#pragma unroll
    for (int mb = 0; mb < 4; ++mb) { const f32x4 v = acc[0][mb]; v2u o; o.x = pk2(v.x, v.y); o.y = pk2(v.z, v.w);
        *(v2u*)(Yo + (size_t)(row0 + 16 * mb + lr) * D + 128 * cb + 16 * wave + 4 * kq) = o; }
}

struct S5C { float ar, ai, fr, fi; };
static __device__ __noinline__ S5C s5_coef(const float* lre, const float* lim, float dt, int nn) {
    const float lr = lre[nn], li = lim[nn], x = lr * dt;
    const float em = x * (1.0f + x * (0.5f + x * (0.16666667f + x * (0.041666668f + x * 0.0083333338f))));
    float sh, ch; my_sincosf(0.5f * li * dt, sh, ch);
    const float cm1 = -2.0f * sh * sh, sn = 2.0f * sh * ch;
    const float arm1 = em * (1.0f + cm1) + cm1;
    S5C o; o.ai = (1.0f + em) * sn; o.ar = 1.0f + arm1;
    const float den = lr * lr + li * li;
    o.fr = (arm1 * lr + o.ai * li) / den; o.fi = (o.ai * lr - arm1 * li) / den;
    return o;
}
DI void s5_scan_task(KArgs a, int l, int b, int dir, int g, LAS bf16* wl  , int lane) {
    const bf16* Z = (const bf16*)(a->ws + WS_ACT); bf16* YS = (bf16*)(a->ws + WS_YS5) + (size_t)dir * NROWS * 256;
    const int pg = (l * 2 + dir) * 16 + g;
    const float* lre = a->in[I_S5LRE] + pg * 64; const float* lim = a->in[I_S5LIM] + pg * 64;
    const float dt = __expf(a->in[I_S5DT][pg]);
    const S5C c0_ = s5_coef(lre, lim, dt, lane); const float ar = c0_.ar, ai = c0_.ai;
    bf16x8 Bf[4];
    { const int hh = lane >> 5;
#pragma unroll
      for (int nblk = 0; nblk < 2; ++nblk) { const int nn = 32 * nblk + (lane & 31); const S5C cn_ = s5_coef(lre, lim, dt, nn); const float fr = cn_.fr, fi = cn_.fi;
        const float* bre = a->in[I_S5BRE] + ((size_t)pg * 64 + nn) * 16 + 8 * hh; const float* bim = a->in[I_S5BIM] + ((size_t)pg * 64 + nn) * 16 + 8 * hh;
        float re[8], im[8];
#pragma unroll
        for (int j = 0; j < 8; ++j) { re[j] = fr * bre[j] - fi * bim[j]; im[j] = fi * bre[j] + fr * bim[j]; }
        Bf[nblk] = pack8(re[0], re[1], re[2], re[3], re[4], re[5], re[6], re[7]); Bf[2 + nblk] = pack8(im[0], im[1], im[2], im[3], im[4], im[5], im[6], im[7]); } }
    bf16x8 Cf[4];
    { const int p = lane & 15, q = lane >> 4;
#pragma unroll
      for (int s = 0; s < 4; ++s) { const int kc = 32 * s + 8 * q; float cv[8];
        const float* src = (s < 2) ? a->in[I_S5CRE] + ((size_t)pg * 16 + p) * 64 + kc : a->in[I_S5CIM] + ((size_t)pg * 16 + p) * 64 + (kc - 64);
        const float sg = (s < 2) ? 1.f : -1.f;
#pragma unroll
        for (int j = 0; j < 8; ++j) cv[j] = sg * src[j];
        Cf[s] = pack8(cv[0], cv[1], cv[2], cv[3], cv[4], cv[5], cv[6], cv[7]); } }
    float sr = 0.f, si = 0.f;
    const int hh = lane >> 5, li5 = lane & 31, q = lane >> 4, t16 = lane & 15;
    const f32x16 zero16 = {0.f, 0.f, 0.f, 0.f, 0.f, 0.f, 0.f, 0.f, 0.f, 0.f, 0.f, 0.f, 0.f, 0.f, 0.f, 0.f};
    const int nchC = TC / 32, nchT = nchC + T / 32;
    auto afload = [&](int gc) -> bf16x8 {
        const int seg = gc >= nchC, ch = seg ? gc - nchC : gc, len = seg ? T : TC;
        const int sidx = 32 * ch + li5, tt = dir ? (len - 1 - sidx) : sidx;
        return *(const bf16x8*)(Z + (size_t)tok_row(b, seg, tt) * ZP + ZS5 + g * 16 + 8 * hh);
    };
    bf16x8 afn = afload(0);
    for (int gc = 0; gc < nchT; ++gc) {
        const int seg = gc >= nchC, ch = seg ? gc - nchC : gc, len = seg ? T : TC;
        {
            const bf16x8 af = afn;
            if (gc + 1 < nchT) afn = afload(gc + 1);
            f32x16 d1 = mfma32(af, Bf[0], zero16), d2 = mfma32(af, Bf[1], zero16), d3 = mfma32(af, Bf[2], zero16), d4 = mfma32(af, Bf[3], zero16);
            float xa[16], xb[16], ya[16], yb[16];
#pragma unroll
            for (int r = 0; r < 16; ++r) {
                auto r1 = __builtin_amdgcn_permlane32_swap(__float_as_uint(d1[r]), __float_as_uint(d2[r]), false, false); xa[r] = __uint_as_float(r1[0]); xb[r] = __uint_as_float(r1[1]);
                auto r2 = __builtin_amdgcn_permlane32_swap(__float_as_uint(d3[r]), __float_as_uint(d4[r]), false, false); ya[r] = __uint_as_float(r2[0]); yb[r] = __uint_as_float(r2[1]); }
#pragma unroll
            for (int i = 0; i < 32; ++i) {
                const int r = 4 * (i >> 3) + (i & 3); const bool hi = (i >> 2) & 1;
                const float xre = hi ? xb[r] : xa[r], xim = hi ? yb[r] : ya[r];
                const float nsr = ar * sr - ai * si + xre, nsi = ar * si + ai * sr + xim; sr = nsr; si = nsi;
                wl[i * 136 + lane] = (bf16)f2bf(sr); wl[i * 136 + 64 + lane] = (bf16)f2bf(si);
            }
#pragma unroll
            for (int tb = 0; tb < 2; ++tb) {
                f32x4 acc = {0.f, 0.f, 0.f, 0.f};
#pragma unroll
                for (int s = 0; s < 4; ++s) { const bf16x8 bfr = *(const LAS bf16x8*)(wl + (16 * tb + t16) * 136 + 32 * s + 8 * q); acc = mfma16(Cf[s], bfr, acc); }
                const int so = 32 * ch + 16 * tb + t16, to = dir ? (len - 1 - so) : so;
                v2u o; o.x = pk2(acc[0], acc[1]); o.y = pk2(acc[2], acc[3]);
                *(v2u*)(YS + (size_t)tok_row(b, seg, to) * 256 + g * 16 + 4 * q) = o;
            }
        }
    }
}

DI void mla_prep_tile(KArgs a, const Ctx& F, int l, int tile) {
    const bf16* Z = (const bf16*)(a->ws + WS_ACT);
    bf16* Q = (bf16*)(a->ws + WS_Q); bf16* Kf = (bf16*)(a->ws + WS_K); bf16* Vt = (bf16*)(a->ws + WS_VT);
    const bf16* WUQ = (const bf16*)(a->ws + WS_SMALLW + SW_UQ); const bf16* WUKV = (const bf16*)(a->ws + WS_SMALLW + SW_UKV);
    const float* rc = (const float*)(a->ws + WS_ROPE); const float* rs = rc + T * 16;
    LAS bf16* Aq = (LAS bf16*)F.lds;
    LAS bf16* Akv = (LAS bf16*)(F.lds + 64 * 264 * 2);
    const int row0 = tile * 64, tid = F.tid, lane = F.lane, wave = F.wave;
    const bool lat = row0 < NLAT;
    {
        const int i = tid >> 3, part = tid & 7, row = row0 + i;
        const bf16* zr = Z + (size_t)row * ZP;
        float q[32], kv[16]; float sq = 0.f, sk = 0.f;
#pragma unroll
        for (int j = 0; j < 4; ++j) { const v4u w = *(const v4u*)(zr + ZCQ + part * 32 + 8 * j);
            q[8 * j + 0] = bflo(w.x); q[8 * j + 1] = bfhi(w.x); q[8 * j + 2] = bflo(w.y); q[8 * j + 3] = bfhi(w.y); q[8 * j + 4] = bflo(w.z); q[8 * j + 5] = bfhi(w.z); q[8 * j + 6] = bflo(w.w); q[8 * j + 7] = bfhi(w.w); }
#pragma unroll
        for (int j = 0; j < 2; ++j) { const v4u w = *(const v4u*)(zr + ZCKV + part * 16 + 8 * j);
            kv[8 * j + 0] = bflo(w.x); kv[8 * j + 1] = bfhi(w.x); kv[8 * j + 2] = bflo(w.y); kv[8 * j + 3] = bfhi(w.y); kv[8 * j + 4] = bflo(w.z); kv[8 * j + 5] = bfhi(w.z); kv[8 * j + 6] = bflo(w.w); kv[8 * j + 7] = bfhi(w.w); }
#pragma unroll
        for (int j = 0; j < 32; ++j) sq += q[j] * q[j];
#pragma unroll
        for (int j = 0; j < 16; ++j) sk += kv[j] * kv[j];
        sq += __shfl_xor(sq, 1); sq += __shfl_xor(sq, 2); sq += __shfl_xor(sq, 4);
        sk += __shfl_xor(sk, 1); sk += __shfl_xor(sk, 2); sk += __shfl_xor(sk, 4);
        const float rq = 1.0f / sqrtf(sq * (1.0f / 256.0f) + NORM_EPS), rk = 1.0f / sqrtf(sk * (1.0f / 128.0f) + NORM_EPS);
        const float* qn = a->in[I_MQN] + l * 256 + part * 32; const float* kn = a->in[I_MKVN] + l * 128 + part * 16;
#pragma unroll
        for (int j = 0; j < 32; j += 2) *(LAS unsigned*)(Aq + i * 264 + part * 32 + j) = pk2(q[j] * rq * qn[j], q[j + 1] * rq * qn[j + 1]);
#pragma unroll
        for (int j = 0; j < 16; j += 2) *(LAS unsigned*)(Akv + i * 136 + part * 16 + j) = pk2(kv[j] * rk * kn[j], kv[j + 1] * rk * kn[j + 1]);
        if (part == 0) {
            float kr[32];
#pragma unroll
            for (int j = 0; j < 4; ++j) { const v4u w = *(const v4u*)(zr + ZKR + 8 * j);
                kr[8 * j + 0] = bflo(w.x); kr[8 * j + 1] = bfhi(w.x); kr[8 * j + 2] = bflo(w.y); kr[8 * j + 3] = bfhi(w.y); kr[8 * j + 4] = bflo(w.z); kr[8 * j + 5] = bfhi(w.z); kr[8 * j + 6] = bflo(w.w); kr[8 * j + 7] = bfhi(w.w); }
            float o[32];
            if (lat) { const int t = row & (T - 1);
#pragma unroll
                for (int hf = 0; hf < 2; ++hf)
#pragma unroll
                    for (int j = 0; j < 8; ++j) { const float c = rc[t * 16 + hf * 8 + j], s = rs[t * 16 + hf * 8 + j]; const float x0 = kr[hf * 16 + j], x1 = kr[hf * 16 + 8 + j];
                        o[hf * 16 + j] = x0 * c - x1 * s; o[hf * 16 + 8 + j] = x1 * c + x0 * s; }
            } else {
#pragma unroll
                for (int j = 0; j < 32; ++j) o[j] = kr[j];
            }
#pragma unroll
            for (int hd = 0; hd < 4; ++hd) { bf16* kp = Kf + (size_t)row * 384 + hd * 96 + 64;
#pragma unroll
                for (int j = 0; j < 4; ++j) { v4u w; w.x = pk2(o[8 * j], o[8 * j + 1]); w.y = pk2(o[8 * j + 2], o[8 * j + 3]); w.z = pk2(o[8 * j + 4], o[8 * j + 5]); w.w = pk2(o[8 * j + 6], o[8 * j + 7]); *(v4u*)(kp + 8 * j) = w; } }
        }
    }
    __syncthreads();
    const int lr = lane & 15, kq = lane >> 4;
    {
        f32x4 acc[3][4];
        small_gemm<256, 3, 4, true>(Aq, 264, WUQ, 48 * wave, acc, lane);
        const float qs = 0.10206207261596577f * 1.44269504089f;
#pragma unroll
        for (int nb = 0; nb < 3; ++nb) { const int blk = 3 * wave + nb, hb = blk % 6;
#pragma unroll
            for (int mb = 0; mb < 4; ++mb) { const int row = row0 + 16 * mb + lr; f32x4 v = acc[nb][mb];
                if (hb >= 4) {
                    f32x4 pv; pv.x = __shfl_xor(v.x, 32); pv.y = __shfl_xor(v.y, 32); pv.z = __shfl_xor(v.z, 32); pv.w = __shfl_xor(v.w, 32);
                    if (lat) { const int t = row & (T - 1); const int fb = (hb - 4) * 8 + 4 * (kq & 1);
                        const f32x4 c = *(const f32x4*)(rc + t * 16 + fb), s = *(const f32x4*)(rs + t * 16 + fb);
                        v = (kq < 2) ? (v * c - pv * s) : (v * c + pv * s); }
                }
                v = v * qs;
                v2u o; o.x = pk2(v.x, v.y); o.y = pk2(v.z, v.w);
                *(v2u*)(Q + (size_t)row * 384 + 16 * blk + 4 * kq) = o; } }
    }
    {
        const int hd = wave >> 1;
        if ((wave & 1) == 0) {
            f32x4 acc[4][4];
            small_gemm<128, 4, 4, true>(Akv, 136, WUKV, 64 * wave, acc, lane);
#pragma unroll
            for (int nb = 0; nb < 4; ++nb)
#pragma unroll
                for (int mb = 0; mb < 4; ++mb) { const int row = row0 + 16 * mb + lr; const f32x4 v = acc[nb][mb];
                    v2u o; o.x = pk2(v.x, v.y); o.y = pk2(v.z, v.w);
                    *(v2u*)(Kf + (size_t)row * 384 + hd * 96 + 16 * nb + 4 * kq) = o; }
        } else {
            f32x4 acc[4][4];
            small_gemm<128, 4, 4, false>(Akv, 136, WUKV, 64 * wave, acc, lane);
            const int bb = lat ? (row0 >> 12) : ((row0 - NLAT) >> 8);
            const int key0 = lat ? (TC + (row0 & (T - 1))) : ((row0 - NLAT) & (TC - 1));
#pragma unroll
            for (int nb = 0; nb < 4; ++nb)
#pragma unroll
                for (int mb = 0; mb < 4; ++mb) { const f32x4 v = acc[nb][mb];
                    v2u o; o.x = pk2(v.x, v.y); o.y = pk2(v.z, v.w);
                    *(v2u*)(Vt + ((size_t)(bb * 4 + hd) * 64 + 16 * nb + lr) * NKEY + key0 + 16 * mb + 4 * kq) = o; }
        }
    }
    __syncthreads();
}

DI void attn_unit(KArgs a, const Ctx& F, int b, int hd, int qrow0, int nkeys) {
    const bf16* Q = (const bf16*)(a->ws + WS_Q); const bf16* Kf = (const bf16*)(a->ws + WS_K); const bf16* Vt = (const bf16*)(a->ws + WS_VT);
    bf16* MO = (bf16*)(a->ws + WS_H);
    constexpr int KP = 208, VP = 144, BUF = 64 * KP + 64 * VP;
    const int tid = F.tid, lane = F.lane, wave = F.wave, l31 = lane & 31, h2 = lane >> 5;
    const int qrow = qrow0 + 32 * wave + l31;
    bf16x8 Qf[6];
#pragma unroll
    for (int s = 0; s < 6; ++s) Qf[s] = *(const bf16x8*)(Q + (size_t)qrow * 384 + hd * 96 + 16 * s + 8 * h2);
    const int kc0 = tid, kc1 = tid + 512;
    const int kr0 = kc0 / 12, kcc0 = kc0 % 12, kr1 = kc1 / 12, kcc1 = kc1 % 12; const bool k1v = kc1 < 768;
    const int vd = tid >> 3, vcc = tid & 7;
    const bf16* vbase = Vt + ((size_t)(b * 4 + hd) * 64 + vd) * NKEY + vcc * 8;
    v4u gk0, gk1, gv;
    auto gload = [&](int kt) {
        const int key0 = 64 * kt; const int krow = key0 < TC ? (NLAT + b * TC + key0) : (b * T + key0 - TC);
        gk0 = *(const v4u*)(Kf + (size_t)(krow + kr0) * 384 + hd * 96 + kcc0 * 8);
        if (k1v) gk1 = *(const v4u*)(Kf + (size_t)(krow + kr1) * 384 + hd * 96 + kcc1 * 8);
        gv = *(const v4u*)(vbase + key0);
    };
    auto lstore = [&](int buf) {
        LAS uchar* base = F.lds + buf * BUF;
        *(LAS v4u*)(base + kr0 * KP + kcc0 * 16) = gk0;
        if (k1v) *(LAS v4u*)(base + kr1 * KP + kcc1 * 16) = gk1;
        *(LAS v4u*)(base + 64 * KP + vd * VP + vcc * 16) = gv;
    };
    const int nt = nkeys / 64;
    gload(0); lstore(0);
    __syncthreads();
    f32x16 O0, O1;
#pragma unroll
    for (int r = 0; r < 16; ++r) { O0[r] = 0.f; O1[r] = 0.f; }
    float m = -1e30f, lsum = 0.f;
    for (int kt = 0; kt < nt; ++kt) {
        const bool more = kt + 1 < nt;
        if (more) gload(kt + 1);
        const LAS uchar* kb_ = F.lds + (kt & 1) * BUF; const LAS uchar* vb_ = kb_ + 64 * KP;
        f32x16 s0, s1;
#pragma unroll
        for (int r = 0; r < 16; ++r) { s0[r] = 0.f; s1[r] = 0.f; }
#pragma unroll
        for (int s = 0; s < 6; ++s) {
            const bf16x8 ka = *(const LAS bf16x8*)(kb_ + l31 * KP + (16 * s + 8 * h2) * 2);
            const bf16x8 kb2 = *(const LAS bf16x8*)(kb_ + (32 + l31) * KP + (16 * s + 8 * h2) * 2);
            s0 = mfma32(ka, Qf[s], s0); s1 = mfma32(kb2, Qf[s], s1);
        }
        float mx = s0[0];
#pragma unroll
        for (int r = 1; r < 16; ++r) mx = fmaxf(mx, s0[r]);
#pragma unroll
        for (int r = 0; r < 16; ++r) mx = fmaxf(mx, s1[r]);
        mx = fmaxf(mx, __shfl_xor(mx, 32));
        const float mn = fmaxf(m, mx), alpha = __builtin_amdgcn_exp2f(m - mn); m = mn;
        float ps = 0.f;
#pragma unroll
        for (int r = 0; r < 16; ++r) { s0[r] = __builtin_amdgcn_exp2f(s0[r] - mn); s1[r] = __builtin_amdgcn_exp2f(s1[r] - mn); ps += s0[r] + s1[r]; }
        lsum = lsum * alpha + ps;
#pragma unroll
        for (int r = 0; r < 16; ++r) { O0[r] *= alpha; O1[r] *= alpha; }
#pragma unroll
        for (int kb = 0; kb < 2; ++kb)
#pragma unroll
            for (int sp = 0; sp < 2; ++sp) {
                const f32x16& sx = kb ? s1 : s0;
                const bf16x8 pf = pack8(sx[8 * sp + 0], sx[8 * sp + 1], sx[8 * sp + 2], sx[8 * sp + 3], sx[8 * sp + 4], sx[8 * sp + 5], sx[8 * sp + 6], sx[8 * sp + 7]);
                const int ko = (32 * kb + 16 * sp + 4 * h2) * 2;
                const bf16x4 a0 = *(const LAS bf16x4*)(vb_ + l31 * VP + ko), a1 = *(const LAS bf16x4*)(vb_ + l31 * VP + ko + 16);
                const bf16x4 c0 = *(const LAS bf16x4*)(vb_ + (32 + l31) * VP + ko), c1 = *(const LAS bf16x4*)(vb_ + (32 + l31) * VP + ko + 16);
                const bf16x8 va = __builtin_shufflevector(a0, a1, 0, 1, 2, 3, 4, 5, 6, 7), vc = __builtin_shufflevector(c0, c1, 0, 1, 2, 3, 4, 5, 6, 7);
                O0 = mfma32(va, pf, O0); O1 = mfma32(vc, pf, O1);
            }
        if (more) lstore((kt + 1) & 1);
        __syncthreads();
    }
    const float ltot = lsum + __shfl_xor(lsum, 32), inv = 1.0f / ltot;
    bf16* op = MO + (size_t)qrow * D + 256 + hd * 64;
#pragma unroll
    for (int gq = 0; gq < 4; ++gq) {
        v2u o; o.x = pk2(O0[4 * gq] * inv, O0[4 * gq + 1] * inv); o.y = pk2(O0[4 * gq + 2] * inv, O0[4 * gq + 3] * inv);
        *(v2u*)(op + 8 * gq + 4 * h2) = o;
        v2u o2; o2.x = pk2(O1[4 * gq] * inv, O1[4 * gq + 1] * inv); o2.y = pk2(O1[4 * gq + 2] * inv, O1[4 * gq + 3] * inv);
        *(v2u*)(op + 32 + 8 * gq + 4 * h2) = o2;
    }
}
DI float conv3(const bf16* Z, int b, int seg, int t, int len, int col, float w0, float w1, float w2, float cb) {
    const bf16* zp = Z + (size_t)tok_row(b, seg, t) * ZP + col;
    float y = cb + w1 * bf2f(zp[0]);
    if (t > 0) y += w0 * bf2f(zp[-ZP]);
    if (t + 1 < len) y += w2 * bf2f(zp[ZP]);
    return y;
}
DI bf16x8 ldperm(const LAS bf16* rowp, int k0, int hh) { const bf16x4 a0 = *(const LAS bf16x4*)(rowp + k0 + 4 * hh), a1 = *(const LAS bf16x4*)(rowp + k0 + 8 + 4 * hh); return __builtin_shufflevector(a0, a1, 0, 1, 2, 3, 4, 5, 6, 7); }
DI bf16x8 pack_acc(const f32x16& x, int s) { return s ? pack8(x[8], x[9], x[10], x[11], x[12], x[13], x[14], x[15]) : pack8(x[0], x[1], x[2], x[3], x[4], x[5], x[6], x[7]); }
DI void rwkv_scan_task(KArgs a, const Ctx& F, int l, int b, int hd, int dir) {
    const bf16* Z = (const bf16*)(a->ws + WS_ACT); bf16* YR = (bf16*)(a->ws + WS_YR) + (size_t)dir * NROWS * 256;
    constexpr int RAWSZ = 13056 + 4608;
    constexpr int FR_OFF = 4 * 4608 + 3 * 5120 + 256 + 2560;
    constexpr int SETSZ = FR_OFF + 6144;
    LAS uchar* const RAW0 = F.lds;
    LAS float* WL = (LAS float*)(F.lds + 2 * RAWSZ);
    LAS float* AL = WL + 2048;
    LAS float* Alw = AL + 2048;
    LAS float* CST = Alw + 512;
    LAS uchar* const SET0 = (LAS uchar*)(CST + 1024);
    const int tid = F.tid, lane = F.lane, wave = F.wave;
    const int hc = hd * 64 + lane;
    bf16x8 lf0 = {0, 0, 0, 0, 0, 0, 0, 0}, lf1 = lf0;
    if (wave >= 4) { const int w4 = wave - 4, l31 = lane & 31, hh = lane >> 5; const float* up = a->in[(w4 >> 1) ? I_RAUP : I_RWUP] + ((size_t)(l * 2 + dir) * 32) * 256 + hd * 64 + 32 * (w4 & 1) + l31;
        float u[16];
#pragma unroll
        for (int s = 0; s < 2; ++s)
#pragma unroll
            for (int j = 0; j < 8; ++j) u[8 * s + j] = up[(size_t)(16 * s + 8 * hh + j) * 256];
        lf0 = pack8(u[0], u[1], u[2], u[3], u[4], u[5], u[6], u[7]); lf1 = pack8(u[8], u[9], u[10], u[11], u[12], u[13], u[14], u[15]); }
    if (wave == 0) {
        const float* cw = a->in[I_RCW] + (size_t)l * 3 * 768; const float* cbp = a->in[I_RCB] + (size_t)l * 768;
        CST[0 * 64 + lane] = a->in[I_RW0][(l * 2 + dir) * 256 + hc]; CST[1 * 64 + lane] = a->in[I_RA0][(l * 2 + dir) * 256 + hc];
        CST[2 * 64 + lane] = a->in[I_RKK][l * 256 + hc]; CST[3 * 64 + lane] = a->in[I_RKA][l * 256 + hc];
#pragma unroll
        for (int j = 0; j < 3; ++j) { CST[(4 + j) * 64 + lane] = cw[j * 768 + hc]; CST[(7 + j) * 64 + lane] = cw[j * 768 + 256 + hc]; CST[(10 + j) * 64 + lane] = cw[j * 768 + 512 + hc]; }
        CST[13 * 64 + lane] = cbp[hc]; CST[14 * 64 + lane] = cbp[256 + hc]; CST[15 * 64 + lane] = cbp[512 + hc];
    }
    f32x16 ST0, ST1;
#pragma unroll
    for (int r = 0; r < 16; ++r) { ST0[r] = 0.f; ST1[r] = 0.f; }
    const int c0r = tid / 24, c0s = (tid % 24) >> 3, c0c = (tid % 24) & 7;
    const int c1 = tid + 512, c1r = c1 / 24, c1s = (c1 % 24) >> 3, c1c = (c1 % 24) & 7; const bool c1v = c1 < 816;
    const int lr_ = tid >> 3, lc_ = tid & 7;
    v4u g0, g1, g2;
    unsigned zz_ = 0u; asm volatile("" : "+v"(zz_)); const v4u zero4 = {zz_, zz_, zz_, zz_};
    const int nchC = TC / 32, nchT = nchC + T / 32;
    auto gload = [&](int gc) {
        const int seg = gc >= nchC, ch = seg ? gc - nchC : gc, len = seg ? T : TC;
        const int tbase = dir ? (len - 32 * (ch + 1)) : 32 * ch;
        { const int t = tbase - 1 + c0r; g0 = (t >= 0 && t < len) ? *(const v4u*)(Z + (size_t)tok_row(b, seg, t) * ZP + ZRKV + c0s * 256 + hd * 64 + c0c * 8) : zero4; }
        if (c1v) { const int t = tbase - 1 + c1r; g1 = (t >= 0 && t < len) ? *(const v4u*)(Z + (size_t)tok_row(b, seg, t) * ZP + ZRKV + c1s * 256 + hd * 64 + c1c * 8) : zero4; }
        if (tid < 256) { const int t = tbase + lr_; g2 = *(const v4u*)(Z + (size_t)tok_row(b, seg, t) * ZP + ZWD + lc_ * 8); }
    };
    auto lstore = [&](int par) {
        LAS bf16* Raw = (LAS bf16*)(RAW0 + par * RAWSZ); LAS bf16* LwB = (LAS bf16*)(RAW0 + par * RAWSZ + 13056);
        *(LAS v4u*)(Raw + c0r * 192 + c0s * 64 + c0c * 8) = g0;
        if (c1v) *(LAS v4u*)(Raw + c1r * 192 + c1s * 64 + c1c * 8) = g1;
        if (tid < 256) { float x[8] = {bflo(g2.x), bfhi(g2.x), bflo(g2.y), bfhi(g2.y), bflo(g2.z), bfhi(g2.z), bflo(g2.w), bfhi(g2.w)};
            if (lc_ < 4) {
#pragma unroll
                for (int j = 0; j < 8; ++j) x[j] = 1.0f - 2.0f * __builtin_amdgcn_rcpf(1.0f + fexp(2.0f * x[j])); }
            v4u w; w.x = pk2(x[0], x[1]); w.y = pk2(x[2], x[3]); w.z = pk2(x[4], x[5]); w.w = pk2(x[6], x[7]);
            *(LAS v4u*)(LwB + lr_ * 72 + lc_ * 8) = w; }
    };
    gload(0); lstore(0);
    __syncthreads();
    for (int n = -2; n < nchT; ++n) {
        if (n + 3 < nchT) gload(n + 3);
        int ln_ = lane; asm volatile("" : "+v"(ln_));
        const int l31 = ln_ & 31, hh = ln_ >> 5;
        if (wave < 2) {
            if (n >= 0) {
                const int seg = n >= nchC, ch = seg ? n - nchC : n, len = seg ? T : TC;
                const int tbase = dir ? (len - 32 * (ch + 1)) : 32 * ch;
                LAS uchar* sp = SET0 + (n & 1) * SETSZ;
                LAS bf16* KhT = (LAS bf16*)sp; LAS bf16* BhT = KhT + 32 * 72; LAS bf16* KkT = BhT + 32 * 72; LAS bf16* RhT = KkT + 32 * 72;
                LAS bf16* Kh = RhT + 32 * 72; LAS bf16* nBh = Kh + 64 * 40; LAS bf16* VT = nBh + 64 * 40; LAS float* GL = (LAS float*)(VT + 64 * 40); LAS bf16* TT = (LAS bf16*)(GL + 64);
                const int vcol = 32 * wave + l31;
                f32x16 accP, accY;
#pragma unroll
                for (int r = 0; r < 16; ++r) { accP[r] = 0.f; accY[r] = 0.f; }
#pragma unroll
                for (int kb = 0; kb < 2; ++kb)
#pragma unroll
                    for (int s = 0; s < 2; ++s) { const bf16x8 sb = pack_acc(kb ? ST1 : ST0, s);
                        accP = mfma32(ldperm(KkT + l31 * 72, 32 * kb + 16 * s, hh), sb, accP);
                        accY = mfma32(ldperm(RhT + l31 * 72, 32 * kb + 16 * s, hh), sb, accY); }
                const LAS bf16x8* FR = (const LAS bf16x8*)(sp + FR_OFF);
#pragma unroll
                for (int s = 0; s < 2; ++s) { const bf16x8 vt_ = ldperm(VT + vcol * 40, 16 * s, hh);
                    accP = mfma32(FR[(0 + s) * 64 + ln_], vt_, accP);
                    accY = mfma32(FR[(2 + s) * 64 + ln_], vt_, accY); }
                f32x16 accC;
#pragma unroll
                for (int r = 0; r < 16; ++r) accC[r] = 0.f;
#pragma unroll
                for (int s = 0; s < 2; ++s) accC = mfma32(ldperm(TT + l31 * 40, 16 * s, hh), pack_acc(accP, s), accC);
#pragma unroll
                for (int s = 0; s < 2; ++s) accY = mfma32(FR[(4 + s) * 64 + ln_], pack_acc(accC, s), accY);
#pragma unroll
                for (int s = 0; s < 2; ++s) { const bf16x8 vb_ = *(const LAS bf16x8*)(VT + vcol * 40 + 16 * s + 8 * hh); const bf16x8 cb_ = pack_acc(accC, s);
                    ST0 = mfma32(*(const LAS bf16x8*)(Kh + l31 * 40 + 16 * s + 8 * hh), vb_, ST0);
                    ST1 = mfma32(*(const LAS bf16x8*)(Kh + (32 + l31) * 40 + 16 * s + 8 * hh), vb_, ST1);
                    ST0 = mfma32(ldperm(nBh + l31 * 40, 16 * s, hh), cb_, ST0);
                    ST1 = mfma32(ldperm(nBh + (32 + l31) * 40, 16 * s, hh), cb_, ST1); }
#pragma unroll
                for (int r = 0; r < 16; ++r) { ST0[r] *= GL[crow(r, hh)]; ST1[r] *= GL[32 + crow(r, hh)]; }
#pragma unroll
                for (int r = 0; r < 16; ++r) { const int i = crow(r, hh), t = dir ? (tbase + 31 - i) : (tbase + i);
                    YR[(size_t)tok_row(b, seg, t) * 256 + hd * 64 + vcol] = (bf16)f2bf(accY[r]); }
            }
        } else if (wave == 2) {
            if (n + 1 >= 0 && n + 1 < nchT) {
                LAS uchar* sp = SET0 + ((n + 1) & 1) * SETSZ;
                LAS bf16* BhT = (LAS bf16*)sp + 32 * 72; LAS bf16* KkT = BhT + 32 * 72; LAS bf16* TT = (LAS bf16*)(sp + 4 * 4608 + 3 * 5120 + 256);
                f32x16 P, PT, Tm, TTm;
#pragma unroll
                for (int r = 0; r < 16; ++r) { P[r] = 0.f; PT[r] = 0.f; }
#pragma unroll
                for (int s = 0; s < 4; ++s) { const bf16x8 bh_ = *(const LAS bf16x8*)(BhT + l31 * 72 + 16 * s + 8 * hh), kk_ = *(const LAS bf16x8*)(KkT + l31 * 72 + 16 * s + 8 * hh);
                    P = mfma32(bh_, kk_, P); PT = mfma32(kk_, bh_, PT); }
#pragma unroll
                for (int r = 0; r < 16; ++r) { const int j = crow(r, hh);
                    P[r] = (j < l31) ? P[r] : 0.f; PT[r] = (j > l31) ? PT[r] : 0.f;
                    const float idv = (j == l31) ? 1.f : 0.f; Tm[r] = idv - P[r]; TTm[r] = idv - PT[r]; }
#pragma unroll
                for (int it = 0; it < 4; ++it) {
                    const bf16x8 p0 = pack_acc(P, 0), p1 = pack_acc(P, 1), q0 = pack_acc(PT, 0), q1 = pack_acc(PT, 1);
                    f32x16 P2, P2T;
#pragma unroll
                    for (int r = 0; r < 16; ++r) { P2[r] = 0.f; P2T[r] = 0.f; }
                    P2 = mfma32(q0, p0, P2); P2 = mfma32(q1, p1, P2);
                    if (it < 3) { P2T = mfma32(p0, q0, P2T); P2T = mfma32(p1, q1, P2T); }
                    const bf16x8 u0 = pack_acc(TTm, 0), u1 = pack_acc(TTm, 1);
                    const bf16x8 a0 = pack_acc(P2, 0), a1 = pack_acc(P2, 1);
                    Tm = mfma32(u0, a0, Tm); Tm = mfma32(u1, a1, Tm);
                    if (it < 3) { TTm = mfma32(a0, u0, TTm); TTm = mfma32(a1, u1, TTm); }
                    P = P2; PT = P2T;
                }
#pragma unroll
                for (int r = 0; r < 16; ++r) TT[l31 * 40 + crow(r, hh)] = (bf16)f2bf(Tm[r]);
            }
        } else if (wave == 3) {
            if (n + 1 >= 0 && n + 1 < nchT) {
                LAS uchar* sp = SET0 + ((n + 1) & 1) * SETSZ;
                LAS bf16* KhT = (LAS bf16*)sp; LAS bf16* BhT = KhT + 32 * 72; LAS bf16* KkT = BhT + 32 * 72; LAS bf16* RhT = KkT + 32 * 72;
                LAS bf16x8* FR = (LAS bf16x8*)(sp + FR_OFF);
                f32x16 a1, a2, a3;
#pragma unroll
                for (int r = 0; r < 16; ++r) { a1[r] = 0.f; a2[r] = 0.f; a3[r] = 0.f; }
#pragma unroll
                for (int s = 0; s < 4; ++s) { const bf16x8 kh_ = *(const LAS bf16x8*)(KhT + l31 * 72 + 16 * s + 8 * hh), kk_ = *(const LAS bf16x8*)(KkT + l31 * 72 + 16 * s + 8 * hh),
                                                             rh_ = *(const LAS bf16x8*)(RhT + l31 * 72 + 16 * s + 8 * hh), bh_ = *(const LAS bf16x8*)(BhT + l31 * 72 + 16 * s + 8 * hh);
                    a1 = mfma32(kh_, kk_, a1); a2 = mfma32(kh_, rh_, a2); a3 = mfma32(bh_, rh_, a3); }
#pragma unroll
                for (int r = 0; r < 16; ++r) { const int j = crow(r, hh); a1[r] = (j < l31) ? a1[r] : 0.f; a2[r] = (j <= l31) ? a2[r] : 0.f; a3[r] = (j <= l31) ? -a3[r] : 0.f; }
#pragma unroll
                for (int s = 0; s < 2; ++s) { FR[(0 + s) * 64 + ln_] = pack_acc(a1, s); FR[(2 + s) * 64 + ln_] = pack_acc(a2, s); FR[(4 + s) * 64 + ln_] = pack_acc(a3, s); }
            }
        } else if (wave >= 4) {
            if (n + 2 < nchT) {
                const int w4 = wave - 4;
                const LAS bf16* LwB = (const LAS bf16*)(RAW0 + ((n + 2) & 1) * RAWSZ + 13056);
                f32x16 acc;
#pragma unroll
                for (int r = 0; r < 16; ++r) acc[r] = 0.f;
                const int ko = (w4 >> 1) * 32;
                acc = mfma32(*(const LAS bf16x8*)(LwB + l31 * 72 + ko + 8 * hh), lf0, acc);
                acc = mfma32(*(const LAS bf16x8*)(LwB + l31 * 72 + ko + 16 + 8 * hh), lf1, acc);
                LAS float* dst = (w4 >> 1) ? AL : WL;
#pragma unroll
                for (int r = 0; r < 16; ++r) dst[crow(r, hh) * 64 + 32 * (w4 & 1) + l31] = acc[r];
            }
        }
        lds_barrier();
#ifdef DBG_REP_R23
        for (int rp_ = 0; rp_ < 2; ++rp_) {
#else
        {
#endif
        const bool pv = n + 2 < nchT;
        const int pi = tid >> 4, c4 = (ln_ & 15) * 4, pli = dir ? (31 - pi) : pi, pjr = dir ? (32 - pi) : (pi + 1);
        f32x4 lwi = {0.f, 0.f, 0.f, 0.f}, cuml = lwi;
        if (pv) {
            const f32x4 wl4 = *(const LAS f32x4*)(WL + pli * 64 + c4) + *(const LAS f32x4*)(CST + c4);
#pragma unroll
            for (int e = 0; e < 4; ++e) { const float xneg = -wl4[e]; const float sp = fmaxf(xneg, 0.f) + 0.69314718056f * __builtin_amdgcn_logf(1.0f + fexp(-fabsf(xneg))); lwi[e] = -fexp(-sp - 0.5f); }
            cuml = lwi;
#pragma unroll
            for (int e = 0; e < 4; ++e) { float y = __shfl_up(cuml[e], 16); if (ln_ >= 16) cuml[e] += y; }
#pragma unroll
            for (int e = 0; e < 4; ++e) { float y = __shfl_up(cuml[e], 32); if (ln_ >= 32) cuml[e] += y; }
            if (ln_ >= 48) *(LAS f32x4*)(Alw + wave * 64 + c4) = cuml;
        }
        lds_barrier();
        if (pv) {
            LAS uchar* sp = SET0 + (n & 1) * SETSZ;
            LAS bf16* KhT = (LAS bf16*)sp; LAS bf16* BhT = KhT + 32 * 72; LAS bf16* KkT = BhT + 32 * 72; LAS bf16* RhT = KkT + 32 * 72;
            LAS bf16* Kh = RhT + 32 * 72; LAS bf16* nBh = Kh + 64 * 40; LAS bf16* VT = nBh + 64 * 40; LAS float* GL = (LAS float*)(VT + 64 * 40);
            const LAS bf16* Raw = (const LAS bf16*)(RAW0 + (n & 1) * RAWSZ);
            f32x4 cum = cuml;
#pragma unroll
            for (int w2 = 0; w2 < 7; ++w2) { const f32x4 x = *(const LAS f32x4*)(Alw + w2 * 64 + c4); if (w2 < wave) cum = cum + x; }
            const f32x4 cpv = cum - lwi;
            float rr[4], kv[4], vv[4];
            { const f32x4 br = *(const LAS f32x4*)(CST + 13 * 64 + c4), bk = *(const LAS f32x4*)(CST + 14 * 64 + c4), bv = *(const LAS f32x4*)(CST + 15 * 64 + c4);
#pragma unroll
              for (int e = 0; e < 4; ++e) { rr[e] = br[e]; kv[e] = bk[e]; vv[e] = bv[e]; } }
#pragma unroll
            for (int tap = 0; tap < 3; ++tap) {
                const LAS bf16* rp = Raw + (pjr - 1 + tap) * 192 + c4;
                const v2u xr = *(const LAS v2u*)rp, xk = *(const LAS v2u*)(rp + 64), xv = *(const LAS v2u*)(rp + 128);
                const f32x4 wr = *(const LAS f32x4*)(CST + (4 + tap) * 64 + c4), wk = *(const LAS f32x4*)(CST + (7 + tap) * 64 + c4), wv = *(const LAS f32x4*)(CST + (10 + tap) * 64 + c4);
                rr[0] += wr[0] * bflo(xr.x); rr[1] += wr[1] * bfhi(xr.x); rr[2] += wr[2] * bflo(xr.y); rr[3] += wr[3] * bfhi(xr.y);
                kv[0] += wk[0] * bflo(xk.x); kv[1] += wk[1] * bfhi(xk.x); kv[2] += wk[2] * bflo(xk.y); kv[3] += wk[3] * bfhi(xk.y);
                vv[0] += wv[0] * bflo(xv.x); vv[1] += wv[1] * bfhi(xv.x); vv[2] += wv[2] * bflo(xv.y); vv[3] += wv[3] * bfhi(xv.y);
            }
            const f32x4 kkc4 = *(const LAS f32x4*)(CST + 2 * 64 + c4), kac4 = *(const LAS f32x4*)(CST + 3 * 64 + c4);
            const f32x4 al4 = *(const LAS f32x4*)(AL + pli * 64 + c4) + *(const LAS f32x4*)(CST + 64 + c4);
            float kx[4]; float ss = 0.f;
#pragma unroll
            for (int e = 0; e < 4; ++e) { kx[e] = kv[e] * kkc4[e]; ss += kx[e] * kx[e]; }
            ss = sum16(ss);
            const float rn = __builtin_amdgcn_rcpf(fmaxf(__builtin_amdgcn_sqrtf(ss), 1e-12f));
            float kh[4], bh[4], kk_[4], rh[4];
#pragma unroll
            for (int e = 0; e < 4; ++e) { const float av = __builtin_amdgcn_rcpf(1.0f + fexp(-al4[e])), kn = kx[e] * rn, en = fexp(-cum[e]), ep = fexp(cum[e]), epv = fexp(cpv[e]);
                kh[e] = kv[e] * (1.0f + (av - 1.0f) * kac4[e]) * en; bh[e] = kn * av * en; kk_[e] = kn * epv; rh[e] = rr[e] * ep; }
            v2u o;
            o.x = pk2(kh[0], kh[1]); o.y = pk2(kh[2], kh[3]); *(LAS v2u*)(KhT + pi * 72 + c4) = o;
            o.x = pk2(bh[0], bh[1]); o.y = pk2(bh[2], bh[3]); *(LAS v2u*)(BhT + pi * 72 + c4) = o;
            o.x = pk2(kk_[0], kk_[1]); o.y = pk2(kk_[2], kk_[3]); *(LAS v2u*)(KkT + pi * 72 + c4) = o;
            o.x = pk2(rh[0], rh[1]); o.y = pk2(rh[2], rh[3]); *(LAS v2u*)(RhT + pi * 72 + c4) = o;
#pragma unroll
            for (int e = 0; e < 4; ++e) { Kh[(c4 + e) * 40 + pi] = (bf16)f2bf(kh[e]); nBh[(c4 + e) * 40 + pi] = (bf16)f2bf(-bh[e]); VT[(c4 + e) * 40 + pi] = (bf16)f2bf(vv[e]); }
            if (pi == 31) *(LAS f32x4*)(GL + c4) = (f32x4){fexp(cum[0]), fexp(cum[1]), fexp(cum[2]), fexp(cum[3])};
        }
        }
        if (n + 3 < nchT) lstore((n + 3) & 1);
        lds_barrier();
    }
}

DI void mlstm_task(KArgs a, const Ctx& F, int l, int b, int hd) {
    const bf16* Z = (const bf16*)(a->ws + WS_ACT);
    const int tid = F.tid, lane = F.lane, wave = F.wave, dir = wave >> 2, w2 = wave & 3, tid2 = tid & 255, l31 = lane & 31, hh = lane >> 5;
    bf16* YM = (bf16*)(a->ws + WS_YM) + (size_t)dir * NROWS * 256;
    constexpr int HP = 72;
    constexpr int HALF_LDS = 6 * 9216 + 2304 + 2048;
    LAS uchar* base = F.lds + dir * HALF_LDS;
    LAS bf16* Qc = (LAS bf16*)base; LAS bf16* Kc = Qc + 64 * HP; LAS bf16* KT = Kc + 64 * HP; LAS bf16* VT = KT + 64 * HP; LAS bf16* Cb0 = VT + 64 * HP;
    LAS float* fv = (LAS float*)(base + 6 * 9216);
    LAS float* Vgv = fv; LAS float* VMr = fv + 64; LAS float* Vwi = fv + 128; LAS float* Vem = fv + 192; LAS float* Vwk = fv + 256; LAS float* Vn0 = fv + 320; LAS float* Vsc = fv + 448;
    LAS float* Cw = fv + 576;
    for (int i = tid2; i < 2 * 64 * HP; i += 256) Cb0[i] = 0;
    if (tid2 < 128) Vn0[tid2] = 0.f;
    { const float* cw = a->in[I_MCW] + (size_t)l * 3 * 512; const float* cbp = a->in[I_MCB] + (size_t)l * 512;
      for (int i = tid2; i < 512; i += 256) { const int tap = i >> 7, cc = i & 127, col = (cc < 64) ? (hd * 64 + cc) : (256 + hd * 64 + cc - 64);
          Cw[i] = (tap < 3) ? cw[tap * 512 + col] : cbp[col]; } }
    f32x16 accC;
#pragma unroll
    for (int r = 0; r < 16; ++r) accC[r] = 0.f;
    float m_run = 0.f;
    const int eb = w2 >> 1, lb = w2 & 1;
    const float gbi = a->in[I_MGB][l * 16 + dir * 8 + hd], gbf = a->in[I_MGB][l * 16 + dir * 8 + 4 + hd];
    const int nchC = TC / 64, nchT = nchC + T / 64;
    const int pi_ = tid2 >> 2, qq = tid2 & 3;
    v4u rq[3][2], rk[3][2], rv[2]; unsigned gr0 = 0u, gr1 = 0u;
    unsigned zz_ = 0u; asm volatile("" : "+v"(zz_)); const v4u zero4 = {zz_, zz_, zz_, zz_};
    auto gload = [&](int gc) {
        const int seg = gc >= nchC, ch = seg ? gc - nchC : gc, len = seg ? T : TC;
        const int tbase = dir ? (len - 64 * (ch + 1)) : 64 * ch;
        const int t = tbase + (dir ? (63 - pi_) : pi_);
#pragma unroll
        for (int tap = 0; tap < 3; ++tap) { const int tt = t - 1 + tap; const bool ok = tt >= 0 && tt < len;
            const bf16* zp = Z + (size_t)tok_row(b, seg, ok ? tt : t) * ZP + ZMQK + hd * 64 + qq * 16;
            rq[tap][0] = ok ? *(const v4u*)zp : zero4; rq[tap][1] = ok ? *(const v4u*)(zp + 8) : zero4;
            rk[tap][0] = ok ? *(const v4u*)(zp + 256) : zero4; rk[tap][1] = ok ? *(const v4u*)(zp + 264) : zero4; }
        { const bf16* zp = Z + (size_t)tok_row(b, seg, t) * ZP + ZMV + hd * 64 + qq * 16; rv[0] = *(const v4u*)zp; rv[1] = *(const v4u*)(zp + 8); }
        if (tid2 < 64) { const bf16* zp = Z + (size_t)tok_row(b, seg, tbase + tid2) * ZP + ZMG + dir * 8 + hd; gr0 = zp[0]; gr1 = zp[4]; }
    };
    gload(0);
    __syncthreads();
    for (int gc = 0; gc < nchT; ++gc) {
        const int seg = gc >= nchC, ch = seg ? gc - nchC : gc, len = seg ? T : TC;
        const int tbase = dir ? (len - 64 * (ch + 1)) : 64 * ch;
        LAS bf16* Cb = Cb0 + (gc & 1) * 64 * HP; LAS bf16* CbN = Cb0 + ((gc + 1) & 1) * 64 * HP;
        LAS float* Vn = Vn0 + (gc & 1) * 64; LAS float* VnN = Vn0 + ((gc + 1) & 1) * 64;
        if (w2 == 0) {
            float li = bf2f(gr0) + gbi; const float fraw = bf2f(gr1) + gbf;
            float lf = fminf(fraw, 0.f) - 0.69314718056f * __builtin_amdgcn_logf(1.0f + fexp(-fabsf(fraw)));
            if (dir) { li = __shfl(li, 63 - lane); lf = __shfl(lf, 63 - lane); }
            const float bc = wave_scan_sum(lf);
            const float g = li - bc; const float pm = wave_scan_max(g);
            const float mprev = m_run;
            const float blast = __shfl(bc, 63);
            const float lw = blast - bc + li;
            const float mnew = fmaxf(blast + mprev, wave_max(lw));
            const float Mr = fmaxf(mprev, pm);
            Vgv[lane] = g; VMr[lane] = Mr; Vwi[lane] = fexp(mprev - Mr); Vem[lane] = fexp(-bc - Mr); Vwk[lane] = fexp(lw - mnew);
            if (lane == 0) Vsc[0] = fexp(blast + mprev - mnew);
            m_run = mnew;
        }
        {
            float qv[16], kvv[16];
#pragma unroll
            for (int j = 0; j < 16; ++j) { qv[j] = Cw[384 + qq * 16 + j]; kvv[j] = Cw[384 + 64 + qq * 16 + j]; }
#pragma unroll
            for (int tap = 0; tap < 3; ++tap) {
                const unsigned qw[8] = {rq[tap][0].x, rq[tap][0].y, rq[tap][0].z, rq[tap][0].w, rq[tap][1].x, rq[tap][1].y, rq[tap][1].z, rq[tap][1].w};
                const unsigned kw[8] = {rk[tap][0].x, rk[tap][0].y, rk[tap][0].z, rk[tap][0].w, rk[tap][1].x, rk[tap][1].y, rk[tap][1].z, rk[tap][1].w};
#pragma unroll
                for (int j = 0; j < 8; ++j) { qv[2 * j] += Cw[tap * 128 + qq * 16 + 2 * j] * bflo(qw[j]); qv[2 * j + 1] += Cw[tap * 128 + qq * 16 + 2 * j + 1] * bfhi(qw[j]);
                    kvv[2 * j] += Cw[tap * 128 + 64 + qq * 16 + 2 * j] * bflo(kw[j]); kvv[2 * j + 1] += Cw[tap * 128 + 64 + qq * 16 + 2 * j + 1] * bfhi(kw[j]); }
            }
#pragma unroll
            for (int j = 0; j < 16; ++j) { qv[j] = qv[j] * fsigmoid(qv[j]); kvv[j] = kvv[j] * fsigmoid(kvv[j]) * 0.125f; }
#pragma unroll
            for (int j = 0; j < 16; j += 2) { *(LAS unsigned*)(Qc + pi_ * HP + qq * 16 + j) = pk2(qv[j], qv[j + 1]); *(LAS unsigned*)(Kc + pi_ * HP + qq * 16 + j) = pk2(kvv[j], kvv[j + 1]); }
            const unsigned vw[8] = {rv[0].x, rv[0].y, rv[0].z, rv[0].w, rv[1].x, rv[1].y, rv[1].z, rv[1].w};
#pragma unroll
            for (int j = 0; j < 16; ++j) { KT[(qq * 16 + j) * HP + pi_] = (bf16)f2bf(kvv[j]); VT[(qq * 16 + j) * HP + pi_] = (bf16)((j & 1) ? (vw[j >> 1] >> 16) : (vw[j >> 1] & 0xffffu)); }
        }
        if (gc + 1 < nchT) gload(gc + 1);
        lds_barrier();
        {
            const int lidx = 32 * lb + l31;
            f32x16 accN, accI;
#pragma unroll
            for (int r = 0; r < 16; ++r) { accN[r] = 0.f; accI[r] = 0.f; }
            float dsum = 0.f;
            const float Mr = VMr[lidx];
#pragma unroll
            for (int sb = 0; sb < 2; ++sb) {
                if (sb <= lb) {
                    f32x16 sT;
#pragma unroll
                    for (int r = 0; r < 16; ++r) sT[r] = 0.f;
#pragma unroll
                    for (int s = 0; s < 4; ++s) {
                        const bf16x8 ka = *(const LAS bf16x8*)(Kc + (32 * sb + l31) * HP + 16 * s + 8 * hh);
                        const bf16x8 qb = *(const LAS bf16x8*)(Qc + lidx * HP + 16 * s + 8 * hh);
                        sT = mfma32(ka, qb, sT);
                    }
#pragma unroll
                    for (int g4 = 0; g4 < 4; ++g4) { const f32x4 gv4 = *(const LAS f32x4*)(Vgv + 32 * sb + 8 * g4 + 4 * hh);
#pragma unroll
                        for (int e = 0; e < 4; ++e) { const int r = 4 * g4 + e, sidx = 32 * sb + 8 * g4 + 4 * hh + e;
                            const float ex = fexp(fminf(gv4[e] - Mr, 0.f));
                            const float p = (sidx <= lidx) ? sT[r] * ex : 0.f; sT[r] = p; dsum += p; } }
#pragma unroll
                    for (int sp = 0; sp < 2; ++sp) {
                        const bf16x8 pf = pack8(sT[8 * sp + 0], sT[8 * sp + 1], sT[8 * sp + 2], sT[8 * sp + 3], sT[8 * sp + 4], sT[8 * sp + 5], sT[8 * sp + 6], sT[8 * sp + 7]);
                        const int ko = 32 * sb + 16 * sp + 4 * hh;
                        const bf16x4 a0 = *(const LAS bf16x4*)(VT + (32 * eb + l31) * HP + ko), a1 = *(const LAS bf16x4*)(VT + (32 * eb + l31) * HP + ko + 8);
                        accN = mfma32(__builtin_shufflevector(a0, a1, 0, 1, 2, 3, 4, 5, 6, 7), pf, accN);
                    }
                }
            }
#pragma unroll
            for (int s = 0; s < 4; ++s) {
                const bf16x8 ca = *(const LAS bf16x8*)(Cb + (32 * eb + l31) * HP + 16 * s + 8 * hh);
                const bf16x8 qb = *(const LAS bf16x8*)(Qc + lidx * HP + 16 * s + 8 * hh);
                accI = mfma32(ca, qb, accI);
            }
            dsum += __shfl_xor(dsum, 32);
            float nq = 0.f;
#pragma unroll
            for (int j = 0; j < 64; j += 8) { const v4u w = *(const LAS v4u*)(Qc + lidx * HP + j); const f32x4 n0 = *(const LAS f32x4*)(Vn + j), n1 = *(const LAS f32x4*)(Vn + j + 4);
                nq += (n0[0] * bflo(w.x) + n0[1] * bfhi(w.x)) + (n0[2] * bflo(w.y) + n0[3] * bfhi(w.y)) + (n1[0] * bflo(w.z) + n1[1] * bfhi(w.z)) + (n1[2] * bflo(w.w) + n1[3] * bfhi(w.w)); }
            const float wi = Vwi[lidx];
            const float den = dsum + wi * nq, hden = fmaxf(fabsf(den), Vem[lidx]), inv = __builtin_amdgcn_rcpf(hden);
            const int t = dir ? (tbase + 63 - lidx) : (tbase + lidx);
            bf16* op = YM + (size_t)tok_row(b, seg, t) * 256 + hd * 64 + 32 * eb;
#pragma unroll
            for (int gq_ = 0; gq_ < 4; ++gq_) {
                const float h0 = (accN[4 * gq_] + wi * accI[4 * gq_]) * inv, h1 = (accN[4 * gq_ + 1] + wi * accI[4 * gq_ + 1]) * inv, h2 = (accN[4 * gq_ + 2] + wi * accI[4 * gq_ + 2]) * inv, h3 = (accN[4 * gq_ + 3] + wi * accI[4 * gq_ + 3]) * inv;
                v2u o; o.x = pk2(h0, h1); o.y = pk2(h2, h3);
                *(v2u*)(op + 8 * gq_ + 4 * hh) = o;
            }
        }
        {
            const float sc = Vsc[0];
#pragma unroll
            for (int r = 0; r < 16; ++r) accC[r] *= sc;
#pragma unroll
            for (int s = 0; s < 4; ++s) {
                const v4u vraw = *(const LAS v4u*)(VT + (32 * eb + l31) * HP + 16 * s + 8 * hh);
                const f32x4 w0 = *(const LAS f32x4*)(Vwk + 16 * s + 8 * hh), w1 = *(const LAS f32x4*)(Vwk + 16 * s + 8 * hh + 4);
                const bf16x8 va = pack8(bflo(vraw.x) * w0[0], bfhi(vraw.x) * w0[1], bflo(vraw.y) * w0[2], bfhi(vraw.y) * w0[3], bflo(vraw.z) * w1[0], bfhi(vraw.z) * w1[1], bflo(vraw.w) * w1[2], bfhi(vraw.w) * w1[3]);
                const bf16x8 kb = *(const LAS bf16x8*)(KT + (32 * lb + l31) * HP + 16 * s + 8 * hh);
                accC = mfma32(va, kb, accC);
            }
#pragma unroll
            for (int r = 0; r < 16; ++r) CbN[(32 * eb + crow(r, hh)) * HP + 32 * lb + l31] = (bf16)f2bf(accC[r]);
            if (tid2 < 64) { float s = 0.f;
#pragma unroll
                for (int j = 0; j < 64; j += 8) { const v4u w = *(const LAS v4u*)(KT + tid2 * HP + j); const f32x4 w0 = *(const LAS f32x4*)(Vwk + j), w1 = *(const LAS f32x4*)(Vwk + j + 4);
                    s += (w0[0] * bflo(w.x) + w0[1] * bfhi(w.x)) + (w0[2] * bflo(w.y) + w0[3] * bfhi(w.y)) + (w1[0] * bflo(w.z) + w1[1] * bfhi(w.z)) + (w1[2] * bflo(w.w) + w1[3] * bfhi(w.w)); }
                VnN[tid2] = sc * Vn[tid2] + s; }
        }
        lds_barrier();
    }
}
DI float gelu_tanh(float x) { const float u = 0.7978845608028654f * (x + 0.044715f * x * x * x); const float e = __expf(2.0f * u); const float th = 1.0f - 2.0f / (e + 1.0f); return 0.5f * x * (1.0f + th); }
DI void unpack8(const v4u w, float (&o)[8]) { o[0] = bflo(w.x); o[1] = bfhi(w.x); o[2] = bflo(w.y); o[3] = bfhi(w.y); o[4] = bflo(w.z); o[5] = bfhi(w.z); o[6] = bflo(w.w); o[7] = bfhi(w.w); }
DI v4u pack8u(const float (&o)[8]) { v4u w; w.x = pk2(o[0], o[1]); w.y = pk2(o[2], o[3]); w.z = pk2(o[4], o[5]); w.w = pk2(o[6], o[7]); return w; }
constexpr int FIN_CST_OFF = 56320;
DI void fin_load_consts(KArgs a, const Ctx& F, int l) {
    LAS float* C = (LAS float*)(F.lds + FIN_CST_OFF);
    for (int i = F.tid; i < 4608; i += NTHR) {
        float v;
        if (i < 2304) v = a->in[I_RCW][(size_t)l * 2304 + i];
        else if (i < 3072) v = a->in[I_RCB][(size_t)l * 768 + (i - 2304)];
        else if (i < 3328) v = a->in[I_RRK][l * 256 + (i - 3072)];
        else if (i < 3584) v = a->in[I_RLNW][l * 256 + (i - 3328)];
        else if (i < 3840) v = a->in[I_RLNB][l * 256 + (i - 3584)];
        else if (i < 4096) v = a->in[I_MNORM][l * 256 + (i - 3840)];
        else if (i < 4352) v = a->in[I_S5D][l * 256 + (i - 4096)];
        else v = a->in[I_S5BGLU][l * 256 + (i - 4352)];
        C[i] = v;
    }
    __syncthreads();
}
DI void fin_tile(KArgs a, const Ctx& F, int l, int tile) {
    const LAS float* CT = (const LAS float*)(F.lds + FIN_CST_OFF);
    const bf16* Z = (const bf16*)(a->ws + WS_ACT); bf16* MO = (bf16*)(a->ws + WS_H);
    const bf16* YS = (const bf16*)(a->ws + WS_YS5); const bf16* YR = (const bf16*)(a->ws + WS_YR); const bf16* YM = (const bf16*)(a->ws + WS_YM);
    const bf16* WGLU = (const bf16*)(a->ws + WS_SMALLW + SW_GLU); const bf16* WGUP = (const bf16*)(a->ws + WS_SMALLW + SW_GUP);
    LAS bf16* Az = (LAS bf16*)F.lds;
    LAS bf16* Ag = (LAS bf16*)(F.lds + 16896);
    LAS float* Pr = (LAS float*)(F.lds + 16896 + 4608);
    int tl_ = F.tid; asm volatile("" : "+v"(tl_));
    const int tid = tl_, lane = tid & 63, wave = F.wave, row0 = tile * 32;
    const int i = tid >> 4, part = tid & 15, row = row0 + i;
    const size_t DS = (size_t)NROWS * 256;
    const bf16* zr = Z + (size_t)row * ZP;
    {
        const LAS float* dsk = CT + 4096 + part * 16;
#pragma unroll
        for (int j = 0; j < 2; ++j) { const int c0 = part * 16 + 8 * j; float y0[8], y1[8], u[8], z[8];
            unpack8(*(const v4u*)(YS + (size_t)row * 256 + c0), y0); unpack8(*(const v4u*)(YS + DS + (size_t)row * 256 + c0), y1); unpack8(*(const v4u*)(zr + ZS5 + c0), u);
#pragma unroll
            for (int e = 0; e < 8; ++e) z[e] = gelu_tanh(y0[e] + y1[e] + dsk[8 * j + e] * u[e]);
            *(LAS v4u*)(Az + i * 264 + c0) = pack8u(z); }
    }
    const int hq = part >> 2, c0 = hq * 64 + (part & 3) * 16;
    const bool lat = row < NLAT; const int t = lat ? (row & (T - 1)) : ((row - NLAT) & (TC - 1)); const int len = lat ? T : TC;
    {
        float y[16]; float s = 0.f;
#pragma unroll
        for (int j = 0; j < 2; ++j) { float y0[8], y1[8]; unpack8(*(const v4u*)(YM + (size_t)row * 256 + c0 + 8 * j), y0); unpack8(*(const v4u*)(YM + DS + (size_t)row * 256 + c0 + 8 * j), y1);
#pragma unroll
            for (int e = 0; e < 8; ++e) { y[8 * j + e] = y0[e] + y1[e]; s += y[8 * j + e]; } }
        s += __shfl_xor(s, 1); s += __shfl_xor(s, 2); const float mu = s * (1.0f / 64.0f); float q = 0.f;
#pragma unroll
        for (int j = 0; j < 16; ++j) { y[j] -= mu; q += y[j] * y[j]; }
        q += __shfl_xor(q, 1); q += __shfl_xor(q, 2); const float rstd = 1.0f / sqrtf(q * (1.0f / 64.0f) + 1e-6f);
        const LAS float* nw = CT + 3840 + c0;
#pragma unroll
        for (int j = 0; j < 2; ++j) { float o[8]; unpack8(*(const v4u*)(zr + ZMO + c0 + 8 * j), o);
#pragma unroll
            for (int e = 0; e < 8; ++e) o[e] = y[8 * j + e] * rstd * nw[8 * j + e] * fsigmoid(o[e]);
            *(v4u*)(MO + (size_t)row * D + 768 + c0 + 8 * j) = pack8u(o); }
    }
    {
        float y[16]; float s = 0.f;
#pragma unroll
        for (int j = 0; j < 2; ++j) { float y0[8], y1[8]; unpack8(*(const v4u*)(YR + (size_t)row * 256 + c0 + 8 * j), y0); unpack8(*(const v4u*)(YR + DS + (size_t)row * 256 + c0 + 8 * j), y1);
#pragma unroll
            for (int e = 0; e < 8; ++e) { y[8 * j + e] = y0[e] + y1[e]; s += y[8 * j + e]; } }
        s += __shfl_xor(s, 1); s += __shfl_xor(s, 2); const float mu = s * (1.0f / 64.0f); float q = 0.f;
#pragma unroll
        for (int j = 0; j < 16; ++j) { y[j] -= mu; q += y[j] * y[j]; }
        q += __shfl_xor(q, 1); q += __shfl_xor(q, 2); const float rstd = 1.0f / sqrtf(q * (1.0f / 64.0f) + 64e-5f);
        const LAS float* cw = CT; const LAS float* cbp = CT + 2304;
        const LAS float* rk = CT + 3072 + c0; const LAS float* lw = CT + 3328 + c0; const LAS float* lb = CT + 3584 + c0;
        float vv[16]; float bs = 0.f;
#pragma unroll
        for (int j = 0; j < 2; ++j) { const int c = c0 + 8 * j;
            float rr[8], kk[8], v[8], x[8];
#pragma unroll
            for (int e = 0; e < 8; ++e) { rr[e] = cbp[c + e]; kk[e] = cbp[256 + c + e]; v[e] = cbp[512 + c + e]; }
#pragma unroll
            for (int tap = 0; tap < 3; ++tap) { const int tt = t - 1 + tap;
                if (tt >= 0 && tt < len) { const bf16* zp = zr + (tap - 1) * ZP + ZRKV + c;
                    unpack8(*(const v4u*)zp, x);
#pragma unroll
                    for (int e = 0; e < 8; ++e) rr[e] += cw[tap * 768 + c + e] * x[e];
                    unpack8(*(const v4u*)(zp + 256), x);
#pragma unroll
                    for (int e = 0; e < 8; ++e) kk[e] += cw[tap * 768 + 256 + c + e] * x[e];
                    unpack8(*(const v4u*)(zp + 512), x);
#pragma unroll
                    for (int e = 0; e < 8; ++e) v[e] += cw[tap * 768 + 512 + c + e] * x[e]; } }
#pragma unroll
            for (int e = 0; e < 8; ++e) { bs += rr[e] * kk[e] * rk[8 * j + e]; vv[8 * j + e] = v[e]; } }
        bs += __shfl_xor(bs, 1); bs += __shfl_xor(bs, 2);
#pragma unroll
        for (int j = 0; j < 16; j += 4) *(LAS f32x4*)(Pr + i * 260 + c0 + j) = (f32x4){y[j] * rstd * lw[j] + lb[j] + bs * vv[j], y[j + 1] * rstd * lw[j + 1] + lb[j + 1] + bs * vv[j + 1], y[j + 2] * rstd * lw[j + 2] + lb[j + 2] + bs * vv[j + 2], y[j + 3] * rstd * lw[j + 3] + lb[j + 3] + bs * vv[j + 3]};
    }
    {
        const v2u gv = *(const v2u*)(zr + ZGD + part * 4);
        v2u o; o.x = pk2(fsigmoid(bflo(gv.x)), fsigmoid(bfhi(gv.x))); o.y = pk2(fsigmoid(bflo(gv.y)), fsigmoid(bfhi(gv.y)));
        *(LAS v2u*)(Ag + i * 72 + part * 4) = o;
    }
    __syncthreads();
    const int lr = lane & 15, kq = lane >> 4;
    {
        f32x4 acc[2][2];
        small_gemm<256, 2, 2, true>(Az, 264, WGLU, 32 * wave, acc, lane);
        const LAS float* bg = CT + 4352;
#pragma unroll
        for (int nb = 0; nb < 2; ++nb)
#pragma unroll
            for (int mb = 0; mb < 2; ++mb) { const int tk = 16 * mb + lr, n = 32 * wave + 16 * nb + 4 * kq; const f32x4 v = acc[nb][mb]; const f32x4 b4 = *(const LAS f32x4*)(bg + n);
                const v2u zz = *(const LAS v2u*)(Az + tk * 264 + n);
                const float o0 = bflo(zz.x) * fsigmoid(v.x + b4.x), o1 = bfhi(zz.x) * fsigmoid(v.y + b4.y), o2 = bflo(zz.y) * fsigmoid(v.z + b4.z), o3 = bfhi(zz.y) * fsigmoid(v.w + b4.w);
                v2u o; o.x = pk2(o0, o1); o.y = pk2(o2, o3);
                *(v2u*)(MO + (size_t)(row0 + tk) * D + n) = o; }
    }
    {
        f32x4 acc[2][2];
        small_gemm<64, 2, 2, true>(Ag, 72, WGUP, 32 * wave, acc, lane);
#pragma unroll
        for (int nb = 0; nb < 2; ++nb)
#pragma unroll
            for (int mb = 0; mb < 2; ++mb) { const int tk = 16 * mb + lr, n = 32 * wave + 16 * nb + 4 * kq; const f32x4 v = acc[nb][mb];
                const f32x4 pr = *(const LAS f32x4*)(Pr + tk * 260 + n);
                v2u o; o.x = pk2(pr.x * v.x, pr.y * v.y); o.y = pk2(pr.z * v.z, pr.w * v.w);
                *(v2u*)(MO + (size_t)(row0 + tk) * D + 512 + n) = o; }
    }
    __syncthreads();
}
#ifndef MK_SPLIT
#define MK_SPLIT 1
#endif
#ifndef MERGE_PREP
#define MERGE_PREP 1
#endif
#ifdef USE_NOINLINE
#define NI static __device__ __noinline__
#else
#define NI static __device__ __forceinline__
#endif
extern __shared__ __attribute__((aligned(16))) unsigned char lds_raw[];
DI Ctx make_ctx(int wave0) {
    Ctx F; F.lds = (LAS uchar*)lds_raw; { int ln_ = __builtin_amdgcn_mbcnt_hi(~0u, __builtin_amdgcn_mbcnt_lo(~0u, 0u)); asm volatile("" : "+v"(ln_)); F.lane = ln_; } F.wave = wave0; F.tid = wave0 * 64 + F.lane;
    F.G = gridDim.x; { int bx = blockIdx.x; asm volatile("" : "+s"(bx)); F.vcu = (F.G % 8 == 0) ? (bx % 8) * (F.G / 8) + bx / 8 : bx; }
    return F;
}
DI void att_subbarrier(unsigned* cnt, unsigned n_att, bool t0) {
    asm volatile("s_waitcnt vmcnt(0)" ::: "memory");
    __syncthreads();
    if (t0) {
        __builtin_amdgcn_fence(__ATOMIC_RELEASE, "agent");
        asm volatile("s_waitcnt vmcnt(0)" ::: "memory");
        (void)xb_add(cnt, 1u);
        unsigned sp = 0u;
        while (xb_ld(cnt) < n_att) { __builtin_amdgcn_s_sleep(1); if (++sp > XB_SPIN_CAP) break; }
        __builtin_amdgcn_fence(__ATOMIC_ACQUIRE, "agent");
        asm volatile("s_waitcnt vmcnt(0)" ::: "memory");
    }
    __syncthreads();
}
NI void ph_prologue(KArgs a_, int wave0) { KArgs a = a_; asm volatile("" : "+s"(a)); const Ctx F = make_ctx(wave0); phase_prologue(a, F); __syncthreads(); }
NI void ph_norm(KArgs a_, int wave0, int l, int kind) { KArgs a = a_; asm volatile("" : "+s"(a));
    const Ctx F = make_ctx(wave0);
    float* modv = (float*)(a->ws + WS_MODV);
    const bool last = (l == DEPTH - 1);
    if (kind == 0) convert_weights(a, F, l, 0);
    if (kind == 1) convert_weights(a, F, l, 1);
    const int lY = (kind == 0) ? (l > 0 ? l - 1 : 0) : l;
    const int gi = (kind == 0 || kind == 3) ? 8 : (kind == 1 ? 2 : 5);
    const int pi = (kind == 0 || kind == 3) ? 2 : (kind == 1 ? 0 : 1);
    const float coef = (kind == 2) ? 1.0f : 0.5f;
    const int si = (kind == 0) ? 0 : (kind == 1 ? 3 : 6);
    const int ni = (kind == 0) ? 0 : (kind == 1 ? 1 : 2);
    const bool first = (kind == 0 && l == 0), hasY = !(kind == 0 && l == 0), hasH = (kind != 3), fin = (kind == 3);
    const int nrows = (kind == 3 || (kind == 2 && last)) ? NLAT : NROWS;
    norm_rows(a, F, first, hasY, hasH, fin, nrows, modv + (size_t)lY * 9 * MODW, gi, a->in[I_NPOST] + (lY * 3 + pi) * D, coef, modv + (size_t)l * 9 * MODW, si, a->in[I_NPRE] + (l * 3 + ni) * D);
    __syncthreads();
}
NI void ph_gemm_swiglu(KArgs a_, int wave0, int M) { KArgs a = a_; asm volatile("" : "+s"(a));
    const Ctx F = make_ctx(wave0);
    pg8::Gemm g{(const bf16*)(a->ws + WS_H), (const bf16*)(a->ws + WS_WGU), M, 2 * FF, D}; pg8::StaticOrder S; S.init(M, 2 * FF, F.G, (int)blockIdx.x);
    pg8::EpiSwiGLU E{(bf16*)(a->ws + WS_ACT), FF};
    pg8::gemm_phase<pg8::EpiSwiGLU, pg8::StaticOrder, PG8_ALIGN, PG8_SP2>(F.lds, g, S, E, F.tid);
}
NI void ph_gemm_store(KArgs a_, int wave0, int which, int M) { KArgs a = a_; asm volatile("" : "+s"(a));
    const Ctx F = make_ctx(wave0);
    const bf16* A = (const bf16*)(a->ws + (which == 0 ? WS_ACT : WS_H));
    const bf16* W = (const bf16*)(a->ws + (which == 0 ? WS_WDN : which == 1 ? WS_WIN : WS_WOUT));
    const int N = which == 1 ? ZPAD : D, K = which == 0 ? FF : D;
    const bool split_ctx = (which != 1) && (M == NROWS);
    const int Mg = split_ctx ? NLAT : M;
    pg8::Gemm g{A, W, Mg, N, K}; pg8::StaticOrder S; S.init(Mg, N, F.G, (int)blockIdx.x);
    pg8::EpiStore E{(bf16*)(a->ws + (which == 1 ? WS_ACT : WS_Y)), which == 1 ? ZP : D, which == 1 ? ZP : D};
    pg8::gemm_phase<pg8::EpiStore, pg8::StaticOrder, PG8_ALIGN, PG8_SP2>(F.lds, g, S, E, F.tid);
    if (split_ctx) { __syncthreads(); ctx_gemm_block(F, A, W, K, (bf16*)(a->ws + WS_Y)); }
}
NI void ph_mla_prep(KArgs a_, int wave0, int l, int first, int stride) { KArgs a = a_; asm volatile("" : "+s"(a)); const Ctx F = make_ctx(wave0); for (int tile = first; tile < NROWS / 64; tile += stride) mla_prep_tile(a, F, l, tile); }
NI void ph_rwkv(KArgs a_, int wave0, int l, int v) { KArgs a = a_; asm volatile("" : "+s"(a)); const Ctx F = make_ctx(wave0); rwkv_scan_task(a, F, l, v >> 3, (v >> 1) & 3, v & 1); }
NI void ph_mlstm(KArgs a_, int wave0, int l, int idx) { KArgs a = a_; asm volatile("" : "+s"(a)); const Ctx F = make_ctx(wave0); mlstm_task(a, F, l, idx >> 2, idx & 3); __syncthreads(); }
NI void ph_s5(KArgs a_, int wave0, int l, int wg) { KArgs a = a_; asm volatile("" : "+s"(a)); const Ctx F = make_ctx(wave0); const int tk = wg * 8 + F.wave; s5_scan_task(a, l, tk >> 5, (tk >> 4) & 1, tk & 15, (LAS bf16*)(F.lds + F.wave * 8704), F.lane); __syncthreads(); }
NI void ph_attn(KArgs a_, int wave0, int first, int stride) { KArgs a = a_; asm volatile("" : "+s"(a));
    const Ctx F = make_ctx(wave0);
    for (int u = first; u < 512 + 32; u += stride) {
        if (u < 512) { const int b = u >> 6, hd = (u >> 4) & 3, qb = u & 15; attn_unit(a, F, b, hd, b * T + qb * 256, NKEY); }
        else { const int c = u - 512, b = c >> 2, hd = c & 3; attn_unit(a, F, b, hd, NLAT + b * TC, TC); }
    }
}
NI void ph_fin(KArgs a_, int wave0, int l, int M) { KArgs a = a_; asm volatile("" : "+s"(a)); const Ctx F = make_ctx(wave0); fin_load_consts(a, F, l); for (int tile = F.vcu; tile < M / 32; tile += F.G) fin_tile(a, F, l, tile); }


#ifdef DBG_CUT
NI void ph_dump(KArgs a_, int wave0) { KArgs a = a_; asm volatile("" : "+s"(a)); const Ctx F = make_ctx(wave0);
    const float* X = (const float*)(a->ws + WS_X); const bf16* Z = (const bf16*)(a->ws + WS_ACT); const bf16* Q = (const bf16*)(a->ws + WS_Q); const bf16* Kf = (const bf16*)(a->ws + WS_K); const bf16* Vt = (const bf16*)(a->ws + WS_VT);
    const bf16* YS = (const bf16*)(a->ws + WS_YS5); const bf16* YR = (const bf16*)(a->ws + WS_YR); const bf16* YM = (const bf16*)(a->ws + WS_YM); const bf16* MO = (const bf16*)(a->ws + WS_H); const bf16* Y = (const bf16*)(a->ws + WS_Y);
    const size_t DS = (size_t)NROWS * 256;
    for (size_t i = (size_t)F.vcu * NTHR + F.tid; i < (size_t)NLAT * D; i += (size_t)F.G * NTHR) {
#ifdef DBG_CTX
        const size_t r = NLAT + ((i >> 10) % NCTX);
#else
        const size_t r = i >> 10;
#endif
        const int c = (int)(i & 1023); float v = 0.f;
        if (DBG_WHICH & 1) v += X[r * D + c];
        if (DBG_WHICH & 2) { v += bf2f(Z[r * ZP + c]) + bf2f(Z[r * ZP + 1024 + c]); if (c + 2048 < ZP) v += bf2f(Z[r * ZP + 2048 + c]); }
        if (DBG_WHICH & 4) { v += bf2f(Q[r * 384 + c % 384]) + bf2f(Kf[r * 384 + c % 384]) + bf2f(Vt[i % ((size_t)NB * 4 * 64 * NKEY)]); }
        if (DBG_WHICH & 256) v += bf2f(Q[r * 384 + c % 384]);
        if (DBG_WHICH & 512) v += bf2f(Kf[r * 384 + c % 384]);
        if (DBG_WHICH & 1024) v += bf2f(Vt[i % ((size_t)NB * 4 * 64 * NKEY)]);
        if (DBG_WHICH & 2048) { const float* rc = (const float*)(a->ws + WS_ROPE); const bf16* sw = (const bf16*)(a->ws + WS_SMALLW); v += rc[i % (T * 32)] + bf2f(sw[i % 245760]); }
        if (DBG_WHICH & 8) v += bf2f(YS[r * 256 + (c & 255)]) + bf2f(YS[DS + r * 256 + (c & 255)]);
        if (DBG_WHICH & 16) v += bf2f(YR[r * 256 + (c & 255)]) + bf2f(YR[DS + r * 256 + (c & 255)]);
        if (DBG_WHICH & 32) v += bf2f(YM[r * 256 + (c & 255)]) + bf2f(YM[DS + r * 256 + (c & 255)]);
        if (DBG_WHICH & 64) v += bf2f(MO[r * D + c]);
        if (DBG_WHICH & 128) v += bf2f(Y[r * D + c]);
        a->out[i] = v;
    }
}
#endif
#if !MK_SPLIT
#if defined(ONLY_PH)
#define PHON(k) ((k) == ONLY_PH)
#elif defined(NO_PH)
#define PHON(k) ((k) != NO_PH)
#else
#define PHON(k) true
#endif
#if defined(ONLY_ROLE)
#define ROLE(k) ((k) == ONLY_ROLE)
#elif defined(NO_ROLE)
#define ROLE(k) ((k) != NO_ROLE)
#else
#define ROLE(k) true
#endif
#ifdef DUP_BAR
#define DUPBAR(x) x
#else
#define DUPBAR(x)
#endif
#ifdef DUP_ROLE
#ifndef DUP_N
#define DUP_N 2
#endif
#define NREPR(k) ((k) == DUP_ROLE ? DUP_N : 1)
#else
#define NREPR(k) 1
#endif
#ifdef DUP_PH
#define NREP(k) ((k) == DUP_PH ? 2 : 1)
#else
#define NREP(k) 1
#endif
constexpr int NPH = 2 + 12 * DEPTH;
__global__ void __launch_bounds__(NTHR, 2) hybrid_fwd(Args args_byval) {
    KArgs a = (KArgs)__builtin_amdgcn_kernarg_segment_ptr();
    LAS uchar* lds = (LAS uchar*)lds_raw;
    const int tid = threadIdx.x; const int wave0 = __builtin_amdgcn_readfirstlane(tid >> 6);
    volatile LAS unsigned* MISC = (volatile LAS unsigned*)(lds + MISC_OFF);
    for (int u = tid; u < (LDS_BYTES - LDSCTL_OFF) / 4; u += NTHR) ((LAS unsigned*)(lds + LDSCTL_OFF))[u] = 0u;
    __syncthreads();
    unsigned* ctl = (unsigned*)(a->ws + WS_CTL);
    const int use_bar = a->use_bar;
    XcdBarrier bar; bar.bar = ctl + CW_BAR; bar.x = 0; bar.st = nullptr;
    if (use_bar) bar = xcd_barrier_post(ctl + CW_BAR, MISC + 8, tid == 0);
    const int lo = a->ph_lo, hi = a->ph_hi;
    const int G = gridDim.x; const int vcu = (G % 8 == 0) ? ((int)blockIdx.x % 8) * (G / 8) + (int)blockIdx.x / 8 : (int)blockIdx.x;
#ifdef DBG_CUT
#define IN(k) (lo <= (k) && (k) < hi && (k) < DBG_CUT)
#else
#define IN(k) (lo <= (k) && (k) < hi)
#endif
#define SEAM(k) do { if (use_bar && IN(k) && IN((k) + 1)) { int ln_ = __builtin_amdgcn_mbcnt_hi(~0u, __builtin_amdgcn_mbcnt_lo(~0u, 0u)); asm volatile("" : "+v"(ln_)); xcd_barrier(bar, wave0 == 0 && ln_ == 0); DUPBAR(xcd_barrier(bar, wave0 == 0 && ln_ == 0);) } } while (0)
    if (PHON(100) && IN(0)) ph_prologue(a, wave0);
    SEAM(0);
#pragma unroll 1
    for (int l = 0; l < DEPTH; ++l) {
        const int P = 1 + 12 * l;
        const int Mtail = (l == DEPTH - 1) ? NLAT : NROWS;
        if (PHON(0) && IN(P + 0)) { ph_norm(a, wave0, l, 0);
#ifdef DUP_FIRSTNORM
            if (l == 0) for (int rr_ = 0; rr_ < DUP_FIRSTNORM; ++rr_) ph_norm(a, wave0, l, 0);
#endif
        }
        SEAM(P + 0);
        if (PHON(1) && IN(P + 1)) for (int rep_ = 0; rep_ < NREP(1); ++rep_) ph_gemm_swiglu(a, wave0, NROWS);
        SEAM(P + 1);
        if (PHON(2) && IN(P + 2)) for (int rep_ = 0; rep_ < NREP(2); ++rep_) ph_gemm_store(a, wave0, 0, NROWS);
        SEAM(P + 2);
        if (PHON(3) && IN(P + 3)) ph_norm(a, wave0, l, 1);
        SEAM(P + 3);
        if (PHON(4) && IN(P + 4)) for (int rep_ = 0; rep_ < NREP(4); ++rep_) ph_gemm_store(a, wave0, 1, NROWS);
        SEAM(P + 4);
#if MERGE_PREP
        if (PHON(6) && IN(P + 6) && G >= 256) {
            if (ROLE(0) && vcu < 64) { for (int rr_ = 0; rr_ < NREPR(0); ++rr_) ph_rwkv(a, wave0, l, vcu); }
            else if (ROLE(1) && vcu < 96) { for (int rr_ = 0; rr_ < NREPR(1); ++rr_) ph_mlstm(a, wave0, l, vcu - 64); }
            else if (ROLE(2) && vcu < 128) { for (int rr_ = 0; rr_ < NREPR(2); ++rr_) ph_s5(a, wave0, l, vcu - 96); }
            else if (ROLE(3)) {
                ph_mla_prep(a, wave0, l, vcu - 128, G - 128);
                { int ln_ = __builtin_amdgcn_mbcnt_hi(~0u, __builtin_amdgcn_mbcnt_lo(~0u, 0u)); asm volatile("" : "+v"(ln_)); att_subbarrier(ctl + CW_SUB + 64 * l, (unsigned)(G - 128), wave0 == 0 && ln_ == 0); }
                for (int rr_ = 0; rr_ < NREPR(3); ++rr_) ph_attn(a, wave0, vcu - 128, G - 128);
            }
        }
#else
        if (PHON(5) && IN(P + 5)) for (int rep_ = 0; rep_ < NREP(5); ++rep_) ph_mla_prep(a, wave0, l);
        SEAM(P + 5);
        if (PHON(6) && IN(P + 6) && G >= 256) for (int rep_ = 0; rep_ < NREP(6); ++rep_) {
            if (ROLE(0) && vcu < 64) { for (int rr_ = 0; rr_ < NREPR(0); ++rr_) ph_rwkv(a, wave0, l, vcu); }
            else if (ROLE(1) && vcu < 96) { for (int rr_ = 0; rr_ < NREPR(1); ++rr_) ph_mlstm(a, wave0, l, vcu - 64); }
            else if (ROLE(2) && vcu < 128) { for (int rr_ = 0; rr_ < NREPR(2); ++rr_) ph_s5(a, wave0, l, vcu - 96); }
            else if (ROLE(3)) { for (int rr_ = 0; rr_ < NREPR(3); ++rr_) ph_attn(a, wave0, vcu - 128, G - 128); }
        }
#endif
        SEAM(P + 6);
        if (PHON(7) && IN(P + 7)) for (int rep_ = 0; rep_ < NREP(7); ++rep_) ph_fin(a, wave0, l, Mtail);
        SEAM(P + 7);
        if (PHON(8) && IN(P + 8)) for (int rep_ = 0; rep_ < NREP(8); ++rep_) ph_gemm_store(a, wave0, 2, Mtail);
        SEAM(P + 8);
        if (PHON(9) && IN(P + 9)) ph_norm(a, wave0, l, 2);
        SEAM(P + 9);
        if (PHON(10) && IN(P + 10)) ph_gemm_swiglu(a, wave0, Mtail);
        SEAM(P + 10);
        if (PHON(11) && IN(P + 11)) ph_gemm_store(a, wave0, 0, Mtail);
        SEAM(P + 11);
    }
#ifdef DBG_CUT
    if (lo <= NPH - 1 && NPH - 1 < hi) ph_dump(a, wave0);
#else
    if (PHON(101) && IN(NPH - 1)) ph_norm(a, wave0, DEPTH - 1, 3);
#endif
#undef IN
#undef SEAM
}

#endif
#if MK_SPLIT
struct ArgsS { Args base; int kind, l, sub, M; };
typedef const __attribute__((address_space(4))) ArgsS* KArgsS;
template <int KIND>
__global__ void __launch_bounds__(NTHR, 2) phase_kernel(ArgsS args_byval) {
    KArgsS as = (KArgsS)__builtin_amdgcn_kernarg_segment_ptr();
    KArgs a = (KArgs)as;
    const int tid = threadIdx.x; const int wave0 = __builtin_amdgcn_readfirstlane(tid >> 6);
    const int l = as->l, sub = as->sub, M = as->M;
    const int G = gridDim.x; const int vcu = (G % 8 == 0) ? ((int)blockIdx.x % 8) * (G / 8) + (int)blockIdx.x / 8 : (int)blockIdx.x;
    if constexpr (KIND == 0) ph_prologue(a, wave0);
    if constexpr (KIND == 1) ph_norm(a, wave0, l, sub);
    if constexpr (KIND == 2) ph_gemm_swiglu(a, wave0, M);
    if constexpr (KIND == 3) ph_gemm_store(a, wave0, sub, M);
    if constexpr (KIND == 4) ph_mla_prep(a, wave0, l, vcu, G);
    if constexpr (KIND == 5) { if (vcu < 64) ph_rwkv(a, wave0, l, vcu); }
    if constexpr (KIND == 6) { if (vcu >= 64 && vcu < 96) ph_mlstm(a, wave0, l, vcu - 64); }
    if constexpr (KIND == 7) { if (vcu >= 96 && vcu < 128) ph_s5(a, wave0, l, vcu - 96); }
    if constexpr (KIND == 8) { if (vcu >= 128) ph_attn(a, wave0, vcu - 128, G - 128); }
    if constexpr (KIND == 9) ph_fin(a, wave0, l, M);
}
template <int KIND> static void launch_phase(int grid, hipStream_t stream, const Args& base, int l, int sub, int M) {
    static bool attr = false;
    if (!attr) { (void)hipFuncSetAttribute((const void*)phase_kernel<KIND>, hipFuncAttributeMaxDynamicSharedMemorySize, LDS_BYTES); attr = true; }
    ArgsS s{}; s.base = base; s.kind = KIND; s.l = l; s.sub = sub; s.M = M;
    hipLaunchKernelGGL(phase_kernel<KIND>, dim3(grid), dim3(NTHR), LDS_BYTES, stream, s);
}
static void launch_split(int grid, hipStream_t stream, const Args& a) {
    launch_phase<0>(grid, stream, a, 0, 0, 0);
    for (int l = 0; l < DEPTH; ++l) {
        const int Mtail = (l == DEPTH - 1) ? NLAT : NROWS;
        launch_phase<1>(grid, stream, a, l, 0, 0);
        launch_phase<2>(grid, stream, a, l, 0, NROWS);
        launch_phase<3>(grid, stream, a, l, 0, NROWS);
        launch_phase<1>(grid, stream, a, l, 1, 0);
        launch_phase<3>(grid, stream, a, l, 1, NROWS);
        launch_phase<4>(grid, stream, a, l, 0, 0);
        launch_phase<5>(grid, stream, a, l, 0, 0);
        launch_phase<6>(grid, stream, a, l, 0, 0);
        launch_phase<7>(grid, stream, a, l, 0, 0);
        launch_phase<8>(grid, stream, a, l, 0, 0);
        launch_phase<9>(grid, stream, a, l, 0, Mtail);
        launch_phase<3>(grid, stream, a, l, 2, Mtail);
        launch_phase<1>(grid, stream, a, l, 2, 0);
        launch_phase<2>(grid, stream, a, l, 0, Mtail);
        launch_phase<3>(grid, stream, a, l, 0, Mtail);
    }
    launch_phase<1>(grid, stream, a, DEPTH - 1, 3, 0);
}
#endif
extern "C" void kernel_launch(void* const* d_in, const int* in_sizes, int n_in, void* d_out, int out_size, void* d_ws, size_t ws_size, hipStream_t stream) {
    static int grid = 0;
    if (grid == 0) {
        if (n_in != 43 || out_size != NLAT * D || ws_size < WS_END) { fprintf(stderr, "kernel_launch: unexpected shapes: n_in %d out %d ws %zu (need %zu)\n", n_in, out_size, ws_size, (size_t)WS_END); grid = -1; return; }
        int dev = 0, cus = 0, per_cu = 0;
        if (hipGetDevice(&dev) != hipSuccess || hipDeviceGetAttribute(&cus, hipDeviceAttributeMultiprocessorCount, dev) != hipSuccess) { grid = -1; return; }
        if (false) { grid = -1; return; }
        (void)hipGetLastError();
        grid = cus;
    }
    if (grid < 0) return;
    (void)hipMemsetAsync((char*)d_ws + WS_CTL, 0, CTL_ZERO_BYTES, stream);
    Args a{};
    for (int i = 0; i < 43; ++i) a.in[i] = (const float*)d_in[i];
    a.out = (float*)d_out; a.ws = (unsigned char*)d_ws; a.pad = 0;
#if MK_SPLIT
    launch_split(grid, stream, a);
#else
    static bool attr1 = false; if (!attr1) { (void)hipFuncSetAttribute((const void*)hybrid_fwd, hipFuncAttributeMaxDynamicSharedMemorySize, LDS_BYTES); attr1 = true; }
    a.ph_lo = 0; a.ph_hi = NPH; a.use_bar = 1;
    hipLaunchKernelGGL(hybrid_fwd, dim3(grid), dim3(NTHR), LDS_BYTES, stream, a);
#endif
}
```

```cpp
#include <hip/hip_runtime.h>
#include <cstdio>
#include <cstdint>
#define MK_SPLIT 0
namespace pg8 {
#define PG8_LAS __attribute__((address_space(3)))
typedef unsigned short bf16_t;
typedef short bf16x8 __attribute__((ext_vector_type(8)));
typedef float f32x4 __attribute__((ext_vector_type(4)));
typedef unsigned u32x4 __attribute__((ext_vector_type(4)));
constexpr int BM = 256, BK = 64, HALF = 128, HTB = HALF * BK * 2  , STAGE_BYTES = 8 * HTB, NXCD = 8, WGM = 8;

__host__ __device__ __forceinline__ int lds_byte(int r, int c) { const int st = (r >> 4) * 2 + (c >> 5), rr = r & 15, cc = c & 31, ob = rr * 64 + cc * 2; return st * 1024 + (ob ^ (((ob >> 9) & 1) << 5)); }
__host__ __device__ __forceinline__ void stage_rc(int b, int& R, int& C) { const int st = b / 1024, sb = b % 1024, swz = sb ^ (((sb >> 9) & 1) << 5); R = (st >> 1) * 16 + swz / 64; C = (st & 1) * 32 + (swz % 64) / 2; }
__host__ __device__ __forceinline__ int perm32(int rho) { const int n = rho >> 4, i = rho & 15; return 8 * (i >> 2) + 4 * n + (i & 3); }

struct Unit { int pm, pn; };
struct Gemm { const bf16_t* A; const bf16_t* Bt; int M, N, K; };

struct StaticOrder {
    int nM, nN, nwg, G, c;
    __host__ __device__ void init(int M, int N, int G_, int c_) { nM = M / BM; nN = N / BM; nwg = nM * nN; G = G_; c = c_; }
    __host__ __device__ bool next(int i, Unit& u) const {
        const long L = (long)i * G + c; if (L >= nwg) return false;
        int wgid = (int)L; { const int q = nwg / NXCD, r = nwg % NXCD, xcd = wgid % NXCD, off = wgid / NXCD; wgid = (xcd < r ? xcd * (q + 1) : r * (q + 1) + (xcd - r) * q) + off; }
        const int nig = WGM * nN, gid = wgid / nig, fm = gid * WGM, gsz = (nM - fm) < WGM ? (nM - fm) : WGM;
        u.pm = fm + ((wgid % nig) % gsz); u.pn = (wgid % nig) / gsz; return true;
    }
    __device__ __forceinline__ void a_ready(const Unit&) const {}
    __device__ __forceinline__ void done(const Unit&) const {}
};

typedef __bf16 nbf16v2 __attribute__((ext_vector_type(2))); typedef float nf32v2 __attribute__((ext_vector_type(2)));
__device__ __forceinline__ unsigned cvt_pk_bf16(float lo, float hi) { const nf32v2 v = {lo, hi}; return __builtin_bit_cast(unsigned, __builtin_convertvector(v, nbf16v2)); }
struct EpiSwiGLU {
    static constexpr bool PERM = true, AFTER_DRAIN = false;
    bf16_t* O; int ldc;
    __device__ __forceinline__ void operator()(const f32x4 (&acc)[2][2][4][2], const Unit& u, int wr, int wc, int fr, int fq) const {
        const int row0 = u.pm * BM + wr * 64 + fr; const int col0 = u.pn * HALF + wc * 32 + 8 * fq;
#pragma unroll
        for (int ai = 0; ai < 2; ++ai)
#pragma unroll
            for (int m = 0; m < 4; ++m) { bf16_t* rowp = O + (size_t)(row0 + ai * HALF + m * 16) * ldc + col0;
                float o[8];
#pragma unroll
                for (int n = 0; n < 2; ++n)
#pragma unroll
                    for (int j = 0; j < 4; ++j) { const float g = acc[ai][0][m][n][j], up = acc[ai][1][m][n][j];
                        const float sg = __builtin_amdgcn_rcpf(1.0f + __builtin_amdgcn_exp2f(-1.44269504089f * g)); o[n * 4 + j] = g * sg * up; }
                u32x4 w; w.x = cvt_pk_bf16(o[0], o[1]); w.y = cvt_pk_bf16(o[2], o[3]); w.z = cvt_pk_bf16(o[4], o[5]); w.w = cvt_pk_bf16(o[6], o[7]);
                *(u32x4*)rowp = w; }
    }
};
struct EpiStore {
    static constexpr bool PERM = true, AFTER_DRAIN = false;
    bf16_t* O; int ldc; int ncols;
    __device__ __forceinline__ void operator()(const f32x4 (&acc)[2][2][4][2], const Unit& u, int wr, int wc, int fr, int fq) const {
        const int row0 = u.pm * BM + wr * 64 + fr; const int col0 = u.pn * BM + wc * 32 + 8 * fq;
#pragma unroll
        for (int ai = 0; ai < 2; ++ai)
#pragma unroll
            for (int m = 0; m < 4; ++m) { bf16_t* rowp = O + (size_t)(row0 + ai * HALF + m * 16) * ldc + col0;
#pragma unroll
                for (int bj = 0; bj < 2; ++bj) { if (col0 + bj * HALF < ncols) { const f32x4 v0 = acc[ai][bj][m][0], v1 = acc[ai][bj][m][1];
                    u32x4 w; w.x = cvt_pk_bf16(v0[0], v0[1]); w.y = cvt_pk_bf16(v0[2], v0[3]); w.z = cvt_pk_bf16(v1[0], v1[1]); w.w = cvt_pk_bf16(v1[2], v1[3]);
                    *(u32x4*)(rowp + bj * HALF) = w; } } }
    }
};
template <class Epi, class Sched, bool ALIGN_EPI = false, bool SP2 = false>
__device__ __forceinline__ void gemm_phase(PG8_LAS unsigned char* lds, const Gemm g, const Sched& S, const Epi& E, const int tid) {
    const int wid = __builtin_amdgcn_readfirstlane(tid >> 6), lane = tid & 63, wr = wid >> 2, wc = wid & 3, fr = lane & 15, fq = lane >> 4;
    const int K = g.K, nt = K / BK;
    unsigned voffA[2], voffB[2];
#pragma unroll
    for (int i = 0; i < 2; ++i) { int R, C; stage_rc(tid * 16 + i * 8192, R, C); const int Rb = Epi::PERM ? ((R & ~31) + perm32(R & 31)) : R;
        voffA[i] = (unsigned)(R * K + C) * 2u; voffB[i] = (unsigned)(Rb * K + C) * 2u; }
    const size_t kstep = (size_t)(BK * 2);
    const size_t hstep = (size_t)HALF * K * 2;
    const size_t tstep = 2 * hstep;
    const unsigned ldsw = (unsigned)wid * 1024u;
    const int aoff = lds_byte(wr * 64 + fr, fq * 8), boff = lds_byte(wc * 32 + fr, fq * 8);
#define PG8_SA(b, h) (((b) * 2 + (h)) * HTB)
#define PG8_SB(b, h) ((4 + (b) * 2 + (h)) * HTB)
#define PG8_STAGE(bufoff, gbase, voff) do { _Pragma("unroll") for (int _i = 0; _i < 2; ++_i) \
        __builtin_amdgcn_global_load_lds((const unsigned*)((const char*)(gbase) + (voff)[_i]), (PG8_LAS unsigned*)(lds + (bufoff) + ldsw + _i * 8192), 16, 0, 0); } while (0)
#define PG8_LDA(dst, b, h) do { _Pragma("unroll") for (int m = 0; m < 4; ++m) _Pragma("unroll") for (int k = 0; k < 2; ++k) dst[m][k] = *(const PG8_LAS bf16x8*)(lds + PG8_SA(b, h) + aoff + m * 2048 + k * 1024); } while (0)
#define PG8_LDB(dst, b, h) do { _Pragma("unroll") for (int n = 0; n < 2; ++n) _Pragma("unroll") for (int k = 0; k < 2; ++k) dst[n][k] = *(const PG8_LAS bf16x8*)(lds + PG8_SB(b, h) + boff + n * 2048 + k * 1024); } while (0)
#define PG8_MMA(ai, bj, At, Bt) do { __builtin_amdgcn_s_setprio(1); _Pragma("unroll") for (int m = 0; m < 4; ++m) _Pragma("unroll") for (int n = 0; n < 2; ++n) _Pragma("unroll") for (int k = 0; k < 2; ++k) \
        acc[ai][bj][m][n] = __builtin_amdgcn_mfma_f32_16x16x32_bf16(Bt[n][k], At[m][k], acc[ai][bj][m][n], 0, 0, 0); __builtin_amdgcn_s_setprio(0); } while (0)
#define PG8_WAIT_V(n) asm volatile("s_waitcnt vmcnt(" #n ")" ::: "memory")
#define PG8_WAIT_L(n) asm volatile("s_waitcnt lgkmcnt(" #n ")" ::: "memory")
#define PG8_BAR __builtin_amdgcn_s_barrier()
#define PG8_SCHED __builtin_amdgcn_sched_barrier(0)
    Unit cur, nxt; int ui = 0;
    if (!S.next(0, cur)) return;
    f32x4 acc[2][2][4][2];
#pragma unroll
    for (int a = 0; a < 2; ++a)
#pragma unroll
        for (int b = 0; b < 2; ++b)
#pragma unroll
            for (int m = 0; m < 4; ++m)
#pragma unroll
                for (int n = 0; n < 2; ++n) acc[a][b][m][n] = (f32x4){0.f, 0.f, 0.f, 0.f};
    bf16x8 At[4][2], B0[2][2], B1[2][2];
    const char* cA = (const char*)g.A + (size_t)cur.pm * tstep; const char* cB = (const char*)g.Bt + (size_t)cur.pn * tstep;
    S.a_ready(cur);
    if constexpr (SP2) {
        PG8_STAGE(PG8_SB(0, 0), cB, voffB); PG8_STAGE(PG8_SB(0, 1), cB + hstep, voffB); PG8_STAGE(PG8_SA(0, 0), cA, voffA); PG8_STAGE(PG8_SA(0, 1), cA + hstep, voffA);
        if (wr == 1) PG8_BAR;
        PG8_WAIT_V(2); PG8_BAR;
        PG8_STAGE(PG8_SB(1, 0), cB + kstep, voffB); PG8_STAGE(PG8_SA(1, 0), cA + kstep, voffA); PG8_STAGE(PG8_SB(1, 1), cB + hstep + kstep, voffB);
        PG8_WAIT_V(6); PG8_BAR;
    } else {
        PG8_STAGE(PG8_SB(0, 0), cB, voffB); PG8_STAGE(PG8_SA(0, 0), cA, voffA); PG8_STAGE(PG8_SB(0, 1), cB + hstep, voffB); PG8_STAGE(PG8_SA(0, 1), cA + hstep, voffA);
        if (wr == 1) PG8_BAR;
        PG8_WAIT_V(4); PG8_BAR;
        PG8_STAGE(PG8_SB(1, 0), cB + kstep, voffB); PG8_STAGE(PG8_SA(1, 0), cA + kstep, voffA); PG8_STAGE(PG8_SB(1, 1), cB + hstep + kstep, voffB);
        PG8_WAIT_V(6); PG8_BAR;
    }
    for (;;) {
        const bool has_next = S.next(ui + 1, nxt);
        const char* nA = has_next ? (const char*)g.A + (size_t)nxt.pm * tstep : cA; const char* nB = has_next ? (const char*)g.Bt + (size_t)nxt.pn * tstep : cB;
        for (int t = 0; t < nt; t += 2) {
            const bool last = (t == nt - 2);
            const char* a1 = cA + (size_t)(t + 1) * kstep;
            const char* a2 = last ? nA : cA + (size_t)(t + 2) * kstep; const char* b2 = last ? nB : cB + (size_t)(t + 2) * kstep;
            const char* a3 = a2 + kstep; const char* b3 = b2 + kstep;
            if (last && has_next) S.a_ready(nxt);
            if constexpr (SP2) {
            PG8_LDB(B0, 0, 0); PG8_LDB(B1, 0, 1); PG8_SCHED; PG8_LDA(At, 0, 0); PG8_STAGE(PG8_SA(1, 1), a1 + hstep, voffA);
            PG8_WAIT_V(8); PG8_WAIT_L(0); PG8_BAR; PG8_MMA(0, 0, At, B0); PG8_MMA(0, 1, At, B1); PG8_BAR; PG8_SCHED;
            PG8_LDA(At, 0, 1); PG8_STAGE(PG8_SB(0, 0), b2, voffB); PG8_STAGE(PG8_SB(0, 1), b2 + hstep, voffB); PG8_STAGE(PG8_SA(0, 0), a2, voffA);
            PG8_WAIT_V(8); PG8_WAIT_L(0); PG8_BAR; PG8_MMA(1, 0, At, B0); PG8_MMA(1, 1, At, B1); PG8_BAR; PG8_SCHED;
            PG8_LDB(B0, 1, 0); PG8_LDB(B1, 1, 1); PG8_SCHED; PG8_LDA(At, 1, 0); PG8_STAGE(PG8_SA(0, 1), a2 + hstep, voffA);
            PG8_WAIT_V(8); PG8_WAIT_L(0); PG8_BAR; PG8_MMA(0, 0, At, B0); PG8_MMA(0, 1, At, B1); PG8_BAR; PG8_SCHED;
            PG8_LDA(At, 1, 1); PG8_STAGE(PG8_SB(1, 0), b3, voffB); PG8_STAGE(PG8_SB(1, 1), b3 + hstep, voffB); PG8_STAGE(PG8_SA(1, 0), a3, voffA);
            PG8_WAIT_V(8); PG8_WAIT_L(0); PG8_BAR; PG8_MMA(1, 0, At, B0); PG8_MMA(1, 1, At, B1); PG8_BAR; PG8_SCHED;
            } else {
            PG8_LDB(B0, 0, 0); PG8_SCHED; PG8_LDA(At, 0, 0); PG8_STAGE(PG8_SA(1, 1), a1 + hstep, voffA);
            PG8_WAIT_L(8); PG8_BAR; PG8_WAIT_L(0); PG8_MMA(0, 0, At, B0); PG8_BAR; PG8_SCHED;
            PG8_LDB(B1, 0, 1); PG8_STAGE(PG8_SB(0, 0), b2, voffB);
            PG8_BAR; PG8_WAIT_L(0); PG8_MMA(0, 1, At, B1); PG8_BAR;
            PG8_LDA(At, 0, 1); PG8_STAGE(PG8_SA(0, 0), a2, voffA);
            PG8_BAR; PG8_WAIT_L(0); PG8_MMA(1, 0, At, B0); PG8_BAR; PG8_SCHED;
            PG8_STAGE(PG8_SB(0, 1), b2 + hstep, voffB);
            PG8_WAIT_V(6); PG8_BAR; PG8_MMA(1, 1, At, B1); PG8_BAR;
            PG8_LDB(B0, 1, 0); PG8_SCHED; PG8_LDA(At, 1, 0); PG8_STAGE(PG8_SA(0, 1), a2 + hstep, voffA);
            PG8_WAIT_L(8); PG8_BAR; PG8_WAIT_L(0); PG8_MMA(0, 0, At, B0); PG8_BAR; PG8_SCHED;
            PG8_LDB(B1, 1, 1); PG8_STAGE(PG8_SB(1, 0), b3, voffB);
            PG8_BAR; PG8_WAIT_L(0); PG8_MMA(0, 1, At, B1); PG8_BAR;
            PG8_LDA(At, 1, 1); PG8_STAGE(PG8_SA(1, 0), a3, voffA);
            PG8_BAR; PG8_WAIT_L(0); PG8_MMA(1, 0, At, B0); PG8_BAR; PG8_SCHED;
            PG8_STAGE(PG8_SB(1, 1), b3 + hstep, voffB);
            PG8_WAIT_V(6); PG8_BAR; PG8_MMA(1, 1, At, B1); PG8_BAR;
            }
        }
        if constexpr (ALIGN_EPI) { if (wr == 0) PG8_BAR; }
        if constexpr (!Epi::AFTER_DRAIN) { E(acc, cur, wr, wc, fr, fq); S.done(cur); }
        if (!has_next) break;
#pragma unroll
        for (int a = 0; a < 2; ++a)
#pragma unroll
            for (int b = 0; b < 2; ++b)
#pragma unroll
                for (int m = 0; m < 4; ++m)
#pragma unroll
                    for (int n = 0; n < 2; ++n) acc[a][b][m][n] = (f32x4){0.f, 0.f, 0.f, 0.f};
        cur = nxt; cA = nA; cB = nB; ++ui;
        if constexpr (ALIGN_EPI) { if (wr == 1) PG8_BAR; }
    }
    PG8_WAIT_V(0);
    if constexpr (!ALIGN_EPI) { if (wr == 0) PG8_BAR; }
    PG8_BAR;
    if constexpr (Epi::AFTER_DRAIN) { E.fused(acc, cur, wr, wc, fr, fq, lds, wid, lane); S.done(cur); }
#undef PG8_SA
#undef PG8_SB
#undef PG8_STAGE
#undef PG8_LDA
#undef PG8_LDB
#undef PG8_MMA
#undef PG8_WAIT_V
#undef PG8_WAIT_L
#undef PG8_BAR
#undef PG8_SCHED
}
}
#ifndef PG8_SP2
#define PG8_SP2 true
#endif
#ifndef PG8_ALIGN
#define PG8_ALIGN true
#endif

constexpr int NWAVES = 8, NTHR = 512;
constexpr int D = 1024, NB = 8, T = 4096, TC = 256, DEPTH = 4, FF = 2816, ZP = 2608, ZPAD = 2816;
constexpr int NLAT = NB * T, NCTX = NB * TC, NROWS = NLAT + NCTX;
constexpr int MODW = 9 * D;
constexpr int NKEY = TC + T;
constexpr float NORM_EPS = 1e-6f;
constexpr int ZS5 = 0, ZCQ = 256, ZCKV = 512, ZKR = 640, ZRKV = 672, ZWD = 1440, ZAD = 1472, ZGD = 1504, ZMQK = 1568, ZMV = 2080, ZMO = 2336, ZMG = 2592;

constexpr size_t MiB = 1u << 20;
constexpr size_t WS_CTL = 0, CTL_ZERO_BYTES = 1 * MiB;
constexpr size_t WS_MODV = 1 * MiB;
constexpr size_t WS_ROPE = 3 * MiB;
constexpr size_t WS_SMALLW = 4 * MiB;
constexpr size_t SW_UQ = 0, SW_UKV = 196608, SW_GLU = 327680, SW_GUP = 458752;
constexpr size_t WS_WGU = 6 * MiB, WS_WDN = 17 * MiB, WS_WIN = 23 * MiB, WS_WOUT = 29 * MiB;
constexpr size_t WS_X = 31 * MiB;
constexpr size_t WS_Y = 167 * MiB;
constexpr size_t WS_Q = WS_Y, WS_K = WS_Y + (size_t)NROWS * 384 * 2, WS_VT = WS_K + (size_t)NROWS * 384 * 2;
constexpr size_t WS_H = 235 * MiB;
constexpr size_t WS_ACT = 303 * MiB;
constexpr size_t WS_YS5 = 490 * MiB, WS_YR = 524 * MiB, WS_YM = 558 * MiB, WS_END = 592 * MiB;
static_assert(WS_VT + (size_t)NB * 4 * 64 * NKEY * 2 <= WS_H, "qkv overlay");
static_assert(WS_WGU + (size_t)5632 * 1024 * 2 <= WS_WDN && WS_WDN + (size_t)1024 * 2816 * 2 <= WS_WIN && WS_WIN + (size_t)2816 * 1024 * 2 <= WS_WOUT && WS_WOUT + 2 * MiB <= WS_X, "weights");
static_assert(WS_X + (size_t)NROWS * D * 4 <= WS_Y && WS_Y + (size_t)NROWS * D * 2 <= WS_H && WS_H + (size_t)NROWS * D * 2 <= WS_ACT && WS_ACT + (size_t)NROWS * ZPAD * 2 <= WS_YS5, "map");
static_assert(WS_YS5 + (size_t)2 * NROWS * 256 * 2 <= WS_YR && WS_YM + (size_t)2 * NROWS * 256 * 2 <= WS_END, "map2");
constexpr int CW_BAR = 4096, CW_SUB = 8192;

constexpr int RING_BYTES = 131072, LDS_BYTES = 147456, LDSCTL_OFF = LDS_BYTES - 512, MISC_OFF = LDSCTL_OFF + 320;

#define GAS __attribute__((address_space(1)))
#define LAS __attribute__((address_space(3)))
typedef unsigned short bf16;
typedef unsigned char uchar;
typedef unsigned v4u __attribute__((ext_vector_type(4)));
typedef unsigned v2u __attribute__((ext_vector_type(2)));
typedef float f32x4 __attribute__((ext_vector_type(4)));
typedef float f32x2 __attribute__((ext_vector_type(2)));
typedef float f32x16 __attribute__((ext_vector_type(16)));
typedef short bf16x8 __attribute__((ext_vector_type(8)));
typedef short bf16x4 __attribute__((ext_vector_type(4)));
#define DI __device__ __forceinline__
DI unsigned f2bf(float f) { unsigned u = __builtin_bit_cast(unsigned, f); return (u + 0x7fffu + ((u >> 16) & 1u)) >> 16; }
DI unsigned pk2(float lo, float hi) { return pg8::cvt_pk_bf16(lo, hi); }
DI float bf2f(unsigned b) { return __builtin_bit_cast(float, b << 16); }
DI float bflo(unsigned w) { return __builtin_bit_cast(float, w << 16); }
DI float bfhi(unsigned w) { return __builtin_bit_cast(float, w & 0xffff0000u); }
template <int CTRL> DI float dpp_f(float x) { return __builtin_bit_cast(float, __builtin_amdgcn_update_dpp(0, __builtin_bit_cast(int, x), CTRL, 0xf, 0xf, true)); }
DI float sum8(float x) { x += dpp_f<0xB1>(x); x += dpp_f<0x4E>(x); x += dpp_f<0x141>(x); return x; }
DI float sum16(float x) { x = sum8(x); x += dpp_f<0x140>(x); return x; }
template <int CTRL, int RM> DI float dpp_z(float x) { return __builtin_bit_cast(float, __builtin_amdgcn_update_dpp(0, __builtin_bit_cast(int, x), CTRL, RM, 0xf, true)); }
template <int CTRL, int RM> DI float dpp_o(float old, float x) { return __builtin_bit_cast(float, __builtin_amdgcn_update_dpp(__builtin_bit_cast(int, old), __builtin_bit_cast(int, x), CTRL, RM, 0xf, false)); }
DI float wave_scan_sum(float x) {
    x += dpp_z<0x111, 0xf>(x); x += dpp_z<0x112, 0xf>(x); x += dpp_z<0x114, 0xf>(x); x += dpp_z<0x118, 0xf>(x);
    x += dpp_z<0x142, 0xa>(x); x += dpp_z<0x143, 0xc>(x); return x;
}
DI float wave_scan_max(float x) {
    const float ninf = -3.0e38f;
    x = fmaxf(x, dpp_o<0x111, 0xf>(ninf, x)); x = fmaxf(x, dpp_o<0x112, 0xf>(ninf, x)); x = fmaxf(x, dpp_o<0x114, 0xf>(ninf, x)); x = fmaxf(x, dpp_o<0x118, 0xf>(ninf, x));
    x = fmaxf(x, dpp_o<0x142, 0xa>(ninf, x)); x = fmaxf(x, dpp_o<0x143, 0xc>(ninf, x)); return x;
}
DI float wave_sum(float v) { v = sum16(v); v += __shfl_xor(v, 16); v += __shfl_xor(v, 32); return v; }
DI float wave_max(float v) {
#pragma unroll
    for (int o = 1; o < 64; o <<= 1) v = fmaxf(v, __shfl_xor(v, o));
    return v;
}
DI void lds_barrier() { asm volatile("s_waitcnt lgkmcnt(0)" ::: "memory"); __builtin_amdgcn_s_barrier(); asm volatile("" ::: "memory"); }
DI float fexp(float x) { return __builtin_amdgcn_exp2f(x * 1.44269504089f); }
DI float fsigmoid(float x) { return __builtin_amdgcn_rcpf(1.0f + fexp(-x)); }
DI f32x16 mfma32(bf16x8 a, bf16x8 b, f32x16 c) { return __builtin_amdgcn_mfma_f32_32x32x16_bf16(a, b, c, 0, 0, 0); }
DI f32x4 mfma16(bf16x8 a, bf16x8 b, f32x4 c) { return __builtin_amdgcn_mfma_f32_16x16x32_bf16(a, b, c, 0, 0, 0); }
DI int crow(int r, int h) { return (r & 3) + 8 * (r >> 2) + 4 * h; }
DI bf16x8 pack8(float a0, float a1, float a2, float a3, float a4, float a5, float a6, float a7) {
    typedef __bf16 nb8 __attribute__((ext_vector_type(8))); typedef float nf8 __attribute__((ext_vector_type(8)));
    const nf8 v = {a0, a1, a2, a3, a4, a5, a6, a7}; return __builtin_bit_cast(bf16x8, __builtin_convertvector(v, nb8));
}
DI void my_sincosf(float x, float& s, float& c) {
    const float k = __builtin_rintf(x * 0.63661977236758134f);
    float r = __builtin_fmaf(-k, 1.5703125f, x); r = __builtin_fmaf(-k, 4.837512969970703125e-4f, r); r = __builtin_fmaf(-k, 7.54978995489188216e-8f, r);
    const float r2 = r * r;
    const float ps = r + r * r2 * (-1.6666654611e-1f + r2 * (8.3321608736e-3f + r2 * (-1.9515295891e-4f)));
    const float pc = 1.0f - 0.5f * r2 + r2 * r2 * (4.166664568298827e-2f + r2 * (-1.388731625493765e-3f + r2 * 2.443315711809948e-5f));
    const int q = ((int)k) & 3;
    const float ss = (q & 1) ? pc : ps, cc = (q & 1) ? ps : pc;
    s = (q & 2) ? -ss : ss; c = ((q + 1) & 2) ? -cc : cc;
}

#define XB_TMO      128
#define XB_XCNT(j)  (256  + 64 * (j))
#define XB_XSUB(j)  (1280 + 64 * (j))
#define XB_XGEN(j)  (2304 + 64 * (j))
#define XB_TOP      3328
#define XB_TOPGEN   3392
#define XCD_BAR_WORDS 3456
#define XB_SPIN_CAP (1u << 22)
DI unsigned xb_ld(unsigned* p)              { return __hip_atomic_load(p, __ATOMIC_RELAXED, __HIP_MEMORY_SCOPE_AGENT); }
DI unsigned xb_add(unsigned* p, unsigned v) { return __hip_atomic_fetch_add(p, v, __ATOMIC_RELAXED, __HIP_MEMORY_SCOPE_AGENT); }
DI unsigned xb_xcc_id() { return (unsigned)__builtin_amdgcn_s_getreg((3 << 11) | 20) & 0xFu; }
#define XB_SPIN(cond, bar) do { unsigned _sp = 0; while (cond) { __builtin_amdgcn_s_sleep(1); \
    if ((++_sp & 255u) == 0u) { if (xb_ld(&(bar)[XB_TMO])) break; if (_sp > XB_SPIN_CAP) { atomicAdd(&(bar)[XB_TMO], 1u); break; } } } } while (0)
struct XcdBarrier { unsigned* bar; unsigned x; volatile LAS unsigned* st; };
DI XcdBarrier xcd_barrier_post(unsigned* bar, volatile LAS unsigned* st, bool t0) {
    XcdBarrier b; b.bar = bar; b.x = xb_xcc_id(); b.st = st;
    if (t0) (void)xb_add(&bar[XB_XCNT(b.x)], 1u);
    return b;
}
DI void xcd_barrier_complete(unsigned* bar, unsigned x, unsigned& nloc, unsigned& nx) {
    const unsigned G = gridDim.x * gridDim.y * gridDim.z;
    unsigned sum, cnt, mine, sp = 0u;
    for (;;) {
        sum = 0u; cnt = 0u; mine = 0u;
#pragma unroll
        for (unsigned j = 0; j < 16; ++j) { const unsigned c = xb_ld(&bar[XB_XCNT(j)]); sum += c; cnt += (c > 0u) ? 1u : 0u; mine = (j == x) ? c : mine; }
        if (sum == G) break;
        __builtin_amdgcn_s_sleep(1);
        if ((++sp & 255u) == 0u) { if (xb_ld(&bar[XB_TMO])) break; if (sp > XB_SPIN_CAP) { atomicAdd(&bar[XB_TMO], 1u); break; } }
    }
    nloc = mine > 0u ? mine : 1u; nx = cnt > 0u ? cnt : 1u;
}
DI void xcd_barrier(const XcdBarrier& b, bool t0) {
    asm volatile("s_waitcnt vmcnt(0)" ::: "memory");
    __syncthreads();
    if (t0) {
        unsigned* bar = b.bar;
        __builtin_amdgcn_s_waitcnt(0);
        unsigned nloc = b.st[0], nx = b.st[1];
        if (nloc == 0u) { xcd_barrier_complete(bar, b.x, nloc, nx); b.st[0] = nloc; b.st[1] = nx; }
        const unsigned old = xb_add(&bar[XB_XSUB(b.x)], 1u);
        const unsigned gen = old / nloc;
        if (old + 1u == (gen + 1u) * nloc) {
            __builtin_amdgcn_fence(__ATOMIC_RELEASE, "agent");
            asm volatile("s_waitcnt vmcnt(0)" ::: "memory");
            const unsigned og = xb_add(&bar[XB_TOP], 1u);
            const unsigned tg = og / nx;
            if (og + 1u == (tg + 1u) * nx) xb_add(&bar[XB_TOPGEN], 1u);
            else XB_SPIN(xb_ld(&bar[XB_TOPGEN]) == tg, bar);
            __builtin_amdgcn_fence(__ATOMIC_ACQUIRE, "agent");
            xb_add(&bar[XB_XGEN(b.x)], 1u);
            asm volatile("s_waitcnt vmcnt(0)" ::: "memory");
        } else {
            XB_SPIN(xb_ld(&bar[XB_XGEN(b.x)]) == gen, bar);
            __builtin_amdgcn_fence(__ATOMIC_ACQUIRE, "agent");
            asm volatile("s_waitcnt vmcnt(0)" ::: "memory");
        }
    }
    __syncthreads();
}

struct Args { const float* in[43]; float* out; unsigned char* ws; int ph_lo, ph_hi, use_bar, pad; };
typedef const __attribute__((address_space(4))) Args* KArgs;
enum { I_X = 0, I_C, I_CTX, I_CCTX, I_WADA, I_BADA, I_NPRE, I_NPOST, I_WG, I_WU, I_WD, I_WIN, I_WOUT, I_S5LRE, I_S5LIM, I_S5DT, I_S5BRE, I_S5BIM, I_S5CRE, I_S5CIM, I_S5D, I_S5GLU, I_S5BGLU,
       I_MQN, I_MKVN, I_MUQ, I_MUKV, I_RCW, I_RCB, I_RW0, I_RWUP, I_RA0, I_RAUP, I_RGUP, I_RKK, I_RKA, I_RRK, I_RLNW, I_RLNB, I_MCW, I_MCB, I_MGB, I_MNORM };

struct Ctx {
    LAS uchar* lds; int tid, lane, wave, vcu, G;
};
DI int tok_row(int b, int seg, int t) { return seg ? b * T + t : NLAT + b * TC + t; }
DI void phase_prologue(KArgs a, const Ctx& F) {
    LAS float* sc = (LAS float*)F.lds;
    LAS float* red = (LAS float*)(F.lds + 40960);
    const float* c = a->in[I_C]; const float* cc = a->in[I_CCTX];
    for (int i = F.tid; i < 9 * D; i += NTHR) { const float v = (i < 8 * D) ? c[i] : cc[i - 8 * D]; sc[i] = v * fsigmoid(v); }
    __syncthreads();
    const float* wada = a->in[I_WADA]; const float* bada = a->in[I_BADA];
    float* modv = (float*)(a->ws + WS_MODV);
    for (int task = F.vcu; task < DEPTH * 144; task += F.G) {
        const int l = task / 144, nb = task % 144, n = nb * 64 + F.lane;
        const float* wp = wada + ((size_t)l * D + F.wave * 128) * MODW + n;
        float acc[9];
#pragma unroll
        for (int m = 0; m < 9; ++m) acc[m] = 0.f;
#pragma unroll 8
        for (int k = 0; k < 128; ++k) { const float w = wp[(size_t)k * MODW];
#pragma unroll
            for (int m = 0; m < 9; ++m) acc[m] += sc[m * D + F.wave * 128 + k] * w; }
#pragma unroll
        for (int m = 0; m < 9; ++m) red[(F.wave * 9 + m) * 64 + F.lane] = acc[m];
        __syncthreads();
        for (int i = F.tid; i < 576; i += NTHR) { const int m = i >> 6, ln = i & 63; float s = 0.f;
#pragma unroll
            for (int w = 0; w < 8; ++w) s += red[(w * 9 + m) * 64 + ln];
            modv[((size_t)l * 9 + m) * MODW + nb * 64 + ln] = s + bada[l * MODW + nb * 64 + ln]; }
        __syncthreads();
    }
    float* rc = (float*)(a->ws + WS_ROPE); float* rs = rc + T * 16;
    for (int i = F.vcu * NTHR + F.tid; i < T * 16; i += F.G * NTHR) {
        const int t = i >> 4, f = i & 15, pos = f < 8 ? (t >> 6) : (t & 63), fi = f & 7;
        const float invf = (fi == 0) ? 1.0f : (fi == 1) ? 0.31622776601683794f : (fi == 2) ? 0.1f : (fi == 3) ? 0.031622776601683794f : (fi == 4) ? 0.01f : (fi == 5) ? 0.0031622776601683794f : (fi == 6) ? 0.001f : 0.00031622776601683794f;
        const float ang = (float)pos * invf; float s, co; my_sincosf(ang, s, co);
        rc[i] = co; rs[i] = s;
    }
}

DI void tr_item(const float* W, int K, int N, bf16* WT, int kb, int n0, int drow0, LAS float* scr, int lane) {
    const int k0 = 64 * kb, nn = n0 + (lane & 31);
#pragma unroll 8
    for (int i = 0; i < 32; ++i) { const int kk = 2 * i + (lane >> 5); scr[kk * 33 + (lane & 31)] = (nn < N) ? W[(size_t)(k0 + kk) * N + nn] : 0.f; }
    const int c = lane & 7;
#pragma unroll
    for (int j = 0; j < 4; ++j) { const int n = (lane >> 3) + 8 * j; const LAS float* s = scr + (8 * c) * 33 + n;
        v4u o; o.x = pk2(s[0 * 33], s[1 * 33]); o.y = pk2(s[2 * 33], s[3 * 33]); o.z = pk2(s[4 * 33], s[5 * 33]); o.w = pk2(s[6 * 33], s[7 * 33]);
        if (n0 + n < N) *(v4u*)(WT + (size_t)(drow0 + n) * K + k0 + 8 * c) = o; }
}
DI void convert_weights(KArgs a, const Ctx& F, int l, int set) {
    LAS float* scr = (LAS float*)(F.lds + F.wave * 8704);
    const int gw = F.vcu * NWAVES + F.wave, NGW = F.G * NWAVES;
    bf16* WGU = (bf16*)(a->ws + WS_WGU); bf16* WDN = (bf16*)(a->ws + WS_WDN); bf16* WIN = (bf16*)(a->ws + WS_WIN); bf16* WOUT = (bf16*)(a->ws + WS_WOUT);
    bf16* SW = (bf16*)(a->ws + WS_SMALLW);
    const int fl = l * 2 + set;
    const float* wg = a->in[I_WG] + (size_t)fl * D * FF; const float* wu = a->in[I_WU] + (size_t)fl * D * FF; const float* wd = a->in[I_WD] + (size_t)fl * FF * D;
    constexpr int I_G = 16 * 88, I_D = 44 * 32, I_IN = 16 * 82, I_O = 16 * 32, I_UQ = 4 * 12, I_UKV = 2 * 16, I_GLU = 4 * 8, I_GUP = 1 * 8;
    const int nitems = set == 0 ? (2 * I_G + I_D + I_IN + I_O + I_UQ + I_UKV + I_GLU + I_GUP) : (2 * I_G + I_D);
    for (int it = gw; it < nitems; it += NGW) {
        int r = it;
        if (r < I_G) { const int kb = r / 88, nb = r % 88, n0 = 32 * nb; tr_item(wg, D, FF, WGU, kb, n0, 256 * (n0 >> 7) + (n0 & 127), scr, F.lane); continue; } r -= I_G;
        if (r < I_G) { const int kb = r / 88, nb = r % 88, n0 = 32 * nb; tr_item(wu, D, FF, WGU, kb, n0, 256 * (n0 >> 7) + 128 + (n0 & 127), scr, F.lane); continue; } r -= I_G;
        if (r < I_D) { const int kb = r / 32, nb = r % 32; tr_item(wd, FF, D, WDN, kb, 32 * nb, 32 * nb, scr, F.lane); continue; } r -= I_D;
        if (r < I_IN) { const int kb = r / 82, nb = r % 82; tr_item(a->in[I_WIN] + (size_t)l * D * ZP, D, ZP, WIN, kb, 32 * nb, 32 * nb, scr, F.lane); continue; } r -= I_IN;
        if (r < I_O) { const int kb = r / 32, nb = r % 32; tr_item(a->in[I_WOUT] + (size_t)l * D * D, D, D, WOUT, kb, 32 * nb, 32 * nb, scr, F.lane); continue; } r -= I_O;
        if (r < I_UQ) { const int kb = r / 12, nb = r % 12; tr_item(a->in[I_MUQ] + (size_t)l * 256 * 384, 256, 384, (bf16*)((uchar*)SW + SW_UQ), kb, 32 * nb, 32 * nb, scr, F.lane); continue; } r -= I_UQ;
        if (r < I_UKV) { const int kb = r / 16, nb = r % 16; tr_item(a->in[I_MUKV] + (size_t)l * 128 * 512, 128, 512, (bf16*)((uchar*)SW + SW_UKV), kb, 32 * nb, 32 * nb, scr, F.lane); continue; } r -= I_UKV;
        if (r < I_GLU) { const int kb = r / 8, nb = r % 8; tr_item(a->in[I_S5GLU] + (size_t)l * 256 * 256, 256, 256, (bf16*)((uchar*)SW + SW_GLU), kb, 32 * nb, 32 * nb, scr, F.lane); continue; } r -= I_GLU;
        { const int nb = r; tr_item(a->in[I_RGUP] + (size_t)l * 64 * 256, 64, 256, (bf16*)((uchar*)SW + SW_GUP), 0, 32 * nb, 32 * nb, scr, F.lane); }
    }
    if (set == 0) {
        unsigned zz_ = 0u; asm volatile("" : "+v"(zz_)); v4u z = {zz_, zz_, zz_, zz_}; v4u* p = (v4u*)(WIN + (size_t)ZP * D);
        for (int i = F.vcu * NTHR + F.tid; i < (ZPAD - ZP) * D / 8; i += F.G * NTHR) p[i] = z;
    }
}

DI void norm_rows(KArgs a, const Ctx& F, bool p_first, bool p_hasY, bool p_hasH, bool p_final, int p_nrows, const float* p_modY, int p_gi, const float* p_pw, float p_coef, const float* p_modH, int p_si, const float* p_prew, bool p_dummy = false) {
    bf16* X = (bf16*)(a->ws + WS_X); const bf16* Y = (const bf16*)(a->ws + WS_Y); bf16* H = (bf16*)(a->ws + (p_dummy ? WS_YS5 : WS_H));
    bf16* Xo = p_dummy ? (bf16*)(a->ws + WS_ACT) : X;
    const int gw = F.vcu * NWAVES + F.wave, NGW = F.G * NWAVES, lane = F.lane;
    const int rpw = (p_nrows + NGW - 1) / NGW, r0 = gw * rpw, r1 = (r0 + rpw < p_nrows) ? (r0 + rpw) : p_nrows;
    if (r0 >= r1) return;
    f32x4 cA[4], cB[4], cC[4];
    int cur_mr = -1;
    f32x4 vn[2][4]; v2u xn[2][4], yn[2][4];
    auto issue = [&](int r) {
#pragma unroll
        for (int k = 0; k < 2; ++k) if (r + k < r1) {
            if (p_first) {
                const float* xs = r + k < NLAT ? a->in[I_X] + (size_t)(r + k) * D : a->in[I_CTX] + (size_t)(r + k - NLAT) * D;
#pragma unroll
                for (int j = 0; j < 4; ++j) vn[k][j] = *(const f32x4*)(xs + 4 * lane + 256 * j);
            } else {
#pragma unroll
                for (int j = 0; j < 4; ++j) xn[k][j] = *(const v2u*)(X + (size_t)(r + k) * D + 4 * lane + 256 * j);
            }
            if (p_hasY) {
#pragma unroll
                for (int j = 0; j < 4; ++j) yn[k][j] = *(const v2u*)(Y + (size_t)(r + k) * D + 4 * lane + 256 * j);
            }
        }
    };
    issue(r0);
    for (int r = r0; r < r1; r += 2) {
        f32x4 v[2][4]; v2u yw[2][4];
#pragma unroll
        for (int k = 0; k < 2; ++k)
#pragma unroll
            for (int j = 0; j < 4; ++j) { v[k][j] = p_first ? vn[k][j] : (f32x4){bflo(xn[k][j].x), bfhi(xn[k][j].x), bflo(xn[k][j].y), bfhi(xn[k][j].y)}; yw[k][j] = yn[k][j]; }
        if (r + 2 < r1) issue(r + 2);
#pragma unroll
        for (int k = 0; k < 2; ++k) if (r + k < r1) {
            const int rr = r + k;
            const int mr = rr < NLAT ? (rr >> 12) : 8;
            if (mr != cur_mr) { cur_mr = mr;
                const float* g = p_modY + (size_t)mr * MODW + p_gi * D; const float* sh = p_modH + (size_t)mr * MODW + p_si * D; const float* scp = sh + D;
#pragma unroll
                for (int j = 0; j < 4; ++j) { const int o = 4 * lane + 256 * j;
                    cA[j] = p_hasY ? (*(const f32x4*)(g + o) * p_coef) * *(const f32x4*)(p_pw + o) : (f32x4){0.f, 0.f, 0.f, 0.f};
                    if (p_hasH) { cB[j] = *(const f32x4*)(p_prew + o) * (*(const f32x4*)(scp + o) + 1.0f); cC[j] = *(const f32x4*)(sh + o); } else { cB[j] = cA[j]; cC[j] = cA[j]; } } }
            if (p_hasY) {
                f32x4 y[4]; float ss = 0.f;
#pragma unroll
                for (int j = 0; j < 4; ++j) { y[j] = (f32x4){bflo(yw[k][j].x), bfhi(yw[k][j].x), bflo(yw[k][j].y), bfhi(yw[k][j].y)};
                    ss += (y[j].x * y[j].x + y[j].y * y[j].y) + (y[j].z * y[j].z + y[j].w * y[j].w); }
                const float rstd = __builtin_amdgcn_rsqf(wave_sum(ss) * (1.0f / D) + NORM_EPS);
#pragma unroll
                for (int j = 0; j < 4; ++j) v[k][j] = v[k][j] + cA[j] * (y[j] * rstd);
            }
            if (p_final) {
#pragma unroll
                for (int j = 0; j < 4; ++j) *(f32x4*)(a->out + (size_t)rr * D + 4 * lane + 256 * j) = v[k][j];
            } else if (p_hasY || p_first) {
#pragma unroll
                for (int j = 0; j < 4; ++j) { v2u o; o.x = pk2(v[k][j].x, v[k][j].y); o.y = pk2(v[k][j].z, v[k][j].w); *(v2u*)(Xo + (size_t)rr * D + 4 * lane + 256 * j) = o; }
            }
            if (p_hasH) {
                float ss = 0.f;
#pragma unroll
                for (int j = 0; j < 4; ++j) ss += (v[k][j].x * v[k][j].x + v[k][j].y * v[k][j].y) + (v[k][j].z * v[k][j].z + v[k][j].w * v[k][j].w);
                const float rstd = __builtin_amdgcn_rsqf(wave_sum(ss) * (1.0f / D) + NORM_EPS);
#pragma unroll
                for (int j = 0; j < 4; ++j) { const f32x4 h = (v[k][j] * rstd) * cB[j] + cC[j];
                    v2u o; o.x = pk2(h.x, h.y); o.y = pk2(h.z, h.w); *(v2u*)(H + (size_t)rr * D + 4 * lane + 256 * j) = o; }
            }
        }
    }
}
template <int K, int NBK, int MBK, bool TRANS, bool ZERO = true>
DI void small_gemm(const LAS bf16* A, int apitch, const bf16* Wt, int n0w, f32x4 (&acc)[NBK][MBK], int lane, int wpitch = K) {
    const int lr = lane & 15, kq = lane >> 4;
    if (ZERO) {
#pragma unroll
        for (int nb = 0; nb < NBK; ++nb)
#pragma unroll
            for (int mb = 0; mb < MBK; ++mb) acc[nb][mb] = (f32x4){0.f, 0.f, 0.f, 0.f};
    }
#pragma unroll 2
    for (int s = 0; s < K / 32; ++s) {
        bf16x8 av[MBK];
#pragma unroll
        for (int mb = 0; mb < MBK; ++mb) av[mb] = *(const LAS bf16x8*)(A + (16 * mb + lr) * apitch + 32 * s + 8 * kq);
#pragma unroll
        for (int nb = 0; nb < NBK; ++nb) { const bf16x8 w = *(const bf16x8*)(Wt + (size_t)(n0w + 16 * nb + lr) * wpitch + 32 * s + 8 * kq);
#pragma unroll
            for (int mb = 0; mb < MBK; ++mb) acc[nb][mb] = TRANS ? mfma16(w, av[mb], acc[nb][mb]) : mfma16(av[mb], w, acc[nb][mb]); }
    }
}
DI void ctx_gemm_block(const Ctx& F, const bf16* A, const bf16* Wt, int K, bf16* Yo) {
    const int bi = F.vcu; if (bi >= 256) return;
    const int rb = bi >> 3, cb = bi & 7, row0 = NLAT + 64 * rb;
    const int tid = F.tid, lane = F.lane, wave = F.wave;
    LAS bf16* As = (LAS bf16*)F.lds;
    const int nch = K / 256;
    v4u g[4];
    auto gload = [&](int ch) {
#pragma unroll
        for (int j = 0; j < 4; ++j) { const int cidx = tid + 512 * j, r = cidx >> 5, cc = cidx & 31; g[j] = *(const v4u*)(A + (size_t)(row0 + r) * K + ch * 256 + cc * 8); }
    };
    auto lstore = [&](int buf) {
#pragma unroll
        for (int j = 0; j < 4; ++j) { const int cidx = tid + 512 * j, r = cidx >> 5, cc = cidx & 31; *(LAS v4u*)(As + buf * 64 * 264 + r * 264 + cc * 8) = g[j]; }
    };
    f32x4 acc[1][4];
#pragma unroll
    for (int mb = 0; mb < 4; ++mb) acc[0][mb] = (f32x4){0.f, 0.f, 0.f, 0.f};
    const int lr_ = lane & 15, kq_ = lane >> 4;
    const bf16* wrow = Wt + (size_t)(128 * cb + 16 * wave + lr_) * K + 8 * kq_;
    bf16x8 wc[8], wn[8];
#pragma unroll
    for (int s = 0; s < 8; ++s) wc[s] = *(const bf16x8*)(wrow + 32 * s);
    gload(0); lstore(0);
    __syncthreads();
    for (int ch = 0; ch < nch; ++ch) {
        if (ch + 1 < nch) { gload(ch + 1);
#pragma unroll
            for (int s = 0; s < 8; ++s) wn[s] = *(const bf16x8*)(wrow + (ch + 1) * 256 + 32 * s); }
        const LAS bf16* Ab = As + (ch & 1) * 64 * 264;
#pragma unroll
        for (int s = 0; s < 8; ++s) {
#pragma unroll
            for (int mb = 0; mb < 4; ++mb) acc[0][mb] = mfma16(wc[s], *(const LAS bf16x8*)(Ab + (16 * mb + lr_) * 264 + 32 * s + 8 * kq_), acc[0][mb]);
        }
        if (ch + 1 < nch) { lstore((ch + 1) & 1);
#pragma unroll
            for (int s = 0; s < 8; ++s) wc[s] = wn[s]; }
        __syncthreads();
    }
    const int lr = lane & 15, kq = lane >> 4;
#pragma unroll
    for (int mb = 0; mb < 4; ++mb) { const f32x4 v = acc[0][mb]; v2u o; o.x = pk2(v.x, v.y); o.y = pk2(v.z, v.w);
        *(v2u*)(Yo + (size_t)(row0 + 16 * mb + lr) * D + 128 * cb + 16 * wave + 4 * kq) = o; }
}

struct S5C { float ar, ai, fr, fi; };
static __device__ __noinline__ S5C s5_coef(const float* lre, const float* lim, float dt, int nn) {
    const float lr = lre[nn], li = lim[nn], x = lr * dt;
    const float em = x * (1.0f + x * (0.5f + x * (0.16666667f + x * (0.041666668f + x * 0.0083333338f))));
    float sh, ch; my_sincosf(0.5f * li * dt, sh, ch);
    const float cm1 = -2.0f * sh * sh, sn = 2.0f * sh * ch;
    const float arm1 = em * (1.0f + cm1) + cm1;
    S5C o; o.ai = (1.0f + em) * sn; o.ar = 1.0f + arm1;
    const float den = lr * lr + li * li;
    o.fr = (arm1 * lr + o.ai * li) / den; o.fi = (o.ai * lr - arm1 * li) / den;
    return o;
}
DI void s5_scan_task(KArgs a, int l, int b, int dir, int g, LAS bf16* wl  , int lane) {
    const bf16* Z = (const bf16*)(a->ws + WS_ACT); bf16* YS = (bf16*)(a->ws + WS_YS5) + (size_t)dir * NROWS * 256;
    const int pg = (l * 2 + dir) * 16 + g;
    const float* lre = a->in[I_S5LRE] + pg * 64; const float* lim = a->in[I_S5LIM] + pg * 64;
    const float dt = __expf(a->in[I_S5DT][pg]);
    const S5C c0_ = s5_coef(lre, lim, dt, lane); const float ar = c0_.ar, ai = c0_.ai;
    bf16x8 Bf[4];
    { const int hh = lane >> 5;
#pragma unroll
      for (int nblk = 0; nblk < 2; ++nblk) { const int nn = 32 * nblk + (lane & 31); const S5C cn_ = s5_coef(lre, lim, dt, nn); const float fr = cn_.fr, fi = cn_.fi;
        const float* bre = a->in[I_S5BRE] + ((size_t)pg * 64 + nn) * 16 + 8 * hh; const float* bim = a->in[I_S5BIM] + ((size_t)pg * 64 + nn) * 16 + 8 * hh;
        float re[8], im[8];
#pragma unroll
        for (int j = 0; j < 8; ++j) { re[j] = fr * bre[j] - fi * bim[j]; im[j] = fi * bre[j] + fr * bim[j]; }
        Bf[nblk] = pack8(re[0], re[1], re[2], re[3], re[4], re[5], re[6], re[7]); Bf[2 + nblk] = pack8(im[0], im[1], im[2], im[3], im[4], im[5], im[6], im[7]); } }
    bf16x8 Cf[4];
    { const int p = lane & 15, q = lane >> 4;
#pragma unroll
      for (int s = 0; s < 4; ++s) { const int kc = 32 * s + 8 * q; float cv[8];
        const float* src = (s < 2) ? a->in[I_S5CRE] + ((size_t)pg * 16 + p) * 64 + kc : a->in[I_S5CIM] + ((size_t)pg * 16 + p) * 64 + (kc - 64);
        const float sg = (s < 2) ? 1.f : -1.f;
#pragma unroll
        for (int j = 0; j < 8; ++j) cv[j] = sg * src[j];
        Cf[s] = pack8(cv[0], cv[1], cv[2], cv[3], cv[4], cv[5], cv[6], cv[7]); } }
    float sr = 0.f, si = 0.f;
    const int hh = lane >> 5, li5 = lane & 31, q = lane >> 4, t16 = lane & 15;
    const f32x16 zero16 = {0.f, 0.f, 0.f, 0.f, 0.f, 0.f, 0.f, 0.f, 0.f, 0.f, 0.f, 0.f, 0.f, 0.f, 0.f, 0.f};
    const int nchC = TC / 32, nchT = nchC + T / 32;
    auto afload = [&](int gc) -> bf16x8 {
        const int seg = gc >= nchC, ch = seg ? gc - nchC : gc, len = seg ? T : TC;
        const int sidx = 32 * ch + li5, tt = dir ? (len - 1 - sidx) : sidx;
        return *(const bf16x8*)(Z + (size_t)tok_row(b, seg, tt) * ZP + ZS5 + g * 16 + 8 * hh);
    };
    bf16x8 afn = afload(0);
    for (int gc = 0; gc < nchT; ++gc) {
        const int seg = gc >= nchC, ch = seg ? gc - nchC : gc, len = seg ? T : TC;
        {
            const bf16x8 af = afn;
            if (gc + 1 < nchT) afn = afload(gc + 1);
            f32x16 d1 = mfma32(af, Bf[0], zero16), d2 = mfma32(af, Bf[1], zero16), d3 = mfma32(af, Bf[2], zero16), d4 = mfma32(af, Bf[3], zero16);
            float xa[16], xb[16], ya[16], yb[16];
#pragma unroll
            for (int r = 0; r < 16; ++r) {
                auto r1 = __builtin_amdgcn_permlane32_swap(__float_as_uint(d1[r]), __float_as_uint(d2[r]), false, false); xa[r] = __uint_as_float(r1[0]); xb[r] = __uint_as_float(r1[1]);
                auto r2 = __builtin_amdgcn_permlane32_swap(__float_as_uint(d3[r]), __float_as_uint(d4[r]), false, false); ya[r] = __uint_as_float(r2[0]); yb[r] = __uint_as_float(r2[1]); }
#pragma unroll
            for (int i = 0; i < 32; ++i) {
                const int r = 4 * (i >> 3) + (i & 3); const bool hi = (i >> 2) & 1;
                const float xre = hi ? xb[r] : xa[r], xim = hi ? yb[r] : ya[r];
                const float nsr = ar * sr - ai * si + xre, nsi = ar * si + ai * sr + xim; sr = nsr; si = nsi;
                wl[i * 136 + lane] = (bf16)f2bf(sr); wl[i * 136 + 64 + lane] = (bf16)f2bf(si);
            }
#pragma unroll
            for (int tb = 0; tb < 2; ++tb) {
                f32x4 acc = {0.f, 0.f, 0.f, 0.f};
#pragma unroll
                for (int s = 0; s < 4; ++s) { const bf16x8 bfr = *(const LAS bf16x8*)(wl + (16 * tb + t16) * 136 + 32 * s + 8 * q); acc = mfma16(Cf[s], bfr, acc); }
                const int so = 32 * ch + 16 * tb + t16, to = dir ? (len - 1 - so) : so;
                v2u o; o.x = pk2(acc[0], acc[1]); o.y = pk2(acc[2], acc[3]);
                *(v2u*)(YS + (size_t)tok_row(b, seg, to) * 256 + g * 16 + 4 * q) = o;
            }
        }
    }
}

DI void mla_prep_tile(KArgs a, const Ctx& F, int l, int tile) {
    const bf16* Z = (const bf16*)(a->ws + WS_ACT);
    bf16* Q = (bf16*)(a->ws + WS_Q); bf16* Kf = (bf16*)(a->ws + WS_K); bf16* Vt = (bf16*)(a->ws + WS_VT);
    const bf16* WUQ = (const bf16*)(a->ws + WS_SMALLW + SW_UQ); const bf16* WUKV = (const bf16*)(a->ws + WS_SMALLW + SW_UKV);
    const float* rc = (const float*)(a->ws + WS_ROPE); const float* rs = rc + T * 16;
    LAS bf16* Aq = (LAS bf16*)F.lds;
    LAS bf16* Akv = (LAS bf16*)(F.lds + 64 * 264 * 2);
    const int row0 = tile * 64, tid = F.tid, lane = F.lane, wave = F.wave;
    const bool lat = row0 < NLAT;
    {
        const int i = tid >> 3, part = tid & 7, row = row0 + i;
        const bf16* zr = Z + (size_t)row * ZP;
        float q[32], kv[16]; float sq = 0.f, sk = 0.f;
#pragma unroll
        for (int j = 0; j < 4; ++j) { const v4u w = *(const v4u*)(zr + ZCQ + part * 32 + 8 * j);
            q[8 * j + 0] = bflo(w.x); q[8 * j + 1] = bfhi(w.x); q[8 * j + 2] = bflo(w.y); q[8 * j + 3] = bfhi(w.y); q[8 * j + 4] = bflo(w.z); q[8 * j + 5] = bfhi(w.z); q[8 * j + 6] = bflo(w.w); q[8 * j + 7] = bfhi(w.w); }
#pragma unroll
        for (int j = 0; j < 2; ++j) { const v4u w = *(const v4u*)(zr + ZCKV + part * 16 + 8 * j);
            kv[8 * j + 0] = bflo(w.x); kv[8 * j + 1] = bfhi(w.x); kv[8 * j + 2] = bflo(w.y); kv[8 * j + 3] = bfhi(w.y); kv[8 * j + 4] = bflo(w.z); kv[8 * j + 5] = bfhi(w.z); kv[8 * j + 6] = bflo(w.w); kv[8 * j + 7] = bfhi(w.w); }
#pragma unroll
        for (int j = 0; j < 32; ++j) sq += q[j] * q[j];
#pragma unroll
        for (int j = 0; j < 16; ++j) sk += kv[j] * kv[j];
        sq += __shfl_xor(sq, 1); sq += __shfl_xor(sq, 2); sq += __shfl_xor(sq, 4);
        sk += __shfl_xor(sk, 1); sk += __shfl_xor(sk, 2); sk += __shfl_xor(sk, 4);
        const float rq = 1.0f / sqrtf(sq * (1.0f / 256.0f) + NORM_EPS), rk = 1.0f / sqrtf(sk * (1.0f / 128.0f) + NORM_EPS);
        const float* qn = a->in[I_MQN] + l * 256 + part * 32; const float* kn = a->in[I_MKVN] + l * 128 + part * 16;
#pragma unroll
        for (int j = 0; j < 32; j += 2) *(LAS unsigned*)(Aq + i * 264 + part * 32 + j) = pk2(q[j] * rq * qn[j], q[j + 1] * rq * qn[j + 1]);
#pragma unroll
        for (int j = 0; j < 16; j += 2) *(LAS unsigned*)(Akv + i * 136 + part * 16 + j) = pk2(kv[j] * rk * kn[j], kv[j + 1] * rk * kn[j + 1]);
        if (part == 0) {
            float kr[32];
#pragma unroll
            for (int j = 0; j < 4; ++j) { const v4u w = *(const v4u*)(zr + ZKR + 8 * j);
                kr[8 * j + 0] = bflo(w.x); kr[8 * j + 1] = bfhi(w.x); kr[8 * j + 2] = bflo(w.y); kr[8 * j + 3] = bfhi(w.y); kr[8 * j + 4] = bflo(w.z); kr[8 * j + 5] = bfhi(w.z); kr[8 * j + 6] = bflo(w.w); kr[8 * j + 7] = bfhi(w.w); }
            float o[32];
            if (lat) { const int t = row & (T - 1);
#pragma unroll
                for (int hf = 0; hf < 2; ++hf)
#pragma unroll
                    for (int j = 0; j < 8; ++j) { const float c = rc[t * 16 + hf * 8 + j], s = rs[t * 16 + hf * 8 + j]; const float x0 = kr[hf * 16 + j], x1 = kr[hf * 16 + 8 + j];
                        o[hf * 16 + j] = x0 * c - x1 * s; o[hf * 16 + 8 + j] = x1 * c + x0 * s; }
            } else {
#pragma unroll
                for (int j = 0; j < 32; ++j) o[j] = kr[j];
            }
#pragma unroll
            for (int hd = 0; hd < 4; ++hd) { bf16* kp = Kf + (size_t)row * 384 + hd * 96 + 64;
#pragma unroll
                for (int j = 0; j < 4; ++j) { v4u w; w.x = pk2(o[8 * j], o[8 * j + 1]); w.y = pk2(o[8 * j + 2], o[8 * j + 3]); w.z = pk2(o[8 * j + 4], o[8 * j + 5]); w.w = pk2(o[8 * j + 6], o[8 * j + 7]); *(v4u*)(kp + 8 * j) = w; } }
        }
    }
    __syncthreads();
    const int lr = lane & 15, kq = lane >> 4;
    {
        f32x4 acc[3][4];
        small_gemm<256, 3, 4, true>(Aq, 264, WUQ, 48 * wave, acc, lane);
        const float qs = 0.10206207261596577f * 1.44269504089f;
#pragma unroll
        for (int nb = 0; nb < 3; ++nb) { const int blk = 3 * wave + nb, hb = blk % 6;
#pragma unroll
            for (int mb = 0; mb < 4; ++mb) { const int row = row0 + 16 * mb + lr; f32x4 v = acc[nb][mb];
                if (hb >= 4) {
                    f32x4 pv; pv.x = __shfl_xor(v.x, 32); pv.y = __shfl_xor(v.y, 32); pv.z = __shfl_xor(v.z, 32); pv.w = __shfl_xor(v.w, 32);
                    if (lat) { const int t = row & (T - 1); const int fb = (hb - 4) * 8 + 4 * (kq & 1);
                        const f32x4 c = *(const f32x4*)(rc + t * 16 + fb), s = *(const f32x4*)(rs + t * 16 + fb);
                        v = (kq < 2) ? (v * c - pv * s) : (v * c + pv * s); }
                }
                v = v * qs;
                v2u o; o.x = pk2(v.x, v.y); o.y = pk2(v.z, v.w);
                *(v2u*)(Q + (size_t)row * 384 + 16 * blk + 4 * kq) = o; } }
    }
    {
        const int hd = wave >> 1;
        if ((wave & 1) == 0) {
            f32x4 acc[4][4];
            small_gemm<128, 4, 4, true>(Akv, 136, WUKV, 64 * wave, acc, lane);
#pragma unroll
            for (int nb = 0; nb < 4; ++nb)
#pragma unroll
                for (int mb = 0; mb < 4; ++mb) { const int row = row0 + 16 * mb + lr; const f32x4 v = acc[nb][mb];
                    v2u o; o.x = pk2(v.x, v.y); o.y = pk2(v.z, v.w);
                    *(v2u*)(Kf + (size_t)row * 384 + hd * 96 + 16 * nb + 4 * kq) = o; }
        } else {
            f32x4 acc[4][4];
            small_gemm<128, 4, 4, false>(Akv, 136, WUKV, 64 * wave, acc, lane);
            const int bb = lat ? (row0 >> 12) : ((row0 - NLAT) >> 8);
            const int key0 = lat ? (TC + (row0 & (T - 1))) : ((row0 - NLAT) & (TC - 1));
#pragma unroll
            for (int nb = 0; nb < 4; ++nb)
#pragma unroll
                for (int mb = 0; mb < 4; ++mb) { const f32x4 v = acc[nb][mb];
                    v2u o; o.x = pk2(v.x, v.y); o.y = pk2(v.z, v.w);
                    *(v2u*)(Vt + ((size_t)(bb * 4 + hd) * 64 + 16 * nb + lr) * NKEY + key0 + 16 * mb + 4 * kq) = o; }
        }
    }
    __syncthreads();
}

DI void attn_unit(KArgs a, const Ctx& F, int b, int hd, int qrow0, int nkeys) {
    const bf16* Q = (const bf16*)(a->ws + WS_Q); const bf16* Kf = (const bf16*)(a->ws + WS_K); const bf16* Vt = (const bf16*)(a->ws + WS_VT);
    bf16* MO = (bf16*)(a->ws + WS_H);
    constexpr int KP = 208, VP = 144, BUF = 64 * KP + 64 * VP;
    const int tid = F.tid, lane = F.lane, wave = F.wave, l31 = lane & 31, h2 = lane >> 5;
    const int qrow = qrow0 + 32 * wave + l31;
    bf16x8 Qf[6];
#pragma unroll
    for (int s = 0; s < 6; ++s) Qf[s] = *(const bf16x8*)(Q + (size_t)qrow * 384 + hd * 96 + 16 * s + 8 * h2);
    const int kc0 = tid, kc1 = tid + 512;
    const int kr0 = kc0 / 12, kcc0 = kc0 % 12, kr1 = kc1 / 12, kcc1 = kc1 % 12; const bool k1v = kc1 < 768;
    const int vd = tid >> 3, vcc = tid & 7;
    const bf16* vbase = Vt + ((size_t)(b * 4 + hd) * 64 + vd) * NKEY + vcc * 8;
    v4u gk0, gk1, gv;
    auto gloadK = [&](int kt) {
        const int key0 = 64 * kt; const int krow = key0 < TC ? (NLAT + b * TC + key0) : (b * T + key0 - TC);
        gk0 = *(const v4u*)(Kf + (size_t)(krow + kr0) * 384 + hd * 96 + kcc0 * 8);
        if (k1v) gk1 = *(const v4u*)(Kf + (size_t)(krow + kr1) * 384 + hd * 96 + kcc1 * 8);
    };
    auto gloadV = [&](int kt) { gv = *(const v4u*)(vbase + 64 * kt); };
    auto lstoreK = [&](int buf) {
        LAS uchar* base = F.lds + buf * BUF;
        *(LAS v4u*)(base + kr0 * KP + kcc0 * 16) = gk0;
        if (k1v) *(LAS v4u*)(base + kr1 * KP + kcc1 * 16) = gk1;
    };
    auto lstoreV = [&](int buf) {
        LAS uchar* vp = F.lds + buf * BUF + 64 * KP + vd * VP + (vcc >> 1) * 32 + (vcc & 1) * 8;
        v2u lo_, hi_; lo_.x = gv.x; lo_.y = gv.y; hi_.x = gv.z; hi_.y = gv.w;
        *(LAS v2u*)vp = lo_; *(LAS v2u*)(vp + 16) = hi_;
    };
    const int nt = nkeys / 64;
    f32x16 O0, O1, negm;
#pragma unroll
    for (int r = 0; r < 16; ++r) { O0[r] = 0.f; O1[r] = 0.f; negm[r] = 0.f; }
    float lsum = 0.f;
    f32x16 s0, s1;
    gloadK(0); gloadV(0); lstoreK(0); lstoreV(0);
    gloadK(1); lstoreK(1);
    __syncthreads();
    {
        s0 = negm; s1 = negm;
#pragma unroll
        for (int s = 0; s < 6; ++s) {
            const bf16x8 ka = *(const LAS bf16x8*)(F.lds + l31 * KP + (16 * s + 8 * h2) * 2);
            const bf16x8 kb2 = *(const LAS bf16x8*)(F.lds + (32 + l31) * KP + (16 * s + 8 * h2) * 2);
            s0 = mfma32(ka, Qf[s], s0); s1 = mfma32(kb2, Qf[s], s1);
        }
    }
    for (int kt = 0; kt < nt; ++kt) {
        const bool more1 = kt + 1 < nt, more2 = kt + 2 < nt;
        if (more2) gloadK(kt + 2);
        if (more1) gloadV(kt + 1);
        float mx = fmaxf(fmaxf(s0[0], s0[1]), s0[2]);
#pragma unroll
        for (int r = 3; r < 15; r += 2) mx = fmaxf(fmaxf(mx, s0[r]), s0[r + 1]);
        mx = fmaxf(mx, s0[15]);
#pragma unroll
        for (int r = 0; r < 16; r += 2) mx = fmaxf(fmaxf(mx, s1[r]), s1[r + 1]);
        mx = fmaxf(mx, __shfl_xor(mx, 32));
        if (kt == 0 || __builtin_amdgcn_ballot_w64(mx > 8.0f) != 0ull) {
            const float dlt = (kt == 0) ? mx : fmaxf(mx, 0.f);
            const float alpha = (kt == 0) ? 1.0f : __builtin_amdgcn_exp2f(-dlt);
            lsum *= alpha;
#pragma unroll
            for (int r = 0; r < 16; ++r) { O0[r] *= alpha; O1[r] *= alpha; s0[r] -= dlt; s1[r] -= dlt; negm[r] -= dlt; }
        }
        f32x16 n0 = negm, n1 = negm;
        {
            const LAS uchar* kn_ = F.lds + ((kt + 1) & 1) * BUF;
#pragma unroll
            for (int s = 0; s < 6; ++s) {
                const bf16x8 ka = *(const LAS bf16x8*)(kn_ + l31 * KP + (16 * s + 8 * h2) * 2);
                const bf16x8 kb2 = *(const LAS bf16x8*)(kn_ + (32 + l31) * KP + (16 * s + 8 * h2) * 2);
                n0 = mfma32(ka, Qf[s], n0); n1 = mfma32(kb2, Qf[s], n1);
            }
        }
        const LAS uchar* vb_ = F.lds + (kt & 1) * BUF + 64 * KP;
        f32x2 ps2 = {0.f, 0.f};
#pragma unroll
        for (int kb = 0; kb < 2; ++kb)
#pragma unroll
            for (int sp = 0; sp < 2; ++sp) {
                f32x16& sx = kb ? s1 : s0;
#pragma unroll
                for (int r = 8 * sp; r < 8 * sp + 8; r += 2) { sx[r] = __builtin_amdgcn_exp2f(sx[r]); sx[r + 1] = __builtin_amdgcn_exp2f(sx[r + 1]); ps2 += (f32x2){sx[r], sx[r + 1]}; }
                const bf16x8 pf = pack8(sx[8 * sp + 0], sx[8 * sp + 1], sx[8 * sp + 2], sx[8 * sp + 3], sx[8 * sp + 4], sx[8 * sp + 5], sx[8 * sp + 6], sx[8 * sp + 7]);
                const int ko = (32 * kb + 16 * sp + 8 * h2) * 2;
                const bf16x8 va = *(const LAS bf16x8*)(vb_ + l31 * VP + ko), vc = *(const LAS bf16x8*)(vb_ + (32 + l31) * VP + ko);
                O0 = mfma32(va, pf, O0); O1 = mfma32(vc, pf, O1);
            }
        lsum += ps2.x + ps2.y;
        if (more2) lstoreK(kt & 1);
        if (more1) lstoreV((kt + 1) & 1);
        lds_barrier();
        s0 = n0; s1 = n1;
    }
    const float ltot = lsum + __shfl_xor(lsum, 32), inv = 1.0f / ltot;
    bf16* op = MO + (size_t)qrow * D + 256 + hd * 64;
#pragma unroll
    for (int gq = 0; gq < 4; ++gq) {
        v2u o; o.x = pk2(O0[4 * gq] * inv, O0[4 * gq + 1] * inv); o.y = pk2(O0[4 * gq + 2] * inv, O0[4 * gq + 3] * inv);
        *(v2u*)(op + 8 * gq + 4 * h2) = o;
        v2u o2; o2.x = pk2(O1[4 * gq] * inv, O1[4 * gq + 1] * inv); o2.y = pk2(O1[4 * gq + 2] * inv, O1[4 * gq + 3] * inv);
        *(v2u*)(op + 32 + 8 * gq + 4 * h2) = o2;
    }
}
DI float conv3(const bf16* Z, int b, int seg, int t, int len, int col, float w0, float w1, float w2, float cb) {
    const bf16* zp = Z + (size_t)tok_row(b, seg, t) * ZP + col;
    float y = cb + w1 * bf2f(zp[0]);
    if (t > 0) y += w0 * bf2f(zp[-ZP]);
    if (t + 1 < len) y += w2 * bf2f(zp[ZP]);
    return y;
}
DI bf16x8 ldperm(const LAS bf16* rowp, int k0, int hh) { const bf16x4 a0 = *(const LAS bf16x4*)(rowp + k0 + 4 * hh), a1 = *(const LAS bf16x4*)(rowp + k0 + 8 + 4 * hh); return __builtin_shufflevector(a0, a1, 0, 1, 2, 3, 4, 5, 6, 7); }
DI bf16x8 pack_acc(const f32x16& x, int s) { return s ? pack8(x[8], x[9], x[10], x[11], x[12], x[13], x[14], x[15]) : pack8(x[0], x[1], x[2], x[3], x[4], x[5], x[6], x[7]); }
DI void rwkv_scan_task(KArgs a, const Ctx& F, int l, int b, int hd, int dir) {
    const bf16* Z = (const bf16*)(a->ws + WS_ACT); bf16* YR = (bf16*)(a->ws + WS_YR) + (size_t)dir * NROWS * 256;
    constexpr int RAWSZ = 13056 + 4608;
    constexpr int FR_OFF = 4 * 4608 + 3 * 5120 + 256 + 2560;
    constexpr int SETSZ = FR_OFF + 6144;
    LAS uchar* const RAW0 = F.lds;
    LAS float* WL = (LAS float*)(F.lds + 2 * RAWSZ);
    LAS float* AL = WL + 2048;
    LAS float* Alw = AL + 2048;
    LAS float* CST = Alw + 512;
    LAS uchar* const SET0 = (LAS uchar*)(CST + 1024);
    const int tid = F.tid, lane = F.lane, wave = F.wave;
    const int hc = hd * 64 + lane;
    bf16x8 lf0 = {0, 0, 0, 0, 0, 0, 0, 0}, lf1 = lf0;
    if (wave >= 4) { const int w4 = wave - 4, l31 = lane & 31, hh = lane >> 5; const float* up = a->in[(w4 >> 1) ? I_RWUP : I_RAUP] + ((size_t)(l * 2 + dir) * 32) * 256 + hd * 64 + 32 * (w4 & 1) + l31;
        float u[16];
#pragma unroll
        for (int s = 0; s < 2; ++s)
#pragma unroll
            for (int j = 0; j < 8; ++j) u[8 * s + j] = up[(size_t)(16 * s + 8 * hh + j) * 256];
        lf0 = pack8(u[0], u[1], u[2], u[3], u[4], u[5], u[6], u[7]); lf1 = pack8(u[8], u[9], u[10], u[11], u[12], u[13], u[14], u[15]); }
    if (wave == 0) {
        const float* cw = a->in[I_RCW] + (size_t)l * 3 * 768; const float* cbp = a->in[I_RCB] + (size_t)l * 768;
        CST[0 * 64 + lane] = a->in[I_RW0][(l * 2 + dir) * 256 + hc]; CST[1 * 64 + lane] = a->in[I_RA0][(l * 2 + dir) * 256 + hc];
        CST[2 * 64 + lane] = a->in[I_RKK][l * 256 + hc]; CST[3 * 64 + lane] = a->in[I_RKA][l * 256 + hc];
#pragma unroll
        for (int j = 0; j < 3; ++j) { CST[(4 + j) * 64 + lane] = cw[j * 768 + hc]; CST[(7 + j) * 64 + lane] = cw[j * 768 + 256 + hc]; CST[(10 + j) * 64 + lane] = cw[j * 768 + 512 + hc]; }
        CST[13 * 64 + lane] = cbp[hc]; CST[14 * 64 + lane] = cbp[256 + hc]; CST[15 * 64 + lane] = cbp[512 + hc];
    }
    f32x16 ST0, ST1;
#pragma unroll
    for (int r = 0; r < 16; ++r) { ST0[r] = 0.f; ST1[r] = 0.f; }
    const int c0r = tid / 24, c0s = (tid % 24) >> 3, c0c = (tid % 24) & 7;
    const int c1 = tid + 512, c1r = c1 / 24, c1s = (c1 % 24) >> 3, c1c = (c1 % 24) & 7; const bool c1v = c1 < 816;
    const int lr_ = tid >> 3, lc_ = tid & 7;
    v4u g0, g1, g2;
    unsigned zz_ = 0u; asm volatile("" : "+v"(zz_)); const v4u zero4 = {zz_, zz_, zz_, zz_};
    const int nchC = TC / 32, nchT = nchC + T / 32;
    auto gload = [&](int gc) {
        const int seg = gc >= nchC, ch = seg ? gc - nchC : gc, len = seg ? T : TC;
        const int tbase = dir ? (len - 32 * (ch + 1)) : 32 * ch;
        { const int t = tbase - 1 + c0r; g0 = (t >= 0 && t < len) ? *(const v4u*)(Z + (size_t)tok_row(b, seg, t) * ZP + ZRKV + c0s * 256 + hd * 64 + c0c * 8) : zero4; }
        if (c1v) { const int t = tbase - 1 + c1r; g1 = (t >= 0 && t < len) ? *(const v4u*)(Z + (size_t)tok_row(b, seg, t) * ZP + ZRKV + c1s * 256 + hd * 64 + c1c * 8) : zero4; }
        if (tid < 256) { const int t = tbase + lr_; g2 = *(const v4u*)(Z + (size_t)tok_row(b, seg, t) * ZP + ZWD + lc_ * 8); }
    };
    auto lstore = [&](int par) {
        LAS bf16* Raw = (LAS bf16*)(RAW0 + par * RAWSZ); LAS bf16* LwB = (LAS bf16*)(RAW0 + par * RAWSZ + 13056);
        *(LAS v4u*)(Raw + c0r * 192 + c0s * 64 + c0c * 8) = g0;
        if (c1v) *(LAS v4u*)(Raw + c1r * 192 + c1s * 64 + c1c * 8) = g1;
        if (tid < 256) { float x[8] = {bflo(g2.x), bfhi(g2.x), bflo(g2.y), bfhi(g2.y), bflo(g2.z), bfhi(g2.z), bflo(g2.w), bfhi(g2.w)};
            if (lc_ < 4) {
#pragma unroll
                for (int j = 0; j < 8; ++j) x[j] = 1.0f - 2.0f * __builtin_amdgcn_rcpf(1.0f + fexp(2.0f * x[j])); }
            v4u w; w.x = pk2(x[0], x[1]); w.y = pk2(x[2], x[3]); w.z = pk2(x[4], x[5]); w.w = pk2(x[6], x[7]);
            *(LAS v4u*)(LwB + lr_ * 72 + lc_ * 8) = w; }
    };
    gload(0); lstore(0);
    __syncthreads();
    for (int n = -2; n < nchT; ++n) {
        if (n + 3 < nchT) gload(n + 3);
        int ln_ = lane; asm volatile("" : "+v"(ln_));
        const int l31 = ln_ & 31, hh = ln_ >> 5;
        if (wave < 2) {
            if (n >= 0) {
                const int seg = n >= nchC, ch = seg ? n - nchC : n, len = seg ? T : TC;
                const int tbase = dir ? (len - 32 * (ch + 1)) : 32 * ch;
                LAS uchar* sp = SET0 + (n & 1) * SETSZ;
                LAS bf16* KhT = (LAS bf16*)sp; LAS bf16* BhT = KhT + 32 * 72; LAS bf16* KkT = BhT + 32 * 72; LAS bf16* RhT = KkT + 32 * 72;
                LAS bf16* Kh = RhT + 32 * 72; LAS bf16* nBh = Kh + 64 * 40; LAS bf16* VT = nBh + 64 * 40; LAS float* GL = (LAS float*)(VT + 64 * 40); LAS bf16* TT = (LAS bf16*)(GL + 64);
                const int vcol = 32 * wave + l31;
                f32x16 accP, accY;
#pragma unroll
                for (int r = 0; r < 16; ++r) { accP[r] = 0.f; accY[r] = 0.f; }
#pragma unroll
                for (int kb = 0; kb < 2; ++kb)
#pragma unroll
                    for (int s = 0; s < 2; ++s) { const bf16x8 sb = pack_acc(kb ? ST1 : ST0, s);
                        accP = mfma32(ldperm(KkT + l31 * 72, 32 * kb + 16 * s, hh), sb, accP);
                        accY = mfma32(ldperm(RhT + l31 * 72, 32 * kb + 16 * s, hh), sb, accY); }
                const LAS bf16x8* FR = (const LAS bf16x8*)(sp + FR_OFF);
#pragma unroll
                for (int s = 0; s < 2; ++s) { const bf16x8 vt_ = ldperm(VT + vcol * 40, 16 * s, hh);
                    accP = mfma32(FR[(0 + s) * 64 + ln_], vt_, accP);
                    accY = mfma32(FR[(2 + s) * 64 + ln_], vt_, accY); }
                f32x16 accC;
#pragma unroll
                for (int r = 0; r < 16; ++r) accC[r] = 0.f;
#pragma unroll
                for (int s = 0; s < 2; ++s) accC = mfma32(ldperm(TT + l31 * 40, 16 * s, hh), pack_acc(accP, s), accC);
#pragma unroll
                for (int s = 0; s < 2; ++s) accY = mfma32(FR[(4 + s) * 64 + ln_], pack_acc(accC, s), accY);
#pragma unroll
                for (int s = 0; s < 2; ++s) { const bf16x8 vb_ = *(const LAS bf16x8*)(VT + vcol * 40 + 16 * s + 8 * hh); const bf16x8 cb_ = pack_acc(accC, s);
                    ST0 = mfma32(*(const LAS bf16x8*)(Kh + l31 * 40 + 16 * s + 8 * hh), vb_, ST0);
                    ST1 = mfma32(*(const LAS bf16x8*)(Kh + (32 + l31) * 40 + 16 * s + 8 * hh), vb_, ST1);
                    ST0 = mfma32(ldperm(nBh + l31 * 40, 16 * s, hh), cb_, ST0);
                    ST1 = mfma32(ldperm(nBh + (32 + l31) * 40, 16 * s, hh), cb_, ST1); }
#pragma unroll
                for (int r = 0; r < 16; ++r) { ST0[r] *= GL[crow(r, hh)]; ST1[r] *= GL[32 + crow(r, hh)]; }
#pragma unroll
                for (int r = 0; r < 16; ++r) { const int i = crow(r, hh), t = dir ? (tbase + 31 - i) : (tbase + i);
                    YR[(size_t)tok_row(b, seg, t) * 256 + hd * 64 + vcol] = (bf16)f2bf(accY[r]); }
            }
        } else if (wave == 2) {
            if (n + 1 >= 0 && n + 1 < nchT) {
                LAS uchar* sp = SET0 + ((n + 1) & 1) * SETSZ;
                LAS bf16* BhT = (LAS bf16*)sp + 32 * 72; LAS bf16* KkT = BhT + 32 * 72; LAS bf16* TT = (LAS bf16*)(sp + 4 * 4608 + 3 * 5120 + 256);
                f32x16 P, PT, Tm, TTm;
#pragma unroll
                for (int r = 0; r < 16; ++r) { P[r] = 0.f; PT[r] = 0.f; }
#pragma unroll
                for (int s = 0; s < 4; ++s) { const bf16x8 bh_ = *(const LAS bf16x8*)(BhT + l31 * 72 + 16 * s + 8 * hh), kk_ = *(const LAS bf16x8*)(KkT + l31 * 72 + 16 * s + 8 * hh);
                    P = mfma32(bh_, kk_, P); PT = mfma32(kk_, bh_, PT); }
#pragma unroll
                for (int r = 0; r < 16; ++r) { const int j = crow(r, hh);
                    P[r] = (j < l31) ? P[r] : 0.f; PT[r] = (j > l31) ? PT[r] : 0.f;
                    const float idv = (j == l31) ? 1.f : 0.f; Tm[r] = idv - P[r]; TTm[r] = idv - PT[r]; }
#pragma unroll
                for (int it = 0; it < 4; ++it) {
                    const bf16x8 p0 = pack_acc(P, 0), p1 = pack_acc(P, 1), q0 = pack_acc(PT, 0), q1 = pack_acc(PT, 1);
                    f32x16 P2, P2T;
#pragma unroll
                    for (int r = 0; r < 16; ++r) { P2[r] = 0.f; P2T[r] = 0.f; }
                    P2 = mfma32(q0, p0, P2); P2 = mfma32(q1, p1, P2);
                    if (it < 3) { P2T = mfma32(p0, q0, P2T); P2T = mfma32(p1, q1, P2T); }
                    const bf16x8 u0 = pack_acc(TTm, 0), u1 = pack_acc(TTm, 1);
                    const bf16x8 a0 = pack_acc(P2, 0), a1 = pack_acc(P2, 1);
                    Tm = mfma32(u0, a0, Tm); Tm = mfma32(u1, a1, Tm);
                    if (it < 3) { TTm = mfma32(a0, u0, TTm); TTm = mfma32(a1, u1, TTm); }
                    P = P2; PT = P2T;
                }
#pragma unroll
                for (int r = 0; r < 16; ++r) TT[l31 * 40 + crow(r, hh)] = (bf16)f2bf(Tm[r]);
            }
        } else if (wave == 3) {
            if (n + 1 >= 0 && n + 1 < nchT) {
                LAS uchar* sp = SET0 + ((n + 1) & 1) * SETSZ;
                LAS bf16* KhT = (LAS bf16*)sp; LAS bf16* BhT = KhT + 32 * 72; LAS bf16* KkT = BhT + 32 * 72; LAS bf16* RhT = KkT + 32 * 72;
                LAS bf16x8* FR = (LAS bf16x8*)(sp + FR_OFF);
                f32x16 a1, a2, a3;
#pragma unroll
                for (int r = 0; r < 16; ++r) { a1[r] = 0.f; a2[r] = 0.f; a3[r] = 0.f; }
#pragma unroll
                for (int s = 0; s < 4; ++s) { const bf16x8 kh_ = *(const LAS bf16x8*)(KhT + l31 * 72 + 16 * s + 8 * hh), kk_ = *(const LAS bf16x8*)(KkT + l31 * 72 + 16 * s + 8 * hh),
                                                             rh_ = *(const LAS bf16x8*)(RhT + l31 * 72 + 16 * s + 8 * hh), bh_ = *(const LAS bf16x8*)(BhT + l31 * 72 + 16 * s + 8 * hh);
                    a1 = mfma32(kh_, kk_, a1); a2 = mfma32(kh_, rh_, a2); a3 = mfma32(bh_, rh_, a3); }
#pragma unroll
                for (int r = 0; r < 16; ++r) { const int j = crow(r, hh); a1[r] = (j < l31) ? a1[r] : 0.f; a2[r] = (j <= l31) ? a2[r] : 0.f; a3[r] = (j <= l31) ? -a3[r] : 0.f; }
#pragma unroll
                for (int s = 0; s < 2; ++s) { FR[(0 + s) * 64 + ln_] = pack_acc(a1, s); FR[(2 + s) * 64 + ln_] = pack_acc(a2, s); FR[(4 + s) * 64 + ln_] = pack_acc(a3, s); }
            }
        } else if (wave >= 4) {
            if (n + 2 < nchT) {
                const int w4 = wave - 4, mat = (w4 >> 1) ^ 1;
                const LAS bf16* LwB = (const LAS bf16*)(RAW0 + ((n + 2) & 1) * RAWSZ + 13056);
                f32x16 acc;
#pragma unroll
                for (int r = 0; r < 16; ++r) acc[r] = 0.f;
                const int ko = mat * 32, arow = dir ? (31 - l31) : l31, cch = 32 * (w4 & 1) + l31;
                acc = mfma32(*(const LAS bf16x8*)(LwB + arow * 72 + ko + 8 * hh), lf0, acc);
                acc = mfma32(*(const LAS bf16x8*)(LwB + arow * 72 + ko + 16 + 8 * hh), lf1, acc);
                const float c0_ = CST[mat * 64 + cch];
                if (mat) {
#pragma unroll
                    for (int r = 0; r < 16; ++r) AL[crow(r, hh) * 64 + cch] = __builtin_amdgcn_rcpf(1.0f + fexp(-(acc[r] + c0_)));
                } else {
#pragma unroll
                    for (int r = 0; r < 16; ++r) acc[r] = -0.60653065971f * __builtin_amdgcn_rcpf(1.0f + fexp(-(acc[r] + c0_)));
                    float off = 0.f;
#pragma unroll
                    for (int g = 0; g < 4; ++g) {
                        acc[4 * g + 1] += acc[4 * g]; acc[4 * g + 2] += acc[4 * g + 1]; acc[4 * g + 3] += acc[4 * g + 2];
                        const float tg = acc[4 * g + 3], ug = __shfl_xor(tg, 32);
                        const float o = off + (hh ? ug : 0.f);
#pragma unroll
                        for (int e = 0; e < 4; ++e) acc[4 * g + e] += o;
                        off += tg + ug;
                    }
#pragma unroll
                    for (int r = 0; r < 16; ++r) WL[crow(r, hh) * 64 + cch] = acc[r];
                }
            }
        }
        lds_barrier();
#ifdef DBG_REP_R23
        for (int rp_ = 0; rp_ < 2; ++rp_) {
#else
        {
#endif
        const bool pv = n + 2 < nchT;
        const int pi = tid >> 4, c4 = (ln_ & 15) * 4, pjr = dir ? (32 - pi) : (pi + 1);
        if (pv) {
            LAS uchar* sp = SET0 + (n & 1) * SETSZ;
            LAS bf16* KhT = (LAS bf16*)sp; LAS bf16* BhT = KhT + 32 * 72; LAS bf16* KkT = BhT + 32 * 72; LAS bf16* RhT = KkT + 32 * 72;
            LAS bf16* Kh = RhT + 32 * 72; LAS bf16* nBh = Kh + 64 * 40; LAS bf16* VT = nBh + 64 * 40; LAS float* GL = (LAS float*)(VT + 64 * 40);
            const LAS bf16* Raw = (const LAS bf16*)(RAW0 + (n & 1) * RAWSZ);
            const f32x4 cum = *(const LAS f32x4*)(WL + pi * 64 + c4);
            f32x4 cpv = *(const LAS f32x4*)(WL + (pi ? pi - 1 : 0) * 64 + c4);
            if (pi == 0) cpv = (f32x4){0.f, 0.f, 0.f, 0.f};
            float rr[4], kv[4], vv[4];
            { const f32x4 br = *(const LAS f32x4*)(CST + 13 * 64 + c4), bk = *(const LAS f32x4*)(CST + 14 * 64 + c4), bv = *(const LAS f32x4*)(CST + 15 * 64 + c4);
#pragma unroll
              for (int e = 0; e < 4; ++e) { rr[e] = br[e]; kv[e] = bk[e]; vv[e] = bv[e]; } }
#pragma unroll
            for (int tap = 0; tap < 3; ++tap) {
                const LAS bf16* rp = Raw + (pjr - 1 + tap) * 192 + c4;
                const v2u xr = *(const LAS v2u*)rp, xk = *(const LAS v2u*)(rp + 64), xv = *(const LAS v2u*)(rp + 128);
                const f32x4 wr = *(const LAS f32x4*)(CST + (4 + tap) * 64 + c4), wk = *(const LAS f32x4*)(CST + (7 + tap) * 64 + c4), wv = *(const LAS f32x4*)(CST + (10 + tap) * 64 + c4);
                rr[0] += wr[0] * bflo(xr.x); rr[1] += wr[1] * bfhi(xr.x); rr[2] += wr[2] * bflo(xr.y); rr[3] += wr[3] * bfhi(xr.y);
                kv[0] += wk[0] * bflo(xk.x); kv[1] += wk[1] * bfhi(xk.x); kv[2] += wk[2] * bflo(xk.y); kv[3] += wk[3] * bfhi(xk.y);
                vv[0] += wv[0] * bflo(xv.x); vv[1] += wv[1] * bfhi(xv.x); vv[2] += wv[2] * bflo(xv.y); vv[3] += wv[3] * bfhi(xv.y);
            }
            const f32x4 kkc4 = *(const LAS f32x4*)(CST + 2 * 64 + c4), kac4 = *(const LAS f32x4*)(CST + 3 * 64 + c4);
            const f32x4 av4 = *(const LAS f32x4*)(AL + pi * 64 + c4);
            float kx[4]; float ss = 0.f;
#pragma unroll
            for (int e = 0; e < 4; ++e) { kx[e] = kv[e] * kkc4[e]; ss += kx[e] * kx[e]; }
            ss = sum16(ss);
            const float rn = __builtin_amdgcn_rcpf(fmaxf(__builtin_amdgcn_sqrtf(ss), 1e-12f));
            float kh[4], bh[4], kk_[4], rh[4];
#pragma unroll
            for (int e = 0; e < 4; ++e) { const float av = av4[e], kn = kx[e] * rn, en = fexp(-cum[e]), ep = fexp(cum[e]), epv = fexp(cpv[e]);
                kh[e] = kv[e] * (1.0f + (av - 1.0f) * kac4[e]) * en; bh[e] = kn * av * en; kk_[e] = kn * epv; rh[e] = rr[e] * ep; }
            v2u o;
            o.x = pk2(kh[0], kh[1]); o.y = pk2(kh[2], kh[3]); *(LAS v2u*)(KhT + pi * 72 + c4) = o;
            o.x = pk2(bh[0], bh[1]); o.y = pk2(bh[2], bh[3]); *(LAS v2u*)(BhT + pi * 72 + c4) = o;
            o.x = pk2(kk_[0], kk_[1]); o.y = pk2(kk_[2], kk_[3]); *(LAS v2u*)(KkT + pi * 72 + c4) = o;
            o.x = pk2(rh[0], rh[1]); o.y = pk2(rh[2], rh[3]); *(LAS v2u*)(RhT + pi * 72 + c4) = o;
#pragma unroll
            for (int e = 0; e < 4; ++e) { Kh[(c4 + e) * 40 + pi] = (bf16)f2bf(kh[e]); nBh[(c4 + e) * 40 + pi] = (bf16)f2bf(-bh[e]); VT[(c4 + e) * 40 + pi] = (bf16)f2bf(vv[e]); }
            if (pi == 31) *(LAS f32x4*)(GL + c4) = (f32x4){fexp(cum[0]), fexp(cum[1]), fexp(cum[2]), fexp(cum[3])};
        }
        }
        if (n + 3 < nchT) lstore((n + 3) & 1);
        lds_barrier();
    }
}

DI void mlstm_task(KArgs a, const Ctx& F, int l, int b, int hd) {
    const bf16* Z = (const bf16*)(a->ws + WS_ACT);
    const int tid = F.tid, lane = F.lane, wave = F.wave, dir = wave >> 2, w2 = wave & 3, tid2 = tid & 255, l31 = lane & 31, hh = lane >> 5;
    bf16* YM = (bf16*)(a->ws + WS_YM) + (size_t)dir * NROWS * 256;
    constexpr int HP = 72;
    constexpr int HALF_LDS = 6 * 9216 + 2304 + 2048;
    LAS uchar* base = F.lds + dir * HALF_LDS;
    LAS bf16* Qc = (LAS bf16*)base; LAS bf16* Kc = Qc + 64 * HP; LAS bf16* KT = Kc + 64 * HP; LAS bf16* VT = KT + 64 * HP; LAS bf16* Cb0 = VT + 64 * HP;
    LAS float* fv = (LAS float*)(base + 6 * 9216);
    LAS float* Vgv = fv; LAS float* VMr = fv + 64; LAS float* Vwi = fv + 128; LAS float* Vem = fv + 192; LAS float* Vwk = fv + 256; LAS float* Vn0 = fv + 320; LAS float* Vsc = fv + 448;
    LAS float* Cw = fv + 576;
    for (int i = tid2; i < 2 * 64 * HP; i += 256) Cb0[i] = 0;
    if (tid2 < 128) Vn0[tid2] = 0.f;
    { const float* cw = a->in[I_MCW] + (size_t)l * 3 * 512; const float* cbp = a->in[I_MCB] + (size_t)l * 512;
      for (int i = tid2; i < 512; i += 256) { const int tap = i >> 7, cc = i & 127, col = (cc < 64) ? (hd * 64 + cc) : (256 + hd * 64 + cc - 64);
          Cw[i] = (tap < 3) ? cw[tap * 512 + col] : cbp[col]; } }
    f32x16 accC;
#pragma unroll
    for (int r = 0; r < 16; ++r) accC[r] = 0.f;
    float m_run = 0.f;
    const int eb = w2 >> 1, lb = w2 & 1;
    const float gbi = a->in[I_MGB][l * 16 + dir * 8 + hd], gbf = a->in[I_MGB][l * 16 + dir * 8 + 4 + hd];
    const int nchC = TC / 64, nchT = nchC + T / 64;
    const int pi_ = tid2 >> 2, qq = tid2 & 3;
    v4u rq[3][2], rk[3][2], rv[2]; unsigned gr0 = 0u, gr1 = 0u;
    unsigned zz_ = 0u; asm volatile("" : "+v"(zz_)); const v4u zero4 = {zz_, zz_, zz_, zz_};
    auto gload = [&](int gc) {
        const int seg = gc >= nchC, ch = seg ? gc - nchC : gc, len = seg ? T : TC;
        const int tbase = dir ? (len - 64 * (ch + 1)) : 64 * ch;
        const int t = tbase + (dir ? (63 - pi_) : pi_);
#pragma unroll
        for (int tap = 0; tap < 3; ++tap) { const int tt = t - 1 + tap; const bool ok = tt >= 0 && tt < len;
            const bf16* zp = Z + (size_t)tok_row(b, seg, ok ? tt : t) * ZP + ZMQK + hd * 64 + qq * 16;
            rq[tap][0] = ok ? *(const v4u*)zp : zero4; rq[tap][1] = ok ? *(const v4u*)(zp + 8) : zero4;
            rk[tap][0] = ok ? *(const v4u*)(zp + 256) : zero4; rk[tap][1] = ok ? *(const v4u*)(zp + 264) : zero4; }
        { const bf16* zp = Z + (size_t)tok_row(b, seg, t) * ZP + ZMV + hd * 64 + qq * 16; rv[0] = *(const v4u*)zp; rv[1] = *(const v4u*)(zp + 8); }
        if (tid2 < 64) { const bf16* zp = Z + (size_t)tok_row(b, seg, tbase + tid2) * ZP + ZMG + dir * 8 + hd; gr0 = zp[0]; gr1 = zp[4]; }
    };
    gload(0);
    __syncthreads();
    for (int gc = 0; gc < nchT; ++gc) {
        const int seg = gc >= nchC, ch = seg ? gc - nchC : gc, len = seg ? T : TC;
        const int tbase = dir ? (len - 64 * (ch + 1)) : 64 * ch;
        LAS bf16* Cb = Cb0 + (gc & 1) * 64 * HP; LAS bf16* CbN = Cb0 + ((gc + 1) & 1) * 64 * HP;
        LAS float* Vn = Vn0 + (gc & 1) * 64; LAS float* VnN = Vn0 + ((gc + 1) & 1) * 64;
        if (w2 == 0) {
            float li = bf2f(gr0) + gbi; const float fraw = bf2f(gr1) + gbf;
            float lf = fminf(fraw, 0.f) - 0.69314718056f * __builtin_amdgcn_logf(1.0f + fexp(-fabsf(fraw)));
            if (dir) { li = __shfl(li, 63 - lane); lf = __shfl(lf, 63 - lane); }
            const float bc = wave_scan_sum(lf);
            const float g = li - bc; const float pm = wave_scan_max(g);
            const float mprev = m_run;
            const float blast = __shfl(bc, 63);
            const float lw = blast - bc + li;
            const float mnew = fmaxf(blast + mprev, wave_max(lw));
            const float Mr = fmaxf(mprev, pm);
            Vgv[lane] = g; VMr[lane] = Mr; Vwi[lane] = fexp(mprev - Mr); Vem[lane] = fexp(-bc - Mr); Vwk[lane] = fexp(lw - mnew);
            if (lane == 0) Vsc[0] = fexp(blast + mprev - mnew);
            m_run = mnew;
        }
        {
            float qv[16], kvv[16];
#pragma unroll
            for (int j = 0; j < 16; ++j) { qv[j] = Cw[384 + qq * 16 + j]; kvv[j] = Cw[384 + 64 + qq * 16 + j]; }
#pragma unroll
            for (int tap = 0; tap < 3; ++tap) {
                const unsigned qw[8] = {rq[tap][0].x, rq[tap][0].y, rq[tap][0].z, rq[tap][0].w, rq[tap][1].x, rq[tap][1].y, rq[tap][1].z, rq[tap][1].w};
                const unsigned kw[8] = {rk[tap][0].x, rk[tap][0].y, rk[tap][0].z, rk[tap][0].w, rk[tap][1].x, rk[tap][1].y, rk[tap][1].z, rk[tap][1].w};
#pragma unroll
                for (int j = 0; j < 8; ++j) { qv[2 * j] += Cw[tap * 128 + qq * 16 + 2 * j] * bflo(qw[j]); qv[2 * j + 1] += Cw[tap * 128 + qq * 16 + 2 * j + 1] * bfhi(qw[j]);
                    kvv[2 * j] += Cw[tap * 128 + 64 + qq * 16 + 2 * j] * bflo(kw[j]); kvv[2 * j + 1] += Cw[tap * 128 + 64 + qq * 16 + 2 * j + 1] * bfhi(kw[j]); }
            }
#pragma unroll
            for (int j = 0; j < 16; ++j) { qv[j] = qv[j] * fsigmoid(qv[j]); kvv[j] = kvv[j] * fsigmoid(kvv[j]) * 0.125f; }
#pragma unroll
            for (int j = 0; j < 16; j += 2) { *(LAS unsigned*)(Qc + pi_ * HP + qq * 16 + j) = pk2(qv[j], qv[j + 1]); *(LAS unsigned*)(Kc + pi_ * HP + qq * 16 + j) = pk2(kvv[j], kvv[j + 1]); }
            const unsigned vw[8] = {rv[0].x, rv[0].y, rv[0].z, rv[0].w, rv[1].x, rv[1].y, rv[1].z, rv[1].w};
#pragma unroll
            for (int j = 0; j < 16; ++j) { KT[(qq * 16 + j) * HP + pi_] = (bf16)f2bf(kvv[j]); VT[(qq * 16 + j) * HP + pi_] = (bf16)((j & 1) ? (vw[j >> 1] >> 16) : (vw[j >> 1] & 0xffffu)); }
        }
        if (gc + 1 < nchT) gload(gc + 1);
        lds_barrier();
        {
            const int lidx = 32 * lb + l31;
            f32x16 accN, accI;
#pragma unroll
            for (int r = 0; r < 16; ++r) { accN[r] = 0.f; accI[r] = 0.f; }
            float dsum = 0.f;
            const float Mr = VMr[lidx];
#pragma unroll
            for (int sb = 0; sb < 2; ++sb) {
                if (sb <= lb) {
                    f32x16 sT;
#pragma unroll
                    for (int r = 0; r < 16; ++r) sT[r] = 0.f;
#pragma unroll
                    for (int s = 0; s < 4; ++s) {
                        const bf16x8 ka = *(const LAS bf16x8*)(Kc + (32 * sb + l31) * HP + 16 * s + 8 * hh);
                        const bf16x8 qb = *(const LAS bf16x8*)(Qc + lidx * HP + 16 * s + 8 * hh);
                        sT = mfma32(ka, qb, sT);
                    }
#pragma unroll
                    for (int g4 = 0; g4 < 4; ++g4) { const f32x4 gv4 = *(const LAS f32x4*)(Vgv + 32 * sb + 8 * g4 + 4 * hh);
#pragma unroll
                        for (int e = 0; e < 4; ++e) { const int r = 4 * g4 + e, sidx = 32 * sb + 8 * g4 + 4 * hh + e;
                            const float ex = fexp(fminf(gv4[e] - Mr, 0.f));
                            const float p = (sidx <= lidx) ? sT[r] * ex : 0.f; sT[r] = p; dsum += p; } }
#pragma unroll
                    for (int sp = 0; sp < 2; ++sp) {
                        const bf16x8 pf = pack8(sT[8 * sp + 0], sT[8 * sp + 1], sT[8 * sp + 2], sT[8 * sp + 3], sT[8 * sp + 4], sT[8 * sp + 5], sT[8 * sp + 6], sT[8 * sp + 7]);
                        const int ko = 32 * sb + 16 * sp + 4 * hh;
                        const bf16x4 a0 = *(const LAS bf16x4*)(VT + (32 * eb + l31) * HP + ko), a1 = *(const LAS bf16x4*)(VT + (32 * eb + l31) * HP + ko + 8);
                        accN = mfma32(__builtin_shufflevector(a0, a1, 0, 1, 2, 3, 4, 5, 6, 7), pf, accN);
                    }
                }
            }
#pragma unroll
            for (int s = 0; s < 4; ++s) {
                const bf16x8 ca = *(const LAS bf16x8*)(Cb + (32 * eb + l31) * HP + 16 * s + 8 * hh);
                const bf16x8 qb = *(const LAS bf16x8*)(Qc + lidx * HP + 16 * s + 8 * hh);
                accI = mfma32(ca, qb, accI);
            }
            dsum += __shfl_xor(dsum, 32);
            float nq = 0.f;
#pragma unroll
            for (int j = 0; j < 64; j += 8) { const v4u w = *(const LAS v4u*)(Qc + lidx * HP + j); const f32x4 n0 = *(const LAS f32x4*)(Vn + j), n1 = *(const LAS f32x4*)(Vn + j + 4);
                nq += (n0[0] * bflo(w.x) + n0[1] * bfhi(w.x)) + (n0[2] * bflo(w.y) + n0[3] * bfhi(w.y)) + (n1[0] * bflo(w.z) + n1[1] * bfhi(w.z)) + (n1[2] * bflo(w.w) + n1[3] * bfhi(w.w)); }
            const float wi = Vwi[lidx];
            const float den = dsum + wi * nq, hden = fmaxf(fabsf(den), Vem[lidx]), inv = __builtin_amdgcn_rcpf(hden);
            const int t = dir ? (tbase + 63 - lidx) : (tbase + lidx);
            bf16* op = YM + (size_t)tok_row(b, seg, t) * 256 + hd * 64 + 32 * eb;
#pragma unroll
            for (int gq_ = 0; gq_ < 4; ++gq_) {
                const float h0 = (accN[4 * gq_] + wi * accI[4 * gq_]) * inv, h1 = (accN[4 * gq_ + 1] + wi * accI[4 * gq_ + 1]) * inv, h2 = (accN[4 * gq_ + 2] + wi * accI[4 * gq_ + 2]) * inv, h3 = (accN[4 * gq_ + 3] + wi * accI[4 * gq_ + 3]) * inv;
                v2u o; o.x = pk2(h0, h1); o.y = pk2(h2, h3);
                *(v2u*)(op + 8 * gq_ + 4 * hh) = o;
            }
        }
        {
            const float sc = Vsc[0];
#pragma unroll
            for (int r = 0; r < 16; ++r) accC[r] *= sc;
#pragma unroll
            for (int s = 0; s < 4; ++s) {
                const v4u vraw = *(const LAS v4u*)(VT + (32 * eb + l31) * HP + 16 * s + 8 * hh);
                const f32x4 w0 = *(const LAS f32x4*)(Vwk + 16 * s + 8 * hh), w1 = *(const LAS f32x4*)(Vwk + 16 * s + 8 * hh + 4);
                const bf16x8 va = pack8(bflo(vraw.x) * w0[0], bfhi(vraw.x) * w0[1], bflo(vraw.y) * w0[2], bfhi(vraw.y) * w0[3], bflo(vraw.z) * w1[0], bfhi(vraw.z) * w1[1], bflo(vraw.w) * w1[2], bfhi(vraw.w) * w1[3]);
                const bf16x8 kb = *(const LAS bf16x8*)(KT + (32 * lb + l31) * HP + 16 * s + 8 * hh);
                accC = mfma32(va, kb, accC);
            }
#pragma unroll
            for (int r = 0; r < 16; ++r) CbN[(32 * eb + crow(r, hh)) * HP + 32 * lb + l31] = (bf16)f2bf(accC[r]);
            if (tid2 < 64) { float s = 0.f;
#pragma unroll
                for (int j = 0; j < 64; j += 8) { const v4u w = *(const LAS v4u*)(KT + tid2 * HP + j); const f32x4 w0 = *(const LAS f32x4*)(Vwk + j), w1 = *(const LAS f32x4*)(Vwk + j + 4);
                    s += (w0[0] * bflo(w.x) + w0[1] * bfhi(w.x)) + (w0[2] * bflo(w.y) + w0[3] * bfhi(w.y)) + (w1[0] * bflo(w.z) + w1[1] * bfhi(w.z)) + (w1[2] * bflo(w.w) + w1[3] * bfhi(w.w)); }
                VnN[tid2] = sc * Vn[tid2] + s; }
        }
        lds_barrier();
    }
}
DI float gelu_tanh(float x) { const float u = 0.7978845608028654f * (x + 0.044715f * x * x * x); const float e = __expf(2.0f * u); const float th = 1.0f - 2.0f / (e + 1.0f); return 0.5f * x * (1.0f + th); }
DI void unpack8(const v4u w, float (&o)[8]) { o[0] = bflo(w.x); o[1] = bfhi(w.x); o[2] = bflo(w.y); o[3] = bfhi(w.y); o[4] = bflo(w.z); o[5] = bfhi(w.z); o[6] = bflo(w.w); o[7] = bfhi(w.w); }
DI v4u pack8u(const float (&o)[8]) { v4u w; w.x = pk2(o[0], o[1]); w.y = pk2(o[2], o[3]); w.z = pk2(o[4], o[5]); w.w = pk2(o[6], o[7]); return w; }
constexpr int FIN_CST_OFF = 56320;
DI void fin_load_consts(KArgs a, const Ctx& F, int l) {
    LAS float* C = (LAS float*)(F.lds + FIN_CST_OFF);
    for (int i = F.tid; i < 4608; i += NTHR) {
        float v;
        if (i < 2304) v = a->in[I_RCW][(size_t)l * 2304 + i];
        else if (i < 3072) v = a->in[I_RCB][(size_t)l * 768 + (i - 2304)];
        else if (i < 3328) v = a->in[I_RRK][l * 256 + (i - 3072)];
        else if (i < 3584) v = a->in[I_RLNW][l * 256 + (i - 3328)];
        else if (i < 3840) v = a->in[I_RLNB][l * 256 + (i - 3584)];
        else if (i < 4096) v = a->in[I_MNORM][l * 256 + (i - 3840)];
        else if (i < 4352) v = a->in[I_S5D][l * 256 + (i - 4096)];
        else v = a->in[I_S5BGLU][l * 256 + (i - 4352)];
        C[i] = v;
    }
    __syncthreads();
}
DI void fin_tile(KArgs a, const Ctx& F, int l, int tile) {
    const LAS float* CT = (const LAS float*)(F.lds + FIN_CST_OFF);
    const bf16* Z = (const bf16*)(a->ws + WS_ACT); bf16* MO = (bf16*)(a->ws + WS_H);
    const bf16* YS = (const bf16*)(a->ws + WS_YS5); const bf16* YR = (const bf16*)(a->ws + WS_YR); const bf16* YM = (const bf16*)(a->ws + WS_YM);
    const bf16* WGLU = (const bf16*)(a->ws + WS_SMALLW + SW_GLU); const bf16* WGUP = (const bf16*)(a->ws + WS_SMALLW + SW_GUP);
    LAS bf16* Az = (LAS bf16*)F.lds;
    LAS bf16* Ag = (LAS bf16*)(F.lds + 16896);
    LAS float* Pr = (LAS float*)(F.lds + 16896 + 4608);
    int tl_ = F.tid; asm volatile("" : "+v"(tl_));
    const int tid = tl_, lane = tid & 63, wave = F.wave, row0 = tile * 32;
    const int i = tid >> 4, part = tid & 15, row = row0 + i;
    const size_t DS = (size_t)NROWS * 256;
    const bf16* zr = Z + (size_t)row * ZP;
    {
        const LAS float* dsk = CT + 4096 + part * 16;
#pragma unroll
        for (int j = 0; j < 2; ++j) { const int c0 = part * 16 + 8 * j; float y0[8], y1[8], u[8], z[8];
            unpack8(*(const v4u*)(YS + (size_t)row * 256 + c0), y0); unpack8(*(const v4u*)(YS + DS + (size_t)row * 256 + c0), y1); unpack8(*(const v4u*)(zr + ZS5 + c0), u);
#pragma unroll
            for (int e = 0; e < 8; ++e) z[e] = gelu_tanh(y0[e] + y1[e] + dsk[8 * j + e] * u[e]);
            *(LAS v4u*)(Az + i * 264 + c0) = pack8u(z); }
    }
    const int hq = part >> 2, c0 = hq * 64 + (part & 3) * 16;
    const bool lat = row < NLAT; const int t = lat ? (row & (T - 1)) : ((row - NLAT) & (TC - 1)); const int len = lat ? T : TC;
    {
        float y[16]; float s = 0.f;
#pragma unroll
        for (int j = 0; j < 2; ++j) { float y0[8], y1[8]; unpack8(*(const v4u*)(YM + (size_t)row * 256 + c0 + 8 * j), y0); unpack8(*(const v4u*)(YM + DS + (size_t)row * 256 + c0 + 8 * j), y1);
#pragma unroll
            for (int e = 0; e < 8; ++e) { y[8 * j + e] = y0[e] + y1[e]; s += y[8 * j + e]; } }
        s += __shfl_xor(s, 1); s += __shfl_xor(s, 2); const float mu = s * (1.0f / 64.0f); float q = 0.f;
#pragma unroll
        for (int j = 0; j < 16; ++j) { y[j] -= mu; q += y[j] * y[j]; }
        q += __shfl_xor(q, 1); q += __shfl_xor(q, 2); const float rstd = 1.0f / sqrtf(q * (1.0f / 64.0f) + 1e-6f);
        const LAS float* nw = CT + 3840 + c0;
#pragma unroll
        for (int j = 0; j < 2; ++j) { float o[8]; unpack8(*(const v4u*)(zr + ZMO + c0 + 8 * j), o);
#pragma unroll
            for (int e = 0; e < 8; ++e) o[e] = y[8 * j + e] * rstd * nw[8 * j + e] * fsigmoid(o[e]);
            *(v4u*)(MO + (size_t)row * D + 768 + c0 + 8 * j) = pack8u(o); }
    }
    {
        float y[16]; float s = 0.f;
#pragma unroll
        for (int j = 0; j < 2; ++j) { float y0[8], y1[8]; unpack8(*(const v4u*)(YR + (size_t)row * 256 + c0 + 8 * j), y0); unpack8(*(const v4u*)(YR + DS + (size_t)row * 256 + c0 + 8 * j), y1);
#pragma unroll
            for (int e = 0; e < 8; ++e) { y[8 * j + e] = y0[e] + y1[e]; s += y[8 * j + e]; } }
        s += __shfl_xor(s, 1); s += __shfl_xor(s, 2); const float mu = s * (1.0f / 64.0f); float q = 0.f;
#pragma unroll
        for (int j = 0; j < 16; ++j) { y[j] -= mu; q += y[j] * y[j]; }
        q += __shfl_xor(q, 1); q += __shfl_xor(q, 2); const float rstd = 1.0f / sqrtf(q * (1.0f / 64.0f) + 64e-5f);
        const LAS float* cw = CT; const LAS float* cbp = CT + 2304;
        const LAS float* rk = CT + 3072 + c0; const LAS float* lw = CT + 3328 + c0; const LAS float* lb = CT + 3584 + c0;
        float vv[16]; float bs = 0.f;
#pragma unroll
        for (int j = 0; j < 2; ++j) { const int c = c0 + 8 * j;
            float rr[8], kk[8], v[8], x[8];
#pragma unroll
            for (int e = 0; e < 8; ++e) { rr[e] = cbp[c + e]; kk[e] = cbp[256 + c + e]; v[e] = cbp[512 + c + e]; }
#pragma unroll
            for (int tap = 0; tap < 3; ++tap) { const int tt = t - 1 + tap;
                if (tt >= 0 && tt < len) { const bf16* zp = zr + (tap - 1) * ZP + ZRKV + c;
                    unpack8(*(const v4u*)zp, x);
#pragma unroll
                    for (int e = 0; e < 8; ++e) rr[e] += cw[tap * 768 + c + e] * x[e];
                    unpack8(*(const v4u*)(zp + 256), x);
#pragma unroll
                    for (int e = 0; e < 8; ++e) kk[e] += cw[tap * 768 + 256 + c + e] * x[e];
                    unpack8(*(const v4u*)(zp + 512), x);
#pragma unroll
                    for (int e = 0; e < 8; ++e) v[e] += cw[tap * 768 + 512 + c + e] * x[e]; } }
#pragma unroll
            for (int e = 0; e < 8; ++e) { bs += rr[e] * kk[e] * rk[8 * j + e]; vv[8 * j + e] = v[e]; } }
        bs += __shfl_xor(bs, 1); bs += __shfl_xor(bs, 2);
#pragma unroll
        for (int j = 0; j < 16; j += 4) *(LAS f32x4*)(Pr + i * 260 + c0 + j) = (f32x4){y[j] * rstd * lw[j] + lb[j] + bs * vv[j], y[j + 1] * rstd * lw[j + 1] + lb[j + 1] + bs * vv[j + 1], y[j + 2] * rstd * lw[j + 2] + lb[j + 2] + bs * vv[j + 2], y[j + 3] * rstd * lw[j + 3] + lb[j + 3] + bs * vv[j + 3]};
    }
    {
        const v2u gv = *(const v2u*)(zr + ZGD + part * 4);
        v2u o; o.x = pk2(fsigmoid(bflo(gv.x)), fsigmoid(bfhi(gv.x))); o.y = pk2(fsigmoid(bflo(gv.y)), fsigmoid(bfhi(gv.y)));
        *(LAS v2u*)(Ag + i * 72 + part * 4) = o;
    }
    __syncthreads();
    const int lr = lane & 15, kq = lane >> 4;
    {
        f32x4 acc[2][2];
        small_gemm<256, 2, 2, true>(Az, 264, WGLU, 32 * wave, acc, lane);
        const LAS float* bg = CT + 4352;
#pragma unroll
        for (int nb = 0; nb < 2; ++nb)
#pragma unroll
            for (int mb = 0; mb < 2; ++mb) { const int tk = 16 * mb + lr, n = 32 * wave + 16 * nb + 4 * kq; const f32x4 v = acc[nb][mb]; const f32x4 b4 = *(const LAS f32x4*)(bg + n);
                const v2u zz = *(const LAS v2u*)(Az + tk * 264 + n);
                const float o0 = bflo(zz.x) * fsigmoid(v.x + b4.x), o1 = bfhi(zz.x) * fsigmoid(v.y + b4.y), o2 = bflo(zz.y) * fsigmoid(v.z + b4.z), o3 = bfhi(zz.y) * fsigmoid(v.w + b4.w);
                v2u o; o.x = pk2(o0, o1); o.y = pk2(o2, o3);
                *(v2u*)(MO + (size_t)(row0 + tk) * D + n) = o; }
    }
    {
        f32x4 acc[2][2];
        small_gemm<64, 2, 2, true>(Ag, 72, WGUP, 32 * wave, acc, lane);
#pragma unroll
        for (int nb = 0; nb < 2; ++nb)
#pragma unroll
            for (int mb = 0; mb < 2; ++mb) { const int tk = 16 * mb + lr, n = 32 * wave + 16 * nb + 4 * kq; const f32x4 v = acc[nb][mb];
                const f32x4 pr = *(const LAS f32x4*)(Pr + tk * 260 + n);
                v2u o; o.x = pk2(pr.x * v.x, pr.y * v.y); o.y = pk2(pr.z * v.z, pr.w * v.w);
                *(v2u*)(MO + (size_t)(row0 + tk) * D + 512 + n) = o; }
    }
    __syncthreads();
}
#ifndef MK_SPLIT
#define MK_SPLIT 1
#endif
#ifndef MERGE_PREP
#define MERGE_PREP 1
#endif
#ifdef USE_NOINLINE
#define NI static __device__ __noinline__
#else
#define NI static __device__ __forceinline__
#endif
extern __shared__ __attribute__((aligned(16))) unsigned char lds_raw[];
DI Ctx make_ctx(int wave0) {
    Ctx F; F.lds = (LAS uchar*)lds_raw; { int ln_ = __builtin_amdgcn_mbcnt_hi(~0u, __builtin_amdgcn_mbcnt_lo(~0u, 0u)); asm volatile("" : "+v"(ln_)); F.lane = ln_; } F.wave = wave0; F.tid = wave0 * 64 + F.lane;
    F.G = gridDim.x; { int bx = blockIdx.x; asm volatile("" : "+s"(bx)); F.vcu = (F.G % 8 == 0) ? (bx % 8) * (F.G / 8) + bx / 8 : bx; }
    return F;
}
DI void att_subbarrier(unsigned* cnt, unsigned n_att, bool t0) {
    asm volatile("s_waitcnt vmcnt(0)" ::: "memory");
    __syncthreads();
    if (t0) {
        __builtin_amdgcn_fence(__ATOMIC_RELEASE, "agent");
        asm volatile("s_waitcnt vmcnt(0)" ::: "memory");
        (void)xb_add(cnt, 1u);
        unsigned sp = 0u;
        while (xb_ld(cnt) < n_att) { __builtin_amdgcn_s_sleep(1); if (++sp > XB_SPIN_CAP) break; }
        __builtin_amdgcn_fence(__ATOMIC_ACQUIRE, "agent");
        asm volatile("s_waitcnt vmcnt(0)" ::: "memory");
    }
    __syncthreads();
}
NI void ph_prologue(KArgs a_, int wave0) { KArgs a = a_; asm volatile("" : "+s"(a)); const Ctx F = make_ctx(wave0); phase_prologue(a, F); __syncthreads(); }
NI void ph_norm(KArgs a_, int wave0, int l, int kind) { KArgs a = a_; asm volatile("" : "+s"(a));
    const Ctx F = make_ctx(wave0);
    float* modv = (float*)(a->ws + WS_MODV);
    const bool last = (l == DEPTH - 1);
    if (kind == 0) convert_weights(a, F, l, 0);
    if (kind == 1) convert_weights(a, F, l, 1);
    const int lY = (kind == 0) ? (l > 0 ? l - 1 : 0) : l;
    const int gi = (kind == 0 || kind == 3) ? 8 : (kind == 1 ? 2 : 5);
    const int pi = (kind == 0 || kind == 3) ? 2 : (kind == 1 ? 0 : 1);
    const float coef = (kind == 2) ? 1.0f : 0.5f;
    const int si = (kind == 0) ? 0 : (kind == 1 ? 3 : 6);
    const int ni = (kind == 0) ? 0 : (kind == 1 ? 1 : 2);
    const bool first = (kind == 0 && l == 0), hasY = !(kind == 0 && l == 0), hasH = (kind != 3), fin = (kind == 3);
    const int nrows = (kind == 3 || (kind == 2 && last)) ? NLAT : NROWS;
#ifdef DUP_NORM
    if (kind == DUP_NORM && hasY) { norm_rows(a, F, first, hasY, hasH, fin, nrows, modv + (size_t)lY * 9 * MODW, gi, a->in[I_NPOST] + (lY * 3 + pi) * D, coef, modv + (size_t)l * 9 * MODW, si, a->in[I_NPRE] + (l * 3 + ni) * D, true); __syncthreads(); }
#endif
    norm_rows(a, F, first, hasY, hasH, fin, nrows, modv + (size_t)lY * 9 * MODW, gi, a->in[I_NPOST] + (lY * 3 + pi) * D, coef, modv + (size_t)l * 9 * MODW, si, a->in[I_NPRE] + (l * 3 + ni) * D);
    __syncthreads();
}
NI void ph_gemm_swiglu(KArgs a_, int wave0, int M) { KArgs a = a_; asm volatile("" : "+s"(a));
    const Ctx F = make_ctx(wave0);
    pg8::Gemm g{(const bf16*)(a->ws + WS_H), (const bf16*)(a->ws + WS_WGU), M, 2 * FF, D}; pg8::StaticOrder S; S.init(M, 2 * FF, F.G, (int)blockIdx.x);
    pg8::EpiSwiGLU E{(bf16*)(a->ws + WS_ACT), FF};
    pg8::gemm_phase<pg8::EpiSwiGLU, pg8::StaticOrder, PG8_ALIGN, PG8_SP2>(F.lds, g, S, E, F.tid);
}
NI void ph_gemm_store(KArgs a_, int wave0, int which, int M) { KArgs a = a_; asm volatile("" : "+s"(a));
    const Ctx F = make_ctx(wave0);
    const bf16* A = (const bf16*)(a->ws + (which == 0 ? WS_ACT : WS_H));
    const bf16* W = (const bf16*)(a->ws + (which == 0 ? WS_WDN : which == 1 ? WS_WIN : WS_WOUT));
    const int N = which == 1 ? ZPAD : D, K = which == 0 ? FF : D;
    const bool split_ctx = (which != 1) && (M == NROWS);
    const int Mg = split_ctx ? NLAT : M;
    pg8::Gemm g{A, W, Mg, N, K}; pg8::StaticOrder S; S.init(Mg, N, F.G, (int)blockIdx.x);
    pg8::EpiStore E{(bf16*)(a->ws + (which == 1 ? WS_ACT : WS_Y)), which == 1 ? ZP : D, which == 1 ? ZP : D};
    pg8::gemm_phase<pg8::EpiStore, pg8::StaticOrder, PG8_ALIGN, PG8_SP2>(F.lds, g, S, E, F.tid);
    if (split_ctx) { __syncthreads(); ctx_gemm_block(F, A, W, K, (bf16*)(a->ws + WS_Y)); }
}
NI void ph_mla_prep(KArgs a_, int wave0, int l, int first, int stride) { KArgs a = a_; asm volatile("" : "+s"(a)); const Ctx F = make_ctx(wave0); for (int tile = first; tile < NROWS / 64; tile += stride) mla_prep_tile(a, F, l, tile); }
NI void ph_rwkv(KArgs a_, int wave0, int l, int v) { KArgs a = a_; asm volatile("" : "+s"(a)); const Ctx F = make_ctx(wave0); rwkv_scan_task(a, F, l, v >> 3, (v >> 1) & 3, v & 1); }
NI void ph_mlstm(KArgs a_, int wave0, int l, int idx) { KArgs a = a_; asm volatile("" : "+s"(a)); const Ctx F = make_ctx(wave0); mlstm_task(a, F, l, idx >> 2, idx & 3); __syncthreads(); }
NI void ph_s5(KArgs a_, int wave0, int l, int wg) { KArgs a = a_; asm volatile("" : "+s"(a)); const Ctx F = make_ctx(wave0); const int tk = wg * 8 + F.wave; s5_scan_task(a, l, tk >> 5, (tk >> 4) & 1, tk & 15, (LAS bf16*)(F.lds + F.wave * 8704), F.lane); __syncthreads(); }
NI void ph_attn(KArgs a_, int wave0, int first, int stride) { KArgs a = a_; asm volatile("" : "+s"(a));
    const Ctx F = make_ctx(wave0);
    for (int u = first; u < 512 + 32; u += stride) {
        if (u < 512) { const int b = u >> 6, hd = (u >> 4) & 3, qb = u & 15; attn_unit(a, F, b, hd, b * T + qb * 256, NKEY); }
        else { const int c = u - 512, b = c >> 2, hd = c & 3; attn_unit(a, F, b, hd, NLAT + b * TC, TC); }
    }
}
NI void ph_fin(KArgs a_, int wave0, int l, int M) { KArgs a = a_; asm volatile("" : "+s"(a)); const Ctx F = make_ctx(wave0); fin_load_consts(a, F, l); for (int tile = F.vcu; tile < M / 32; tile += F.G) fin_tile(a, F, l, tile); }


#ifdef DBG_CUT
NI void ph_dump(KArgs a_, int wave0) { KArgs a = a_; asm volatile("" : "+s"(a)); const Ctx F = make_ctx(wave0);
    const float* X = (const float*)(a->ws + WS_X); const bf16* Z = (const bf16*)(a->ws + WS_ACT); const bf16* Q = (const bf16*)(a->ws + WS_Q); const bf16* Kf = (const bf16*)(a->ws + WS_K); const bf16* Vt = (const bf16*)(a->ws + WS_VT);
    const bf16* YS = (const bf16*)(a->ws + WS_YS5); const bf16* YR = (const bf16*)(a->ws + WS_YR); const bf16* YM = (const bf16*)(a->ws + WS_YM); const bf16* MO = (const bf16*)(a->ws + WS_H); const bf16* Y = (const bf16*)(a->ws + WS_Y);
    const size_t DS = (size_t)NROWS * 256;
    for (size_t i = (size_t)F.vcu * NTHR + F.tid; i < (size_t)NLAT * D; i += (size_t)F.G * NTHR) {
#ifdef DBG_CTX
        const size_t r = NLAT + ((i >> 10) % NCTX);
#else
        const size_t r = i >> 10;
#endif
        const int c = (int)(i & 1023); float v = 0.f;
        if (DBG_WHICH & 1) v += X[r * D + c];
        if (DBG_WHICH & 2) { v += bf2f(Z[r * ZP + c]) + bf2f(Z[r * ZP + 1024 + c]); if (c + 2048 < ZP) v += bf2f(Z[r * ZP + 2048 + c]); }
        if (DBG_WHICH & 4) { v += bf2f(Q[r * 384 + c % 384]) + bf2f(Kf[r * 384 + c % 384]) + bf2f(Vt[i % ((size_t)NB * 4 * 64 * NKEY)]); }
        if (DBG_WHICH & 256) v += bf2f(Q[r * 384 + c % 384]);
        if (DBG_WHICH & 512) v += bf2f(Kf[r * 384 + c % 384]);
        if (DBG_WHICH & 1024) v += bf2f(Vt[i % ((size_t)NB * 4 * 64 * NKEY)]);
        if (DBG_WHICH & 2048) { const float* rc = (const float*)(a->ws + WS_ROPE); const bf16* sw = (const bf16*)(a->ws + WS_SMALLW); v += rc[i % (T * 32)] + bf2f(sw[i % 245760]); }
        if (DBG_WHICH & 8) v += bf2f(YS[r * 256 + (c & 255)]) + bf2f(YS[DS + r * 256 + (c & 255)]);
        if (DBG_WHICH & 16) v += bf2f(YR[r * 256 + (c & 255)]) + bf2f(YR[DS + r * 256 + (c & 255)]);
        if (DBG_WHICH & 32) v += bf2f(YM[r * 256 + (c & 255)]) + bf2f(YM[DS + r * 256 + (c & 255)]);
        if (DBG_WHICH & 64) v += bf2f(MO[r * D + c]);
        if (DBG_WHICH & 128) v += bf2f(Y[r * D + c]);
        a->out[i] = v;
    }
}
#endif
#if !MK_SPLIT
#if defined(ONLY_PH)
#define PHON(k) ((k) == ONLY_PH)
#elif defined(NO_PH)
#define PHON(k) ((k) != NO_PH)
#else
#define PHON(k) true
#endif
#if defined(ONLY_ROLE)
#define ROLE(k) ((k) == ONLY_ROLE)
#elif defined(NO_ROLE)
#define ROLE(k) ((k) != NO_ROLE)
#else
#define ROLE(k) true
#endif
#ifdef DUP_BAR
#define DUPBAR(x) x
#else
#define DUPBAR(x)
#endif
#ifdef DUP_ROLE
#ifndef DUP_N
#define DUP_N 2
#endif
#define NREPR(k) ((k) == DUP_ROLE ? DUP_N : 1)
#else
#define NREPR(k) 1
#endif
#ifdef DUP_PH
#define NREP(k) ((k) == DUP_PH ? 2 : 1)
#else
#define NREP(k) 1
#endif
constexpr int NPH = 2 + 12 * DEPTH;
__global__ void __launch_bounds__(NTHR, 2) hybrid_fwd(Args args_byval) {
    KArgs a = (KArgs)__builtin_amdgcn_kernarg_segment_ptr();
    LAS uchar* lds = (LAS uchar*)lds_raw;
    const int tid = threadIdx.x; const int wave0 = __builtin_amdgcn_readfirstlane(tid >> 6);
    volatile LAS unsigned* MISC = (volatile LAS unsigned*)(lds + MISC_OFF);
    for (int u = tid; u < (LDS_BYTES - LDSCTL_OFF) / 4; u += NTHR) ((LAS unsigned*)(lds + LDSCTL_OFF))[u] = 0u;
    __syncthreads();
    unsigned* ctl = (unsigned*)(a->ws + WS_CTL);
    const int use_bar = a->use_bar;
    XcdBarrier bar; bar.bar = ctl + CW_BAR; bar.x = 0; bar.st = nullptr;
    if (use_bar) bar = xcd_barrier_post(ctl + CW_BAR, MISC + 8, tid == 0);
    const int lo = a->ph_lo, hi = a->ph_hi;
    const int G = gridDim.x; const int vcu = (G % 8 == 0) ? ((int)blockIdx.x % 8) * (G / 8) + (int)blockIdx.x / 8 : (int)blockIdx.x;
#ifdef DBG_CUT
#define IN(k) (lo <= (k) && (k) < hi && (k) < DBG_CUT)
#else
#define IN(k) (lo <= (k) && (k) < hi)
#endif
#define SEAM(k) do { if (use_bar && IN(k) && IN((k) + 1)) { int ln_ = __builtin_amdgcn_mbcnt_hi(~0u, __builtin_amdgcn_mbcnt_lo(~0u, 0u)); asm volatile("" : "+v"(ln_)); xcd_barrier(bar, wave0 == 0 && ln_ == 0); DUPBAR(xcd_barrier(bar, wave0 == 0 && ln_ == 0);) } } while (0)
    if (PHON(100) && IN(0)) ph_prologue(a, wave0);
    SEAM(0);
#pragma unroll 1
    for (int l = 0; l < DEPTH; ++l) {
        const int P = 1 + 12 * l;
        const int Mtail = (l == DEPTH - 1) ? NLAT : NROWS;
        if (PHON(0) && IN(P + 0)) { ph_norm(a, wave0, l, 0);
#ifdef DUP_FIRSTNORM
            if (l == 0) for (int rr_ = 0; rr_ < DUP_FIRSTNORM; ++rr_) ph_norm(a, wave0, l, 0);
#endif
        }
        SEAM(P + 0);
        if (PHON(1) && IN(P + 1)) for (int rep_ = 0; rep_ < NREP(1); ++rep_) ph_gemm_swiglu(a, wave0, NROWS);
        SEAM(P + 1);
        if (PHON(2) && IN(P + 2)) for (int rep_ = 0; rep_ < NREP(2); ++rep_) ph_gemm_store(a, wave0, 0, NROWS);
        SEAM(P + 2);
        if (PHON(3) && IN(P + 3)) ph_norm(a, wave0, l, 1);
        SEAM(P + 3);
        if (PHON(4) && IN(P + 4)) for (int rep_ = 0; rep_ < NREP(4); ++rep_) ph_gemm_store(a, wave0, 1, NROWS);
        SEAM(P + 4);
#if MERGE_PREP
        if (PHON(6) && IN(P + 6) && G >= 256) {
            if (ROLE(0) && vcu < 64) { for (int rr_ = 0; rr_ < NREPR(0); ++rr_) ph_rwkv(a, wave0, l, vcu); }
            else if (ROLE(1) && vcu < 96) { for (int rr_ = 0; rr_ < NREPR(1); ++rr_) ph_mlstm(a, wave0, l, vcu - 64); }
            else if (ROLE(2) && vcu < 128) { for (int rr_ = 0; rr_ < NREPR(2); ++rr_) ph_s5(a, wave0, l, vcu - 96); }
            else if (ROLE(3)) {
                ph_mla_prep(a, wave0, l, vcu - 128, G - 128);
                { int ln_ = __builtin_amdgcn_mbcnt_hi(~0u, __builtin_amdgcn_mbcnt_lo(~0u, 0u)); asm volatile("" : "+v"(ln_)); att_subbarrier(ctl + CW_SUB + 64 * l, (unsigned)(G - 128), wave0 == 0 && ln_ == 0); }
                for (int rr_ = 0; rr_ < NREPR(3); ++rr_) ph_attn(a, wave0, vcu - 128, G - 128);
            }
        }
#else
        if (PHON(5) && IN(P + 5)) for (int rep_ = 0; rep_ < NREP(5); ++rep_) ph_mla_prep(a, wave0, l);
        SEAM(P + 5);
        if (PHON(6) && IN(P + 6) && G >= 256) for (int rep_ = 0; rep_ < NREP(6); ++rep_) {
            if (ROLE(0) && vcu < 64) { for (int rr_ = 0; rr_ < NREPR(0); ++rr_) ph_rwkv(a, wave0, l, vcu); }
            else if (ROLE(1) && vcu < 96) { for (int rr_ = 0; rr_ < NREPR(1); ++rr_) ph_mlstm(a, wave0, l, vcu - 64); }
            else if (ROLE(2) && vcu < 128) { for (int rr_ = 0; rr_ < NREPR(2); ++rr_) ph_s5(a, wave0, l, vcu - 96); }
            else if (ROLE(3)) { for (int rr_ = 0; rr_ < NREPR(3); ++rr_) ph_attn(a, wave0, vcu - 128, G - 128); }
        }
#endif
        SEAM(P + 6);
        if (PHON(7) && IN(P + 7)) for (int rep_ = 0; rep_ < NREP(7); ++rep_) ph_fin(a, wave0, l, Mtail);
        SEAM(P + 7);
        if (PHON(8) && IN(P + 8)) for (int rep_ = 0; rep_ < NREP(8); ++rep_) ph_gemm_store(a, wave0, 2, Mtail);
        SEAM(P + 8);
        if (PHON(9) && IN(P + 9)) ph_norm(a, wave0, l, 2);
        SEAM(P + 9);
        if (PHON(10) && IN(P + 10)) ph_gemm_swiglu(a, wave0, Mtail);
        SEAM(P + 10);
        if (PHON(11) && IN(P + 11)) ph_gemm_store(a, wave0, 0, Mtail);
        SEAM(P + 11);
    }
#ifdef DBG_CUT
    if (lo <= NPH - 1 && NPH - 1 < hi) ph_dump(a, wave0);
#else
    if (PHON(101) && IN(NPH - 1)) ph_norm(a, wave0, DEPTH - 1, 3);
#endif
#undef IN
#undef SEAM
}

#endif
#if MK_SPLIT
struct ArgsS { Args base; int kind, l, sub, M; };
typedef const __attribute__((address_space(4))) ArgsS* KArgsS;
template <int KIND>
__global__ void __launch_bounds__(NTHR, 2) phase_kernel(ArgsS args_byval) {
    KArgsS as = (KArgsS)__builtin_amdgcn_kernarg_segment_ptr();
    KArgs a = (KArgs)as;
    const int tid = threadIdx.x; const int wave0 = __builtin_amdgcn_readfirstlane(tid >> 6);
    const int l = as->l, sub = as->sub, M = as->M;
    const int G = gridDim.x; const int vcu = (G % 8 == 0) ? ((int)blockIdx.x % 8) * (G / 8) + (int)blockIdx.x / 8 : (int)blockIdx.x;
    if constexpr (KIND == 0) ph_prologue(a, wave0);
    if constexpr (KIND == 1) ph_norm(a, wave0, l, sub);
    if constexpr (KIND == 2) ph_gemm_swiglu(a, wave0, M);
    if constexpr (KIND == 3) ph_gemm_store(a, wave0, sub, M);
    if constexpr (KIND == 4) ph_mla_prep(a, wave0, l, vcu, G);
    if constexpr (KIND == 5) { if (vcu < 64) ph_rwkv(a, wave0, l, vcu); }
    if constexpr (KIND == 6) { if (vcu >= 64 && vcu < 96) ph_mlstm(a, wave0, l, vcu - 64); }
    if constexpr (KIND == 7) { if (vcu >= 96 && vcu < 128) ph_s5(a, wave0, l, vcu - 96); }
    if constexpr (KIND == 8) { if (vcu >= 128) ph_attn(a, wave0, vcu - 128, G - 128); }
    if constexpr (KIND == 9) ph_fin(a, wave0, l, M);
}
template <int KIND> static void launch_phase(int grid, hipStream_t stream, const Args& base, int l, int sub, int M) {
    static bool attr = false;
    if (!attr) { (void)hipFuncSetAttribute((const void*)phase_kernel<KIND>, hipFuncAttributeMaxDynamicSharedMemorySize, LDS_BYTES); attr = true; }
    ArgsS s{}; s.base = base; s.kind = KIND; s.l = l; s.sub = sub; s.M = M;
    hipLaunchKernelGGL(phase_kernel<KIND>, dim3(grid), dim3(NTHR), LDS_BYTES, stream, s);
}
static void launch_split(int grid, hipStream_t stream, const Args& a) {
    launch_phase<0>(grid, stream, a, 0, 0, 0);
    for (int l = 0; l < DEPTH; ++l) {
        const int Mtail = (l == DEPTH - 1) ? NLAT : NROWS;
        launch_phase<1>(grid, stream, a, l, 0, 0);
        launch_phase<2>(grid, stream, a, l, 0, NROWS);
        launch_phase<3>(grid, stream, a, l, 0, NROWS);
        launch_phase<1>(grid, stream, a, l, 1, 0);
        launch_phase<3>(grid, stream, a, l, 1, NROWS);
        launch_phase<4>(grid, stream, a, l, 0, 0);
        launch_phase<5>(grid, stream, a, l, 0, 0);
        launch_phase<6>(grid, stream, a, l, 0, 0);
        launch_phase<7>(grid, stream, a, l, 0, 0);
        launch_phase<8>(grid, stream, a, l, 0, 0);
        launch_phase<9>(grid, stream, a, l, 0, Mtail);
        launch_phase<3>(grid, stream, a, l, 2, Mtail);
        launch_phase<1>(grid, stream, a, l, 2, 0);
        launch_phase<2>(grid, stream, a, l, 0, Mtail);
        launch_phase<3>(grid, stream, a, l, 0, Mtail);
    }
    launch_phase<1>(grid, stream, a, DEPTH - 1, 3, 0);
}
#endif
extern "C" void kernel_launch(void* const* d_in, const int* in_sizes, int n_in, void* d_out, int out_size, void* d_ws, size_t ws_size, hipStream_t stream) {
    static int grid = 0;
    if (grid == 0) {
        if (n_in != 43 || out_size != NLAT * D || ws_size < WS_END) { fprintf(stderr, "kernel_launch: unexpected shapes: n_in %d out %d ws %zu (need %zu)\n", n_in, out_size, ws_size, (size_t)WS_END); grid = -1; return; }
        int dev = 0, cus = 0, per_cu = 0;
        if (hipGetDevice(&dev) != hipSuccess || hipDeviceGetAttribute(&cus, hipDeviceAttributeMultiprocessorCount, dev) != hipSuccess) { grid = -1; return; }
        if (false) { grid = -1; return; }
        (void)hipGetLastError();
        grid = cus;
    }
    if (grid < 0) return;
    (void)hipMemsetAsync((char*)d_ws + WS_CTL, 0, CTL_ZERO_BYTES, stream);
    Args a{};
    for (int i = 0; i < 43; ++i) a.in[i] = (const float*)d_in[i];
    a.out = (float*)d_out; a.ws = (unsigned char*)d_ws; a.pad = 0;
#if MK_SPLIT
    launch_split(grid, stream, a);
#else
    static bool attr1 = false; if (!attr1) { (void)hipFuncSetAttribute((const void*)hybrid_fwd, hipFuncAttributeMaxDynamicSharedMemorySize, LDS_BYTES); attr1 = true; }
    a.ph_lo = 0; a.ph_hi = NPH; a.use_bar = 1;
    hipLaunchKernelGGL(hybrid_fwd, dim3(grid), dim3(NTHR), LDS_BYTES, stream, a);
#endif
}
```

```cpp
#include <hip/hip_runtime.h>
#include <cstdio>
#include <cstdint>
#define MK_SPLIT 0
namespace pg8 {
#define PG8_LAS __attribute__((address_space(3)))
typedef unsigned short bf16_t;
typedef short bf16x8 __attribute__((ext_vector_type(8)));
typedef float f32x4 __attribute__((ext_vector_type(4)));
typedef unsigned u32x4 __attribute__((ext_vector_type(4)));
constexpr int BM = 256, BK = 64, HALF = 128, HTB = HALF * BK * 2  , STAGE_BYTES = 8 * HTB, NXCD = 8, WGM = 8;

__host__ __device__ __forceinline__ int lds_byte(int r, int c) { const int st = (r >> 4) * 2 + (c >> 5), rr = r & 15, cc = c & 31, ob = rr * 64 + cc * 2; return st * 1024 + (ob ^ (((ob >> 9) & 1) << 5)); }
__host__ __device__ __forceinline__ void stage_rc(int b, int& R, int& C) { const int st = b / 1024, sb = b % 1024, swz = sb ^ (((sb >> 9) & 1) << 5); R = (st >> 1) * 16 + swz / 64; C = (st & 1) * 32 + (swz % 64) / 2; }
__host__ __device__ __forceinline__ int perm32(int rho) { const int n = rho >> 4, i = rho & 15; return 8 * (i >> 2) + 4 * n + (i & 3); }

struct Unit { int pm, pn; };
struct Gemm { const bf16_t* A; const bf16_t* Bt; int M, N, K; };

struct StaticOrder {
    int nM, nN, nwg, G, c;
    __host__ __device__ void init(int M, int N, int G_, int c_) { nM = M / BM; nN = N / BM; nwg = nM * nN; G = G_; c = c_; }
    __host__ __device__ bool next(int i, Unit& u) const {
        const long L = (long)i * G + c; if (L >= nwg) return false;
        int wgid = (int)L; { const int q = nwg / NXCD, r = nwg % NXCD, xcd = wgid % NXCD, off = wgid / NXCD; wgid = (xcd < r ? xcd * (q + 1) : r * (q + 1) + (xcd - r) * q) + off; }
        const int nig = WGM * nN, gid = wgid / nig, fm = gid * WGM, gsz = (nM - fm) < WGM ? (nM - fm) : WGM;
        u.pm = fm + ((wgid % nig) % gsz); u.pn = (wgid % nig) / gsz; return true;
    }
    __device__ __forceinline__ void a_ready(const Unit&) const {}
    __device__ __forceinline__ void done(const Unit&) const {}
};

typedef __bf16 nbf16v2 __attribute__((ext_vector_type(2))); typedef float nf32v2 __attribute__((ext_vector_type(2)));
__device__ __forceinline__ unsigned cvt_pk_bf16(float lo, float hi) { const nf32v2 v = {lo, hi}; return __builtin_bit_cast(unsigned, __builtin_convertvector(v, nbf16v2)); }
struct EpiSwiGLU {
    static constexpr bool PERM = true, AFTER_DRAIN = false;
    bf16_t* O; int ldc;
    __device__ __forceinline__ void operator()(const f32x4 (&acc)[2][2][4][2], const Unit& u, int wr, int wc, int fr, int fq) const {
        const int row0 = u.pm * BM + wr * 64 + fr; const int col0 = u.pn * HALF + wc * 32 + 8 * fq;
#pragma unroll
        for (int ai = 0; ai < 2; ++ai)
#pragma unroll
            for (int m = 0; m < 4; ++m) { bf16_t* rowp = O + (size_t)(row0 + ai * HALF + m * 16) * ldc + col0;
                float o[8];
#pragma unroll
                for (int n = 0; n < 2; ++n)
#pragma unroll
                    for (int j = 0; j < 4; ++j) { const float g = acc[ai][0][m][n][j], up = acc[ai][1][m][n][j];
                        const float sg = __builtin_amdgcn_rcpf(1.0f + __builtin_amdgcn_exp2f(-1.44269504089f * g)); o[n * 4 + j] = g * sg * up; }
                u32x4 w; w.x = cvt_pk_bf16(o[0], o[1]); w.y = cvt_pk_bf16(o[2], o[3]); w.z = cvt_pk_bf16(o[4], o[5]); w.w = cvt_pk_bf16(o[6], o[7]);
                *(u32x4*)rowp = w; }
    }
};
struct EpiStore {
    static constexpr bool PERM = true, AFTER_DRAIN = false;
    bf16_t* O; int ldc; int ncols;
    __device__ __forceinline__ void operator()(const f32x4 (&acc)[2][2][4][2], const Unit& u, int wr, int wc, int fr, int fq) const {
        const int row0 = u.pm * BM + wr * 64 + fr; const int col0 = u.pn * BM + wc * 32 + 8 * fq;
#pragma unroll
        for (int ai = 0; ai < 2; ++ai)
#pragma unroll
            for (int m = 0; m < 4; ++m) { bf16_t* rowp = O + (size_t)(row0 + ai * HALF + m * 16) * ldc + col0;
#pragma unroll
                for (int bj = 0; bj < 2; ++bj) { if (col0 + bj * HALF < ncols) { const f32x4 v0 = acc[ai][bj][m][0], v1 = acc[ai][bj][m][1];
                    u32x4 w; w.x = cvt_pk_bf16(v0[0], v0[1]); w.y = cvt_pk_bf16(v0[2], v0[3]); w.z = cvt_pk_bf16(v1[0], v1[1]); w.w = cvt_pk_bf16(v1[2], v1[3]);
                    *(u32x4*)(rowp + bj * HALF) = w; } } }
    }
};
template <class Epi, class Sched, bool ALIGN_EPI = false, bool SP2 = false>
__device__ __forceinline__ void gemm_phase(PG8_LAS unsigned char* lds, const Gemm g, const Sched& S, const Epi& E, const int tid) {
    const int wid = __builtin_amdgcn_readfirstlane(tid >> 6), lane = tid & 63, wr = wid >> 2, wc = wid & 3, fr = lane & 15, fq = lane >> 4;
    const int K = g.K, nt = K / BK;
    unsigned voffA[2], voffB[2];
#pragma unroll
    for (int i = 0; i < 2; ++i) { int R, C; stage_rc(tid * 16 + i * 8192, R, C); const int Rb = Epi::PERM ? ((R & ~31) + perm32(R & 31)) : R;
        voffA[i] = (unsigned)(R * K + C) * 2u; voffB[i] = (unsigned)(Rb * K + C) * 2u; }
    const size_t kstep = (size_t)(BK * 2);
    const size_t hstep = (size_t)HALF * K * 2;
    const size_t tstep = 2 * hstep;
    const unsigned ldsw = (unsigned)wid * 1024u;
    const int aoff = lds_byte(wr * 64 + fr, fq * 8), boff = lds_byte(wc * 32 + fr, fq * 8);
#define PG8_SA(b, h) (((b) * 2 + (h)) * HTB)
#define PG8_SB(b, h) ((4 + (b) * 2 + (h)) * HTB)
#define PG8_STAGE(bufoff, gbase, voff) do { _Pragma("unroll") for (int _i = 0; _i < 2; ++_i) \
        __builtin_amdgcn_global_load_lds((const unsigned*)((const char*)(gbase) + (voff)[_i]), (PG8_LAS unsigned*)(lds + (bufoff) + ldsw + _i * 8192), 16, 0, 0); } while (0)
#define PG8_LDA(dst, b, h) do { _Pragma("unroll") for (int m = 0; m < 4; ++m) _Pragma("unroll") for (int k = 0; k < 2; ++k) dst[m][k] = *(const PG8_LAS bf16x8*)(lds + PG8_SA(b, h) + aoff + m * 2048 + k * 1024); } while (0)
#define PG8_LDB(dst, b, h) do { _Pragma("unroll") for (int n = 0; n < 2; ++n) _Pragma("unroll") for (int k = 0; k < 2; ++k) dst[n][k] = *(const PG8_LAS bf16x8*)(lds + PG8_SB(b, h) + boff + n * 2048 + k * 1024); } while (0)
#define PG8_MMA(ai, bj, At, Bt) do { __builtin_amdgcn_s_setprio(1); _Pragma("unroll") for (int m = 0; m < 4; ++m) _Pragma("unroll") for (int n = 0; n < 2; ++n) _Pragma("unroll") for (int k = 0; k < 2; ++k) \
        acc[ai][bj][m][n] = __builtin_amdgcn_mfma_f32_16x16x32_bf16(Bt[n][k], At[m][k], acc[ai][bj][m][n], 0, 0, 0); __builtin_amdgcn_s_setprio(0); } while (0)
#define PG8_WAIT_V(n) asm volatile("s_waitcnt vmcnt(" #n ")" ::: "memory")
#define PG8_WAIT_L(n) asm volatile("s_waitcnt lgkmcnt(" #n ")" ::: "memory")
#define PG8_BAR __builtin_amdgcn_s_barrier()
#define PG8_SCHED __builtin_amdgcn_sched_barrier(0)
    Unit cur, nxt; int ui = 0;
    if (!S.next(0, cur)) return;
    f32x4 acc[2][2][4][2];
#pragma unroll
    for (int a = 0; a < 2; ++a)
#pragma unroll
        for (int b = 0; b < 2; ++b)
#pragma unroll
            for (int m = 0; m < 4; ++m)
#pragma unroll
                for (int n = 0; n < 2; ++n) acc[a][b][m][n] = (f32x4){0.f, 0.f, 0.f, 0.f};
    bf16x8 At[4][2], B0[2][2], B1[2][2];
    const char* cA = (const char*)g.A + (size_t)cur.pm * tstep; const char* cB = (const char*)g.Bt + (size_t)cur.pn * tstep;
    S.a_ready(cur);
    if constexpr (SP2) {
        PG8_STAGE(PG8_SB(0, 0), cB, voffB); PG8_STAGE(PG8_SB(0, 1), cB + hstep, voffB); PG8_STAGE(PG8_SA(0, 0), cA, voffA); PG8_STAGE(PG8_SA(0, 1), cA + hstep, voffA);
        if (wr == 1) PG8_BAR;
        PG8_WAIT_V(2); PG8_BAR;
        PG8_STAGE(PG8_SB(1, 0), cB + kstep, voffB); PG8_STAGE(PG8_SA(1, 0), cA + kstep, voffA); PG8_STAGE(PG8_SB(1, 1), cB + hstep + kstep, voffB);
        PG8_WAIT_V(6); PG8_BAR;
    } else {
        PG8_STAGE(PG8_SB(0, 0), cB, voffB); PG8_STAGE(PG8_SA(0, 0), cA, voffA); PG8_STAGE(PG8_SB(0, 1), cB + hstep, voffB); PG8_STAGE(PG8_SA(0, 1), cA + hstep, voffA);
        if (wr == 1) PG8_BAR;
        PG8_WAIT_V(4); PG8_BAR;
        PG8_STAGE(PG8_SB(1, 0), cB + kstep, voffB); PG8_STAGE(PG8_SA(1, 0), cA + kstep, voffA); PG8_STAGE(PG8_SB(1, 1), cB + hstep + kstep, voffB);
        PG8_WAIT_V(6); PG8_BAR;
    }
    for (;;) {
        const bool has_next = S.next(ui + 1, nxt);
        const char* nA = has_next ? (const char*)g.A + (size_t)nxt.pm * tstep : cA; const char* nB = has_next ? (const char*)g.Bt + (size_t)nxt.pn * tstep : cB;
        for (int t = 0; t < nt; t += 2) {
            const bool last = (t == nt - 2);
            const char* a1 = cA + (size_t)(t + 1) * kstep;
            const char* a2 = last ? nA : cA + (size_t)(t + 2) * kstep; const char* b2 = last ? nB : cB + (size_t)(t + 2) * kstep;
            const char* a3 = a2 + kstep; const char* b3 = b2 + kstep;
            if (last && has_next) S.a_ready(nxt);
            if constexpr (SP2) {
            PG8_LDB(B0, 0, 0); PG8_LDB(B1, 0, 1); PG8_SCHED; PG8_LDA(At, 0, 0); PG8_STAGE(PG8_SA(1, 1), a1 + hstep, voffA);
            PG8_WAIT_V(8); PG8_WAIT_L(0); PG8_BAR; PG8_MMA(0, 0, At, B0); PG8_MMA(0, 1, At, B1); PG8_BAR; PG8_SCHED;
            PG8_LDA(At, 0, 1); PG8_STAGE(PG8_SB(0, 0), b2, voffB); PG8_STAGE(PG8_SB(0, 1), b2 + hstep, voffB); PG8_STAGE(PG8_SA(0, 0), a2, voffA);
            PG8_WAIT_V(8); PG8_WAIT_L(0); PG8_BAR; PG8_MMA(1, 0, At, B0); PG8_MMA(1, 1, At, B1); PG8_BAR; PG8_SCHED;
            PG8_LDB(B0, 1, 0); PG8_LDB(B1, 1, 1); PG8_SCHED; PG8_LDA(At, 1, 0); PG8_STAGE(PG8_SA(0, 1), a2 + hstep, voffA);
            PG8_WAIT_V(8); PG8_WAIT_L(0); PG8_BAR; PG8_MMA(0, 0, At, B0); PG8_MMA(0, 1, At, B1); PG8_BAR; PG8_SCHED;
            PG8_LDA(At, 1, 1); PG8_STAGE(PG8_SB(1, 0), b3, voffB); PG8_STAGE(PG8_SB(1, 1), b3 + hstep, voffB); PG8_STAGE(PG8_SA(1, 0), a3, voffA);
            PG8_WAIT_V(8); PG8_WAIT_L(0); PG8_BAR; PG8_MMA(1, 0, At, B0); PG8_MMA(1, 1, At, B1); PG8_BAR; PG8_SCHED;
            } else {
            PG8_LDB(B0, 0, 0); PG8_SCHED; PG8_LDA(At, 0, 0); PG8_STAGE(PG8_SA(1, 1), a1 + hstep, voffA);
            PG8_WAIT_L(8); PG8_BAR; PG8_WAIT_L(0); PG8_MMA(0, 0, At, B0); PG8_BAR; PG8_SCHED;
            PG8_LDB(B1, 0, 1); PG8_STAGE(PG8_SB(0, 0), b2, voffB);
            PG8_BAR; PG8_WAIT_L(0); PG8_MMA(0, 1, At, B1); PG8_BAR;
            PG8_LDA(At, 0, 1); PG8_STAGE(PG8_SA(0, 0), a2, voffA);
            PG8_BAR; PG8_WAIT_L(0); PG8_MMA(1, 0, At, B0); PG8_BAR; PG8_SCHED;
            PG8_STAGE(PG8_SB(0, 1), b2 + hstep, voffB);
            PG8_WAIT_V(6); PG8_BAR; PG8_MMA(1, 1, At, B1); PG8_BAR;
            PG8_LDB(B0, 1, 0); PG8_SCHED; PG8_LDA(At, 1, 0); PG8_STAGE(PG8_SA(0, 1), a2 + hstep, voffA);
            PG8_WAIT_L(8); PG8_BAR; PG8_WAIT_L(0); PG8_MMA(0, 0, At, B0); PG8_BAR; PG8_SCHED;
            PG8_LDB(B1, 1, 1); PG8_STAGE(PG8_SB(1, 0), b3, voffB);
            PG8_BAR; PG8_WAIT_L(0); PG8_MMA(0, 1, At, B1); PG8_BAR;
            PG8_LDA(At, 1, 1); PG8_STAGE(PG8_SA(1, 0), a3, voffA);
            PG8_BAR; PG8_WAIT_L(0); PG8_MMA(1, 0, At, B0); PG8_BAR; PG8_SCHED;
            PG8_STAGE(PG8_SB(1, 1), b3 + hstep, voffB);
            PG8_WAIT_V(6); PG8_BAR; PG8_MMA(1, 1, At, B1); PG8_BAR;
            }
        }
        if constexpr (ALIGN_EPI) { if (wr == 0) PG8_BAR; }
        if constexpr (!Epi::AFTER_DRAIN) { E(acc, cur, wr, wc, fr, fq); S.done(cur); }
        if (!has_next) break;
#pragma unroll
        for (int a = 0; a < 2; ++a)
#pragma unroll
            for (int b = 0; b < 2; ++b)
#pragma unroll
                for (int m = 0; m < 4; ++m)
#pragma unroll
                    for (int n = 0; n < 2; ++n) acc[a][b][m][n] = (f32x4){0.f, 0.f, 0.f, 0.f};
        cur = nxt; cA = nA; cB = nB; ++ui;
        if constexpr (ALIGN_EPI) { if (wr == 1) PG8_BAR; }
    }
    PG8_WAIT_V(0);
    if constexpr (!ALIGN_EPI) { if (wr == 0) PG8_BAR; }
    PG8_BAR;
    if constexpr (Epi::AFTER_DRAIN) { E.fused(acc, cur, wr, wc, fr, fq, lds, wid, lane); S.done(cur); }
#undef PG8_SA
#undef PG8_SB
#undef PG8_STAGE
#undef PG8_LDA
#undef PG8_LDB
#undef PG8_MMA
#undef PG8_WAIT_V
#undef PG8_WAIT_L
#undef PG8_BAR
#undef PG8_SCHED
}
}
#ifndef PG8_SP2
#define PG8_SP2 true
#endif
#ifndef PG8_ALIGN
#define PG8_ALIGN true
#endif

constexpr int NWAVES = 8, NTHR = 512;
constexpr int D = 1024, NB = 8, T = 4096, TC = 256, DEPTH = 4, FF = 2816, ZP = 2608, ZPAD = 2816;
constexpr int NLAT = NB * T, NCTX = NB * TC, NROWS = NLAT + NCTX;
constexpr int MODW = 9 * D;
constexpr int NKEY = TC + T;
constexpr float NORM_EPS = 1e-6f;
constexpr int ZS5 = 0, ZCQ = 256, ZCKV = 512, ZKR = 640, ZRKV = 672, ZWD = 1440, ZAD = 1472, ZGD = 1504, ZMQK = 1568, ZMV = 2080, ZMO = 2336, ZMG = 2592;

constexpr size_t MiB = 1u << 20;
constexpr size_t WS_CTL = 0, CTL_ZERO_BYTES = 1 * MiB;
constexpr size_t WS_MODV = 1 * MiB;
constexpr size_t WS_ROPE = 3 * MiB;
constexpr size_t WS_SMALLW = 4 * MiB;
constexpr size_t SW_UQ = 0, SW_UKV = 196608, SW_GLU = 327680, SW_GUP = 458752;
constexpr size_t WS_WGU = 6 * MiB, WS_WDN = 17 * MiB, WS_WIN = 23 * MiB, WS_WOUT = 29 * MiB;
constexpr size_t WS_X = 31 * MiB;
constexpr size_t WS_Y = 167 * MiB;
constexpr size_t WS_Q = WS_Y, WS_K = WS_Y + (size_t)NROWS * 384 * 2, WS_VT = WS_K + (size_t)NROWS * 384 * 2;
constexpr size_t WS_H = 235 * MiB;
constexpr size_t WS_ACT = 303 * MiB;
constexpr size_t WS_YS5 = 490 * MiB, WS_YR = 524 * MiB, WS_YM = 558 * MiB, WS_END = 592 * MiB;
static_assert(WS_VT + (size_t)NB * 4 * 64 * NKEY * 2 <= WS_H, "qkv overlay");
static_assert(WS_WGU + (size_t)5632 * 1024 * 2 <= WS_WDN && WS_WDN + (size_t)1024 * 2816 * 2 <= WS_WIN && WS_WIN + (size_t)2816 * 1024 * 2 <= WS_WOUT && WS_WOUT + 2 * MiB <= WS_X, "weights");
static_assert(WS_X + (size_t)NROWS * D * 4 <= WS_Y && WS_Y + (size_t)NROWS * D * 2 <= WS_H && WS_H + (size_t)NROWS * D * 2 <= WS_ACT && WS_ACT + (size_t)NROWS * ZPAD * 2 <= WS_YS5, "map");
static_assert(WS_YS5 + (size_t)2 * NROWS * 256 * 2 <= WS_YR && WS_YM + (size_t)2 * NROWS * 256 * 2 <= WS_END, "map2");
constexpr int CW_BAR = 4096, CW_SUB = 8192;

constexpr int RING_BYTES = 131072, LDS_BYTES = 147456, LDSCTL_OFF = LDS_BYTES - 512, MISC_OFF = LDSCTL_OFF + 320;

#define GAS __attribute__((address_space(1)))
#define LAS __attribute__((address_space(3)))
typedef unsigned short bf16;
typedef unsigned char uchar;
typedef unsigned v4u __attribute__((ext_vector_type(4)));
typedef unsigned v2u __attribute__((ext_vector_type(2)));
typedef float f32x4 __attribute__((ext_vector_type(4)));
typedef float f32x2 __attribute__((ext_vector_type(2)));
typedef float f32x16 __attribute__((ext_vector_type(16)));
typedef short bf16x8 __attribute__((ext_vector_type(8)));
typedef short bf16x4 __attribute__((ext_vector_type(4)));
#define DI __device__ __forceinline__
DI unsigned f2bf(float f) { unsigned u = __builtin_bit_cast(unsigned, f); return (u + 0x7fffu + ((u >> 16) & 1u)) >> 16; }
DI unsigned pk2(float lo, float hi) { return pg8::cvt_pk_bf16(lo, hi); }
DI float bf2f(unsigned b) { return __builtin_bit_cast(float, b << 16); }
DI float bflo(unsigned w) { return __builtin_bit_cast(float, w << 16); }
DI float bfhi(unsigned w) { return __builtin_bit_cast(float, w & 0xffff0000u); }
template <int CTRL> DI float dpp_f(float x) { return __builtin_bit_cast(float, __builtin_amdgcn_update_dpp(0, __builtin_bit_cast(int, x), CTRL, 0xf, 0xf, true)); }
DI float sum8(float x) { x += dpp_f<0xB1>(x); x += dpp_f<0x4E>(x); x += dpp_f<0x141>(x); return x; }
DI float sum16(float x) { x = sum8(x); x += dpp_f<0x140>(x); return x; }
template <int CTRL, int RM> DI float dpp_z(float x) { return __builtin_bit_cast(float, __builtin_amdgcn_update_dpp(0, __builtin_bit_cast(int, x), CTRL, RM, 0xf, true)); }
template <int CTRL, int RM> DI float dpp_o(float old, float x) { return __builtin_bit_cast(float, __builtin_amdgcn_update_dpp(__builtin_bit_cast(int, old), __builtin_bit_cast(int, x), CTRL, RM, 0xf, false)); }
DI float wave_scan_sum(float x) {
    x += dpp_z<0x111, 0xf>(x); x += dpp_z<0x112, 0xf>(x); x += dpp_z<0x114, 0xf>(x); x += dpp_z<0x118, 0xf>(x);
    x += dpp_z<0x142, 0xa>(x); x += dpp_z<0x143, 0xc>(x); return x;
}
DI float wave_scan_max(float x) {
    const float ninf = -3.0e38f;
    x = fmaxf(x, dpp_o<0x111, 0xf>(ninf, x)); x = fmaxf(x, dpp_o<0x112, 0xf>(ninf, x)); x = fmaxf(x, dpp_o<0x114, 0xf>(ninf, x)); x = fmaxf(x, dpp_o<0x118, 0xf>(ninf, x));
    x = fmaxf(x, dpp_o<0x142, 0xa>(ninf, x)); x = fmaxf(x, dpp_o<0x143, 0xc>(ninf, x)); return x;
}
DI float wave_sum(float v) { v = sum16(v); v += __shfl_xor(v, 16); v += __shfl_xor(v, 32); return v; }
DI float wave_max(float v) {
#pragma unroll
    for (int o = 1; o < 64; o <<= 1) v = fmaxf(v, __shfl_xor(v, o));
    return v;
}
DI void lds_barrier() { asm volatile("s_waitcnt lgkmcnt(0)" ::: "memory"); __builtin_amdgcn_s_barrier(); asm volatile("" ::: "memory"); }
DI float fexp(float x) { return __builtin_amdgcn_exp2f(x * 1.44269504089f); }
DI float fsigmoid(float x) { return __builtin_amdgcn_rcpf(1.0f + fexp(-x)); }
DI f32x16 mfma32(bf16x8 a, bf16x8 b, f32x16 c) { return __builtin_amdgcn_mfma_f32_32x32x16_bf16(a, b, c, 0, 0, 0); }
DI f32x4 mfma16(bf16x8 a, bf16x8 b, f32x4 c) { return __builtin_amdgcn_mfma_f32_16x16x32_bf16(a, b, c, 0, 0, 0); }
DI int crow(int r, int h) { return (r & 3) + 8 * (r >> 2) + 4 * h; }
DI bf16x8 pack8(float a0, float a1, float a2, float a3, float a4, float a5, float a6, float a7) {
    typedef __bf16 nb8 __attribute__((ext_vector_type(8))); typedef float nf8 __attribute__((ext_vector_type(8)));
    const nf8 v = {a0, a1, a2, a3, a4, a5, a6, a7}; return __builtin_bit_cast(bf16x8, __builtin_convertvector(v, nb8));
}
DI void my_sincosf(float x, float& s, float& c) {
    const float k = __builtin_rintf(x * 0.63661977236758134f);
    float r = __builtin_fmaf(-k, 1.5703125f, x); r = __builtin_fmaf(-k, 4.837512969970703125e-4f, r); r = __builtin_fmaf(-k, 7.54978995489188216e-8f, r);
    const float r2 = r * r;
    const float ps = r + r * r2 * (-1.6666654611e-1f + r2 * (8.3321608736e-3f + r2 * (-1.9515295891e-4f)));
    const float pc = 1.0f - 0.5f * r2 + r2 * r2 * (4.166664568298827e-2f + r2 * (-1.388731625493765e-3f + r2 * 2.443315711809948e-5f));
    const int q = ((int)k) & 3;
    const float ss = (q & 1) ? pc : ps, cc = (q & 1) ? ps : pc;
    s = (q & 2) ? -ss : ss; c = ((q + 1) & 2) ? -cc : cc;
}

#define XB_TMO      128
#define XB_XCNT(j)  (256  + 64 * (j))
#define XB_XSUB(j)  (1280 + 64 * (j))
#define XB_XGEN(j)  (2304 + 64 * (j))
#define XB_TOP      3328
#define XB_TOPGEN   3392
#define XCD_BAR_WORDS 3456
#define XB_SPIN_CAP (1u << 22)
DI unsigned xb_ld(unsigned* p)              { return __hip_atomic_load(p, __ATOMIC_RELAXED, __HIP_MEMORY_SCOPE_AGENT); }
DI unsigned xb_add(unsigned* p, unsigned v) { return __hip_atomic_fetch_add(p, v, __ATOMIC_RELAXED, __HIP_MEMORY_SCOPE_AGENT); }
DI unsigned xb_xcc_id() { return (unsigned)__builtin_amdgcn_s_getreg((3 << 11) | 20) & 0xFu; }
#define XB_SPIN(cond, bar) do { unsigned _sp = 0; while (cond) { __builtin_amdgcn_s_sleep(1); \
    if ((++_sp & 255u) == 0u) { if (xb_ld(&(bar)[XB_TMO])) break; if (_sp > XB_SPIN_CAP) { atomicAdd(&(bar)[XB_TMO], 1u); break; } } } } while (0)
struct XcdBarrier { unsigned* bar; unsigned x; volatile LAS unsigned* st; };
DI XcdBarrier xcd_barrier_post(unsigned* bar, volatile LAS unsigned* st, bool t0) {
    XcdBarrier b; b.bar = bar; b.x = xb_xcc_id(); b.st = st;
    if (t0) (void)xb_add(&bar[XB_XCNT(b.x)], 1u);
    return b;
}
DI void xcd_barrier_complete(unsigned* bar, unsigned x, unsigned& nloc, unsigned& nx) {
    const unsigned G = gridDim.x * gridDim.y * gridDim.z;
    unsigned sum, cnt, mine, sp = 0u;
    for (;;) {
        sum = 0u; cnt = 0u; mine = 0u;
#pragma unroll
        for (unsigned j = 0; j < 16; ++j) { const unsigned c = xb_ld(&bar[XB_XCNT(j)]); sum += c; cnt += (c > 0u) ? 1u : 0u; mine = (j == x) ? c : mine; }
        if (sum == G) break;
        __builtin_amdgcn_s_sleep(1);
        if ((++sp & 255u) == 0u) { if (xb_ld(&bar[XB_TMO])) break; if (sp > XB_SPIN_CAP) { atomicAdd(&bar[XB_TMO], 1u); break; } }
    }
    nloc = mine > 0u ? mine : 1u; nx = cnt > 0u ? cnt : 1u;
}
DI void xcd_barrier(const XcdBarrier& b, bool t0) {
    asm volatile("s_waitcnt vmcnt(0)" ::: "memory");
    __syncthreads();
    if (t0) {
        unsigned* bar = b.bar;
        __builtin_amdgcn_s_waitcnt(0);
        unsigned nloc = b.st[0], nx = b.st[1];
        if (nloc == 0u) { xcd_barrier_complete(bar, b.x, nloc, nx); b.st[0] = nloc; b.st[1] = nx; }
        const unsigned old = xb_add(&bar[XB_XSUB(b.x)], 1u);
        const unsigned gen = old / nloc;
        if (old + 1u == (gen + 1u) * nloc) {
            __builtin_amdgcn_fence(__ATOMIC_RELEASE, "agent");
            asm volatile("s_waitcnt vmcnt(0)" ::: "memory");
            const unsigned og = xb_add(&bar[XB_TOP], 1u);
            const unsigned tg = og / nx;
            if (og + 1u == (tg + 1u) * nx) xb_add(&bar[XB_TOPGEN], 1u);
            else XB_SPIN(xb_ld(&bar[XB_TOPGEN]) == tg, bar);
            __builtin_amdgcn_fence(__ATOMIC_ACQUIRE, "agent");
            xb_add(&bar[XB_XGEN(b.x)], 1u);
            asm volatile("s_waitcnt vmcnt(0)" ::: "memory");
        } else {
            XB_SPIN(xb_ld(&bar[XB_XGEN(b.x)]) == gen, bar);
            __builtin_amdgcn_fence(__ATOMIC_ACQUIRE, "agent");
            asm volatile("s_waitcnt vmcnt(0)" ::: "memory");
        }
    }
    __syncthreads();
}

struct Args { const float* in[43]; float* out; unsigned char* ws; int ph_lo, ph_hi, use_bar, pad; };
typedef const __attribute__((address_space(4))) Args* KArgs;
enum { I_X = 0, I_C, I_CTX, I_CCTX, I_WADA, I_BADA, I_NPRE, I_NPOST, I_WG, I_WU, I_WD, I_WIN, I_WOUT, I_S5LRE, I_S5LIM, I_S5DT, I_S5BRE, I_S5BIM, I_S5CRE, I_S5CIM, I_S5D, I_S5GLU, I_S5BGLU,
       I_MQN, I_MKVN, I_MUQ, I_MUKV, I_RCW, I_RCB, I_RW0, I_RWUP, I_RA0, I_RAUP, I_RGUP, I_RKK, I_RKA, I_RRK, I_RLNW, I_RLNB, I_MCW, I_MCB, I_MGB, I_MNORM };

struct Ctx {
    LAS uchar* lds; int tid, lane, wave, vcu, G;
};
DI int tok_row(int b, int seg, int t) { return seg ? b * T + t : NLAT + b * TC + t; }
DI void phase_prologue(KArgs a, const Ctx& F) {
    LAS float* sc = (LAS float*)F.lds;
    LAS float* red = (LAS float*)(F.lds + 40960);
    const float* c = a->in[I_C]; const float* cc = a->in[I_CCTX];
    for (int i = F.tid; i < 9 * D; i += NTHR) { const float v = (i < 8 * D) ? c[i] : cc[i - 8 * D]; sc[i] = v * fsigmoid(v); }
    __syncthreads();
    const float* wada = a->in[I_WADA]; const float* bada = a->in[I_BADA];
    float* modv = (float*)(a->ws + WS_MODV);
    for (int task = F.vcu; task < DEPTH * 144; task += F.G) {
        const int l = task / 144, nb = task % 144, n = nb * 64 + F.lane;
        const float* wp = wada + ((size_t)l * D + F.wave * 128) * MODW + n;
        float acc[9];
#pragma unroll
        for (int m = 0; m < 9; ++m) acc[m] = 0.f;
#pragma unroll 8
        for (int k = 0; k < 128; ++k) { const float w = wp[(size_t)k * MODW];
#pragma unroll
            for (int m = 0; m < 9; ++m) acc[m] += sc[m * D + F.wave * 128 + k] * w; }
#pragma unroll
        for (int m = 0; m < 9; ++m) red[(F.wave * 9 + m) * 64 + F.lane] = acc[m];
        __syncthreads();
        for (int i = F.tid; i < 576; i += NTHR) { const int m = i >> 6, ln = i & 63; float s = 0.f;
#pragma unroll
            for (int w = 0; w < 8; ++w) s += red[(w * 9 + m) * 64 + ln];
            modv[((size_t)l * 9 + m) * MODW + nb * 64 + ln] = s + bada[l * MODW + nb * 64 + ln]; }
        __syncthreads();
    }
    float* rc = (float*)(a->ws + WS_ROPE); float* rs = rc + T * 16;
    for (int i = F.vcu * NTHR + F.tid; i < T * 16; i += F.G * NTHR) {
        const int t = i >> 4, f = i & 15, pos = f < 8 ? (t >> 6) : (t & 63), fi = f & 7;
        const float invf = (fi == 0) ? 1.0f : (fi == 1) ? 0.31622776601683794f : (fi == 2) ? 0.1f : (fi == 3) ? 0.031622776601683794f : (fi == 4) ? 0.01f : (fi == 5) ? 0.0031622776601683794f : (fi == 6) ? 0.001f : 0.00031622776601683794f;
        const float ang = (float)pos * invf; float s, co; my_sincosf(ang, s, co);
        rc[i] = co; rs[i] = s;
    }
}

DI void tr_item(const float* W, int K, int N, bf16* WT, int kb, int n0, int drow0, LAS float* scr, int lane) {
    const int k0 = 64 * kb, nn = n0 + (lane & 31);
#pragma unroll 8
    for (int i = 0; i < 32; ++i) { const int kk = 2 * i + (lane >> 5); scr[kk * 33 + (lane & 31)] = (nn < N) ? W[(size_t)(k0 + kk) * N + nn] : 0.f; }
    const int c = lane & 7;
#pragma unroll
    for (int j = 0; j < 4; ++j) { const int n = (lane >> 3) + 8 * j; const LAS float* s = scr + (8 * c) * 33 + n;
        v4u o; o.x = pk2(s[0 * 33], s[1 * 33]); o.y = pk2(s[2 * 33], s[3 * 33]); o.z = pk2(s[4 * 33], s[5 * 33]); o.w = pk2(s[6 * 33], s[7 * 33]);
        if (n0 + n < N) *(v4u*)(WT + (size_t)(drow0 + n) * K + k0 + 8 * c) = o; }
}
DI void convert_weights(KArgs a, const Ctx& F, int l, int set) {
    LAS float* scr = (LAS float*)(F.lds + F.wave * 8704);
    const int gw = F.vcu * NWAVES + F.wave, NGW = F.G * NWAVES;
    bf16* WGU = (bf16*)(a->ws + WS_WGU); bf16* WDN = (bf16*)(a->ws + WS_WDN); bf16* WIN = (bf16*)(a->ws + WS_WIN); bf16* WOUT = (bf16*)(a->ws + WS_WOUT);
    bf16* SW = (bf16*)(a->ws + WS_SMALLW);
    const int fl = l * 2 + set;
    const float* wg = a->in[I_WG] + (size_t)fl * D * FF; const float* wu = a->in[I_WU] + (size_t)fl * D * FF; const float* wd = a->in[I_WD] + (size_t)fl * FF * D;
    constexpr int I_G = 16 * 88, I_D = 44 * 32, I_IN = 16 * 82, I_O = 16 * 32, I_UQ = 4 * 12, I_UKV = 2 * 16, I_GLU = 4 * 8, I_GUP = 1 * 8;
    const int nitems = set == 0 ? (2 * I_G + I_D + I_IN + I_O + I_UQ + I_UKV + I_GLU + I_GUP) : (2 * I_G + I_D);
    for (int it = gw; it < nitems; it += NGW) {
        int r = it;
        if (r < I_G) { const int kb = r / 88, nb = r % 88, n0 = 32 * nb; tr_item(wg, D, FF, WGU, kb, n0, 256 * (n0 >> 7) + (n0 & 127), scr, F.lane); continue; } r -= I_G;
        if (r < I_G) { const int kb = r / 88, nb = r % 88, n0 = 32 * nb; tr_item(wu, D, FF, WGU, kb, n0, 256 * (n0 >> 7) + 128 + (n0 & 127), scr, F.lane); continue; } r -= I_G;
        if (r < I_D) { const int kb = r / 32, nb = r % 32; tr_item(wd, FF, D, WDN, kb, 32 * nb, 32 * nb, scr, F.lane); continue; } r -= I_D;
        if (r < I_IN) { const int kb = r / 82, nb = r % 82; tr_item(a->in[I_WIN] + (size_t)l * D * ZP, D, ZP, WIN, kb, 32 * nb, 32 * nb, scr, F.lane); continue; } r -= I_IN;
        if (r < I_O) { const int kb = r / 32, nb = r % 32; tr_item(a->in[I_WOUT] + (size_t)l * D * D, D, D, WOUT, kb, 32 * nb, 32 * nb, scr, F.lane); continue; } r -= I_O;
        if (r < I_UQ) { const int kb = r / 12, nb = r % 12; tr_item(a->in[I_MUQ] + (size_t)l * 256 * 384, 256, 384, (bf16*)((uchar*)SW + SW_UQ), kb, 32 * nb, 32 * nb, scr, F.lane); continue; } r -= I_UQ;
        if (r < I_UKV) { const int kb = r / 16, nb = r % 16; tr_item(a->in[I_MUKV] + (size_t)l * 128 * 512, 128, 512, (bf16*)((uchar*)SW + SW_UKV), kb, 32 * nb, 32 * nb, scr, F.lane); continue; } r -= I_UKV;
        if (r < I_GLU) { const int kb = r / 8, nb = r % 8; tr_item(a->in[I_S5GLU] + (size_t)l * 256 * 256, 256, 256, (bf16*)((uchar*)SW + SW_GLU), kb, 32 * nb, 32 * nb, scr, F.lane); continue; } r -= I_GLU;
        { const int nb = r; tr_item(a->in[I_RGUP] + (size_t)l * 64 * 256, 64, 256, (bf16*)((uchar*)SW + SW_GUP), 0, 32 * nb, 32 * nb, scr, F.lane); }
    }
    if (set == 0) {
        unsigned zz_ = 0u; asm volatile("" : "+v"(zz_)); v4u z = {zz_, zz_, zz_, zz_}; v4u* p = (v4u*)(WIN + (size_t)ZP * D);
        for (int i = F.vcu * NTHR + F.tid; i < (ZPAD - ZP) * D / 8; i += F.G * NTHR) p[i] = z;
    }
}

DI void norm_rows(KArgs a, const Ctx& F, bool p_first, bool p_hasY, bool p_hasH, bool p_final, int p_nrows, const float* p_modY, int p_gi, const float* p_pw, float p_coef, const float* p_modH, int p_si, const float* p_prew, bool p_dummy = false) {
    bf16* X = (bf16*)(a->ws + WS_X); const bf16* Y = (const bf16*)(a->ws + WS_Y); bf16* H = (bf16*)(a->ws + (p_dummy ? WS_YS5 : WS_H));
    bf16* Xo = p_dummy ? (bf16*)(a->ws + WS_ACT) : X;
    const int gw = F.vcu * NWAVES + F.wave, NGW = F.G * NWAVES, lane = F.lane;
    const int rpw = (p_nrows + NGW - 1) / NGW, r0 = gw * rpw, r1 = (r0 + rpw < p_nrows) ? (r0 + rpw) : p_nrows;
    if (r0 >= r1) return;
    f32x4 cA[4], cB[4], cC[4];
    int cur_mr = -1;
    f32x4 vn[2][4]; v2u xn[2][4], yn[2][4];
    auto issue = [&](int r) {
#pragma unroll
        for (int k = 0; k < 2; ++k) if (r + k < r1) {
            if (p_first) {
                const float* xs = r + k < NLAT ? a->in[I_X] + (size_t)(r + k) * D : a->in[I_CTX] + (size_t)(r + k - NLAT) * D;
#pragma unroll
                for (int j = 0; j < 4; ++j) vn[k][j] = *(const f32x4*)(xs + 4 * lane + 256 * j);
            } else {
#pragma unroll
                for (int j = 0; j < 4; ++j) xn[k][j] = *(const v2u*)(X + (size_t)(r + k) * D + 4 * lane + 256 * j);
            }
            if (p_hasY) {
#pragma unroll
                for (int j = 0; j < 4; ++j) yn[k][j] = *(const v2u*)(Y + (size_t)(r + k) * D + 4 * lane + 256 * j);
            }
        }
    };
    issue(r0);
    for (int r = r0; r < r1; r += 2) {
        f32x4 v[2][4]; v2u yw[2][4];
#pragma unroll
        for (int k = 0; k < 2; ++k)
#pragma unroll
            for (int j = 0; j < 4; ++j) { v[k][j] = p_first ? vn[k][j] : (f32x4){bflo(xn[k][j].x), bfhi(xn[k][j].x), bflo(xn[k][j].y), bfhi(xn[k][j].y)}; yw[k][j] = yn[k][j]; }
        if (r + 2 < r1) issue(r + 2);
#pragma unroll
        for (int k = 0; k < 2; ++k) if (r + k < r1) {
            const int rr = r + k;
            const int mr = rr < NLAT ? (rr >> 12) : 8;
            if (mr != cur_mr) { cur_mr = mr;
                const float* g = p_modY + (size_t)mr * MODW + p_gi * D; const float* sh = p_modH + (size_t)mr * MODW + p_si * D; const float* scp = sh + D;
#pragma unroll
                for (int j = 0; j < 4; ++j) { const int o = 4 * lane + 256 * j;
                    cA[j] = p_hasY ? (*(const f32x4*)(g + o) * p_coef) * *(const f32x4*)(p_pw + o) : (f32x4){0.f, 0.f, 0.f, 0.f};
                    if (p_hasH) { cB[j] = *(const f32x4*)(p_prew + o) * (*(const f32x4*)(scp + o) + 1.0f); cC[j] = *(const f32x4*)(sh + o); } else { cB[j] = cA[j]; cC[j] = cA[j]; } } }
            if (p_hasY) {
                f32x4 y[4]; float ss = 0.f;
#pragma unroll
                for (int j = 0; j < 4; ++j) { y[j] = (f32x4){bflo(yw[k][j].x), bfhi(yw[k][j].x), bflo(yw[k][j].y), bfhi(yw[k][j].y)};
                    ss += (y[j].x * y[j].x + y[j].y * y[j].y) + (y[j].z * y[j].z + y[j].w * y[j].w); }
                const float rstd = __builtin_amdgcn_rsqf(wave_sum(ss) * (1.0f / D) + NORM_EPS);
#pragma unroll
                for (int j = 0; j < 4; ++j) v[k][j] = v[k][j] + cA[j] * (y[j] * rstd);
            }
            if (p_final) {
#pragma unroll
                for (int j = 0; j < 4; ++j) *(f32x4*)(a->out + (size_t)rr * D + 4 * lane + 256 * j) = v[k][j];
            } else if (p_hasY || p_first) {
#pragma unroll
                for (int j = 0; j < 4; ++j) { v2u o; o.x = pk2(v[k][j].x, v[k][j].y); o.y = pk2(v[k][j].z, v[k][j].w); *(v2u*)(Xo + (size_t)rr * D + 4 * lane + 256 * j) = o; }
            }
            if (p_hasH) {
                float ss = 0.f;
#pragma unroll
                for (int j = 0; j < 4; ++j) ss += (v[k][j].x * v[k][j].x + v[k][j].y * v[k][j].y) + (v[k][j].z * v[k][j].z + v[k][j].w * v[k][j].w);
                const float rstd = __builtin_amdgcn_rsqf(wave_sum(ss) * (1.0f / D) + NORM_EPS);
#pragma unroll
                for (int j = 0; j < 4; ++j) { const f32x4 h = (v[k][j] * rstd) * cB[j] + cC[j];
                    v2u o; o.x = pk2(h.x, h.y); o.y = pk2(h.z, h.w); *(v2u*)(H + (size_t)rr * D + 4 * lane + 256 * j) = o; }
            }
        }
    }
}
template <int K, int NBK, int MBK, bool TRANS, bool ZERO = true>
DI void small_gemm(const LAS bf16* A, int apitch, const bf16* Wt, int n0w, f32x4 (&acc)[NBK][MBK], int lane, int wpitch = K) {
    const int lr = lane & 15, kq = lane >> 4;
    if (ZERO) {
#pragma unroll
        for (int nb = 0; nb < NBK; ++nb)
#pragma unroll
            for (int mb = 0; mb < MBK; ++mb) acc[nb][mb] = (f32x4){0.f, 0.f, 0.f, 0.f};
    }
#pragma unroll 2
    for (int s = 0; s < K / 32; ++s) {
        bf16x8 av[MBK];
#pragma unroll
        for (int mb = 0; mb < MBK; ++mb) av[mb] = *(const LAS bf16x8*)(A + (16 * mb + lr) * apitch + 32 * s + 8 * kq);
#pragma unroll
        for (int nb = 0; nb < NBK; ++nb) { const bf16x8 w = *(const bf16x8*)(Wt + (size_t)(n0w + 16 * nb + lr) * wpitch + 32 * s + 8 * kq);
#pragma unroll
            for (int mb = 0; mb < MBK; ++mb) acc[nb][mb] = TRANS ? mfma16(w, av[mb], acc[nb][mb]) : mfma16(av[mb], w, acc[nb][mb]); }
    }
}
DI void ctx_gemm_block(const Ctx& F, const bf16* A, const bf16* Wt, int K, bf16* Yo) {
    const int bi = F.vcu; if (bi >= 256) return;
    const int rb = bi >> 3, cb = bi & 7, row0 = NLAT + 64 * rb;
    const int tid = F.tid, lane = F.lane, wave = F.wave;
    LAS bf16* As = (LAS bf16*)F.lds;
    const int nch = K / 256;
    v4u g[4];
    auto gload = [&](int ch) {
#pragma unroll
        for (int j = 0; j < 4; ++j) { const int cidx = tid + 512 * j, r = cidx >> 5, cc = cidx & 31; g[j] = *(const v4u*)(A + (size_t)(row0 + r) * K + ch * 256 + cc * 8); }
    };
    auto lstore = [&](int buf) {
#pragma unroll
        for (int j = 0; j < 4; ++j) { const int cidx = tid + 512 * j, r = cidx >> 5, cc = cidx & 31; *(LAS v4u*)(As + buf * 64 * 264 + r * 264 + cc * 8) = g[j]; }
    };
    f32x4 acc[1][4];
#pragma unroll
    for (int mb = 0; mb < 4; ++mb) acc[0][mb] = (f32x4){0.f, 0.f, 0.f, 0.f};
    const int lr_ = lane & 15, kq_ = lane >> 4;
    const bf16* wrow = Wt + (size_t)(128 * cb + 16 * wave + lr_) * K + 8 * kq_;
    bf16x8 wc[8], wn[8];
#pragma unroll
    for (int s = 0; s < 8; ++s) wc[s] = *(const bf16x8*)(wrow + 32 * s);
    gload(0); lstore(0);
    __syncthreads();
    for (int ch = 0; ch < nch; ++ch) {
        if (ch + 1 < nch) { gload(ch + 1);
#pragma unroll
            for (int s = 0; s < 8; ++s) wn[s] = *(const bf16x8*)(wrow + (ch + 1) * 256 + 32 * s); }
        const LAS bf16* Ab = As + (ch & 1) * 64 * 264;
#pragma unroll
        for (int s = 0; s < 8; ++s) {
#pragma unroll
            for (int mb = 0; mb < 4; ++mb) acc[0][mb] = mfma16(wc[s], *(const LAS bf16x8*)(Ab + (16 * mb + lr_) * 264 + 32 * s + 8 * kq_), acc[0][mb]);
        }
        if (ch + 1 < nch) { lstore((ch + 1) & 1);
#pragma unroll
            for (int s = 0; s < 8; ++s) wc[s] = wn[s]; }
        __syncthreads();
    }
    const int lr = lane & 15, kq = lane >> 4;
#pragma unroll
    for (int mb = 0; mb < 4; ++mb) { const f32x4 v = acc[0][mb]; v2u o; o.x = pk2(v.x, v.y); o.y = pk2(v.z, v.w);
        *(v2u*)(Yo + (size_t)(row0 + 16 * mb + lr) * D + 128 * cb + 16 * wave + 4 * kq) = o; }
}

struct S5C { float ar, ai, fr, fi; };
static __device__ __noinline__ S5C s5_coef(const float* lre, const float* lim, float dt, int nn) {
    const float lr = lre[nn], li = lim[nn], x = lr * dt;
    const float em = x * (1.0f + x * (0.5f + x * (0.16666667f + x * (0.041666668f + x * 0.0083333338f))));
    float sh, ch; my_sincosf(0.5f * li * dt, sh, ch);
    const float cm1 = -2.0f * sh * sh, sn = 2.0f * sh * ch;
    const float arm1 = em * (1.0f + cm1) + cm1;
    S5C o; o.ai = (1.0f + em) * sn; o.ar = 1.0f + arm1;
    const float den = lr * lr + li * li;
    o.fr = (arm1 * lr + o.ai * li) / den; o.fi = (o.ai * lr - arm1 * li) / den;
    return o;
}
DI void s5_scan_task(KArgs a, int l, int b, int dir, int g, LAS bf16* wl  , int lane) {
    const bf16* Z = (const bf16*)(a->ws + WS_ACT); bf16* YS = (bf16*)(a->ws + WS_YS5) + (size_t)dir * NROWS * 256;
    const int pg = (l * 2 + dir) * 16 + g;
    const float* lre = a->in[I_S5LRE] + pg * 64; const float* lim = a->in[I_S5LIM] + pg * 64;
    const float dt = __expf(a->in[I_S5DT][pg]);
    const S5C c0_ = s5_coef(lre, lim, dt, lane); const float ar = c0_.ar, ai = c0_.ai;
    bf16x8 Bf[4];
    { const int hh = lane >> 5;
#pragma unroll
      for (int nblk = 0; nblk < 2; ++nblk) { const int nn = 32 * nblk + (lane & 31); const S5C cn_ = s5_coef(lre, lim, dt, nn); const float fr = cn_.fr, fi = cn_.fi;
        const float* bre = a->in[I_S5BRE] + ((size_t)pg * 64 + nn) * 16 + 8 * hh; const float* bim = a->in[I_S5BIM] + ((size_t)pg * 64 + nn) * 16 + 8 * hh;
        float re[8], im[8];
#pragma unroll
        for (int j = 0; j < 8; ++j) { re[j] = fr * bre[j] - fi * bim[j]; im[j] = fi * bre[j] + fr * bim[j]; }
        Bf[nblk] = pack8(re[0], re[1], re[2], re[3], re[4], re[5], re[6], re[7]); Bf[2 + nblk] = pack8(im[0], im[1], im[2], im[3], im[4], im[5], im[6], im[7]); } }
    bf16x8 Cf[4];
    { const int p = lane & 15, q = lane >> 4;
#pragma unroll
      for (int s = 0; s < 4; ++s) { const int kc = 32 * s + 8 * q; float cv[8];
        const float* src = (s < 2) ? a->in[I_S5CRE] + ((size_t)pg * 16 + p) * 64 + kc : a->in[I_S5CIM] + ((size_t)pg * 16 + p) * 64 + (kc - 64);
        const float sg = (s < 2) ? 1.f : -1.f;
#pragma unroll
        for (int j = 0; j < 8; ++j) cv[j] = sg * src[j];
        Cf[s] = pack8(cv[0], cv[1], cv[2], cv[3], cv[4], cv[5], cv[6], cv[7]); } }
    float sr = 0.f, si = 0.f;
    const int hh = lane >> 5, li5 = lane & 31, q = lane >> 4, t16 = lane & 15;
    const f32x16 zero16 = {0.f, 0.f, 0.f, 0.f, 0.f, 0.f, 0.f, 0.f, 0.f, 0.f, 0.f, 0.f, 0.f, 0.f, 0.f, 0.f};
    const int nchC = TC / 32, nchT = nchC + T / 32;
    auto afload = [&](int gc) -> bf16x8 {
        const int seg = gc >= nchC, ch = seg ? gc - nchC : gc, len = seg ? T : TC;
        const int sidx = 32 * ch + li5, tt = dir ? (len - 1 - sidx) : sidx;
        return *(const bf16x8*)(Z + (size_t)tok_row(b, seg, tt) * ZP + ZS5 + g * 16 + 8 * hh);
    };
    bf16x8 afn = afload(0);
    for (int gc = 0; gc < nchT; ++gc) {
        const int seg = gc >= nchC, ch = seg ? gc - nchC : gc, len = seg ? T : TC;
        {
            const bf16x8 af = afn;
            if (gc + 1 < nchT) afn = afload(gc + 1);
            f32x16 d1 = mfma32(af, Bf[0], zero16), d2 = mfma32(af, Bf[1], zero16), d3 = mfma32(af, Bf[2], zero16), d4 = mfma32(af, Bf[3], zero16);
            float xa[16], xb[16], ya[16], yb[16];
#pragma unroll
            for (int r = 0; r < 16; ++r) {
                auto r1 = __builtin_amdgcn_permlane32_swap(__float_as_uint(d1[r]), __float_as_uint(d2[r]), false, false); xa[r] = __uint_as_float(r1[0]); xb[r] = __uint_as_float(r1[1]);
                auto r2 = __builtin_amdgcn_permlane32_swap(__float_as_uint(d3[r]), __float_as_uint(d4[r]), false, false); ya[r] = __uint_as_float(r2[0]); yb[r] = __uint_as_float(r2[1]); }
#pragma unroll
            for (int i = 0; i < 32; ++i) {
                const int r = 4 * (i >> 3) + (i & 3); const bool hi = (i >> 2) & 1;
                const float xre = hi ? xb[r] : xa[r], xim = hi ? yb[r] : ya[r];
                const float nsr = ar * sr - ai * si + xre, nsi = ar * si + ai * sr + xim; sr = nsr; si = nsi;
                wl[i * 136 + lane] = (bf16)f2bf(sr); wl[i * 136 + 64 + lane] = (bf16)f2bf(si);
            }
#pragma unroll
            for (int tb = 0; tb < 2; ++tb) {
                f32x4 acc = {0.f, 0.f, 0.f, 0.f};
#pragma unroll
                for (int s = 0; s < 4; ++s) { const bf16x8 bfr = *(const LAS bf16x8*)(wl + (16 * tb + t16) * 136 + 32 * s + 8 * q); acc = mfma16(Cf[s], bfr, acc); }
                const int so = 32 * ch + 16 * tb + t16, to = dir ? (len - 1 - so) : so;
                v2u o; o.x = pk2(acc[0], acc[1]); o.y = pk2(acc[2], acc[3]);
                *(v2u*)(YS + (size_t)tok_row(b, seg, to) * 256 + g * 16 + 4 * q) = o;
            }
        }
    }
}

DI void mla_prep_tile(KArgs a, const Ctx& F, int l, int tile) {
    const bf16* Z = (const bf16*)(a->ws + WS_ACT);
    bf16* Q = (bf16*)(a->ws + WS_Q); bf16* Kf = (bf16*)(a->ws + WS_K); bf16* Vt = (bf16*)(a->ws + WS_VT);
    const bf16* WUQ = (const bf16*)(a->ws + WS_SMALLW + SW_UQ); const bf16* WUKV = (const bf16*)(a->ws + WS_SMALLW + SW_UKV);
    const float* rc = (const float*)(a->ws + WS_ROPE); const float* rs = rc + T * 16;
    LAS bf16* Aq = (LAS bf16*)F.lds;
    LAS bf16* Akv = (LAS bf16*)(F.lds + 64 * 264 * 2);
    const int row0 = tile * 64, tid = F.tid, lane = F.lane, wave = F.wave;
    const bool lat = row0 < NLAT;
    {
        const int i = tid >> 3, part = tid & 7, row = row0 + i;
        const bf16* zr = Z + (size_t)row * ZP;
        float q[32], kv[16]; float sq = 0.f, sk = 0.f;
#pragma unroll
        for (int j = 0; j < 4; ++j) { const v4u w = *(const v4u*)(zr + ZCQ + part * 32 + 8 * j);
            q[8 * j + 0] = bflo(w.x); q[8 * j + 1] = bfhi(w.x); q[8 * j + 2] = bflo(w.y); q[8 * j + 3] = bfhi(w.y); q[8 * j + 4] = bflo(w.z); q[8 * j + 5] = bfhi(w.z); q[8 * j + 6] = bflo(w.w); q[8 * j + 7] = bfhi(w.w); }
#pragma unroll
        for (int j = 0; j < 2; ++j) { const v4u w = *(const v4u*)(zr + ZCKV + part * 16 + 8 * j);
            kv[8 * j + 0] = bflo(w.x); kv[8 * j + 1] = bfhi(w.x); kv[8 * j + 2] = bflo(w.y); kv[8 * j + 3] = bfhi(w.y); kv[8 * j + 4] = bflo(w.z); kv[8 * j + 5] = bfhi(w.z); kv[8 * j + 6] = bflo(w.w); kv[8 * j + 7] = bfhi(w.w); }
#pragma unroll
        for (int j = 0; j < 32; ++j) sq += q[j] * q[j];
#pragma unroll
        for (int j = 0; j < 16; ++j) sk += kv[j] * kv[j];
        sq += __shfl_xor(sq, 1); sq += __shfl_xor(sq, 2); sq += __shfl_xor(sq, 4);
        sk += __shfl_xor(sk, 1); sk += __shfl_xor(sk, 2); sk += __shfl_xor(sk, 4);
        const float rq = 1.0f / sqrtf(sq * (1.0f / 256.0f) + NORM_EPS), rk = 1.0f / sqrtf(sk * (1.0f / 128.0f) + NORM_EPS);
        const float* qn = a->in[I_MQN] + l * 256 + part * 32; const float* kn = a->in[I_MKVN] + l * 128 + part * 16;
#pragma unroll
        for (int j = 0; j < 32; j += 2) *(LAS unsigned*)(Aq + i * 264 + part * 32 + j) = pk2(q[j] * rq * qn[j], q[j + 1] * rq * qn[j + 1]);
#pragma unroll
        for (int j = 0; j < 16; j += 2) *(LAS unsigned*)(Akv + i * 136 + part * 16 + j) = pk2(kv[j] * rk * kn[j], kv[j + 1] * rk * kn[j + 1]);
        if (part == 0) {
            float kr[32];
#pragma unroll
            for (int j = 0; j < 4; ++j) { const v4u w = *(const v4u*)(zr + ZKR + 8 * j);
                kr[8 * j + 0] = bflo(w.x); kr[8 * j + 1] = bfhi(w.x); kr[8 * j + 2] = bflo(w.y); kr[8 * j + 3] = bfhi(w.y); kr[8 * j + 4] = bflo(w.z); kr[8 * j + 5] = bfhi(w.z); kr[8 * j + 6] = bflo(w.w); kr[8 * j + 7] = bfhi(w.w); }
            float o[32];
            if (lat) { const int t = row & (T - 1);
#pragma unroll
                for (int hf = 0; hf < 2; ++hf)
#pragma unroll
                    for (int j = 0; j < 8; ++j) { const float c = rc[t * 16 + hf * 8 + j], s = rs[t * 16 + hf * 8 + j]; const float x0 = kr[hf * 16 + j], x1 = kr[hf * 16 + 8 + j];
                        o[hf * 16 + j] = x0 * c - x1 * s; o[hf * 16 + 8 + j] = x1 * c + x0 * s; }
            } else {
#pragma unroll
                for (int j = 0; j < 32; ++j) o[j] = kr[j];
            }
#pragma unroll
            for (int hd = 0; hd < 4; ++hd) { bf16* kp = Kf + (size_t)row * 384 + hd * 96 + 64;
#pragma unroll
                for (int j = 0; j < 4; ++j) { v4u w; w.x = pk2(o[8 * j], o[8 * j + 1]); w.y = pk2(o[8 * j + 2], o[8 * j + 3]); w.z = pk2(o[8 * j + 4], o[8 * j + 5]); w.w = pk2(o[8 * j + 6], o[8 * j + 7]); *(v4u*)(kp + 8 * j) = w; } }
        }
    }
    __syncthreads();
    const int lr = lane & 15, kq = lane >> 4;
    {
        f32x4 acc[3][4];
        small_gemm<256, 3, 4, true>(Aq, 264, WUQ, 48 * wave, acc, lane);
        const float qs = 0.10206207261596577f * 1.44269504089f;
#pragma unroll
        for (int nb = 0; nb < 3; ++nb) { const int blk = 3 * wave + nb, hb = blk % 6;
#pragma unroll
            for (int mb = 0; mb < 4; ++mb) { const int row = row0 + 16 * mb + lr; f32x4 v = acc[nb][mb];
                if (hb >= 4) {
                    f32x4 pv; pv.x = __shfl_xor(v.x, 32); pv.y = __shfl_xor(v.y, 32); pv.z = __shfl_xor(v.z, 32); pv.w = __shfl_xor(v.w, 32);
                    if (lat) { const int t = row & (T - 1); const int fb = (hb - 4) * 8 + 4 * (kq & 1);
                        const f32x4 c = *(const f32x4*)(rc + t * 16 + fb), s = *(const f32x4*)(rs + t * 16 + fb);
                        v = (kq < 2) ? (v * c - pv * s) : (v * c + pv * s); }
                }
                v = v * qs;
                v2u o; o.x = pk2(v.x, v.y); o.y = pk2(v.z, v.w);
                *(v2u*)(Q + (size_t)row * 384 + 16 * blk + 4 * kq) = o; } }
    }
    {
        const int hd = wave >> 1;
        if ((wave & 1) == 0) {
            f32x4 acc[4][4];
            small_gemm<128, 4, 4, true>(Akv, 136, WUKV, 64 * wave, acc, lane);
#pragma unroll
            for (int nb = 0; nb < 4; ++nb)
#pragma unroll
                for (int mb = 0; mb < 4; ++mb) { const int row = row0 + 16 * mb + lr; const f32x4 v = acc[nb][mb];
                    v2u o; o.x = pk2(v.x, v.y); o.y = pk2(v.z, v.w);
                    *(v2u*)(Kf + (size_t)row * 384 + hd * 96 + 16 * nb + 4 * kq) = o; }
        } else {
            f32x4 acc[4][4];
            small_gemm<128, 4, 4, false>(Akv, 136, WUKV, 64 * wave, acc, lane);
            const int bb = lat ? (row0 >> 12) : ((row0 - NLAT) >> 8);
            const int key0 = lat ? (TC + (row0 & (T - 1))) : ((row0 - NLAT) & (TC - 1));
#pragma unroll
            for (int nb = 0; nb < 4; ++nb)
#pragma unroll
                for (int mb = 0; mb < 4; ++mb) { const f32x4 v = acc[nb][mb];
                    v2u o; o.x = pk2(v.x, v.y); o.y = pk2(v.z, v.w);
                    *(v2u*)(Vt + ((size_t)(bb * 4 + hd) * 64 + 16 * nb + lr) * NKEY + key0 + 16 * mb + 4 * kq) = o; }
        }
    }
    __syncthreads();
}

DI void attn_unit(KArgs a, const Ctx& F, int b, int hd, int qrow0, int nkeys) {
    const bf16* Q = (const bf16*)(a->ws + WS_Q); const bf16* Kf = (const bf16*)(a->ws + WS_K); const bf16* Vt = (const bf16*)(a->ws + WS_VT);
    bf16* MO = (bf16*)(a->ws + WS_H);
    constexpr int KP = 208, VP = 144, BUF = 64 * KP + 64 * VP;
    const int tid = F.tid, lane = F.lane, wave = F.wave, l31 = lane & 31, h2 = lane >> 5;
    const int qrow = qrow0 + 32 * wave + l31;
    bf16x8 Qf[6];
#pragma unroll
    for (int s = 0; s < 6; ++s) Qf[s] = *(const bf16x8*)(Q + (size_t)qrow * 384 + hd * 96 + 16 * s + 8 * h2);
    const int kc0 = tid, kc1 = tid + 512;
    const int kr0 = kc0 / 12, kcc0 = kc0 % 12, kr1 = kc1 / 12, kcc1 = kc1 % 12; const bool k1v = kc1 < 768;
    const int vd = tid >> 3, vcc = tid & 7;
    const bf16* vbase = Vt + ((size_t)(b * 4 + hd) * 64 + vd) * NKEY + vcc * 8;
    v4u gk0, gk1, gv;
    auto gloadK = [&](int kt) {
        const int key0 = 64 * kt; const int krow = key0 < TC ? (NLAT + b * TC + key0) : (b * T + key0 - TC);
        gk0 = *(const v4u*)(Kf + (size_t)(krow + kr0) * 384 + hd * 96 + kcc0 * 8);
        if (k1v) gk1 = *(const v4u*)(Kf + (size_t)(krow + kr1) * 384 + hd * 96 + kcc1 * 8);
    };
    auto gloadV = [&](int kt) { gv = *(const v4u*)(vbase + 64 * kt); };
    auto lstoreK = [&](int buf) {
        LAS uchar* base = F.lds + buf * BUF;
        *(LAS v4u*)(base + kr0 * KP + kcc0 * 16) = gk0;
        if (k1v) *(LAS v4u*)(base + kr1 * KP + kcc1 * 16) = gk1;
    };
    auto lstoreV = [&](int buf) {
        LAS uchar* vp = F.lds + buf * BUF + 64 * KP + vd * VP + (vcc >> 1) * 32 + (vcc & 1) * 8;
        v2u lo_, hi_; lo_.x = gv.x; lo_.y = gv.y; hi_.x = gv.z; hi_.y = gv.w;
        *(LAS v2u*)vp = lo_; *(LAS v2u*)(vp + 16) = hi_;
    };
    const int nt = nkeys / 64;
    f32x16 O0, O1, negm;
#pragma unroll
    for (int r = 0; r < 16; ++r) { O0[r] = 0.f; O1[r] = 0.f; negm[r] = 0.f; }
    float lsum = 0.f;
    f32x16 s0, s1;
    gloadK(0); gloadV(0); lstoreK(0); lstoreV(0);
    gloadK(1); lstoreK(1);
    __syncthreads();
    {
        s0 = negm; s1 = negm;
#pragma unroll
        for (int s = 0; s < 6; ++s) {
            const bf16x8 ka = *(const LAS bf16x8*)(F.lds + l31 * KP + (16 * s + 8 * h2) * 2);
            const bf16x8 kb2 = *(const LAS bf16x8*)(F.lds + (32 + l31) * KP + (16 * s + 8 * h2) * 2);
            s0 = mfma32(ka, Qf[s], s0); s1 = mfma32(kb2, Qf[s], s1);
        }
    }
    for (int kt = 0; kt < nt; ++kt) {
        const bool more1 = kt + 1 < nt, more2 = kt + 2 < nt;
        if (more2) gloadK(kt + 2);
        if (more1) gloadV(kt + 1);
        float mx = fmaxf(fmaxf(s0[0], s0[1]), s0[2]);
#pragma unroll
        for (int r = 3; r < 15; r += 2) mx = fmaxf(fmaxf(mx, s0[r]), s0[r + 1]);
        mx = fmaxf(mx, s0[15]);
#pragma unroll
        for (int r = 0; r < 16; r += 2) mx = fmaxf(fmaxf(mx, s1[r]), s1[r + 1]);
        mx = fmaxf(mx, __shfl_xor(mx, 32));
        if (kt == 0 || __builtin_amdgcn_ballot_w64(mx > 8.0f) != 0ull) {
            const float dlt = (kt == 0) ? mx : fmaxf(mx, 0.f);
            const float alpha = (kt == 0) ? 1.0f : __builtin_amdgcn_exp2f(-dlt);
            lsum *= alpha;
#pragma unroll
            for (int r = 0; r < 16; ++r) { O0[r] *= alpha; O1[r] *= alpha; s0[r] -= dlt; s1[r] -= dlt; negm[r] -= dlt; }
        }
        f32x16 n0 = negm, n1 = negm;
        {
            const LAS uchar* kn_ = F.lds + ((kt + 1) & 1) * BUF;
#pragma unroll
            for (int s = 0; s < 6; ++s) {
                const bf16x8 ka = *(const LAS bf16x8*)(kn_ + l31 * KP + (16 * s + 8 * h2) * 2);
                const bf16x8 kb2 = *(const LAS bf16x8*)(kn_ + (32 + l31) * KP + (16 * s + 8 * h2) * 2);
                n0 = mfma32(ka, Qf[s], n0); n1 = mfma32(kb2, Qf[s], n1);
            }
        }
        const LAS uchar* vb_ = F.lds + (kt & 1) * BUF + 64 * KP;
        f32x2 ps2 = {0.f, 0.f};
#pragma unroll
        for (int kb = 0; kb < 2; ++kb)
#pragma unroll
            for (int sp = 0; sp < 2; ++sp) {
                f32x16& sx = kb ? s1 : s0;
#pragma unroll
                for (int r = 8 * sp; r < 8 * sp + 8; r += 2) { sx[r] = __builtin_amdgcn_exp2f(sx[r]); sx[r + 1] = __builtin_amdgcn_exp2f(sx[r + 1]); ps2 += (f32x2){sx[r], sx[r + 1]}; }
                const bf16x8 pf = pack8(sx[8 * sp + 0], sx[8 * sp + 1], sx[8 * sp + 2], sx[8 * sp + 3], sx[8 * sp + 4], sx[8 * sp + 5], sx[8 * sp + 6], sx[8 * sp + 7]);
                const int ko = (32 * kb + 16 * sp + 8 * h2) * 2;
                const bf16x8 va = *(const LAS bf16x8*)(vb_ + l31 * VP + ko), vc = *(const LAS bf16x8*)(vb_ + (32 + l31) * VP + ko);
                O0 = mfma32(va, pf, O0); O1 = mfma32(vc, pf, O1);
            }
        lsum += ps2.x + ps2.y;
        if (more2) lstoreK(kt & 1);
        if (more1) lstoreV((kt + 1) & 1);
        lds_barrier();
        s0 = n0; s1 = n1;
    }
    const float ltot = lsum + __shfl_xor(lsum, 32), inv = 1.0f / ltot;
    bf16* op = MO + (size_t)qrow * D + 256 + hd * 64;
#pragma unroll
    for (int gq = 0; gq < 4; ++gq) {
        v2u o; o.x = pk2(O0[4 * gq] * inv, O0[4 * gq + 1] * inv); o.y = pk2(O0[4 * gq + 2] * inv, O0[4 * gq + 3] * inv);
        *(v2u*)(op + 8 * gq + 4 * h2) = o;
        v2u o2; o2.x = pk2(O1[4 * gq] * inv, O1[4 * gq + 1] * inv); o2.y = pk2(O1[4 * gq + 2] * inv, O1[4 * gq + 3] * inv);
        *(v2u*)(op + 32 + 8 * gq + 4 * h2) = o2;
    }
}
DI float conv3(const bf16* Z, int b, int seg, int t, int len, int col, float w0, float w1, float w2, float cb) {
    const bf16* zp = Z + (size_t)tok_row(b, seg, t) * ZP + col;
    float y = cb + w1 * bf2f(zp[0]);
    if (t > 0) y += w0 * bf2f(zp[-ZP]);
    if (t + 1 < len) y += w2 * bf2f(zp[ZP]);
    return y;
}
DI bf16x8 ldperm(const LAS bf16* rowp, int k0, int hh) { const bf16x4 a0 = *(const LAS bf16x4*)(rowp + k0 + 4 * hh), a1 = *(const LAS bf16x4*)(rowp + k0 + 8 + 4 * hh); return __builtin_shufflevector(a0, a1, 0, 1, 2, 3, 4, 5, 6, 7); }
DI bf16x8 pack_acc(const f32x16& x, int s) { return s ? pack8(x[8], x[9], x[10], x[11], x[12], x[13], x[14], x[15]) : pack8(x[0], x[1], x[2], x[3], x[4], x[5], x[6], x[7]); }
DI void rwkv_scan_task(KArgs a, const Ctx& F, int l, int b, int hd, int dir) {
    const bf16* Z = (const bf16*)(a->ws + WS_ACT); bf16* YR = (bf16*)(a->ws + WS_YR) + (size_t)dir * NROWS * 256;
    constexpr int RAWSZ = 13056 + 4608;
    constexpr int FR_OFF = 4 * 4608 + 3 * 5120 + 256 + 2560;
    constexpr int SETSZ = FR_OFF + 6144;
    LAS uchar* const RAW0 = F.lds;
    LAS float* WL = (LAS float*)(F.lds + 2 * RAWSZ);
    LAS float* AL = WL + 2048;
    LAS float* Alw = AL + 2048;
    LAS float* CST = Alw + 512;
    LAS uchar* const SET0 = (LAS uchar*)(CST + 1024);
    const int tid = F.tid, lane = F.lane, wave = F.wave;
    const int hc = hd * 64 + lane;
    bf16x8 lf0 = {0, 0, 0, 0, 0, 0, 0, 0}, lf1 = lf0;
    if (wave >= 4) { const int w4 = wave - 4, l31 = lane & 31, hh = lane >> 5; const float* up = a->in[(w4 >> 1) ? I_RWUP : I_RAUP] + ((size_t)(l * 2 + dir) * 32) * 256 + hd * 64 + 32 * (w4 & 1) + l31;
        float u[16];
#pragma unroll
        for (int s = 0; s < 2; ++s)
#pragma unroll
            for (int j = 0; j < 8; ++j) u[8 * s + j] = up[(size_t)(16 * s + 8 * hh + j) * 256];
        lf0 = pack8(u[0], u[1], u[2], u[3], u[4], u[5], u[6], u[7]); lf1 = pack8(u[8], u[9], u[10], u[11], u[12], u[13], u[14], u[15]); }
    if (wave == 0) {
        const float* cw = a->in[I_RCW] + (size_t)l * 3 * 768; const float* cbp = a->in[I_RCB] + (size_t)l * 768;
        CST[0 * 64 + lane] = a->in[I_RW0][(l * 2 + dir) * 256 + hc]; CST[1 * 64 + lane] = a->in[I_RA0][(l * 2 + dir) * 256 + hc];
        CST[2 * 64 + lane] = a->in[I_RKK][l * 256 + hc]; CST[3 * 64 + lane] = a->in[I_RKA][l * 256 + hc];
#pragma unroll
        for (int j = 0; j < 3; ++j) { CST[(4 + j) * 64 + lane] = cw[j * 768 + hc]; CST[(7 + j) * 64 + lane] = cw[j * 768 + 256 + hc]; CST[(10 + j) * 64 + lane] = cw[j * 768 + 512 + hc]; }
        CST[13 * 64 + lane] = cbp[hc]; CST[14 * 64 + lane] = cbp[256 + hc]; CST[15 * 64 + lane] = cbp[512 + hc];
    }
    f32x16 ST0, ST1;
#pragma unroll
    for (int r = 0; r < 16; ++r) { ST0[r] = 0.f; ST1[r] = 0.f; }
    const int c0r = tid / 24, c0s = (tid % 24) >> 3, c0c = (tid % 24) & 7;
    const int c1 = tid + 512, c1r = c1 / 24, c1s = (c1 % 24) >> 3, c1c = (c1 % 24) & 7; const bool c1v = c1 < 816;
    const int lr_ = tid >> 3, lc_ = tid & 7;
    v4u g0, g1, g2;
    unsigned zz_ = 0u; asm volatile("" : "+v"(zz_)); const v4u zero4 = {zz_, zz_, zz_, zz_};
    const int nchC = TC / 32, nchT = nchC + T / 32;
    auto gload = [&](int gc) {
        const int seg = gc >= nchC, ch = seg ? gc - nchC : gc, len = seg ? T : TC;
        const int tbase = dir ? (len - 32 * (ch + 1)) : 32 * ch;
        { const int t = tbase - 1 + c0r; g0 = (t >= 0 && t < len) ? *(const v4u*)(Z + (size_t)tok_row(b, seg, t) * ZP + ZRKV + c0s * 256 + hd * 64 + c0c * 8) : zero4; }
        if (c1v) { const int t = tbase - 1 + c1r; g1 = (t >= 0 && t < len) ? *(const v4u*)(Z + (size_t)tok_row(b, seg, t) * ZP + ZRKV + c1s * 256 + hd * 64 + c1c * 8) : zero4; }
        if (tid < 256) { const int t = tbase + lr_; g2 = *(const v4u*)(Z + (size_t)tok_row(b, seg, t) * ZP + ZWD + lc_ * 8); }
    };
    auto lstore = [&](int par) {
        LAS bf16* Raw = (LAS bf16*)(RAW0 + par * RAWSZ); LAS bf16* LwB = (LAS bf16*)(RAW0 + par * RAWSZ + 13056);
        *(LAS v4u*)(Raw + c0r * 192 + c0s * 64 + c0c * 8) = g0;
        if (c1v) *(LAS v4u*)(Raw + c1r * 192 + c1s * 64 + c1c * 8) = g1;
        if (tid < 256) { float x[8] = {bflo(g2.x), bfhi(g2.x), bflo(g2.y), bfhi(g2.y), bflo(g2.z), bfhi(g2.z), bflo(g2.w), bfhi(g2.w)};
            if (lc_ < 4) {
#pragma unroll
                for (int j = 0; j < 8; ++j) x[j] = 1.0f - 2.0f * __builtin_amdgcn_rcpf(1.0f + fexp(2.0f * x[j])); }
            v4u w; w.x = pk2(x[0], x[1]); w.y = pk2(x[2], x[3]); w.z = pk2(x[4], x[5]); w.w = pk2(x[6], x[7]);
            *(LAS v4u*)(LwB + lr_ * 72 + lc_ * 8) = w; }
    };
    gload(0); lstore(0);
    __syncthreads();
    for (int n = -2; n < nchT; ++n) {
        if (n + 3 < nchT) gload(n + 3);
        int ln_ = lane; asm volatile("" : "+v"(ln_));
        const int l31 = ln_ & 31, hh = ln_ >> 5;
        if (wave < 2) {
            if (n >= 0) {
                const int seg = n >= nchC, ch = seg ? n - nchC : n, len = seg ? T : TC;
                const int tbase = dir ? (len - 32 * (ch + 1)) : 32 * ch;
                LAS uchar* sp = SET0 + (n & 1) * SETSZ;
                LAS bf16* KhT = (LAS bf16*)sp; LAS bf16* BhT = KhT + 32 * 72; LAS bf16* KkT = BhT + 32 * 72; LAS bf16* RhT = KkT + 32 * 72;
                LAS bf16* Kh = RhT + 32 * 72; LAS bf16* nBh = Kh + 64 * 40; LAS bf16* VT = nBh + 64 * 40; LAS float* GL = (LAS float*)(VT + 64 * 40); LAS bf16* TT = (LAS bf16*)(GL + 64);
                const int vcol = 32 * wave + l31;
                f32x16 accP, accY;
#pragma unroll
                for (int r = 0; r < 16; ++r) { accP[r] = 0.f; accY[r] = 0.f; }
#pragma unroll
                for (int kb = 0; kb < 2; ++kb)
#pragma unroll
                    for (int s = 0; s < 2; ++s) { const bf16x8 sb = pack_acc(kb ? ST1 : ST0, s);
                        accP = mfma32(ldperm(KkT + l31 * 72, 32 * kb + 16 * s, hh), sb, accP);
                        accY = mfma32(ldperm(RhT + l31 * 72, 32 * kb + 16 * s, hh), sb, accY); }
                const LAS bf16x8* FR = (const LAS bf16x8*)(sp + FR_OFF);
#pragma unroll
                for (int s = 0; s < 2; ++s) { const bf16x8 vt_ = ldperm(VT + vcol * 40, 16 * s, hh);
                    accP = mfma32(FR[(0 + s) * 64 + ln_], vt_, accP);
                    accY = mfma32(FR[(2 + s) * 64 + ln_], vt_, accY); }
                f32x16 accC;
#pragma unroll
                for (int r = 0; r < 16; ++r) accC[r] = 0.f;
#pragma unroll
                for (int s = 0; s < 2; ++s) accC = mfma32(ldperm(TT + l31 * 40, 16 * s, hh), pack_acc(accP, s), accC);
#pragma unroll
                for (int s = 0; s < 2; ++s) accY = mfma32(FR[(4 + s) * 64 + ln_], pack_acc(accC, s), accY);
#pragma unroll
                for (int s = 0; s < 2; ++s) { const bf16x8 vb_ = *(const LAS bf16x8*)(VT + vcol * 40 + 16 * s + 8 * hh); const bf16x8 cb_ = pack_acc(accC, s);
                    ST0 = mfma32(*(const LAS bf16x8*)(Kh + l31 * 40 + 16 * s + 8 * hh), vb_, ST0);
                    ST1 = mfma32(*(const LAS bf16x8*)(Kh + (32 + l31) * 40 + 16 * s + 8 * hh), vb_, ST1);
                    ST0 = mfma32(ldperm(nBh + l31 * 40, 16 * s, hh), cb_, ST0);
                    ST1 = mfma32(ldperm(nBh + (32 + l31) * 40, 16 * s, hh), cb_, ST1); }
#pragma unroll
                for (int r = 0; r < 16; ++r) { ST0[r] *= GL[crow(r, hh)]; ST1[r] *= GL[32 + crow(r, hh)]; }
#pragma unroll
                for (int r = 0; r < 16; ++r) { const int i = crow(r, hh), t = dir ? (tbase + 31 - i) : (tbase + i);
                    YR[(size_t)tok_row(b, seg, t) * 256 + hd * 64 + vcol] = (bf16)f2bf(accY[r]); }
            }
        } else if (wave == 2) {
            if (n + 1 >= 0 && n + 1 < nchT) {
                LAS uchar* sp = SET0 + ((n + 1) & 1) * SETSZ;
                LAS bf16* BhT = (LAS bf16*)sp + 32 * 72; LAS bf16* KkT = BhT + 32 * 72; LAS bf16* TT = (LAS bf16*)(sp + 4 * 4608 + 3 * 5120 + 256);
                f32x16 P, PT, Tm, TTm;
#pragma unroll
                for (int r = 0; r < 16; ++r) { P[r] = 0.f; PT[r] = 0.f; }
#pragma unroll
                for (int s = 0; s < 4; ++s) { const bf16x8 bh_ = *(const LAS bf16x8*)(BhT + l31 * 72 + 16 * s + 8 * hh), kk_ = *(const LAS bf16x8*)(KkT + l31 * 72 + 16 * s + 8 * hh);
                    P = mfma32(bh_, kk_, P); PT = mfma32(kk_, bh_, PT); }
#pragma unroll
                for (int r = 0; r < 16; ++r) { const int j = crow(r, hh);
                    P[r] = (j < l31) ? P[r] : 0.f; PT[r] = (j > l31) ? PT[r] : 0.f;
                    const float idv = (j == l31) ? 1.f : 0.f; Tm[r] = idv - P[r]; TTm[r] = idv - PT[r]; }
#pragma unroll
                for (int it = 0; it < 4; ++it) {
                    const bf16x8 p0 = pack_acc(P, 0), p1 = pack_acc(P, 1), q0 = pack_acc(PT, 0), q1 = pack_acc(PT, 1);
                    f32x16 P2, P2T;
#pragma unroll
                    for (int r = 0; r < 16; ++r) { P2[r] = 0.f; P2T[r] = 0.f; }
                    P2 = mfma32(q0, p0, P2); P2 = mfma32(q1, p1, P2);
                    if (it < 3) { P2T = mfma32(p0, q0, P2T); P2T = mfma32(p1, q1, P2T); }
                    const bf16x8 u0 = pack_acc(TTm, 0), u1 = pack_acc(TTm, 1);
                    const bf16x8 a0 = pack_acc(P2, 0), a1 = pack_acc(P2, 1);
                    Tm = mfma32(u0, a0, Tm); Tm = mfma32(u1, a1, Tm);
                    if (it < 3) { TTm = mfma32(a0, u0, TTm); TTm = mfma32(a1, u1, TTm); }
                    P = P2; PT = P2T;
                }
#pragma unroll
                for (int r = 0; r < 16; ++r) TT[l31 * 40 + crow(r, hh)] = (bf16)f2bf(Tm[r]);
            }
        } else if (wave == 3) {
            if (n + 1 >= 0 && n + 1 < nchT) {
                LAS uchar* sp = SET0 + ((n + 1) & 1) * SETSZ;
                LAS bf16* KhT = (LAS bf16*)sp; LAS bf16* BhT = KhT + 32 * 72; LAS bf16* KkT = BhT + 32 * 72; LAS bf16* RhT = KkT + 32 * 72;
                LAS bf16x8* FR = (LAS bf16x8*)(sp + FR_OFF);
                f32x16 a1, a2, a3;
#pragma unroll
                for (int r = 0; r < 16; ++r) { a1[r] = 0.f; a2[r] = 0.f; a3[r] = 0.f; }
#pragma unroll
                for (int s = 0; s < 4; ++s) { const bf16x8 kh_ = *(const LAS bf16x8*)(KhT + l31 * 72 + 16 * s + 8 * hh), kk_ = *(const LAS bf16x8*)(KkT + l31 * 72 + 16 * s + 8 * hh),
                                                             rh_ = *(const LAS bf16x8*)(RhT + l31 * 72 + 16 * s + 8 * hh), bh_ = *(const LAS bf16x8*)(BhT + l31 * 72 + 16 * s + 8 * hh);
                    a1 = mfma32(kh_, kk_, a1); a2 = mfma32(kh_, rh_, a2); a3 = mfma32(bh_, rh_, a3); }
#pragma unroll
                for (int r = 0; r < 16; ++r) { const int j = crow(r, hh); a1[r] = (j < l31) ? a1[r] : 0.f; a2[r] = (j <= l31) ? a2[r] : 0.f; a3[r] = (j <= l31) ? -a3[r] : 0.f; }
#pragma unroll
                for (int s = 0; s < 2; ++s) { FR[(0 + s) * 64 + ln_] = pack_acc(a1, s); FR[(2 + s) * 64 + ln_] = pack_acc(a2, s); FR[(4 + s) * 64 + ln_] = pack_acc(a3, s); }
            }
        } else if (wave >= 4) {
            if (n + 2 < nchT) {
                const int w4 = wave - 4, mat = (w4 >> 1) ^ 1;
                const LAS bf16* LwB = (const LAS bf16*)(RAW0 + ((n + 2) & 1) * RAWSZ + 13056);
                f32x16 acc;
#pragma unroll
                for (int r = 0; r < 16; ++r) acc[r] = 0.f;
                const int ko = mat * 32, arow = dir ? (31 - l31) : l31, cch = 32 * (w4 & 1) + l31;
                acc = mfma32(*(const LAS bf16x8*)(LwB + arow * 72 + ko + 8 * hh), lf0, acc);
                acc = mfma32(*(const LAS bf16x8*)(LwB + arow * 72 + ko + 16 + 8 * hh), lf1, acc);
                const float c0_ = CST[mat * 64 + cch];
                if (mat) {
#pragma unroll
                    for (int r = 0; r < 16; ++r) AL[crow(r, hh) * 64 + cch] = __builtin_amdgcn_rcpf(1.0f + fexp(-(acc[r] + c0_)));
                } else {
#pragma unroll
                    for (int r = 0; r < 16; ++r) acc[r] = -0.60653065971f * __builtin_amdgcn_rcpf(1.0f + fexp(-(acc[r] + c0_)));
                    float off = 0.f;
#pragma unroll
                    for (int g = 0; g < 4; ++g) {
                        acc[4 * g + 1] += acc[4 * g]; acc[4 * g + 2] += acc[4 * g + 1]; acc[4 * g + 3] += acc[4 * g + 2];
                        const float tg = acc[4 * g + 3], ug = __shfl_xor(tg, 32);
                        const float o = off + (hh ? ug : 0.f);
#pragma unroll
                        for (int e = 0; e < 4; ++e) acc[4 * g + e] += o;
                        off += tg + ug;
                    }
#pragma unroll
                    for (int r = 0; r < 16; ++r) WL[crow(r, hh) * 64 + cch] = acc[r];
                }
            }
        }
        lds_barrier();
#ifdef DBG_REP_R23
        for (int rp_ = 0; rp_ < 2; ++rp_) {
#else
        {
#endif
        const bool pv = n + 2 < nchT;
        const int pi = tid >> 4, c4 = (ln_ & 15) * 4, pjr = dir ? (32 - pi) : (pi + 1);
        if (pv) {
            LAS uchar* sp = SET0 + (n & 1) * SETSZ;
            LAS bf16* KhT = (LAS bf16*)sp; LAS bf16* BhT = KhT + 32 * 72; LAS bf16* KkT = BhT + 32 * 72; LAS bf16* RhT = KkT + 32 * 72;
            LAS bf16* Kh = RhT + 32 * 72; LAS bf16* nBh = Kh + 64 * 40; LAS bf16* VT = nBh + 64 * 40; LAS float* GL = (LAS float*)(VT + 64 * 40);
            const LAS bf16* Raw = (const LAS bf16*)(RAW0 + (n & 1) * RAWSZ);
            const f32x4 cum = *(const LAS f32x4*)(WL + pi * 64 + c4);
            f32x4 cpv = *(const LAS f32x4*)(WL + (pi ? pi - 1 : 0) * 64 + c4);
            if (pi == 0) cpv = (f32x4){0.f, 0.f, 0.f, 0.f};
            float rr[4], kv[4], vv[4];
            { const f32x4 br = *(const LAS f32x4*)(CST + 13 * 64 + c4), bk = *(const LAS f32x4*)(CST + 14 * 64 + c4), bv = *(const LAS f32x4*)(CST + 15 * 64 + c4);
#pragma unroll
              for (int e = 0; e < 4; ++e) { rr[e] = br[e]; kv[e] = bk[e]; vv[e] = bv[e]; } }
#pragma unroll
            for (int tap = 0; tap < 3; ++tap) {
                const LAS bf16* rp = Raw + (pjr - 1 + tap) * 192 + c4;
                const v2u xr = *(const LAS v2u*)rp, xk = *(const LAS v2u*)(rp + 64), xv = *(const LAS v2u*)(rp + 128);
                const f32x4 wr = *(const LAS f32x4*)(CST + (4 + tap) * 64 + c4), wk = *(const LAS f32x4*)(CST + (7 + tap) * 64 + c4), wv = *(const LAS f32x4*)(CST + (10 + tap) * 64 + c4);
                rr[0] += wr[0] * bflo(xr.x); rr[1] += wr[1] * bfhi(xr.x); rr[2] += wr[2] * bflo(xr.y); rr[3] += wr[3] * bfhi(xr.y);
                kv[0] += wk[0] * bflo(xk.x); kv[1] += wk[1] * bfhi(xk.x); kv[2] += wk[2] * bflo(xk.y); kv[3] += wk[3] * bfhi(xk.y);
                vv[0] += wv[0] * bflo(xv.x); vv[1] += wv[1] * bfhi(xv.x); vv[2] += wv[2] * bflo(xv.y); vv[3] += wv[3] * bfhi(xv.y);
            }
            const f32x4 kkc4 = *(const LAS f32x4*)(CST + 2 * 64 + c4), kac4 = *(const LAS f32x4*)(CST + 3 * 64 + c4);
            const f32x4 av4 = *(const LAS f32x4*)(AL + pi * 64 + c4);
            float kx[4]; float ss = 0.f;
#pragma unroll
            for (int e = 0; e < 4; ++e) { kx[e] = kv[e] * kkc4[e]; ss += kx[e] * kx[e]; }
            ss = sum16(ss);
            const float rn = __builtin_amdgcn_rcpf(fmaxf(__builtin_amdgcn_sqrtf(ss), 1e-12f));
            float kh[4], bh[4], kk_[4], rh[4];
#pragma unroll
            for (int e = 0; e < 4; ++e) { const float av = av4[e], kn = kx[e] * rn, en = fexp(-cum[e]), ep = fexp(cum[e]), epv = fexp(cpv[e]);
                kh[e] = kv[e] * (1.0f + (av - 1.0f) * kac4[e]) * en; bh[e] = kn * av * en; kk_[e] = kn * epv; rh[e] = rr[e] * ep; }
            v2u o;
            o.x = pk2(kh[0], kh[1]); o.y = pk2(kh[2], kh[3]); *(LAS v2u*)(KhT + pi * 72 + c4) = o;
            o.x = pk2(bh[0], bh[1]); o.y = pk2(bh[2], bh[3]); *(LAS v2u*)(BhT + pi * 72 + c4) = o;
            o.x = pk2(kk_[0], kk_[1]); o.y = pk2(kk_[2], kk_[3]); *(LAS v2u*)(KkT + pi * 72 + c4) = o;
            o.x = pk2(rh[0], rh[1]); o.y = pk2(rh[2], rh[3]); *(LAS v2u*)(RhT + pi * 72 + c4) = o;
#pragma unroll
            for (int e = 0; e < 4; ++e) { Kh[(c4 + e) * 40 + pi] = (bf16)f2bf(kh[e]); nBh[(c4 + e) * 40 + pi] = (bf16)f2bf(-bh[e]); VT[(c4 + e) * 40 + pi] = (bf16)f2bf(vv[e]); }
            if (pi == 31) *(LAS f32x4*)(GL + c4) = (f32x4){fexp(cum[0]), fexp(cum[1]), fexp(cum[2]), fexp(cum[3])};
        }
        }
        if (n + 3 < nchT) lstore((n + 3) & 1);
        lds_barrier();
    }
}

DI void mlstm_task(KArgs a, const Ctx& F, int l, int b, int hd) {
    const bf16* Z = (const bf16*)(a->ws + WS_ACT);
    const int tid = F.tid, lane = F.lane, wave = F.wave, dir = wave >> 2, w2 = wave & 3, tid2 = tid & 255, l31 = lane & 31, hh = lane >> 5;
    bf16* YM = (bf16*)(a->ws + WS_YM) + (size_t)dir * NROWS * 256;
    constexpr int HP = 72;
    constexpr int HALF_LDS = 6 * 9216 + 2304 + 2048;
    LAS uchar* base = F.lds + dir * HALF_LDS;
    LAS bf16* Qc = (LAS bf16*)base; LAS bf16* Kc = Qc + 64 * HP; LAS bf16* KT = Kc + 64 * HP; LAS bf16* VT = KT + 64 * HP; LAS bf16* Cb0 = VT + 64 * HP;
    LAS float* fv = (LAS float*)(base + 6 * 9216);
    LAS float* Vgv = fv; LAS float* VMr = fv + 64; LAS float* Vwi = fv + 128; LAS float* Vem = fv + 192; LAS float* Vwk = fv + 256; LAS float* Vn0 = fv + 320; LAS float* Vsc = fv + 448;
    LAS float* Cw = fv + 576;
    for (int i = tid2; i < 2 * 64 * HP; i += 256) Cb0[i] = 0;
    if (tid2 < 128) Vn0[tid2] = 0.f;
    { const float* cw = a->in[I_MCW] + (size_t)l * 3 * 512; const float* cbp = a->in[I_MCB] + (size_t)l * 512;
      for (int i = tid2; i < 512; i += 256) { const int tap = i >> 7, cc = i & 127, col = (cc < 64) ? (hd * 64 + cc) : (256 + hd * 64 + cc - 64);
          Cw[i] = (tap < 3) ? cw[tap * 512 + col] : cbp[col]; } }
    f32x16 accC;
#pragma unroll
    for (int r = 0; r < 16; ++r) accC[r] = 0.f;
    float m_run = 0.f;
    const int eb = w2 >> 1, lb = w2 & 1;
    const float gbi = a->in[I_MGB][l * 16 + dir * 8 + hd], gbf = a->in[I_MGB][l * 16 + dir * 8 + 4 + hd];
    const int nchC = TC / 64, nchT = nchC + T / 64;
    const int pi_ = tid2 >> 2, qq = tid2 & 3;
    v4u rq[3][2], rk[3][2], rv[2]; unsigned gr0 = 0u, gr1 = 0u;
    unsigned zz_ = 0u; asm volatile("" : "+v"(zz_)); const v4u zero4 = {zz_, zz_, zz_, zz_};
    auto gload = [&](int gc) {
        const int seg = gc >= nchC, ch = seg ? gc - nchC : gc, len = seg ? T : TC;
        const int tbase = dir ? (len - 64 * (ch + 1)) : 64 * ch;
        const int t = tbase + (dir ? (63 - pi_) : pi_);
#pragma unroll
        for (int tap = 0; tap < 3; ++tap) { const int tt = t - 1 + tap; const bool ok = tt >= 0 && tt < len;
            const bf16* zp = Z + (size_t)tok_row(b, seg, ok ? tt : t) * ZP + ZMQK + hd * 64 + qq * 16;
            rq[tap][0] = ok ? *(const v4u*)zp : zero4; rq[tap][1] = ok ? *(const v4u*)(zp + 8) : zero4;
            rk[tap][0] = ok ? *(const v4u*)(zp + 256) : zero4; rk[tap][1] = ok ? *(const v4u*)(zp + 264) : zero4; }
        { const bf16* zp = Z + (size_t)tok_row(b, seg, t) * ZP + ZMV + hd * 64 + qq * 16; rv[0] = *(const v4u*)zp; rv[1] = *(const v4u*)(zp + 8); }
        if (tid2 < 64) { const bf16* zp = Z + (size_t)tok_row(b, seg, tbase + tid2) * ZP + ZMG + dir * 8 + hd; gr0 = zp[0]; gr1 = zp[4]; }
    };
    gload(0);
    __syncthreads();
    for (int gc = 0; gc < nchT; ++gc) {
        const int seg = gc >= nchC, ch = seg ? gc - nchC : gc, len = seg ? T : TC;
        const int tbase = dir ? (len - 64 * (ch + 1)) : 64 * ch;
        LAS bf16* Cb = Cb0 + (gc & 1) * 64 * HP; LAS bf16* CbN = Cb0 + ((gc + 1) & 1) * 64 * HP;
        LAS float* Vn = Vn0 + (gc & 1) * 64; LAS float* VnN = Vn0 + ((gc + 1) & 1) * 64;
        if (w2 == 0) {
            float li = bf2f(gr0) + gbi; const float fraw = bf2f(gr1) + gbf;
            float lf = fminf(fraw, 0.f) - 0.69314718056f * __builtin_amdgcn_logf(1.0f + fexp(-fabsf(fraw)));
            if (dir) { li = __shfl(li, 63 - lane); lf = __shfl(lf, 63 - lane); }
            const float bc = wave_scan_sum(lf);
            const float g = li - bc; const float pm = wave_scan_max(g);
            const float mprev = m_run;
            const float blast = __shfl(bc, 63);
            const float lw = blast - bc + li;
            const float mnew = fmaxf(blast + mprev, wave_max(lw));
            const float Mr = fmaxf(mprev, pm);
            Vgv[lane] = g; VMr[lane] = Mr; Vwi[lane] = fexp(mprev - Mr); Vem[lane] = fexp(-bc - Mr); Vwk[lane] = fexp(lw - mnew);
            if (lane == 0) Vsc[0] = fexp(blast + mprev - mnew);
            m_run = mnew;
        }
        {
            float qv[16], kvv[16];
#pragma unroll
            for (int j = 0; j < 16; ++j) { qv[j] = Cw[384 + qq * 16 + j]; kvv[j] = Cw[384 + 64 + qq * 16 + j]; }
#pragma unroll
            for (int tap = 0; tap < 3; ++tap) {
                const unsigned qw[8] = {rq[tap][0].x, rq[tap][0].y, rq[tap][0].z, rq[tap][0].w, rq[tap][1].x, rq[tap][1].y, rq[tap][1].z, rq[tap][1].w};
                const unsigned kw[8] = {rk[tap][0].x, rk[tap][0].y, rk[tap][0].z, rk[tap][0].w, rk[tap][1].x, rk[tap][1].y, rk[tap][1].z, rk[tap][1].w};
#pragma unroll
                for (int j = 0; j < 8; ++j) { qv[2 * j] += Cw[tap * 128 + qq * 16 + 2 * j] * bflo(qw[j]); qv[2 * j + 1] += Cw[tap * 128 + qq * 16 + 2 * j + 1] * bfhi(qw[j]);
                    kvv[2 * j] += Cw[tap * 128 + 64 + qq * 16 + 2 * j] * bflo(kw[j]); kvv[2 * j + 1] += Cw[tap * 128 + 64 + qq * 16 + 2 * j + 1] * bfhi(kw[j]); }
            }
#pragma unroll
            for (int j = 0; j < 16; ++j) { qv[j] = qv[j] * fsigmoid(qv[j]); kvv[j] = kvv[j] * fsigmoid(kvv[j]) * 0.125f; }
#pragma unroll
            for (int j = 0; j < 16; j += 2) { *(LAS unsigned*)(Qc + pi_ * HP + qq * 16 + j) = pk2(qv[j], qv[j + 1]); *(LAS unsigned*)(Kc + pi_ * HP + qq * 16 + j) = pk2(kvv[j], kvv[j + 1]); }
            const unsigned vw[8] = {rv[0].x, rv[0].y, rv[0].z, rv[0].w, rv[1].x, rv[1].y, rv[1].z, rv[1].w};
#pragma unroll
            for (int j = 0; j < 16; ++j) { KT[(qq * 16 + j) * HP + pi_] = (bf16)f2bf(kvv[j]); VT[(qq * 16 + j) * HP + pi_] = (bf16)((j & 1) ? (vw[j >> 1] >> 16) : (vw[j >> 1] & 0xffffu)); }
        }
        if (gc + 1 < nchT) gload(gc + 1);
        lds_barrier();
        {
            const int lidx = 32 * lb + l31;
            f32x16 accN, accI;
#pragma unroll
            for (int r = 0; r < 16; ++r) { accN[r] = 0.f; accI[r] = 0.f; }
            float dsum = 0.f;
            const float Mr = VMr[lidx];
#pragma unroll
            for (int sb = 0; sb < 2; ++sb) {
                if (sb <= lb) {
                    f32x16 sT;
#pragma unroll
                    for (int r = 0; r < 16; ++r) sT[r] = 0.f;
#pragma unroll
                    for (int s = 0; s < 4; ++s) {
                        const bf16x8 ka = *(const LAS bf16x8*)(Kc + (32 * sb + l31) * HP + 16 * s + 8 * hh);
                        const bf16x8 qb = *(const LAS bf16x8*)(Qc + lidx * HP + 16 * s + 8 * hh);
                        sT = mfma32(ka, qb, sT);
                    }
#pragma unroll
                    for (int g4 = 0; g4 < 4; ++g4) { const f32x4 gv4 = *(const LAS f32x4*)(Vgv + 32 * sb + 8 * g4 + 4 * hh);
#pragma unroll
                        for (int e = 0; e < 4; ++e) { const int r = 4 * g4 + e, sidx = 32 * sb + 8 * g4 + 4 * hh + e;
                            const float ex = fexp(fminf(gv4[e] - Mr, 0.f));
                            const float p = (sidx <= lidx) ? sT[r] * ex : 0.f; sT[r] = p; dsum += p; } }
#pragma unroll
                    for (int sp = 0; sp < 2; ++sp) {
                        const bf16x8 pf = pack8(sT[8 * sp + 0], sT[8 * sp + 1], sT[8 * sp + 2], sT[8 * sp + 3], sT[8 * sp + 4], sT[8 * sp + 5], sT[8 * sp + 6], sT[8 * sp + 7]);
                        const int ko = 32 * sb + 16 * sp + 4 * hh;
                        const bf16x4 a0 = *(const LAS bf16x4*)(VT + (32 * eb + l31) * HP + ko), a1 = *(const LAS bf16x4*)(VT + (32 * eb + l31) * HP + ko + 8);
                        accN = mfma32(__builtin_shufflevector(a0, a1, 0, 1, 2, 3, 4, 5, 6, 7), pf, accN);
                    }
                }
            }
#pragma unroll
            for (int s = 0; s < 4; ++s) {
                const bf16x8 ca = *(const LAS bf16x8*)(Cb + (32 * eb + l31) * HP + 16 * s + 8 * hh);
                const bf16x8 qb = *(const LAS bf16x8*)(Qc + lidx * HP + 16 * s + 8 * hh);
                accI = mfma32(ca, qb, accI);
            }
            dsum += __shfl_xor(dsum, 32);
            float nq = 0.f;
#pragma unroll
            for (int j = 0; j < 64; j += 8) { const v4u w = *(const LAS v4u*)(Qc + lidx * HP + j); const f32x4 n0 = *(const LAS f32x4*)(Vn + j), n1 = *(const LAS f32x4*)(Vn + j + 4);
                nq += (n0[0] * bflo(w.x) + n0[1] * bfhi(w.x)) + (n0[2] * bflo(w.y) + n0[3] * bfhi(w.y)) + (n1[0] * bflo(w.z) + n1[1] * bfhi(w.z)) + (n1[2] * bflo(w.w) + n1[3] * bfhi(w.w)); }
            const float wi = Vwi[lidx];
            const float den = dsum + wi * nq, hden = fmaxf(fabsf(den), Vem[lidx]), inv = __builtin_amdgcn_rcpf(hden);
            const int t = dir ? (tbase + 63 - lidx) : (tbase + lidx);
            bf16* op = YM + (size_t)tok_row(b, seg, t) * 256 + hd * 64 + 32 * eb;
#pragma unroll
            for (int gq_ = 0; gq_ < 4; ++gq_) {
                const float h0 = (accN[4 * gq_] + wi * accI[4 * gq_]) * inv, h1 = (accN[4 * gq_ + 1] + wi * accI[4 * gq_ + 1]) * inv, h2 = (accN[4 * gq_ + 2] + wi * accI[4 * gq_ + 2]) * inv, h3 = (accN[4 * gq_ + 3] + wi * accI[4 * gq_ + 3]) * inv;
                v2u o; o.x = pk2(h0, h1); o.y = pk2(h2, h3);
                *(v2u*)(op + 8 * gq_ + 4 * hh) = o;
            }
        }
        {
            const float sc = Vsc[0];
#pragma unroll
            for (int r = 0; r < 16; ++r) accC[r] *= sc;
#pragma unroll
            for (int s = 0; s < 4; ++s) {
                const v4u vraw = *(const LAS v4u*)(VT + (32 * eb + l31) * HP + 16 * s + 8 * hh);
                const f32x4 w0 = *(const LAS f32x4*)(Vwk + 16 * s + 8 * hh), w1 = *(const LAS f32x4*)(Vwk + 16 * s + 8 * hh + 4);
                const bf16x8 va = pack8(bflo(vraw.x) * w0[0], bfhi(vraw.x) * w0[1], bflo(vraw.y) * w0[2], bfhi(vraw.y) * w0[3], bflo(vraw.z) * w1[0], bfhi(vraw.z) * w1[1], bflo(vraw.w) * w1[2], bfhi(vraw.w) * w1[3]);
                const bf16x8 kb = *(const LAS bf16x8*)(KT + (32 * lb + l31) * HP + 16 * s + 8 * hh);
                accC = mfma32(va, kb, accC);
            }
#pragma unroll
            for (int r = 0; r < 16; ++r) CbN[(32 * eb + crow(r, hh)) * HP + 32 * lb + l31] = (bf16)f2bf(accC[r]);
            if (tid2 < 64) { float s = 0.f;
#pragma unroll
                for (int j = 0; j < 64; j += 8) { const v4u w = *(const LAS v4u*)(KT + tid2 * HP + j); const f32x4 w0 = *(const LAS f32x4*)(Vwk + j), w1 = *(const LAS f32x4*)(Vwk + j + 4);
                    s += (w0[0] * bflo(w.x) + w0[1] * bfhi(w.x)) + (w0[2] * bflo(w.y) + w0[3] * bfhi(w.y)) + (w1[0] * bflo(w.z) + w1[1] * bfhi(w.z)) + (w1[2] * bflo(w.w) + w1[3] * bfhi(w.w)); }
                VnN[tid2] = sc * Vn[tid2] + s; }
        }
        lds_barrier();
    }
}
DI float gelu_tanh(float x) { const float u = 0.7978845608028654f * (x + 0.044715f * x * x * x); const float e = __expf(2.0f * u); const float th = 1.0f - 2.0f / (e + 1.0f); return 0.5f * x * (1.0f + th); }
DI void unpack8(const v4u w, float (&o)[8]) { o[0] = bflo(w.x); o[1] = bfhi(w.x); o[2] = bflo(w.y); o[3] = bfhi(w.y); o[4] = bflo(w.z); o[5] = bfhi(w.z); o[6] = bflo(w.w); o[7] = bfhi(w.w); }
DI v4u pack8u(const float (&o)[8]) { v4u w; w.x = pk2(o[0], o[1]); w.y = pk2(o[2], o[3]); w.z = pk2(o[4], o[5]); w.w = pk2(o[6], o[7]); return w; }
constexpr int FIN_CST_OFF = 56320;
DI void fin_load_consts(KArgs a, const Ctx& F, int l) {
    LAS float* C = (LAS float*)(F.lds + FIN_CST_OFF);
    for (int i = F.tid; i < 4608; i += NTHR) {
        float v;
        if (i < 2304) v = a->in[I_RCW][(size_t)l * 2304 + i];
        else if (i < 3072) v = a->in[I_RCB][(size_t)l * 768 + (i - 2304)];
        else if (i < 3328) v = a->in[I_RRK][l * 256 + (i - 3072)];
        else if (i < 3584) v = a->in[I_RLNW][l * 256 + (i - 3328)];
        else if (i < 3840) v = a->in[I_RLNB][l * 256 + (i - 3584)];
        else if (i < 4096) v = a->in[I_MNORM][l * 256 + (i - 3840)];
        else if (i < 4352) v = a->in[I_S5D][l * 256 + (i - 4096)];
        else v = a->in[I_S5BGLU][l * 256 + (i - 4352)];
        C[i] = v;
    }
    __syncthreads();
}
DI void fin_tile(KArgs a, const Ctx& F, int l, int tile) {
    const LAS float* CT = (const LAS float*)(F.lds + FIN_CST_OFF);
    const bf16* Z = (const bf16*)(a->ws + WS_ACT); bf16* MO = (bf16*)(a->ws + WS_H);
    const bf16* YS = (const bf16*)(a->ws + WS_YS5); const bf16* YR = (const bf16*)(a->ws + WS_YR); const bf16* YM = (const bf16*)(a->ws + WS_YM);
    const bf16* WGLU = (const bf16*)(a->ws + WS_SMALLW + SW_GLU); const bf16* WGUP = (const bf16*)(a->ws + WS_SMALLW + SW_GUP);
    LAS bf16* Az = (LAS bf16*)F.lds;
    LAS bf16* Ag = (LAS bf16*)(F.lds + 16896);
    LAS float* Pr = (LAS float*)(F.lds + 16896 + 4608);
    int tl_ = F.tid; asm volatile("" : "+v"(tl_));
    const int tid = tl_, lane = tid & 63, wave = F.wave, row0 = tile * 32;
    const int i = tid >> 4, part = tid & 15, row = row0 + i;
    const size_t DS = (size_t)NROWS * 256;
    const bf16* zr = Z + (size_t)row * ZP;
    {
        const LAS float* dsk = CT + 4096 + part * 16;
#pragma unroll
        for (int j = 0; j < 2; ++j) { const int c0 = part * 16 + 8 * j; float y0[8], y1[8], u[8], z[8];
            unpack8(*(const v4u*)(YS + (size_t)row * 256 + c0), y0); unpack8(*(const v4u*)(YS + DS + (size_t)row * 256 + c0), y1); unpack8(*(const v4u*)(zr + ZS5 + c0), u);
#pragma unroll
            for (int e = 0; e < 8; ++e) z[e] = gelu_tanh(y0[e] + y1[e] + dsk[8 * j + e] * u[e]);
            *(LAS v4u*)(Az + i * 264 + c0) = pack8u(z); }
    }
    const int hq = part >> 2, c0 = hq * 64 + (part & 3) * 16;
    const bool lat = row < NLAT; const int t = lat ? (row & (T - 1)) : ((row - NLAT) & (TC - 1)); const int len = lat ? T : TC;
    {
        float y[16]; float s = 0.f;
#pragma unroll
        for (int j = 0; j < 2; ++j) { float y0[8], y1[8]; unpack8(*(const v4u*)(YM + (size_t)row * 256 + c0 + 8 * j), y0); unpack8(*(const v4u*)(YM + DS + (size_t)row * 256 + c0 + 8 * j), y1);
#pragma unroll
            for (int e = 0; e < 8; ++e) { y[8 * j + e] = y0[e] + y1[e]; s += y[8 * j + e]; } }
        s += __shfl_xor(s, 1); s += __shfl_xor(s, 2); const float mu = s * (1.0f / 64.0f); float q = 0.f;
#pragma unroll
        for (int j = 0; j < 16; ++j) { y[j] -= mu; q += y[j] * y[j]; }
        q += __shfl_xor(q, 1); q += __shfl_xor(q, 2); const float rstd = 1.0f / sqrtf(q * (1.0f / 64.0f) + 1e-6f);
        const LAS float* nw = CT + 3840 + c0;
#pragma unroll
        for (int j = 0; j < 2; ++j) { float o[8]; unpack8(*(const v4u*)(zr + ZMO + c0 + 8 * j), o);
#pragma unroll
            for (int e = 0; e < 8; ++e) o[e] = y[8 * j + e] * rstd * nw[8 * j + e] * fsigmoid(o[e]);
            *(v4u*)(MO + (size_t)row * D + 768 + c0 + 8 * j) = pack8u(o); }
    }
    {
        float y[16]; float s = 0.f;
#pragma unroll
        for (int j = 0; j < 2; ++j) { float y0[8], y1[8]; unpack8(*(const v4u*)(YR + (size_t)row * 256 + c0 + 8 * j), y0); unpack8(*(const v4u*)(YR + DS + (size_t)row * 256 + c0 + 8 * j), y1);
#pragma unroll
            for (int e = 0; e < 8; ++e) { y[8 * j + e] = y0[e] + y1[e]; s += y[8 * j + e]; } }
        s += __shfl_xor(s, 1); s += __shfl_xor(s, 2); const float mu = s * (1.0f / 64.0f); float q = 0.f;
#pragma unroll
        for (int j = 0; j < 16; ++j) { y[j] -= mu; q += y[j] * y[j]; }
        q += __shfl_xor(q, 1); q += __shfl_xor(q, 2); const float rstd = 1.0f / sqrtf(q * (1.0f / 64.0f) + 64e-5f);
        const LAS float* cw = CT; const LAS float* cbp = CT + 2304;
        const LAS float* rk = CT + 3072 + c0; const LAS float* lw = CT + 3328 + c0; const LAS float* lb = CT + 3584 + c0;
        float vv[16]; float bs = 0.f;
#pragma unroll
        for (int j = 0; j < 2; ++j) { const int c = c0 + 8 * j;
            float rr[8], kk[8], v[8], x[8];
#pragma unroll
            for (int e = 0; e < 8; ++e) { rr[e] = cbp[c + e]; kk[e] = cbp[256 + c + e]; v[e] = cbp[512 + c + e]; }
#pragma unroll
            for (int tap = 0; tap < 3; ++tap) { const int tt = t - 1 + tap;
                const bool ok = tt >= 0 && tt < len;
                const float okf = ok ? 1.0f : 0.0f;
                const bf16* zp = zr + (ok ? (tap - 1) * ZP : 0) + ZRKV + c;
                unpack8(*(const v4u*)zp, x);
#pragma unroll
                for (int e = 0; e < 8; ++e) rr[e] += (cw[tap * 768 + c + e] * okf) * x[e];
                unpack8(*(const v4u*)(zp + 256), x);
#pragma unroll
                for (int e = 0; e < 8; ++e) kk[e] += (cw[tap * 768 + 256 + c + e] * okf) * x[e];
                unpack8(*(const v4u*)(zp + 512), x);
#pragma unroll
                for (int e = 0; e < 8; ++e) v[e] += (cw[tap * 768 + 512 + c + e] * okf) * x[e]; }
#pragma unroll
            for (int e = 0; e < 8; ++e) { bs += rr[e] * kk[e] * rk[8 * j + e]; vv[8 * j + e] = v[e]; } }
        bs += __shfl_xor(bs, 1); bs += __shfl_xor(bs, 2);
#pragma unroll
        for (int j = 0; j < 16; j += 4) *(LAS f32x4*)(Pr + i * 260 + c0 + j) = (f32x4){y[j] * rstd * lw[j] + lb[j] + bs * vv[j], y[j + 1] * rstd * lw[j + 1] + lb[j + 1] + bs * vv[j + 1], y[j + 2] * rstd * lw[j + 2] + lb[j + 2] + bs * vv[j + 2], y[j + 3] * rstd * lw[j + 3] + lb[j + 3] + bs * vv[j + 3]};
    }
    {
        const v2u gv = *(const v2u*)(zr + ZGD + part * 4);
        v2u o; o.x = pk2(fsigmoid(bflo(gv.x)), fsigmoid(bfhi(gv.x))); o.y = pk2(fsigmoid(bflo(gv.y)), fsigmoid(bfhi(gv.y)));
        *(LAS v2u*)(Ag + i * 72 + part * 4) = o;
    }
    __syncthreads();
    const int lr = lane & 15, kq = lane >> 4;
    {
        f32x4 acc[2][2];
        small_gemm<256, 2, 2, true>(Az, 264, WGLU, 32 * wave, acc, lane);
        const LAS float* bg = CT + 4352;
#pragma unroll
        for (int nb = 0; nb < 2; ++nb)
#pragma unroll
            for (int mb = 0; mb < 2; ++mb) { const int tk = 16 * mb + lr, n = 32 * wave + 16 * nb + 4 * kq; const f32x4 v = acc[nb][mb]; const f32x4 b4 = *(const LAS f32x4*)(bg + n);
                const v2u zz = *(const LAS v2u*)(Az + tk * 264 + n);
                const float o0 = bflo(zz.x) * fsigmoid(v.x + b4.x), o1 = bfhi(zz.x) * fsigmoid(v.y + b4.y), o2 = bflo(zz.y) * fsigmoid(v.z + b4.z), o3 = bfhi(zz.y) * fsigmoid(v.w + b4.w);
                v2u o; o.x = pk2(o0, o1); o.y = pk2(o2, o3);
                *(v2u*)(MO + (size_t)(row0 + tk) * D + n) = o; }
    }
    {
        f32x4 acc[2][2];
        small_gemm<64, 2, 2, true>(Ag, 72, WGUP, 32 * wave, acc, lane);
#pragma unroll
        for (int nb = 0; nb < 2; ++nb)
#pragma unroll
            for (int mb = 0; mb < 2; ++mb) { const int tk = 16 * mb + lr, n = 32 * wave + 16 * nb + 4 * kq; const f32x4 v = acc[nb][mb];
                const f32x4 pr = *(const LAS f32x4*)(Pr + tk * 260 + n);
                v2u o; o.x = pk2(pr.x * v.x, pr.y * v.y); o.y = pk2(pr.z * v.z, pr.w * v.w);
                *(v2u*)(MO + (size_t)(row0 + tk) * D + 512 + n) = o; }
    }
    __syncthreads();
}
#ifndef MK_SPLIT
#define MK_SPLIT 1
#endif
#ifndef MERGE_PREP
#define MERGE_PREP 1
#endif
#ifdef USE_NOINLINE
#define NI static __device__ __noinline__
#else
#define NI static __device__ __forceinline__
#endif
extern __shared__ __attribute__((aligned(16))) unsigned char lds_raw[];
DI Ctx make_ctx(int wave0) {
    Ctx F; F.lds = (LAS uchar*)lds_raw; { int ln_ = __builtin_amdgcn_mbcnt_hi(~0u, __builtin_amdgcn_mbcnt_lo(~0u, 0u)); asm volatile("" : "+v"(ln_)); F.lane = ln_; } F.wave = wave0; F.tid = wave0 * 64 + F.lane;
    F.G = gridDim.x; { int bx = blockIdx.x; asm volatile("" : "+s"(bx)); F.vcu = (F.G % 8 == 0) ? (bx % 8) * (F.G / 8) + bx / 8 : bx; }
    return F;
}
DI void att_subbarrier(unsigned* cnt, unsigned n_att, bool t0) {
    asm volatile("s_waitcnt vmcnt(0)" ::: "memory");
    __syncthreads();
    if (t0) {
        __builtin_amdgcn_fence(__ATOMIC_RELEASE, "agent");
        asm volatile("s_waitcnt vmcnt(0)" ::: "memory");
        (void)xb_add(cnt, 1u);
        unsigned sp = 0u;
        while (xb_ld(cnt) < n_att) { __builtin_amdgcn_s_sleep(1); if (++sp > XB_SPIN_CAP) break; }
        __builtin_amdgcn_fence(__ATOMIC_ACQUIRE, "agent");
        asm volatile("s_waitcnt vmcnt(0)" ::: "memory");
    }
    __syncthreads();
}
NI void ph_prologue(KArgs a_, int wave0) { KArgs a = a_; asm volatile("" : "+s"(a)); const Ctx F = make_ctx(wave0); phase_prologue(a, F); __syncthreads(); }
NI void ph_norm(KArgs a_, int wave0, int l, int kind) { KArgs a = a_; asm volatile("" : "+s"(a));
    const Ctx F = make_ctx(wave0);
    float* modv = (float*)(a->ws + WS_MODV);
    const bool last = (l == DEPTH - 1);
    if (kind == 0) convert_weights(a, F, l, 0);
    if (kind == 1) convert_weights(a, F, l, 1);
    const int lY = (kind == 0) ? (l > 0 ? l - 1 : 0) : l;
    const int gi = (kind == 0 || kind == 3) ? 8 : (kind == 1 ? 2 : 5);
    const int pi = (kind == 0 || kind == 3) ? 2 : (kind == 1 ? 0 : 1);
    const float coef = (kind == 2) ? 1.0f : 0.5f;
    const int si = (kind == 0) ? 0 : (kind == 1 ? 3 : 6);
    const int ni = (kind == 0) ? 0 : (kind == 1 ? 1 : 2);
    const bool first = (kind == 0 && l == 0), hasY = !(kind == 0 && l == 0), hasH = (kind != 3), fin = (kind == 3);
    const int nrows = (kind == 3 || (kind == 2 && last)) ? NLAT : NROWS;
#ifdef DUP_NORM
    if (kind == DUP_NORM && hasY) { norm_rows(a, F, first, hasY, hasH, fin, nrows, modv + (size_t)lY * 9 * MODW, gi, a->in[I_NPOST] + (lY * 3 + pi) * D, coef, modv + (size_t)l * 9 * MODW, si, a->in[I_NPRE] + (l * 3 + ni) * D, true); __syncthreads(); }
#endif
    norm_rows(a, F, first, hasY, hasH, fin, nrows, modv + (size_t)lY * 9 * MODW, gi, a->in[I_NPOST] + (lY * 3 + pi) * D, coef, modv + (size_t)l * 9 * MODW, si, a->in[I_NPRE] + (l * 3 + ni) * D);
    __syncthreads();
}
NI void ph_gemm_swiglu(KArgs a_, int wave0, int M) { KArgs a = a_; asm volatile("" : "+s"(a));
    const Ctx F = make_ctx(wave0);
    pg8::Gemm g{(const bf16*)(a->ws + WS_H), (const bf16*)(a->ws + WS_WGU), M, 2 * FF, D}; pg8::StaticOrder S; S.init(M, 2 * FF, F.G, (int)blockIdx.x);
    pg8::EpiSwiGLU E{(bf16*)(a->ws + WS_ACT), FF};
    pg8::gemm_phase<pg8::EpiSwiGLU, pg8::StaticOrder, PG8_ALIGN, PG8_SP2>(F.lds, g, S, E, F.tid);
}
NI void ph_gemm_store(KArgs a_, int wave0, int which, int M) { KArgs a = a_; asm volatile("" : "+s"(a));
    const Ctx F = make_ctx(wave0);
    const bf16* A = (const bf16*)(a->ws + (which == 0 ? WS_ACT : WS_H));
    const bf16* W = (const bf16*)(a->ws + (which == 0 ? WS_WDN : which == 1 ? WS_WIN : WS_WOUT));
    const int N = which == 1 ? ZPAD : D, K = which == 0 ? FF : D;
    const bool split_ctx = (which != 1) && (M == NROWS);
    const int Mg = split_ctx ? NLAT : M;
    pg8::Gemm g{A, W, Mg, N, K}; pg8::StaticOrder S; S.init(Mg, N, F.G, (int)blockIdx.x);
    pg8::EpiStore E{(bf16*)(a->ws + (which == 1 ? WS_ACT : WS_Y)), which == 1 ? ZP : D, which == 1 ? ZP : D};
    pg8::gemm_phase<pg8::EpiStore, pg8::StaticOrder, PG8_ALIGN, PG8_SP2>(F.lds, g, S, E, F.tid);
    if (split_ctx) { __syncthreads(); ctx_gemm_block(F, A, W, K, (bf16*)(a->ws + WS_Y)); }
}
NI void ph_mla_prep(KArgs a_, int wave0, int l, int first, int stride) { KArgs a = a_; asm volatile("" : "+s"(a)); const Ctx F = make_ctx(wave0); for (int tile = first; tile < NROWS / 64; tile += stride) mla_prep_tile(a, F, l, tile); }
NI void ph_rwkv(KArgs a_, int wave0, int l, int v) { KArgs a = a_; asm volatile("" : "+s"(a)); const Ctx F = make_ctx(wave0); rwkv_scan_task(a, F, l, v >> 3, (v >> 1) & 3, v & 1); }
NI void ph_mlstm(KArgs a_, int wave0, int l, int idx) { KArgs a = a_; asm volatile("" : "+s"(a)); const Ctx F = make_ctx(wave0); mlstm_task(a, F, l, idx >> 2, idx & 3); __syncthreads(); }
NI void ph_s5(KArgs a_, int wave0, int l, int wg) { KArgs a = a_; asm volatile("" : "+s"(a)); const Ctx F = make_ctx(wave0); const int tk = wg * 8 + F.wave; s5_scan_task(a, l, tk >> 5, (tk >> 4) & 1, tk & 15, (LAS bf16*)(F.lds + F.wave * 8704), F.lane); __syncthreads(); }
NI void ph_attn(KArgs a_, int wave0, int first, int stride) { KArgs a = a_; asm volatile("" : "+s"(a));
    const Ctx F = make_ctx(wave0);
    for (int u = first; u < 512 + 32; u += stride) {
        if (u < 512) { const int b = u >> 6, hd = (u >> 4) & 3, qb = u & 15; attn_unit(a, F, b, hd, b * T + qb * 256, NKEY); }
        else { const int c = u - 512, b = c >> 2, hd = c & 3; attn_unit(a, F, b, hd, NLAT + b * TC, TC); }
    }
}
NI void ph_fin(KArgs a_, int wave0, int l, int M) { KArgs a = a_; asm volatile("" : "+s"(a)); const Ctx F = make_ctx(wave0); fin_load_consts(a, F, l); for (int tile = F.vcu; tile < M / 32; tile += F.G) fin_tile(a, F, l, tile); }


#ifdef DBG_CUT
NI void ph_dump(KArgs a_, int wave0) { KArgs a = a_; asm volatile("" : "+s"(a)); const Ctx F = make_ctx(wave0);
    const float* X = (const float*)(a->ws + WS_X); const bf16* Z = (const bf16*)(a->ws + WS_ACT); const bf16* Q = (const bf16*)(a->ws + WS_Q); const bf16* Kf = (const bf16*)(a->ws + WS_K); const bf16* Vt = (const bf16*)(a->ws + WS_VT);
    const bf16* YS = (const bf16*)(a->ws + WS_YS5); const bf16* YR = (const bf16*)(a->ws + WS_YR); const bf16* YM = (const bf16*)(a->ws + WS_YM); const bf16* MO = (const bf16*)(a->ws + WS_H); const bf16* Y = (const bf16*)(a->ws + WS_Y);
    const size_t DS = (size_t)NROWS * 256;
    for (size_t i = (size_t)F.vcu * NTHR + F.tid; i < (size_t)NLAT * D; i += (size_t)F.G * NTHR) {
#ifdef DBG_CTX
        const size_t r = NLAT + ((i >> 10) % NCTX);
#else
        const size_t r = i >> 10;
#endif
        const int c = (int)(i & 1023); float v = 0.f;
        if (DBG_WHICH & 1) v += X[r * D + c];
        if (DBG_WHICH & 2) { v += bf2f(Z[r * ZP + c]) + bf2f(Z[r * ZP + 1024 + c]); if (c + 2048 < ZP) v += bf2f(Z[r * ZP + 2048 + c]); }
        if (DBG_WHICH & 4) { v += bf2f(Q[r * 384 + c % 384]) + bf2f(Kf[r * 384 + c % 384]) + bf2f(Vt[i % ((size_t)NB * 4 * 64 * NKEY)]); }
        if (DBG_WHICH & 256) v += bf2f(Q[r * 384 + c % 384]);
        if (DBG_WHICH & 512) v += bf2f(Kf[r * 384 + c % 384]);
        if (DBG_WHICH & 1024) v += bf2f(Vt[i % ((size_t)NB * 4 * 64 * NKEY)]);
        if (DBG_WHICH & 2048) { const float* rc = (const float*)(a->ws + WS_ROPE); const bf16* sw = (const bf16*)(a->ws + WS_SMALLW); v += rc[i % (T * 32)] + bf2f(sw[i % 245760]); }
        if (DBG_WHICH & 8) v += bf2f(YS[r * 256 + (c & 255)]) + bf2f(YS[DS + r * 256 + (c & 255)]);
        if (DBG_WHICH & 16) v += bf2f(YR[r * 256 + (c & 255)]) + bf2f(YR[DS + r * 256 + (c & 255)]);
        if (DBG_WHICH & 32) v += bf2f(YM[r * 256 + (c & 255)]) + bf2f(YM[DS + r * 256 + (c & 255)]);
        if (DBG_WHICH & 64) v += bf2f(MO[r * D + c]);
        if (DBG_WHICH & 128) v += bf2f(Y[r * D + c]);
        a->out[i] = v;
    }
}
#endif
#if !MK_SPLIT
#if defined(ONLY_PH)
#define PHON(k) ((k) == ONLY_PH)
#elif defined(NO_PH)
#define PHON(k) ((k) != NO_PH)
#else
#define PHON(k) true
#endif
#if defined(ONLY_ROLE)
#define ROLE(k) ((k) == ONLY_ROLE)
#elif defined(NO_ROLE)
#define ROLE(k) ((k) != NO_ROLE)
#else
#define ROLE(k) true
#endif
#ifdef DUP_BAR
#define DUPBAR(x) x
#else
#define DUPBAR(x)
#endif
#ifdef DUP_ROLE
#ifndef DUP_N
#define DUP_N 2
#endif
#define NREPR(k) ((k) == DUP_ROLE ? DUP_N : 1)
#else
#define NREPR(k) 1
#endif
#ifdef DUP_PH
#define NREP(k) ((k) == DUP_PH ? 2 : 1)
#else
#define NREP(k) 1
#endif
constexpr int NPH = 2 + 12 * DEPTH;
__global__ void __launch_bounds__(NTHR, 2) hybrid_fwd(Args args_byval) {
    KArgs a = (KArgs)__builtin_amdgcn_kernarg_segment_ptr();
    LAS uchar* lds = (LAS uchar*)lds_raw;
    const int tid = threadIdx.x; const int wave0 = __builtin_amdgcn_readfirstlane(tid >> 6);
    volatile LAS unsigned* MISC = (volatile LAS unsigned*)(lds + MISC_OFF);
    for (int u = tid; u < (LDS_BYTES - LDSCTL_OFF) / 4; u += NTHR) ((LAS unsigned*)(lds + LDSCTL_OFF))[u] = 0u;
    __syncthreads();
    unsigned* ctl = (unsigned*)(a->ws + WS_CTL);
    const int use_bar = a->use_bar;
    XcdBarrier bar; bar.bar = ctl + CW_BAR; bar.x = 0; bar.st = nullptr;
    if (use_bar) bar = xcd_barrier_post(ctl + CW_BAR, MISC + 8, tid == 0);
    const int lo = a->ph_lo, hi = a->ph_hi;
    const int G = gridDim.x; const int vcu = (G % 8 == 0) ? ((int)blockIdx.x % 8) * (G / 8) + (int)blockIdx.x / 8 : (int)blockIdx.x;
#ifdef DBG_CUT
#define IN(k) (lo <= (k) && (k) < hi && (k) < DBG_CUT)
#else
#define IN(k) (lo <= (k) && (k) < hi)
#endif
#define SEAM(k) do { if (use_bar && IN(k) && IN((k) + 1)) { int ln_ = __builtin_amdgcn_mbcnt_hi(~0u, __builtin_amdgcn_mbcnt_lo(~0u, 0u)); asm volatile("" : "+v"(ln_)); xcd_barrier(bar, wave0 == 0 && ln_ == 0); DUPBAR(xcd_barrier(bar, wave0 == 0 && ln_ == 0);) } } while (0)
    if (PHON(100) && IN(0)) ph_prologue(a, wave0);
    SEAM(0);
#pragma unroll 1
    for (int l = 0; l < DEPTH; ++l) {
        const int P = 1 + 12 * l;
        const int Mtail = (l == DEPTH - 1) ? NLAT : NROWS;
        if (PHON(0) && IN(P + 0)) { ph_norm(a, wave0, l, 0);
#ifdef DUP_FIRSTNORM
            if (l == 0) for (int rr_ = 0; rr_ < DUP_FIRSTNORM; ++rr_) ph_norm(a, wave0, l, 0);
#endif
        }
        SEAM(P + 0);
        if (PHON(1) && IN(P + 1)) for (int rep_ = 0; rep_ < NREP(1); ++rep_) ph_gemm_swiglu(a, wave0, NROWS);
        SEAM(P + 1);
        if (PHON(2) && IN(P + 2)) for (int rep_ = 0; rep_ < NREP(2); ++rep_) ph_gemm_store(a, wave0, 0, NROWS);
        SEAM(P + 2);
        if (PHON(3) && IN(P + 3)) ph_norm(a, wave0, l, 1);
        SEAM(P + 3);
        if (PHON(4) && IN(P + 4)) for (int rep_ = 0; rep_ < NREP(4); ++rep_) ph_gemm_store(a, wave0, 1, NROWS);
        SEAM(P + 4);
#if MERGE_PREP
        if (PHON(6) && IN(P + 6) && G >= 256) {
            if (ROLE(0) && vcu < 64) { for (int rr_ = 0; rr_ < NREPR(0); ++rr_) ph_rwkv(a, wave0, l, vcu); }
            else if (ROLE(1) && vcu < 96) { for (int rr_ = 0; rr_ < NREPR(1); ++rr_) ph_mlstm(a, wave0, l, vcu - 64); }
            else if (ROLE(2) && vcu < 128) { for (int rr_ = 0; rr_ < NREPR(2); ++rr_) ph_s5(a, wave0, l, vcu - 96); }
            else if (ROLE(3)) {
                ph_mla_prep(a, wave0, l, vcu - 128, G - 128);
                { int ln_ = __builtin_amdgcn_mbcnt_hi(~0u, __builtin_amdgcn_mbcnt_lo(~0u, 0u)); asm volatile("" : "+v"(ln_)); att_subbarrier(ctl + CW_SUB + 64 * l, (unsigned)(G - 128), wave0 == 0 && ln_ == 0); }
                for (int rr_ = 0; rr_ < NREPR(3); ++rr_) ph_attn(a, wave0, vcu - 128, G - 128);
            }
        }
#else
        if (PHON(5) && IN(P + 5)) for (int rep_ = 0; rep_ < NREP(5); ++rep_) ph_mla_prep(a, wave0, l);
        SEAM(P + 5);
        if (PHON(6) && IN(P + 6) && G >= 256) for (int rep_ = 0; rep_ < NREP(6); ++rep_) {
            if (ROLE(0) && vcu < 64) { for (int rr_ = 0; rr_ < NREPR(0); ++rr_) ph_rwkv(a, wave0, l, vcu); }
            else if (ROLE(1) && vcu < 96) { for (int rr_ = 0; rr_ < NREPR(1); ++rr_) ph_mlstm(a, wave0, l, vcu - 64); }
            else if (ROLE(2) && vcu < 128) { for (int rr_ = 0; rr_ < NREPR(2); ++rr_) ph_s5(a, wave0, l, vcu - 96); }
            else if (ROLE(3)) { for (int rr_ = 0; rr_ < NREPR(3); ++rr_) ph_attn(a, wave0, vcu - 128, G - 128); }
        }
#endif
        SEAM(P + 6);
        if (PHON(7) && IN(P + 7)) for (int rep_ = 0; rep_ < NREP(7); ++rep_) ph_fin(a, wave0, l, Mtail);
        SEAM(P + 7);
        if (PHON(8) && IN(P + 8)) for (int rep_ = 0; rep_ < NREP(8); ++rep_) ph_gemm_store(a, wave0, 2, Mtail);
        SEAM(P + 8);
        if (PHON(9) && IN(P + 9)) ph_norm(a, wave0, l, 2);
        SEAM(P + 9);
        if (PHON(10) && IN(P + 10)) ph_gemm_swiglu(a, wave0, Mtail);
        SEAM(P + 10);
        if (PHON(11) && IN(P + 11)) ph_gemm_store(a, wave0, 0, Mtail);
        SEAM(P + 11);
    }
#ifdef DBG_CUT
    if (lo <= NPH - 1 && NPH - 1 < hi) ph_dump(a, wave0);
#else
    if (PHON(101) && IN(NPH - 1)) ph_norm(a, wave0, DEPTH - 1, 3);
#endif
#undef IN
#undef SEAM
}

#endif
#if MK_SPLIT
struct ArgsS { Args base; int kind, l, sub, M; };
typedef const __attribute__((address_space(4))) ArgsS* KArgsS;
template <int KIND>
__global__ void __launch_bounds__(NTHR, 2) phase_kernel(ArgsS args_byval) {
    KArgsS as = (KArgsS)__builtin_amdgcn_kernarg_segment_ptr();
    KArgs a = (KArgs)as;
    const int tid = threadIdx.x; const int wave0 = __builtin_amdgcn_readfirstlane(tid >> 6);
    const int l = as->l, sub = as->sub, M = as->M;
    const int G = gridDim.x; const int vcu = (G % 8 == 0) ? ((int)blockIdx.x % 8) * (G / 8) + (int)blockIdx.x / 8 : (int)blockIdx.x;
    if constexpr (KIND == 0) ph_prologue(a, wave0);
    if constexpr (KIND == 1) ph_norm(a, wave0, l, sub);
    if constexpr (KIND == 2) ph_gemm_swiglu(a, wave0, M);
    if constexpr (KIND == 3) ph_gemm_store(a, wave0, sub, M);
    if constexpr (KIND == 4) ph_mla_prep(a, wave0, l, vcu, G);
    if constexpr (KIND == 5) { if (vcu < 64) ph_rwkv(a, wave0, l, vcu); }
    if constexpr (KIND == 6) { if (vcu >= 64 && vcu < 96) ph_mlstm(a, wave0, l, vcu - 64); }
    if constexpr (KIND == 7) { if (vcu >= 96 && vcu < 128) ph_s5(a, wave0, l, vcu - 96); }
    if constexpr (KIND == 8) { if (vcu >= 128) ph_attn(a, wave0, vcu - 128, G - 128); }
    if constexpr (KIND == 9) ph_fin(a, wave0, l, M);
}
template <int KIND> static void launch_phase(int grid, hipStream_t stream, const Args& base, int l, int sub, int M) {
    static bool attr = false;
    if (!attr) { (void)hipFuncSetAttribute((const void*)phase_kernel<KIND>, hipFuncAttributeMaxDynamicSharedMemorySize, LDS_BYTES); attr = true; }
    ArgsS s{}; s.base = base; s.kind = KIND; s.l = l; s.sub = sub; s.M = M;
    hipLaunchKernelGGL(phase_kernel<KIND>, dim3(grid), dim3(NTHR), LDS_BYTES, stream, s);
}
static void launch_split(int grid, hipStream_t stream, const Args& a) {
    launch_phase<0>(grid, stream, a, 0, 0, 0);
    for (int l = 0; l < DEPTH; ++l) {
        const int Mtail = (l == DEPTH - 1) ? NLAT : NROWS;
        launch_phase<1>(grid, stream, a, l, 0, 0);
        launch_phase<2>(grid, stream, a, l, 0, NROWS);
        launch_phase<3>(grid, stream, a, l, 0, NROWS);
        launch_phase<1>(grid, stream, a, l, 1, 0);
        launch_phase<3>(grid, stream, a, l, 1, NROWS);
        launch_phase<4>(grid, stream, a, l, 0, 0);
        launch_phase<5>(grid, stream, a, l, 0, 0);
        launch_phase<6>(grid, stream, a, l, 0, 0);
        launch_phase<7>(grid, stream, a, l, 0, 0);
        launch_phase<8>(grid, stream, a, l, 0, 0);
        launch_phase<9>(grid, stream, a, l, 0, Mtail);
        launch_phase<3>(grid, stream, a, l, 2, Mtail);
        launch_phase<1>(grid, stream, a, l, 2, 0);
        launch_phase<2>(grid, stream, a, l, 0, Mtail);
        launch_phase<3>(grid, stream, a, l, 0, Mtail);
    }
    launch_phase<1>(grid, stream, a, DEPTH - 1, 3, 0);
}
#endif
extern "C" void kernel_launch(void* const* d_in, const int* in_sizes, int n_in, void* d_out, int out_size, void* d_ws, size_t ws_size, hipStream_t stream) {
    static int grid = 0;
    if (grid == 0) {
        if (n_in != 43 || out_size != NLAT * D || ws_size < WS_END) { fprintf(stderr, "kernel_launch: unexpected shapes: n_in %d out %d ws %zu (need %zu)\n", n_in, out_size, ws_size, (size_t)WS_END); grid = -1; return; }
        int dev = 0, cus = 0, per_cu = 0;
        if (hipGetDevice(&dev) != hipSuccess || hipDeviceGetAttribute(&cus, hipDeviceAttributeMultiprocessorCount, dev) != hipSuccess) { grid = -1; return; }
        if (false) { grid = -1; return; }
        (void)hipGetLastError();
        grid = cus;
    }
    if (grid < 0) return;
    (void)hipMemsetAsync((char*)d_ws + WS_CTL, 0, CTL_ZERO_BYTES, stream);
    Args a{};
    for (int i = 0; i < 43; ++i) a.in[i] = (const float*)d_in[i];
    a.out = (float*)d_out; a.ws = (unsigned char*)d_ws; a.pad = 0;
#if MK_SPLIT
    launch_split(grid, stream, a);
#else
    static bool attr1 = false; if (!attr1) { (void)hipFuncSetAttribute((const void*)hybrid_fwd, hipFuncAttributeMaxDynamicSharedMemorySize, LDS_BYTES); attr1 = true; }
    a.ph_lo = 0; a.ph_hi = NPH; a.use_bar = 1;
    hipLaunchKernelGGL(hybrid_fwd, dim3(grid), dim3(NTHR), LDS_BYTES, stream, a);
#endif
}
```

```cpp
#include <hip/hip_runtime.h>
#include <cstdio>
#include <cstdint>
#define MK_SPLIT 0
namespace pg8 {
#define PG8_LAS __attribute__((address_space(3)))
typedef unsigned short bf16_t;
typedef short bf16x8 __attribute__((ext_vector_type(8)));
typedef float f32x4 __attribute__((ext_vector_type(4)));
typedef unsigned u32x4 __attribute__((ext_vector_type(4)));
constexpr int BM = 256, BK = 64, HALF = 128, HTB = HALF * BK * 2  , STAGE_BYTES = 8 * HTB, NXCD = 8, WGM = 8;

__host__ __device__ __forceinline__ int lds_byte(int r, int c) { const int st = (r >> 4) * 2 + (c >> 5), rr = r & 15, cc = c & 31, ob = rr * 64 + cc * 2; return st * 1024 + (ob ^ (((ob >> 9) & 1) << 5)); }
__host__ __device__ __forceinline__ void stage_rc(int b, int& R, int& C) { const int st = b / 1024, sb = b % 1024, swz = sb ^ (((sb >> 9) & 1) << 5); R = (st >> 1) * 16 + swz / 64; C = (st & 1) * 32 + (swz % 64) / 2; }
__host__ __device__ __forceinline__ int perm32(int rho) { const int n = rho >> 4, i = rho & 15; return 8 * (i >> 2) + 4 * n + (i & 3); }

struct Unit { int pm, pn; };
struct Gemm { const bf16_t* A; const bf16_t* Bt; int M, N, K; };

struct StaticOrder {
    int nM, nN, nwg, G, c;
    __host__ __device__ void init(int M, int N, int G_, int c_) { nM = M / BM; nN = N / BM; nwg = nM * nN; G = G_; c = c_; }
    __host__ __device__ bool next(int i, Unit& u) const {
        const long L = (long)i * G + c; if (L >= nwg) return false;
        int wgid = (int)L; { const int q = nwg / NXCD, r = nwg % NXCD, xcd = wgid % NXCD, off = wgid / NXCD; wgid = (xcd < r ? xcd * (q + 1) : r * (q + 1) + (xcd - r) * q) + off; }
        const int nig = WGM * nN, gid = wgid / nig, fm = gid * WGM, gsz = (nM - fm) < WGM ? (nM - fm) : WGM;
        u.pm = fm + ((wgid % nig) % gsz); u.pn = (wgid % nig) / gsz; return true;
    }
    __device__ __forceinline__ void a_ready(const Unit&) const {}
    __device__ __forceinline__ void done(const Unit&) const {}
};

typedef __bf16 nbf16v2 __attribute__((ext_vector_type(2))); typedef float nf32v2 __attribute__((ext_vector_type(2)));
__device__ __forceinline__ unsigned cvt_pk_bf16(float lo, float hi) { const nf32v2 v = {lo, hi}; return __builtin_bit_cast(unsigned, __builtin_convertvector(v, nbf16v2)); }
struct EpiSwiGLU {
    static constexpr bool PERM = true, AFTER_DRAIN = false;
    bf16_t* O; int ldc;
    __device__ __forceinline__ void operator()(const f32x4 (&acc)[2][2][4][2], const Unit& u, int wr, int wc, int fr, int fq) const {
        const int row0 = u.pm * BM + wr * 64 + fr; const int col0 = u.pn * HALF + wc * 32 + 8 * fq;
#pragma unroll
        for (int ai = 0; ai < 2; ++ai)
#pragma unroll
            for (int m = 0; m < 4; ++m) { bf16_t* rowp = O + (size_t)(row0 + ai * HALF + m * 16) * ldc + col0;
                float o[8];
#pragma unroll
                for (int n = 0; n < 2; ++n)
#pragma unroll
                    for (int j = 0; j < 4; ++j) { const float g = acc[ai][0][m][n][j], up = acc[ai][1][m][n][j];
                        const float sg = __builtin_amdgcn_rcpf(1.0f + __builtin_amdgcn_exp2f(-1.44269504089f * g)); o[n * 4 + j] = g * sg * up; }
                u32x4 w; w.x = cvt_pk_bf16(o[0], o[1]); w.y = cvt_pk_bf16(o[2], o[3]); w.z = cvt_pk_bf16(o[4], o[5]); w.w = cvt_pk_bf16(o[6], o[7]);
                *(u32x4*)rowp = w; }
    }
};
struct EpiStore {
    static constexpr bool PERM = true, AFTER_DRAIN = false;
    bf16_t* O; int ldc; int ncols;
    __device__ __forceinline__ void operator()(const f32x4 (&acc)[2][2][4][2], const Unit& u, int wr, int wc, int fr, int fq) const {
        const int row0 = u.pm * BM + wr * 64 + fr; const int col0 = u.pn * BM + wc * 32 + 8 * fq;
#pragma unroll
        for (int ai = 0; ai < 2; ++ai)
#pragma unroll
            for (int m = 0; m < 4; ++m) { bf16_t* rowp = O + (size_t)(row0 + ai * HALF + m * 16) * ldc + col0;
#pragma unroll
                for (int bj = 0; bj < 2; ++bj) { if (col0 + bj * HALF < ncols) { const f32x4 v0 = acc[ai][bj][m][0], v1 = acc[ai][bj][m][1];
                    u32x4 w; w.x = cvt_pk_bf16(v0[0], v0[1]); w.y = cvt_pk_bf16(v0[2], v0[3]); w.z = cvt_pk_bf16(v1[0], v1[1]); w.w = cvt_pk_bf16(v1[2], v1[3]);
                    *(u32x4*)(rowp + bj * HALF) = w; } } }
    }
};
template <class Epi, class Sched, bool ALIGN_EPI = false, bool SP2 = false>
__device__ __forceinline__ void gemm_phase(PG8_LAS unsigned char* lds, const Gemm g, const Sched& S, const Epi& E, const int tid) {
    const int wid = __builtin_amdgcn_readfirstlane(tid >> 6), lane = tid & 63, wr = wid >> 2, wc = wid & 3, fr = lane & 15, fq = lane >> 4;
    const int K = g.K, nt = K / BK;
    unsigned voffA[2], voffB[2];
#pragma unroll
    for (int i = 0; i < 2; ++i) { int R, C; stage_rc(tid * 16 + i * 8192, R, C); const int Rb = Epi::PERM ? ((R & ~31) + perm32(R & 31)) : R;
        voffA[i] = (unsigned)(R * K + C) * 2u; voffB[i] = (unsigned)(Rb * K + C) * 2u; }
    const size_t kstep = (size_t)(BK * 2);
    const size_t hstep = (size_t)HALF * K * 2;
    const size_t tstep = 2 * hstep;
    const unsigned ldsw = (unsigned)wid * 1024u;
    const int aoff = lds_byte(wr * 64 + fr, fq * 8), boff = lds_byte(wc * 32 + fr, fq * 8);
#define PG8_SA(b, h) (((b) * 2 + (h)) * HTB)
#define PG8_SB(b, h) ((4 + (b) * 2 + (h)) * HTB)
#define PG8_STAGE(bufoff, gbase, voff) do { _Pragma("unroll") for (int _i = 0; _i < 2; ++_i) \
        __builtin_amdgcn_global_load_lds((const unsigned*)((const char*)(gbase) + (voff)[_i]), (PG8_LAS unsigned*)(lds + (bufoff) + ldsw + _i * 8192), 16, 0, 0); } while (0)
#define PG8_LDA(dst, b, h) do { _Pragma("unroll") for (int m = 0; m < 4; ++m) _Pragma("unroll") for (int k = 0; k < 2; ++k) dst[m][k] = *(const PG8_LAS bf16x8*)(lds + PG8_SA(b, h) + aoff + m * 2048 + k * 1024); } while (0)
#define PG8_LDB(dst, b, h) do { _Pragma("unroll") for (int n = 0; n < 2; ++n) _Pragma("unroll") for (int k = 0; k < 2; ++k) dst[n][k] = *(const PG8_LAS bf16x8*)(lds + PG8_SB(b, h) + boff + n * 2048 + k * 1024); } while (0)
#define PG8_MMA(ai, bj, At, Bt) do { __builtin_amdgcn_s_setprio(1); _Pragma("unroll") for (int m = 0; m < 4; ++m) _Pragma("unroll") for (int n = 0; n < 2; ++n) _Pragma("unroll") for (int k = 0; k < 2; ++k) \
        acc[ai][bj][m][n] = __builtin_amdgcn_mfma_f32_16x16x32_bf16(Bt[n][k], At[m][k], acc[ai][bj][m][n], 0, 0, 0); __builtin_amdgcn_s_setprio(0); } while (0)
#define PG8_WAIT_V(n) asm volatile("s_waitcnt vmcnt(" #n ")" ::: "memory")
#define PG8_WAIT_L(n) asm volatile("s_waitcnt lgkmcnt(" #n ")" ::: "memory")
#define PG8_BAR __builtin_amdgcn_s_barrier()
#define PG8_SCHED __builtin_amdgcn_sched_barrier(0)
    Unit cur, nxt; int ui = 0;
    if (!S.next(0, cur)) return;
    f32x4 acc[2][2][4][2];
#pragma unroll
    for (int a = 0; a < 2; ++a)
#pragma unroll
        for (int b = 0; b < 2; ++b)
#pragma unroll
            for (int m = 0; m < 4; ++m)
#pragma unroll
                for (int n = 0; n < 2; ++n) acc[a][b][m][n] = (f32x4){0.f, 0.f, 0.f, 0.f};
    bf16x8 At[4][2], B0[2][2], B1[2][2];
    const char* cA = (const char*)g.A + (size_t)cur.pm * tstep; const char* cB = (const char*)g.Bt + (size_t)cur.pn * tstep;
    S.a_ready(cur);
    if constexpr (SP2) {
        PG8_STAGE(PG8_SB(0, 0), cB, voffB); PG8_STAGE(PG8_SB(0, 1), cB + hstep, voffB); PG8_STAGE(PG8_SA(0, 0), cA, voffA); PG8_STAGE(PG8_SA(0, 1), cA + hstep, voffA);
        if (wr == 1) PG8_BAR;
        PG8_WAIT_V(2); PG8_BAR;
        PG8_STAGE(PG8_SB(1, 0), cB + kstep, voffB); PG8_STAGE(PG8_SA(1, 0), cA + kstep, voffA); PG8_STAGE(PG8_SB(1, 1), cB + hstep + kstep, voffB);
        PG8_WAIT_V(6); PG8_BAR;
    } else {
        PG8_STAGE(PG8_SB(0, 0), cB, voffB); PG8_STAGE(PG8_SA(0, 0), cA, voffA); PG8_STAGE(PG8_SB(0, 1), cB + hstep, voffB); PG8_STAGE(PG8_SA(0, 1), cA + hstep, voffA);
        if (wr == 1) PG8_BAR;
        PG8_WAIT_V(4); PG8_BAR;
        PG8_STAGE(PG8_SB(1, 0), cB + kstep, voffB); PG8_STAGE(PG8_SA(1, 0), cA + kstep, voffA); PG8_STAGE(PG8_SB(1, 1), cB + hstep + kstep, voffB);
        PG8_WAIT_V(6); PG8_BAR;
    }
    for (;;) {
        const bool has_next = S.next(ui + 1, nxt);
        const char* nA = has_next ? (const char*)g.A + (size_t)nxt.pm * tstep : cA; const char* nB = has_next ? (const char*)g.Bt + (size_t)nxt.pn * tstep : cB;
        for (int t = 0; t < nt; t += 2) {
            const bool last = (t == nt - 2);
            const char* a1 = cA + (size_t)(t + 1) * kstep;
            const char* a2 = last ? nA : cA + (size_t)(t + 2) * kstep; const char* b2 = last ? nB : cB + (size_t)(t + 2) * kstep;
            const char* a3 = a2 + kstep; const char* b3 = b2 + kstep;
            if (last && has_next) S.a_ready(nxt);
            if constexpr (SP2) {
            PG8_LDB(B0, 0, 0); PG8_LDB(B1, 0, 1); PG8_SCHED; PG8_LDA(At, 0, 0); PG8_STAGE(PG8_SA(1, 1), a1 + hstep, voffA);
            PG8_WAIT_V(8); PG8_WAIT_L(0); PG8_BAR; PG8_MMA(0, 0, At, B0); PG8_MMA(0, 1, At, B1); PG8_BAR; PG8_SCHED;
            PG8_LDA(At, 0, 1); PG8_STAGE(PG8_SB(0, 0), b2, voffB); PG8_STAGE(PG8_SB(0, 1), b2 + hstep, voffB); PG8_STAGE(PG8_SA(0, 0), a2, voffA);
            PG8_WAIT_V(8); PG8_WAIT_L(0); PG8_BAR; PG8_MMA(1, 0, At, B0); PG8_MMA(1, 1, At, B1); PG8_BAR; PG8_SCHED;
            PG8_LDB(B0, 1, 0); PG8_LDB(B1, 1, 1); PG8_SCHED; PG8_LDA(At, 1, 0); PG8_STAGE(PG8_SA(0, 1), a2 + hstep, voffA);
            PG8_WAIT_V(8); PG8_WAIT_L(0); PG8_BAR; PG8_MMA(0, 0, At, B0); PG8_MMA(0, 1, At, B1); PG8_BAR; PG8_SCHED;
            PG8_LDA(At, 1, 1); PG8_STAGE(PG8_SB(1, 0), b3, voffB); PG8_STAGE(PG8_SB(1, 1), b3 + hstep, voffB); PG8_STAGE(PG8_SA(1, 0), a3, voffA);
            PG8_WAIT_V(8); PG8_WAIT_L(0); PG8_BAR; PG8_MMA(1, 0, At, B0); PG8_MMA(1, 1, At, B1); PG8_BAR; PG8_SCHED;
            } else {
            PG8_LDB(B0, 0, 0); PG8_SCHED; PG8_LDA(At, 0, 0); PG8_STAGE(PG8_SA(1, 1), a1 + hstep, voffA);
            PG8_WAIT_L(8); PG8_BAR; PG8_WAIT_L(0); PG8_MMA(0, 0, At, B0); PG8_BAR; PG8_SCHED;
            PG8_LDB(B1, 0, 1); PG8_STAGE(PG8_SB(0, 0), b2, voffB);
            PG8_BAR; PG8_WAIT_L(0); PG8_MMA(0, 1, At, B1); PG8_BAR;
            PG8_LDA(At, 0, 1); PG8_STAGE(PG8_SA(0, 0), a2, voffA);
            PG8_BAR; PG8_WAIT_L(0); PG8_MMA(1, 0, At, B0); PG8_BAR; PG8_SCHED;
            PG8_STAGE(PG8_SB(0, 1), b2 + hstep, voffB);
            PG8_WAIT_V(6); PG8_BAR; PG8_MMA(1, 1, At, B1); PG8_BAR;
            PG8_LDB(B0, 1, 0); PG8_SCHED; PG8_LDA(At, 1, 0); PG8_STAGE(PG8_SA(0, 1), a2 + hstep, voffA);
            PG8_WAIT_L(8); PG8_BAR; PG8_WAIT_L(0); PG8_MMA(0, 0, At, B0); PG8_BAR; PG8_SCHED;
            PG8_LDB(B1, 1, 1); PG8_STAGE(PG8_SB(1, 0), b3, voffB);
            PG8_BAR; PG8_WAIT_L(0); PG8_MMA(0, 1, At, B1); PG8_BAR;
            PG8_LDA(At, 1, 1); PG8_STAGE(PG8_SA(1, 0), a3, voffA);
            PG8_BAR; PG8_WAIT_L(0); PG8_MMA(1, 0, At, B0); PG8_BAR; PG8_SCHED;
            PG8_STAGE(PG8_SB(1, 1), b3 + hstep, voffB);
            PG8_WAIT_V(6); PG8_BAR; PG8_MMA(1, 1, At, B1); PG8_BAR;
            }
        }
        if constexpr (ALIGN_EPI) { if (wr == 0) PG8_BAR; }
        if constexpr (!Epi::AFTER_DRAIN) { E(acc, cur, wr, wc, fr, fq); S.done(cur); }
        if (!has_next) break;
#pragma unroll
        for (int a = 0; a < 2; ++a)
#pragma unroll
            for (int b = 0; b < 2; ++b)
#pragma unroll
                for (int m = 0; m < 4; ++m)
#pragma unroll
                    for (int n = 0; n < 2; ++n) acc[a][b][m][n] = (f32x4){0.f, 0.f, 0.f, 0.f};
        cur = nxt; cA = nA; cB = nB; ++ui;
        if constexpr (ALIGN_EPI) { if (wr == 1) PG8_BAR; }
    }
    PG8_WAIT_V(0);
    if constexpr (!ALIGN_EPI) { if (wr == 0) PG8_BAR; }
    PG8_BAR;
    if constexpr (Epi::AFTER_DRAIN) { E.fused(acc, cur, wr, wc, fr, fq, lds, wid, lane); S.done(cur); }
#undef PG8_SA
#undef PG8_SB
#undef PG8_STAGE
#undef PG8_LDA
#undef PG8_LDB
#undef PG8_MMA
#undef PG8_WAIT_V
#undef PG8_WAIT_L
#undef PG8_BAR
#undef PG8_SCHED
}
}
#ifndef PG8_SP2
#define PG8_SP2 true
#endif
#ifndef PG8_ALIGN
#define PG8_ALIGN true
#endif

constexpr int NWAVES = 8, NTHR = 512;
constexpr int D = 1024, NB = 8, T = 4096, TC = 256, DEPTH = 4, FF = 2816, ZP = 2608, ZPAD = 2816;
constexpr int NLAT = NB * T, NCTX = NB * TC, NROWS = NLAT + NCTX;
constexpr int MODW = 9 * D;
constexpr int NKEY = TC + T;
constexpr float NORM_EPS = 1e-6f;
constexpr int ZS5 = 0, ZCQ = 256, ZCKV = 512, ZKR = 640, ZRKV = 672, ZWD = 1440, ZAD = 1472, ZGD = 1504, ZMQK = 1568, ZMV = 2080, ZMO = 2336, ZMG = 2592;

constexpr size_t MiB = 1u << 20;
constexpr size_t WS_CTL = 0, CTL_ZERO_BYTES = 1 * MiB;
constexpr size_t WS_MODV = 1 * MiB;
constexpr size_t WS_ROPE = 3 * MiB;
constexpr size_t WS_SMALLW = 4 * MiB;
constexpr size_t SW_UQ = 0, SW_UKV = 196608, SW_GLU = 327680, SW_GUP = 458752;
constexpr size_t WS_WGU = 6 * MiB, WS_WDN = 17 * MiB, WS_WIN = 23 * MiB, WS_WOUT = 29 * MiB;
constexpr size_t WS_X = 31 * MiB;
constexpr size_t WS_Y = 167 * MiB;
constexpr size_t WS_Q = WS_Y, WS_K = WS_Y + (size_t)NROWS * 384 * 2, WS_VT = WS_K + (size_t)NROWS * 384 * 2;
constexpr size_t WS_H = 235 * MiB;
constexpr size_t WS_ACT = 303 * MiB;
constexpr size_t WS_YS5 = 490 * MiB, WS_YR = 524 * MiB, WS_YM = 558 * MiB, WS_END = 592 * MiB;
static_assert(WS_VT + (size_t)NB * 4 * 64 * NKEY * 2 <= WS_H, "qkv overlay");
static_assert(WS_WGU + (size_t)5632 * 1024 * 2 <= WS_WDN && WS_WDN + (size_t)1024 * 2816 * 2 <= WS_WIN && WS_WIN + (size_t)2816 * 1024 * 2 <= WS_WOUT && WS_WOUT + 2 * MiB <= WS_X, "weights");
static_assert(WS_X + (size_t)NROWS * D * 4 <= WS_Y && WS_Y + (size_t)NROWS * D * 2 <= WS_H && WS_H + (size_t)NROWS * D * 2 <= WS_ACT && WS_ACT + (size_t)NROWS * ZPAD * 2 <= WS_YS5, "map");
static_assert(WS_YS5 + (size_t)2 * NROWS * 256 * 2 <= WS_YR && WS_YM + (size_t)2 * NROWS * 256 * 2 <= WS_END, "map2");
constexpr int CW_BAR = 4096, CW_SUB = 8192;

constexpr int RING_BYTES = 131072, LDS_BYTES = 147456, LDSCTL_OFF = LDS_BYTES - 512, MISC_OFF = LDSCTL_OFF + 320;

#define GAS __attribute__((address_space(1)))
#define LAS __attribute__((address_space(3)))
typedef unsigned short bf16;
typedef unsigned char uchar;
typedef unsigned v4u __attribute__((ext_vector_type(4)));
typedef unsigned v2u __attribute__((ext_vector_type(2)));
typedef float f32x4 __attribute__((ext_vector_type(4)));
typedef float f32x2 __attribute__((ext_vector_type(2)));
typedef float f32x16 __attribute__((ext_vector_type(16)));
typedef short bf16x8 __attribute__((ext_vector_type(8)));
typedef short bf16x4 __attribute__((ext_vector_type(4)));
#define DI __device__ __forceinline__
DI unsigned f2bf(float f) { unsigned u = __builtin_bit_cast(unsigned, f); return (u + 0x7fffu + ((u >> 16) & 1u)) >> 16; }
DI unsigned pk2(float lo, float hi) { return pg8::cvt_pk_bf16(lo, hi); }
DI float bf2f(unsigned b) { return __builtin_bit_cast(float, b << 16); }
DI float bflo(unsigned w) { return __builtin_bit_cast(float, w << 16); }
DI float bfhi(unsigned w) { return __builtin_bit_cast(float, w & 0xffff0000u); }
template <int CTRL> DI float dpp_f(float x) { return __builtin_bit_cast(float, __builtin_amdgcn_update_dpp(0, __builtin_bit_cast(int, x), CTRL, 0xf, 0xf, true)); }
DI float sum8(float x) { x += dpp_f<0xB1>(x); x += dpp_f<0x4E>(x); x += dpp_f<0x141>(x); return x; }
DI float sum16(float x) { x = sum8(x); x += dpp_f<0x140>(x); return x; }
template <int CTRL, int RM> DI float dpp_z(float x) { return __builtin_bit_cast(float, __builtin_amdgcn_update_dpp(0, __builtin_bit_cast(int, x), CTRL, RM, 0xf, true)); }
template <int CTRL, int RM> DI float dpp_o(float old, float x) { return __builtin_bit_cast(float, __builtin_amdgcn_update_dpp(__builtin_bit_cast(int, old), __builtin_bit_cast(int, x), CTRL, RM, 0xf, false)); }
DI float wave_scan_sum(float x) {
    x += dpp_z<0x111, 0xf>(x); x += dpp_z<0x112, 0xf>(x); x += dpp_z<0x114, 0xf>(x); x += dpp_z<0x118, 0xf>(x);
    x += dpp_z<0x142, 0xa>(x); x += dpp_z<0x143, 0xc>(x); return x;
}
DI float wave_scan_max(float x) {
    const float ninf = -3.0e38f;
    x = fmaxf(x, dpp_o<0x111, 0xf>(ninf, x)); x = fmaxf(x, dpp_o<0x112, 0xf>(ninf, x)); x = fmaxf(x, dpp_o<0x114, 0xf>(ninf, x)); x = fmaxf(x, dpp_o<0x118, 0xf>(ninf, x));
    x = fmaxf(x, dpp_o<0x142, 0xa>(ninf, x)); x = fmaxf(x, dpp_o<0x143, 0xc>(ninf, x)); return x;
}
DI float wave_sum(float v) { v = sum16(v); v += __shfl_xor(v, 16); v += __shfl_xor(v, 32); return v; }
DI float wave_max(float v) {
#pragma unroll
    for (int o = 1; o < 64; o <<= 1) v = fmaxf(v, __shfl_xor(v, o));
    return v;
}
DI void lds_barrier() { asm volatile("s_waitcnt lgkmcnt(0)" ::: "memory"); __builtin_amdgcn_s_barrier(); asm volatile("" ::: "memory"); }
DI float fexp(float x) { return __builtin_amdgcn_exp2f(x * 1.44269504089f); }
DI float fsigmoid(float x) { return __builtin_amdgcn_rcpf(1.0f + fexp(-x)); }
DI f32x16 mfma32(bf16x8 a, bf16x8 b, f32x16 c) { return __builtin_amdgcn_mfma_f32_32x32x16_bf16(a, b, c, 0, 0, 0); }
DI f32x4 mfma16(bf16x8 a, bf16x8 b, f32x4 c) { return __builtin_amdgcn_mfma_f32_16x16x32_bf16(a, b, c, 0, 0, 0); }
DI int crow(int r, int h) { return (r & 3) + 8 * (r >> 2) + 4 * h; }
DI bf16x8 pack8(float a0, float a1, float a2, float a3, float a4, float a5, float a6, float a7) {
    typedef __bf16 nb8 __attribute__((ext_vector_type(8))); typedef float nf8 __attribute__((ext_vector_type(8)));
    const nf8 v = {a0, a1, a2, a3, a4, a5, a6, a7}; return __builtin_bit_cast(bf16x8, __builtin_convertvector(v, nb8));
}
DI void my_sincosf(float x, float& s, float& c) {
    const float k = __builtin_rintf(x * 0.63661977236758134f);
    float r = __builtin_fmaf(-k, 1.5703125f, x); r = __builtin_fmaf(-k, 4.837512969970703125e-4f, r); r = __builtin_fmaf(-k, 7.54978995489188216e-8f, r);
    const float r2 = r * r;
    const float ps = r + r * r2 * (-1.6666654611e-1f + r2 * (8.3321608736e-3f + r2 * (-1.9515295891e-4f)));
    const float pc = 1.0f - 0.5f * r2 + r2 * r2 * (4.166664568298827e-2f + r2 * (-1.388731625493765e-3f + r2 * 2.443315711809948e-5f));
    const int q = ((int)k) & 3;
    const float ss = (q & 1) ? pc : ps, cc = (q & 1) ? ps : pc;
    s = (q & 2) ? -ss : ss; c = ((q + 1) & 2) ? -cc : cc;
}

#define XB_TMO      128
#define XB_XCNT(j)  (256  + 64 * (j))
#define XB_XSUB(j)  (1280 + 64 * (j))
#define XB_XGEN(j)  (2304 + 64 * (j))
#define XB_TOP      3328
#define XB_TOPGEN   3392
#define XCD_BAR_WORDS 3456
#define XB_SPIN_CAP (1u << 22)
DI unsigned xb_ld(unsigned* p)              { return __hip_atomic_load(p, __ATOMIC_RELAXED, __HIP_MEMORY_SCOPE_AGENT); }
DI unsigned xb_add(unsigned* p, unsigned v) { return __hip_atomic_fetch_add(p, v, __ATOMIC_RELAXED, __HIP_MEMORY_SCOPE_AGENT); }
DI unsigned xb_xcc_id() { return (unsigned)__builtin_amdgcn_s_getreg((3 << 11) | 20) & 0xFu; }
#define XB_SPIN(cond, bar) do { unsigned _sp = 0; while (cond) { __builtin_amdgcn_s_sleep(1); \
    if ((++_sp & 255u) == 0u) { if (xb_ld(&(bar)[XB_TMO])) break; if (_sp > XB_SPIN_CAP) { atomicAdd(&(bar)[XB_TMO], 1u); break; } } } } while (0)
struct XcdBarrier { unsigned* bar; unsigned x; volatile LAS unsigned* st; };
DI XcdBarrier xcd_barrier_post(unsigned* bar, volatile LAS unsigned* st, bool t0) {
    XcdBarrier b; b.bar = bar; b.x = xb_xcc_id(); b.st = st;
    if (t0) (void)xb_add(&bar[XB_XCNT(b.x)], 1u);
    return b;
}
DI void xcd_barrier_complete(unsigned* bar, unsigned x, unsigned& nloc, unsigned& nx) {
    const unsigned G = gridDim.x * gridDim.y * gridDim.z;
    unsigned sum, cnt, mine, sp = 0u;
    for (;;) {
        sum = 0u; cnt = 0u; mine = 0u;
#pragma unroll
        for (unsigned j = 0; j < 16; ++j) { const unsigned c = xb_ld(&bar[XB_XCNT(j)]); sum += c; cnt += (c > 0u) ? 1u : 0u; mine = (j == x) ? c : mine; }
        if (sum == G) break;
        __builtin_amdgcn_s_sleep(1);
        if ((++sp & 255u) == 0u) { if (xb_ld(&bar[XB_TMO])) break; if (sp > XB_SPIN_CAP) { atomicAdd(&bar[XB_TMO], 1u); break; } }
    }
    nloc = mine > 0u ? mine : 1u; nx = cnt > 0u ? cnt : 1u;
}
DI void xcd_barrier(const XcdBarrier& b, bool t0) {
    asm volatile("s_waitcnt vmcnt(0)" ::: "memory");
    __syncthreads();
    if (t0) {
        unsigned* bar = b.bar;
        __builtin_amdgcn_s_waitcnt(0);
        unsigned nloc = b.st[0], nx = b.st[1];
        if (nloc == 0u) { xcd_barrier_complete(bar, b.x, nloc, nx); b.st[0] = nloc; b.st[1] = nx; }
        const unsigned old = xb_add(&bar[XB_XSUB(b.x)], 1u);
        const unsigned gen = old / nloc;
        if (old + 1u == (gen + 1u) * nloc) {
            __builtin_amdgcn_fence(__ATOMIC_RELEASE, "agent");
            asm volatile("s_waitcnt vmcnt(0)" ::: "memory");
            const unsigned og = xb_add(&bar[XB_TOP], 1u);
            const unsigned tg = og / nx;
            if (og + 1u == (tg + 1u) * nx) xb_add(&bar[XB_TOPGEN], 1u);
            else XB_SPIN(xb_ld(&bar[XB_TOPGEN]) == tg, bar);
            __builtin_amdgcn_fence(__ATOMIC_ACQUIRE, "agent");
            xb_add(&bar[XB_XGEN(b.x)], 1u);
            asm volatile("s_waitcnt vmcnt(0)" ::: "memory");
        } else {
            XB_SPIN(xb_ld(&bar[XB_XGEN(b.x)]) == gen, bar);
            __builtin_amdgcn_fence(__ATOMIC_ACQUIRE, "agent");
            asm volatile("s_waitcnt vmcnt(0)" ::: "memory");
        }
    }
    __syncthreads();
}

struct Args { const float* in[43]; float* out; unsigned char* ws; int ph_lo, ph_hi, use_bar, pad; };
typedef const __attribute__((address_space(4))) Args* KArgs;
enum { I_X = 0, I_C, I_CTX, I_CCTX, I_WADA, I_BADA, I_NPRE, I_NPOST, I_WG, I_WU, I_WD, I_WIN, I_WOUT, I_S5LRE, I_S5LIM, I_S5DT, I_S5BRE, I_S5BIM, I_S5CRE, I_S5CIM, I_S5D, I_S5GLU, I_S5BGLU,
       I_MQN, I_MKVN, I_MUQ, I_MUKV, I_RCW, I_RCB, I_RW0, I_RWUP, I_RA0, I_RAUP, I_RGUP, I_RKK, I_RKA, I_RRK, I_RLNW, I_RLNB, I_MCW, I_MCB, I_MGB, I_MNORM };

struct Ctx {
    LAS uchar* lds; int tid, lane, wave, vcu, G;
};
DI int tok_row(int b, int seg, int t) { return seg ? b * T + t : NLAT + b * TC + t; }
DI void phase_prologue(KArgs a, const Ctx& F) {
    LAS float* sc = (LAS float*)F.lds;
    LAS float* red = (LAS float*)(F.lds + 40960);
    const float* c = a->in[I_C]; const float* cc = a->in[I_CCTX];
    for (int i = F.tid; i < 9 * D; i += NTHR) { const float v = (i < 8 * D) ? c[i] : cc[i - 8 * D]; sc[i] = v * fsigmoid(v); }
    __syncthreads();
    const float* wada = a->in[I_WADA]; const float* bada = a->in[I_BADA];
    float* modv = (float*)(a->ws + WS_MODV);
    for (int task = F.vcu; task < DEPTH * 144; task += F.G) {
        const int l = task / 144, nb = task % 144, n = nb * 64 + F.lane;
        const float* wp = wada + ((size_t)l * D + F.wave * 128) * MODW + n;
        float acc[9];
#pragma unroll
        for (int m = 0; m < 9; ++m) acc[m] = 0.f;
#pragma unroll 8
        for (int k = 0; k < 128; ++k) { const float w = wp[(size_t)k * MODW];
#pragma unroll
            for (int m = 0; m < 9; ++m) acc[m] += sc[m * D + F.wave * 128 + k] * w; }
#pragma unroll
        for (int m = 0; m < 9; ++m) red[(F.wave * 9 + m) * 64 + F.lane] = acc[m];
        __syncthreads();
        for (int i = F.tid; i < 576; i += NTHR) { const int m = i >> 6, ln = i & 63; float s = 0.f;
#pragma unroll
            for (int w = 0; w < 8; ++w) s += red[(w * 9 + m) * 64 + ln];
            modv[((size_t)l * 9 + m) * MODW + nb * 64 + ln] = s + bada[l * MODW + nb * 64 + ln]; }
        __syncthreads();
    }
    float* rc = (float*)(a->ws + WS_ROPE); float* rs = rc + T * 16;
    for (int i = F.vcu * NTHR + F.tid; i < T * 16; i += F.G * NTHR) {
        const int t = i >> 4, f = i & 15, pos = f < 8 ? (t >> 6) : (t & 63), fi = f & 7;
        const float invf = (fi == 0) ? 1.0f : (fi == 1) ? 0.31622776601683794f : (fi == 2) ? 0.1f : (fi == 3) ? 0.031622776601683794f : (fi == 4) ? 0.01f : (fi == 5) ? 0.0031622776601683794f : (fi == 6) ? 0.001f : 0.00031622776601683794f;
        const float ang = (float)pos * invf; float s, co; my_sincosf(ang, s, co);
        rc[i] = co; rs[i] = s;
    }
}

DI void tr_item(const float* W, int K, int N, bf16* WT, int kb, int n0, int drow0, LAS float* scr, int lane) {
    const int k0 = 64 * kb, nq = 4 * (lane & 7), nn = n0 + nq;
    f32x4 ld[8];
#pragma unroll
    for (int i = 0; i < 8; ++i) { const int kk = 8 * i + (lane >> 3); ld[i] = (nn < N) ? *(const f32x4*)(W + (size_t)(k0 + kk) * N + nn) : (f32x4){0.f, 0.f, 0.f, 0.f}; }
#pragma unroll
    for (int i = 0; i < 8; ++i) { const int kk = 8 * i + (lane >> 3); LAS float* s = scr + kk * 33 + nq; s[0] = ld[i].x; s[1] = ld[i].y; s[2] = ld[i].z; s[3] = ld[i].w; }
    const int c = lane & 7;
#pragma unroll
    for (int j = 0; j < 4; ++j) { const int n = (lane >> 3) + 8 * j; const LAS float* s = scr + (8 * c) * 33 + n;
        v4u o; o.x = pk2(s[0 * 33], s[1 * 33]); o.y = pk2(s[2 * 33], s[3 * 33]); o.z = pk2(s[4 * 33], s[5 * 33]); o.w = pk2(s[6 * 33], s[7 * 33]);
        if (n0 + n < N) *(v4u*)(WT + (size_t)(drow0 + n) * K + k0 + 8 * c) = o; }
}
DI void convert_weights(KArgs a, const Ctx& F, int l, int set) {
    LAS float* scr = (LAS float*)(F.lds + F.wave * 8704);
    const int gw = F.vcu * NWAVES + F.wave, NGW = F.G * NWAVES;
    bf16* WGU = (bf16*)(a->ws + WS_WGU); bf16* WDN = (bf16*)(a->ws + WS_WDN); bf16* WIN = (bf16*)(a->ws + WS_WIN); bf16* WOUT = (bf16*)(a->ws + WS_WOUT);
    bf16* SW = (bf16*)(a->ws + WS_SMALLW);
    const int fl = l * 2 + set;
    const float* wg = a->in[I_WG] + (size_t)fl * D * FF; const float* wu = a->in[I_WU] + (size_t)fl * D * FF; const float* wd = a->in[I_WD] + (size_t)fl * FF * D;
    constexpr int I_G = 16 * 88, I_D = 44 * 32, I_IN = 16 * 82, I_O = 16 * 32, I_UQ = 4 * 12, I_UKV = 2 * 16, I_GLU = 4 * 8, I_GUP = 1 * 8;
    const int nitems = set == 0 ? (2 * I_G + I_D + I_IN + I_O + I_UQ + I_UKV + I_GLU + I_GUP) : (2 * I_G + I_D);
    for (int it = gw; it < nitems; it += NGW) {
        int r = it;
        if (r < I_G) { const int kb = r / 88, nb = r % 88, n0 = 32 * nb; tr_item(wg, D, FF, WGU, kb, n0, 256 * (n0 >> 7) + (n0 & 127), scr, F.lane); continue; } r -= I_G;
        if (r < I_G) { const int kb = r / 88, nb = r % 88, n0 = 32 * nb; tr_item(wu, D, FF, WGU, kb, n0, 256 * (n0 >> 7) + 128 + (n0 & 127), scr, F.lane); continue; } r -= I_G;
        if (r < I_D) { const int kb = r / 32, nb = r % 32; tr_item(wd, FF, D, WDN, kb, 32 * nb, 32 * nb, scr, F.lane); continue; } r -= I_D;
        if (r < I_IN) { const int kb = r / 82, nb = r % 82; tr_item(a->in[I_WIN] + (size_t)l * D * ZP, D, ZP, WIN, kb, 32 * nb, 32 * nb, scr, F.lane); continue; } r -= I_IN;
        if (r < I_O) { const int kb = r / 32, nb = r % 32; tr_item(a->in[I_WOUT] + (size_t)l * D * D, D, D, WOUT, kb, 32 * nb, 32 * nb, scr, F.lane); continue; } r -= I_O;
        if (r < I_UQ) { const int kb = r / 12, nb = r % 12; tr_item(a->in[I_MUQ] + (size_t)l * 256 * 384, 256, 384, (bf16*)((uchar*)SW + SW_UQ), kb, 32 * nb, 32 * nb, scr, F.lane); continue; } r -= I_UQ;
        if (r < I_UKV) { const int kb = r / 16, nb = r % 16; tr_item(a->in[I_MUKV] + (size_t)l * 128 * 512, 128, 512, (bf16*)((uchar*)SW + SW_UKV), kb, 32 * nb, 32 * nb, scr, F.lane); continue; } r -= I_UKV;
        if (r < I_GLU) { const int kb = r / 8, nb = r % 8; tr_item(a->in[I_S5GLU] + (size_t)l * 256 * 256, 256, 256, (bf16*)((uchar*)SW + SW_GLU), kb, 32 * nb, 32 * nb, scr, F.lane); continue; } r -= I_GLU;
        { const int nb = r; tr_item(a->in[I_RGUP] + (size_t)l * 64 * 256, 64, 256, (bf16*)((uchar*)SW + SW_GUP), 0, 32 * nb, 32 * nb, scr, F.lane); }
    }
    if (set == 0) {
        unsigned zz_ = 0u; asm volatile("" : "+v"(zz_)); v4u z = {zz_, zz_, zz_, zz_}; v4u* p = (v4u*)(WIN + (size_t)ZP * D);
        for (int i = F.vcu * NTHR + F.tid; i < (ZPAD - ZP) * D / 8; i += F.G * NTHR) p[i] = z;
    }
}

DI void norm_rows(KArgs a, const Ctx& F, bool p_first, bool p_hasY, bool p_hasH, bool p_final, int p_nrows, const float* p_modY, int p_gi, const float* p_pw, float p_coef, const float* p_modH, int p_si, const float* p_prew, bool p_dummy = false) {
    bf16* X = (bf16*)(a->ws + WS_X); const bf16* Y = (const bf16*)(a->ws + WS_Y); bf16* H = (bf16*)(a->ws + (p_dummy ? WS_YS5 : WS_H));
    bf16* Xo = p_dummy ? (bf16*)(a->ws + WS_ACT) : X;
    const int gw = F.vcu * NWAVES + F.wave, NGW = F.G * NWAVES, lane = F.lane;
    const int rpw = (p_nrows + NGW - 1) / NGW, r0 = gw * rpw, r1 = (r0 + rpw < p_nrows) ? (r0 + rpw) : p_nrows;
    if (r0 >= r1) return;
    f32x4 cA[4], cB[4], cC[4];
    int cur_mr = -1;
    f32x4 vn[2][4]; v2u xn[2][4], yn[2][4];
    auto issue = [&](int r) {
#pragma unroll
        for (int k = 0; k < 2; ++k) if (r + k < r1) {
            if (p_first) {
                const float* xs = r + k < NLAT ? a->in[I_X] + (size_t)(r + k) * D : a->in[I_CTX] + (size_t)(r + k - NLAT) * D;
#pragma unroll
                for (int j = 0; j < 4; ++j) vn[k][j] = *(const f32x4*)(xs + 4 * lane + 256 * j);
            } else {
#pragma unroll
                for (int j = 0; j < 4; ++j) xn[k][j] = *(const v2u*)(X + (size_t)(r + k) * D + 4 * lane + 256 * j);
            }
            if (p_hasY) {
#pragma unroll
                for (int j = 0; j < 4; ++j) yn[k][j] = *(const v2u*)(Y + (size_t)(r + k) * D + 4 * lane + 256 * j);
            }
        }
    };
    issue(r0);
    for (int r = r0; r < r1; r += 2) {
        f32x4 v[2][4]; v2u yw[2][4];
#pragma unroll
        for (int k = 0; k < 2; ++k)
#pragma unroll
            for (int j = 0; j < 4; ++j) { v[k][j] = p_first ? vn[k][j] : (f32x4){bflo(xn[k][j].x), bfhi(xn[k][j].x), bflo(xn[k][j].y), bfhi(xn[k][j].y)}; yw[k][j] = yn[k][j]; }
        if (r + 2 < r1) issue(r + 2);
#pragma unroll
        for (int k = 0; k < 2; ++k) if (r + k < r1) {
            const int rr = r + k;
            const int mr = rr < NLAT ? (rr >> 12) : 8;
            if (mr != cur_mr) { cur_mr = mr;
                const float* g = p_modY + (size_t)mr * MODW + p_gi * D; const float* sh = p_modH + (size_t)mr * MODW + p_si * D; const float* scp = sh + D;
#pragma unroll
                for (int j = 0; j < 4; ++j) { const int o = 4 * lane + 256 * j;
                    cA[j] = p_hasY ? (*(const f32x4*)(g + o) * p_coef) * *(const f32x4*)(p_pw + o) : (f32x4){0.f, 0.f, 0.f, 0.f};
                    if (p_hasH) { cB[j] = *(const f32x4*)(p_prew + o) * (*(const f32x4*)(scp + o) + 1.0f); cC[j] = *(const f32x4*)(sh + o); } else { cB[j] = cA[j]; cC[j] = cA[j]; } } }
            if (p_hasY) {
                f32x4 y[4]; float ss = 0.f;
#pragma unroll
                for (int j = 0; j < 4; ++j) { y[j] = (f32x4){bflo(yw[k][j].x), bfhi(yw[k][j].x), bflo(yw[k][j].y), bfhi(yw[k][j].y)};
                    ss += (y[j].x * y[j].x + y[j].y * y[j].y) + (y[j].z * y[j].z + y[j].w * y[j].w); }
                const float rstd = __builtin_amdgcn_rsqf(wave_sum(ss) * (1.0f / D) + NORM_EPS);
#pragma unroll
                for (int j = 0; j < 4; ++j) v[k][j] = v[k][j] + cA[j] * (y[j] * rstd);
            }
            if (p_final) {
#pragma unroll
                for (int j = 0; j < 4; ++j) *(f32x4*)(a->out + (size_t)rr * D + 4 * lane + 256 * j) = v[k][j];
            } else if (p_hasY || p_first) {
#pragma unroll
                for (int j = 0; j < 4; ++j) { v2u o; o.x = pk2(v[k][j].x, v[k][j].y); o.y = pk2(v[k][j].z, v[k][j].w); *(v2u*)(Xo + (size_t)rr * D + 4 * lane + 256 * j) = o; }
            }
            if (p_hasH) {
                float ss = 0.f;
#pragma unroll
                for (int j = 0; j < 4; ++j) ss += (v[k][j].x * v[k][j].x + v[k][j].y * v[k][j].y) + (v[k][j].z * v[k][j].z + v[k][j].w * v[k][j].w);
                const float rstd = __builtin_amdgcn_rsqf(wave_sum(ss) * (1.0f / D) + NORM_EPS);
#pragma unroll
                for (int j = 0; j < 4; ++j) { const f32x4 h = (v[k][j] * rstd) * cB[j] + cC[j];
                    v2u o; o.x = pk2(h.x, h.y); o.y = pk2(h.z, h.w); *(v2u*)(H + (size_t)rr * D + 4 * lane + 256 * j) = o; }
            }
        }
    }
}
template <int K, int NBK, int MBK, bool TRANS, bool ZERO = true>
DI void small_gemm(const LAS bf16* A, int apitch, const bf16* Wt, int n0w, f32x4 (&acc)[NBK][MBK], int lane, int wpitch = K) {
    const int lr = lane & 15, kq = lane >> 4;
    if (ZERO) {
#pragma unroll
        for (int nb = 0; nb < NBK; ++nb)
#pragma unroll
            for (int mb = 0; mb < MBK; ++mb) acc[nb][mb] = (f32x4){0.f, 0.f, 0.f, 0.f};
    }
#pragma unroll 2
    for (int s = 0; s < K / 32; ++s) {
        bf16x8 av[MBK];
#pragma unroll
        for (int mb = 0; mb < MBK; ++mb) av[mb] = *(const LAS bf16x8*)(A + (16 * mb + lr) * apitch + 32 * s + 8 * kq);
#pragma unroll
        for (int nb = 0; nb < NBK; ++nb) { const bf16x8 w = *(const bf16x8*)(Wt + (size_t)(n0w + 16 * nb + lr) * wpitch + 32 * s + 8 * kq);
#pragma unroll
            for (int mb = 0; mb < MBK; ++mb) acc[nb][mb] = TRANS ? mfma16(w, av[mb], acc[nb][mb]) : mfma16(av[mb], w, acc[nb][mb]); }
    }
}
DI void ctx_gemm_block(const Ctx& F, const bf16* A, const bf16* Wt, int K, bf16* Yo) {
    const int bi = F.vcu; if (bi >= 256) return;
    const int rb = bi >> 3, cb = bi & 7, row0 = NLAT + 64 * rb;
    const int tid = F.tid, lane = F.lane, wave = F.wave;
    LAS bf16* As = (LAS bf16*)F.lds;
    const int nch = K / 256;
    v4u g[4];
    auto gload = [&](int ch) {
#pragma unroll
        for (int j = 0; j < 4; ++j) { const int cidx = tid + 512 * j, r = cidx >> 5, cc = cidx & 31; g[j] = *(const v4u*)(A + (size_t)(row0 + r) * K + ch * 256 + cc * 8); }
    };
    auto lstore = [&](int buf) {
#pragma unroll
        for (int j = 0; j < 4; ++j) { const int cidx = tid + 512 * j, r = cidx >> 5, cc = cidx & 31; *(LAS v4u*)(As + buf * 64 * 264 + r * 264 + cc * 8) = g[j]; }
    };
    f32x4 acc[1][4];
#pragma unroll
    for (int mb = 0; mb < 4; ++mb) acc[0][mb] = (f32x4){0.f, 0.f, 0.f, 0.f};
    const int lr_ = lane & 15, kq_ = lane >> 4;
    const bf16* wrow = Wt + (size_t)(128 * cb + 16 * wave + lr_) * K + 8 * kq_;
    bf16x8 wc[8], wn[8];
#pragma unroll
    for (int s = 0; s < 8; ++s) wc[s] = *(const bf16x8*)(wrow + 32 * s);
    gload(0); lstore(0);
    __syncthreads();
    for (int ch = 0; ch < nch; ++ch) {
        if (ch + 1 < nch) { gload(ch + 1);
#pragma unroll
            for (int s = 0; s < 8; ++s) wn[s] = *(const bf16x8*)(wrow + (ch + 1) * 256 + 32 * s); }
        const LAS bf16* Ab = As + (ch & 1) * 64 * 264;
#pragma unroll
        for (int s = 0; s < 8; ++s) {
#pragma unroll
            for (int mb = 0; mb < 4; ++mb) acc[0][mb] = mfma16(wc[s], *(const LAS bf16x8*)(Ab + (16 * mb + lr_) * 264 + 32 * s + 8 * kq_), acc[0][mb]);
        }
        if (ch + 1 < nch) { lstore((ch + 1) & 1);
#pragma unroll
            for (int s = 0; s < 8; ++s) wc[s] = wn[s]; }
        __syncthreads();
    }
    const int lr = lane & 15, kq = lane >> 4;
#pragma unroll
    for (int mb = 0; mb < 4; ++mb) { const f32x4 v = acc[0][mb]; v2u o; o.x = pk2(v.x, v.y); o.y = pk2(v.z, v.w);
        *(v2u*)(Yo + (size_t)(row0 + 16 * mb + lr) * D + 128 * cb + 16 * wave + 4 * kq) = o; }
}

struct S5C { float ar, ai, fr, fi; };
static __device__ __noinline__ S5C s5_coef(const float* lre, const float* lim, float dt, int nn) {
    const float lr = lre[nn], li = lim[nn], x = lr * dt;
    const float em = x * (1.0f + x * (0.5f + x * (0.16666667f + x * (0.041666668f + x * 0.0083333338f))));
    float sh, ch; my_sincosf(0.5f * li * dt, sh, ch);
    const float cm1 = -2.0f * sh * sh, sn = 2.0f * sh * ch;
    const float arm1 = em * (1.0f + cm1) + cm1;
    S5C o; o.ai = (1.0f + em) * sn; o.ar = 1.0f + arm1;
    const float den = lr * lr + li * li;
    o.fr = (arm1 * lr + o.ai * li) / den; o.fi = (o.ai * lr - arm1 * li) / den;
    return o;
}
DI void s5_scan_task(KArgs a, int l, int b, int dir, int g, LAS bf16* wl  , int lane) {
    const bf16* Z = (const bf16*)(a->ws + WS_ACT); bf16* YS = (bf16*)(a->ws + WS_YS5) + (size_t)dir * NROWS * 256;
    const int pg = (l * 2 + dir) * 16 + g;
    const float* lre = a->in[I_S5LRE] + pg * 64; const float* lim = a->in[I_S5LIM] + pg * 64;
    const float dt = __expf(a->in[I_S5DT][pg]);
    const S5C c0_ = s5_coef(lre, lim, dt, lane); const float ar = c0_.ar, ai = c0_.ai;
    bf16x8 Bf[4];
    { const int hh = lane >> 5;
#pragma unroll
      for (int nblk = 0; nblk < 2; ++nblk) { const int nn = 32 * nblk + (lane & 31); const S5C cn_ = s5_coef(lre, lim, dt, nn); const float fr = cn_.fr, fi = cn_.fi;
        const float* bre = a->in[I_S5BRE] + ((size_t)pg * 64 + nn) * 16 + 8 * hh; const float* bim = a->in[I_S5BIM] + ((size_t)pg * 64 + nn) * 16 + 8 * hh;
        float re[8], im[8];
#pragma unroll
        for (int j = 0; j < 8; ++j) { re[j] = fr * bre[j] - fi * bim[j]; im[j] = fi * bre[j] + fr * bim[j]; }
        Bf[nblk] = pack8(re[0], re[1], re[2], re[3], re[4], re[5], re[6], re[7]); Bf[2 + nblk] = pack8(im[0], im[1], im[2], im[3], im[4], im[5], im[6], im[7]); } }
    bf16x8 Cf[4];
    { const int p = lane & 15, q = lane >> 4;
#pragma unroll
      for (int s = 0; s < 4; ++s) { const int kc = 32 * s + 8 * q; float cv[8];
        const float* src = (s < 2) ? a->in[I_S5CRE] + ((size_t)pg * 16 + p) * 64 + kc : a->in[I_S5CIM] + ((size_t)pg * 16 + p) * 64 + (kc - 64);
        const float sg = (s < 2) ? 1.f : -1.f;
#pragma unroll
        for (int j = 0; j < 8; ++j) cv[j] = sg * src[j];
        Cf[s] = pack8(cv[0], cv[1], cv[2], cv[3], cv[4], cv[5], cv[6], cv[7]); } }
    float sr = 0.f, si = 0.f;
    const int hh = lane >> 5, li5 = lane & 31, q = lane >> 4, t16 = lane & 15;
    const f32x16 zero16 = {0.f, 0.f, 0.f, 0.f, 0.f, 0.f, 0.f, 0.f, 0.f, 0.f, 0.f, 0.f, 0.f, 0.f, 0.f, 0.f};
    const int nchC = TC / 32, nchT = nchC + T / 32;
    auto afload = [&](int gc) -> bf16x8 {
        const int seg = gc >= nchC, ch = seg ? gc - nchC : gc, len = seg ? T : TC;
        const int sidx = 32 * ch + li5, tt = dir ? (len - 1 - sidx) : sidx;
        return *(const bf16x8*)(Z + (size_t)tok_row(b, seg, tt) * ZP + ZS5 + g * 16 + 8 * hh);
    };
    bf16x8 afn = afload(0);
    for (int gc = 0; gc < nchT; ++gc) {
        const int seg = gc >= nchC, ch = seg ? gc - nchC : gc, len = seg ? T : TC;
        {
            const bf16x8 af = afn;
            if (gc + 1 < nchT) afn = afload(gc + 1);
            f32x16 d1 = mfma32(af, Bf[0], zero16), d2 = mfma32(af, Bf[1], zero16), d3 = mfma32(af, Bf[2], zero16), d4 = mfma32(af, Bf[3], zero16);
            float xa[16], xb[16], ya[16], yb[16];
#pragma unroll
            for (int r = 0; r < 16; ++r) {
                auto r1 = __builtin_amdgcn_permlane32_swap(__float_as_uint(d1[r]), __float_as_uint(d2[r]), false, false); xa[r] = __uint_as_float(r1[0]); xb[r] = __uint_as_float(r1[1]);
                auto r2 = __builtin_amdgcn_permlane32_swap(__float_as_uint(d3[r]), __float_as_uint(d4[r]), false, false); ya[r] = __uint_as_float(r2[0]); yb[r] = __uint_as_float(r2[1]); }
#pragma unroll
            for (int i = 0; i < 32; ++i) {
                const int r = 4 * (i >> 3) + (i & 3); const bool hi = (i >> 2) & 1;
                const float xre = hi ? xb[r] : xa[r], xim = hi ? yb[r] : ya[r];
                const float nsr = ar * sr - ai * si + xre, nsi = ar * si + ai * sr + xim; sr = nsr; si = nsi;
                wl[i * 136 + lane] = (bf16)f2bf(sr); wl[i * 136 + 64 + lane] = (bf16)f2bf(si);
            }
#pragma unroll
            for (int tb = 0; tb < 2; ++tb) {
                f32x4 acc = {0.f, 0.f, 0.f, 0.f};
#pragma unroll
                for (int s = 0; s < 4; ++s) { const bf16x8 bfr = *(const LAS bf16x8*)(wl + (16 * tb + t16) * 136 + 32 * s + 8 * q); acc = mfma16(Cf[s], bfr, acc); }
                const int so = 32 * ch + 16 * tb + t16, to = dir ? (len - 1 - so) : so;
                v2u o; o.x = pk2(acc[0], acc[1]); o.y = pk2(acc[2], acc[3]);
                *(v2u*)(YS + (size_t)tok_row(b, seg, to) * 256 + g * 16 + 4 * q) = o;
            }
        }
    }
}

DI void mla_prep_tile(KArgs a, const Ctx& F, int l, int tile) {
    const bf16* Z = (const bf16*)(a->ws + WS_ACT);
    bf16* Q = (bf16*)(a->ws + WS_Q); bf16* Kf = (bf16*)(a->ws + WS_K); bf16* Vt = (bf16*)(a->ws + WS_VT);
    const bf16* WUQ = (const bf16*)(a->ws + WS_SMALLW + SW_UQ); const bf16* WUKV = (const bf16*)(a->ws + WS_SMALLW + SW_UKV);
    const float* rc = (const float*)(a->ws + WS_ROPE); const float* rs = rc + T * 16;
    LAS bf16* Aq = (LAS bf16*)F.lds;
    LAS bf16* Akv = (LAS bf16*)(F.lds + 64 * 264 * 2);
    const int row0 = tile * 64, tid = F.tid, lane = F.lane, wave = F.wave;
    const bool lat = row0 < NLAT;
    {
        const int i = tid >> 3, part = tid & 7, row = row0 + i;
        const bf16* zr = Z + (size_t)row * ZP;
        float q[32], kv[16]; float sq = 0.f, sk = 0.f;
#pragma unroll
        for (int j = 0; j < 4; ++j) { const v4u w = *(const v4u*)(zr + ZCQ + part * 32 + 8 * j);
            q[8 * j + 0] = bflo(w.x); q[8 * j + 1] = bfhi(w.x); q[8 * j + 2] = bflo(w.y); q[8 * j + 3] = bfhi(w.y); q[8 * j + 4] = bflo(w.z); q[8 * j + 5] = bfhi(w.z); q[8 * j + 6] = bflo(w.w); q[8 * j + 7] = bfhi(w.w); }
#pragma unroll
        for (int j = 0; j < 2; ++j) { const v4u w = *(const v4u*)(zr + ZCKV + part * 16 + 8 * j);
            kv[8 * j + 0] = bflo(w.x); kv[8 * j + 1] = bfhi(w.x); kv[8 * j + 2] = bflo(w.y); kv[8 * j + 3] = bfhi(w.y); kv[8 * j + 4] = bflo(w.z); kv[8 * j + 5] = bfhi(w.z); kv[8 * j + 6] = bflo(w.w); kv[8 * j + 7] = bfhi(w.w); }
#pragma unroll
        for (int j = 0; j < 32; ++j) sq += q[j] * q[j];
#pragma unroll
        for (int j = 0; j < 16; ++j) sk += kv[j] * kv[j];
        sq += __shfl_xor(sq, 1); sq += __shfl_xor(sq, 2); sq += __shfl_xor(sq, 4);
        sk += __shfl_xor(sk, 1); sk += __shfl_xor(sk, 2); sk += __shfl_xor(sk, 4);
        const float rq = 1.0f / sqrtf(sq * (1.0f / 256.0f) + NORM_EPS), rk = 1.0f / sqrtf(sk * (1.0f / 128.0f) + NORM_EPS);
        const float* qn = a->in[I_MQN] + l * 256 + part * 32; const float* kn = a->in[I_MKVN] + l * 128 + part * 16;
#pragma unroll
        for (int j = 0; j < 32; j += 2) *(LAS unsigned*)(Aq + i * 264 + part * 32 + j) = pk2(q[j] * rq * qn[j], q[j + 1] * rq * qn[j + 1]);
#pragma unroll
        for (int j = 0; j < 16; j += 2) *(LAS unsigned*)(Akv + i * 136 + part * 16 + j) = pk2(kv[j] * rk * kn[j], kv[j + 1] * rk * kn[j + 1]);
        if (part == 0) {
            float kr[32];
#pragma unroll
            for (int j = 0; j < 4; ++j) { const v4u w = *(const v4u*)(zr + ZKR + 8 * j);
                kr[8 * j + 0] = bflo(w.x); kr[8 * j + 1] = bfhi(w.x); kr[8 * j + 2] = bflo(w.y); kr[8 * j + 3] = bfhi(w.y); kr[8 * j + 4] = bflo(w.z); kr[8 * j + 5] = bfhi(w.z); kr[8 * j + 6] = bflo(w.w); kr[8 * j + 7] = bfhi(w.w); }
            float o[32];
            if (lat) { const int t = row & (T - 1);
#pragma unroll
                for (int hf = 0; hf < 2; ++hf)
#pragma unroll
                    for (int j = 0; j < 8; ++j) { const float c = rc[t * 16 + hf * 8 + j], s = rs[t * 16 + hf * 8 + j]; const float x0 = kr[hf * 16 + j], x1 = kr[hf * 16 + 8 + j];
                        o[hf * 16 + j] = x0 * c - x1 * s; o[hf * 16 + 8 + j] = x1 * c + x0 * s; }
            } else {
#pragma unroll
                for (int j = 0; j < 32; ++j) o[j] = kr[j];
            }
#pragma unroll
            for (int hd = 0; hd < 4; ++hd) { bf16* kp = Kf + (size_t)row * 384 + hd * 96 + 64;
#pragma unroll
                for (int j = 0; j < 4; ++j) { v4u w; w.x = pk2(o[8 * j], o[8 * j + 1]); w.y = pk2(o[8 * j + 2], o[8 * j + 3]); w.z = pk2(o[8 * j + 4], o[8 * j + 5]); w.w = pk2(o[8 * j + 6], o[8 * j + 7]); *(v4u*)(kp + 8 * j) = w; } }
        }
    }
    __syncthreads();
    const int lr = lane & 15, kq = lane >> 4;
    {
        f32x4 acc[3][4];
        small_gemm<256, 3, 4, true>(Aq, 264, WUQ, 48 * wave, acc, lane);
        const float qs = 0.10206207261596577f * 1.44269504089f;
#pragma unroll
        for (int nb = 0; nb < 3; ++nb) { const int blk = 3 * wave + nb, hb = blk % 6;
#pragma unroll
            for (int mb = 0; mb < 4; ++mb) { const int row = row0 + 16 * mb + lr; f32x4 v = acc[nb][mb];
                if (hb >= 4) {
                    f32x4 pv; pv.x = __shfl_xor(v.x, 32); pv.y = __shfl_xor(v.y, 32); pv.z = __shfl_xor(v.z, 32); pv.w = __shfl_xor(v.w, 32);
                    if (lat) { const int t = row & (T - 1); const int fb = (hb - 4) * 8 + 4 * (kq & 1);
                        const f32x4 c = *(const f32x4*)(rc + t * 16 + fb), s = *(const f32x4*)(rs + t * 16 + fb);
                        v = (kq < 2) ? (v * c - pv * s) : (v * c + pv * s); }
                }
                v = v * qs;
                v2u o; o.x = pk2(v.x, v.y); o.y = pk2(v.z, v.w);
                *(v2u*)(Q + (size_t)row * 384 + 16 * blk + 4 * kq) = o; } }
    }
    {
        const int hd = wave >> 1;
        if ((wave & 1) == 0) {
            f32x4 acc[4][4];
            small_gemm<128, 4, 4, true>(Akv, 136, WUKV, 64 * wave, acc, lane);
#pragma unroll
            for (int nb = 0; nb < 4; ++nb)
#pragma unroll
                for (int mb = 0; mb < 4; ++mb) { const int row = row0 + 16 * mb + lr; const f32x4 v = acc[nb][mb];
                    v2u o; o.x = pk2(v.x, v.y); o.y = pk2(v.z, v.w);
                    *(v2u*)(Kf + (size_t)row * 384 + hd * 96 + 16 * nb + 4 * kq) = o; }
        } else {
            f32x4 acc[4][4];
            small_gemm<128, 4, 4, false>(Akv, 136, WUKV, 64 * wave, acc, lane);
            const int bb = lat ? (row0 >> 12) : ((row0 - NLAT) >> 8);
            const int key0 = lat ? (TC + (row0 & (T - 1))) : ((row0 - NLAT) & (TC - 1));
#pragma unroll
            for (int nb = 0; nb < 4; ++nb)
#pragma unroll
                for (int mb = 0; mb < 4; ++mb) { const f32x4 v = acc[nb][mb];
                    v2u o; o.x = pk2(v.x, v.y); o.y = pk2(v.z, v.w);
                    *(v2u*)(Vt + ((size_t)(bb * 4 + hd) * 64 + 16 * nb + lr) * NKEY + key0 + 16 * mb + 4 * kq) = o; }
        }
    }
    __syncthreads();
}

DI void attn_unit(KArgs a, const Ctx& F, int b, int hd, int qrow0, int nkeys) {
    const bf16* Q = (const bf16*)(a->ws + WS_Q); const bf16* Kf = (const bf16*)(a->ws + WS_K); const bf16* Vt = (const bf16*)(a->ws + WS_VT);
    bf16* MO = (bf16*)(a->ws + WS_H);
    constexpr int KP = 208, VP = 144, BUF = 64 * KP + 64 * VP;
    const int tid = F.tid, lane = F.lane, wave = F.wave, l31 = lane & 31, h2 = lane >> 5;
    const int qrow = qrow0 + 32 * wave + l31;
    bf16x8 Qf[6];
#pragma unroll
    for (int s = 0; s < 6; ++s) Qf[s] = *(const bf16x8*)(Q + (size_t)qrow * 384 + hd * 96 + 16 * s + 8 * h2);
    const int kc0 = tid, kc1 = tid + 512;
    const int kr0 = kc0 / 12, kcc0 = kc0 % 12, kr1 = kc1 / 12, kcc1 = kc1 % 12; const bool k1v = kc1 < 768;
    const int vd = tid >> 3, vcc = tid & 7;
    const bf16* vbase = Vt + ((size_t)(b * 4 + hd) * 64 + vd) * NKEY + vcc * 8;
    v4u gk0, gk1, gv;
    auto gloadK = [&](int kt) {
        const int key0 = 64 * kt; const int krow = key0 < TC ? (NLAT + b * TC + key0) : (b * T + key0 - TC);
        gk0 = *(const v4u*)(Kf + (size_t)(krow + kr0) * 384 + hd * 96 + kcc0 * 8);
        if (k1v) gk1 = *(const v4u*)(Kf + (size_t)(krow + kr1) * 384 + hd * 96 + kcc1 * 8);
    };
    auto gloadV = [&](int kt) { gv = *(const v4u*)(vbase + 64 * kt); };
    auto lstoreK = [&](int buf) {
        LAS uchar* base = F.lds + buf * BUF;
        *(LAS v4u*)(base + kr0 * KP + kcc0 * 16) = gk0;
        if (k1v) *(LAS v4u*)(base + kr1 * KP + kcc1 * 16) = gk1;
    };
    auto lstoreV = [&](int buf) {
        LAS uchar* vp = F.lds + buf * BUF + 64 * KP + vd * VP + (vcc >> 1) * 32 + (vcc & 1) * 8;
        v2u lo_, hi_; lo_.x = gv.x; lo_.y = gv.y; hi_.x = gv.z; hi_.y = gv.w;
        *(LAS v2u*)vp = lo_; *(LAS v2u*)(vp + 16) = hi_;
    };
    const int nt = nkeys / 64;
    f32x16 O0, O1, negm;
#pragma unroll
    for (int r = 0; r < 16; ++r) { O0[r] = 0.f; O1[r] = 0.f; negm[r] = 0.f; }
    float lsum = 0.f;
    f32x16 s0, s1;
    gloadK(0); gloadV(0); lstoreK(0); lstoreV(0);
    gloadK(1); lstoreK(1);
    __syncthreads();
    {
        s0 = negm; s1 = negm;
#pragma unroll
        for (int s = 0; s < 6; ++s) {
            const bf16x8 ka = *(const LAS bf16x8*)(F.lds + l31 * KP + (16 * s + 8 * h2) * 2);
            const bf16x8 kb2 = *(const LAS bf16x8*)(F.lds + (32 + l31) * KP + (16 * s + 8 * h2) * 2);
            s0 = mfma32(ka, Qf[s], s0); s1 = mfma32(kb2, Qf[s], s1);
        }
    }
    for (int kt = 0; kt < nt; ++kt) {
        const bool more1 = kt + 1 < nt, more2 = kt + 2 < nt;
        if (more2) gloadK(kt + 2);
        if (more1) gloadV(kt + 1);
        float mx = fmaxf(fmaxf(s0[0], s0[1]), s0[2]);
#pragma unroll
        for (int r = 3; r < 15; r += 2) mx = fmaxf(fmaxf(mx, s0[r]), s0[r + 1]);
        mx = fmaxf(mx, s0[15]);
#pragma unroll
        for (int r = 0; r < 16; r += 2) mx = fmaxf(fmaxf(mx, s1[r]), s1[r + 1]);
        mx = fmaxf(mx, __shfl_xor(mx, 32));
        if (kt == 0 || __builtin_amdgcn_ballot_w64(mx > 8.0f) != 0ull) {
            const float dlt = (kt == 0) ? mx : fmaxf(mx, 0.f);
            const float alpha = (kt == 0) ? 1.0f : __builtin_amdgcn_exp2f(-dlt);
            lsum *= alpha;
#pragma unroll
            for (int r = 0; r < 16; ++r) { O0[r] *= alpha; O1[r] *= alpha; s0[r] -= dlt; s1[r] -= dlt; negm[r] -= dlt; }
        }
        f32x16 n0 = negm, n1 = negm;
        {
            const LAS uchar* kn_ = F.lds + ((kt + 1) & 1) * BUF;
#pragma unroll
            for (int s = 0; s < 6; ++s) {
                const bf16x8 ka = *(const LAS bf16x8*)(kn_ + l31 * KP + (16 * s + 8 * h2) * 2);
                const bf16x8 kb2 = *(const LAS bf16x8*)(kn_ + (32 + l31) * KP + (16 * s + 8 * h2) * 2);
                n0 = mfma32(ka, Qf[s], n0); n1 = mfma32(kb2, Qf[s], n1);
            }
        }
        const LAS uchar* vb_ = F.lds + (kt & 1) * BUF + 64 * KP;
        f32x2 ps2 = {0.f, 0.f};
#pragma unroll
        for (int kb = 0; kb < 2; ++kb)
#pragma unroll
            for (int sp = 0; sp < 2; ++sp) {
                f32x16& sx = kb ? s1 : s0;
#pragma unroll
                for (int r = 8 * sp; r < 8 * sp + 8; r += 2) { sx[r] = __builtin_amdgcn_exp2f(sx[r]); sx[r + 1] = __builtin_amdgcn_exp2f(sx[r + 1]); ps2 += (f32x2){sx[r], sx[r + 1]}; }
                const bf16x8 pf = pack8(sx[8 * sp + 0], sx[8 * sp + 1], sx[8 * sp + 2], sx[8 * sp + 3], sx[8 * sp + 4], sx[8 * sp + 5], sx[8 * sp + 6], sx[8 * sp + 7]);
                const int ko = (32 * kb + 16 * sp + 8 * h2) * 2;
                const bf16x8 va = *(const LAS bf16x8*)(vb_ + l31 * VP + ko), vc = *(const LAS bf16x8*)(vb_ + (32 + l31) * VP + ko);
                O0 = mfma32(va, pf, O0); O1 = mfma32(vc, pf, O1);
            }
        lsum += ps2.x + ps2.y;
        if (more2) lstoreK(kt & 1);
        if (more1) lstoreV((kt + 1) & 1);
        lds_barrier();
        s0 = n0; s1 = n1;
    }
    const float ltot = lsum + __shfl_xor(lsum, 32), inv = 1.0f / ltot;
    bf16* op = MO + (size_t)qrow * D + 256 + hd * 64;
#pragma unroll
    for (int gq = 0; gq < 4; ++gq) {
        v2u o; o.x = pk2(O0[4 * gq] * inv, O0[4 * gq + 1] * inv); o.y = pk2(O0[4 * gq + 2] * inv, O0[4 * gq + 3] * inv);
        *(v2u*)(op + 8 * gq + 4 * h2) = o;
        v2u o2; o2.x = pk2(O1[4 * gq] * inv, O1[4 * gq + 1] * inv); o2.y = pk2(O1[4 * gq + 2] * inv, O1[4 * gq + 3] * inv);
        *(v2u*)(op + 32 + 8 * gq + 4 * h2) = o2;
    }
}
DI float conv3(const bf16* Z, int b, int seg, int t, int len, int col, float w0, float w1, float w2, float cb) {
    const bf16* zp = Z + (size_t)tok_row(b, seg, t) * ZP + col;
    float y = cb + w1 * bf2f(zp[0]);
    if (t > 0) y += w0 * bf2f(zp[-ZP]);
    if (t + 1 < len) y += w2 * bf2f(zp[ZP]);
    return y;
}
DI bf16x8 ldperm(const LAS bf16* rowp, int k0, int hh) { const bf16x4 a0 = *(const LAS bf16x4*)(rowp + k0 + 4 * hh), a1 = *(const LAS bf16x4*)(rowp + k0 + 8 + 4 * hh); return __builtin_shufflevector(a0, a1, 0, 1, 2, 3, 4, 5, 6, 7); }
DI bf16x8 pack_acc(const f32x16& x, int s) { return s ? pack8(x[8], x[9], x[10], x[11], x[12], x[13], x[14], x[15]) : pack8(x[0], x[1], x[2], x[3], x[4], x[5], x[6], x[7]); }
DI void rwkv_scan_task(KArgs a, const Ctx& F, int l, int b, int hd, int dir) {
    const bf16* Z = (const bf16*)(a->ws + WS_ACT); bf16* YR = (bf16*)(a->ws + WS_YR) + (size_t)dir * NROWS * 256;
    constexpr int RAWSZ = 13056 + 4608;
    constexpr int FR_OFF = 4 * 4608 + 3 * 5120 + 256 + 2560;
    constexpr int SETSZ = FR_OFF + 6144;
    LAS uchar* const RAW0 = F.lds;
    LAS float* WL = (LAS float*)(F.lds + 2 * RAWSZ);
    LAS float* AL = WL + 2048;
    LAS float* Alw = AL + 2048;
    LAS float* CST = Alw + 512;
    LAS uchar* const SET0 = (LAS uchar*)(CST + 1024);
    const int tid = F.tid, lane = F.lane, wave = F.wave;
    const int hc = hd * 64 + lane;
    bf16x8 lf0 = {0, 0, 0, 0, 0, 0, 0, 0}, lf1 = lf0;
    if (wave >= 4) { const int w4 = wave - 4, l31 = lane & 31, hh = lane >> 5; const float* up = a->in[(w4 >> 1) ? I_RWUP : I_RAUP] + ((size_t)(l * 2 + dir) * 32) * 256 + hd * 64 + 32 * (w4 & 1) + l31;
        float u[16];
#pragma unroll
        for (int s = 0; s < 2; ++s)
#pragma unroll
            for (int j = 0; j < 8; ++j) u[8 * s + j] = up[(size_t)(16 * s + 8 * hh + j) * 256];
        lf0 = pack8(u[0], u[1], u[2], u[3], u[4], u[5], u[6], u[7]); lf1 = pack8(u[8], u[9], u[10], u[11], u[12], u[13], u[14], u[15]); }
    if (wave == 0) {
        const float* cw = a->in[I_RCW] + (size_t)l * 3 * 768; const float* cbp = a->in[I_RCB] + (size_t)l * 768;
        CST[0 * 64 + lane] = a->in[I_RW0][(l * 2 + dir) * 256 + hc]; CST[1 * 64 + lane] = a->in[I_RA0][(l * 2 + dir) * 256 + hc];
        CST[2 * 64 + lane] = a->in[I_RKK][l * 256 + hc]; CST[3 * 64 + lane] = a->in[I_RKA][l * 256 + hc];
#pragma unroll
        for (int j = 0; j < 3; ++j) { CST[(4 + j) * 64 + lane] = cw[j * 768 + hc]; CST[(7 + j) * 64 + lane] = cw[j * 768 + 256 + hc]; CST[(10 + j) * 64 + lane] = cw[j * 768 + 512 + hc]; }
        CST[13 * 64 + lane] = cbp[hc]; CST[14 * 64 + lane] = cbp[256 + hc]; CST[15 * 64 + lane] = cbp[512 + hc];
    }
    f32x16 ST0, ST1;
#pragma unroll
    for (int r = 0; r < 16; ++r) { ST0[r] = 0.f; ST1[r] = 0.f; }
    const int c0r = tid / 24, c0s = (tid % 24) >> 3, c0c = (tid % 24) & 7;
    const int c1 = tid + 512, c1r = c1 / 24, c1s = (c1 % 24) >> 3, c1c = (c1 % 24) & 7; const bool c1v = c1 < 816;
    const int lr_ = tid >> 3, lc_ = tid & 7;
    v4u g0, g1, g2;
    unsigned zz_ = 0u; asm volatile("" : "+v"(zz_)); const v4u zero4 = {zz_, zz_, zz_, zz_};
    const int nchC = TC / 32, nchT = nchC + T / 32;
    auto gload = [&](int gc) {
        const int seg = gc >= nchC, ch = seg ? gc - nchC : gc, len = seg ? T : TC;
        const int tbase = dir ? (len - 32 * (ch + 1)) : 32 * ch;
        { const int t = tbase - 1 + c0r; g0 = (t >= 0 && t < len) ? *(const v4u*)(Z + (size_t)tok_row(b, seg, t) * ZP + ZRKV + c0s * 256 + hd * 64 + c0c * 8) : zero4; }
        if (c1v) { const int t = tbase - 1 + c1r; g1 = (t >= 0 && t < len) ? *(const v4u*)(Z + (size_t)tok_row(b, seg, t) * ZP + ZRKV + c1s * 256 + hd * 64 + c1c * 8) : zero4; }
        if (tid < 256) { const int t = tbase + lr_; g2 = *(const v4u*)(Z + (size_t)tok_row(b, seg, t) * ZP + ZWD + lc_ * 8); }
    };
    auto lstore = [&](int par) {
        LAS bf16* Raw = (LAS bf16*)(RAW0 + par * RAWSZ); LAS bf16* LwB = (LAS bf16*)(RAW0 + par * RAWSZ + 13056);
        *(LAS v4u*)(Raw + c0r * 192 + c0s * 64 + c0c * 8) = g0;
        if (c1v) *(LAS v4u*)(Raw + c1r * 192 + c1s * 64 + c1c * 8) = g1;
        if (tid < 256) { float x[8] = {bflo(g2.x), bfhi(g2.x), bflo(g2.y), bfhi(g2.y), bflo(g2.z), bfhi(g2.z), bflo(g2.w), bfhi(g2.w)};
            if (lc_ < 4) {
#pragma unroll
                for (int j = 0; j < 8; ++j) x[j] = 1.0f - 2.0f * __builtin_amdgcn_rcpf(1.0f + fexp(2.0f * x[j])); }
            v4u w; w.x = pk2(x[0], x[1]); w.y = pk2(x[2], x[3]); w.z = pk2(x[4], x[5]); w.w = pk2(x[6], x[7]);
            *(LAS v4u*)(LwB + lr_ * 72 + lc_ * 8) = w; }
    };
    gload(0); lstore(0);
    __syncthreads();
    for (int n = -2; n < nchT; ++n) {
        if (n + 3 < nchT) gload(n + 3);
        int ln_ = lane; asm volatile("" : "+v"(ln_));
        const int l31 = ln_ & 31, hh = ln_ >> 5;
        if (wave < 2) {
            if (n >= 0) {
                const int seg = n >= nchC, ch = seg ? n - nchC : n, len = seg ? T : TC;
                const int tbase = dir ? (len - 32 * (ch + 1)) : 32 * ch;
                LAS uchar* sp = SET0 + (n & 1) * SETSZ;
                LAS bf16* KhT = (LAS bf16*)sp; LAS bf16* BhT = KhT + 32 * 72; LAS bf16* KkT = BhT + 32 * 72; LAS bf16* RhT = KkT + 32 * 72;
                LAS bf16* Kh = RhT + 32 * 72; LAS bf16* nBh = Kh + 64 * 40; LAS bf16* VT = nBh + 64 * 40; LAS float* GL = (LAS float*)(VT + 64 * 40); LAS bf16* TT = (LAS bf16*)(GL + 64);
                const int vcol = 32 * wave + l31;
                f32x16 accP, accY;
#pragma unroll
                for (int r = 0; r < 16; ++r) { accP[r] = 0.f; accY[r] = 0.f; }
#pragma unroll
                for (int kb = 0; kb < 2; ++kb)
#pragma unroll
                    for (int s = 0; s < 2; ++s) { const bf16x8 sb = pack_acc(kb ? ST1 : ST0, s);
                        accP = mfma32(ldperm(KkT + l31 * 72, 32 * kb + 16 * s, hh), sb, accP);
                        accY = mfma32(ldperm(RhT + l31 * 72, 32 * kb + 16 * s, hh), sb, accY); }
                const LAS bf16x8* FR = (const LAS bf16x8*)(sp + FR_OFF);
#pragma unroll
                for (int s = 0; s < 2; ++s) { const bf16x8 vt_ = ldperm(VT + vcol * 40, 16 * s, hh);
                    accP = mfma32(FR[(0 + s) * 64 + ln_], vt_, accP);
                    accY = mfma32(FR[(2 + s) * 64 + ln_], vt_, accY); }
                f32x16 accC;
#pragma unroll
                for (int r = 0; r < 16; ++r) accC[r] = 0.f;
#pragma unroll
                for (int s = 0; s < 2; ++s) accC = mfma32(ldperm(TT + l31 * 40, 16 * s, hh), pack_acc(accP, s), accC);
#pragma unroll
                for (int s = 0; s < 2; ++s) accY = mfma32(FR[(4 + s) * 64 + ln_], pack_acc(accC, s), accY);
#pragma unroll
                for (int s = 0; s < 2; ++s) { const bf16x8 vb_ = *(const LAS bf16x8*)(VT + vcol * 40 + 16 * s + 8 * hh); const bf16x8 cb_ = pack_acc(accC, s);
                    ST0 = mfma32(*(const LAS bf16x8*)(Kh + l31 * 40 + 16 * s + 8 * hh), vb_, ST0);
                    ST1 = mfma32(*(const LAS bf16x8*)(Kh + (32 + l31) * 40 + 16 * s + 8 * hh), vb_, ST1);
                    ST0 = mfma32(ldperm(nBh + l31 * 40, 16 * s, hh), cb_, ST0);
                    ST1 = mfma32(ldperm(nBh + (32 + l31) * 40, 16 * s, hh), cb_, ST1); }
#pragma unroll
                for (int r = 0; r < 16; ++r) { ST0[r] *= GL[crow(r, hh)]; ST1[r] *= GL[32 + crow(r, hh)]; }
#pragma unroll
                for (int r = 0; r < 16; ++r) { const int i = crow(r, hh), t = dir ? (tbase + 31 - i) : (tbase + i);
                    YR[(size_t)tok_row(b, seg, t) * 256 + hd * 64 + vcol] = (bf16)f2bf(accY[r]); }
            }
        } else if (wave == 2) {
            if (n + 1 >= 0 && n + 1 < nchT) {
                LAS uchar* sp = SET0 + ((n + 1) & 1) * SETSZ;
                LAS bf16* BhT = (LAS bf16*)sp + 32 * 72; LAS bf16* KkT = BhT + 32 * 72; LAS bf16* TT = (LAS bf16*)(sp + 4 * 4608 + 3 * 5120 + 256);
                f32x16 P, PT, Tm, TTm;
#pragma unroll
                for (int r = 0; r < 16; ++r) { P[r] = 0.f; PT[r] = 0.f; }
#pragma unroll
                for (int s = 0; s < 4; ++s) { const bf16x8 bh_ = *(const LAS bf16x8*)(BhT + l31 * 72 + 16 * s + 8 * hh), kk_ = *(const LAS bf16x8*)(KkT + l31 * 72 + 16 * s + 8 * hh);
                    P = mfma32(bh_, kk_, P); PT = mfma32(kk_, bh_, PT); }
#pragma unroll
                for (int r = 0; r < 16; ++r) { const int j = crow(r, hh);
                    P[r] = (j < l31) ? P[r] : 0.f; PT[r] = (j > l31) ? PT[r] : 0.f;
                    const float idv = (j == l31) ? 1.f : 0.f; Tm[r] = idv - P[r]; TTm[r] = idv - PT[r]; }
#pragma unroll
                for (int it = 0; it < 4; ++it) {
                    const bf16x8 p0 = pack_acc(P, 0), p1 = pack_acc(P, 1), q0 = pack_acc(PT, 0), q1 = pack_acc(PT, 1);
                    f32x16 P2, P2T;
#pragma unroll
                    for (int r = 0; r < 16; ++r) { P2[r] = 0.f; P2T[r] = 0.f; }
                    P2 = mfma32(q0, p0, P2); P2 = mfma32(q1, p1, P2);
                    if (it < 3) { P2T = mfma32(p0, q0, P2T); P2T = mfma32(p1, q1, P2T); }
                    const bf16x8 u0 = pack_acc(TTm, 0), u1 = pack_acc(TTm, 1);
                    const bf16x8 a0 = pack_acc(P2, 0), a1 = pack_acc(P2, 1);
                    Tm = mfma32(u0, a0, Tm); Tm = mfma32(u1, a1, Tm);
                    if (it < 3) { TTm = mfma32(a0, u0, TTm); TTm = mfma32(a1, u1, TTm); }
                    P = P2; PT = P2T;
                }
#pragma unroll
                for (int r = 0; r < 16; ++r) TT[l31 * 40 + crow(r, hh)] = (bf16)f2bf(Tm[r]);
            }
        } else if (wave == 3) {
            if (n + 1 >= 0 && n + 1 < nchT) {
                LAS uchar* sp = SET0 + ((n + 1) & 1) * SETSZ;
                LAS bf16* KhT = (LAS bf16*)sp; LAS bf16* BhT = KhT + 32 * 72; LAS bf16* KkT = BhT + 32 * 72; LAS bf16* RhT = KkT + 32 * 72;
                LAS bf16x8* FR = (LAS bf16x8*)(sp + FR_OFF);
                f32x16 a1, a2, a3;
#pragma unroll
                for (int r = 0; r < 16; ++r) { a1[r] = 0.f; a2[r] = 0.f; a3[r] = 0.f; }
#pragma unroll
                for (int s = 0; s < 4; ++s) { const bf16x8 kh_ = *(const LAS bf16x8*)(KhT + l31 * 72 + 16 * s + 8 * hh), kk_ = *(const LAS bf16x8*)(KkT + l31 * 72 + 16 * s + 8 * hh),
                                                             rh_ = *(const LAS bf16x8*)(RhT + l31 * 72 + 16 * s + 8 * hh), bh_ = *(const LAS bf16x8*)(BhT + l31 * 72 + 16 * s + 8 * hh);
                    a1 = mfma32(kh_, kk_, a1); a2 = mfma32(kh_, rh_, a2); a3 = mfma32(bh_, rh_, a3); }
#pragma unroll
                for (int r = 0; r < 16; ++r) { const int j = crow(r, hh); a1[r] = (j < l31) ? a1[r] : 0.f; a2[r] = (j <= l31) ? a2[r] : 0.f; a3[r] = (j <= l31) ? -a3[r] : 0.f; }
#pragma unroll
                for (int s = 0; s < 2; ++s) { FR[(0 + s) * 64 + ln_] = pack_acc(a1, s); FR[(2 + s) * 64 + ln_] = pack_acc(a2, s); FR[(4 + s) * 64 + ln_] = pack_acc(a3, s); }
            }
        } else if (wave >= 4) {
            if (n + 2 < nchT) {
                const int w4 = wave - 4, mat = (w4 >> 1) ^ 1;
                const LAS bf16* LwB = (const LAS bf16*)(RAW0 + ((n + 2) & 1) * RAWSZ + 13056);
                f32x16 acc;
#pragma unroll
                for (int r = 0; r < 16; ++r) acc[r] = 0.f;
                const int ko = mat * 32, arow = dir ? (31 - l31) : l31, cch = 32 * (w4 & 1) + l31;
                acc = mfma32(*(const LAS bf16x8*)(LwB + arow * 72 + ko + 8 * hh), lf0, acc);
                acc = mfma32(*(const LAS bf16x8*)(LwB + arow * 72 + ko + 16 + 8 * hh), lf1, acc);
                const float c0_ = CST[mat * 64 + cch];
                if (mat) {
#pragma unroll
                    for (int r = 0; r < 16; ++r) AL[crow(r, hh) * 64 + cch] = __builtin_amdgcn_rcpf(1.0f + fexp(-(acc[r] + c0_)));
                } else {
#pragma unroll
                    for (int r = 0; r < 16; ++r) acc[r] = -0.60653065971f * __builtin_amdgcn_rcpf(1.0f + fexp(-(acc[r] + c0_)));
                    float off = 0.f;
#pragma unroll
                    for (int g = 0; g < 4; ++g) {
                        acc[4 * g + 1] += acc[4 * g]; acc[4 * g + 2] += acc[4 * g + 1]; acc[4 * g + 3] += acc[4 * g + 2];
                        const float tg = acc[4 * g + 3], ug = __shfl_xor(tg, 32);
                        const float o = off + (hh ? ug : 0.f);
#pragma unroll
                        for (int e = 0; e < 4; ++e) acc[4 * g + e] += o;
                        off += tg + ug;
                    }
#pragma unroll
                    for (int r = 0; r < 16; ++r) WL[crow(r, hh) * 64 + cch] = acc[r];
                }
            }
        }
        lds_barrier();
#ifdef DBG_REP_R23
        for (int rp_ = 0; rp_ < 2; ++rp_) {
#else
        {
#endif
        const bool pv = n + 2 < nchT;
        const int pi = tid >> 4, c4 = (ln_ & 15) * 4, pjr = dir ? (32 - pi) : (pi + 1);
        if (pv) {
            LAS uchar* sp = SET0 + (n & 1) * SETSZ;
            LAS bf16* KhT = (LAS bf16*)sp; LAS bf16* BhT = KhT + 32 * 72; LAS bf16* KkT = BhT + 32 * 72; LAS bf16* RhT = KkT + 32 * 72;
            LAS bf16* Kh = RhT + 32 * 72; LAS bf16* nBh = Kh + 64 * 40; LAS bf16* VT = nBh + 64 * 40; LAS float* GL = (LAS float*)(VT + 64 * 40);
            const LAS bf16* Raw = (const LAS bf16*)(RAW0 + (n & 1) * RAWSZ);
            const f32x4 cum = *(const LAS f32x4*)(WL + pi * 64 + c4);
            f32x4 cpv = *(const LAS f32x4*)(WL + (pi ? pi - 1 : 0) * 64 + c4);
            if (pi == 0) cpv = (f32x4){0.f, 0.f, 0.f, 0.f};
            float rr[4], kv[4], vv[4];
            { const f32x4 br = *(const LAS f32x4*)(CST + 13 * 64 + c4), bk = *(const LAS f32x4*)(CST + 14 * 64 + c4), bv = *(const LAS f32x4*)(CST + 15 * 64 + c4);
#pragma unroll
              for (int e = 0; e < 4; ++e) { rr[e] = br[e]; kv[e] = bk[e]; vv[e] = bv[e]; } }
#pragma unroll
            for (int tap = 0; tap < 3; ++tap) {
                const LAS bf16* rp = Raw + (pjr - 1 + tap) * 192 + c4;
                const v2u xr = *(const LAS v2u*)rp, xk = *(const LAS v2u*)(rp + 64), xv = *(const LAS v2u*)(rp + 128);
                const f32x4 wr = *(const LAS f32x4*)(CST + (4 + tap) * 64 + c4), wk = *(const LAS f32x4*)(CST + (7 + tap) * 64 + c4), wv = *(const LAS f32x4*)(CST + (10 + tap) * 64 + c4);
                rr[0] += wr[0] * bflo(xr.x); rr[1] += wr[1] * bfhi(xr.x); rr[2] += wr[2] * bflo(xr.y); rr[3] += wr[3] * bfhi(xr.y);
                kv[0] += wk[0] * bflo(xk.x); kv[1] += wk[1] * bfhi(xk.x); kv[2] += wk[2] * bflo(xk.y); kv[3] += wk[3] * bfhi(xk.y);
                vv[0] += wv[0] * bflo(xv.x); vv[1] += wv[1] * bfhi(xv.x); vv[2] += wv[2] * bflo(xv.y); vv[3] += wv[3] * bfhi(xv.y);
            }
            const f32x4 kkc4 = *(const LAS f32x4*)(CST + 2 * 64 + c4), kac4 = *(const LAS f32x4*)(CST + 3 * 64 + c4);
            const f32x4 av4 = *(const LAS f32x4*)(AL + pi * 64 + c4);
            float kx[4]; float ss = 0.f;
#pragma unroll
            for (int e = 0; e < 4; ++e) { kx[e] = kv[e] * kkc4[e]; ss += kx[e] * kx[e]; }
            ss = sum16(ss);
            const float rn = __builtin_amdgcn_rcpf(fmaxf(__builtin_amdgcn_sqrtf(ss), 1e-12f));
            float kh[4], bh[4], kk_[4], rh[4];
#pragma unroll
            for (int e = 0; e < 4; ++e) { const float av = av4[e], kn = kx[e] * rn, en = fexp(-cum[e]), ep = fexp(cum[e]), epv = fexp(cpv[e]);
                kh[e] = kv[e] * (1.0f + (av - 1.0f) * kac4[e]) * en; bh[e] = kn * av * en; kk_[e] = kn * epv; rh[e] = rr[e] * ep; }
            v2u o;
            o.x = pk2(kh[0], kh[1]); o.y = pk2(kh[2], kh[3]); *(LAS v2u*)(KhT + pi * 72 + c4) = o;
            o.x = pk2(bh[0], bh[1]); o.y = pk2(bh[2], bh[3]); *(LAS v2u*)(BhT + pi * 72 + c4) = o;
            o.x = pk2(kk_[0], kk_[1]); o.y = pk2(kk_[2], kk_[3]); *(LAS v2u*)(KkT + pi * 72 + c4) = o;
            o.x = pk2(rh[0], rh[1]); o.y = pk2(rh[2], rh[3]); *(LAS v2u*)(RhT + pi * 72 + c4) = o;
#pragma unroll
            for (int e = 0; e < 4; ++e) { Kh[(c4 + e) * 40 + pi] = (bf16)f2bf(kh[e]); nBh[(c4 + e) * 40 + pi] = (bf16)f2bf(-bh[e]); VT[(c4 + e) * 40 + pi] = (bf16)f2bf(vv[e]); }
            if (pi == 31) *(LAS f32x4*)(GL + c4) = (f32x4){fexp(cum[0]), fexp(cum[1]), fexp(cum[2]), fexp(cum[3])};
        }
        }
        if (n + 3 < nchT) lstore((n + 3) & 1);
        lds_barrier();
    }
}

DI void mlstm_task(KArgs a, const Ctx& F, int l, int b, int hd) {
    const bf16* Z = (const bf16*)(a->ws + WS_ACT);
    const int tid = F.tid, lane = F.lane, wave = F.wave, dir = wave >> 2, w2 = wave & 3, tid2 = tid & 255, l31 = lane & 31, hh = lane >> 5;
    bf16* YM = (bf16*)(a->ws + WS_YM) + (size_t)dir * NROWS * 256;
    constexpr int HP = 72;
    constexpr int HALF_LDS = 6 * 9216 + 2304 + 2048;
    LAS uchar* base = F.lds + dir * HALF_LDS;
    LAS bf16* Qc = (LAS bf16*)base; LAS bf16* Kc = Qc + 64 * HP; LAS bf16* KT = Kc + 64 * HP; LAS bf16* VT = KT + 64 * HP; LAS bf16* Cb0 = VT + 64 * HP;
    LAS float* fv = (LAS float*)(base + 6 * 9216);
    LAS float* Vgv = fv; LAS float* VMr = fv + 64; LAS float* Vwi = fv + 128; LAS float* Vem = fv + 192; LAS float* Vwk = fv + 256; LAS float* Vn0 = fv + 320; LAS float* Vsc = fv + 448;
    LAS float* Cw = fv + 576;
    for (int i = tid2; i < 2 * 64 * HP; i += 256) Cb0[i] = 0;
    if (tid2 < 128) Vn0[tid2] = 0.f;
    { const float* cw = a->in[I_MCW] + (size_t)l * 3 * 512; const float* cbp = a->in[I_MCB] + (size_t)l * 512;
      for (int i = tid2; i < 512; i += 256) { const int tap = i >> 7, cc = i & 127, col = (cc < 64) ? (hd * 64 + cc) : (256 + hd * 64 + cc - 64);
          Cw[i] = (tap < 3) ? cw[tap * 512 + col] : cbp[col]; } }
    f32x16 accC;
#pragma unroll
    for (int r = 0; r < 16; ++r) accC[r] = 0.f;
    float m_run = 0.f;
    const int eb = w2 >> 1, lb = w2 & 1;
    const float gbi = a->in[I_MGB][l * 16 + dir * 8 + hd], gbf = a->in[I_MGB][l * 16 + dir * 8 + 4 + hd];
    const int nchC = TC / 64, nchT = nchC + T / 64;
    const int pi_ = tid2 >> 2, qq = tid2 & 3;
    v4u rq[3][2], rk[3][2], rv[2]; unsigned gr0 = 0u, gr1 = 0u;
    unsigned zz_ = 0u; asm volatile("" : "+v"(zz_)); const v4u zero4 = {zz_, zz_, zz_, zz_};
    auto gload = [&](int gc) {
        const int seg = gc >= nchC, ch = seg ? gc - nchC : gc, len = seg ? T : TC;
        const int tbase = dir ? (len - 64 * (ch + 1)) : 64 * ch;
        const int t = tbase + (dir ? (63 - pi_) : pi_);
#pragma unroll
        for (int tap = 0; tap < 3; ++tap) { const int tt = t - 1 + tap; const bool ok = tt >= 0 && tt < len;
            const bf16* zp = Z + (size_t)tok_row(b, seg, ok ? tt : t) * ZP + ZMQK + hd * 64 + qq * 16;
            rq[tap][0] = ok ? *(const v4u*)zp : zero4; rq[tap][1] = ok ? *(const v4u*)(zp + 8) : zero4;
            rk[tap][0] = ok ? *(const v4u*)(zp + 256) : zero4; rk[tap][1] = ok ? *(const v4u*)(zp + 264) : zero4; }
        { const bf16* zp = Z + (size_t)tok_row(b, seg, t) * ZP + ZMV + hd * 64 + qq * 16; rv[0] = *(const v4u*)zp; rv[1] = *(const v4u*)(zp + 8); }
        if (tid2 < 64) { const bf16* zp = Z + (size_t)tok_row(b, seg, tbase + tid2) * ZP + ZMG + dir * 8 + hd; gr0 = zp[0]; gr1 = zp[4]; }
    };
    gload(0);
    __syncthreads();
    for (int gc = 0; gc < nchT; ++gc) {
        const int seg = gc >= nchC, ch = seg ? gc - nchC : gc, len = seg ? T : TC;
        const int tbase = dir ? (len - 64 * (ch + 1)) : 64 * ch;
        LAS bf16* Cb = Cb0 + (gc & 1) * 64 * HP; LAS bf16* CbN = Cb0 + ((gc + 1) & 1) * 64 * HP;
        LAS float* Vn = Vn0 + (gc & 1) * 64; LAS float* VnN = Vn0 + ((gc + 1) & 1) * 64;
        if (w2 == 0) {
            float li = bf2f(gr0) + gbi; const float fraw = bf2f(gr1) + gbf;
            float lf = fminf(fraw, 0.f) - 0.69314718056f * __builtin_amdgcn_logf(1.0f + fexp(-fabsf(fraw)));
            if (dir) { li = __shfl(li, 63 - lane); lf = __shfl(lf, 63 - lane); }
            const float bc = wave_scan_sum(lf);
            const float g = li - bc; const float pm = wave_scan_max(g);
            const float mprev = m_run;
            const float blast = __shfl(bc, 63);
            const float lw = blast - bc + li;
            const float mnew = fmaxf(blast + mprev, wave_max(lw));
            const float Mr = fmaxf(mprev, pm);
            Vgv[lane] = g; VMr[lane] = Mr; Vwi[lane] = fexp(mprev - Mr); Vem[lane] = fexp(-bc - Mr); Vwk[lane] = fexp(lw - mnew);
            if (lane == 0) Vsc[0] = fexp(blast + mprev - mnew);
            m_run = mnew;
        }
        {
            float qv[16], kvv[16];
#pragma unroll
            for (int j = 0; j < 16; ++j) { qv[j] = Cw[384 + qq * 16 + j]; kvv[j] = Cw[384 + 64 + qq * 16 + j]; }
#pragma unroll
            for (int tap = 0; tap < 3; ++tap) {
                const unsigned qw[8] = {rq[tap][0].x, rq[tap][0].y, rq[tap][0].z, rq[tap][0].w, rq[tap][1].x, rq[tap][1].y, rq[tap][1].z, rq[tap][1].w};
                const unsigned kw[8] = {rk[tap][0].x, rk[tap][0].y, rk[tap][0].z, rk[tap][0].w, rk[tap][1].x, rk[tap][1].y, rk[tap][1].z, rk[tap][1].w};
#pragma unroll
                for (int j = 0; j < 8; ++j) { qv[2 * j] += Cw[tap * 128 + qq * 16 + 2 * j] * bflo(qw[j]); qv[2 * j + 1] += Cw[tap * 128 + qq * 16 + 2 * j + 1] * bfhi(qw[j]);
                    kvv[2 * j] += Cw[tap * 128 + 64 + qq * 16 + 2 * j] * bflo(kw[j]); kvv[2 * j + 1] += Cw[tap * 128 + 64 + qq * 16 + 2 * j + 1] * bfhi(kw[j]); }
            }
#pragma unroll
            for (int j = 0; j < 16; ++j) { qv[j] = qv[j] * fsigmoid(qv[j]); kvv[j] = kvv[j] * fsigmoid(kvv[j]) * 0.125f; }
#pragma unroll
            for (int j = 0; j < 16; j += 2) { *(LAS unsigned*)(Qc + pi_ * HP + qq * 16 + j) = pk2(qv[j], qv[j + 1]); *(LAS unsigned*)(Kc + pi_ * HP + qq * 16 + j) = pk2(kvv[j], kvv[j + 1]); }
            const unsigned vw[8] = {rv[0].x, rv[0].y, rv[0].z, rv[0].w, rv[1].x, rv[1].y, rv[1].z, rv[1].w};
#pragma unroll
            for (int j = 0; j < 16; ++j) { KT[(qq * 16 + j) * HP + pi_] = (bf16)f2bf(kvv[j]); VT[(qq * 16 + j) * HP + pi_] = (bf16)((j & 1) ? (vw[j >> 1] >> 16) : (vw[j >> 1] & 0xffffu)); }
        }
        if (gc + 1 < nchT) gload(gc + 1);
        lds_barrier();
        {
            const int lidx = 32 * lb + l31;
            f32x16 accN, accI;
#pragma unroll
            for (int r = 0; r < 16; ++r) { accN[r] = 0.f; accI[r] = 0.f; }
            float dsum = 0.f;
            const float Mr = VMr[lidx];
#pragma unroll
            for (int sb = 0; sb < 2; ++sb) {
                if (sb <= lb) {
                    f32x16 sT;
#pragma unroll
                    for (int r = 0; r < 16; ++r) sT[r] = 0.f;
#pragma unroll
                    for (int s = 0; s < 4; ++s) {
                        const bf16x8 ka = *(const LAS bf16x8*)(Kc + (32 * sb + l31) * HP + 16 * s + 8 * hh);
                        const bf16x8 qb = *(const LAS bf16x8*)(Qc + lidx * HP + 16 * s + 8 * hh);
                        sT = mfma32(ka, qb, sT);
                    }
#pragma unroll
                    for (int g4 = 0; g4 < 4; ++g4) { const f32x4 gv4 = *(const LAS f32x4*)(Vgv + 32 * sb + 8 * g4 + 4 * hh);
#pragma unroll
                        for (int e = 0; e < 4; ++e) { const int r = 4 * g4 + e, sidx = 32 * sb + 8 * g4 + 4 * hh + e;
                            const float ex = fexp(fminf(gv4[e] - Mr, 0.f));
                            const float p = (sidx <= lidx) ? sT[r] * ex : 0.f; sT[r] = p; dsum += p; } }
#pragma unroll
                    for (int sp = 0; sp < 2; ++sp) {
                        const bf16x8 pf = pack8(sT[8 * sp + 0], sT[8 * sp + 1], sT[8 * sp + 2], sT[8 * sp + 3], sT[8 * sp + 4], sT[8 * sp + 5], sT[8 * sp + 6], sT[8 * sp + 7]);
                        const int ko = 32 * sb + 16 * sp + 4 * hh;
                        const bf16x4 a0 = *(const LAS bf16x4*)(VT + (32 * eb + l31) * HP + ko), a1 = *(const LAS bf16x4*)(VT + (32 * eb + l31) * HP + ko + 8);
                        accN = mfma32(__builtin_shufflevector(a0, a1, 0, 1, 2, 3, 4, 5, 6, 7), pf, accN);
                    }
                }
            }
#pragma unroll
            for (int s = 0; s < 4; ++s) {
                const bf16x8 ca = *(const LAS bf16x8*)(Cb + (32 * eb + l31) * HP + 16 * s + 8 * hh);
                const bf16x8 qb = *(const LAS bf16x8*)(Qc + lidx * HP + 16 * s + 8 * hh);
                accI = mfma32(ca, qb, accI);
            }
            dsum += __shfl_xor(dsum, 32);
            float nq = 0.f;
#pragma unroll
            for (int j = 0; j < 64; j += 8) { const v4u w = *(const LAS v4u*)(Qc + lidx * HP + j); const f32x4 n0 = *(const LAS f32x4*)(Vn + j), n1 = *(const LAS f32x4*)(Vn + j + 4);
                nq += (n0[0] * bflo(w.x) + n0[1] * bfhi(w.x)) + (n0[2] * bflo(w.y) + n0[3] * bfhi(w.y)) + (n1[0] * bflo(w.z) + n1[1] * bfhi(w.z)) + (n1[2] * bflo(w.w) + n1[3] * bfhi(w.w)); }
            const float wi = Vwi[lidx];
            const float den = dsum + wi * nq, hden = fmaxf(fabsf(den), Vem[lidx]), inv = __builtin_amdgcn_rcpf(hden);
            const int t = dir ? (tbase + 63 - lidx) : (tbase + lidx);
            bf16* op = YM + (size_t)tok_row(b, seg, t) * 256 + hd * 64 + 32 * eb;
#pragma unroll
            for (int gq_ = 0; gq_ < 4; ++gq_) {
                const float h0 = (accN[4 * gq_] + wi * accI[4 * gq_]) * inv, h1 = (accN[4 * gq_ + 1] + wi * accI[4 * gq_ + 1]) * inv, h2 = (accN[4 * gq_ + 2] + wi * accI[4 * gq_ + 2]) * inv, h3 = (accN[4 * gq_ + 3] + wi * accI[4 * gq_ + 3]) * inv;
                v2u o; o.x = pk2(h0, h1); o.y = pk2(h2, h3);
                *(v2u*)(op + 8 * gq_ + 4 * hh) = o;
            }
        }
        {
            const float sc = Vsc[0];
#pragma unroll
            for (int r = 0; r < 16; ++r) accC[r] *= sc;
#pragma unroll
            for (int s = 0; s < 4; ++s) {
                const v4u vraw = *(const LAS v4u*)(VT + (32 * eb + l31) * HP + 16 * s + 8 * hh);
                const f32x4 w0 = *(const LAS f32x4*)(Vwk + 16 * s + 8 * hh), w1 = *(const LAS f32x4*)(Vwk + 16 * s + 8 * hh + 4);
                const bf16x8 va = pack8(bflo(vraw.x) * w0[0], bfhi(vraw.x) * w0[1], bflo(vraw.y) * w0[2], bfhi(vraw.y) * w0[3], bflo(vraw.z) * w1[0], bfhi(vraw.z) * w1[1], bflo(vraw.w) * w1[2], bfhi(vraw.w) * w1[3]);
                const bf16x8 kb = *(const LAS bf16x8*)(KT + (32 * lb + l31) * HP + 16 * s + 8 * hh);
                accC = mfma32(va, kb, accC);
            }
#pragma unroll
            for (int r = 0; r < 16; ++r) CbN[(32 * eb + crow(r, hh)) * HP + 32 * lb + l31] = (bf16)f2bf(accC[r]);
            if (tid2 < 64) { float s = 0.f;
#pragma unroll
                for (int j = 0; j < 64; j += 8) { const v4u w = *(const LAS v4u*)(KT + tid2 * HP + j); const f32x4 w0 = *(const LAS f32x4*)(Vwk + j), w1 = *(const LAS f32x4*)(Vwk + j + 4);
                    s += (w0[0] * bflo(w.x) + w0[1] * bfhi(w.x)) + (w0[2] * bflo(w.y) + w0[3] * bfhi(w.y)) + (w1[0] * bflo(w.z) + w1[1] * bfhi(w.z)) + (w1[2] * bflo(w.w) + w1[3] * bfhi(w.w)); }
                VnN[tid2] = sc * Vn[tid2] + s; }
        }
        lds_barrier();
    }
}
DI float gelu_tanh(float x) { const float u = 0.7978845608028654f * (x + 0.044715f * x * x * x); const float e = __expf(2.0f * u); const float th = 1.0f - 2.0f / (e + 1.0f); return 0.5f * x * (1.0f + th); }
DI void unpack8(const v4u w, float (&o)[8]) { o[0] = bflo(w.x); o[1] = bfhi(w.x); o[2] = bflo(w.y); o[3] = bfhi(w.y); o[4] = bflo(w.z); o[5] = bfhi(w.z); o[6] = bflo(w.w); o[7] = bfhi(w.w); }
DI v4u pack8u(const float (&o)[8]) { v4u w; w.x = pk2(o[0], o[1]); w.y = pk2(o[2], o[3]); w.z = pk2(o[4], o[5]); w.w = pk2(o[6], o[7]); return w; }
constexpr int FIN_CST_OFF = 56320;
DI void fin_load_consts(KArgs a, const Ctx& F, int l) {
    LAS float* C = (LAS float*)(F.lds + FIN_CST_OFF);
    for (int i = F.tid; i < 4608; i += NTHR) {
        float v;
        if (i < 2304) v = a->in[I_RCW][(size_t)l * 2304 + i];
        else if (i < 3072) v = a->in[I_RCB][(size_t)l * 768 + (i - 2304)];
        else if (i < 3328) v = a->in[I_RRK][l * 256 + (i - 3072)];
        else if (i < 3584) v = a->in[I_RLNW][l * 256 + (i - 3328)];
        else if (i < 3840) v = a->in[I_RLNB][l * 256 + (i - 3584)];
        else if (i < 4096) v = a->in[I_MNORM][l * 256 + (i - 3840)];
        else if (i < 4352) v = a->in[I_S5D][l * 256 + (i - 4096)];
        else v = a->in[I_S5BGLU][l * 256 + (i - 4352)];
        C[i] = v;
    }
    __syncthreads();
}
DI void fin_tile(KArgs a, const Ctx& F, int l, int tile) {
    const LAS float* CT = (const LAS float*)(F.lds + FIN_CST_OFF);
    const bf16* Z = (const bf16*)(a->ws + WS_ACT); bf16* MO = (bf16*)(a->ws + WS_H);
    const bf16* YS = (const bf16*)(a->ws + WS_YS5); const bf16* YR = (const bf16*)(a->ws + WS_YR); const bf16* YM = (const bf16*)(a->ws + WS_YM);
    const bf16* WGLU = (const bf16*)(a->ws + WS_SMALLW + SW_GLU); const bf16* WGUP = (const bf16*)(a->ws + WS_SMALLW + SW_GUP);
    LAS bf16* Az = (LAS bf16*)F.lds;
    LAS bf16* Ag = (LAS bf16*)(F.lds + 16896);
    LAS float* Pr = (LAS float*)(F.lds + 16896 + 4608);
    int tl_ = F.tid; asm volatile("" : "+v"(tl_));
    const int tid = tl_, lane = tid & 63, wave = F.wave, row0 = tile * 32;
    const int i = tid >> 4, part = tid & 15, row = row0 + i;
    const size_t DS = (size_t)NROWS * 256;
    const bf16* zr = Z + (size_t)row * ZP;
    {
        const LAS float* dsk = CT + 4096 + part * 16;
#pragma unroll
        for (int j = 0; j < 2; ++j) { const int c0 = part * 16 + 8 * j; float y0[8], y1[8], u[8], z[8];
            unpack8(*(const v4u*)(YS + (size_t)row * 256 + c0), y0); unpack8(*(const v4u*)(YS + DS + (size_t)row * 256 + c0), y1); unpack8(*(const v4u*)(zr + ZS5 + c0), u);
#pragma unroll
            for (int e = 0; e < 8; ++e) z[e] = gelu_tanh(y0[e] + y1[e] + dsk[8 * j + e] * u[e]);
            *(LAS v4u*)(Az + i * 264 + c0) = pack8u(z); }
    }
    const int hq = part >> 2, c0 = hq * 64 + (part & 3) * 16;
    const bool lat = row < NLAT; const int t = lat ? (row & (T - 1)) : ((row - NLAT) & (TC - 1)); const int len = lat ? T : TC;
    {
        float y[16]; float s = 0.f;
#pragma unroll
        for (int j = 0; j < 2; ++j) { float y0[8], y1[8]; unpack8(*(const v4u*)(YM + (size_t)row * 256 + c0 + 8 * j), y0); unpack8(*(const v4u*)(YM + DS + (size_t)row * 256 + c0 + 8 * j), y1);
#pragma unroll
            for (int e = 0; e < 8; ++e) { y[8 * j + e] = y0[e] + y1[e]; s += y[8 * j + e]; } }
        s += __shfl_xor(s, 1); s += __shfl_xor(s, 2); const float mu = s * (1.0f / 64.0f); float q = 0.f;
#pragma unroll
        for (int j = 0; j < 16; ++j) { y[j] -= mu; q += y[j] * y[j]; }
        q += __shfl_xor(q, 1); q += __shfl_xor(q, 2); const float rstd = 1.0f / sqrtf(q * (1.0f / 64.0f) + 1e-6f);
        const LAS float* nw = CT + 3840 + c0;
#pragma unroll
        for (int j = 0; j < 2; ++j) { float o[8]; unpack8(*(const v4u*)(zr + ZMO + c0 + 8 * j), o);
#pragma unroll
            for (int e = 0; e < 8; ++e) o[e] = y[8 * j + e] * rstd * nw[8 * j + e] * fsigmoid(o[e]);
            *(v4u*)(MO + (size_t)row * D + 768 + c0 + 8 * j) = pack8u(o); }
    }
    {
        float y[16]; float s = 0.f;
#pragma unroll
        for (int j = 0; j < 2; ++j) { float y0[8], y1[8]; unpack8(*(const v4u*)(YR + (size_t)row * 256 + c0 + 8 * j), y0); unpack8(*(const v4u*)(YR + DS + (size_t)row * 256 + c0 + 8 * j), y1);
#pragma unroll
            for (int e = 0; e < 8; ++e) { y[8 * j + e] = y0[e] + y1[e]; s += y[8 * j + e]; } }
        s += __shfl_xor(s, 1); s += __shfl_xor(s, 2); const float mu = s * (1.0f / 64.0f); float q = 0.f;
#pragma unroll
        for (int j = 0; j < 16; ++j) { y[j] -= mu; q += y[j] * y[j]; }
        q += __shfl_xor(q, 1); q += __shfl_xor(q, 2); const float rstd = 1.0f / sqrtf(q * (1.0f / 64.0f) + 64e-5f);
        const LAS float* cw = CT; const LAS float* cbp = CT + 2304;
        const LAS float* rk = CT + 3072 + c0; const LAS float* lw = CT + 3328 + c0; const LAS float* lb = CT + 3584 + c0;
        float vv[16]; float bs = 0.f;
#pragma unroll
        for (int j = 0; j < 2; ++j) { const int c = c0 + 8 * j;
            float rr[8], kk[8], v[8], x[8];
#pragma unroll
            for (int e = 0; e < 8; ++e) { rr[e] = cbp[c + e]; kk[e] = cbp[256 + c + e]; v[e] = cbp[512 + c + e]; }
#pragma unroll
            for (int tap = 0; tap < 3; ++tap) { const int tt = t - 1 + tap;
                const bool ok = tt >= 0 && tt < len;
                const float okf = ok ? 1.0f : 0.0f;
                const bf16* zp = zr + (ok ? (tap - 1) * ZP : 0) + ZRKV + c;
                unpack8(*(const v4u*)zp, x);
#pragma unroll
                for (int e = 0; e < 8; ++e) rr[e] += (cw[tap * 768 + c + e] * okf) * x[e];
                unpack8(*(const v4u*)(zp + 256), x);
#pragma unroll
                for (int e = 0; e < 8; ++e) kk[e] += (cw[tap * 768 + 256 + c + e] * okf) * x[e];
                unpack8(*(const v4u*)(zp + 512), x);
#pragma unroll
                for (int e = 0; e < 8; ++e) v[e] += (cw[tap * 768 + 512 + c + e] * okf) * x[e]; }
#pragma unroll
            for (int e = 0; e < 8; ++e) { bs += rr[e] * kk[e] * rk[8 * j + e]; vv[8 * j + e] = v[e]; } }
        bs += __shfl_xor(bs, 1); bs += __shfl_xor(bs, 2);
#pragma unroll
        for (int j = 0; j < 16; j += 4) *(LAS f32x4*)(Pr + i * 260 + c0 + j) = (f32x4){y[j] * rstd * lw[j] + lb[j] + bs * vv[j], y[j + 1] * rstd * lw[j + 1] + lb[j + 1] + bs * vv[j + 1], y[j + 2] * rstd * lw[j + 2] + lb[j + 2] + bs * vv[j + 2], y[j + 3] * rstd * lw[j + 3] + lb[j + 3] + bs * vv[j + 3]};
    }
    {
        const v2u gv = *(const v2u*)(zr + ZGD + part * 4);
        v2u o; o.x = pk2(fsigmoid(bflo(gv.x)), fsigmoid(bfhi(gv.x))); o.y = pk2(fsigmoid(bflo(gv.y)), fsigmoid(bfhi(gv.y)));
        *(LAS v2u*)(Ag + i * 72 + part * 4) = o;
    }
    __syncthreads();
    const int lr = lane & 15, kq = lane >> 4;
    {
        f32x4 acc[2][2];
        small_gemm<256, 2, 2, true>(Az, 264, WGLU, 32 * wave, acc, lane);
        const LAS float* bg = CT + 4352;
#pragma unroll
        for (int nb = 0; nb < 2; ++nb)
#pragma unroll
            for (int mb = 0; mb < 2; ++mb) { const int tk = 16 * mb + lr, n = 32 * wave + 16 * nb + 4 * kq; const f32x4 v = acc[nb][mb]; const f32x4 b4 = *(const LAS f32x4*)(bg + n);
                const v2u zz = *(const LAS v2u*)(Az + tk * 264 + n);
                const float o0 = bflo(zz.x) * fsigmoid(v.x + b4.x), o1 = bfhi(zz.x) * fsigmoid(v.y + b4.y), o2 = bflo(zz.y) * fsigmoid(v.z + b4.z), o3 = bfhi(zz.y) * fsigmoid(v.w + b4.w);
                v2u o; o.x = pk2(o0, o1); o.y = pk2(o2, o3);
                *(v2u*)(MO + (size_t)(row0 + tk) * D + n) = o; }
    }
    {
        f32x4 acc[2][2];
        small_gemm<64, 2, 2, true>(Ag, 72, WGUP, 32 * wave, acc, lane);
#pragma unroll
        for (int nb = 0; nb < 2; ++nb)
#pragma unroll
            for (int mb = 0; mb < 2; ++mb) { const int tk = 16 * mb + lr, n = 32 * wave + 16 * nb + 4 * kq; const f32x4 v = acc[nb][mb];
                const f32x4 pr = *(const LAS f32x4*)(Pr + tk * 260 + n);
                v2u o; o.x = pk2(pr.x * v.x, pr.y * v.y); o.y = pk2(pr.z * v.z, pr.w * v.w);
                *(v2u*)(MO + (size_t)(row0 + tk) * D + 512 + n) = o; }
    }
    __syncthreads();
}
#ifndef MK_SPLIT
#define MK_SPLIT 1
#endif
#ifndef MERGE_PREP
#define MERGE_PREP 1
#endif
#ifdef USE_NOINLINE
#define NI static __device__ __noinline__
#else
#define NI static __device__ __forceinline__
#endif
extern __shared__ __attribute__((aligned(16))) unsigned char lds_raw[];
DI Ctx make_ctx(int wave0) {
    Ctx F; F.lds = (LAS uchar*)lds_raw; { int ln_ = __builtin_amdgcn_mbcnt_hi(~0u, __builtin_amdgcn_mbcnt_lo(~0u, 0u)); asm volatile("" : "+v"(ln_)); F.lane = ln_; } F.wave = wave0; F.tid = wave0 * 64 + F.lane;
    F.G = gridDim.x; { int bx = blockIdx.x; asm volatile("" : "+s"(bx)); F.vcu = (F.G % 8 == 0) ? (bx % 8) * (F.G / 8) + bx / 8 : bx; }
    return F;
}
DI void att_subbarrier(unsigned* cnt, unsigned n_att, bool t0) {
    asm volatile("s_waitcnt vmcnt(0)" ::: "memory");
    __syncthreads();
    if (t0) {
        __builtin_amdgcn_fence(__ATOMIC_RELEASE, "agent");
        asm volatile("s_waitcnt vmcnt(0)" ::: "memory");
        (void)xb_add(cnt, 1u);
        unsigned sp = 0u;
        while (xb_ld(cnt) < n_att) { __builtin_amdgcn_s_sleep(1); if (++sp > XB_SPIN_CAP) break; }
        __builtin_amdgcn_fence(__ATOMIC_ACQUIRE, "agent");
        asm volatile("s_waitcnt vmcnt(0)" ::: "memory");
    }
    __syncthreads();
}
NI void ph_prologue(KArgs a_, int wave0) { KArgs a = a_; asm volatile("" : "+s"(a)); const Ctx F = make_ctx(wave0); phase_prologue(a, F); __syncthreads(); }
NI void ph_norm(KArgs a_, int wave0, int l, int kind) { KArgs a = a_; asm volatile("" : "+s"(a));
    const Ctx F = make_ctx(wave0);
    float* modv = (float*)(a->ws + WS_MODV);
    const bool last = (l == DEPTH - 1);
    if (kind == 0) convert_weights(a, F, l, 0);
    if (kind == 1) convert_weights(a, F, l, 1);
#ifdef DUP_CONV
    if (kind == 0) convert_weights(a, F, l, 0);
    if (kind == 1) convert_weights(a, F, l, 1);
#endif
    const int lY = (kind == 0) ? (l > 0 ? l - 1 : 0) : l;
    const int gi = (kind == 0 || kind == 3) ? 8 : (kind == 1 ? 2 : 5);
    const int pi = (kind == 0 || kind == 3) ? 2 : (kind == 1 ? 0 : 1);
    const float coef = (kind == 2) ? 1.0f : 0.5f;
    const int si = (kind == 0) ? 0 : (kind == 1 ? 3 : 6);
    const int ni = (kind == 0) ? 0 : (kind == 1 ? 1 : 2);
    const bool first = (kind == 0 && l == 0), hasY = !(kind == 0 && l == 0), hasH = (kind != 3), fin = (kind == 3);
    const int nrows = (kind == 3 || (kind == 2 && last)) ? NLAT : NROWS;
#ifdef DUP_NORM
    if (kind == DUP_NORM && hasY) { norm_rows(a, F, first, hasY, hasH, fin, nrows, modv + (size_t)lY * 9 * MODW, gi, a->in[I_NPOST] + (lY * 3 + pi) * D, coef, modv + (size_t)l * 9 * MODW, si, a->in[I_NPRE] + (l * 3 + ni) * D, true); __syncthreads(); }
#endif
    norm_rows(a, F, first, hasY, hasH, fin, nrows, modv + (size_t)lY * 9 * MODW, gi, a->in[I_NPOST] + (lY * 3 + pi) * D, coef, modv + (size_t)l * 9 * MODW, si, a->in[I_NPRE] + (l * 3 + ni) * D);
    __syncthreads();
}
NI void ph_gemm_swiglu(KArgs a_, int wave0, int M) { KArgs a = a_; asm volatile("" : "+s"(a));
    const Ctx F = make_ctx(wave0);
    pg8::Gemm g{(const bf16*)(a->ws + WS_H), (const bf16*)(a->ws + WS_WGU), M, 2 * FF, D}; pg8::StaticOrder S; S.init(M, 2 * FF, F.G, (int)blockIdx.x);
    pg8::EpiSwiGLU E{(bf16*)(a->ws + WS_ACT), FF};
    pg8::gemm_phase<pg8::EpiSwiGLU, pg8::StaticOrder, PG8_ALIGN, PG8_SP2>(F.lds, g, S, E, F.tid);
}
NI void ph_gemm_store(KArgs a_, int wave0, int which, int M) { KArgs a = a_; asm volatile("" : "+s"(a));
    const Ctx F = make_ctx(wave0);
    const bf16* A = (const bf16*)(a->ws + (which == 0 ? WS_ACT : WS_H));
    const bf16* W = (const bf16*)(a->ws + (which == 0 ? WS_WDN : which == 1 ? WS_WIN : WS_WOUT));
    const int N = which == 1 ? ZPAD : D, K = which == 0 ? FF : D;
    const bool split_ctx = (which != 1) && (M == NROWS);
    const int Mg = split_ctx ? NLAT : M;
    pg8::Gemm g{A, W, Mg, N, K}; pg8::StaticOrder S; S.init(Mg, N, F.G, (int)blockIdx.x);
    pg8::EpiStore E{(bf16*)(a->ws + (which == 1 ? WS_ACT : WS_Y)), which == 1 ? ZP : D, which == 1 ? ZP : D};
    pg8::gemm_phase<pg8::EpiStore, pg8::StaticOrder, PG8_ALIGN, PG8_SP2>(F.lds, g, S, E, F.tid);
    if (split_ctx) { __syncthreads(); ctx_gemm_block(F, A, W, K, (bf16*)(a->ws + WS_Y)); }
}
NI void ph_mla_prep(KArgs a_, int wave0, int l, int first, int stride) { KArgs a = a_; asm volatile("" : "+s"(a)); const Ctx F = make_ctx(wave0); for (int tile = first; tile < NROWS / 64; tile += stride) mla_prep_tile(a, F, l, tile); }
NI void ph_rwkv(KArgs a_, int wave0, int l, int v) { KArgs a = a_; asm volatile("" : "+s"(a)); const Ctx F = make_ctx(wave0); rwkv_scan_task(a, F, l, v >> 3, (v >> 1) & 3, v & 1); }
NI void ph_mlstm(KArgs a_, int wave0, int l, int idx) { KArgs a = a_; asm volatile("" : "+s"(a)); const Ctx F = make_ctx(wave0); mlstm_task(a, F, l, idx >> 2, idx & 3); __syncthreads(); }
NI void ph_s5(KArgs a_, int wave0, int l, int wg) { KArgs a = a_; asm volatile("" : "+s"(a)); const Ctx F = make_ctx(wave0); const int tk = wg * 8 + F.wave; s5_scan_task(a, l, tk >> 5, (tk >> 4) & 1, tk & 15, (LAS bf16*)(F.lds + F.wave * 8704), F.lane); __syncthreads(); }
NI void ph_attn(KArgs a_, int wave0, int first, int stride) { KArgs a = a_; asm volatile("" : "+s"(a));
    const Ctx F = make_ctx(wave0);
    for (int u = first; u < 512 + 32; u += stride) {
        if (u < 512) { const int b = u >> 6, hd = (u >> 4) & 3, qb = u & 15; attn_unit(a, F, b, hd, b * T + qb * 256, NKEY); }
        else { const int c = u - 512, b = c >> 2, hd = c & 3; attn_unit(a, F, b, hd, NLAT + b * TC, TC); }
    }
}
NI void ph_fin(KArgs a_, int wave0, int l, int M) { KArgs a = a_; asm volatile("" : "+s"(a)); const Ctx F = make_ctx(wave0); fin_load_consts(a, F, l); for (int tile = F.vcu; tile < M / 32; tile += F.G) fin_tile(a, F, l, tile); }


#ifdef DBG_CUT
NI void ph_dump(KArgs a_, int wave0) { KArgs a = a_; asm volatile("" : "+s"(a)); const Ctx F = make_ctx(wave0);
    const float* X = (const float*)(a->ws + WS_X); const bf16* Z = (const bf16*)(a->ws + WS_ACT); const bf16* Q = (const bf16*)(a->ws + WS_Q); const bf16* Kf = (const bf16*)(a->ws + WS_K); const bf16* Vt = (const bf16*)(a->ws + WS_VT);
    const bf16* YS = (const bf16*)(a->ws + WS_YS5); const bf16* YR = (const bf16*)(a->ws + WS_YR); const bf16* YM = (const bf16*)(a->ws + WS_YM); const bf16* MO = (const bf16*)(a->ws + WS_H); const bf16* Y = (const bf16*)(a->ws + WS_Y);
    const size_t DS = (size_t)NROWS * 256;
    for (size_t i = (size_t)F.vcu * NTHR + F.tid; i < (size_t)NLAT * D; i += (size_t)F.G * NTHR) {
#ifdef DBG_CTX
        const size_t r = NLAT + ((i >> 10) % NCTX);
#else
        const size_t r = i >> 10;
#endif
        const int c = (int)(i & 1023); float v = 0.f;
        if (DBG_WHICH & 1) v += X[r * D + c];
        if (DBG_WHICH & 2) { v += bf2f(Z[r * ZP + c]) + bf2f(Z[r * ZP + 1024 + c]); if (c + 2048 < ZP) v += bf2f(Z[r * ZP + 2048 + c]); }
        if (DBG_WHICH & 4) { v += bf2f(Q[r * 384 + c % 384]) + bf2f(Kf[r * 384 + c % 384]) + bf2f(Vt[i % ((size_t)NB * 4 * 64 * NKEY)]); }
        if (DBG_WHICH & 256) v += bf2f(Q[r * 384 + c % 384]);
        if (DBG_WHICH & 512) v += bf2f(Kf[r * 384 + c % 384]);
        if (DBG_WHICH & 1024) v += bf2f(Vt[i % ((size_t)NB * 4 * 64 * NKEY)]);
        if (DBG_WHICH & 2048) { const float* rc = (const float*)(a->ws + WS_ROPE); const bf16* sw = (const bf16*)(a->ws + WS_SMALLW); v += rc[i % (T * 32)] + bf2f(sw[i % 245760]); }
        if (DBG_WHICH & 8) v += bf2f(YS[r * 256 + (c & 255)]) + bf2f(YS[DS + r * 256 + (c & 255)]);
        if (DBG_WHICH & 16) v += bf2f(YR[r * 256 + (c & 255)]) + bf2f(YR[DS + r * 256 + (c & 255)]);
        if (DBG_WHICH & 32) v += bf2f(YM[r * 256 + (c & 255)]) + bf2f(YM[DS + r * 256 + (c & 255)]);
        if (DBG_WHICH & 64) v += bf2f(MO[r * D + c]);
        if (DBG_WHICH & 128) v += bf2f(Y[r * D + c]);
        a->out[i] = v;
    }
}
#endif
#if !MK_SPLIT
#if defined(ONLY_PH)
#define PHON(k) ((k) == ONLY_PH)
#elif defined(NO_PH)
#define PHON(k) ((k) != NO_PH)
#else
#define PHON(k) true
#endif
#if defined(ONLY_ROLE)
#define ROLE(k) ((k) == ONLY_ROLE)
#elif defined(NO_ROLE)
#define ROLE(k) ((k) != NO_ROLE)
#else
#define ROLE(k) true
#endif
#ifdef DUP_BAR
#define DUPBAR(x) x
#else
#define DUPBAR(x)
#endif
#ifdef DUP_ROLE
#ifndef DUP_N
#define DUP_N 2
#endif
#define NREPR(k) ((k) == DUP_ROLE ? DUP_N : 1)
#else
#define NREPR(k) 1
#endif
#ifdef DUP_PH
#define NREP(k) ((k) == DUP_PH ? 2 : 1)
#else
#define NREP(k) 1
#endif
constexpr int NPH = 2 + 12 * DEPTH;
__global__ void __launch_bounds__(NTHR, 2) hybrid_fwd(Args args_byval) {
    KArgs a = (KArgs)__builtin_amdgcn_kernarg_segment_ptr();
    LAS uchar* lds = (LAS uchar*)lds_raw;
    const int tid = threadIdx.x; const int wave0 = __builtin_amdgcn_readfirstlane(tid >> 6);
    volatile LAS unsigned* MISC = (volatile LAS unsigned*)(lds + MISC_OFF);
    for (int u = tid; u < (LDS_BYTES - LDSCTL_OFF) / 4; u += NTHR) ((LAS unsigned*)(lds + LDSCTL_OFF))[u] = 0u;
    __syncthreads();
    unsigned* ctl = (unsigned*)(a->ws + WS_CTL);
    const int use_bar = a->use_bar;
    XcdBarrier bar; bar.bar = ctl + CW_BAR; bar.x = 0; bar.st = nullptr;
    if (use_bar) bar = xcd_barrier_post(ctl + CW_BAR, MISC + 8, tid == 0);
    const int lo = a->ph_lo, hi = a->ph_hi;
    const int G = gridDim.x; const int vcu = (G % 8 == 0) ? ((int)blockIdx.x % 8) * (G / 8) + (int)blockIdx.x / 8 : (int)blockIdx.x;
#ifdef DBG_CUT
#define IN(k) (lo <= (k) && (k) < hi && (k) < DBG_CUT)
#else
#define IN(k) (lo <= (k) && (k) < hi)
#endif
#define SEAM(k) do { if (use_bar && IN(k) && IN((k) + 1)) { int ln_ = __builtin_amdgcn_mbcnt_hi(~0u, __builtin_amdgcn_mbcnt_lo(~0u, 0u)); asm volatile("" : "+v"(ln_)); xcd_barrier(bar, wave0 == 0 && ln_ == 0); DUPBAR(xcd_barrier(bar, wave0 == 0 && ln_ == 0);) } } while (0)
    if (PHON(100) && IN(0)) ph_prologue(a, wave0);
    SEAM(0);
#pragma unroll 1
    for (int l = 0; l < DEPTH; ++l) {
        const int P = 1 + 12 * l;
        const int Mtail = (l == DEPTH - 1) ? NLAT : NROWS;
        if (PHON(0) && IN(P + 0)) { ph_norm(a, wave0, l, 0);
#ifdef DUP_FIRSTNORM
            if (l == 0) for (int rr_ = 0; rr_ < DUP_FIRSTNORM; ++rr_) ph_norm(a, wave0, l, 0);
#endif
        }
        SEAM(P + 0);
        if (PHON(1) && IN(P + 1)) for (int rep_ = 0; rep_ < NREP(1); ++rep_) ph_gemm_swiglu(a, wave0, NROWS);
        SEAM(P + 1);
        if (PHON(2) && IN(P + 2)) for (int rep_ = 0; rep_ < NREP(2); ++rep_) ph_gemm_store(a, wave0, 0, NROWS);
        SEAM(P + 2);
        if (PHON(3) && IN(P + 3)) ph_norm(a, wave0, l, 1);
        SEAM(P + 3);
        if (PHON(4) && IN(P + 4)) for (int rep_ = 0; rep_ < NREP(4); ++rep_) ph_gemm_store(a, wave0, 1, NROWS);
        SEAM(P + 4);
#if MERGE_PREP
        if (PHON(6) && IN(P + 6) && G >= 256) {
            if (ROLE(0) && vcu < 64) { for (int rr_ = 0; rr_ < NREPR(0); ++rr_) ph_rwkv(a, wave0, l, vcu); }
            else if (ROLE(1) && vcu < 96) { for (int rr_ = 0; rr_ < NREPR(1); ++rr_) ph_mlstm(a, wave0, l, vcu - 64); }
            else if (ROLE(2) && vcu < 128) { for (int rr_ = 0; rr_ < NREPR(2); ++rr_) ph_s5(a, wave0, l, vcu - 96); }
            else if (ROLE(3)) {
                ph_mla_prep(a, wave0, l, vcu - 128, G - 128);
                { int ln_ = __builtin_amdgcn_mbcnt_hi(~0u, __builtin_amdgcn_mbcnt_lo(~0u, 0u)); asm volatile("" : "+v"(ln_)); att_subbarrier(ctl + CW_SUB + 64 * l, (unsigned)(G - 128), wave0 == 0 && ln_ == 0); }
                for (int rr_ = 0; rr_ < NREPR(3); ++rr_) ph_attn(a, wave0, vcu - 128, G - 128);
            }
        }
#else
        if (PHON(5) && IN(P + 5)) for (int rep_ = 0; rep_ < NREP(5); ++rep_) ph_mla_prep(a, wave0, l);
        SEAM(P + 5);
        if (PHON(6) && IN(P + 6) && G >= 256) for (int rep_ = 0; rep_ < NREP(6); ++rep_) {
            if (ROLE(0) && vcu < 64) { for (int rr_ = 0; rr_ < NREPR(0); ++rr_) ph_rwkv(a, wave0, l, vcu); }
            else if (ROLE(1) && vcu < 96) { for (int rr_ = 0; rr_ < NREPR(1); ++rr_) ph_mlstm(a, wave0, l, vcu - 64); }
            else if (ROLE(2) && vcu < 128) { for (int rr_ = 0; rr_ < NREPR(2); ++rr_) ph_s5(a, wave0, l, vcu - 96); }
            else if (ROLE(3)) { for (int rr_ = 0; rr_ < NREPR(3); ++rr_) ph_attn(a, wave0, vcu - 128, G - 128); }
        }
#endif
        SEAM(P + 6);
        if (PHON(7) && IN(P + 7)) for (int rep_ = 0; rep_ < NREP(7); ++rep_) ph_fin(a, wave0, l, Mtail);
        SEAM(P + 7);
        if (PHON(8) && IN(P + 8)) for (int rep_ = 0; rep_ < NREP(8); ++rep_) ph_gemm_store(a, wave0, 2, Mtail);
        SEAM(P + 8);
        if (PHON(9) && IN(P + 9)) ph_norm(a, wave0, l, 2);
        SEAM(P + 9);
        if (PHON(10) && IN(P + 10)) ph_gemm_swiglu(a, wave0, Mtail);
        SEAM(P + 10);
        if (PHON(11) && IN(P + 11)) ph_gemm_store(a, wave0, 0, Mtail);
        SEAM(P + 11);
    }
#ifdef DBG_CUT
    if (lo <= NPH - 1 && NPH - 1 < hi) ph_dump(a, wave0);
#else
    if (PHON(101) && IN(NPH - 1)) ph_norm(a, wave0, DEPTH - 1, 3);
#endif
#undef IN
#undef SEAM
}

#endif
#if MK_SPLIT
struct ArgsS { Args base; int kind, l, sub, M; };
typedef const __attribute__((address_space(4))) ArgsS* KArgsS;
template <int KIND>
__global__ void __launch_bounds__(NTHR, 2) phase_kernel(ArgsS args_byval) {
    KArgsS as = (KArgsS)__builtin_amdgcn_kernarg_segment_ptr();
    KArgs a = (KArgs)as;
    const int tid = threadIdx.x; const int wave0 = __builtin_amdgcn_readfirstlane(tid >> 6);
    const int l = as->l, sub = as->sub, M = as->M;
    const int G = gridDim.x; const int vcu = (G % 8 == 0) ? ((int)blockIdx.x % 8) * (G / 8) + (int)blockIdx.x / 8 : (int)blockIdx.x;
    if constexpr (KIND == 0) ph_prologue(a, wave0);
    if constexpr (KIND == 1) ph_norm(a, wave0, l, sub);
    if constexpr (KIND == 2) ph_gemm_swiglu(a, wave0, M);
    if constexpr (KIND == 3) ph_gemm_store(a, wave0, sub, M);
    if constexpr (KIND == 4) ph_mla_prep(a, wave0, l, vcu, G);
    if constexpr (KIND == 5) { if (vcu < 64) ph_rwkv(a, wave0, l, vcu); }
    if constexpr (KIND == 6) { if (vcu >= 64 && vcu < 96) ph_mlstm(a, wave0, l, vcu - 64); }
    if constexpr (KIND == 7) { if (vcu >= 96 && vcu < 128) ph_s5(a, wave0, l, vcu - 96); }
    if constexpr (KIND == 8) { if (vcu >= 128) ph_attn(a, wave0, vcu - 128, G - 128); }
    if constexpr (KIND == 9) ph_fin(a, wave0, l, M);
}
template <int KIND> static void launch_phase(int grid, hipStream_t stream, const Args& base, int l, int sub, int M) {
    static bool attr = false;
    if (!attr) { (void)hipFuncSetAttribute((const void*)phase_kernel<KIND>, hipFuncAttributeMaxDynamicSharedMemorySize, LDS_BYTES); attr = true; }
    ArgsS s{}; s.base = base; s.kind = KIND; s.l = l; s.sub = sub; s.M = M;
    hipLaunchKernelGGL(phase_kernel<KIND>, dim3(grid), dim3(NTHR), LDS_BYTES, stream, s);
}
static void launch_split(int grid, hipStream_t stream, const Args& a) {
    launch_phase<0>(grid, stream, a, 0, 0, 0);
    for (int l = 0; l < DEPTH; ++l) {
        const int Mtail = (l == DEPTH - 1) ? NLAT : NROWS;
        launch_phase<1>(grid, stream, a, l, 0, 0);
        launch_phase<2>(grid, stream, a, l, 0, NROWS);
        launch_phase<3>(grid, stream, a, l, 0, NROWS);
        launch_phase<1>(grid, stream, a, l, 1, 0);
        launch_phase<3>(grid, stream, a, l, 1, NROWS);
        launch_phase<4>(grid, stream, a, l, 0, 0);
        launch_phase<5>(grid, stream, a, l, 0, 0);
        launch_phase<6>(grid, stream, a, l, 0, 0);
        launch_phase<7>(grid, stream, a, l, 0, 0);
        launch_phase<8>(grid, stream, a, l, 0, 0);
        launch_phase<9>(grid, stream, a, l, 0, Mtail);
        launch_phase<3>(grid, stream, a, l, 2, Mtail);
        launch_phase<1>(grid, stream, a, l, 2, 0);
        launch_phase<2>(grid, stream, a, l, 0, Mtail);
        launch_phase<3>(grid, stream, a, l, 0, Mtail);
    }
    launch_phase<1>(grid, stream, a, DEPTH - 1, 3, 0);
}
#endif
extern "C" void kernel_launch(void* const* d_in, const int* in_sizes, int n_in, void* d_out, int out_size, void* d_ws, size_t ws_size, hipStream_t stream) {
    static int grid = 0;
    if (grid == 0) {
        if (n_in != 43 || out_size != NLAT * D || ws_size < WS_END) { fprintf(stderr, "kernel_launch: unexpected shapes: n_in %d out %d ws %zu (need %zu)\n", n_in, out_size, ws_size, (size_t)WS_END); grid = -1; return; }
        int dev = 0, cus = 0, per_cu = 0;
        if (hipGetDevice(&dev) != hipSuccess || hipDeviceGetAttribute(&cus, hipDeviceAttributeMultiprocessorCount, dev) != hipSuccess) { grid = -1; return; }
        if (false) { grid = -1; return; }
        (void)hipGetLastError();
        grid = cus;
    }
    if (grid < 0) return;
    (void)hipMemsetAsync((char*)d_ws + WS_CTL, 0, CTL_ZERO_BYTES, stream);
    Args a{};
    for (int i = 0; i < 43; ++i) a.in[i] = (const float*)d_in[i];
    a.out = (float*)d_out; a.ws = (unsigned char*)d_ws; a.pad = 0;
#if MK_SPLIT
    launch_split(grid, stream, a);
#else
    static bool attr1 = false; if (!attr1) { (void)hipFuncSetAttribute((const void*)hybrid_fwd, hipFuncAttributeMaxDynamicSharedMemorySize, LDS_BYTES); attr1 = true; }
    a.ph_lo = 0; a.ph_hi = NPH; a.use_bar = 1;
    hipLaunchKernelGGL(hybrid_fwd, dim3(grid), dim3(NTHR), LDS_BYTES, stream, a);
#endif
}
```

```cpp
#include <hip/hip_runtime.h>
#include <cstdio>
#include <cstdint>
#define MK_SPLIT 0
namespace pg8 {
#define PG8_LAS __attribute__((address_space(3)))
typedef unsigned short bf16_t;
typedef short bf16x8 __attribute__((ext_vector_type(8)));
typedef float f32x4 __attribute__((ext_vector_type(4)));
typedef unsigned u32x4 __attribute__((ext_vector_type(4)));
constexpr int BM = 256, BK = 64, HALF = 128, HTB = HALF * BK * 2  , STAGE_BYTES = 8 * HTB, NXCD = 8, WGM = 8;

__host__ __device__ __forceinline__ int lds_byte(int r, int c) { const int st = (r >> 4) * 2 + (c >> 5), rr = r & 15, cc = c & 31, ob = rr * 64 + cc * 2; return st * 1024 + (ob ^ (((ob >> 9) & 1) << 5)); }
__host__ __device__ __forceinline__ void stage_rc(int b, int& R, int& C) { const int st = b / 1024, sb = b % 1024, swz = sb ^ (((sb >> 9) & 1) << 5); R = (st >> 1) * 16 + swz / 64; C = (st & 1) * 32 + (swz % 64) / 2; }
__host__ __device__ __forceinline__ int perm32(int rho) { const int n = rho >> 4, i = rho & 15; return 8 * (i >> 2) + 4 * n + (i & 3); }

struct Unit { int pm, pn; };
struct Gemm { const bf16_t* A; const bf16_t* Bt; int M, N, K; };

struct StaticOrder {
    int nM, nN, nwg, G, c;
    __host__ __device__ void init(int M, int N, int G_, int c_) { nM = M / BM; nN = N / BM; nwg = nM * nN; G = G_; c = c_; }
    __host__ __device__ bool next(int i, Unit& u) const {
        const long L = (long)i * G + c; if (L >= nwg) return false;
        int wgid = (int)L; { const int q = nwg / NXCD, r = nwg % NXCD, xcd = wgid % NXCD, off = wgid / NXCD; wgid = (xcd < r ? xcd * (q + 1) : r * (q + 1) + (xcd - r) * q) + off; }
        const int nig = WGM * nN, gid = wgid / nig, fm = gid * WGM, gsz = (nM - fm) < WGM ? (nM - fm) : WGM;
        u.pm = fm + ((wgid % nig) % gsz); u.pn = (wgid % nig) / gsz; return true;
    }
    __device__ __forceinline__ void a_ready(const Unit&) const {}
    __device__ __forceinline__ void done(const Unit&) const {}
};

typedef __bf16 nbf16v2 __attribute__((ext_vector_type(2))); typedef float nf32v2 __attribute__((ext_vector_type(2)));
__device__ __forceinline__ unsigned cvt_pk_bf16(float lo, float hi) { const nf32v2 v = {lo, hi}; return __builtin_bit_cast(unsigned, __builtin_convertvector(v, nbf16v2)); }
struct EpiSwiGLU {
    static constexpr bool PERM = true, AFTER_DRAIN = false;
    bf16_t* O; int ldc;
    __device__ __forceinline__ void operator()(const f32x4 (&acc)[2][2][4][2], const Unit& u, int wr, int wc, int fr, int fq) const {
        const int row0 = u.pm * BM + wr * 64 + fr; const int col0 = u.pn * HALF + wc * 32 + 8 * fq;
#pragma unroll
        for (int ai = 0; ai < 2; ++ai)
#pragma unroll
            for (int m = 0; m < 4; ++m) { bf16_t* rowp = O + (size_t)(row0 + ai * HALF + m * 16) * ldc + col0;
                float o[8];
#pragma unroll
                for (int n = 0; n < 2; ++n)
#pragma unroll
                    for (int j = 0; j < 4; ++j) { const float g = acc[ai][0][m][n][j], up = acc[ai][1][m][n][j];
                        const float sg = __builtin_amdgcn_rcpf(1.0f + __builtin_amdgcn_exp2f(-1.44269504089f * g)); o[n * 4 + j] = g * sg * up; }
                u32x4 w; w.x = cvt_pk_bf16(o[0], o[1]); w.y = cvt_pk_bf16(o[2], o[3]); w.z = cvt_pk_bf16(o[4], o[5]); w.w = cvt_pk_bf16(o[6], o[7]);
                *(u32x4*)rowp = w; }
    }
};
struct EpiStore {
    static constexpr bool PERM = true, AFTER_DRAIN = false;
    bf16_t* O; int ldc; int ncols;
    __device__ __forceinline__ void operator()(const f32x4 (&acc)[2][2][4][2], const Unit& u, int wr, int wc, int fr, int fq) const {
        const int row0 = u.pm * BM + wr * 64 + fr; const int col0 = u.pn * BM + wc * 32 + 8 * fq;
#pragma unroll
        for (int ai = 0; ai < 2; ++ai)
#pragma unroll
            for (int m = 0; m < 4; ++m) { bf16_t* rowp = O + (size_t)(row0 + ai * HALF + m * 16) * ldc + col0;
#pragma unroll
                for (int bj = 0; bj < 2; ++bj) { if (col0 + bj * HALF < ncols) { const f32x4 v0 = acc[ai][bj][m][0], v1 = acc[ai][bj][m][1];
                    u32x4 w; w.x = cvt_pk_bf16(v0[0], v0[1]); w.y = cvt_pk_bf16(v0[2], v0[3]); w.z = cvt_pk_bf16(v1[0], v1[1]); w.w = cvt_pk_bf16(v1[2], v1[3]);
                    *(u32x4*)(rowp + bj * HALF) = w; } } }
    }
};
template <class Epi, class Sched, bool ALIGN_EPI = false, bool SP2 = false>
__device__ __forceinline__ void gemm_phase(PG8_LAS unsigned char* lds, const Gemm g, const Sched& S, const Epi& E, const int tid) {
    const int wid = __builtin_amdgcn_readfirstlane(tid >> 6), lane = tid & 63, wr = wid >> 2, wc = wid & 3, fr = lane & 15, fq = lane >> 4;
    const int K = g.K, nt = K / BK;
    unsigned voffA[2], voffB[2];
#pragma unroll
    for (int i = 0; i < 2; ++i) { int R, C; stage_rc(tid * 16 + i * 8192, R, C); const int Rb = Epi::PERM ? ((R & ~31) + perm32(R & 31)) : R;
        voffA[i] = (unsigned)(R * K + C) * 2u; voffB[i] = (unsigned)(Rb * K + C) * 2u; }
    const size_t kstep = (size_t)(BK * 2);
    const size_t hstep = (size_t)HALF * K * 2;
    const size_t tstep = 2 * hstep;
    const unsigned ldsw = (unsigned)wid * 1024u;
    const int aoff = lds_byte(wr * 64 + fr, fq * 8), boff = lds_byte(wc * 32 + fr, fq * 8);
#define PG8_SA(b, h) (((b) * 2 + (h)) * HTB)
#define PG8_SB(b, h) ((4 + (b) * 2 + (h)) * HTB)
#define PG8_STAGE(bufoff, gbase, voff) do { _Pragma("unroll") for (int _i = 0; _i < 2; ++_i) \
        __builtin_amdgcn_global_load_lds((const unsigned*)((const char*)(gbase) + (voff)[_i]), (PG8_LAS unsigned*)(lds + (bufoff) + ldsw + _i * 8192), 16, 0, 0); } while (0)
#define PG8_LDA(dst, b, h) do { _Pragma("unroll") for (int m = 0; m < 4; ++m) _Pragma("unroll") for (int k = 0; k < 2; ++k) dst[m][k] = *(const PG8_LAS bf16x8*)(lds + PG8_SA(b, h) + aoff + m * 2048 + k * 1024); } while (0)
#define PG8_LDB(dst, b, h) do { _Pragma("unroll") for (int n = 0; n < 2; ++n) _Pragma("unroll") for (int k = 0; k < 2; ++k) dst[n][k] = *(const PG8_LAS bf16x8*)(lds + PG8_SB(b, h) + boff + n * 2048 + k * 1024); } while (0)
#define PG8_MMA(ai, bj, At, Bt) do { __builtin_amdgcn_s_setprio(1); _Pragma("unroll") for (int m = 0; m < 4; ++m) _Pragma("unroll") for (int n = 0; n < 2; ++n) _Pragma("unroll") for (int k = 0; k < 2; ++k) \
        acc[ai][bj][m][n] = __builtin_amdgcn_mfma_f32_16x16x32_bf16(Bt[n][k], At[m][k], acc[ai][bj][m][n], 0, 0, 0); __builtin_amdgcn_s_setprio(0); } while (0)
#define PG8_WAIT_V(n) asm volatile("s_waitcnt vmcnt(" #n ")" ::: "memory")
#define PG8_WAIT_L(n) asm volatile("s_waitcnt lgkmcnt(" #n ")" ::: "memory")
#define PG8_BAR __builtin_amdgcn_s_barrier()
#define PG8_SCHED __builtin_amdgcn_sched_barrier(0)
    Unit cur, nxt; int ui = 0;
    if (!S.next(0, cur)) return;
    f32x4 acc[2][2][4][2];
#pragma unroll
    for (int a = 0; a < 2; ++a)
#pragma unroll
        for (int b = 0; b < 2; ++b)
#pragma unroll
            for (int m = 0; m < 4; ++m)
#pragma unroll
                for (int n = 0; n < 2; ++n) acc[a][b][m][n] = (f32x4){0.f, 0.f, 0.f, 0.f};
    bf16x8 At[4][2], B0[2][2], B1[2][2];
    const char* cA = (const char*)g.A + (size_t)cur.pm * tstep; const char* cB = (const char*)g.Bt + (size_t)cur.pn * tstep;
    S.a_ready(cur);
    if constexpr (SP2) {
        PG8_STAGE(PG8_SB(0, 0), cB, voffB); PG8_STAGE(PG8_SB(0, 1), cB + hstep, voffB); PG8_STAGE(PG8_SA(0, 0), cA, voffA); PG8_STAGE(PG8_SA(0, 1), cA + hstep, voffA);
        if (wr == 1) PG8_BAR;
        PG8_WAIT_V(2); PG8_BAR;
        PG8_STAGE(PG8_SB(1, 0), cB + kstep, voffB); PG8_STAGE(PG8_SA(1, 0), cA + kstep, voffA); PG8_STAGE(PG8_SB(1, 1), cB + hstep + kstep, voffB);
        PG8_WAIT_V(6); PG8_BAR;
    } else {
        PG8_STAGE(PG8_SB(0, 0), cB, voffB); PG8_STAGE(PG8_SA(0, 0), cA, voffA); PG8_STAGE(PG8_SB(0, 1), cB + hstep, voffB); PG8_STAGE(PG8_SA(0, 1), cA + hstep, voffA);
        if (wr == 1) PG8_BAR;
        PG8_WAIT_V(4); PG8_BAR;
        PG8_STAGE(PG8_SB(1, 0), cB + kstep, voffB); PG8_STAGE(PG8_SA(1, 0), cA + kstep, voffA); PG8_STAGE(PG8_SB(1, 1), cB + hstep + kstep, voffB);
        PG8_WAIT_V(6); PG8_BAR;
    }
    for (;;) {
        const bool has_next = S.next(ui + 1, nxt);
        const char* nA = has_next ? (const char*)g.A + (size_t)nxt.pm * tstep : cA; const char* nB = has_next ? (const char*)g.Bt + (size_t)nxt.pn * tstep : cB;
        for (int t = 0; t < nt; t += 2) {
            const bool last = (t == nt - 2);
            const char* a1 = cA + (size_t)(t + 1) * kstep;
            const char* a2 = last ? nA : cA + (size_t)(t + 2) * kstep; const char* b2 = last ? nB : cB + (size_t)(t + 2) * kstep;
            const char* a3 = a2 + kstep; const char* b3 = b2 + kstep;
            if (last && has_next) S.a_ready(nxt);
            if constexpr (SP2) {
            PG8_LDB(B0, 0, 0); PG8_LDB(B1, 0, 1); PG8_SCHED; PG8_LDA(At, 0, 0); PG8_STAGE(PG8_SA(1, 1), a1 + hstep, voffA);
            PG8_WAIT_V(8); PG8_WAIT_L(0); PG8_BAR; PG8_MMA(0, 0, At, B0); PG8_MMA(0, 1, At, B1); PG8_BAR; PG8_SCHED;
            PG8_LDA(At, 0, 1); PG8_STAGE(PG8_SB(0, 0), b2, voffB); PG8_STAGE(PG8_SB(0, 1), b2 + hstep, voffB); PG8_STAGE(PG8_SA(0, 0), a2, voffA);
            PG8_WAIT_V(8); PG8_WAIT_L(0); PG8_BAR; PG8_MMA(1, 0, At, B0); PG8_MMA(1, 1, At, B1); PG8_BAR; PG8_SCHED;
            PG8_LDB(B0, 1, 0); PG8_LDB(B1, 1, 1); PG8_SCHED; PG8_LDA(At, 1, 0); PG8_STAGE(PG8_SA(0, 1), a2 + hstep, voffA);
            PG8_WAIT_V(8); PG8_WAIT_L(0); PG8_BAR; PG8_MMA(0, 0, At, B0); PG8_MMA(0, 1, At, B1); PG8_BAR; PG8_SCHED;
            PG8_LDA(At, 1, 1); PG8_STAGE(PG8_SB(1, 0), b3, voffB); PG8_STAGE(PG8_SB(1, 1), b3 + hstep, voffB); PG8_STAGE(PG8_SA(1, 0), a3, voffA);
            PG8_WAIT_V(8); PG8_WAIT_L(0); PG8_BAR; PG8_MMA(1, 0, At, B0); PG8_MMA(1, 1, At, B1); PG8_BAR; PG8_SCHED;
            } else {
            PG8_LDB(B0, 0, 0); PG8_SCHED; PG8_LDA(At, 0, 0); PG8_STAGE(PG8_SA(1, 1), a1 + hstep, voffA);
            PG8_WAIT_L(8); PG8_BAR; PG8_WAIT_L(0); PG8_MMA(0, 0, At, B0); PG8_BAR; PG8_SCHED;
            PG8_LDB(B1, 0, 1); PG8_STAGE(PG8_SB(0, 0), b2, voffB);
            PG8_BAR; PG8_WAIT_L(0); PG8_MMA(0, 1, At, B1); PG8_BAR;
            PG8_LDA(At, 0, 1); PG8_STAGE(PG8_SA(0, 0), a2, voffA);
            PG8_BAR; PG8_WAIT_L(0); PG8_MMA(1, 0, At, B0); PG8_BAR; PG8_SCHED;
            PG8_STAGE(PG8_SB(0, 1), b2 + hstep, voffB);
            PG8_WAIT_V(6); PG8_BAR; PG8_MMA(1, 1, At, B1); PG8_BAR;
            PG8_LDB(B0, 1, 0); PG8_SCHED; PG8_LDA(At, 1, 0); PG8_STAGE(PG8_SA(0, 1), a2 + hstep, voffA);
            PG8_WAIT_L(8); PG8_BAR; PG8_WAIT_L(0); PG8_MMA(0, 0, At, B0); PG8_BAR; PG8_SCHED;
            PG8_LDB(B1, 1, 1); PG8_STAGE(PG8_SB(1, 0), b3, voffB);
            PG8_BAR; PG8_WAIT_L(0); PG8_MMA(0, 1, At, B1); PG8_BAR;
            PG8_LDA(At, 1, 1); PG8_STAGE(PG8_SA(1, 0), a3, voffA);
            PG8_BAR; PG8_WAIT_L(0); PG8_MMA(1, 0, At, B0); PG8_BAR; PG8_SCHED;
            PG8_STAGE(PG8_SB(1, 1), b3 + hstep, voffB);
            PG8_WAIT_V(6); PG8_BAR; PG8_MMA(1, 1, At, B1); PG8_BAR;
            }
        }
        if constexpr (ALIGN_EPI) { if (wr == 0) PG8_BAR; }
        if constexpr (!Epi::AFTER_DRAIN) { E(acc, cur, wr, wc, fr, fq); S.done(cur); }
        if (!has_next) break;
#pragma unroll
        for (int a = 0; a < 2; ++a)
#pragma unroll
            for (int b = 0; b < 2; ++b)
#pragma unroll
                for (int m = 0; m < 4; ++m)
#pragma unroll
                    for (int n = 0; n < 2; ++n) acc[a][b][m][n] = (f32x4){0.f, 0.f, 0.f, 0.f};
        cur = nxt; cA = nA; cB = nB; ++ui;
        if constexpr (ALIGN_EPI) { if (wr == 1) PG8_BAR; }
    }
    PG8_WAIT_V(0);
    if constexpr (!ALIGN_EPI) { if (wr == 0) PG8_BAR; }
    PG8_BAR;
    if constexpr (Epi::AFTER_DRAIN) { E.fused(acc, cur, wr, wc, fr, fq, lds, wid, lane); S.done(cur); }
#undef PG8_SA
#undef PG8_SB
#undef PG8_STAGE
#undef PG8_LDA
#undef PG8_LDB
#undef PG8_MMA
#undef PG8_WAIT_V
#undef PG8_WAIT_L
#undef PG8_BAR
#undef PG8_SCHED
}
}
#ifndef PG8_SP2
#define PG8_SP2 true
#endif
#ifndef PG8_ALIGN
#define PG8_ALIGN true
#endif

constexpr int NWAVES = 8, NTHR = 512;
constexpr int D = 1024, NB = 8, T = 4096, TC = 256, DEPTH = 4, FF = 2816, ZP = 2608, ZPAD = 2816;
constexpr int NLAT = NB * T, NCTX = NB * TC, NROWS = NLAT + NCTX;
constexpr int MODW = 9 * D;
constexpr int NKEY = TC + T;
constexpr float NORM_EPS = 1e-6f;
constexpr int ZS5 = 0, ZCQ = 256, ZCKV = 512, ZKR = 640, ZRKV = 672, ZWD = 1440, ZAD = 1472, ZGD = 1504, ZMQK = 1568, ZMV = 2080, ZMO = 2336, ZMG = 2592;

constexpr size_t MiB = 1u << 20;
constexpr size_t WS_CTL = 0, CTL_ZERO_BYTES = 1 * MiB;
constexpr size_t WS_MODV = 1 * MiB;
constexpr size_t WS_ROPE = 3 * MiB;
constexpr size_t WS_SMALLW = 4 * MiB;
constexpr size_t SW_UQ = 0, SW_UKV = 196608, SW_GLU = 327680, SW_GUP = 458752;
constexpr size_t WS_WGU = 6 * MiB, WS_WDN = 17 * MiB, WS_WIN = 23 * MiB, WS_WOUT = 29 * MiB;
constexpr size_t WS_X = 31 * MiB;
constexpr size_t WS_Y = 167 * MiB;
constexpr size_t WS_Q = WS_Y, WS_K = WS_Y + (size_t)NROWS * 384 * 2, WS_VT = WS_K + (size_t)NROWS * 384 * 2;
constexpr size_t WS_H = 235 * MiB;
constexpr size_t WS_ACT = 303 * MiB;
constexpr size_t WS_YS5 = 490 * MiB, WS_YR = 524 * MiB, WS_YM = 558 * MiB, WS_END = 592 * MiB;
static_assert(WS_VT + (size_t)NB * 4 * 64 * NKEY * 2 <= WS_H, "qkv overlay");
static_assert(WS_WGU + (size_t)5632 * 1024 * 2 <= WS_WDN && WS_WDN + (size_t)1024 * 2816 * 2 <= WS_WIN && WS_WIN + (size_t)2816 * 1024 * 2 <= WS_WOUT && WS_WOUT + 2 * MiB <= WS_X, "weights");
static_assert(WS_X + (size_t)NROWS * D * 4 <= WS_Y && WS_Y + (size_t)NROWS * D * 2 <= WS_H && WS_H + (size_t)NROWS * D * 2 <= WS_ACT && WS_ACT + (size_t)NROWS * ZPAD * 2 <= WS_YS5, "map");
static_assert(WS_YS5 + (size_t)2 * NROWS * 256 * 2 <= WS_YR && WS_YM + (size_t)2 * NROWS * 256 * 2 <= WS_END, "map2");
constexpr int CW_BAR = 4096, CW_SUB = 8192;

constexpr int RING_BYTES = 131072, LDS_BYTES = 147456, LDSCTL_OFF = LDS_BYTES - 512, MISC_OFF = LDSCTL_OFF + 320;

#define GAS __attribute__((address_space(1)))
#define LAS __attribute__((address_space(3)))
typedef unsigned short bf16;
typedef unsigned char uchar;
typedef unsigned v4u __attribute__((ext_vector_type(4)));
typedef unsigned v2u __attribute__((ext_vector_type(2)));
typedef float f32x4 __attribute__((ext_vector_type(4)));
typedef float f32x2 __attribute__((ext_vector_type(2)));
typedef float f32x16 __attribute__((ext_vector_type(16)));
typedef short bf16x8 __attribute__((ext_vector_type(8)));
typedef short bf16x4 __attribute__((ext_vector_type(4)));
#define DI __device__ __forceinline__
DI unsigned f2bf(float f) { unsigned u = __builtin_bit_cast(unsigned, f); return (u + 0x7fffu + ((u >> 16) & 1u)) >> 16; }
DI unsigned pk2(float lo, float hi) { return pg8::cvt_pk_bf16(lo, hi); }
DI float bf2f(unsigned b) { return __builtin_bit_cast(float, b << 16); }
DI float bflo(unsigned w) { return __builtin_bit_cast(float, w << 16); }
DI float bfhi(unsigned w) { return __builtin_bit_cast(float, w & 0xffff0000u); }
template <int CTRL> DI float dpp_f(float x) { return __builtin_bit_cast(float, __builtin_amdgcn_update_dpp(0, __builtin_bit_cast(int, x), CTRL, 0xf, 0xf, true)); }
DI float sum8(float x) { x += dpp_f<0xB1>(x); x += dpp_f<0x4E>(x); x += dpp_f<0x141>(x); return x; }
DI float sum16(float x) { x = sum8(x); x += dpp_f<0x140>(x); return x; }
template <int CTRL, int RM> DI float dpp_z(float x) { return __builtin_bit_cast(float, __builtin_amdgcn_update_dpp(0, __builtin_bit_cast(int, x), CTRL, RM, 0xf, true)); }
template <int CTRL, int RM> DI float dpp_o(float old, float x) { return __builtin_bit_cast(float, __builtin_amdgcn_update_dpp(__builtin_bit_cast(int, old), __builtin_bit_cast(int, x), CTRL, RM, 0xf, false)); }
DI float wave_scan_sum(float x) {
    x += dpp_z<0x111, 0xf>(x); x += dpp_z<0x112, 0xf>(x); x += dpp_z<0x114, 0xf>(x); x += dpp_z<0x118, 0xf>(x);
    x += dpp_z<0x142, 0xa>(x); x += dpp_z<0x143, 0xc>(x); return x;
}
DI float wave_scan_max(float x) {
    const float ninf = -3.0e38f;
    x = fmaxf(x, dpp_o<0x111, 0xf>(ninf, x)); x = fmaxf(x, dpp_o<0x112, 0xf>(ninf, x)); x = fmaxf(x, dpp_o<0x114, 0xf>(ninf, x)); x = fmaxf(x, dpp_o<0x118, 0xf>(ninf, x));
    x = fmaxf(x, dpp_o<0x142, 0xa>(ninf, x)); x = fmaxf(x, dpp_o<0x143, 0xc>(ninf, x)); return x;
}
DI float wave_sum(float v) { v = sum16(v); v += __shfl_xor(v, 16); v += __shfl_xor(v, 32); return v; }
DI float wave_max(float v) {
#pragma unroll
    for (int o = 1; o < 64; o <<= 1) v = fmaxf(v, __shfl_xor(v, o));
    return v;
}
DI void lds_barrier() { asm volatile("s_waitcnt lgkmcnt(0)" ::: "memory"); __builtin_amdgcn_s_barrier(); asm volatile("" ::: "memory"); }
DI float fexp(float x) { return __builtin_amdgcn_exp2f(x * 1.44269504089f); }
DI float fsigmoid(float x) { return __builtin_amdgcn_rcpf(1.0f + fexp(-x)); }
DI f32x16 mfma32(bf16x8 a, bf16x8 b, f32x16 c) { return __builtin_amdgcn_mfma_f32_32x32x16_bf16(a, b, c, 0, 0, 0); }
DI f32x4 mfma16(bf16x8 a, bf16x8 b, f32x4 c) { return __builtin_amdgcn_mfma_f32_16x16x32_bf16(a, b, c, 0, 0, 0); }
DI int crow(int r, int h) { return (r & 3) + 8 * (r >> 2) + 4 * h; }
DI bf16x8 pack8(float a0, float a1, float a2, float a3, float a4, float a5, float a6, float a7) {
    typedef __bf16 nb8 __attribute__((ext_vector_type(8))); typedef float nf8 __attribute__((ext_vector_type(8)));
    const nf8 v = {a0, a1, a2, a3, a4, a5, a6, a7}; return __builtin_bit_cast(bf16x8, __builtin_convertvector(v, nb8));
}
DI void my_sincosf(float x, float& s, float& c) {
    const float k = __builtin_rintf(x * 0.63661977236758134f);
    float r = __builtin_fmaf(-k, 1.5703125f, x); r = __builtin_fmaf(-k, 4.837512969970703125e-4f, r); r = __builtin_fmaf(-k, 7.54978995489188216e-8f, r);
    const float r2 = r * r;
    const float ps = r + r * r2 * (-1.6666654611e-1f + r2 * (8.3321608736e-3f + r2 * (-1.9515295891e-4f)));
    const float pc = 1.0f - 0.5f * r2 + r2 * r2 * (4.166664568298827e-2f + r2 * (-1.388731625493765e-3f + r2 * 2.443315711809948e-5f));
    const int q = ((int)k) & 3;
    const float ss = (q & 1) ? pc : ps, cc = (q & 1) ? ps : pc;
    s = (q & 2) ? -ss : ss; c = ((q + 1) & 2) ? -cc : cc;
}

#define XB_TMO      128
#define XB_XCNT(j)  (256  + 64 * (j))
#define XB_XSUB(j)  (1280 + 64 * (j))
#define XB_XGEN(j)  (2304 + 64 * (j))
#define XB_TOP      3328
#define XB_TOPGEN   3392
#define XCD_BAR_WORDS 3456
#define XB_SPIN_CAP (1u << 22)
DI unsigned xb_ld(unsigned* p)              { return __hip_atomic_load(p, __ATOMIC_RELAXED, __HIP_MEMORY_SCOPE_AGENT); }
DI unsigned xb_add(unsigned* p, unsigned v) { return __hip_atomic_fetch_add(p, v, __ATOMIC_RELAXED, __HIP_MEMORY_SCOPE_AGENT); }
DI unsigned xb_xcc_id() { return (unsigned)__builtin_amdgcn_s_getreg((3 << 11) | 20) & 0xFu; }
#define XB_SPIN(cond, bar) do { unsigned _sp = 0; while (cond) { __builtin_amdgcn_s_sleep(1); \
    if ((++_sp & 255u) == 0u) { if (xb_ld(&(bar)[XB_TMO])) break; if (_sp > XB_SPIN_CAP) { atomicAdd(&(bar)[XB_TMO], 1u); break; } } } } while (0)
struct XcdBarrier { unsigned* bar; unsigned x; volatile LAS unsigned* st; };
DI XcdBarrier xcd_barrier_post(unsigned* bar, volatile LAS unsigned* st, bool t0) {
    XcdBarrier b; b.bar = bar; b.x = xb_xcc_id(); b.st = st;
    if (t0) (void)xb_add(&bar[XB_XCNT(b.x)], 1u);
    return b;
}
DI void xcd_barrier_complete(unsigned* bar, unsigned x, unsigned& nloc, unsigned& nx) {
    const unsigned G = gridDim.x * gridDim.y * gridDim.z;
    unsigned sum, cnt, mine, sp = 0u;
    for (;;) {
        sum = 0u; cnt = 0u; mine = 0u;
#pragma unroll
        for (unsigned j = 0; j < 16; ++j) { const unsigned c = xb_ld(&bar[XB_XCNT(j)]); sum += c; cnt += (c > 0u) ? 1u : 0u; mine = (j == x) ? c : mine; }
        if (sum == G) break;
        __builtin_amdgcn_s_sleep(1);
        if ((++sp & 255u) == 0u) { if (xb_ld(&bar[XB_TMO])) break; if (sp > XB_SPIN_CAP) { atomicAdd(&bar[XB_TMO], 1u); break; } }
    }
    nloc = mine > 0u ? mine : 1u; nx = cnt > 0u ? cnt : 1u;
}
DI void xcd_barrier(const XcdBarrier& b, bool t0) {
    asm volatile("s_waitcnt vmcnt(0)" ::: "memory");
    __syncthreads();
    if (t0) {
        unsigned* bar = b.bar;
        __builtin_amdgcn_s_waitcnt(0);
        unsigned nloc = b.st[0], nx = b.st[1];
        if (nloc == 0u) { xcd_barrier_complete(bar, b.x, nloc, nx); b.st[0] = nloc; b.st[1] = nx; }
        const unsigned old = xb_add(&bar[XB_XSUB(b.x)], 1u);
        const unsigned gen = old / nloc;
        if (old + 1u == (gen + 1u) * nloc) {
            __builtin_amdgcn_fence(__ATOMIC_RELEASE, "agent");
            asm volatile("s_waitcnt vmcnt(0)" ::: "memory");
            const unsigned og = xb_add(&bar[XB_TOP], 1u);
            const unsigned tg = og / nx;
            if (og + 1u == (tg + 1u) * nx) xb_add(&bar[XB_TOPGEN], 1u);
            else XB_SPIN(xb_ld(&bar[XB_TOPGEN]) == tg, bar);
            __builtin_amdgcn_fence(__ATOMIC_ACQUIRE, "agent");
            xb_add(&bar[XB_XGEN(b.x)], 1u);
            asm volatile("s_waitcnt vmcnt(0)" ::: "memory");
        } else {
            XB_SPIN(xb_ld(&bar[XB_XGEN(b.x)]) == gen, bar);
            __builtin_amdgcn_fence(__ATOMIC_ACQUIRE, "agent");
            asm volatile("s_waitcnt vmcnt(0)" ::: "memory");
        }
    }
    __syncthreads();
}

struct Args { const float* in[43]; float* out; unsigned char* ws; int ph_lo, ph_hi, use_bar, pad; };
typedef const __attribute__((address_space(4))) Args* KArgs;
enum { I_X = 0, I_C, I_CTX, I_CCTX, I_WADA, I_BADA, I_NPRE, I_NPOST, I_WG, I_WU, I_WD, I_WIN, I_WOUT, I_S5LRE, I_S5LIM, I_S5DT, I_S5BRE, I_S5BIM, I_S5CRE, I_S5CIM, I_S5D, I_S5GLU, I_S5BGLU,
       I_MQN, I_MKVN, I_MUQ, I_MUKV, I_RCW, I_RCB, I_RW0, I_RWUP, I_RA0, I_RAUP, I_RGUP, I_RKK, I_RKA, I_RRK, I_RLNW, I_RLNB, I_MCW, I_MCB, I_MGB, I_MNORM };

struct Ctx {
    LAS uchar* lds; int tid, lane, wave, vcu, G;
};
DI int tok_row(int b, int seg, int t) { return seg ? b * T + t : NLAT + b * TC + t; }
DI void phase_prologue(KArgs a, const Ctx& F) {
    LAS float* sc = (LAS float*)F.lds;
    LAS float* red = (LAS float*)(F.lds + 40960);
    const float* c = a->in[I_C]; const float* cc = a->in[I_CCTX];
    for (int i = F.tid; i < 9 * D; i += NTHR) { const float v = (i < 8 * D) ? c[i] : cc[i - 8 * D]; sc[i] = v * fsigmoid(v); }
    __syncthreads();
    const float* wada = a->in[I_WADA]; const float* bada = a->in[I_BADA];
    float* modv = (float*)(a->ws + WS_MODV);
    for (int task = F.vcu; task < DEPTH * 144; task += F.G) {
        const int l = task / 144, nb = task % 144, n = nb * 64 + F.lane;
        const float* wp = wada + ((size_t)l * D + F.wave * 128) * MODW + n;
        float acc[9];
#pragma unroll
        for (int m = 0; m < 9; ++m) acc[m] = 0.f;
#pragma unroll 8
        for (int k = 0; k < 128; ++k) { const float w = wp[(size_t)k * MODW];
#pragma unroll
            for (int m = 0; m < 9; ++m) acc[m] += sc[m * D + F.wave * 128 + k] * w; }
#pragma unroll
        for (int m = 0; m < 9; ++m) red[(F.wave * 9 + m) * 64 + F.lane] = acc[m];
        __syncthreads();
        for (int i = F.tid; i < 576; i += NTHR) { const int m = i >> 6, ln = i & 63; float s = 0.f;
#pragma unroll
            for (int w = 0; w < 8; ++w) s += red[(w * 9 + m) * 64 + ln];
            modv[((size_t)l * 9 + m) * MODW + nb * 64 + ln] = s + bada[l * MODW + nb * 64 + ln]; }
        __syncthreads();
    }
    float* rc = (float*)(a->ws + WS_ROPE); float* rs = rc + T * 16;
    for (int i = F.vcu * NTHR + F.tid; i < T * 16; i += F.G * NTHR) {
        const int t = i >> 4, f = i & 15, pos = f < 8 ? (t >> 6) : (t & 63), fi = f & 7;
        const float invf = (fi == 0) ? 1.0f : (fi == 1) ? 0.31622776601683794f : (fi == 2) ? 0.1f : (fi == 3) ? 0.031622776601683794f : (fi == 4) ? 0.01f : (fi == 5) ? 0.0031622776601683794f : (fi == 6) ? 0.001f : 0.00031622776601683794f;
        const float ang = (float)pos * invf; float s, co; my_sincosf(ang, s, co);
        rc[i] = co; rs[i] = s;
    }
}

DI void tr_item(const float* W, int K, int N, bf16* WT, int kb, int n0, int drow0, LAS float* scr, int lane) {
    const int k0 = 64 * kb, nq = 4 * (lane & 7), nn = n0 + nq;
    f32x4 ld[8];
#pragma unroll
    for (int i = 0; i < 8; ++i) { const int kk = 8 * i + (lane >> 3); ld[i] = (nn < N) ? *(const f32x4*)(W + (size_t)(k0 + kk) * N + nn) : (f32x4){0.f, 0.f, 0.f, 0.f}; }
#pragma unroll
    for (int i = 0; i < 8; ++i) { const int kk = 8 * i + (lane >> 3); LAS float* s = scr + kk * 33 + nq; s[0] = ld[i].x; s[1] = ld[i].y; s[2] = ld[i].z; s[3] = ld[i].w; }
    const int c = lane & 7;
#pragma unroll
    for (int j = 0; j < 4; ++j) { const int n = (lane >> 3) + 8 * j; const LAS float* s = scr + (8 * c) * 33 + n;
        v4u o; o.x = pk2(s[0 * 33], s[1 * 33]); o.y = pk2(s[2 * 33], s[3 * 33]); o.z = pk2(s[4 * 33], s[5 * 33]); o.w = pk2(s[6 * 33], s[7 * 33]);
        if (n0 + n < N) *(v4u*)(WT + (size_t)(drow0 + n) * K + k0 + 8 * c) = o; }
}
DI void convert_weights(KArgs a, const Ctx& F, int l, int set) {
    LAS float* scr = (LAS float*)(F.lds + F.wave * 8704);
    const int gw = F.vcu * NWAVES + F.wave, NGW = F.G * NWAVES;
    bf16* WGU = (bf16*)(a->ws + WS_WGU); bf16* WDN = (bf16*)(a->ws + WS_WDN); bf16* WIN = (bf16*)(a->ws + WS_WIN); bf16* WOUT = (bf16*)(a->ws + WS_WOUT);
    bf16* SW = (bf16*)(a->ws + WS_SMALLW);
    const int fl = l * 2 + set;
    const float* wg = a->in[I_WG] + (size_t)fl * D * FF; const float* wu = a->in[I_WU] + (size_t)fl * D * FF; const float* wd = a->in[I_WD] + (size_t)fl * FF * D;
    constexpr int I_G = 16 * 88, I_D = 44 * 32, I_IN = 16 * 82, I_O = 16 * 32, I_UQ = 4 * 12, I_UKV = 2 * 16, I_GLU = 4 * 8, I_GUP = 1 * 8;
    const int nitems = set == 0 ? (2 * I_G + I_D + I_IN + I_O + I_UQ + I_UKV + I_GLU + I_GUP) : (2 * I_G + I_D);
    for (int it = gw; it < nitems; it += NGW) {
        int r = it;
        if (r < I_G) { const int kb = r / 88, nb = r % 88, n0 = 32 * nb; tr_item(wg, D, FF, WGU, kb, n0, 256 * (n0 >> 7) + (n0 & 127), scr, F.lane); continue; } r -= I_G;
        if (r < I_G) { const int kb = r / 88, nb = r % 88, n0 = 32 * nb; tr_item(wu, D, FF, WGU, kb, n0, 256 * (n0 >> 7) + 128 + (n0 & 127), scr, F.lane); continue; } r -= I_G;
        if (r < I_D) { const int kb = r / 32, nb = r % 32; tr_item(wd, FF, D, WDN, kb, 32 * nb, 32 * nb, scr, F.lane); continue; } r -= I_D;
        if (r < I_IN) { const int kb = r / 82, nb = r % 82; tr_item(a->in[I_WIN] + (size_t)l * D * ZP, D, ZP, WIN, kb, 32 * nb, 32 * nb, scr, F.lane); continue; } r -= I_IN;
        if (r < I_O) { const int kb = r / 32, nb = r % 32; tr_item(a->in[I_WOUT] + (size_t)l * D * D, D, D, WOUT, kb, 32 * nb, 32 * nb, scr, F.lane); continue; } r -= I_O;
        if (r < I_UQ) { const int kb = r / 12, nb = r % 12; tr_item(a->in[I_MUQ] + (size_t)l * 256 * 384, 256, 384, (bf16*)((uchar*)SW + SW_UQ), kb, 32 * nb, 32 * nb, scr, F.lane); continue; } r -= I_UQ;
        if (r < I_UKV) { const int kb = r / 16, nb = r % 16; tr_item(a->in[I_MUKV] + (size_t)l * 128 * 512, 128, 512, (bf16*)((uchar*)SW + SW_UKV), kb, 32 * nb, 32 * nb, scr, F.lane); continue; } r -= I_UKV;
        if (r < I_GLU) { const int kb = r / 8, nb = r % 8; tr_item(a->in[I_S5GLU] + (size_t)l * 256 * 256, 256, 256, (bf16*)((uchar*)SW + SW_GLU), kb, 32 * nb, 32 * nb, scr, F.lane); continue; } r -= I_GLU;
        { const int nb = r; tr_item(a->in[I_RGUP] + (size_t)l * 64 * 256, 64, 256, (bf16*)((uchar*)SW + SW_GUP), 0, 32 * nb, 32 * nb, scr, F.lane); }
    }
    if (set == 0) {
        unsigned zz_ = 0u; asm volatile("" : "+v"(zz_)); v4u z = {zz_, zz_, zz_, zz_}; v4u* p = (v4u*)(WIN + (size_t)ZP * D);
        for (int i = F.vcu * NTHR + F.tid; i < (ZPAD - ZP) * D / 8; i += F.G * NTHR) p[i] = z;
    }
}

DI void norm_rows(KArgs a, const Ctx& F, bool p_first, bool p_hasY, bool p_hasH, bool p_final, int p_nrows, const float* p_modY, int p_gi, const float* p_pw, float p_coef, const float* p_modH, int p_si, const float* p_prew, bool p_dummy = false) {
    bf16* X = (bf16*)(a->ws + WS_X); const bf16* Y = (const bf16*)(a->ws + WS_Y); bf16* H = (bf16*)(a->ws + (p_dummy ? WS_YS5 : WS_H));
    bf16* Xo = p_dummy ? (bf16*)(a->ws + WS_ACT) : X;
    const int gw = F.vcu * NWAVES + F.wave, NGW = F.G * NWAVES, lane = F.lane;
    const int rpw = (p_nrows + NGW - 1) / NGW, r0 = gw * rpw, r1 = (r0 + rpw < p_nrows) ? (r0 + rpw) : p_nrows;
    if (r0 >= r1) return;
    f32x4 cA[4], cB[4], cC[4];
    int cur_mr = -1;
    f32x4 vn[2][4]; v2u xn[2][4], yn[2][4];
    auto issue = [&](int r) {
#pragma unroll
        for (int k = 0; k < 2; ++k) if (r + k < r1) {
            if (p_first) {
                const float* xs = r + k < NLAT ? a->in[I_X] + (size_t)(r + k) * D : a->in[I_CTX] + (size_t)(r + k - NLAT) * D;
#pragma unroll
                for (int j = 0; j < 4; ++j) vn[k][j] = *(const f32x4*)(xs + 4 * lane + 256 * j);
            } else {
#pragma unroll
                for (int j = 0; j < 4; ++j) xn[k][j] = *(const v2u*)(X + (size_t)(r + k) * D + 4 * lane + 256 * j);
            }
            if (p_hasY) {
#pragma unroll
                for (int j = 0; j < 4; ++j) yn[k][j] = *(const v2u*)(Y + (size_t)(r + k) * D + 4 * lane + 256 * j);
            }
        }
    };
    issue(r0);
    for (int r = r0; r < r1; r += 2) {
        f32x4 v[2][4]; v2u yw[2][4];
#pragma unroll
        for (int k = 0; k < 2; ++k)
#pragma unroll
            for (int j = 0; j < 4; ++j) { v[k][j] = p_first ? vn[k][j] : (f32x4){bflo(xn[k][j].x), bfhi(xn[k][j].x), bflo(xn[k][j].y), bfhi(xn[k][j].y)}; yw[k][j] = yn[k][j]; }
        if (r + 2 < r1) issue(r + 2);
#pragma unroll
        for (int k = 0; k < 2; ++k) if (r + k < r1) {
            const int rr = r + k;
            const int mr = rr < NLAT ? (rr >> 12) : 8;
            if (mr != cur_mr) { cur_mr = mr;
                const float* g = p_modY + (size_t)mr * MODW + p_gi * D; const float* sh = p_modH + (size_t)mr * MODW + p_si * D; const float* scp = sh + D;
#pragma unroll
                for (int j = 0; j < 4; ++j) { const int o = 4 * lane + 256 * j;
                    cA[j] = p_hasY ? (*(const f32x4*)(g + o) * p_coef) * *(const f32x4*)(p_pw + o) : (f32x4){0.f, 0.f, 0.f, 0.f};
                    if (p_hasH) { cB[j] = *(const f32x4*)(p_prew + o) * (*(const f32x4*)(scp + o) + 1.0f); cC[j] = *(const f32x4*)(sh + o); } else { cB[j] = cA[j]; cC[j] = cA[j]; } } }
            if (p_hasY) {
                f32x4 y[4]; float ss = 0.f;
#pragma unroll
                for (int j = 0; j < 4; ++j) { y[j] = (f32x4){bflo(yw[k][j].x), bfhi(yw[k][j].x), bflo(yw[k][j].y), bfhi(yw[k][j].y)};
                    ss += (y[j].x * y[j].x + y[j].y * y[j].y) + (y[j].z * y[j].z + y[j].w * y[j].w); }
                const float rstd = __builtin_amdgcn_rsqf(wave_sum(ss) * (1.0f / D) + NORM_EPS);
#pragma unroll
                for (int j = 0; j < 4; ++j) v[k][j] = v[k][j] + cA[j] * (y[j] * rstd);
            }
            if (p_final) {
#pragma unroll
                for (int j = 0; j < 4; ++j) *(f32x4*)(a->out + (size_t)rr * D + 4 * lane + 256 * j) = v[k][j];
            } else if (p_hasY || p_first) {
#pragma unroll
                for (int j = 0; j < 4; ++j) { v2u o; o.x = pk2(v[k][j].x, v[k][j].y); o.y = pk2(v[k][j].z, v[k][j].w); *(v2u*)(Xo + (size_t)rr * D + 4 * lane + 256 * j) = o; }
            }
            if (p_hasH) {
                float ss = 0.f;
#pragma unroll
                for (int j = 0; j < 4; ++j) ss += (v[k][j].x * v[k][j].x + v[k][j].y * v[k][j].y) + (v[k][j].z * v[k][j].z + v[k][j].w * v[k][j].w);
                const float rstd = __builtin_amdgcn_rsqf(wave_sum(ss) * (1.0f / D) + NORM_EPS);
#pragma unroll
                for (int j = 0; j < 4; ++j) { const f32x4 h = (v[k][j] * rstd) * cB[j] + cC[j];
                    v2u o; o.x = pk2(h.x, h.y); o.y = pk2(h.z, h.w); *(v2u*)(H + (size_t)rr * D + 4 * lane + 256 * j) = o; }
            }
        }
    }
}
template <int K, int NBK, int MBK, bool TRANS, bool ZERO = true>
DI void small_gemm(const LAS bf16* A, int apitch, const bf16* Wt, int n0w, f32x4 (&acc)[NBK][MBK], int lane, int wpitch = K) {
    const int lr = lane & 15, kq = lane >> 4;
    if (ZERO) {
#pragma unroll
        for (int nb = 0; nb < NBK; ++nb)
#pragma unroll
            for (int mb = 0; mb < MBK; ++mb) acc[nb][mb] = (f32x4){0.f, 0.f, 0.f, 0.f};
    }
#pragma unroll 2
    for (int s = 0; s < K / 32; ++s) {
        bf16x8 av[MBK];
#pragma unroll
        for (int mb = 0; mb < MBK; ++mb) av[mb] = *(const LAS bf16x8*)(A + (16 * mb + lr) * apitch + 32 * s + 8 * kq);
#pragma unroll
        for (int nb = 0; nb < NBK; ++nb) { const bf16x8 w = *(const bf16x8*)(Wt + (size_t)(n0w + 16 * nb + lr) * wpitch + 32 * s + 8 * kq);
#pragma unroll
            for (int mb = 0; mb < MBK; ++mb) acc[nb][mb] = TRANS ? mfma16(w, av[mb], acc[nb][mb]) : mfma16(av[mb], w, acc[nb][mb]); }
    }
}
DI void ctx_gemm_block(const Ctx& F, const bf16* A, const bf16* Wt, int K, bf16* Yo) {
    const int bi = F.vcu; if (bi >= 256) return;
    const int rb = bi >> 3, cb = bi & 7, row0 = NLAT + 64 * rb;
    const int tid = F.tid, lane = F.lane, wave = F.wave;
    LAS bf16* As = (LAS bf16*)F.lds;
    const int nch = K / 256;
    v4u g[4];
    auto gload = [&](int ch) {
#pragma unroll
        for (int j = 0; j < 4; ++j) { const int cidx = tid + 512 * j, r = cidx >> 5, cc = cidx & 31; g[j] = *(const v4u*)(A + (size_t)(row0 + r) * K + ch * 256 + cc * 8); }
    };
    auto lstore = [&](int buf) {
#pragma unroll
        for (int j = 0; j < 4; ++j) { const int cidx = tid + 512 * j, r = cidx >> 5, cc = cidx & 31; *(LAS v4u*)(As + buf * 64 * 264 + r * 264 + cc * 8) = g[j]; }
    };
    f32x4 acc[1][4];
#pragma unroll
    for (int mb = 0; mb < 4; ++mb) acc[0][mb] = (f32x4){0.f, 0.f, 0.f, 0.f};
    const int lr_ = lane & 15, kq_ = lane >> 4;
    const bf16* wrow = Wt + (size_t)(128 * cb + 16 * wave + lr_) * K + 8 * kq_;
    bf16x8 wc[8], wn[8];
#pragma unroll
    for (int s = 0; s < 8; ++s) wc[s] = *(const bf16x8*)(wrow + 32 * s);
    gload(0); lstore(0);
    __syncthreads();
    for (int ch = 0; ch < nch; ++ch) {
        if (ch + 1 < nch) { gload(ch + 1);
#pragma unroll
            for (int s = 0; s < 8; ++s) wn[s] = *(const bf16x8*)(wrow + (ch + 1) * 256 + 32 * s); }
        const LAS bf16* Ab = As + (ch & 1) * 64 * 264;
#pragma unroll
        for (int s = 0; s < 8; ++s) {
#pragma unroll
            for (int mb = 0; mb < 4; ++mb) acc[0][mb] = mfma16(wc[s], *(const LAS bf16x8*)(Ab + (16 * mb + lr_) * 264 + 32 * s + 8 * kq_), acc[0][mb]);
        }
        if (ch + 1 < nch) { lstore((ch + 1) & 1);
#pragma unroll
            for (int s = 0; s < 8; ++s) wc[s] = wn[s]; }
        __syncthreads();
    }
    const int lr = lane & 15, kq = lane >> 4;
#pragma unroll
    for (int mb = 0; mb < 4; ++mb) { const f32x4 v = acc[0][mb]; v2u o; o.x = pk2(v.x, v.y); o.y = pk2(v.z, v.w);
        *(v2u*)(Yo + (size_t)(row0 + 16 * mb + lr) * D + 128 * cb + 16 * wave + 4 * kq) = o; }
}

struct S5C { float ar, ai, fr, fi; };
static __device__ __noinline__ S5C s5_coef(const float* lre, const float* lim, float dt, int nn) {
    const float lr = lre[nn], li = lim[nn], x = lr * dt;
    const float em = x * (1.0f + x * (0.5f + x * (0.16666667f + x * (0.041666668f + x * 0.0083333338f))));
    float sh, ch; my_sincosf(0.5f * li * dt, sh, ch);
    const float cm1 = -2.0f * sh * sh, sn = 2.0f * sh * ch;
    const float arm1 = em * (1.0f + cm1) + cm1;
    S5C o; o.ai = (1.0f + em) * sn; o.ar = 1.0f + arm1;
    const float den = lr * lr + li * li;
    o.fr = (arm1 * lr + o.ai * li) / den; o.fi = (o.ai * lr - arm1 * li) / den;
    return o;
}
DI void s5_scan_task(KArgs a, int l, int b, int dir, int g, LAS bf16* wl  , int lane) {
    const bf16* Z = (const bf16*)(a->ws + WS_ACT); bf16* YS = (bf16*)(a->ws + WS_YS5) + (size_t)dir * NROWS * 256;
    const int pg = (l * 2 + dir) * 16 + g;
    const float* lre = a->in[I_S5LRE] + pg * 64; const float* lim = a->in[I_S5LIM] + pg * 64;
    const float dt = __expf(a->in[I_S5DT][pg]);
    const S5C c0_ = s5_coef(lre, lim, dt, lane); const float ar = c0_.ar, ai = c0_.ai;
    bf16x8 Bf[4];
    { const int hh = lane >> 5;
#pragma unroll
      for (int nblk = 0; nblk < 2; ++nblk) { const int nn = 32 * nblk + (lane & 31); const S5C cn_ = s5_coef(lre, lim, dt, nn); const float fr = cn_.fr, fi = cn_.fi;
        const float* bre = a->in[I_S5BRE] + ((size_t)pg * 64 + nn) * 16 + 8 * hh; const float* bim = a->in[I_S5BIM] + ((size_t)pg * 64 + nn) * 16 + 8 * hh;
        float re[8], im[8];
#pragma unroll
        for (int j = 0; j < 8; ++j) { re[j] = fr * bre[j] - fi * bim[j]; im[j] = fi * bre[j] + fr * bim[j]; }
        Bf[nblk] = pack8(re[0], re[1], re[2], re[3], re[4], re[5], re[6], re[7]); Bf[2 + nblk] = pack8(im[0], im[1], im[2], im[3], im[4], im[5], im[6], im[7]); } }
    bf16x8 Cf[4];
    { const int p = lane & 15, q = lane >> 4;
#pragma unroll
      for (int s = 0; s < 4; ++s) { const int kc = 32 * s + 8 * q; float cv[8];
        const float* src = (s < 2) ? a->in[I_S5CRE] + ((size_t)pg * 16 + p) * 64 + kc : a->in[I_S5CIM] + ((size_t)pg * 16 + p) * 64 + (kc - 64);
        const float sg = (s < 2) ? 1.f : -1.f;
#pragma unroll
        for (int j = 0; j < 8; ++j) cv[j] = sg * src[j];
        Cf[s] = pack8(cv[0], cv[1], cv[2], cv[3], cv[4], cv[5], cv[6], cv[7]); } }
    float sr = 0.f, si = 0.f;
    const int hh = lane >> 5, li5 = lane & 31, q = lane >> 4, t16 = lane & 15;
    const f32x16 zero16 = {0.f, 0.f, 0.f, 0.f, 0.f, 0.f, 0.f, 0.f, 0.f, 0.f, 0.f, 0.f, 0.f, 0.f, 0.f, 0.f};
    const int nchC = TC / 32, nchT = nchC + T / 32;
    auto afload = [&](int gc) -> bf16x8 {
        const int seg = gc >= nchC, ch = seg ? gc - nchC : gc, len = seg ? T : TC;
        const int sidx = 32 * ch + li5, tt = dir ? (len - 1 - sidx) : sidx;
        return *(const bf16x8*)(Z + (size_t)tok_row(b, seg, tt) * ZP + ZS5 + g * 16 + 8 * hh);
    };
    bf16x8 afn = afload(0);
    for (int gc = 0; gc < nchT; ++gc) {
        const int seg = gc >= nchC, ch = seg ? gc - nchC : gc, len = seg ? T : TC;
        {
            const bf16x8 af = afn;
            if (gc + 1 < nchT) afn = afload(gc + 1);
            f32x16 d1 = mfma32(af, Bf[0], zero16), d2 = mfma32(af, Bf[1], zero16), d3 = mfma32(af, Bf[2], zero16), d4 = mfma32(af, Bf[3], zero16);
            float xa[16], xb[16], ya[16], yb[16];
#pragma unroll
            for (int r = 0; r < 16; ++r) {
                auto r1 = __builtin_amdgcn_permlane32_swap(__float_as_uint(d1[r]), __float_as_uint(d2[r]), false, false); xa[r] = __uint_as_float(r1[0]); xb[r] = __uint_as_float(r1[1]);
                auto r2 = __builtin_amdgcn_permlane32_swap(__float_as_uint(d3[r]), __float_as_uint(d4[r]), false, false); ya[r] = __uint_as_float(r2[0]); yb[r] = __uint_as_float(r2[1]); }
#pragma unroll
            for (int i = 0; i < 32; ++i) {
                const int r = 4 * (i >> 3) + (i & 3); const bool hi = (i >> 2) & 1;
                const float xre = hi ? xb[r] : xa[r], xim = hi ? yb[r] : ya[r];
                const float nsr = ar * sr - ai * si + xre, nsi = ar * si + ai * sr + xim; sr = nsr; si = nsi;
                wl[i * 136 + lane] = (bf16)f2bf(sr); wl[i * 136 + 64 + lane] = (bf16)f2bf(si);
            }
#pragma unroll
            for (int tb = 0; tb < 2; ++tb) {
                f32x4 acc = {0.f, 0.f, 0.f, 0.f};
#pragma unroll
                for (int s = 0; s < 4; ++s) { const bf16x8 bfr = *(const LAS bf16x8*)(wl + (16 * tb + t16) * 136 + 32 * s + 8 * q); acc = mfma16(Cf[s], bfr, acc); }
                const int so = 32 * ch + 16 * tb + t16, to = dir ? (len - 1 - so) : so;
                v2u o; o.x = pk2(acc[0], acc[1]); o.y = pk2(acc[2], acc[3]);
                *(v2u*)(YS + (size_t)tok_row(b, seg, to) * 256 + g * 16 + 4 * q) = o;
            }
        }
    }
}

DI void mla_prep_tile(KArgs a, const Ctx& F, int l, int tile) {
    const bf16* Z = (const bf16*)(a->ws + WS_ACT);
    bf16* Q = (bf16*)(a->ws + WS_Q); bf16* Kf = (bf16*)(a->ws + WS_K); bf16* Vt = (bf16*)(a->ws + WS_VT);
    const bf16* WUQ = (const bf16*)(a->ws + WS_SMALLW + SW_UQ); const bf16* WUKV = (const bf16*)(a->ws + WS_SMALLW + SW_UKV);
    const float* rc = (const float*)(a->ws + WS_ROPE); const float* rs = rc + T * 16;
    LAS bf16* Aq = (LAS bf16*)F.lds;
    LAS bf16* Akv = (LAS bf16*)(F.lds + 64 * 264 * 2);
    const int row0 = tile * 64, tid = F.tid, lane = F.lane, wave = F.wave;
    const bool lat = row0 < NLAT;
    {
        const int i = tid >> 3, part = tid & 7, row = row0 + i;
        const bf16* zr = Z + (size_t)row * ZP;
        float q[32], kv[16]; float sq = 0.f, sk = 0.f;
#pragma unroll
        for (int j = 0; j < 4; ++j) { const v4u w = *(const v4u*)(zr + ZCQ + part * 32 + 8 * j);
            q[8 * j + 0] = bflo(w.x); q[8 * j + 1] = bfhi(w.x); q[8 * j + 2] = bflo(w.y); q[8 * j + 3] = bfhi(w.y); q[8 * j + 4] = bflo(w.z); q[8 * j + 5] = bfhi(w.z); q[8 * j + 6] = bflo(w.w); q[8 * j + 7] = bfhi(w.w); }
#pragma unroll
        for (int j = 0; j < 2; ++j) { const v4u w = *(const v4u*)(zr + ZCKV + part * 16 + 8 * j);
            kv[8 * j + 0] = bflo(w.x); kv[8 * j + 1] = bfhi(w.x); kv[8 * j + 2] = bflo(w.y); kv[8 * j + 3] = bfhi(w.y); kv[8 * j + 4] = bflo(w.z); kv[8 * j + 5] = bfhi(w.z); kv[8 * j + 6] = bflo(w.w); kv[8 * j + 7] = bfhi(w.w); }
#pragma unroll
        for (int j = 0; j < 32; ++j) sq += q[j] * q[j];
#pragma unroll
        for (int j = 0; j < 16; ++j) sk += kv[j] * kv[j];
        sq += __shfl_xor(sq, 1); sq += __shfl_xor(sq, 2); sq += __shfl_xor(sq, 4);
        sk += __shfl_xor(sk, 1); sk += __shfl_xor(sk, 2); sk += __shfl_xor(sk, 4);
        const float rq = 1.0f / sqrtf(sq * (1.0f / 256.0f) + NORM_EPS), rk = 1.0f / sqrtf(sk * (1.0f / 128.0f) + NORM_EPS);
        const float* qn = a->in[I_MQN] + l * 256 + part * 32; const float* kn = a->in[I_MKVN] + l * 128 + part * 16;
#pragma unroll
        for (int j = 0; j < 32; j += 2) *(LAS unsigned*)(Aq + i * 264 + part * 32 + j) = pk2(q[j] * rq * qn[j], q[j + 1] * rq * qn[j + 1]);
#pragma unroll
        for (int j = 0; j < 16; j += 2) *(LAS unsigned*)(Akv + i * 136 + part * 16 + j) = pk2(kv[j] * rk * kn[j], kv[j + 1] * rk * kn[j + 1]);
        {
            const int hf = part >> 2, j = 2 * (part & 3);
            const unsigned w0 = *(const unsigned*)(zr + ZKR + hf * 16 + j), w1 = *(const unsigned*)(zr + ZKR + hf * 16 + 8 + j);
            float x0a = bflo(w0), x0b = bfhi(w0), x1a = bflo(w1), x1b = bfhi(w1);
            { const int t = row & (T - 1);
                f32x2 c = *(const f32x2*)(rc + t * 16 + hf * 8 + j), s = *(const f32x2*)(rs + t * 16 + hf * 8 + j);
                if (!lat) { c = (f32x2){1.f, 1.f}; s = (f32x2){0.f, 0.f}; }
                const float o0a = x0a * c.x - x1a * s.x, o1a = x1a * c.x + x0a * s.x, o0b = x0b * c.y - x1b * s.y, o1b = x1b * c.y + x0b * s.y;
                x0a = o0a; x1a = o1a; x0b = o0b; x1b = o1b; }
            const unsigned p0 = pk2(x0a, x0b), p1 = pk2(x1a, x1b);
#pragma unroll
            for (int hd = 0; hd < 4; ++hd) { bf16* kp = Kf + (size_t)row * 384 + hd * 96 + 64 + hf * 16 + j; *(unsigned*)kp = p0; *(unsigned*)(kp + 8) = p1; }
        }
    }
    lds_barrier();
    const int lr = lane & 15, kq = lane >> 4;
    {
        f32x4 acc[3][4];
        small_gemm<256, 3, 4, true>(Aq, 264, WUQ, 48 * wave, acc, lane);
        const float qs = 0.10206207261596577f * 1.44269504089f;
#pragma unroll
        for (int nb = 0; nb < 3; ++nb) { const int blk = 3 * wave + nb, hb = blk % 6;
#pragma unroll
            for (int mb = 0; mb < 4; ++mb) { const int row = row0 + 16 * mb + lr; f32x4 v = acc[nb][mb];
                if (hb >= 4) {
                    f32x4 pv; pv.x = __shfl_xor(v.x, 32); pv.y = __shfl_xor(v.y, 32); pv.z = __shfl_xor(v.z, 32); pv.w = __shfl_xor(v.w, 32);
                    if (lat) { const int t = row & (T - 1); const int fb = (hb - 4) * 8 + 4 * (kq & 1);
                        const f32x4 c = *(const f32x4*)(rc + t * 16 + fb), s = *(const f32x4*)(rs + t * 16 + fb);
                        v = (kq < 2) ? (v * c - pv * s) : (v * c + pv * s); }
                }
                v = v * qs;
                v2u o; o.x = pk2(v.x, v.y); o.y = pk2(v.z, v.w);
                *(v2u*)(Q + (size_t)row * 384 + 16 * blk + 4 * kq) = o; } }
    }
    {
        const int hd = wave >> 1;
        if ((wave & 1) == 0) {
            f32x4 acc[4][4];
            small_gemm<128, 4, 4, true>(Akv, 136, WUKV, 64 * wave, acc, lane);
#pragma unroll
            for (int nb = 0; nb < 4; ++nb)
#pragma unroll
                for (int mb = 0; mb < 4; ++mb) { const int row = row0 + 16 * mb + lr; const f32x4 v = acc[nb][mb];
                    v2u o; o.x = pk2(v.x, v.y); o.y = pk2(v.z, v.w);
                    *(v2u*)(Kf + (size_t)row * 384 + hd * 96 + 16 * nb + 4 * kq) = o; }
        } else {
            f32x4 acc[4][4];
            small_gemm<128, 4, 4, false>(Akv, 136, WUKV, 64 * wave, acc, lane);
            const int bb = lat ? (row0 >> 12) : ((row0 - NLAT) >> 8);
            const int key0 = lat ? (TC + (row0 & (T - 1))) : ((row0 - NLAT) & (TC - 1));
#pragma unroll
            for (int nb = 0; nb < 4; ++nb)
#pragma unroll
                for (int mb = 0; mb < 4; ++mb) { const f32x4 v = acc[nb][mb];
                    v2u o; o.x = pk2(v.x, v.y); o.y = pk2(v.z, v.w);
                    *(v2u*)(Vt + ((size_t)(bb * 4 + hd) * 64 + 16 * nb + lr) * NKEY + key0 + 16 * mb + 4 * kq) = o; }
        }
    }
    lds_barrier();
}

DI void attn_unit(KArgs a, const Ctx& F, int b, int hd, int qrow0, int nkeys) {
    const bf16* Q = (const bf16*)(a->ws + WS_Q); const bf16* Kf = (const bf16*)(a->ws + WS_K); const bf16* Vt = (const bf16*)(a->ws + WS_VT);
    bf16* MO = (bf16*)(a->ws + WS_H);
    constexpr int KP = 208, VP = 144, BUF = 64 * KP + 64 * VP;
    const int tid = F.tid, lane = F.lane, wave = F.wave, l31 = lane & 31, h2 = lane >> 5;
    const int qrow = qrow0 + 32 * wave + l31;
    bf16x8 Qf[6];
#pragma unroll
    for (int s = 0; s < 6; ++s) Qf[s] = *(const bf16x8*)(Q + (size_t)qrow * 384 + hd * 96 + 16 * s + 8 * h2);
    const int kc0 = tid, kc1 = tid + 512;
    const int kr0 = kc0 / 12, kcc0 = kc0 % 12, kr1 = kc1 / 12, kcc1 = kc1 % 12; const bool k1v = kc1 < 768;
    const int vd = tid >> 3, vcc = tid & 7;
    const bf16* vbase = Vt + ((size_t)(b * 4 + hd) * 64 + vd) * NKEY + vcc * 8;
    v4u gk0, gk1, gv;
    auto gloadK = [&](int kt) {
        const int key0 = 64 * kt; const int krow = key0 < TC ? (NLAT + b * TC + key0) : (b * T + key0 - TC);
        gk0 = *(const v4u*)(Kf + (size_t)(krow + kr0) * 384 + hd * 96 + kcc0 * 8);
        if (k1v) gk1 = *(const v4u*)(Kf + (size_t)(krow + kr1) * 384 + hd * 96 + kcc1 * 8);
    };
    auto gloadV = [&](int kt) { gv = *(const v4u*)(vbase + 64 * kt); };
    auto lstoreK = [&](int buf) {
        LAS uchar* base = F.lds + buf * BUF;
        *(LAS v4u*)(base + kr0 * KP + kcc0 * 16) = gk0;
        if (k1v) *(LAS v4u*)(base + kr1 * KP + kcc1 * 16) = gk1;
    };
    auto lstoreV = [&](int buf) {
        LAS uchar* vp = F.lds + buf * BUF + 64 * KP + vd * VP + (vcc >> 1) * 32 + (vcc & 1) * 8;
        v2u lo_, hi_; lo_.x = gv.x; lo_.y = gv.y; hi_.x = gv.z; hi_.y = gv.w;
        *(LAS v2u*)vp = lo_; *(LAS v2u*)(vp + 16) = hi_;
    };
    const int nt = nkeys / 64;
    f32x16 O0, O1, negm;
#pragma unroll
    for (int r = 0; r < 16; ++r) { O0[r] = 0.f; O1[r] = 0.f; negm[r] = 0.f; }
    float lsum = 0.f;
    f32x16 s0, s1;
    gloadK(0); gloadV(0); lstoreK(0); lstoreV(0);
    gloadK(1); lstoreK(1);
    __syncthreads();
    {
        s0 = negm; s1 = negm;
#pragma unroll
        for (int s = 0; s < 6; ++s) {
            const bf16x8 ka = *(const LAS bf16x8*)(F.lds + l31 * KP + (16 * s + 8 * h2) * 2);
            const bf16x8 kb2 = *(const LAS bf16x8*)(F.lds + (32 + l31) * KP + (16 * s + 8 * h2) * 2);
            s0 = mfma32(ka, Qf[s], s0); s1 = mfma32(kb2, Qf[s], s1);
        }
    }
    for (int kt = 0; kt < nt; ++kt) {
        const bool more1 = kt + 1 < nt, more2 = kt + 2 < nt;
        if (more2) gloadK(kt + 2);
        if (more1) gloadV(kt + 1);
        float mx = fmaxf(fmaxf(s0[0], s0[1]), s0[2]);
#pragma unroll
        for (int r = 3; r < 15; r += 2) mx = fmaxf(fmaxf(mx, s0[r]), s0[r + 1]);
        mx = fmaxf(mx, s0[15]);
#pragma unroll
        for (int r = 0; r < 16; r += 2) mx = fmaxf(fmaxf(mx, s1[r]), s1[r + 1]);
        mx = fmaxf(mx, __shfl_xor(mx, 32));
        if (kt == 0 || __builtin_amdgcn_ballot_w64(mx > 8.0f) != 0ull) {
            const float dlt = (kt == 0) ? mx : fmaxf(mx, 0.f);
            const float alpha = (kt == 0) ? 1.0f : __builtin_amdgcn_exp2f(-dlt);
            lsum *= alpha;
#pragma unroll
            for (int r = 0; r < 16; ++r) { O0[r] *= alpha; O1[r] *= alpha; s0[r] -= dlt; s1[r] -= dlt; negm[r] -= dlt; }
        }
        f32x16 n0 = negm, n1 = negm;
        {
            const LAS uchar* kn_ = F.lds + ((kt + 1) & 1) * BUF;
#pragma unroll
            for (int s = 0; s < 6; ++s) {
                const bf16x8 ka = *(const LAS bf16x8*)(kn_ + l31 * KP + (16 * s + 8 * h2) * 2);
                const bf16x8 kb2 = *(const LAS bf16x8*)(kn_ + (32 + l31) * KP + (16 * s + 8 * h2) * 2);
                n0 = mfma32(ka, Qf[s], n0); n1 = mfma32(kb2, Qf[s], n1);
            }
        }
        const LAS uchar* vb_ = F.lds + (kt & 1) * BUF + 64 * KP;
        f32x2 ps2 = {0.f, 0.f};
#pragma unroll
        for (int kb = 0; kb < 2; ++kb)
#pragma unroll
            for (int sp = 0; sp < 2; ++sp) {
                f32x16& sx = kb ? s1 : s0;
#pragma unroll
                for (int r = 8 * sp; r < 8 * sp + 8; r += 2) { sx[r] = __builtin_amdgcn_exp2f(sx[r]); sx[r + 1] = __builtin_amdgcn_exp2f(sx[r + 1]); ps2 += (f32x2){sx[r], sx[r + 1]}; }
                const bf16x8 pf = pack8(sx[8 * sp + 0], sx[8 * sp + 1], sx[8 * sp + 2], sx[8 * sp + 3], sx[8 * sp + 4], sx[8 * sp + 5], sx[8 * sp + 6], sx[8 * sp + 7]);
                const int ko = (32 * kb + 16 * sp + 8 * h2) * 2;
                const bf16x8 va = *(const LAS bf16x8*)(vb_ + l31 * VP + ko), vc = *(const LAS bf16x8*)(vb_ + (32 + l31) * VP + ko);
                O0 = mfma32(va, pf, O0); O1 = mfma32(vc, pf, O1);
            }
        lsum += ps2.x + ps2.y;
        if (more2) lstoreK(kt & 1);
        if (more1) lstoreV((kt + 1) & 1);
        lds_barrier();
        s0 = n0; s1 = n1;
    }
    const float ltot = lsum + __shfl_xor(lsum, 32), inv = 1.0f / ltot;
    bf16* op = MO + (size_t)qrow * D + 256 + hd * 64;
#pragma unroll
    for (int gq = 0; gq < 4; ++gq) {
        v2u o; o.x = pk2(O0[4 * gq] * inv, O0[4 * gq + 1] * inv); o.y = pk2(O0[4 * gq + 2] * inv, O0[4 * gq + 3] * inv);
        *(v2u*)(op + 8 * gq + 4 * h2) = o;
        v2u o2; o2.x = pk2(O1[4 * gq] * inv, O1[4 * gq + 1] * inv); o2.y = pk2(O1[4 * gq + 2] * inv, O1[4 * gq + 3] * inv);
        *(v2u*)(op + 32 + 8 * gq + 4 * h2) = o2;
    }
}
DI float conv3(const bf16* Z, int b, int seg, int t, int len, int col, float w0, float w1, float w2, float cb) {
    const bf16* zp = Z + (size_t)tok_row(b, seg, t) * ZP + col;
    float y = cb + w1 * bf2f(zp[0]);
    if (t > 0) y += w0 * bf2f(zp[-ZP]);
    if (t + 1 < len) y += w2 * bf2f(zp[ZP]);
    return y;
}
DI bf16x8 ldperm(const LAS bf16* rowp, int k0, int hh) { const bf16x4 a0 = *(const LAS bf16x4*)(rowp + k0 + 4 * hh), a1 = *(const LAS bf16x4*)(rowp + k0 + 8 + 4 * hh); return __builtin_shufflevector(a0, a1, 0, 1, 2, 3, 4, 5, 6, 7); }
DI bf16x8 pack_acc(const f32x16& x, int s) { return s ? pack8(x[8], x[9], x[10], x[11], x[12], x[13], x[14], x[15]) : pack8(x[0], x[1], x[2], x[3], x[4], x[5], x[6], x[7]); }
DI void rwkv_scan_task(KArgs a, const Ctx& F, int l, int b, int hd, int dir) {
    const bf16* Z = (const bf16*)(a->ws + WS_ACT); bf16* YR = (bf16*)(a->ws + WS_YR) + (size_t)dir * NROWS * 256;
    constexpr int RAWSZ = 13056 + 4608;
    constexpr int FR_OFF = 4 * 4608 + 3 * 5120 + 256 + 2560;
    constexpr int SETSZ = FR_OFF + 6144;
    LAS uchar* const RAW0 = F.lds;
    LAS float* WL = (LAS float*)(F.lds + 2 * RAWSZ);
    LAS float* AL = WL + 2048;
    LAS float* Alw = AL + 2048;
    LAS float* CST = Alw + 512;
    LAS uchar* const SET0 = (LAS uchar*)(CST + 1024);
    const int tid = F.tid, lane = F.lane, wave = F.wave;
    const int hc = hd * 64 + lane;
    bf16x8 lf0 = {0, 0, 0, 0, 0, 0, 0, 0}, lf1 = lf0;
    if (wave >= 4) { const int w4 = wave - 4, l31 = lane & 31, hh = lane >> 5; const float* up = a->in[(w4 >> 1) ? I_RWUP : I_RAUP] + ((size_t)(l * 2 + dir) * 32) * 256 + hd * 64 + 32 * (w4 & 1) + l31;
        float u[16];
#pragma unroll
        for (int s = 0; s < 2; ++s)
#pragma unroll
            for (int j = 0; j < 8; ++j) u[8 * s + j] = up[(size_t)(16 * s + 8 * hh + j) * 256];
        lf0 = pack8(u[0], u[1], u[2], u[3], u[4], u[5], u[6], u[7]); lf1 = pack8(u[8], u[9], u[10], u[11], u[12], u[13], u[14], u[15]); }
    if (wave == 0) {
        const float* cw = a->in[I_RCW] + (size_t)l * 3 * 768; const float* cbp = a->in[I_RCB] + (size_t)l * 768;
        CST[0 * 64 + lane] = a->in[I_RW0][(l * 2 + dir) * 256 + hc]; CST[1 * 64 + lane] = a->in[I_RA0][(l * 2 + dir) * 256 + hc];
        CST[2 * 64 + lane] = a->in[I_RKK][l * 256 + hc]; CST[3 * 64 + lane] = a->in[I_RKA][l * 256 + hc];
#pragma unroll
        for (int j = 0; j < 3; ++j) { CST[(4 + j) * 64 + lane] = cw[j * 768 + hc]; CST[(7 + j) * 64 + lane] = cw[j * 768 + 256 + hc]; CST[(10 + j) * 64 + lane] = cw[j * 768 + 512 + hc]; }
        CST[13 * 64 + lane] = cbp[hc]; CST[14 * 64 + lane] = cbp[256 + hc]; CST[15 * 64 + lane] = cbp[512 + hc];
    }
    f32x16 ST0, ST1;
#pragma unroll
    for (int r = 0; r < 16; ++r) { ST0[r] = 0.f; ST1[r] = 0.f; }
    const int c0r = tid / 24, c0s = (tid % 24) >> 3, c0c = (tid % 24) & 7;
    const int c1 = tid + 512, c1r = c1 / 24, c1s = (c1 % 24) >> 3, c1c = (c1 % 24) & 7; const bool c1v = c1 < 816;
    const int lr_ = tid >> 3, lc_ = tid & 7;
    v4u g0, g1, g2;
    unsigned zz_ = 0u; asm volatile("" : "+v"(zz_)); const v4u zero4 = {zz_, zz_, zz_, zz_};
    const int nchC = TC / 32, nchT = nchC + T / 32;
    auto gload = [&](int gc) {
        const int seg = gc >= nchC, ch = seg ? gc - nchC : gc, len = seg ? T : TC;
        const int tbase = dir ? (len - 32 * (ch + 1)) : 32 * ch;
        { const int t = tbase - 1 + c0r; g0 = (t >= 0 && t < len) ? *(const v4u*)(Z + (size_t)tok_row(b, seg, t) * ZP + ZRKV + c0s * 256 + hd * 64 + c0c * 8) : zero4; }
        if (c1v) { const int t = tbase - 1 + c1r; g1 = (t >= 0 && t < len) ? *(const v4u*)(Z + (size_t)tok_row(b, seg, t) * ZP + ZRKV + c1s * 256 + hd * 64 + c1c * 8) : zero4; }
        if (tid < 256) { const int t = tbase + lr_; g2 = *(const v4u*)(Z + (size_t)tok_row(b, seg, t) * ZP + ZWD + lc_ * 8); }
    };
    auto lstore = [&](int par) {
        LAS bf16* Raw = (LAS bf16*)(RAW0 + par * RAWSZ); LAS bf16* LwB = (LAS bf16*)(RAW0 + par * RAWSZ + 13056);
        *(LAS v4u*)(Raw + c0r * 192 + c0s * 64 + c0c * 8) = g0;
        if (c1v) *(LAS v4u*)(Raw + c1r * 192 + c1s * 64 + c1c * 8) = g1;
        if (tid < 256) { float x[8] = {bflo(g2.x), bfhi(g2.x), bflo(g2.y), bfhi(g2.y), bflo(g2.z), bfhi(g2.z), bflo(g2.w), bfhi(g2.w)};
            if (lc_ < 4) {
#pragma unroll
                for (int j = 0; j < 8; ++j) x[j] = 1.0f - 2.0f * __builtin_amdgcn_rcpf(1.0f + fexp(2.0f * x[j])); }
            v4u w; w.x = pk2(x[0], x[1]); w.y = pk2(x[2], x[3]); w.z = pk2(x[4], x[5]); w.w = pk2(x[6], x[7]);
            *(LAS v4u*)(LwB + lr_ * 72 + lc_ * 8) = w; }
    };
    gload(0); lstore(0);
    __syncthreads();
    for (int n = -2; n < nchT; ++n) {
        if (n + 3 < nchT) gload(n + 3);
        int ln_ = lane; asm volatile("" : "+v"(ln_));
        const int l31 = ln_ & 31, hh = ln_ >> 5;
        if (wave < 2) {
            if (n >= 0) {
                const int seg = n >= nchC, ch = seg ? n - nchC : n, len = seg ? T : TC;
                const int tbase = dir ? (len - 32 * (ch + 1)) : 32 * ch;
                LAS uchar* sp = SET0 + (n & 1) * SETSZ;
                LAS bf16* KhT = (LAS bf16*)sp; LAS bf16* BhT = KhT + 32 * 72; LAS bf16* KkT = BhT + 32 * 72; LAS bf16* RhT = KkT + 32 * 72;
                LAS bf16* Kh = RhT + 32 * 72; LAS bf16* nBh = Kh + 64 * 40; LAS bf16* VT = nBh + 64 * 40; LAS float* GL = (LAS float*)(VT + 64 * 40); LAS bf16* TT = (LAS bf16*)(GL + 64);
                const int vcol = 32 * wave + l31;
                f32x16 accP, accY;
#pragma unroll
                for (int r = 0; r < 16; ++r) { accP[r] = 0.f; accY[r] = 0.f; }
#pragma unroll
                for (int kb = 0; kb < 2; ++kb)
#pragma unroll
                    for (int s = 0; s < 2; ++s) { const bf16x8 sb = pack_acc(kb ? ST1 : ST0, s);
                        accP = mfma32(ldperm(KkT + l31 * 72, 32 * kb + 16 * s, hh), sb, accP);
                        accY = mfma32(ldperm(RhT + l31 * 72, 32 * kb + 16 * s, hh), sb, accY); }
                const LAS bf16x8* FR = (const LAS bf16x8*)(sp + FR_OFF);
#pragma unroll
                for (int s = 0; s < 2; ++s) { const bf16x8 vt_ = ldperm(VT + vcol * 40, 16 * s, hh);
                    accP = mfma32(FR[(0 + s) * 64 + ln_], vt_, accP);
                    accY = mfma32(FR[(2 + s) * 64 + ln_], vt_, accY); }
                f32x16 accC;
#pragma unroll
                for (int r = 0; r < 16; ++r) accC[r] = 0.f;
#pragma unroll
                for (int s = 0; s < 2; ++s) accC = mfma32(ldperm(TT + l31 * 40, 16 * s, hh), pack_acc(accP, s), accC);
#pragma unroll
                for (int s = 0; s < 2; ++s) accY = mfma32(FR[(4 + s) * 64 + ln_], pack_acc(accC, s), accY);
#pragma unroll
                for (int s = 0; s < 2; ++s) { const bf16x8 vb_ = *(const LAS bf16x8*)(VT + vcol * 40 + 16 * s + 8 * hh); const bf16x8 cb_ = pack_acc(accC, s);
                    ST0 = mfma32(*(const LAS bf16x8*)(Kh + l31 * 40 + 16 * s + 8 * hh), vb_, ST0);
                    ST1 = mfma32(*(const LAS bf16x8*)(Kh + (32 + l31) * 40 + 16 * s + 8 * hh), vb_, ST1);
                    ST0 = mfma32(ldperm(nBh + l31 * 40, 16 * s, hh), cb_, ST0);
                    ST1 = mfma32(ldperm(nBh + (32 + l31) * 40, 16 * s, hh), cb_, ST1); }
#pragma unroll
                for (int r = 0; r < 16; ++r) { ST0[r] *= GL[crow(r, hh)]; ST1[r] *= GL[32 + crow(r, hh)]; }
#pragma unroll
                for (int r = 0; r < 16; ++r) { const int i = crow(r, hh), t = dir ? (tbase + 31 - i) : (tbase + i);
                    YR[(size_t)tok_row(b, seg, t) * 256 + hd * 64 + vcol] = (bf16)f2bf(accY[r]); }
            }
        } else if (wave == 2) {
            if (n + 1 >= 0 && n + 1 < nchT) {
                LAS uchar* sp = SET0 + ((n + 1) & 1) * SETSZ;
                LAS bf16* BhT = (LAS bf16*)sp + 32 * 72; LAS bf16* KkT = BhT + 32 * 72; LAS bf16* TT = (LAS bf16*)(sp + 4 * 4608 + 3 * 5120 + 256);
                f32x16 P, PT, Tm, TTm;
#pragma unroll
                for (int r = 0; r < 16; ++r) { P[r] = 0.f; PT[r] = 0.f; }
#pragma unroll
                for (int s = 0; s < 4; ++s) { const bf16x8 bh_ = *(const LAS bf16x8*)(BhT + l31 * 72 + 16 * s + 8 * hh), kk_ = *(const LAS bf16x8*)(KkT + l31 * 72 + 16 * s + 8 * hh);
                    P = mfma32(bh_, kk_, P); PT = mfma32(kk_, bh_, PT); }
#pragma unroll
                for (int r = 0; r < 16; ++r) { const int j = crow(r, hh);
                    P[r] = (j < l31) ? P[r] : 0.f; PT[r] = (j > l31) ? PT[r] : 0.f;
                    const float idv = (j == l31) ? 1.f : 0.f; Tm[r] = idv - P[r]; TTm[r] = idv - PT[r]; }
#pragma unroll
                for (int it = 0; it < 4; ++it) {
                    const bf16x8 p0 = pack_acc(P, 0), p1 = pack_acc(P, 1), q0 = pack_acc(PT, 0), q1 = pack_acc(PT, 1);
                    f32x16 P2, P2T;
#pragma unroll
                    for (int r = 0; r < 16; ++r) { P2[r] = 0.f; P2T[r] = 0.f; }
                    P2 = mfma32(q0, p0, P2); P2 = mfma32(q1, p1, P2);
                    if (it < 3) { P2T = mfma32(p0, q0, P2T); P2T = mfma32(p1, q1, P2T); }
                    const bf16x8 u0 = pack_acc(TTm, 0), u1 = pack_acc(TTm, 1);
                    const bf16x8 a0 = pack_acc(P2, 0), a1 = pack_acc(P2, 1);
                    Tm = mfma32(u0, a0, Tm); Tm = mfma32(u1, a1, Tm);
                    if (it < 3) { TTm = mfma32(a0, u0, TTm); TTm = mfma32(a1, u1, TTm); }
                    P = P2; PT = P2T;
                }
#pragma unroll
                for (int r = 0; r < 16; ++r) TT[l31 * 40 + crow(r, hh)] = (bf16)f2bf(Tm[r]);
            }
        } else if (wave == 3) {
            if (n + 1 >= 0 && n + 1 < nchT) {
                LAS uchar* sp = SET0 + ((n + 1) & 1) * SETSZ;
                LAS bf16* KhT = (LAS bf16*)sp; LAS bf16* BhT = KhT + 32 * 72; LAS bf16* KkT = BhT + 32 * 72; LAS bf16* RhT = KkT + 32 * 72;
                LAS bf16x8* FR = (LAS bf16x8*)(sp + FR_OFF);
                f32x16 a1, a2, a3;
#pragma unroll
                for (int r = 0; r < 16; ++r) { a1[r] = 0.f; a2[r] = 0.f; a3[r] = 0.f; }
#pragma unroll
                for (int s = 0; s < 4; ++s) { const bf16x8 kh_ = *(const LAS bf16x8*)(KhT + l31 * 72 + 16 * s + 8 * hh), kk_ = *(const LAS bf16x8*)(KkT + l31 * 72 + 16 * s + 8 * hh),
                                                             rh_ = *(const LAS bf16x8*)(RhT + l31 * 72 + 16 * s + 8 * hh), bh_ = *(const LAS bf16x8*)(BhT + l31 * 72 + 16 * s + 8 * hh);
                    a1 = mfma32(kh_, kk_, a1); a2 = mfma32(kh_, rh_, a2); a3 = mfma32(bh_, rh_, a3); }
#pragma unroll
                for (int r = 0; r < 16; ++r) { const int j = crow(r, hh); a1[r] = (j < l31) ? a1[r] : 0.f; a2[r] = (j <= l31) ? a2[r] : 0.f; a3[r] = (j <= l31) ? -a3[r] : 0.f; }
#pragma unroll
                for (int s = 0; s < 2; ++s) { FR[(0 + s) * 64 + ln_] = pack_acc(a1, s); FR[(2 + s) * 64 + ln_] = pack_acc(a2, s); FR[(4 + s) * 64 + ln_] = pack_acc(a3, s); }
            }
        } else if (wave >= 4) {
            if (n + 2 < nchT) {
                const int w4 = wave - 4, mat = (w4 >> 1) ^ 1;
                const LAS bf16* LwB = (const LAS bf16*)(RAW0 + ((n + 2) & 1) * RAWSZ + 13056);
                f32x16 acc;
#pragma unroll
                for (int r = 0; r < 16; ++r) acc[r] = 0.f;
                const int ko = mat * 32, arow = dir ? (31 - l31) : l31, cch = 32 * (w4 & 1) + l31;
                acc = mfma32(*(const LAS bf16x8*)(LwB + arow * 72 + ko + 8 * hh), lf0, acc);
                acc = mfma32(*(const LAS bf16x8*)(LwB + arow * 72 + ko + 16 + 8 * hh), lf1, acc);
                const float c0_ = CST[mat * 64 + cch];
                if (mat) {
#pragma unroll
                    for (int r = 0; r < 16; ++r) AL[crow(r, hh) * 64 + cch] = __builtin_amdgcn_rcpf(1.0f + fexp(-(acc[r] + c0_)));
                } else {
#pragma unroll
                    for (int r = 0; r < 16; ++r) acc[r] = -0.60653065971f * __builtin_amdgcn_rcpf(1.0f + fexp(-(acc[r] + c0_)));
                    float off = 0.f;
#pragma unroll
                    for (int g = 0; g < 4; ++g) {
                        acc[4 * g + 1] += acc[4 * g]; acc[4 * g + 2] += acc[4 * g + 1]; acc[4 * g + 3] += acc[4 * g + 2];
                        const float tg = acc[4 * g + 3], ug = __shfl_xor(tg, 32);
                        const float o = off + (hh ? ug : 0.f);
#pragma unroll
                        for (int e = 0; e < 4; ++e) acc[4 * g + e] += o;
                        off += tg + ug;
                    }
#pragma unroll
                    for (int r = 0; r < 16; ++r) WL[crow(r, hh) * 64 + cch] = acc[r];
                }
            }
        }
        lds_barrier();
#ifdef DBG_REP_R23
        for (int rp_ = 0; rp_ < 2; ++rp_) {
#else
        {
#endif
        const bool pv = n + 2 < nchT;
        const int pi = tid >> 4, c4 = (ln_ & 15) * 4, pjr = dir ? (32 - pi) : (pi + 1);
        if (pv) {
            LAS uchar* sp = SET0 + (n & 1) * SETSZ;
            LAS bf16* KhT = (LAS bf16*)sp; LAS bf16* BhT = KhT + 32 * 72; LAS bf16* KkT = BhT + 32 * 72; LAS bf16* RhT = KkT + 32 * 72;
            LAS bf16* Kh = RhT + 32 * 72; LAS bf16* nBh = Kh + 64 * 40; LAS bf16* VT = nBh + 64 * 40; LAS float* GL = (LAS float*)(VT + 64 * 40);
            const LAS bf16* Raw = (const LAS bf16*)(RAW0 + (n & 1) * RAWSZ);
            const f32x4 cum = *(const LAS f32x4*)(WL + pi * 64 + c4);
            f32x4 cpv = *(const LAS f32x4*)(WL + (pi ? pi - 1 : 0) * 64 + c4);
            if (pi == 0) cpv = (f32x4){0.f, 0.f, 0.f, 0.f};
            float rr[4], kv[4], vv[4];
            { const f32x4 br = *(const LAS f32x4*)(CST + 13 * 64 + c4), bk = *(const LAS f32x4*)(CST + 14 * 64 + c4), bv = *(const LAS f32x4*)(CST + 15 * 64 + c4);
#pragma unroll
              for (int e = 0; e < 4; ++e) { rr[e] = br[e]; kv[e] = bk[e]; vv[e] = bv[e]; } }
#pragma unroll
            for (int tap = 0; tap < 3; ++tap) {
                const LAS bf16* rp = Raw + (pjr - 1 + tap) * 192 + c4;
                const v2u xr = *(const LAS v2u*)rp, xk = *(const LAS v2u*)(rp + 64), xv = *(const LAS v2u*)(rp + 128);
                const f32x4 wr = *(const LAS f32x4*)(CST + (4 + tap) * 64 + c4), wk = *(const LAS f32x4*)(CST + (7 + tap) * 64 + c4), wv = *(const LAS f32x4*)(CST + (10 + tap) * 64 + c4);
                rr[0] += wr[0] * bflo(xr.x); rr[1] += wr[1] * bfhi(xr.x); rr[2] += wr[2] * bflo(xr.y); rr[3] += wr[3] * bfhi(xr.y);
                kv[0] += wk[0] * bflo(xk.x); kv[1] += wk[1] * bfhi(xk.x); kv[2] += wk[2] * bflo(xk.y); kv[3] += wk[3] * bfhi(xk.y);
                vv[0] += wv[0] * bflo(xv.x); vv[1] += wv[1] * bfhi(xv.x); vv[2] += wv[2] * bflo(xv.y); vv[3] += wv[3] * bfhi(xv.y);
            }
            const f32x4 kkc4 = *(const LAS f32x4*)(CST + 2 * 64 + c4), kac4 = *(const LAS f32x4*)(CST + 3 * 64 + c4);
            const f32x4 av4 = *(const LAS f32x4*)(AL + pi * 64 + c4);
            float kx[4]; float ss = 0.f;
#pragma unroll
            for (int e = 0; e < 4; ++e) { kx[e] = kv[e] * kkc4[e]; ss += kx[e] * kx[e]; }
            ss = sum16(ss);
            const float rn = __builtin_amdgcn_rcpf(fmaxf(__builtin_amdgcn_sqrtf(ss), 1e-12f));
            float kh[4], bh[4], kk_[4], rh[4];
#pragma unroll
            for (int e = 0; e < 4; ++e) { const float av = av4[e], kn = kx[e] * rn, en = fexp(-cum[e]), ep = fexp(cum[e]), epv = fexp(cpv[e]);
                kh[e] = kv[e] * (1.0f + (av - 1.0f) * kac4[e]) * en; bh[e] = kn * av * en; kk_[e] = kn * epv; rh[e] = rr[e] * ep; }
            v2u o;
            o.x = pk2(kh[0], kh[1]); o.y = pk2(kh[2], kh[3]); *(LAS v2u*)(KhT + pi * 72 + c4) = o;
            o.x = pk2(bh[0], bh[1]); o.y = pk2(bh[2], bh[3]); *(LAS v2u*)(BhT + pi * 72 + c4) = o;
            o.x = pk2(kk_[0], kk_[1]); o.y = pk2(kk_[2], kk_[3]); *(LAS v2u*)(KkT + pi * 72 + c4) = o;
            o.x = pk2(rh[0], rh[1]); o.y = pk2(rh[2], rh[3]); *(LAS v2u*)(RhT + pi * 72 + c4) = o;
#pragma unroll
            for (int e = 0; e < 4; ++e) { Kh[(c4 + e) * 40 + pi] = (bf16)f2bf(kh[e]); nBh[(c4 + e) * 40 + pi] = (bf16)f2bf(-bh[e]); VT[(c4 + e) * 40 + pi] = (bf16)f2bf(vv[e]); }
            if (pi == 31) *(LAS f32x4*)(GL + c4) = (f32x4){fexp(cum[0]), fexp(cum[1]), fexp(cum[2]), fexp(cum[3])};
        }
        }
        if (n + 3 < nchT) lstore((n + 3) & 1);
        lds_barrier();
    }
}

DI void mlstm_task(KArgs a, const Ctx& F, int l, int b, int hd) {
    const bf16* Z = (const bf16*)(a->ws + WS_ACT);
    const int tid = F.tid, lane = F.lane, wave = F.wave, dir = wave >> 2, w2 = wave & 3, tid2 = tid & 255, l31 = lane & 31, hh = lane >> 5;
    bf16* YM = (bf16*)(a->ws + WS_YM) + (size_t)dir * NROWS * 256;
    constexpr int HP = 72;
    constexpr int HALF_LDS = 6 * 9216 + 2304 + 2048;
    LAS uchar* base = F.lds + dir * HALF_LDS;
    LAS bf16* Qc = (LAS bf16*)base; LAS bf16* Kc = Qc + 64 * HP; LAS bf16* KT = Kc + 64 * HP; LAS bf16* VT = KT + 64 * HP; LAS bf16* Cb0 = VT + 64 * HP;
    LAS float* fv = (LAS float*)(base + 6 * 9216);
    LAS float* Vgv = fv; LAS float* VMr = fv + 64; LAS float* Vwi = fv + 128; LAS float* Vem = fv + 192; LAS float* Vwk = fv + 256; LAS float* Vn0 = fv + 320; LAS float* Vsc = fv + 448;
    LAS float* Cw = fv + 576;
    for (int i = tid2; i < 2 * 64 * HP; i += 256) Cb0[i] = 0;
    if (tid2 < 128) Vn0[tid2] = 0.f;
    { const float* cw = a->in[I_MCW] + (size_t)l * 3 * 512; const float* cbp = a->in[I_MCB] + (size_t)l * 512;
      for (int i = tid2; i < 512; i += 256) { const int tap = i >> 7, cc = i & 127, col = (cc < 64) ? (hd * 64 + cc) : (256 + hd * 64 + cc - 64);
          Cw[i] = (tap < 3) ? cw[tap * 512 + col] : cbp[col]; } }
    f32x16 accC;
#pragma unroll
    for (int r = 0; r < 16; ++r) accC[r] = 0.f;
    float m_run = 0.f;
    const int eb = w2 >> 1, lb = w2 & 1;
    const float gbi = a->in[I_MGB][l * 16 + dir * 8 + hd], gbf = a->in[I_MGB][l * 16 + dir * 8 + 4 + hd];
    const int nchC = TC / 64, nchT = nchC + T / 64;
    const int pi_ = tid2 >> 2, qq = tid2 & 3;
    v4u rq[3][2], rk[3][2], rv[2]; unsigned gr0 = 0u, gr1 = 0u;
    unsigned zz_ = 0u; asm volatile("" : "+v"(zz_)); const v4u zero4 = {zz_, zz_, zz_, zz_};
    auto gload = [&](int gc) {
        const int seg = gc >= nchC, ch = seg ? gc - nchC : gc, len = seg ? T : TC;
        const int tbase = dir ? (len - 64 * (ch + 1)) : 64 * ch;
        const int t = tbase + (dir ? (63 - pi_) : pi_);
#pragma unroll
        for (int tap = 0; tap < 3; ++tap) { const int tt = t - 1 + tap; const bool ok = tt >= 0 && tt < len;
            const bf16* zp = Z + (size_t)tok_row(b, seg, ok ? tt : t) * ZP + ZMQK + hd * 64 + qq * 16;
            rq[tap][0] = ok ? *(const v4u*)zp : zero4; rq[tap][1] = ok ? *(const v4u*)(zp + 8) : zero4;
            rk[tap][0] = ok ? *(const v4u*)(zp + 256) : zero4; rk[tap][1] = ok ? *(const v4u*)(zp + 264) : zero4; }
        { const bf16* zp = Z + (size_t)tok_row(b, seg, t) * ZP + ZMV + hd * 64 + qq * 16; rv[0] = *(const v4u*)zp; rv[1] = *(const v4u*)(zp + 8); }
        if (tid2 < 64) { const bf16* zp = Z + (size_t)tok_row(b, seg, tbase + tid2) * ZP + ZMG + dir * 8 + hd; gr0 = zp[0]; gr1 = zp[4]; }
    };
    gload(0);
    __syncthreads();
    for (int gc = 0; gc < nchT; ++gc) {
        const int seg = gc >= nchC, ch = seg ? gc - nchC : gc, len = seg ? T : TC;
        const int tbase = dir ? (len - 64 * (ch + 1)) : 64 * ch;
        LAS bf16* Cb = Cb0 + (gc & 1) * 64 * HP; LAS bf16* CbN = Cb0 + ((gc + 1) & 1) * 64 * HP;
        LAS float* Vn = Vn0 + (gc & 1) * 64; LAS float* VnN = Vn0 + ((gc + 1) & 1) * 64;
        if (w2 == 0) {
            float li = bf2f(gr0) + gbi; const float fraw = bf2f(gr1) + gbf;
            float lf = fminf(fraw, 0.f) - 0.69314718056f * __builtin_amdgcn_logf(1.0f + fexp(-fabsf(fraw)));
            if (dir) { li = __shfl(li, 63 - lane); lf = __shfl(lf, 63 - lane); }
            const float bc = wave_scan_sum(lf);
            const float g = li - bc; const float pm = wave_scan_max(g);
            const float mprev = m_run;
            const float blast = __shfl(bc, 63);
            const float lw = blast - bc + li;
            const float mnew = fmaxf(blast + mprev, wave_max(lw));
            const float Mr = fmaxf(mprev, pm);
            Vgv[lane] = g; VMr[lane] = Mr; Vwi[lane] = fexp(mprev - Mr); Vem[lane] = fexp(-bc - Mr); Vwk[lane] = fexp(lw - mnew);
            if (lane == 0) Vsc[0] = fexp(blast + mprev - mnew);
            m_run = mnew;
        }
        {
            float qv[16], kvv[16];
#pragma unroll
            for (int j = 0; j < 16; ++j) { qv[j] = Cw[384 + qq * 16 + j]; kvv[j] = Cw[384 + 64 + qq * 16 + j]; }
#pragma unroll
            for (int tap = 0; tap < 3; ++tap) {
                const unsigned qw[8] = {rq[tap][0].x, rq[tap][0].y, rq[tap][0].z, rq[tap][0].w, rq[tap][1].x, rq[tap][1].y, rq[tap][1].z, rq[tap][1].w};
                const unsigned kw[8] = {rk[tap][0].x, rk[tap][0].y, rk[tap][0].z, rk[tap][0].w, rk[tap][1].x, rk[tap][1].y, rk[tap][1].z, rk[tap][1].w};
#pragma unroll
                for (int j = 0; j < 8; ++j) { qv[2 * j] += Cw[tap * 128 + qq * 16 + 2 * j] * bflo(qw[j]); qv[2 * j + 1] += Cw[tap * 128 + qq * 16 + 2 * j + 1] * bfhi(qw[j]);
                    kvv[2 * j] += Cw[tap * 128 + 64 + qq * 16 + 2 * j] * bflo(kw[j]); kvv[2 * j + 1] += Cw[tap * 128 + 64 + qq * 16 + 2 * j + 1] * bfhi(kw[j]); }
            }
#pragma unroll
            for (int j = 0; j < 16; ++j) { qv[j] = qv[j] * fsigmoid(qv[j]); kvv[j] = kvv[j] * fsigmoid(kvv[j]) * 0.125f; }
#pragma unroll
            for (int j = 0; j < 16; j += 2) { *(LAS unsigned*)(Qc + pi_ * HP + qq * 16 + j) = pk2(qv[j], qv[j + 1]); *(LAS unsigned*)(Kc + pi_ * HP + qq * 16 + j) = pk2(kvv[j], kvv[j + 1]); }
            const unsigned vw[8] = {rv[0].x, rv[0].y, rv[0].z, rv[0].w, rv[1].x, rv[1].y, rv[1].z, rv[1].w};
#pragma unroll
            for (int j = 0; j < 16; ++j) { KT[(qq * 16 + j) * HP + pi_] = (bf16)f2bf(kvv[j]); VT[(qq * 16 + j) * HP + pi_] = (bf16)((j & 1) ? (vw[j >> 1] >> 16) : (vw[j >> 1] & 0xffffu)); }
        }
        if (gc + 1 < nchT) gload(gc + 1);
        lds_barrier();
        {
            const int lidx = 32 * lb + l31;
            f32x16 accN, accI;
#pragma unroll
            for (int r = 0; r < 16; ++r) { accN[r] = 0.f; accI[r] = 0.f; }
            float dsum = 0.f;
            const float Mr = VMr[lidx];
#pragma unroll
            for (int sb = 0; sb < 2; ++sb) {
                if (sb <= lb) {
                    f32x16 sT;
#pragma unroll
                    for (int r = 0; r < 16; ++r) sT[r] = 0.f;
#pragma unroll
                    for (int s = 0; s < 4; ++s) {
                        const bf16x8 ka = *(const LAS bf16x8*)(Kc + (32 * sb + l31) * HP + 16 * s + 8 * hh);
                        const bf16x8 qb = *(const LAS bf16x8*)(Qc + lidx * HP + 16 * s + 8 * hh);
                        sT = mfma32(ka, qb, sT);
                    }
#pragma unroll
                    for (int g4 = 0; g4 < 4; ++g4) { const f32x4 gv4 = *(const LAS f32x4*)(Vgv + 32 * sb + 8 * g4 + 4 * hh);
#pragma unroll
                        for (int e = 0; e < 4; ++e) { const int r = 4 * g4 + e, sidx = 32 * sb + 8 * g4 + 4 * hh + e;
                            const float ex = fexp(fminf(gv4[e] - Mr, 0.f));
                            const float p = (sidx <= lidx) ? sT[r] * ex : 0.f; sT[r] = p; dsum += p; } }
#pragma unroll
                    for (int sp = 0; sp < 2; ++sp) {
                        const bf16x8 pf = pack8(sT[8 * sp + 0], sT[8 * sp + 1], sT[8 * sp + 2], sT[8 * sp + 3], sT[8 * sp + 4], sT[8 * sp + 5], sT[8 * sp + 6], sT[8 * sp + 7]);
                        const int ko = 32 * sb + 16 * sp + 4 * hh;
                        const bf16x4 a0 = *(const LAS bf16x4*)(VT + (32 * eb + l31) * HP + ko), a1 = *(const LAS bf16x4*)(VT + (32 * eb + l31) * HP + ko + 8);
                        accN = mfma32(__builtin_shufflevector(a0, a1, 0, 1, 2, 3, 4, 5, 6, 7), pf, accN);
                    }
                }
            }
#pragma unroll
            for (int s = 0; s < 4; ++s) {
                const bf16x8 ca = *(const LAS bf16x8*)(Cb + (32 * eb + l31) * HP + 16 * s + 8 * hh);
                const bf16x8 qb = *(const LAS bf16x8*)(Qc + lidx * HP + 16 * s + 8 * hh);
                accI = mfma32(ca, qb, accI);
            }
            dsum += __shfl_xor(dsum, 32);
            float nq = 0.f;
#pragma unroll
            for (int j = 0; j < 64; j += 8) { const v4u w = *(const LAS v4u*)(Qc + lidx * HP + j); const f32x4 n0 = *(const LAS f32x4*)(Vn + j), n1 = *(const LAS f32x4*)(Vn + j + 4);
                nq += (n0[0] * bflo(w.x) + n0[1] * bfhi(w.x)) + (n0[2] * bflo(w.y) + n0[3] * bfhi(w.y)) + (n1[0] * bflo(w.z) + n1[1] * bfhi(w.z)) + (n1[2] * bflo(w.w) + n1[3] * bfhi(w.w)); }
            const float wi = Vwi[lidx];
            const float den = dsum + wi * nq, hden = fmaxf(fabsf(den), Vem[lidx]), inv = __builtin_amdgcn_rcpf(hden);
            const int t = dir ? (tbase + 63 - lidx) : (tbase + lidx);
            bf16* op = YM + (size_t)tok_row(b, seg, t) * 256 + hd * 64 + 32 * eb;
#pragma unroll
            for (int gq_ = 0; gq_ < 4; ++gq_) {
                const float h0 = (accN[4 * gq_] + wi * accI[4 * gq_]) * inv, h1 = (accN[4 * gq_ + 1] + wi * accI[4 * gq_ + 1]) * inv, h2 = (accN[4 * gq_ + 2] + wi * accI[4 * gq_ + 2]) * inv, h3 = (accN[4 * gq_ + 3] + wi * accI[4 * gq_ + 3]) * inv;
                v2u o; o.x = pk2(h0, h1); o.y = pk2(h2, h3);
                *(v2u*)(op + 8 * gq_ + 4 * hh) = o;
            }
        }
        {
            const float sc = Vsc[0];
#pragma unroll
            for (int r = 0; r < 16; ++r) accC[r] *= sc;
#pragma unroll
            for (int s = 0; s < 4; ++s) {
                const v4u vraw = *(const LAS v4u*)(VT + (32 * eb + l31) * HP + 16 * s + 8 * hh);
                const f32x4 w0 = *(const LAS f32x4*)(Vwk + 16 * s + 8 * hh), w1 = *(const LAS f32x4*)(Vwk + 16 * s + 8 * hh + 4);
                const bf16x8 va = pack8(bflo(vraw.x) * w0[0], bfhi(vraw.x) * w0[1], bflo(vraw.y) * w0[2], bfhi(vraw.y) * w0[3], bflo(vraw.z) * w1[0], bfhi(vraw.z) * w1[1], bflo(vraw.w) * w1[2], bfhi(vraw.w) * w1[3]);
                const bf16x8 kb = *(const LAS bf16x8*)(KT + (32 * lb + l31) * HP + 16 * s + 8 * hh);
                accC = mfma32(va, kb, accC);
            }
#pragma unroll
            for (int r = 0; r < 16; ++r) CbN[(32 * eb + crow(r, hh)) * HP + 32 * lb + l31] = (bf16)f2bf(accC[r]);
            if (tid2 < 64) { float s = 0.f;
#pragma unroll
                for (int j = 0; j < 64; j += 8) { const v4u w = *(const LAS v4u*)(KT + tid2 * HP + j); const f32x4 w0 = *(const LAS f32x4*)(Vwk + j), w1 = *(const LAS f32x4*)(Vwk + j + 4);
                    s += (w0[0] * bflo(w.x) + w0[1] * bfhi(w.x)) + (w0[2] * bflo(w.y) + w0[3] * bfhi(w.y)) + (w1[0] * bflo(w.z) + w1[1] * bfhi(w.z)) + (w1[2] * bflo(w.w) + w1[3] * bfhi(w.w)); }
                VnN[tid2] = sc * Vn[tid2] + s; }
        }
        lds_barrier();
    }
}
DI float gelu_tanh(float x) { const float u = 0.7978845608028654f * (x + 0.044715f * x * x * x); const float e = __expf(2.0f * u); const float th = 1.0f - 2.0f / (e + 1.0f); return 0.5f * x * (1.0f + th); }
DI void unpack8(const v4u w, float (&o)[8]) { o[0] = bflo(w.x); o[1] = bfhi(w.x); o[2] = bflo(w.y); o[3] = bfhi(w.y); o[4] = bflo(w.z); o[5] = bfhi(w.z); o[6] = bflo(w.w); o[7] = bfhi(w.w); }
DI v4u pack8u(const float (&o)[8]) { v4u w; w.x = pk2(o[0], o[1]); w.y = pk2(o[2], o[3]); w.z = pk2(o[4], o[5]); w.w = pk2(o[6], o[7]); return w; }
constexpr int FIN_CST_OFF = 56320;
DI void fin_load_consts(KArgs a, const Ctx& F, int l) {
    LAS float* C = (LAS float*)(F.lds + FIN_CST_OFF);
    for (int i = F.tid; i < 4608; i += NTHR) {
        float v;
        if (i < 2304) v = a->in[I_RCW][(size_t)l * 2304 + i];
        else if (i < 3072) v = a->in[I_RCB][(size_t)l * 768 + (i - 2304)];
        else if (i < 3328) v = a->in[I_RRK][l * 256 + (i - 3072)];
        else if (i < 3584) v = a->in[I_RLNW][l * 256 + (i - 3328)];
        else if (i < 3840) v = a->in[I_RLNB][l * 256 + (i - 3584)];
        else if (i < 4096) v = a->in[I_MNORM][l * 256 + (i - 3840)];
        else if (i < 4352) v = a->in[I_S5D][l * 256 + (i - 4096)];
        else v = a->in[I_S5BGLU][l * 256 + (i - 4352)];
        C[i] = v;
    }
    __syncthreads();
}
DI void fin_tile(KArgs a, const Ctx& F, int l, int tile) {
    const LAS float* CT = (const LAS float*)(F.lds + FIN_CST_OFF);
    const bf16* Z = (const bf16*)(a->ws + WS_ACT); bf16* MO = (bf16*)(a->ws + WS_H);
    const bf16* YS = (const bf16*)(a->ws + WS_YS5); const bf16* YR = (const bf16*)(a->ws + WS_YR); const bf16* YM = (const bf16*)(a->ws + WS_YM);
    const bf16* WGLU = (const bf16*)(a->ws + WS_SMALLW + SW_GLU); const bf16* WGUP = (const bf16*)(a->ws + WS_SMALLW + SW_GUP);
    LAS bf16* Az = (LAS bf16*)F.lds;
    LAS bf16* Ag = (LAS bf16*)(F.lds + 16896);
    LAS float* Pr = (LAS float*)(F.lds + 16896 + 4608);
    int tl_ = F.tid; asm volatile("" : "+v"(tl_));
    const int tid = tl_, lane = tid & 63, wave = F.wave, row0 = tile * 32;
    const int i = tid >> 4, part = tid & 15, row = row0 + i;
    const size_t DS = (size_t)NROWS * 256;
    const bf16* zr = Z + (size_t)row * ZP;
    {
        const LAS float* dsk = CT + 4096 + part * 16;
#pragma unroll
        for (int j = 0; j < 2; ++j) { const int c0 = part * 16 + 8 * j; float y0[8], y1[8], u[8], z[8];
            unpack8(*(const v4u*)(YS + (size_t)row * 256 + c0), y0); unpack8(*(const v4u*)(YS + DS + (size_t)row * 256 + c0), y1); unpack8(*(const v4u*)(zr + ZS5 + c0), u);
#pragma unroll
            for (int e = 0; e < 8; ++e) z[e] = gelu_tanh(y0[e] + y1[e] + dsk[8 * j + e] * u[e]);
            *(LAS v4u*)(Az + i * 264 + c0) = pack8u(z); }
    }
    const int hq = part >> 2, c0 = hq * 64 + (part & 3) * 16;
    const bool lat = row < NLAT; const int t = lat ? (row & (T - 1)) : ((row - NLAT) & (TC - 1)); const int len = lat ? T : TC;
    {
        float y[16]; float s = 0.f;
#pragma unroll
        for (int j = 0; j < 2; ++j) { float y0[8], y1[8]; unpack8(*(const v4u*)(YM + (size_t)row * 256 + c0 + 8 * j), y0); unpack8(*(const v4u*)(YM + DS + (size_t)row * 256 + c0 + 8 * j), y1);
#pragma unroll
            for (int e = 0; e < 8; ++e) { y[8 * j + e] = y0[e] + y1[e]; s += y[8 * j + e]; } }
        s += __shfl_xor(s, 1); s += __shfl_xor(s, 2); const float mu = s * (1.0f / 64.0f); float q = 0.f;
#pragma unroll
        for (int j = 0; j < 16; ++j) { y[j] -= mu; q += y[j] * y[j]; }
        q += __shfl_xor(q, 1); q += __shfl_xor(q, 2); const float rstd = 1.0f / sqrtf(q * (1.0f / 64.0f) + 1e-6f);
        const LAS float* nw = CT + 3840 + c0;
#pragma unroll
        for (int j = 0; j < 2; ++j) { float o[8]; unpack8(*(const v4u*)(zr + ZMO + c0 + 8 * j), o);
#pragma unroll
            for (int e = 0; e < 8; ++e) o[e] = y[8 * j + e] * rstd * nw[8 * j + e] * fsigmoid(o[e]);
            *(v4u*)(MO + (size_t)row * D + 768 + c0 + 8 * j) = pack8u(o); }
    }
    {
        float y[16]; float s = 0.f;
#pragma unroll
        for (int j = 0; j < 2; ++j) { float y0[8], y1[8]; unpack8(*(const v4u*)(YR + (size_t)row * 256 + c0 + 8 * j), y0); unpack8(*(const v4u*)(YR + DS + (size_t)row * 256 + c0 + 8 * j), y1);
#pragma unroll
            for (int e = 0; e < 8; ++e) { y[8 * j + e] = y0[e] + y1[e]; s += y[8 * j + e]; } }
        s += __shfl_xor(s, 1); s += __shfl_xor(s, 2); const float mu = s * (1.0f / 64.0f); float q = 0.f;
#pragma unroll
        for (int j = 0; j < 16; ++j) { y[j] -= mu; q += y[j] * y[j]; }
        q += __shfl_xor(q, 1); q += __shfl_xor(q, 2); const float rstd = 1.0f / sqrtf(q * (1.0f / 64.0f) + 64e-5f);
        const LAS float* cw = CT; const LAS float* cbp = CT + 2304;
        const LAS float* rk = CT + 3072 + c0; const LAS float* lw = CT + 3328 + c0; const LAS float* lb = CT + 3584 + c0;
        float vv[16]; float bs = 0.f;
#pragma unroll
        for (int j = 0; j < 2; ++j) { const int c = c0 + 8 * j;
            float rr[8], kk[8], v[8], x[8];
#pragma unroll
            for (int e = 0; e < 8; ++e) { rr[e] = cbp[c + e]; kk[e] = cbp[256 + c + e]; v[e] = cbp[512 + c + e]; }
#pragma unroll
            for (int tap = 0; tap < 3; ++tap) { const int tt = t - 1 + tap;
                const bool ok = tt >= 0 && tt < len;
                const float okf = ok ? 1.0f : 0.0f;
                const bf16* zp = zr + (ok ? (tap - 1) * ZP : 0) + ZRKV + c;
                unpack8(*(const v4u*)zp, x);
#pragma unroll
                for (int e = 0; e < 8; ++e) rr[e] += (cw[tap * 768 + c + e] * okf) * x[e];
                unpack8(*(const v4u*)(zp + 256), x);
#pragma unroll
                for (int e = 0; e < 8; ++e) kk[e] += (cw[tap * 768 + 256 + c + e] * okf) * x[e];
                unpack8(*(const v4u*)(zp + 512), x);
#pragma unroll
                for (int e = 0; e < 8; ++e) v[e] += (cw[tap * 768 + 512 + c + e] * okf) * x[e]; }
#pragma unroll
            for (int e = 0; e < 8; ++e) { bs += rr[e] * kk[e] * rk[8 * j + e]; vv[8 * j + e] = v[e]; } }
        bs += __shfl_xor(bs, 1); bs += __shfl_xor(bs, 2);
#pragma unroll
        for (int j = 0; j < 16; j += 4) *(LAS f32x4*)(Pr + i * 260 + c0 + j) = (f32x4){y[j] * rstd * lw[j] + lb[j] + bs * vv[j], y[j + 1] * rstd * lw[j + 1] + lb[j + 1] + bs * vv[j + 1], y[j + 2] * rstd * lw[j + 2] + lb[j + 2] + bs * vv[j + 2], y[j + 3] * rstd * lw[j + 3] + lb[j + 3] + bs * vv[j + 3]};
    }
    {
        const v2u gv = *(const v2u*)(zr + ZGD + part * 4);
        v2u o; o.x = pk2(fsigmoid(bflo(gv.x)), fsigmoid(bfhi(gv.x))); o.y = pk2(fsigmoid(bflo(gv.y)), fsigmoid(bfhi(gv.y)));
        *(LAS v2u*)(Ag + i * 72 + part * 4) = o;
    }
    __syncthreads();
    const int lr = lane & 15, kq = lane >> 4;
    {
        f32x4 acc[2][2];
        small_gemm<256, 2, 2, true>(Az, 264, WGLU, 32 * wave, acc, lane);
        const LAS float* bg = CT + 4352;
#pragma unroll
        for (int nb = 0; nb < 2; ++nb)
#pragma unroll
            for (int mb = 0; mb < 2; ++mb) { const int tk = 16 * mb + lr, n = 32 * wave + 16 * nb + 4 * kq; const f32x4 v = acc[nb][mb]; const f32x4 b4 = *(const LAS f32x4*)(bg + n);
                const v2u zz = *(const LAS v2u*)(Az + tk * 264 + n);
                const float o0 = bflo(zz.x) * fsigmoid(v.x + b4.x), o1 = bfhi(zz.x) * fsigmoid(v.y + b4.y), o2 = bflo(zz.y) * fsigmoid(v.z + b4.z), o3 = bfhi(zz.y) * fsigmoid(v.w + b4.w);
                v2u o; o.x = pk2(o0, o1); o.y = pk2(o2, o3);
                *(v2u*)(MO + (size_t)(row0 + tk) * D + n) = o; }
    }
    {
        f32x4 acc[2][2];
        small_gemm<64, 2, 2, true>(Ag, 72, WGUP, 32 * wave, acc, lane);
#pragma unroll
        for (int nb = 0; nb < 2; ++nb)
#pragma unroll
            for (int mb = 0; mb < 2; ++mb) { const int tk = 16 * mb + lr, n = 32 * wave + 16 * nb + 4 * kq; const f32x4 v = acc[nb][mb];
                const f32x4 pr = *(const LAS f32x4*)(Pr + tk * 260 + n);
                v2u o; o.x = pk2(pr.x * v.x, pr.y * v.y); o.y = pk2(pr.z * v.z, pr.w * v.w);
                *(v2u*)(MO + (size_t)(row0 + tk) * D + 512 + n) = o; }
    }
    __syncthreads();
}
#ifndef MK_SPLIT
#define MK_SPLIT 1
#endif
#ifndef MERGE_PREP
#define MERGE_PREP 1
#endif
#ifdef USE_NOINLINE
#define NI static __device__ __noinline__
#else
#define NI static __device__ __forceinline__
#endif
extern __shared__ __attribute__((aligned(16))) unsigned char lds_raw[];
DI Ctx make_ctx(int wave0) {
    Ctx F; F.lds = (LAS uchar*)lds_raw; { int ln_ = __builtin_amdgcn_mbcnt_hi(~0u, __builtin_amdgcn_mbcnt_lo(~0u, 0u)); asm volatile("" : "+v"(ln_)); F.lane = ln_; } F.wave = wave0; F.tid = wave0 * 64 + F.lane;
    F.G = gridDim.x; { int bx = blockIdx.x; asm volatile("" : "+s"(bx)); F.vcu = (F.G % 8 == 0) ? (bx % 8) * (F.G / 8) + bx / 8 : bx; }
    return F;
}
DI void att_subbarrier(unsigned* cnt, unsigned n_att, bool t0) {
    asm volatile("s_waitcnt vmcnt(0)" ::: "memory");
    __syncthreads();
    if (t0) {
        __builtin_amdgcn_fence(__ATOMIC_RELEASE, "agent");
        asm volatile("s_waitcnt vmcnt(0)" ::: "memory");
        (void)xb_add(cnt, 1u);
        unsigned sp = 0u;
        while (xb_ld(cnt) < n_att) { __builtin_amdgcn_s_sleep(1); if (++sp > XB_SPIN_CAP) break; }
        __builtin_amdgcn_fence(__ATOMIC_ACQUIRE, "agent");
        asm volatile("s_waitcnt vmcnt(0)" ::: "memory");
    }
    __syncthreads();
}
NI void ph_prologue(KArgs a_, int wave0) { KArgs a = a_; asm volatile("" : "+s"(a)); const Ctx F = make_ctx(wave0); phase_prologue(a, F); __syncthreads(); }
NI void ph_norm(KArgs a_, int wave0, int l, int kind) { KArgs a = a_; asm volatile("" : "+s"(a));
    const Ctx F = make_ctx(wave0);
    float* modv = (float*)(a->ws + WS_MODV);
    const bool last = (l == DEPTH - 1);
    if (kind == 0) convert_weights(a, F, l, 0);
    if (kind == 1) convert_weights(a, F, l, 1);
#ifdef DUP_CONV
    if (kind == 0) convert_weights(a, F, l, 0);
    if (kind == 1) convert_weights(a, F, l, 1);
#endif
    const int lY = (kind == 0) ? (l > 0 ? l - 1 : 0) : l;
    const int gi = (kind == 0 || kind == 3) ? 8 : (kind == 1 ? 2 : 5);
    const int pi = (kind == 0 || kind == 3) ? 2 : (kind == 1 ? 0 : 1);
    const float coef = (kind == 2) ? 1.0f : 0.5f;
    const int si = (kind == 0) ? 0 : (kind == 1 ? 3 : 6);
    const int ni = (kind == 0) ? 0 : (kind == 1 ? 1 : 2);
    const bool first = (kind == 0 && l == 0), hasY = !(kind == 0 && l == 0), hasH = (kind != 3), fin = (kind == 3);
    const int nrows = (kind == 3 || (kind == 2 && last)) ? NLAT : NROWS;
#ifdef DUP_NORM
    if (kind == DUP_NORM && hasY) { norm_rows(a, F, first, hasY, hasH, fin, nrows, modv + (size_t)lY * 9 * MODW, gi, a->in[I_NPOST] + (lY * 3 + pi) * D, coef, modv + (size_t)l * 9 * MODW, si, a->in[I_NPRE] + (l * 3 + ni) * D, true); __syncthreads(); }
#endif
    norm_rows(a, F, first, hasY, hasH, fin, nrows, modv + (size_t)lY * 9 * MODW, gi, a->in[I_NPOST] + (lY * 3 + pi) * D, coef, modv + (size_t)l * 9 * MODW, si, a->in[I_NPRE] + (l * 3 + ni) * D);
    __syncthreads();
}
NI void ph_gemm_swiglu(KArgs a_, int wave0, int M) { KArgs a = a_; asm volatile("" : "+s"(a));
    const Ctx F = make_ctx(wave0);
    pg8::Gemm g{(const bf16*)(a->ws + WS_H), (const bf16*)(a->ws + WS_WGU), M, 2 * FF, D}; pg8::StaticOrder S; S.init(M, 2 * FF, F.G, (int)blockIdx.x);
    pg8::EpiSwiGLU E{(bf16*)(a->ws + WS_ACT), FF};
    pg8::gemm_phase<pg8::EpiSwiGLU, pg8::StaticOrder, PG8_ALIGN, PG8_SP2>(F.lds, g, S, E, F.tid);
}
NI void ph_gemm_store(KArgs a_, int wave0, int which, int M) { KArgs a = a_; asm volatile("" : "+s"(a));
    const Ctx F = make_ctx(wave0);
    const bf16* A = (const bf16*)(a->ws + (which == 0 ? WS_ACT : WS_H));
    const bf16* W = (const bf16*)(a->ws + (which == 0 ? WS_WDN : which == 1 ? WS_WIN : WS_WOUT));
    const int N = which == 1 ? ZPAD : D, K = which == 0 ? FF : D;
    const bool split_ctx = (which != 1) && (M == NROWS);
    const int Mg = split_ctx ? NLAT : M;
    pg8::Gemm g{A, W, Mg, N, K}; pg8::StaticOrder S; S.init(Mg, N, F.G, (int)blockIdx.x);
    pg8::EpiStore E{(bf16*)(a->ws + (which == 1 ? WS_ACT : WS_Y)), which == 1 ? ZP : D, which == 1 ? ZP : D};
    pg8::gemm_phase<pg8::EpiStore, pg8::StaticOrder, PG8_ALIGN, PG8_SP2>(F.lds, g, S, E, F.tid);
    if (split_ctx) { __syncthreads(); ctx_gemm_block(F, A, W, K, (bf16*)(a->ws + WS_Y)); }
}
NI void ph_mla_prep(KArgs a_, int wave0, int l, int first, int stride) { KArgs a = a_; asm volatile("" : "+s"(a)); const Ctx F = make_ctx(wave0); for (int tile = first; tile < NROWS / 64; tile += stride) mla_prep_tile(a, F, l, tile); }
NI void ph_rwkv(KArgs a_, int wave0, int l, int v) { KArgs a = a_; asm volatile("" : "+s"(a)); const Ctx F = make_ctx(wave0); rwkv_scan_task(a, F, l, v >> 3, (v >> 1) & 3, v & 1); }
NI void ph_mlstm(KArgs a_, int wave0, int l, int idx) { KArgs a = a_; asm volatile("" : "+s"(a)); const Ctx F = make_ctx(wave0); mlstm_task(a, F, l, idx >> 2, idx & 3); __syncthreads(); }
NI void ph_s5(KArgs a_, int wave0, int l, int wg) { KArgs a = a_; asm volatile("" : "+s"(a)); const Ctx F = make_ctx(wave0); const int tk = wg * 8 + F.wave; s5_scan_task(a, l, tk >> 5, (tk >> 4) & 1, tk & 15, (LAS bf16*)(F.lds + F.wave * 8704), F.lane); __syncthreads(); }
NI void ph_attn(KArgs a_, int wave0, int first, int stride) { KArgs a = a_; asm volatile("" : "+s"(a));
    const Ctx F = make_ctx(wave0);
    for (int u = first; u < 512 + 32; u += stride) {
        if (u < 512) { const int b = u >> 6, hd = (u >> 4) & 3, qb = u & 15; attn_unit(a, F, b, hd, b * T + qb * 256, NKEY); }
        else { const int c = u - 512, b = c >> 2, hd = c & 3; attn_unit(a, F, b, hd, NLAT + b * TC, TC); }
    }
}
NI void ph_fin(KArgs a_, int wave0, int l, int M) { KArgs a = a_; asm volatile("" : "+s"(a)); const Ctx F = make_ctx(wave0); fin_load_consts(a, F, l); for (int tile = F.vcu; tile < M / 32; tile += F.G) fin_tile(a, F, l, tile); }


#ifdef DBG_CUT
NI void ph_dump(KArgs a_, int wave0) { KArgs a = a_; asm volatile("" : "+s"(a)); const Ctx F = make_ctx(wave0);
    const float* X = (const float*)(a->ws + WS_X); const bf16* Z = (const bf16*)(a->ws + WS_ACT); const bf16* Q = (const bf16*)(a->ws + WS_Q); const bf16* Kf = (const bf16*)(a->ws + WS_K); const bf16* Vt = (const bf16*)(a->ws + WS_VT);
    const bf16* YS = (const bf16*)(a->ws + WS_YS5); const bf16* YR = (const bf16*)(a->ws + WS_YR); const bf16* YM = (const bf16*)(a->ws + WS_YM); const bf16* MO = (const bf16*)(a->ws + WS_H); const bf16* Y = (const bf16*)(a->ws + WS_Y);
    const size_t DS = (size_t)NROWS * 256;
    for (size_t i = (size_t)F.vcu * NTHR + F.tid; i < (size_t)NLAT * D; i += (size_t)F.G * NTHR) {
#ifdef DBG_CTX
        const size_t r = NLAT + ((i >> 10) % NCTX);
#else
        const size_t r = i >> 10;
#endif
        const int c = (int)(i & 1023); float v = 0.f;
        if (DBG_WHICH & 1) v += X[r * D + c];
        if (DBG_WHICH & 2) { v += bf2f(Z[r * ZP + c]) + bf2f(Z[r * ZP + 1024 + c]); if (c + 2048 < ZP) v += bf2f(Z[r * ZP + 2048 + c]); }
        if (DBG_WHICH & 4) { v += bf2f(Q[r * 384 + c % 384]) + bf2f(Kf[r * 384 + c % 384]) + bf2f(Vt[i % ((size_t)NB * 4 * 64 * NKEY)]); }
        if (DBG_WHICH & 256) v += bf2f(Q[r * 384 + c % 384]);
        if (DBG_WHICH & 512) v += bf2f(Kf[r * 384 + c % 384]);
        if (DBG_WHICH & 1024) v += bf2f(Vt[i % ((size_t)NB * 4 * 64 * NKEY)]);
        if (DBG_WHICH & 2048) { const float* rc = (const float*)(a->ws + WS_ROPE); const bf16* sw = (const bf16*)(a->ws + WS_SMALLW); v += rc[i % (T * 32)] + bf2f(sw[i % 245760]); }
        if (DBG_WHICH & 8) v += bf2f(YS[r * 256 + (c & 255)]) + bf2f(YS[DS + r * 256 + (c & 255)]);
        if (DBG_WHICH & 16) v += bf2f(YR[r * 256 + (c & 255)]) + bf2f(YR[DS + r * 256 + (c & 255)]);
        if (DBG_WHICH & 32) v += bf2f(YM[r * 256 + (c & 255)]) + bf2f(YM[DS + r * 256 + (c & 255)]);
        if (DBG_WHICH & 64) v += bf2f(MO[r * D + c]);
        if (DBG_WHICH & 128) v += bf2f(Y[r * D + c]);
        a->out[i] = v;
    }
}
#endif
#if !MK_SPLIT
#if defined(ONLY_PH)
#define PHON(k) ((k) == ONLY_PH)
#elif defined(NO_PH)
#define PHON(k) ((k) != NO_PH)
#else
#define PHON(k) true
#endif
#if defined(ONLY_ROLE)
#define ROLE(k) ((k) == ONLY_ROLE)
#elif defined(NO_ROLE)
#define ROLE(k) ((k) != NO_ROLE)
#else
#define ROLE(k) true
#endif
#ifdef DUP_BAR
#define DUPBAR(x) x
#else
#define DUPBAR(x)
#endif
#ifdef DUP_ROLE
#ifndef DUP_N
#define DUP_N 2
#endif
#define NREPR(k) ((k) == DUP_ROLE ? DUP_N : 1)
#else
#define NREPR(k) 1
#endif
#ifdef DUP_PH
#define NREP(k) ((k) == DUP_PH ? 2 : 1)
#else
#define NREP(k) 1
#endif
constexpr int NPH = 2 + 12 * DEPTH;
__global__ void __launch_bounds__(NTHR, 2) hybrid_fwd(Args args_byval) {
    KArgs a = (KArgs)__builtin_amdgcn_kernarg_segment_ptr();
    LAS uchar* lds = (LAS uchar*)lds_raw;
    const int tid = threadIdx.x; const int wave0 = __builtin_amdgcn_readfirstlane(tid >> 6);
    volatile LAS unsigned* MISC = (volatile LAS unsigned*)(lds + MISC_OFF);
    for (int u = tid; u < (LDS_BYTES - LDSCTL_OFF) / 4; u += NTHR) ((LAS unsigned*)(lds + LDSCTL_OFF))[u] = 0u;
    __syncthreads();
    unsigned* ctl = (unsigned*)(a->ws + WS_CTL);
    const int use_bar = a->use_bar;
    XcdBarrier bar; bar.bar = ctl + CW_BAR; bar.x = 0; bar.st = nullptr;
    if (use_bar) bar = xcd_barrier_post(ctl + CW_BAR, MISC + 8, tid == 0);
    const int lo = a->ph_lo, hi = a->ph_hi;
    const int G = gridDim.x; const int vcu = (G % 8 == 0) ? ((int)blockIdx.x % 8) * (G / 8) + (int)blockIdx.x / 8 : (int)blockIdx.x;
#ifdef DBG_CUT
#define IN(k) (lo <= (k) && (k) < hi && (k) < DBG_CUT)
#else
#define IN(k) (lo <= (k) && (k) < hi)
#endif
#define SEAM(k) do { if (use_bar && IN(k) && IN((k) + 1)) { int ln_ = __builtin_amdgcn_mbcnt_hi(~0u, __builtin_amdgcn_mbcnt_lo(~0u, 0u)); asm volatile("" : "+v"(ln_)); xcd_barrier(bar, wave0 == 0 && ln_ == 0); DUPBAR(xcd_barrier(bar, wave0 == 0 && ln_ == 0);) } } while (0)
    if (PHON(100) && IN(0)) ph_prologue(a, wave0);
#ifdef DUP_PROLOGUE
    if (PHON(100) && IN(0)) for (int rr_ = 0; rr_ < DUP_PROLOGUE; ++rr_) ph_prologue(a, wave0);
#endif
    SEAM(0);
#pragma unroll 1
    for (int l = 0; l < DEPTH; ++l) {
        const int P = 1 + 12 * l;
        const int Mtail = (l == DEPTH - 1) ? NLAT : NROWS;
        if (PHON(0) && IN(P + 0)) { ph_norm(a, wave0, l, 0);
#ifdef DUP_FIRSTNORM
            if (l == 0) for (int rr_ = 0; rr_ < DUP_FIRSTNORM; ++rr_) ph_norm(a, wave0, l, 0);
#endif
        }
        SEAM(P + 0);
        if (PHON(1) && IN(P + 1)) for (int rep_ = 0; rep_ < NREP(1); ++rep_) ph_gemm_swiglu(a, wave0, NROWS);
        SEAM(P + 1);
        if (PHON(2) && IN(P + 2)) for (int rep_ = 0; rep_ < NREP(2); ++rep_) ph_gemm_store(a, wave0, 0, NROWS);
        SEAM(P + 2);
        if (PHON(3) && IN(P + 3)) ph_norm(a, wave0, l, 1);
        SEAM(P + 3);
        if (PHON(4) && IN(P + 4)) for (int rep_ = 0; rep_ < NREP(4); ++rep_) ph_gemm_store(a, wave0, 1, NROWS);
        SEAM(P + 4);
#if MERGE_PREP
        if (PHON(6) && IN(P + 6) && G >= 256) {
            if (ROLE(0) && vcu < 64) { for (int rr_ = 0; rr_ < NREPR(0); ++rr_) ph_rwkv(a, wave0, l, vcu); }
            else if (ROLE(1) && vcu < 96) { for (int rr_ = 0; rr_ < NREPR(1); ++rr_) ph_mlstm(a, wave0, l, vcu - 64); }
            else if (ROLE(2) && vcu < 128) { for (int rr_ = 0; rr_ < NREPR(2); ++rr_) ph_s5(a, wave0, l, vcu - 96); }
            else if (ROLE(3)) {
                ph_mla_prep(a, wave0, l, vcu - 128, G - 128);
#ifdef DUP_PREP
                ph_mla_prep(a, wave0, l, vcu - 128, G - 128);
#endif
                { int ln_ = __builtin_amdgcn_mbcnt_hi(~0u, __builtin_amdgcn_mbcnt_lo(~0u, 0u)); asm volatile("" : "+v"(ln_)); att_subbarrier(ctl + CW_SUB + 64 * l, (unsigned)(G - 128), wave0 == 0 && ln_ == 0); }
                for (int rr_ = 0; rr_ < NREPR(3); ++rr_) ph_attn(a, wave0, vcu - 128, G - 128);
            }
        }
#else
        if (PHON(5) && IN(P + 5)) for (int rep_ = 0; rep_ < NREP(5); ++rep_) ph_mla_prep(a, wave0, l);
        SEAM(P + 5);
        if (PHON(6) && IN(P + 6) && G >= 256) for (int rep_ = 0; rep_ < NREP(6); ++rep_) {
            if (ROLE(0) && vcu < 64) { for (int rr_ = 0; rr_ < NREPR(0); ++rr_) ph_rwkv(a, wave0, l, vcu); }
            else if (ROLE(1) && vcu < 96) { for (int rr_ = 0; rr_ < NREPR(1); ++rr_) ph_mlstm(a, wave0, l, vcu - 64); }
            else if (ROLE(2) && vcu < 128) { for (int rr_ = 0; rr_ < NREPR(2); ++rr_) ph_s5(a, wave0, l, vcu - 96); }
            else if (ROLE(3)) { for (int rr_ = 0; rr_ < NREPR(3); ++rr_) ph_attn(a, wave0, vcu - 128, G - 128); }
        }
#endif
        SEAM(P + 6);
        if (PHON(7) && IN(P + 7)) for (int rep_ = 0; rep_ < NREP(7); ++rep_) ph_fin(a, wave0, l, Mtail);
        SEAM(P + 7);
        if (PHON(8) && IN(P + 8)) for (int rep_ = 0; rep_ < NREP(8); ++rep_) ph_gemm_store(a, wave0, 2, Mtail);
        SEAM(P + 8);
        if (PHON(9) && IN(P + 9)) ph_norm(a, wave0, l, 2);
        SEAM(P + 9);
        if (PHON(10) && IN(P + 10)) ph_gemm_swiglu(a, wave0, Mtail);
        SEAM(P + 10);
        if (PHON(11) && IN(P + 11)) ph_gemm_store(a, wave0, 0, Mtail);
        SEAM(P + 11);
    }
#ifdef DBG_CUT
    if (lo <= NPH - 1 && NPH - 1 < hi) ph_dump(a, wave0);
#else
    if (PHON(101) && IN(NPH - 1)) ph_norm(a, wave0, DEPTH - 1, 3);
#endif
#undef IN
#undef SEAM
}

#endif
#if MK_SPLIT
struct ArgsS { Args base; int kind, l, sub, M; };
typedef const __attribute__((address_space(4))) ArgsS* KArgsS;
template <int KIND>
__global__ void __launch_bounds__(NTHR, 2) phase_kernel(ArgsS args_byval) {
    KArgsS as = (KArgsS)__builtin_amdgcn_kernarg_segment_ptr();
    KArgs a = (KArgs)as;
    const int tid = threadIdx.x; const int wave0 = __builtin_amdgcn_readfirstlane(tid >> 6);
    const int l = as->l, sub = as->sub, M = as->M;
    const int G = gridDim.x; const int vcu = (G % 8 == 0) ? ((int)blockIdx.x % 8) * (G / 8) + (int)blockIdx.x / 8 : (int)blockIdx.x;
    if constexpr (KIND == 0) ph_prologue(a, wave0);
    if constexpr (KIND == 1) ph_norm(a, wave0, l, sub);
    if constexpr (KIND == 2) ph_gemm_swiglu(a, wave0, M);
    if constexpr (KIND == 3) ph_gemm_store(a, wave0, sub, M);
    if constexpr (KIND == 4) ph_mla_prep(a, wave0, l, vcu, G);
    if constexpr (KIND == 5) { if (vcu < 64) ph_rwkv(a, wave0, l, vcu); }
    if constexpr (KIND == 6) { if (vcu >= 64 && vcu < 96) ph_mlstm(a, wave0, l, vcu - 64); }
    if constexpr (KIND == 7) { if (vcu >= 96 && vcu < 128) ph_s5(a, wave0, l, vcu - 96); }
    if constexpr (KIND == 8) { if (vcu >= 128) ph_attn(a, wave0, vcu - 128, G - 128); }
    if constexpr (KIND == 9) ph_fin(a, wave0, l, M);
}
template <int KIND> static void launch_phase(int grid, hipStream_t stream, const Args& base, int l, int sub, int M) {
    static bool attr = false;
    if (!attr) { (void)hipFuncSetAttribute((const void*)phase_kernel<KIND>, hipFuncAttributeMaxDynamicSharedMemorySize, LDS_BYTES); attr = true; }
    ArgsS s{}; s.base = base; s.kind = KIND; s.l = l; s.sub = sub; s.M = M;
    hipLaunchKernelGGL(phase_kernel<KIND>, dim3(grid), dim3(NTHR), LDS_BYTES, stream, s);
}
static void launch_split(int grid, hipStream_t stream, const Args& a) {
    launch_phase<0>(grid, stream, a, 0, 0, 0);
    for (int l = 0; l < DEPTH; ++l) {
        const int Mtail = (l == DEPTH - 1) ? NLAT : NROWS;
        launch_phase<1>(grid, stream, a, l, 0, 0);
        launch_phase<2>(grid, stream, a, l, 0, NROWS);
        launch_phase<3>(grid, stream, a, l, 0, NROWS);
        launch_phase<1>(grid, stream, a, l, 1, 0);
        launch_phase<3>(grid, stream, a, l, 1, NROWS);
        launch_phase<4>(grid, stream, a, l, 0, 0);
        launch_phase<5>(grid, stream, a, l, 0, 0);
        launch_phase<6>(grid, stream, a, l, 0, 0);
        launch_phase<7>(grid, stream, a, l, 0, 0);
        launch_phase<8>(grid, stream, a, l, 0, 0);
        launch_phase<9>(grid, stream, a, l, 0, Mtail);
        launch_phase<3>(grid, stream, a, l, 2, Mtail);
        launch_phase<1>(grid, stream, a, l, 2, 0);
        launch_phase<2>(grid, stream, a, l, 0, Mtail);
        launch_phase<3>(grid, stream, a, l, 0, Mtail);
    }
    launch_phase<1>(grid, stream, a, DEPTH - 1, 3, 0);
}
#endif
extern "C" void kernel_launch(void* const* d_in, const int* in_sizes, int n_in, void* d_out, int out_size, void* d_ws, size_t ws_size, hipStream_t stream) {
    static int grid = 0;
    if (grid == 0) {
        if (n_in != 43 || out_size != NLAT * D || ws_size < WS_END) { fprintf(stderr, "kernel_launch: unexpected shapes: n_in %d out %d ws %zu (need %zu)\n", n_in, out_size, ws_size, (size_t)WS_END); grid = -1; return; }
        int dev = 0, cus = 0, per_cu = 0;
        if (hipGetDevice(&dev) != hipSuccess || hipDeviceGetAttribute(&cus, hipDeviceAttributeMultiprocessorCount, dev) != hipSuccess) { grid = -1; return; }
        if (false) { grid = -1; return; }
        (void)hipGetLastError();
        grid = cus;
    }
    if (grid < 0) return;
    (void)hipMemsetAsync((char*)d_ws + WS_CTL, 0, CTL_ZERO_BYTES, stream);
    Args a{};
    for (int i = 0; i < 43; ++i) a.in[i] = (const float*)d_in[i];
    a.out = (float*)d_out; a.ws = (unsigned char*)d_ws; a.pad = 0;
#if MK_SPLIT
    launch_split(grid, stream, a);
#else
    static bool attr1 = false; if (!attr1) { (void)hipFuncSetAttribute((const void*)hybrid_fwd, hipFuncAttributeMaxDynamicSharedMemorySize, LDS_BYTES); attr1 = true; }
    a.ph_lo = 0; a.ph_hi = NPH; a.use_bar = 1;
    hipLaunchKernelGGL(hybrid_fwd, dim3(grid), dim3(NTHR), LDS_BYTES, stream, a);
#endif
}
```
